# Optimizing an MI355X kernel written in HIP

```python
import jax, jax.numpy as jnp
from jax import lax
import numpy as np

D_MODEL = 2048
BATCH = 1
SEQ = 8192
DEPTH = 2

ROPE_THETA = 500000.0
Q_BLOCK = 128
MLA_HEADS = 8
MLA_Q_LORA = 512
MLA_KV_LORA = 256
MLA_NOPE = 128
MLA_ROPE = 64
MLA_V = 128
DSA_HEADS = 8
DSA_KV_HEADS = 2
DSA_HEAD_DIM = 128
DSA_ROT = DSA_HEAD_DIM // 4
IDX_HEADS = 16
IDX_DIM = 64
IDX_ROT = IDX_DIM // 4
IDX_TOPK_MAX = 256
RET_HEADS = 8
RET_QK_DIM = 256
RET_V_DIM = 512
RET_CHUNK = 128
RET_THETA = 10000.0
N_EXPERTS = 64
N_GROUPS = 8
EXPERTS_PER_GROUP = N_EXPERTS // N_GROUPS
TOP_K = 2
D_EXPERT = 512
D_SHARED = 1024
DEEPNORM_ALPHA = (2.0 * DEPTH) ** 0.25
DEEPNORM_BETA = (8.0 * DEPTH) ** -0.25

SPLITS_AB = (MLA_Q_LORA, MLA_KV_LORA, MLA_ROPE, DSA_HEADS * DSA_HEAD_DIM,
             2 * DSA_KV_HEADS * DSA_HEAD_DIM, IDX_HEADS * IDX_DIM, IDX_DIM, IDX_HEADS)
IN_AB = sum(SPLITS_AB)
OUT_AB = MLA_HEADS * MLA_V + DSA_HEADS * DSA_HEAD_DIM
SPLITS_C = (RET_HEADS * RET_QK_DIM, RET_HEADS * RET_QK_DIM, RET_HEADS * RET_V_DIM, RET_HEADS * RET_V_DIM)
IN_C = sum(SPLITS_C)
OUT_C = RET_HEADS * RET_V_DIM

kernel_name = 'hybrid_mla_dsa_retention_grouped_moe'


def split_cols(h, sizes):
    return jnp.split(h, [int(c) for c in np.cumsum(sizes)[:-1]], axis=-1)


def layernorm(x, g, b, eps=1e-5):
    xf = x.astype(jnp.float32)
    mu = xf.mean(-1, keepdims=True)
    var = jnp.square(xf - mu).mean(-1, keepdims=True)
    return ((xf - mu) * lax.rsqrt(var + eps) * g + b).astype(x.dtype)


def rmsnorm(x, g, eps=1e-6):
    xf = x.astype(jnp.float32)
    return (xf * lax.rsqrt(jnp.mean(xf * xf, -1, keepdims=True) + eps) * g).astype(x.dtype)


def rotary(x, pos, rot_dim, theta):
    half = rot_dim // 2
    inv = (1.0 / (theta ** (np.arange(half, dtype=np.float32) / half))).astype(np.float32)
    ang = pos.astype(jnp.float32)[..., None] * inv
    cos = jnp.cos(ang)[:, :, None, :]
    sin = jnp.sin(ang)[:, :, None, :]
    x1 = x[..., :half].astype(jnp.float32)
    x2 = x[..., half:rot_dim].astype(jnp.float32)
    rot = jnp.concatenate([x1 * cos - x2 * sin, x1 * sin + x2 * cos], -1).astype(x.dtype)
    return jnp.concatenate([rot, x[..., rot_dim:]], -1)


def to_blocks(t):
    nb = t.shape[1] // Q_BLOCK
    return jnp.moveaxis(t.reshape((t.shape[0], nb, Q_BLOCK) + t.shape[2:]), 1, 0)


def from_blocks(o):
    return jnp.moveaxis(o, 0, 1).reshape((o.shape[1], o.shape[0] * o.shape[2]) + o.shape[3:])


def dense_causal_attention(q, k, v, scale):
    S = q.shape[1]
    key_idx = jnp.arange(S)

    def block(args):
        i, qi = args
        q_idx = i * Q_BLOCK + jnp.arange(Q_BLOCK)
        s = jnp.einsum('bqhd,bkhd->bhqk', qi, k).astype(jnp.float32) * scale
        s = jnp.where(key_idx[None, :] <= q_idx[:, None], s, -jnp.inf)
        p = jax.nn.softmax(s, axis=-1).astype(v.dtype)
        o = jnp.einsum('bhqk,bkhd->bqhd', p, v)
        return o.reshape(o.shape[0], Q_BLOCK, -1)

    out = lax.map(block, (jnp.arange(S // Q_BLOCK), to_blocks(q)))
    return from_blocks(out)


def dsa_attention(q, k, v, iq, ik, iw):
    B, S = q.shape[:2]
    n_sel = min(IDX_TOPK_MAX, S // 4)
    rep = DSA_HEADS // DSA_KV_HEADS
    key_idx = jnp.arange(S)
    gather = jax.vmap(lambda t, idx: t[idx])

    def block(args):
        i, qi, iqi, iwi = args
        q_idx = i * Q_BLOCK + jnp.arange(Q_BLOCK)
        rel = jax.nn.relu(jnp.einsum('bqhd,bkd->bqhk', iqi, ik).astype(jnp.float32) * IDX_DIM ** -0.5)
        score = jnp.einsum('bqh,bqhk->bqk', iwi.astype(jnp.float32), rel)
        score = jnp.where(key_idx[None, None, :] <= q_idx[None, :, None], score, -jnp.inf)
        _, sel = lax.top_k(score, n_sel)
        valid = sel <= q_idx[None, :, None]
        ks = gather(k, sel)
        vs = gather(v, sel)
        qg = qi.reshape(B, Q_BLOCK, DSA_KV_HEADS, rep, DSA_HEAD_DIM)
        s = jnp.einsum('bqgrd,bqkgd->bqgrk', qg, ks).astype(jnp.float32) * DSA_HEAD_DIM ** -0.5
        s = jnp.where(valid[:, :, None, None, :], s, -jnp.inf)
        p = jax.nn.softmax(s, axis=-1).astype(v.dtype)
        o = jnp.einsum('bqgrk,bqkgd->bqgrd', p, vs)
        return o.reshape(B, Q_BLOCK, DSA_HEADS * DSA_HEAD_DIM)

    out = lax.map(block, (jnp.arange(S // Q_BLOCK), to_blocks(q), to_blocks(iq), to_blocks(iw)))
    return from_blocks(out)


def mla_dsa_mixer(x, pos, w_in, q_norm, w_uq, kv_norm, w_ukv, w_out):
    B, S, _ = x.shape
    cq, ckv, krope, dq, dkv, iq, ik, iw = split_cols(x @ w_in, SPLITS_AB)
    qa = (rmsnorm(cq, q_norm) @ w_uq).reshape(B, S, MLA_HEADS, MLA_NOPE + MLA_ROPE)
    qa = jnp.concatenate([qa[..., :MLA_NOPE], rotary(qa[..., MLA_NOPE:], pos, MLA_ROPE, ROPE_THETA)], -1)
    kva = (rmsnorm(ckv, kv_norm) @ w_ukv).reshape(B, S, MLA_HEADS, MLA_NOPE + MLA_V)
    k_pe = rotary(krope[:, :, None, :], pos, MLA_ROPE, ROPE_THETA)
    ka = jnp.concatenate([kva[..., :MLA_NOPE],
                          jnp.broadcast_to(k_pe, (B, S, MLA_HEADS, MLA_ROPE))], -1)
    va = kva[..., MLA_NOPE:]
    out_a = dense_causal_attention(qa, ka, va, (MLA_NOPE + MLA_ROPE) ** -0.5)
    qb = rotary(dq.reshape(B, S, DSA_HEADS, DSA_HEAD_DIM), pos, DSA_ROT, ROPE_THETA)
    kvb = dkv.reshape(B, S, 2, DSA_KV_HEADS, DSA_HEAD_DIM)
    kb = rotary(kvb[:, :, 0], pos, DSA_ROT, ROPE_THETA)
    vb = kvb[:, :, 1]
    iq = rotary(iq.reshape(B, S, IDX_HEADS, IDX_DIM), pos, IDX_ROT, ROPE_THETA)
    ik = rotary(ik[:, :, None, :], pos, IDX_ROT, ROPE_THETA)[:, :, 0]
    iw = iw * IDX_HEADS ** -0.5
    out_b = dsa_attention(qb, kb, vb, iq, ik, iw)
    return jnp.concatenate([out_a, out_b], -1) @ w_out


def retention_mixer(x, pos, w_in, gn_g, gn_b, w_out):
    B, S, _ = x.shape
    H, DK, DV, C = RET_HEADS, RET_QK_DIM, RET_V_DIM, RET_CHUNK
    q, k, v, g = split_cols(x @ w_in, SPLITS_C)
    q = rotary(q.reshape(B, S, H, DK), pos, DK, RET_THETA)
    k = rotary(k.reshape(B, S, H, DK), pos, DK, RET_THETA) * DK ** -0.5
    v = v.reshape(B, S, H, DV)
    log_g = np.log(1.0 - 2.0 ** (-5.0 - np.arange(H, dtype=np.float32))).astype(np.float32)
    idx = np.arange(C, dtype=np.float32)
    diff = idx[:, None] - idx[None, :]
    decay_in = jnp.where(diff[None] >= 0, jnp.exp(jnp.maximum(diff, 0.0)[None] * log_g[:, None, None]), 0.0)
    xi = jnp.exp((idx + 1.0)[None, :] * log_g[:, None])
    zeta = jnp.exp((C - 1.0 - idx)[None, :] * log_g[:, None])
    chunk_decay = jnp.exp(C * log_g)
    n = S // C
    chunks = lambda t: jnp.transpose(t.reshape(B, n, C, H, t.shape[-1]), (1, 0, 3, 2, 4))

    def step(R, inp):
        qi, ki, vi = inp
        inner = jnp.einsum('bhqd,bhkd->bhqk', qi, ki).astype(jnp.float32) * decay_in
        o = jnp.einsum('bhqk,bhkv->bhqv', inner, vi.astype(jnp.float32)) \
            + jnp.einsum('bhqd,bhdv->bhqv', qi.astype(jnp.float32), R) * xi[None, :, :, None]
        R = chunk_decay[None, :, None, None] * R + jnp.einsum(
            'bhkd,bhkv->bhdv', ki.astype(jnp.float32) * zeta[None, :, :, None], vi.astype(jnp.float32))
        return R, o

    R0 = jnp.zeros((B, H, DK, DV), jnp.float32)
    _, o = lax.scan(step, R0, (chunks(q), chunks(k), chunks(v)))
    o = jnp.transpose(o, (1, 0, 3, 2, 4)).reshape(B, S, H, DV)
    mu = o.mean(-1, keepdims=True)
    var = jnp.square(o - mu).mean(-1, keepdims=True)
    y = ((o - mu) * lax.rsqrt(var + 1e-5)).reshape(B, S, H * DV) * gn_g + gn_b
    return (jax.nn.silu(g.astype(jnp.float32)) * y).astype(x.dtype) @ w_out


def grouped_moe(x, router_w, router_b, w_gate, w_up, w_down, sh_gate, sh_up, sh_down):
    B, S, D = x.shape
    T = B * S
    xt = x.reshape(T, D)
    scores = jax.nn.sigmoid((xt @ router_w).astype(jnp.float32))
    biased = (scores + router_b).reshape(T, N_GROUPS, EXPERTS_PER_GROUP)
    group_score = lax.top_k(biased, 2)[0].sum(-1)
    gsel = jnp.argmax(group_score, axis=-1)
    in_group = jnp.take_along_axis(biased, gsel[:, None, None], axis=1)[:, 0]
    _, loc = lax.top_k(in_group, TOP_K)
    expert = gsel[:, None] * EXPERTS_PER_GROUP + loc
    gate = jnp.take_along_axis(scores, expert, axis=1)
    gate = gate / gate.sum(-1, keepdims=True)
    flat_e = expert.reshape(-1)
    order = jnp.argsort(flat_e)
    tok = order // TOP_K
    xs = xt[tok]
    sizes = jnp.bincount(flat_e, length=N_EXPERTS).astype(jnp.int32)
    h = jax.nn.silu(lax.ragged_dot(xs, w_gate, sizes)) * lax.ragged_dot(xs, w_up, sizes)
    y = lax.ragged_dot(h, w_down, sizes).astype(jnp.float32) * gate.reshape(-1)[order][:, None]
    routed = jnp.zeros((T, D), jnp.float32).at[tok].add(y)
    shared = (jax.nn.silu(xt @ sh_gate) * (xt @ sh_up)) @ sh_down
    return (routed + shared.astype(jnp.float32)).astype(x.dtype).reshape(B, S, D)


def setup_inputs(seed: int = 0) -> dict:
    key = jax.random.key(seed)
    ks = iter(jax.random.split(key, 64))
    nrm = lambda shape, scale: jax.random.normal(next(ks), shape, jnp.float32) * scale
    gain = lambda n: 1.0 + nrm((n,), 0.02)
    bias = lambda n: nrm((n,), 0.02)
    d = D_MODEL
    p = {}
    p['x'] = nrm((BATCH, SEQ, d), 1.0)
    p['positions'] = jnp.broadcast_to(jnp.arange(SEQ, dtype=jnp.int32), (BATCH, SEQ))
    p['router_w'] = nrm((d, N_EXPERTS), d ** -0.5)
    p['router_b'] = nrm((N_EXPERTS,), 0.01)
    p['l0_w_in'] = nrm((d, IN_AB), d ** -0.5)
    p['l0_mla_q_norm'] = gain(MLA_Q_LORA)
    p['l0_mla_w_uq'] = nrm((MLA_Q_LORA, MLA_HEADS * (MLA_NOPE + MLA_ROPE)), MLA_Q_LORA ** -0.5)
    p['l0_mla_kv_norm'] = gain(MLA_KV_LORA)
    p['l0_mla_w_ukv'] = nrm((MLA_KV_LORA, MLA_HEADS * (MLA_NOPE + MLA_V)), MLA_KV_LORA ** -0.5)
    p['l0_w_out'] = nrm((OUT_AB, d), OUT_AB ** -0.5 * DEEPNORM_BETA)
    p['l1_w_in'] = nrm((d, IN_C), d ** -0.5)
    p['l1_ret_gn_g'] = gain(OUT_C)
    p['l1_ret_gn_b'] = bias(OUT_C)
    p['l1_w_out'] = nrm((OUT_C, d), OUT_C ** -0.5 * DEEPNORM_BETA)
    for l in range(DEPTH):
        p['l%d_ln_mix_g' % l] = gain(d)
        p['l%d_ln_mix_b' % l] = bias(d)
        p['l%d_moe_w_gate' % l] = nrm((N_EXPERTS, d, D_EXPERT), d ** -0.5)
        p['l%d_moe_w_up' % l] = nrm((N_EXPERTS, d, D_EXPERT), d ** -0.5)
        p['l%d_moe_w_down' % l] = nrm((N_EXPERTS, D_EXPERT, d), D_EXPERT ** -0.5 * DEEPNORM_BETA)
        p['l%d_sh_gate' % l] = nrm((d, D_SHARED), d ** -0.5)
        p['l%d_sh_up' % l] = nrm((d, D_SHARED), d ** -0.5)
        p['l%d_sh_down' % l] = nrm((D_SHARED, d), D_SHARED ** -0.5 * DEEPNORM_BETA)
        p['l%d_ln_ffn_g' % l] = gain(d)
        p['l%d_ln_ffn_b' % l] = bias(d)
    return p


def reference(x, positions, router_w, router_b,
              l0_w_in, l0_mla_q_norm, l0_mla_w_uq, l0_mla_kv_norm, l0_mla_w_ukv, l0_w_out,
              l1_w_in, l1_ret_gn_g, l1_ret_gn_b, l1_w_out,
              l0_ln_mix_g, l0_ln_mix_b, l0_moe_w_gate, l0_moe_w_up, l0_moe_w_down,
              l0_sh_gate, l0_sh_up, l0_sh_down, l0_ln_ffn_g, l0_ln_ffn_b,
              l1_ln_mix_g, l1_ln_mix_b, l1_moe_w_gate, l1_moe_w_up, l1_moe_w_down,
              l1_sh_gate, l1_sh_up, l1_sh_down, l1_ln_ffn_g, l1_ln_ffn_b):
    ln_mix = ((l0_ln_mix_g, l0_ln_mix_b), (l1_ln_mix_g, l1_ln_mix_b))
    ln_ffn = ((l0_ln_ffn_g, l0_ln_ffn_b), (l1_ln_ffn_g, l1_ln_ffn_b))
    experts = ((l0_moe_w_gate, l0_moe_w_up, l0_moe_w_down, l0_sh_gate, l0_sh_up, l0_sh_down),
               (l1_moe_w_gate, l1_moe_w_up, l1_moe_w_down, l1_sh_gate, l1_sh_up, l1_sh_down))
    for layer in range(DEPTH):
        if layer % 2 == 0:
            mix = mla_dsa_mixer(x, positions, l0_w_in, l0_mla_q_norm, l0_mla_w_uq,
                                l0_mla_kv_norm, l0_mla_w_ukv, l0_w_out)
        else:
            mix = retention_mixer(x, positions, l1_w_in, l1_ret_gn_g, l1_ret_gn_b, l1_w_out)
        x = layernorm(DEEPNORM_ALPHA * x + mix, *ln_mix[layer])
        x = layernorm(DEEPNORM_ALPHA * x + grouped_moe(x, router_w, router_b, *experts[layer]), *ln_ffn[layer])
    return x
```

```cpp
#include <hip/hip_runtime.h>
#include <stdint.h>

typedef unsigned short u16;
typedef __attribute__((ext_vector_type(8))) short bf16x8;
typedef __attribute__((ext_vector_type(4))) float f32x4;
typedef __attribute__((ext_vector_type(2))) float f32x2;
typedef __attribute__((ext_vector_type(4))) unsigned u32x4;
typedef __attribute__((ext_vector_type(2))) unsigned u32x2;
typedef __attribute__((ext_vector_type(2))) __bf16 bf16x2_t;

#define XB_TMO      128
#define XB_XCNT(j)  (256  + 64 * (j))
#define XB_XSUB(j)  (1280 + 64 * (j))
#define XB_XGEN(j)  (2304 + 64 * (j))
#define XB_TOP      3328
#define XB_TOPGEN   3392
#define XCD_BAR_WORDS 3456
#define XB_SPIN_CAP (1u << 22)
#define LAS __attribute__((address_space(3)))

__device__ __forceinline__ unsigned xb_ld(unsigned* p)              { return __hip_atomic_load(p, __ATOMIC_RELAXED, __HIP_MEMORY_SCOPE_AGENT); }
__device__ __forceinline__ unsigned xb_add(unsigned* p, unsigned v) { return __hip_atomic_fetch_add(p, v, __ATOMIC_RELAXED, __HIP_MEMORY_SCOPE_AGENT); }
__device__ __forceinline__ unsigned xb_xcc_id() { return (unsigned)__builtin_amdgcn_s_getreg((3 << 11) | 20) & 0xFu; }
#define XB_SPIN(cond, bar) do { unsigned _sp = 0; while (cond) { __builtin_amdgcn_s_sleep(1); \
    if ((++_sp & 255u) == 0u) { if (xb_ld(&(bar)[XB_TMO])) break; if (_sp > XB_SPIN_CAP) { atomicAdd(&(bar)[XB_TMO], 1u); break; } } } } while (0)

struct XcdBarrier { unsigned* bar; unsigned x; volatile LAS unsigned* st; };

__device__ __forceinline__ XcdBarrier xcd_barrier_post(unsigned* bar, volatile LAS unsigned* st) {
    XcdBarrier b; b.bar = bar; b.x = xb_xcc_id(); b.st = st;
    if (threadIdx.x == 0) (void)xb_add(&bar[XB_XCNT(b.x)], 1u);
    return b;
}
__device__ __forceinline__ void xcd_barrier_complete(unsigned* bar, unsigned x, unsigned& nloc, unsigned& nx) {
    const unsigned G = gridDim.x * gridDim.y * gridDim.z;
    unsigned sum, cnt, mine, sp = 0u;
    for (;;) {
        sum = 0u; cnt = 0u; mine = 0u;
#pragma unroll
        for (unsigned j = 0; j < 16; ++j) { const unsigned c = xb_ld(&bar[XB_XCNT(j)]); sum += c; cnt += (c > 0u) ? 1u : 0u; mine = (j == x) ? c : mine; }
        if (sum == G) break;
        __builtin_amdgcn_s_sleep(1);
        if ((++sp & 255u) == 0u) { if (xb_ld(&bar[XB_TMO])) break; if (sp > XB_SPIN_CAP) { atomicAdd(&bar[XB_TMO], 1u); break; } }
    }
    nloc = mine > 0u ? mine : 1u; nx = cnt > 0u ? cnt : 1u;
}
__device__ __forceinline__ void xcd_barrier(const XcdBarrier& b) {
    asm volatile("s_waitcnt vmcnt(0)" ::: "memory");
    __syncthreads();
    if (threadIdx.x == 0) {
        unsigned* bar = b.bar;
        __builtin_amdgcn_s_waitcnt(0);
        unsigned nloc = b.st[0], nx = b.st[1];
        if (nloc == 0u) { xcd_barrier_complete(bar, b.x, nloc, nx); b.st[0] = nloc; b.st[1] = nx; }
        const unsigned old = xb_add(&bar[XB_XSUB(b.x)], 1u);
        const unsigned gen = old / nloc;
        if (old + 1u == (gen + 1u) * nloc) {
            __builtin_amdgcn_fence(__ATOMIC_RELEASE, "agent");
            asm volatile("s_waitcnt vmcnt(0)" ::: "memory");
            const unsigned og = xb_add(&bar[XB_TOP], 1u);
            const unsigned tg = og / nx;
            if (og + 1u == (tg + 1u) * nx) xb_add(&bar[XB_TOPGEN], 1u);
            else XB_SPIN(xb_ld(&bar[XB_TOPGEN]) == tg, bar);
            __builtin_amdgcn_fence(__ATOMIC_ACQUIRE, "agent");
            xb_add(&bar[XB_XGEN(b.x)], 1u);
            asm volatile("s_waitcnt vmcnt(0)" ::: "memory");
        } else {
            XB_SPIN(xb_ld(&bar[XB_XGEN(b.x)]) == gen, bar);
            __builtin_amdgcn_fence(__ATOMIC_ACQUIRE, "agent");
            asm volatile("s_waitcnt vmcnt(0)" ::: "memory");
        }
    }
    __syncthreads();
}

__device__ __forceinline__ int ltid() { int t = threadIdx.x; asm volatile("" : "+v"(t)); return t; }
__device__ __forceinline__ u16 f2bf(float f) {
    unsigned u = __float_as_uint(f);
    u += 0x7fffu + ((u >> 16) & 1u);
    return (u16)(u >> 16);
}
__device__ __forceinline__ float bf2f(u16 h) { return __uint_as_float(((unsigned)h) << 16); }
__device__ __forceinline__ unsigned pack2(float a, float b) {
    f32x2 v = {a, b};
    bf16x2_t r = __builtin_convertvector(v, bf16x2_t);
    return *(unsigned*)&r;
}

__device__ __forceinline__ float wave_sum(float v) {
#pragma unroll
    for (int o = 32; o > 0; o >>= 1) v += __shfl_xor(v, o);
    return v;
}
__device__ __forceinline__ float wave_max(float v) {
#pragma unroll
    for (int o = 32; o > 0; o >>= 1) v = fmaxf(v, __shfl_xor(v, o));
    return v;
}
__device__ __forceinline__ int wave_isum(int v) {
#pragma unroll
    for (int o = 32; o > 0; o >>= 1) v += __shfl_xor(v, o);
    return v;
}
__device__ __forceinline__ float silu_f(float x) { return x / (1.f + __expf(-x)); }

#define T_ 8192
#define D_ 2048
#define IN_AB 3472
#define IN_C 12288
#define NT 256
#define ALPHA_ 1.4142135623730951f
#define LOG2E_ 1.4426950408889634f

#define BM 128
#define BN 128
#define BK 64
#define LROW 80
#define GEMM_LDS_BYTES (2 * BM * LROW * 2)

#define B_F32_KN 0
#define B_BF16_NK 1

typedef f32x4 Acc[4][4];

__device__ __forceinline__ void acc_zero(Acc& acc) {
#pragma unroll
    for (int m = 0; m < 4; ++m)
#pragma unroll
        for (int n = 0; n < 4; ++n) acc[m][n] = (f32x4){0.f, 0.f, 0.f, 0.f};
}

template <int BMODE, class ARow, class BSel>
__device__ __forceinline__ void gemm_accum(Acc& acc, const u16* __restrict__ A, int lda, ARow arow,
                                           const void* __restrict__ Bv, int ldb, BSel bsel,
                                           int K, u16* lds) {
    const int tid = ltid(), lane = tid & 63;
    const int wid = __builtin_amdgcn_readfirstlane(tid >> 6);
    const int wr = wid >> 1, wc = wid & 1, fr = lane & 15, fq = lane >> 4;
    u16* sA = lds;
    u16* sB = lds + BM * LROW;
    const int ac = tid & 7, ar0 = tid >> 3;
    const unsigned ao0 = (unsigned)arow(ar0) * (unsigned)lda + ac * 8;
    const unsigned ao1 = (unsigned)arow(ar0 + 32) * (unsigned)lda + ac * 8;
    const unsigned ao2 = (unsigned)arow(ar0 + 64) * (unsigned)lda + ac * 8;
    const unsigned ao3 = (unsigned)arow(ar0 + 96) * (unsigned)lda + ac * 8;
    u32x4 a0, a1, a2, a3;
    const int nk = K / BK;
    const int sa_w = ar0 * LROW + ac * 8;

    if constexpr (BMODE == B_F32_KN) {
        const int l = tid & 127, bkh = wid >> 1;
        const float* bbase = bsel.base((const float*)Bv, wid & 1) + (size_t)(bkh * 8) * ldb;
        const unsigned boff = bsel.off(l);
        const int sb_w = bsel.vcol(l) * LROW + bkh * 8;
        float bf[32];
#define GL_F32(k0) do { \
        const u16* Ak = A + (k0); \
        a0 = *(const u32x4*)(Ak + ao0); a1 = *(const u32x4*)(Ak + ao1); \
        a2 = *(const u32x4*)(Ak + ao2); a3 = *(const u32x4*)(Ak + ao3); \
        _Pragma("unroll") for (int kk = 0; kk < 4; ++kk) \
        _Pragma("unroll") for (int j = 0; j < 8; ++j) { \
            const float* rowp = bbase + (size_t)((k0) + kk * 16 + j) * ldb; \
            bf[kk * 8 + j] = rowp[boff]; } } while (0)
        GL_F32(0);
        for (int kt = 0; kt < nk; ++kt) {
            *(u32x4*)(sA + sa_w) = a0;
            *(u32x4*)(sA + sa_w + 32 * LROW) = a1;
            *(u32x4*)(sA + sa_w + 64 * LROW) = a2;
            *(u32x4*)(sA + sa_w + 96 * LROW) = a3;
#pragma unroll
            for (int kk = 0; kk < 4; ++kk) {
                u32x4 v;
                v.x = pack2(bf[kk * 8 + 0], bf[kk * 8 + 1]);
                v.y = pack2(bf[kk * 8 + 2], bf[kk * 8 + 3]);
                v.z = pack2(bf[kk * 8 + 4], bf[kk * 8 + 5]);
                v.w = pack2(bf[kk * 8 + 6], bf[kk * 8 + 7]);
                *(u32x4*)(sB + sb_w + kk * 16) = v;
            }
            __syncthreads();
            if (kt + 1 < nk) GL_F32((kt + 1) * BK);
#pragma unroll
            for (int ks = 0; ks < 2; ++ks) {
                bf16x8 af[4], bfr[4];
#pragma unroll
                for (int m = 0; m < 4; ++m) af[m] = *(const bf16x8*)(sA + (wr * 64 + m * 16 + fr) * LROW + ks * 32 + fq * 8);
#pragma unroll
                for (int n = 0; n < 4; ++n) bfr[n] = *(const bf16x8*)(sB + (wc * 64 + n * 16 + fr) * LROW + ks * 32 + fq * 8);
#pragma unroll
                for (int m = 0; m < 4; ++m)
#pragma unroll
                    for (int n = 0; n < 4; ++n)
                        acc[m][n] = __builtin_amdgcn_mfma_f32_16x16x32_bf16(af[m], bfr[n], acc[m][n], 0, 0, 0);
            }
            __syncthreads();
        }
#undef GL_F32
    } else {
        const u16* Bb = (const u16*)Bv;
        const unsigned bo0 = (unsigned)bsel(ar0) * (unsigned)ldb + ac * 8;
        const unsigned bo1 = (unsigned)bsel(ar0 + 32) * (unsigned)ldb + ac * 8;
        const unsigned bo2 = (unsigned)bsel(ar0 + 64) * (unsigned)ldb + ac * 8;
        const unsigned bo3 = (unsigned)bsel(ar0 + 96) * (unsigned)ldb + ac * 8;
        u32x4 b0, b1, b2, b3;
#define GL_BF(k0) do { \
        const u16* Ak = A + (k0); const u16* Bk = Bb + (k0); \
        a0 = *(const u32x4*)(Ak + ao0); a1 = *(const u32x4*)(Ak + ao1); \
        a2 = *(const u32x4*)(Ak + ao2); a3 = *(const u32x4*)(Ak + ao3); \
        b0 = *(const u32x4*)(Bk + bo0); b1 = *(const u32x4*)(Bk + bo1); \
        b2 = *(const u32x4*)(Bk + bo2); b3 = *(const u32x4*)(Bk + bo3); } while (0)
        GL_BF(0);
        for (int kt = 0; kt < nk; ++kt) {
            *(u32x4*)(sA + sa_w) = a0;
            *(u32x4*)(sA + sa_w + 32 * LROW) = a1;
            *(u32x4*)(sA + sa_w + 64 * LROW) = a2;
            *(u32x4*)(sA + sa_w + 96 * LROW) = a3;
            *(u32x4*)(sB + sa_w) = b0;
            *(u32x4*)(sB + sa_w + 32 * LROW) = b1;
            *(u32x4*)(sB + sa_w + 64 * LROW) = b2;
            *(u32x4*)(sB + sa_w + 96 * LROW) = b3;
            __syncthreads();
            if (kt + 1 < nk) GL_BF((kt + 1) * BK);
#pragma unroll
            for (int ks = 0; ks < 2; ++ks) {
                bf16x8 af[4], bfr[4];
#pragma unroll
                for (int m = 0; m < 4; ++m) af[m] = *(const bf16x8*)(sA + (wr * 64 + m * 16 + fr) * LROW + ks * 32 + fq * 8);
#pragma unroll
                for (int n = 0; n < 4; ++n) bfr[n] = *(const bf16x8*)(sB + (wc * 64 + n * 16 + fr) * LROW + ks * 32 + fq * 8);
#pragma unroll
                for (int m = 0; m < 4; ++m)
#pragma unroll
                    for (int n = 0; n < 4; ++n)
                        acc[m][n] = __builtin_amdgcn_mfma_f32_16x16x32_bf16(af[m], bfr[n], acc[m][n], 0, 0, 0);
            }
            __syncthreads();
        }
#undef GL_BF
    }
}

struct Params {
    const float* x; const int* pos; const float* router_w; const float* router_b;
    const float* w_in0; const float* q_norm; const float* w_uq; const float* kv_norm; const float* w_ukv; const float* w_out0;
    const float* w_in1; const float* gn_g; const float* gn_b; const float* w_out1;
    const float* ln_mix_g[2]; const float* ln_mix_b[2];
    const float* moe_wg[2]; const float* moe_wu[2]; const float* moe_wd[2];
    const float* sh_g[2]; const float* sh_u[2]; const float* sh_d[2];
    const float* ln_ffn_g[2]; const float* ln_ffn_b[2];
    float* out;
    unsigned* bar; unsigned* ctl;
    float* cosA; float* sinA; float* cosR; float* sinR;
    u16* xb; float* H0;
    u16* cqn; u16* ckvn; u16* kpe; u16* qb; u16* kb; u16* vb; u16* iqb; u16* ikb; float* iwf;
    u16* qa; u16* ka; u16* vaT;
    float* scores; u16* sel; u16* outcat;
    float* ybuf; float* xa; u16* xab; float* y2; float* xc; u16* xcb;
    int* tok_e; float* tok_g; int* list; u16* hbuf; u16* hsh; u16* yr;
    u16* qr; u16* qx; u16* kr; u16* kzT; u16* v1T; u16* sg; u16* KVt; u16* innerG; u16* obuf; u16* gated;
    int out_size; int pad_;
};
typedef const __attribute__((address_space(4))) Params* KP;
__device__ __forceinline__ KP getp() { KP kp = (KP)__builtin_amdgcn_kernarg_segment_ptr(); asm volatile("" : "+s"(kp)); return kp; }
#define CTL_FLAGS 0
#define CTL_QUEUE 16
#define CTL_CNT0 64
#define CTL_CNT1 128
#define CTL_WORDS 256

struct RowId { int base; __device__ __forceinline__ int operator()(int r) const { return base + r; } };
struct ColOff { int c0;
    __device__ __forceinline__ const float* base(const float* B, int) const { return B; }
    __device__ __forceinline__ unsigned off(int l) const { return (unsigned)(c0 + l); }
    __device__ __forceinline__ int vcol(int l) const { return l; } };
struct ColClampOff { int c0, n;
    __device__ __forceinline__ const float* base(const float* B, int) const { return B; }
    __device__ __forceinline__ unsigned off(int l) const { const int c = c0 + l; return (unsigned)(c < n ? c : n - 1); }
    __device__ __forceinline__ int vcol(int l) const { return l; } };

__device__ __forceinline__ void ph_prep(KP p) {
    const int gtid = blockIdx.x * NT + ltid(), gsz = gridDim.x * NT;
    for (size_t i = gtid; i < (size_t)T_ * D_ / 4; i += gsz) {
        float4 v = ((const float4*)p->x)[i];
        u32x2 o; o.x = pack2(v.x, v.y); o.y = pack2(v.z, v.w);
        ((u32x2*)p->xb)[i] = o;
    }
    const double inv2pi = 0.15915494309189535;
    for (int idx = gtid; idx < T_ * 32; idx += gsz) {
        const int t = idx >> 5, i = idx & 31;
        const float inv = (float)exp2(-(double)i * (18.931568569324174 / 32.0));
        double rev = (double)p->pos[t] * (double)inv * inv2pi;
        rev -= floor(rev);
        p->cosA[idx] = __builtin_amdgcn_cosf((float)rev);
        p->sinA[idx] = __builtin_amdgcn_sinf((float)rev);
    }
    for (int idx = gtid; idx < T_ * 128; idx += gsz) {
        const int t = idx >> 7, i = idx & 127;
        const float inv = (float)exp2(-(double)i * (13.287712379549449 / 128.0));
        double rev = (double)p->pos[t] * (double)inv * inv2pi;
        rev -= floor(rev);
        p->cosR[idx] = __builtin_amdgcn_cosf((float)rev);
        p->sinR[idx] = __builtin_amdgcn_sinf((float)rev);
    }
}

struct EpiF32 {
    float* C; int ldc; int row0, col0, ncols;
    __device__ __forceinline__ void operator()(Acc& acc, int wr0, int wc0, int fr, int fq) const {
#pragma unroll
        for (int m = 0; m < 4; ++m)
#pragma unroll
            for (int n = 0; n < 4; ++n) {
                const int c = col0 + wc0 + n * 16 + fr;
                if (c < ncols) {
#pragma unroll
                    for (int j = 0; j < 4; ++j)
                        C[(size_t)(row0 + wr0 + m * 16 + fq * 4 + j) * ldc + c] = acc[m][n][j];
                }
            }
    }
};
struct EpiBF16 {
    u16* C; int ldc; int row0, col0;
    __device__ __forceinline__ void operator()(Acc& acc, int wr0, int wc0, int fr, int fq) const {
#pragma unroll
        for (int m = 0; m < 4; ++m)
#pragma unroll
            for (int n = 0; n < 4; ++n) {
                const int c = col0 + wc0 + n * 16 + fr;
#pragma unroll
                for (int j = 0; j < 4; ++j)
                    C[(size_t)(row0 + wr0 + m * 16 + fq * 4 + j) * ldc + c] = f2bf(acc[m][n][j]);
            }
    }
};
struct EpiResid {
    float* C; const float* X; int ldc; int row0, col0;
    __device__ __forceinline__ void operator()(Acc& acc, int wr0, int wc0, int fr, int fq) const {
#pragma unroll
        for (int m = 0; m < 4; ++m)
#pragma unroll
            for (int n = 0; n < 4; ++n) {
                const int c = col0 + wc0 + n * 16 + fr;
#pragma unroll
                for (int j = 0; j < 4; ++j) {
                    const size_t o = (size_t)(row0 + wr0 + m * 16 + fq * 4 + j) * ldc + c;
                    C[o] = ALPHA_ * X[o] + acc[m][n][j];
                }
            }
    }
};

__device__ __forceinline__ void ph_post0(KP p) {
    const int lane = ltid() & 63;
    const int gw = (blockIdx.x * NT + ltid()) >> 6, nw = (gridDim.x * NT) >> 6;
    const float qscale = 0.08838834764831845f * LOG2E_;
    for (int t = gw; t < T_; t += nw) {
        const float* h = p->H0 + (size_t)t * IN_AB;
        const float* ca = p->cosA + t * 32;
        const float* sa = p->sinA + t * 32;
        {
            float v[8]; float ss = 0.f;
#pragma unroll
            for (int j = 0; j < 8; ++j) { v[j] = h[lane + 64 * j]; ss += v[j] * v[j]; }
            ss = wave_sum(ss);
            const float r = rsqrtf(ss * (1.f / 512.f) + 1e-6f);
#pragma unroll
            for (int j = 0; j < 8; ++j) p->cqn[(size_t)t * 512 + lane + 64 * j] = f2bf(v[j] * r * p->q_norm[lane + 64 * j]);
        }
        {
            float v[4]; float ss = 0.f;
#pragma unroll
            for (int j = 0; j < 4; ++j) { v[j] = h[512 + lane + 64 * j]; ss += v[j] * v[j]; }
            ss = wave_sum(ss);
            const float r = rsqrtf(ss * (1.f / 256.f) + 1e-6f);
#pragma unroll
            for (int j = 0; j < 4; ++j) p->ckvn[(size_t)t * 256 + lane + 64 * j] = f2bf(v[j] * r * p->kv_norm[lane + 64 * j]);
        }
        {
            const int i = lane & 31;
            const float c = ca[i], s = sa[i];
            const float x1 = h[768 + i], x2 = h[768 + 32 + i];
            p->kpe[(size_t)t * 64 + lane] = f2bf(lane < 32 ? x1 * c - x2 * s : x1 * s + x2 * c);
        }
#pragma unroll 4
        for (int j = 0; j < 16; ++j) {
            const int e = lane + 64 * j, hd = e >> 7, d = e & 127;
            float o;
            if (d < 32) {
                const int i = d & 15;
                const float c = ca[2 * i], s = sa[2 * i];
                const float x1 = h[832 + hd * 128 + i], x2 = h[832 + hd * 128 + 16 + i];
                o = d < 16 ? x1 * c - x2 * s : x1 * s + x2 * c;
            } else o = h[832 + e];
            p->qb[(size_t)t * 1024 + e] = f2bf(o * qscale);
        }
#pragma unroll
        for (int j = 0; j < 4; ++j) {
            const int e = lane + 64 * j, hd = e >> 7, d = e & 127;
            float o;
            if (d < 32) {
                const int i = d & 15;
                const float c = ca[2 * i], s = sa[2 * i];
                const float x1 = h[1856 + hd * 128 + i], x2 = h[1856 + hd * 128 + 16 + i];
                o = d < 16 ? x1 * c - x2 * s : x1 * s + x2 * c;
            } else o = h[1856 + e];
            p->kb[(size_t)t * 256 + e] = f2bf(o);
            p->vb[(size_t)t * 256 + e] = f2bf(h[2112 + e]);
        }
#pragma unroll 4
        for (int j = 0; j < 16; ++j) {
            const int e = lane + 64 * j, hd = e >> 6, d = e & 63;
            float o;
            if (d < 16) {
                const int i = d & 7;
                const float c = ca[4 * i], s = sa[4 * i];
                const float x1 = h[2368 + hd * 64 + i], x2 = h[2368 + hd * 64 + 8 + i];
                o = d < 8 ? x1 * c - x2 * s : x1 * s + x2 * c;
            } else o = h[2368 + e];
            p->iqb[(size_t)t * 1024 + e] = f2bf(o);
        }
        {
            const int d = lane;
            float o;
            if (d < 16) {
                const int i = d & 7;
                const float c = ca[4 * i], s = sa[4 * i];
                const float x1 = h[3392 + i], x2 = h[3392 + 8 + i];
                o = d < 8 ? x1 * c - x2 * s : x1 * s + x2 * c;
            } else o = h[3392 + d];
            p->ikb[(size_t)t * 64 + d] = f2bf(o);
        }
        if (lane < 16) p->iwf[t * 16 + lane] = h[3456 + lane] * 0.03125f;
    }
}

struct EpiQa {
    u16* C; const float* ca; const float* sa; int row0, col0;
    __device__ __forceinline__ void operator()(Acc& acc, int wr0, int wc0, int fr, int fq) const {
        const float sc = 0.07216878364870323f * LOG2E_;
        const int cbase = col0 + wc0;
        const bool rope = (cbase % 192) == 128;
#pragma unroll
        for (int m = 0; m < 4; ++m)
#pragma unroll
            for (int j = 0; j < 4; ++j) {
                const int r = row0 + wr0 + m * 16 + fq * 4 + j;
                float v[4];
#pragma unroll
                for (int n = 0; n < 4; ++n) v[n] = acc[m][n][j];
                if (rope) {
#pragma unroll
                    for (int n = 0; n < 2; ++n) {
                        const int i = n * 16 + fr;
                        const float c = ca[r * 32 + i], s = sa[r * 32 + i];
                        const float x1 = v[n], x2 = v[n + 2];
                        v[n] = x1 * c - x2 * s; v[n + 2] = x1 * s + x2 * c;
                    }
                }
#pragma unroll
                for (int n = 0; n < 4; ++n) C[(size_t)r * 1536 + cbase + n * 16 + fr] = f2bf(v[n] * sc);
            }
    }
};
struct EpiKva {
    u16* ka; u16* vaT; int row0, col0;
    __device__ __forceinline__ void operator()(Acc& acc, int wr0, int wc0, int fr, int fq) const {
        const int cbase = col0 + wc0;
        const int hd = cbase >> 8, within = cbase & 255;
#pragma unroll
        for (int m = 0; m < 4; ++m) {
            const int r = row0 + wr0 + m * 16 + fq * 4;
#pragma unroll
            for (int n = 0; n < 4; ++n) {
                const int c = within + n * 16 + fr;
                if (within < 128) {
#pragma unroll
                    for (int j = 0; j < 4; ++j) ka[(size_t)(r + j) * 1024 + hd * 128 + c] = f2bf(acc[m][n][j]);
                } else {
                    u32x2 o; o.x = pack2(acc[m][n][0], acc[m][n][1]); o.y = pack2(acc[m][n][2], acc[m][n][3]);
                    *(u32x2*)(vaT + (size_t)(hd * 128 + (c - 128)) * T_ + r) = o;
                }
            }
        }
    }
};

__device__ __forceinline__ void indexer_tile(KP p, int qt, int kt) {
    const int lane = ltid() & 63, wid = ltid() >> 6;
    const int wr = wid >> 1, wc = wid & 1, fr = lane & 15, fq = lane >> 4;
    const int k0 = kt * 128 + wr * 64, q0 = qt * 128 + wc * 64;
    bf16x8 af[4][2];
#pragma unroll
    for (int m = 0; m < 4; ++m)
#pragma unroll
        for (int ks = 0; ks < 2; ++ks)
            af[m][ks] = *(const bf16x8*)(p->ikb + (size_t)(k0 + m * 16 + fr) * 64 + ks * 32 + fq * 8);
    Acc sc; acc_zero(sc);
    for (int h = 0; h < 16; ++h) {
        bf16x8 bq[4][2]; float w[4];
#pragma unroll
        for (int n = 0; n < 4; ++n) {
            const size_t qrow = (size_t)(q0 + n * 16 + fr);
            bq[n][0] = *(const bf16x8*)(p->iqb + qrow * 1024 + h * 64 + fq * 8);
            bq[n][1] = *(const bf16x8*)(p->iqb + qrow * 1024 + h * 64 + 32 + fq * 8);
            w[n] = p->iwf[qrow * 16 + h];
        }
#pragma unroll
        for (int m = 0; m < 4; ++m)
#pragma unroll
            for (int n = 0; n < 4; ++n) {
                f32x4 d = (f32x4){0.f, 0.f, 0.f, 0.f};
                d = __builtin_amdgcn_mfma_f32_16x16x32_bf16(af[m][0], bq[n][0], d, 0, 0, 0);
                d = __builtin_amdgcn_mfma_f32_16x16x32_bf16(af[m][1], bq[n][1], d, 0, 0, 0);
#pragma unroll
                for (int j = 0; j < 4; ++j) sc[m][n][j] += w[n] * fmaxf(d[j], 0.f);
            }
    }
#pragma unroll
    for (int m = 0; m < 4; ++m)
#pragma unroll
        for (int n = 0; n < 4; ++n)
            *(f32x4*)(p->scores + (size_t)(q0 + n * 16 + fr) * T_ + k0 + m * 16 + fq * 4) = sc[m][n];
}

__device__ __forceinline__ unsigned fkey(float f) {
    const unsigned u = __float_as_uint(f);
    return (u & 0x80000000u) ? ~u : (u | 0x80000000u);
}
__device__ __forceinline__ void ph_topk(KP p, unsigned* lds32) {
    const int tid = ltid(), lane = tid & 63, wid = tid >> 6;
    for (int q = blockIdx.x; q < T_; q += gridDim.x) {
        u16* so = p->sel + (size_t)q * 256;
        if (q < 256) { so[tid] = (u16)(tid <= q ? tid : 0); continue; }
        unsigned key[32];
        const float* row = p->scores + (size_t)q * T_;
#pragma unroll
        for (int i = 0; i < 32; ++i) {
            const int idx = tid + 256 * i;
            key[i] = idx <= q ? fkey(row[idx]) : 0u;
        }
        unsigned prefix = 0u;
        for (int b = 31; b >= 0; --b) {
            const unsigned cand = prefix | (1u << b);
            int cnt = 0;
#pragma unroll
            for (int i = 0; i < 32; ++i) cnt += (key[i] >= cand) ? 1 : 0;
            cnt = wave_isum(cnt);
            unsigned* slot = lds32 + (b & 1) * 4;
            if (lane == 0) slot[wid] = (unsigned)cnt;
            __syncthreads();
            const unsigned tot = slot[0] + slot[1] + slot[2] + slot[3];
            if (tot >= 256u) prefix = cand;
        }
        int g = 0, e = 0;
#pragma unroll
        for (int i = 0; i < 32; ++i) { g += (key[i] > prefix) ? 1 : 0; e += (key[i] == prefix) ? 1 : 0; }
        unsigned v = ((unsigned)g << 16) | (unsigned)e;
        unsigned incl = v;
#pragma unroll
        for (int o = 1; o < 64; o <<= 1) { const unsigned t2 = __shfl_up(incl, o); if (lane >= o) incl += t2; }
        __syncthreads();
        if (lane == 63) lds32[8 + wid] = incl;
        __syncthreads();
        unsigned woff = 0, total = 0;
#pragma unroll
        for (int w = 0; w < 4; ++w) { const unsigned t2 = lds32[8 + w]; if (w < wid) woff += t2; total += t2; }
        const unsigned excl = woff + incl - v;
        int gpos = (int)(excl >> 16);
        int epos = (int)(total >> 16) + (int)(excl & 0xffffu);
#pragma unroll
        for (int i = 0; i < 32; ++i) {
            const int idx = tid + 256 * i;
            if (key[i] > prefix) { so[gpos++] = (u16)idx; }
            else if (key[i] == prefix) { if (epos < 256) so[epos] = (u16)idx; epos++; }
        }
        __syncthreads();
    }
}
#define KROW 208
#define VROW 80
#define ATT_LDS_BYTES (64 * KROW * 2 + 128 * VROW * 2)

__device__ __forceinline__ void mla_item(KP p, int h, int qb, u16* lds) {
    const int tid = ltid(), lane = tid & 63, wid = tid >> 6, fr = lane & 15, fq = lane >> 4;
    u16* sK = lds;
    u16* sV = lds + 64 * KROW;
    const int q0 = qb * 128;
    bf16x8 qf[2][6];
#pragma unroll
    for (int nq = 0; nq < 2; ++nq)
#pragma unroll
        for (int kc = 0; kc < 6; ++kc)
            qf[nq][kc] = *(const bf16x8*)(p->qa + (size_t)(q0 + wid * 32 + nq * 16 + fr) * 1536 + h * 192 + kc * 32 + fq * 8);
    f32x4 O[8][2];
#pragma unroll
    for (int m = 0; m < 8; ++m) { O[m][0] = (f32x4){0.f, 0.f, 0.f, 0.f}; O[m][1] = (f32x4){0.f, 0.f, 0.f, 0.f}; }
    float mrun[2] = {-1e30f, -1e30f}, lrun[2] = {0.f, 0.f};

    const int k0t = tid >> 4, k1t = tid >> 3;
    const u16* kpn = p->ka + (size_t)k0t * 1024 + h * 128 + (tid & 15) * 8;
    const u16* kpr = p->kpe + (size_t)k1t * 64 + (tid & 7) * 8;
    const u16* vpp = p->vaT + (size_t)(h * 128 + k1t) * T_ + (tid & 7) * 8;
    const int kln = (((k0t >> 2) & 1) * 16 + (k0t >> 3) * 4 + (k0t & 3)) * KROW + (tid & 15) * 8;
    const int klr = (((k1t >> 2) & 1) * 16 + (k1t >> 3) * 4 + (k1t & 3)) * KROW + 128 + (tid & 7) * 8;
    const int vl0 = k1t * VROW + (tid & 7) * 8;
    u32x4 kreg[6], vreg[4];
    const int ntiles = 2 * qb + 2;
#define ATT_GLOAD(kt) do { \
    _Pragma("unroll") for (int i = 0; i < 4; ++i) kreg[i] = *(const u32x4*)(kpn + (size_t)((kt) * 64 + 16 * i) * 1024); \
    _Pragma("unroll") for (int i = 0; i < 2; ++i) kreg[4 + i] = *(const u32x4*)(kpr + (size_t)((kt) * 64 + 32 * i) * 64); \
    _Pragma("unroll") for (int i = 0; i < 4; ++i) vreg[i] = *(const u32x4*)(vpp + (size_t)(32 * i) * T_ + (kt) * 64); } while (0)
    ATT_GLOAD(0);
    for (int kt = 0; kt < ntiles; ++kt) {
#pragma unroll
        for (int i = 0; i < 4; ++i) *(u32x4*)(sK + kln + (8 * (i & 1) + 32 * (i >> 1)) * KROW) = kreg[i];
#pragma unroll
        for (int i = 0; i < 2; ++i) *(u32x4*)(sK + klr + 32 * i * KROW) = kreg[4 + i];
#pragma unroll
        for (int i = 0; i < 4; ++i) *(u32x4*)(sV + vl0 + 32 * i * VROW) = vreg[i];
        __syncthreads();
        if (kt + 1 < ntiles) ATT_GLOAD(kt + 1);
        f32x4 s[2][4];
#pragma unroll
        for (int n = 0; n < 4; ++n) { s[0][n] = (f32x4){0.f, 0.f, 0.f, 0.f}; s[1][n] = (f32x4){0.f, 0.f, 0.f, 0.f}; }
#pragma unroll
        for (int kc = 0; kc < 6; ++kc)
#pragma unroll
            for (int n = 0; n < 4; ++n) {
                const bf16x8 a = *(const bf16x8*)(sK + (n * 16 + fr) * KROW + kc * 32 + fq * 8);
                s[0][n] = __builtin_amdgcn_mfma_f32_16x16x32_bf16(a, qf[0][kc], s[0][n], 0, 0, 0);
                s[1][n] = __builtin_amdgcn_mfma_f32_16x16x32_bf16(a, qf[1][kc], s[1][n], 0, 0, 0);
            }
        if (kt >= ntiles - 2) {
#pragma unroll
            for (int nq = 0; nq < 2; ++nq) {
                const int qi = q0 + wid * 32 + nq * 16 + fr;
#pragma unroll
                for (int n = 0; n < 4; ++n)
#pragma unroll
                    for (int j = 0; j < 4; ++j) {
                        const int ki = kt * 64 + (n >> 1) * 32 + fq * 8 + (n & 1) * 4 + j;
                        if (ki > qi) s[nq][n][j] = -1e30f;
                    }
            }
        }
        bf16x8 pf[2][2];
#pragma unroll
        for (int nq = 0; nq < 2; ++nq) {
            float mx = -1e30f;
#pragma unroll
            for (int n = 0; n < 4; ++n)
#pragma unroll
                for (int j = 0; j < 4; ++j) mx = fmaxf(mx, s[nq][n][j]);
            mx = fmaxf(mx, __shfl_xor(mx, 16));
            mx = fmaxf(mx, __shfl_xor(mx, 32));
            const float mnew = fmaxf(mrun[nq], mx);
            const float al = exp2f(mrun[nq] - mnew);
            mrun[nq] = mnew;
            float ps = 0.f;
#pragma unroll
            for (int n = 0; n < 4; ++n)
#pragma unroll
                for (int j = 0; j < 4; ++j) { const float e = exp2f(s[nq][n][j] - mnew); s[nq][n][j] = e; ps += e; }
            lrun[nq] = lrun[nq] * al + ps;
#pragma unroll
            for (int m = 0; m < 8; ++m) O[m][nq] *= al;
#pragma unroll
            for (int c = 0; c < 2; ++c) {
                u32x4 w;
                w.x = pack2(s[nq][2 * c][0], s[nq][2 * c][1]);
                w.y = pack2(s[nq][2 * c][2], s[nq][2 * c][3]);
                w.z = pack2(s[nq][2 * c + 1][0], s[nq][2 * c + 1][1]);
                w.w = pack2(s[nq][2 * c + 1][2], s[nq][2 * c + 1][3]);
                pf[nq][c] = *(bf16x8*)&w;
            }
        }
#pragma unroll
        for (int m = 0; m < 8; ++m)
#pragma unroll
            for (int c = 0; c < 2; ++c) {
                const bf16x8 a = *(const bf16x8*)(sV + (m * 16 + fr) * VROW + c * 32 + fq * 8);
                O[m][0] = __builtin_amdgcn_mfma_f32_16x16x32_bf16(a, pf[0][c], O[m][0], 0, 0, 0);
                O[m][1] = __builtin_amdgcn_mfma_f32_16x16x32_bf16(a, pf[1][c], O[m][1], 0, 0, 0);
            }
        __syncthreads();
    }
#undef ATT_GLOAD
#pragma unroll
    for (int nq = 0; nq < 2; ++nq) {
        float l = lrun[nq];
        l += __shfl_xor(l, 16);
        l += __shfl_xor(l, 32);
        const float il = 1.f / l;
        const int qi = q0 + wid * 32 + nq * 16 + fr;
#pragma unroll
        for (int m = 0; m < 8; ++m) {
            u32x2 o;
            o.x = pack2(O[m][nq][0] * il, O[m][nq][1] * il);
            o.y = pack2(O[m][nq][2] * il, O[m][nq][3] * il);
            *(u32x2*)(p->outcat + (size_t)qi * 2048 + h * 128 + m * 16 + fq * 4) = o;
        }
    }
}

#define DSA_WLDS 5632
__device__ __forceinline__ void dsa_task(KP p, int q, int g, unsigned char* wl) {
    const int lane = ltid() & 63;
    u16* sQ = (u16*)wl;
    float* sP = (float*)(wl + 1024);
    u16* sS = (u16*)(wl + 1024 + 4096);
    const int nsel = q < 255 ? q + 1 : 256;
    {
        const u16* qsrc = p->qb + (size_t)q * 1024 + g * 512;
        *(u32x4*)(sQ + lane * 8) = *(const u32x4*)(qsrc + lane * 8);
        *(u32x2*)(sS + lane * 4) = *(const u32x2*)(p->sel + (size_t)q * 256 + lane * 4);
    }
    __builtin_amdgcn_s_waitcnt(0);
    float sc[4][4];
    float mx[4] = {-1e30f, -1e30f, -1e30f, -1e30f};
#pragma unroll
    for (int r = 0; r < 4; ++r) {
        const int slot = lane + 64 * r;
        float a0 = 0.f, a1 = 0.f, a2 = 0.f, a3 = 0.f;
        if (slot < nsel) {
            const int ki = sS[slot];
            const u16* kr = p->kb + (size_t)ki * 256 + g * 128;
#pragma unroll
            for (int c = 0; c < 16; ++c) {
                const u32x4 kv = *(const u32x4*)(kr + c * 8);
                const u32x4 q0v = *(const u32x4*)(sQ + 0 * 128 + c * 8);
                const u32x4 q1v = *(const u32x4*)(sQ + 1 * 128 + c * 8);
                const u32x4 q2v = *(const u32x4*)(sQ + 2 * 128 + c * 8);
                const u32x4 q3v = *(const u32x4*)(sQ + 3 * 128 + c * 8);
#pragma unroll
                for (int e = 0; e < 4; ++e) {
                    const unsigned kk = kv[e];
                    const bf16x2_t kb2 = *(const bf16x2_t*)&kk;
                    unsigned t0 = q0v[e], t1 = q1v[e], t2 = q2v[e], t3 = q3v[e];
                    a0 = __builtin_amdgcn_fdot2_f32_bf16(kb2, *(const bf16x2_t*)&t0, a0, false);
                    a1 = __builtin_amdgcn_fdot2_f32_bf16(kb2, *(const bf16x2_t*)&t1, a1, false);
                    a2 = __builtin_amdgcn_fdot2_f32_bf16(kb2, *(const bf16x2_t*)&t2, a2, false);
                    a3 = __builtin_amdgcn_fdot2_f32_bf16(kb2, *(const bf16x2_t*)&t3, a3, false);
                }
            }
        } else { a0 = a1 = a2 = a3 = -1e30f; }
        sc[r][0] = a0; sc[r][1] = a1; sc[r][2] = a2; sc[r][3] = a3;
        mx[0] = fmaxf(mx[0], a0); mx[1] = fmaxf(mx[1], a1); mx[2] = fmaxf(mx[2], a2); mx[3] = fmaxf(mx[3], a3);
    }
    float ls[4];
#pragma unroll
    for (int hh = 0; hh < 4; ++hh) {
        const float m = wave_max(mx[hh]);
        float s = 0.f;
#pragma unroll
        for (int r = 0; r < 4; ++r) { const float e = exp2f(sc[r][hh] - m); sc[r][hh] = e; s += e; }
        ls[hh] = wave_sum(s);
    }
#pragma unroll
    for (int r = 0; r < 4; ++r) {
        f32x4 pv = {sc[r][0], sc[r][1], sc[r][2], sc[r][3]};
        *(f32x4*)(sP + (lane + 64 * r) * 4) = pv;
    }
    __builtin_amdgcn_s_waitcnt(0);
    float o[4][2];
#pragma unroll
    for (int hh = 0; hh < 4; ++hh) { o[hh][0] = 0.f; o[hh][1] = 0.f; }
    const u16* vbase = p->vb + g * 128 + lane * 2;
    int s = 0;
    for (; s + 4 <= nsel; s += 4) {
        unsigned vv[4]; f32x4 pp[4];
#pragma unroll
        for (int u = 0; u < 4; ++u) {
            const int ki = sS[s + u];
            vv[u] = *(const unsigned*)(vbase + (size_t)ki * 256);
            pp[u] = *(const f32x4*)(sP + (s + u) * 4);
        }
#pragma unroll
        for (int u = 0; u < 4; ++u) {
            const float v0 = __uint_as_float(vv[u] << 16), v1 = __uint_as_float(vv[u] & 0xffff0000u);
#pragma unroll
            for (int hh = 0; hh < 4; ++hh) { o[hh][0] += pp[u][hh] * v0; o[hh][1] += pp[u][hh] * v1; }
        }
    }
    for (; s < nsel; ++s) {
        const int ki = sS[s];
        const unsigned vv = *(const unsigned*)(vbase + (size_t)ki * 256);
        const f32x4 pp = *(const f32x4*)(sP + s * 4);
        const float v0 = __uint_as_float(vv << 16), v1 = __uint_as_float(vv & 0xffff0000u);
#pragma unroll
        for (int hh = 0; hh < 4; ++hh) { o[hh][0] += pp[hh] * v0; o[hh][1] += pp[hh] * v1; }
    }
#pragma unroll
    for (int hh = 0; hh < 4; ++hh) {
        const float il = 1.f / ls[hh];
        *(unsigned*)(p->outcat + (size_t)q * 2048 + 1024 + (g * 4 + hh) * 128 + lane * 2) = pack2(o[hh][0] * il, o[hh][1] * il);
    }
    __builtin_amdgcn_s_waitcnt(0);
}

__device__ __forceinline__ void ph_attn(KP p, unsigned char* smem, unsigned* misc) {
    const int tid = ltid(), wid = tid >> 6;
    for (;;) {
        __syncthreads();
        if (tid == 0) misc[0] = atomicAdd(&p->ctl[CTL_QUEUE], 1u);
        __syncthreads();
        const int it = (int)misc[0];
        if (it >= 1024) break;
        if (it < 512) {
            mla_item(p, it & 7, 63 - (it >> 3), (u16*)smem);
        } else {
            const int base = (it - 512) * 16;
            for (int k = 0; k < 8; ++k) {
                const int task = wid * 8 + k;
                dsa_task(p, base + (task >> 1), task & 1, smem + wid * DSA_WLDS);
            }
        }
    }
}
template <bool ADD_ROUTED, bool ROUTE, bool WRITE_B>
__device__ __forceinline__ void ph_ln(KP p, const float* Y, const float* g, const float* b,
                                      float* XF, u16* XB, unsigned* cnt, unsigned char* smem) {
    const int lane = ltid() & 63, wid = ltid() >> 6;
    const int gw = (blockIdx.x * NT + ltid()) >> 6, nw = (gridDim.x * NT) >> 6;
    float* sx = (float*)smem + wid * 2048;
    for (int t = gw; t < T_; t += nw) {
        float v[32];
        const float* y = Y + (size_t)t * D_;
        float sum = 0.f;
#pragma unroll
        for (int j = 0; j < 8; ++j) {
            const f32x4 a = *(const f32x4*)(y + j * 256 + lane * 4);
            v[4 * j] = a[0]; v[4 * j + 1] = a[1]; v[4 * j + 2] = a[2]; v[4 * j + 3] = a[3];
        }
        if constexpr (ADD_ROUTED) {
            const u16* r0 = p->yr + (size_t)(2 * t) * D_;
            const u16* r1 = r0 + D_;
#pragma unroll
            for (int j = 0; j < 8; ++j) {
                const u32x2 a = *(const u32x2*)(r0 + j * 256 + lane * 4);
                const u32x2 c = *(const u32x2*)(r1 + j * 256 + lane * 4);
                v[4 * j]     += __uint_as_float(a.x << 16) + __uint_as_float(c.x << 16);
                v[4 * j + 1] += __uint_as_float(a.x & 0xffff0000u) + __uint_as_float(c.x & 0xffff0000u);
                v[4 * j + 2] += __uint_as_float(a.y << 16) + __uint_as_float(c.y << 16);
                v[4 * j + 3] += __uint_as_float(a.y & 0xffff0000u) + __uint_as_float(c.y & 0xffff0000u);
            }
        }
#pragma unroll
        for (int i = 0; i < 32; ++i) sum += v[i];
        const float mu = wave_sum(sum) * (1.f / 2048.f);
        float var = 0.f;
#pragma unroll
        for (int i = 0; i < 32; ++i) { const float d = v[i] - mu; var += d * d; }
        var = wave_sum(var) * (1.f / 2048.f);
        const float rs = rsqrtf(var + 1e-5f);
#pragma unroll
        for (int j = 0; j < 8; ++j) {
            const int c = j * 256 + lane * 4;
            const f32x4 gg = *(const f32x4*)(g + c), bb = *(const f32x4*)(b + c);
            f32x4 o;
#pragma unroll
            for (int e = 0; e < 4; ++e) o[e] = (v[4 * j + e] - mu) * rs * gg[e] + bb[e];
            *(f32x4*)(XF + (size_t)t * D_ + c) = o;
            if constexpr (WRITE_B) {
                u32x2 w; w.x = pack2(o[0], o[1]); w.y = pack2(o[2], o[3]);
                *(u32x2*)(XB + (size_t)t * D_ + c) = w;
            }
            if constexpr (ROUTE) *(f32x4*)(sx + c) = o;
        }
        if constexpr (ROUTE) {
            __builtin_amdgcn_s_waitcnt(0);
            float acc0 = 0.f, acc1 = 0.f, acc2 = 0.f, acc3 = 0.f;
            const float* rw = p->router_w + lane;
            for (int d = 0; d < D_; d += 4) {
                const f32x4 xv = *(const f32x4*)(sx + d);
                acc0 += xv[0] * rw[(size_t)(d + 0) * 64];
                acc1 += xv[1] * rw[(size_t)(d + 1) * 64];
                acc2 += xv[2] * rw[(size_t)(d + 2) * 64];
                acc3 += xv[3] * rw[(size_t)(d + 3) * 64];
            }
            const float logit = (acc0 + acc1) + (acc2 + acc3);
            const float sc = 1.f / (1.f + __expf(-logit));
            const float bi = sc + p->router_b[lane];
            float m1 = bi;
            m1 = fmaxf(m1, __shfl_xor(m1, 1)); m1 = fmaxf(m1, __shfl_xor(m1, 2)); m1 = fmaxf(m1, __shfl_xor(m1, 4));
            const int seg = lane >> 3;
            unsigned long long bal = __ballot(bi == m1);
            const int f1 = __builtin_ctz((unsigned)((bal >> (seg * 8)) & 0xffull));
            const float b2 = ((lane & 7) == f1) ? -1e30f : bi;
            float m2 = b2;
            m2 = fmaxf(m2, __shfl_xor(m2, 1)); m2 = fmaxf(m2, __shfl_xor(m2, 2)); m2 = fmaxf(m2, __shfl_xor(m2, 4));
            bal = __ballot(b2 == m2);
            const int f2 = __builtin_ctz((unsigned)((bal >> (seg * 8)) & 0xffull));
            const float gs = m1 + m2;
            float gm = gs;
            gm = fmaxf(gm, __shfl_xor(gm, 8)); gm = fmaxf(gm, __shfl_xor(gm, 16)); gm = fmaxf(gm, __shfl_xor(gm, 32));
            bal = __ballot(gs == gm);
            const int gsel = (int)(__builtin_ctzll(bal) >> 3);
            const int e0 = gsel * 8 + __shfl(f1, gsel * 8);
            const int e1 = gsel * 8 + __shfl(f2, gsel * 8);
            const float s0 = __shfl(sc, e0), s1 = __shfl(sc, e1);
            if (lane == 0) {
                const float inv = 1.f / (s0 + s1);
                const unsigned p0 = atomicAdd(&cnt[e0], 1u);
                const unsigned p1 = atomicAdd(&cnt[e1], 1u);
                p->list[e0 * T_ + p0] = 2 * t;
                p->list[e1 * T_ + p1] = 2 * t + 1;
                p->tok_g[2 * t] = s0 * inv;
                p->tok_g[2 * t + 1] = s1 * inv;
            }
        }
    }
}

struct ColGateUp { int c0; const float* up;
    __device__ __forceinline__ const float* base(const float* B, int whalf) const { return whalf ? up : B; }
    __device__ __forceinline__ unsigned off(int l) const { const int li = l & 63; return (unsigned)(c0 + (li >> 5) * 32 + (li & 31)); }
    __device__ __forceinline__ int vcol(int l) const { const int li = l & 63; return (li >> 5) * 64 + ((l >> 6) ? 32 : 0) + (li & 31); } };
struct RowList { const int* lst; int m0, n; __device__ __forceinline__ int operator()(int r) const { const int i = m0 + r; return lst[i < n ? i : n - 1] >> 1; } };
struct EpiSwiglu {
    u16* C; int ldc; int row0, c0, nrows;
    __device__ __forceinline__ void operator()(Acc& acc, int wr0, int wc0, int fr, int fq) const {
        const int cb = c0 + (wc0 >> 1);
#pragma unroll
        for (int m = 0; m < 4; ++m)
#pragma unroll
            for (int j = 0; j < 4; ++j) {
                const int r = wr0 + m * 16 + fq * 4 + j;
                if (r < nrows) {
#pragma unroll
                    for (int n = 0; n < 2; ++n)
                        C[(size_t)(row0 + r) * ldc + cb + n * 16 + fr] = f2bf(silu_f(acc[m][n][j]) * acc[m][n + 2][j]);
                }
            }
    }
};
struct EpiDownRouted {
    u16* yr; const int* lst; const float* tg; int m0, n, col0;
    __device__ __forceinline__ void operator()(Acc& acc, int wr0, int wc0, int fr, int fq) const {
#pragma unroll
        for (int m = 0; m < 4; ++m)
#pragma unroll
            for (int j = 0; j < 4; ++j) {
                const int i = m0 + wr0 + m * 16 + fq * 4 + j;
                if (i < n) {
                    const int slot = lst[i];
                    const float gt = tg[slot];
#pragma unroll
                    for (int nn = 0; nn < 4; ++nn)
                        yr[(size_t)slot * D_ + col0 + wc0 + nn * 16 + fr] = f2bf(gt * acc[m][nn][j]);
                }
            }
    }
};

struct RowH { int base, mx; __device__ __forceinline__ int operator()(int r) const { const int i = base + r; return i < mx ? i : mx; } };
__device__ __forceinline__ void moe_prefix(const unsigned* cnt, int* s_tp, int* s_off) {
    __syncthreads();
    if (ltid() == 0) {
        int tp = 0, off = 0;
        for (int e = 0; e < 64; ++e) {
            const int n = (int)__hip_atomic_load(&cnt[e], __ATOMIC_RELAXED, __HIP_MEMORY_SCOPE_AGENT);
            s_tp[e] = tp; s_off[e] = off;
            tp += (n + 127) >> 7; off += n;
        }
        s_tp[64] = tp; s_off[64] = off;
    }
    __syncthreads();
}

struct RowGen { const int* lst; int m0, n, base; __device__ __forceinline__ int operator()(int r) const {
    if (lst) { const int i = m0 + r; return lst[i < n ? i : n - 1] >> 1; }
    return base + r; } };

template <int L>
__device__ __forceinline__ void ph_moe_up(KP p, const u16* X, unsigned char* smem, int* s_tp, int* s_off) {
    u16* lds = (u16*)smem;
    const unsigned* cnt = p->ctl + (L == 0 ? CTL_CNT0 : CTL_CNT1);
    moe_prefix(cnt, s_tp, s_off);
    const int nrt = s_tp[64] * 8;
    const int nsh = 64 * 16;
            for (int t = blockIdx.x; t < nrt + nsh; t += gridDim.x) {
        Acc acc; acc_zero(acc);
        RowGen rg; const float* W; int ldb; ColGateUp cg; EpiSwiglu ep;
        if (t < nrt) {
            const int mtile = t >> 3, nt = t & 7;
            int e = 0;
            for (int s = 32; s > 0; s >>= 1) if (e + s < 64 && s_tp[e + s] <= mtile) e += s;
            const int n = s_off[e + 1] - s_off[e], m0 = (mtile - s_tp[e]) * 128;
            W = p->moe_wg[L] + (size_t)e * D_ * 512; ldb = 512;
            rg = RowGen{p->list + e * T_, m0, n, 0};
            cg = ColGateUp{nt * 64, p->moe_wu[L] + (size_t)e * D_ * 512};
            ep = EpiSwiglu{p->hbuf, 512, s_off[e] + m0, nt * 64, n - m0};
        } else {
            const int u = t - nrt, mt = u >> 4, nt = u & 15;
            W = p->sh_g[L]; ldb = 1024;
            rg = RowGen{nullptr, 0, 0, mt * 128};
            cg = ColGateUp{nt * 64, p->sh_u[L]};
            ep = EpiSwiglu{p->hsh, 1024, mt * 128, nt * 64, 128};
        }
        gemm_accum<B_F32_KN>(acc, X, D_, rg, W, ldb, cg, D_, lds);
        ep(acc, (ltid() >> 7) * 64, ((ltid() >> 6) & 1) * 64, ltid() & 15, (ltid() & 63) >> 4);
    }
}

template <int L>
__device__ __forceinline__ void ph_moe_down(KP p, const float* XF, unsigned char* smem, int* s_tp, int* s_off) {
    u16* lds = (u16*)smem;
    const unsigned* cnt = p->ctl + (L == 0 ? CTL_CNT0 : CTL_CNT1);
    moe_prefix(cnt, s_tp, s_off);
    const int nrt = s_tp[64] * 16, nsh = 64 * 16;
    for (int t = blockIdx.x; t < nrt + nsh; t += gridDim.x) {
        Acc acc; acc_zero(acc);
        const int wr0 = (ltid() >> 7) * 64, wc0 = ((ltid() >> 6) & 1) * 64, fr = ltid() & 15, fq = (ltid() & 63) >> 4;
        const bool routed = t < nrt;
        const u16* A; int lda, K; RowH rh; const float* W; int nt;
        int e = 0, n = 0, m0 = 0, mt = 0;
        if (routed) {
            const int mtile = t >> 4; nt = t & 15;
            for (int s = 32; s > 0; s >>= 1) if (e + s < 64 && s_tp[e + s] <= mtile) e += s;
            n = s_off[e + 1] - s_off[e]; m0 = (mtile - s_tp[e]) * 128;
            A = p->hbuf; lda = 512; K = 512; rh = RowH{s_off[e] + m0, 2 * T_ - 1};
            W = p->moe_wd[L] + (size_t)e * 512 * D_;
        } else {
            const int u = t - nrt; mt = u >> 4; nt = u & 15;
            A = p->hsh; lda = 1024; K = 1024; rh = RowH{mt * 128, T_ - 1};
            W = p->sh_d[L];
        }
        gemm_accum<B_F32_KN>(acc, A, lda, rh, W, D_, ColOff{nt * 128}, K, lds);
        if (routed) EpiDownRouted{p->yr, p->list + e * T_, p->tok_g, m0, n, nt * 128}(acc, wr0, wc0, fr, fq);
        else EpiResid{p->y2, XF, D_, mt * 128, nt * 128}(acc, wr0, wc0, fr, fq);
    }
}
struct ColRot { int cbase; bool rot;
    __device__ __forceinline__ const float* base(const float* B, int) const { return B; }
    __device__ __forceinline__ unsigned off(int v) const { const int s = v >> 6, u = v & 63;
        return rot ? (unsigned)(cbase + s * 32 + (u < 32 ? u : 128 + (u - 32))) : (unsigned)(cbase + v); }
    __device__ __forceinline__ int vcol(int l) const { return l; } };

__device__ __forceinline__ float ret_log2g(int h) { return log1pf(-exp2f(-5.f - (float)h)) * LOG2E_; }

struct EpiRetQK {
    KP p; int row0; int hd; int tp; bool isk;
    __device__ __forceinline__ void operator()(Acc& acc, int wr0, int wc0, int fr, int fq) const {
        const float l2g = ret_log2g(hd);
        const int dbase = tp * 64 + (wc0 >> 1);
#pragma unroll
        for (int m = 0; m < 4; ++m) {
            const int r0 = row0 + wr0 + m * 16 + fq * 4;
#pragma unroll
            for (int n = 0; n < 2; ++n) {
                const int i = dbase + n * 16 + fr;
                float lo[4], hi[4];
#pragma unroll
                for (int j = 0; j < 4; ++j) {
                    const int t = r0 + j;
                    const float c = p->cosR[t * 128 + i], s = p->sinR[t * 128 + i];
                    const float x1 = acc[m][n][j], x2 = acc[m][n + 2][j];
                    lo[j] = x1 * c - x2 * s; hi[j] = x1 * s + x2 * c;
                }
                if (!isk) {
#pragma unroll
                    for (int j = 0; j < 4; ++j) {
                        const int t = r0 + j;
                        const float xi = exp2f((float)((t & 127) + 1) * l2g);
                        const size_t o = (size_t)t * 2048 + hd * 256 + i;
                        p->qr[o] = f2bf(lo[j]); p->qr[o + 128] = f2bf(hi[j]);
                        p->qx[o] = f2bf(lo[j] * xi); p->qx[o + 128] = f2bf(hi[j] * xi);
                    }
                } else {
                    float zl[4], zh[4];
#pragma unroll
                    for (int j = 0; j < 4; ++j) {
                        const int t = r0 + j;
                        const float ze = exp2f((float)(127 - (t & 127)) * l2g);
                        lo[j] *= 0.0625f; hi[j] *= 0.0625f;
                        const size_t o = (size_t)t * 2048 + hd * 256 + i;
                        p->kr[o] = f2bf(lo[j]); p->kr[o + 128] = f2bf(hi[j]);
                        zl[j] = lo[j] * ze; zh[j] = hi[j] * ze;
                    }
                    u32x2 a, b;
                    a.x = pack2(zl[0], zl[1]); a.y = pack2(zl[2], zl[3]);
                    b.x = pack2(zh[0], zh[1]); b.y = pack2(zh[2], zh[3]);
                    *(u32x2*)(p->kzT + (size_t)(hd * 256 + i) * T_ + r0) = a;
                    *(u32x2*)(p->kzT + (size_t)(hd * 256 + i + 128) * T_ + r0) = b;
                }
            }
        }
    }
};
struct EpiRetV {
    u16* vT; int row0, col0;
    __device__ __forceinline__ void operator()(Acc& acc, int wr0, int wc0, int fr, int fq) const {
#pragma unroll
        for (int m = 0; m < 4; ++m) {
            const int r0 = row0 + wr0 + m * 16 + fq * 4;
#pragma unroll
            for (int n = 0; n < 4; ++n) {
                u32x2 o; o.x = pack2(acc[m][n][0], acc[m][n][1]); o.y = pack2(acc[m][n][2], acc[m][n][3]);
                *(u32x2*)(vT + (size_t)(col0 + wc0 + n * 16 + fr) * T_ + r0) = o;
            }
        }
    }
};
struct EpiSilu {
    u16* C; int ldc; int row0, col0;
    __device__ __forceinline__ void operator()(Acc& acc, int wr0, int wc0, int fr, int fq) const {
#pragma unroll
        for (int m = 0; m < 4; ++m)
#pragma unroll
            for (int n = 0; n < 4; ++n)
#pragma unroll
                for (int j = 0; j < 4; ++j)
                    C[(size_t)(row0 + wr0 + m * 16 + fq * 4 + j) * ldc + col0 + wc0 + n * 16 + fr] = f2bf(silu_f(acc[m][n][j]));
    }
};
struct EpiInner {
    u16* C; int hd;
    __device__ __forceinline__ void operator()(Acc& acc, int wr0, int wc0, int fr, int fq) const {
        const float l2g = ret_log2g(hd);
#pragma unroll
        for (int m = 0; m < 4; ++m)
#pragma unroll
            for (int n = 0; n < 4; ++n)
#pragma unroll
                for (int j = 0; j < 4; ++j) {
                    const int i = wr0 + m * 16 + fq * 4 + j, k = wc0 + n * 16 + fr;
                    const float d = i >= k ? exp2f((float)(i - k) * l2g) : 0.f;
                    C[i * 128 + k] = f2bf(acc[m][n][j] * d);
                }
    }
};

#define WR0_ ((ltid() >> 7) * 64)
#define WC0_ (((ltid() >> 6) & 1) * 64)
#define FR_ (ltid() & 15)
#define FQ_ ((ltid() & 63) >> 4)

__device__ __forceinline__ void ph_l1_in(KP p, u16* lds) {
    const int ntm = T_ / BM, ntn = IN_C / BN;
    for (int t = blockIdx.x; t < ntm * ntn; t += gridDim.x) {
        const int nt = t / ntm, mt = t % ntm;
        Acc acc; acc_zero(acc);
        const bool isk = nt >= 16;
        const int u = nt & 15, hd = u >> 1, tp = u & 1;
        const ColRot cr = nt < 32 ? ColRot{(isk ? 2048 : 0) + hd * 256 + tp * 64, true} : ColRot{nt * BN, false};
        gemm_accum<B_F32_KN>(acc, p->xcb, D_, RowId{mt * BM}, p->w_in1, IN_C, cr, D_, lds);
        if (nt < 32) EpiRetQK{p, mt * BM, hd, tp, isk}(acc, WR0_, WC0_, FR_, FQ_);
        else if (nt < 64) EpiRetV{p->v1T, mt * BM, (nt - 32) * BN}(acc, WR0_, WC0_, FR_, FQ_);
        else EpiSilu{p->sg, 4096, mt * BM, (nt - 64) * BN}(acc, WR0_, WC0_, FR_, FQ_);
    }
}

__device__ __forceinline__ void ph_ret_a(KP p, u16* lds) {
    const int nkv = 8 * 64 * 8, nin = 8 * 64;
    for (int t = blockIdx.x; t < nkv + nin; t += gridDim.x) {
        Acc acc; acc_zero(acc);
        const bool kv = t < nkv;
        const int hc = kv ? (t >> 3) : (t - nkv), sub = t & 7, hd = hc >> 6, c = hc & 63, mt = sub >> 1, nt = sub & 1;
        const u16* A = kv ? p->v1T + c * 128 : p->qr + hd * 256;
        const u16* B = kv ? p->kzT + c * 128 : p->kr + hd * 256;
        const int ld = kv ? T_ : 2048, K = kv ? 128 : 256;
        const int ar = kv ? hd * 512 + mt * 128 : c * 128, br = kv ? hd * 256 + nt * 128 : c * 128;
        gemm_accum<B_BF16_NK>(acc, A, ld, RowId{ar}, B, ld, RowId{br}, K, lds);
        if (kv) EpiBF16{p->KVt + (size_t)hc * 512 * 256, 256, mt * 128, nt * 128}(acc, WR0_, WC0_, FR_, FQ_);
        else EpiInner{p->innerG + (size_t)hc * 128 * 128, hd}(acc, WR0_, WC0_, FR_, FQ_);
    }
}
__device__ __forceinline__ void ph_ret_b(KP p) {
    const int gtid = blockIdx.x * NT + ltid(), gsz = gridDim.x * NT;
    for (int e = gtid; e < 8 * 512 * 256 / 8; e += gsz) {
        const int hd = e / (512 * 256 / 8);
        const int within = e - hd * (512 * 256 / 8);
        const float g128 = exp2f(128.f * ret_log2g(hd));
        u16* base = p->KVt + (size_t)hd * 64 * 512 * 256 + (size_t)within * 8;
        float r[8];
#pragma unroll
        for (int i = 0; i < 8; ++i) r[i] = 0.f;
#pragma unroll 4
        for (int c = 0; c < 64; ++c) {
            u32x4* ptr = (u32x4*)(base + (size_t)c * 512 * 256);
            const u32x4 in = *ptr;
            u32x4 o;
            o.x = pack2(r[0], r[1]); o.y = pack2(r[2], r[3]); o.z = pack2(r[4], r[5]); o.w = pack2(r[6], r[7]);
            *ptr = o;
#pragma unroll
            for (int i = 0; i < 4; ++i) {
                r[2 * i] = r[2 * i] * g128 + __uint_as_float(in[i] << 16);
                r[2 * i + 1] = r[2 * i + 1] * g128 + __uint_as_float(in[i] & 0xffff0000u);
            }
        }
    }
}
__device__ __forceinline__ void ph_ret_c(KP p, u16* lds) {
    for (int t = blockIdx.x; t < 8 * 64 * 4; t += gridDim.x) {
        const int hc = t >> 2, nt = t & 3, hd = hc >> 6, c = hc & 63;
        Acc acc; acc_zero(acc);
        gemm_accum<B_BF16_NK>(acc, p->innerG + (size_t)hc * 128 * 128, 128, RowId{0}, p->v1T + c * 128, T_, RowId{hd * 512 + nt * 128}, 128, lds);
        gemm_accum<B_BF16_NK>(acc, p->qx + hd * 256, 2048, RowId{c * 128}, p->KVt + (size_t)hc * 512 * 256, 256, RowId{nt * 128}, 256, lds);
        EpiBF16{p->obuf, 4096, c * 128, hd * 512 + nt * 128}(acc, WR0_, WC0_, FR_, FQ_);
    }
}
__device__ __forceinline__ void ph_gn(KP p) {
    const int lane = ltid() & 63;
    const int gw = (blockIdx.x * NT + ltid()) >> 6, nw = (gridDim.x * NT) >> 6;
    for (int r = gw; r < T_ * 8; r += nw) {
        const int hd = r & 7;
        const size_t off = (size_t)(r >> 3) * 4096 + hd * 512 + lane * 8;
        const u32x4 in = *(const u32x4*)(p->obuf + off);
        float v[8];
#pragma unroll
        for (int i = 0; i < 4; ++i) { v[2 * i] = __uint_as_float(in[i] << 16); v[2 * i + 1] = __uint_as_float(in[i] & 0xffff0000u); }
        float s = 0.f;
#pragma unroll
        for (int i = 0; i < 8; ++i) s += v[i];
        const float mu = wave_sum(s) * (1.f / 512.f);
        float var = 0.f;
#pragma unroll
        for (int i = 0; i < 8; ++i) { const float d = v[i] - mu; var += d * d; }
        var = wave_sum(var) * (1.f / 512.f);
        const float rs = rsqrtf(var + 1e-5f);
        const u32x4 gin = *(const u32x4*)(p->sg + off);
        const float* gg = p->gn_g + hd * 512 + lane * 8;
        const float* gb = p->gn_b + hd * 512 + lane * 8;
        float o[8];
#pragma unroll
        for (int i = 0; i < 8; ++i) {
            const float sgv = (i & 1) ? __uint_as_float(gin[i >> 1] & 0xffff0000u) : __uint_as_float(gin[i >> 1] << 16);
            o[i] = ((v[i] - mu) * rs * gg[i] + gb[i]) * sgv;
        }
        u32x4 w; w.x = pack2(o[0], o[1]); w.y = pack2(o[2], o[3]); w.z = pack2(o[4], o[5]); w.w = pack2(o[6], o[7]);
        *(u32x4*)(p->gated + off) = w;
    }
}
#define MAXLDS_(a, b) ((a) > (b) ? (a) : (b))
#define PHASE_LDS MAXLDS_(MAXLDS_(GEMM_LDS_BYTES, ATT_LDS_BYTES), 4 * 8192)
#define LDS_TOTAL (PHASE_LDS + 16 + 16 + 65 * 4 * 2 + 8)

__global__ void __launch_bounds__(NT, 2) mega(Params kparams) {
    extern __shared__ __attribute__((aligned(16))) unsigned char smem[];
    u16* lds = (u16*)smem;
    uint4* xbw = (uint4*)(smem + PHASE_LDS);
    unsigned* misc = (unsigned*)(smem + PHASE_LDS + 16);
    int* s_tp = (int*)(smem + PHASE_LDS + 32);
    int* s_off = s_tp + 65;
    if (threadIdx.x == 0) *xbw = make_uint4(0u, 0u, 0u, 0u);
    __syncthreads();
    XcdBarrier bar = xcd_barrier_post(getp()->bar, (volatile LAS unsigned*)xbw);

    ph_prep(getp());
    xcd_barrier(bar);
    {
        KP p = getp();
        const int ntn = (IN_AB + BN - 1) / BN, ntm = T_ / BM;
        for (int t = blockIdx.x; t < ntn * ntm; t += gridDim.x) {
            const int nt = t / ntm, mt = t % ntm;
            Acc acc; acc_zero(acc);
            gemm_accum<B_F32_KN>(acc, p->xb, D_, RowId{mt * BM}, p->w_in0, IN_AB, ColClampOff{nt * BN, IN_AB}, D_, lds);
            EpiF32{p->H0, IN_AB, mt * BM, nt * BN, IN_AB}(acc, WR0_, WC0_, FR_, FQ_);
        }
    }
    xcd_barrier(bar);
    ph_post0(getp());
    xcd_barrier(bar);
    {
        KP p = getp();
        const int ntm = T_ / BM;
        const int n1 = ntm * 12, n2 = ntm * 16, n3 = 64 * 65 / 2;
        for (int t = blockIdx.x; t < n1 + n2 + n3; t += gridDim.x) {
            if (t < n1 + n2) {
                const bool isq = t < n1;
                const int u = isq ? t : t - n1, nt = u / ntm, mt = u % ntm;
                Acc acc; acc_zero(acc);
                gemm_accum<B_F32_KN>(acc, isq ? p->cqn : p->ckvn, isq ? 512 : 256, RowId{mt * BM}, isq ? p->w_uq : p->w_ukv,
                                     isq ? 1536 : 2048, ColOff{nt * BN}, isq ? 512 : 256, lds);
                if (isq) EpiQa{p->qa, p->cosA, p->sinA, mt * BM, nt * BN}(acc, WR0_, WC0_, FR_, FQ_);
                else EpiKva{p->ka, p->vaT, mt * BM, nt * BN}(acc, WR0_, WC0_, FR_, FQ_);
            } else {
                const int u = t - n1 - n2;
                int qt = (int)((sqrtf(8.f * (float)u + 1.f) - 1.f) * 0.5f);
                while ((qt + 1) * (qt + 2) / 2 <= u) ++qt;
                while (qt * (qt + 1) / 2 > u) --qt;
                const int kt = u - qt * (qt + 1) / 2;
                indexer_tile(p, qt, kt);
            }
        }
    }
    xcd_barrier(bar);
    ph_topk(getp(), (unsigned*)smem);
    xcd_barrier(bar);
    ph_attn(getp(), smem, misc);
    xcd_barrier(bar);
    {
        KP p = getp();
        const int ntm = T_ / BM;
        for (int t = blockIdx.x; t < ntm * 16; t += gridDim.x) {
            const int nt = t / ntm, mt = t % ntm;
            Acc acc; acc_zero(acc);
            gemm_accum<B_F32_KN>(acc, p->outcat, D_, RowId{mt * BM}, p->w_out0, D_, ColOff{nt * BN}, D_, lds);
            EpiResid{p->ybuf, p->x, D_, mt * BM, nt * BN}(acc, WR0_, WC0_, FR_, FQ_);
        }
    }
    xcd_barrier(bar);
    { KP p = getp(); ph_ln<false, true, true>(p, p->ybuf, p->ln_mix_g[0], p->ln_mix_b[0], p->xa, p->xab, p->ctl + CTL_CNT0, smem); }
    xcd_barrier(bar);
    { KP p = getp(); ph_moe_up<0>(p, p->xab, smem, s_tp, s_off); }
    xcd_barrier(bar);
    { KP p = getp(); ph_moe_down<0>(p, p->xa, smem, s_tp, s_off); }
    xcd_barrier(bar);
    { KP p = getp(); ph_ln<true, false, true>(p, p->y2, p->ln_ffn_g[0], p->ln_ffn_b[0], p->xc, p->xcb, nullptr, smem); }
    xcd_barrier(bar);
    ph_l1_in(getp(), lds);
    xcd_barrier(bar);
    ph_ret_a(getp(), lds);
    xcd_barrier(bar);
    ph_ret_b(getp());
    xcd_barrier(bar);
    ph_ret_c(getp(), lds);
    xcd_barrier(bar);
    ph_gn(getp());
    xcd_barrier(bar);
    {
        KP p = getp();
        const int ntm = T_ / BM;
        for (int t = blockIdx.x; t < ntm * 16; t += gridDim.x) {
            const int nt = t / ntm, mt = t % ntm;
            Acc acc; acc_zero(acc);
            gemm_accum<B_F32_KN>(acc, p->gated, 4096, RowId{mt * BM}, p->w_out1, D_, ColOff{nt * BN}, 4096, lds);
            EpiResid{p->ybuf, p->xc, D_, mt * BM, nt * BN}(acc, WR0_, WC0_, FR_, FQ_);
        }
    }
    xcd_barrier(bar);
    { KP p = getp(); ph_ln<false, true, true>(p, p->ybuf, p->ln_mix_g[1], p->ln_mix_b[1], p->xa, p->xab, p->ctl + CTL_CNT1, smem); }
    xcd_barrier(bar);
    { KP p = getp(); ph_moe_up<1>(p, p->xab, smem, s_tp, s_off); }
    xcd_barrier(bar);
    { KP p = getp(); ph_moe_down<1>(p, p->xa, smem, s_tp, s_off); }
    xcd_barrier(bar);
    { KP p = getp(); ph_ln<true, false, false>(p, p->y2, p->ln_ffn_g[1], p->ln_ffn_b[1], p->out, nullptr, nullptr, smem); }
    {
        KP p = getp();
        if (xb_ld(&p->bar[XB_TMO])) {
            asm volatile("s_waitcnt vmcnt(0)" ::: "memory");
            for (int i = blockIdx.x * NT + ltid(); i < p->out_size; i += gridDim.x * NT) p->out[i] = __uint_as_float(0x7fc00000u);
        }
    }
}

extern "C" void kernel_launch(void* const* d_in, const int* in_sizes, int n_in,
                              void* d_out, int out_size, void* d_ws, size_t ws_size,
                              hipStream_t stream) {
    const size_t kDynLds = LDS_TOTAL;
    static int grid = 0;
    if (!grid) {
        int dev = 0, cus = 0, per_cu = 0;
        (void)hipGetDevice(&dev);
        (void)hipDeviceGetAttribute(&cus, hipDeviceAttributeMultiprocessorCount, dev);
        (void)hipFuncSetAttribute((const void*)mega, hipFuncAttributeMaxDynamicSharedMemorySize, (int)kDynLds);
        (void)hipOccupancyMaxActiveBlocksPerMultiprocessor(&per_cu, mega, NT, kDynLds);
        int k = per_cu < 2 ? per_cu : 2;
        if (k < 1) k = 1;
        grid = cus * k;
    }
    unsigned char* ws = (unsigned char*)d_ws;
    size_t off = 0;
    auto take = [&](size_t bytes) { void* q = ws + off; off += (bytes + 255) & ~(size_t)255; return q; };
    Params p{};
    p.bar = (unsigned*)take(XCD_BAR_WORDS * 4);
    p.ctl = (unsigned*)take(CTL_WORDS * 4);
    const size_t ctl_bytes = off;
    (void)hipMemsetAsync(ws, 0, ctl_bytes, stream);
    auto F = [&](int i) { return (const float*)d_in[i]; };
    p.x = F(0); p.pos = (const int*)d_in[1]; p.router_w = F(2); p.router_b = F(3);
    p.w_in0 = F(4); p.q_norm = F(5); p.w_uq = F(6); p.kv_norm = F(7); p.w_ukv = F(8); p.w_out0 = F(9);
    p.w_in1 = F(10); p.gn_g = F(11); p.gn_b = F(12); p.w_out1 = F(13);
    for (int l = 0; l < 2; ++l) {
        const int b = 14 + 10 * l;
        p.ln_mix_g[l] = F(b); p.ln_mix_b[l] = F(b + 1);
        p.moe_wg[l] = F(b + 2); p.moe_wu[l] = F(b + 3); p.moe_wd[l] = F(b + 4);
        p.sh_g[l] = F(b + 5); p.sh_u[l] = F(b + 6); p.sh_d[l] = F(b + 7);
        p.ln_ffn_g[l] = F(b + 8); p.ln_ffn_b[l] = F(b + 9);
    }
    p.out = (float*)d_out;
    const size_t T = T_;
    p.cosA = (float*)take(T * 32 * 4); p.sinA = (float*)take(T * 32 * 4);
    p.cosR = (float*)take(T * 128 * 4); p.sinR = (float*)take(T * 128 * 4);
    p.xb = (u16*)take(T * 2048 * 2); p.H0 = (float*)take(T * IN_AB * 4);
    p.cqn = (u16*)take(T * 512 * 2); p.ckvn = (u16*)take(T * 256 * 2); p.kpe = (u16*)take(T * 64 * 2);
    p.qb = (u16*)take(T * 1024 * 2); p.kb = (u16*)take(T * 256 * 2); p.vb = (u16*)take(T * 256 * 2);
    p.iqb = (u16*)take(T * 1024 * 2); p.ikb = (u16*)take(T * 64 * 2); p.iwf = (float*)take(T * 16 * 4);
    p.qa = (u16*)take(T * 1536 * 2); p.ka = (u16*)take(T * 1024 * 2); p.vaT = (u16*)take(T * 1024 * 2);
    p.scores = (float*)take(T * T * 4); p.sel = (u16*)take(T * 256 * 2); p.outcat = (u16*)take(T * 2048 * 2);
    p.ybuf = (float*)take(T * 2048 * 4); p.xa = (float*)take(T * 2048 * 4); p.xab = (u16*)take(T * 2048 * 2);
    p.y2 = (float*)take(T * 2048 * 4); p.xc = (float*)take(T * 2048 * 4); p.xcb = (u16*)take(T * 2048 * 2);
    p.tok_e = (int*)take(T * 2 * 4); p.tok_g = (float*)take(T * 2 * 4); p.list = (int*)take(64 * T * 4);
    p.hbuf = (u16*)take(T * 2 * 512 * 2); p.hsh = (u16*)take(T * 1024 * 2); p.yr = (u16*)take(T * 2 * 2048 * 2);
    p.qr = (u16*)take(T * 2048 * 2); p.qx = (u16*)take(T * 2048 * 2); p.kr = (u16*)take(T * 2048 * 2);
    p.kzT = (u16*)take(T * 2048 * 2); p.v1T = (u16*)take(T * 4096 * 2); p.sg = (u16*)take(T * 4096 * 2);
    p.innerG = (u16*)take((size_t)8 * 64 * 128 * 128 * 2);
    {
        unsigned char* sbase = (unsigned char*)p.scores;
        p.KVt = (u16*)sbase; p.obuf = (u16*)(sbase + ((size_t)128 << 20)); p.gated = (u16*)(sbase + ((size_t)192 << 20));
    }
    p.out_size = out_size; p.pad_ = 0;
    if (off > ws_size) return;
    mega<<<dim3(grid), dim3(NT), kDynLds, stream>>>(p);
}
```

```cpp
#include <hip/hip_runtime.h>
#include <stdint.h>

typedef unsigned short u16;
typedef __attribute__((ext_vector_type(8))) short bf16x8;
typedef __attribute__((ext_vector_type(4))) float f32x4;
typedef __attribute__((ext_vector_type(2))) float f32x2;
typedef __attribute__((ext_vector_type(4))) unsigned u32x4;
typedef __attribute__((ext_vector_type(2))) unsigned u32x2;
typedef __attribute__((ext_vector_type(2))) __bf16 bf16x2_t;
typedef __attribute__((ext_vector_type(4))) short s16x4;

#define XB_TMO      128
#define XB_XCNT(j)  (256  + 64 * (j))
#define XB_XSUB(j)  (1280 + 64 * (j))
#define XB_XGEN(j)  (2304 + 64 * (j))
#define XB_TOP      3328
#define XB_TOPGEN   3392
#define XCD_BAR_WORDS 3456
#define XB_SPIN_CAP (1u << 22)
#define LAS __attribute__((address_space(3)))

__device__ __forceinline__ unsigned xb_ld(unsigned* p)              { return __hip_atomic_load(p, __ATOMIC_RELAXED, __HIP_MEMORY_SCOPE_AGENT); }
__device__ __forceinline__ unsigned xb_add(unsigned* p, unsigned v) { return __hip_atomic_fetch_add(p, v, __ATOMIC_RELAXED, __HIP_MEMORY_SCOPE_AGENT); }
__device__ __forceinline__ unsigned xb_xcc_id() { return (unsigned)__builtin_amdgcn_s_getreg((3 << 11) | 20) & 0xFu; }
#define XB_SPIN(cond, bar) do { unsigned _sp = 0; while (cond) { __builtin_amdgcn_s_sleep(1); \
    if ((++_sp & 255u) == 0u) { if (xb_ld(&(bar)[XB_TMO])) break; if (_sp > XB_SPIN_CAP) { atomicAdd(&(bar)[XB_TMO], 1u); break; } } } } while (0)

struct XcdBarrier { unsigned* bar; unsigned x; volatile LAS unsigned* st; };

__device__ __forceinline__ XcdBarrier xcd_barrier_post(unsigned* bar, volatile LAS unsigned* st) {
    XcdBarrier b; b.bar = bar; b.x = xb_xcc_id(); b.st = st;
    if (threadIdx.x == 0) (void)xb_add(&bar[XB_XCNT(b.x)], 1u);
    return b;
}
__device__ __forceinline__ void xcd_barrier_complete(unsigned* bar, unsigned x, unsigned& nloc, unsigned& nx) {
    const unsigned G = gridDim.x * gridDim.y * gridDim.z;
    unsigned sum, cnt, mine, sp = 0u;
    for (;;) {
        sum = 0u; cnt = 0u; mine = 0u;
#pragma unroll
        for (unsigned j = 0; j < 16; ++j) { const unsigned c = xb_ld(&bar[XB_XCNT(j)]); sum += c; cnt += (c > 0u) ? 1u : 0u; mine = (j == x) ? c : mine; }
        if (sum == G) break;
        __builtin_amdgcn_s_sleep(1);
        if ((++sp & 255u) == 0u) { if (xb_ld(&bar[XB_TMO])) break; if (sp > XB_SPIN_CAP) { atomicAdd(&bar[XB_TMO], 1u); break; } }
    }
    nloc = mine > 0u ? mine : 1u; nx = cnt > 0u ? cnt : 1u;
}
__device__ __forceinline__ void xcd_barrier(const XcdBarrier& b) {
    asm volatile("s_waitcnt vmcnt(0)" ::: "memory");
    __syncthreads();
    if (threadIdx.x == 0) {
        unsigned* bar = b.bar;
        __builtin_amdgcn_s_waitcnt(0);
        unsigned nloc = b.st[0], nx = b.st[1];
        if (nloc == 0u) { xcd_barrier_complete(bar, b.x, nloc, nx); b.st[0] = nloc; b.st[1] = nx; }
        const unsigned old = xb_add(&bar[XB_XSUB(b.x)], 1u);
        const unsigned gen = old / nloc;
        if (old + 1u == (gen + 1u) * nloc) {
            __builtin_amdgcn_fence(__ATOMIC_RELEASE, "agent");
            asm volatile("s_waitcnt vmcnt(0)" ::: "memory");
            const unsigned og = xb_add(&bar[XB_TOP], 1u);
            const unsigned tg = og / nx;
            if (og + 1u == (tg + 1u) * nx) xb_add(&bar[XB_TOPGEN], 1u);
            else XB_SPIN(xb_ld(&bar[XB_TOPGEN]) == tg, bar);
            __builtin_amdgcn_fence(__ATOMIC_ACQUIRE, "agent");
            xb_add(&bar[XB_XGEN(b.x)], 1u);
            asm volatile("s_waitcnt vmcnt(0)" ::: "memory");
        } else {
            XB_SPIN(xb_ld(&bar[XB_XGEN(b.x)]) == gen, bar);
            __builtin_amdgcn_fence(__ATOMIC_ACQUIRE, "agent");
            asm volatile("s_waitcnt vmcnt(0)" ::: "memory");
        }
    }
    __syncthreads();
}

__device__ __forceinline__ int ltid() { int t = threadIdx.x; asm volatile("" : "+v"(t)); return t; }
__device__ __forceinline__ u16 f2bf(float f) {
    unsigned u = __float_as_uint(f);
    u += 0x7fffu + ((u >> 16) & 1u);
    return (u16)(u >> 16);
}
__device__ __forceinline__ float bf2f(u16 h) { return __uint_as_float(((unsigned)h) << 16); }
__device__ __forceinline__ unsigned pack2(float a, float b) {
    f32x2 v = {a, b};
    bf16x2_t r = __builtin_convertvector(v, bf16x2_t);
    return *(unsigned*)&r;
}

__device__ __forceinline__ float wave_sum(float v) {
#pragma unroll
    for (int o = 32; o > 0; o >>= 1) v += __shfl_xor(v, o);
    return v;
}
__device__ __forceinline__ float wave_max(float v) {
#pragma unroll
    for (int o = 32; o > 0; o >>= 1) v = fmaxf(v, __shfl_xor(v, o));
    return v;
}
__device__ __forceinline__ int wave_isum(int v) {
#pragma unroll
    for (int o = 32; o > 0; o >>= 1) v += __shfl_xor(v, o);
    return v;
}
__device__ __forceinline__ float silu_f(float x) { return x / (1.f + __expf(-x)); }

#define T_ 8192
#define D_ 2048
#define IN_AB 3472
#define IN_C 12288
#define NT 512
#define ALPHA_ 1.4142135623730951f
#define LOG2E_ 1.4426950408889634f

#define BM 256
#define BN 128
#define BK 64
#define LROW 80
#define GEMM_BUF (BM * LROW + BN * LROW)
#define GEMM_LDS_BYTES (2 * GEMM_BUF * 2)

#define B_F32_KN 0
#define B_BF16_NK 1

typedef f32x4 Acc[4][4];

__device__ __forceinline__ __amdgpu_buffer_rsrc_t make_rsrc(const void* p) {
    const unsigned long long a = (unsigned long long)p;
    const unsigned lo = __builtin_amdgcn_readfirstlane((unsigned)a), hi = __builtin_amdgcn_readfirstlane((unsigned)(a >> 32));
    return __builtin_amdgcn_make_buffer_rsrc((void*)(((unsigned long long)hi << 32) | lo), 0, 0x7fffffff, 0x00020000);
}
__device__ __forceinline__ u32x4 bload16(__amdgpu_buffer_rsrc_t r, unsigned voff, unsigned soff) {
    return __builtin_amdgcn_raw_buffer_load_b128(r, (int)voff, (int)soff, 0);
}

__device__ __forceinline__ void acc_zero(Acc& acc) {
#pragma unroll
    for (int m = 0; m < 4; ++m)
#pragma unroll
        for (int n = 0; n < 4; ++n) acc[m][n] = (f32x4){0.f, 0.f, 0.f, 0.f};
}

template <int BMODE, bool KS, class ARow, class BSel>
__device__ __forceinline__ void gemm_accum(Acc& acc, const u16* __restrict__ A, int lda, ARow arow,
                                           const void* __restrict__ Bv, int ldb, BSel bsel,
                                           int K, u16* lds) {
    const int tid = ltid(), lane = tid & 63;
    const int wid = __builtin_amdgcn_readfirstlane(tid >> 6);
    const int wr = KS ? ((wid & 3) >> 1) : (wid >> 1), wc = wid & 1, fr = lane & 15, fq = lane >> 4;
    constexpr int NA = KS ? 2 : 4;
    const int ac = tid & 7, ar0 = tid >> 3;
    unsigned ao[NA];
#pragma unroll
    for (int i = 0; i < NA; ++i) ao[i] = ((unsigned)arow(ar0 + 64 * i) * (unsigned)lda + ac * 8) * 2u;
    const int nk = K / BK;
    const int sa_w = ar0 * LROW + ac * 8;
    constexpr int SB0 = BM * LROW;
    const __amdgpu_buffer_rsrc_t rA = make_rsrc(A);

#define GEMM_COMPUTE(buf) do { \
        const u16* sA = lds + (buf) * GEMM_BUF; const u16* sB = sA + SB0; \
        _Pragma("unroll") for (int ks = 0; ks < 2; ++ks) { \
            if (KS && ks != (wid >> 2)) continue; \
            bf16x8 af[4], bfr[4]; \
            _Pragma("unroll") for (int m = 0; m < 4; ++m) af[m] = *(const bf16x8*)(sA + (wr * 64 + m * 16 + fr) * LROW + ks * 32 + fq * 8); \
            _Pragma("unroll") for (int n = 0; n < 4; ++n) bfr[n] = *(const bf16x8*)(sB + (wc * 64 + n * 16 + fr) * LROW + ks * 32 + fq * 8); \
            _Pragma("unroll") for (int m = 0; m < 4; ++m) \
            _Pragma("unroll") for (int n = 0; n < 4; ++n) \
                acc[m][n] = __builtin_amdgcn_mfma_f32_16x16x32_bf16(af[m], bfr[n], acc[m][n], 0, 0, 0); \
        } } while (0)

    __syncthreads();

    if constexpr (BMODE == B_F32_KN) {
        const int g4 = tid & 15, kr = tid >> 4;
        const __amdgpu_buffer_rsrc_t rB0 = make_rsrc(bsel.base((const float*)Bv, 0));
        const __amdgpu_buffer_rsrc_t rB1 = make_rsrc(bsel.base((const float*)Bv, 1));
        const unsigned ldb4 = (unsigned)ldb * 4u;
        const unsigned bof0 = (unsigned)kr * ldb4 + bsel.off4(0, g4) * 4u, bof1 = (unsigned)kr * ldb4 + bsel.off4(1, g4) * 4u;
        const int xw = ((kr & 3) << 2) | ((kr >> 2) & 3);
        const int v00 = bsel.vcol4(0, g4), v01 = bsel.vcol4(1, g4);
        const int sbw0 = SB0 * 2 + kr * 256 + 16 * ((v00 >> 3) ^ xw) + 8 * ((v00 >> 2) & 1);
        const int sbw1 = SB0 * 2 + kr * 256 + 16 * ((v01 >> 3) ^ xw) + 8 * ((v01 >> 2) & 1);
        int rdo[2][4];
#pragma unroll
        for (int t = 0; t < 2; ++t) {
            const int xr = ((fr >> 2) << 2) | ((2 * fq + t) & 3);
#pragma unroll
            for (int n = 0; n < 4; ++n)
                rdo[t][n] = SB0 * 2 + (8 * fq + 4 * t + (fr >> 2)) * 256 + 16 * ((2 * (wc * 4 + n) + ((fr & 3) >> 1)) ^ xr) + 8 * (fr & 1);
        }
        u32x4 ra0[NA], ra1[NA]; u32x4 rb0[4], rb1[4];
#define PK4_(V) (w_.x = pack2(__uint_as_float(V[0]), __uint_as_float(V[1])), w_.y = pack2(__uint_as_float(V[2]), __uint_as_float(V[3])))
#define GL_F32(k0, RA, RB) do { \
        _Pragma("unroll") for (int i = 0; i < NA; ++i) RA[i] = bload16(rA, ao[i], (unsigned)(k0) * 2u); \
        const unsigned s0_ = (unsigned)(k0) * ldb4, s1_ = s0_ + 32u * ldb4; \
        RB[0] = bload16(rB0, bof0, s0_); RB[1] = bload16(rB1, bof1, s0_); \
        RB[2] = bload16(rB0, bof0, s1_); RB[3] = bload16(rB1, bof1, s1_); } while (0)
#define LW_F32(buf, RA, RB) do { \
        u16* sb_ = lds + (buf) * GEMM_BUF; \
        _Pragma("unroll") for (int i = 0; i < NA; ++i) *(u32x4*)(sb_ + sa_w + 64 * i * LROW) = RA[i]; \
        char* cb_ = (char*)sb_; \
        u32x2 w_; \
        PK4_(RB[0]); *(u32x2*)(cb_ + sbw0) = w_; \
        PK4_(RB[1]); *(u32x2*)(cb_ + sbw1) = w_; \
        PK4_(RB[2]); *(u32x2*)(cb_ + sbw0 + 32 * 256) = w_; \
        PK4_(RB[3]); *(u32x2*)(cb_ + sbw1 + 32 * 256) = w_; } while (0)
#define COMPUTE_KN(buf) do { \
        const u16* sA = lds + (buf) * GEMM_BUF; \
        const LAS char* cB = (const LAS char*)(lds + (buf) * GEMM_BUF); \
        _Pragma("unroll") for (int ks = 0; ks < 2; ++ks) { \
            if (KS && ks != (wid >> 2)) continue; \
            bf16x8 af[4], bfr[4]; \
            _Pragma("unroll") for (int m = 0; m < 4; ++m) af[m] = *(const bf16x8*)(sA + (wr * 64 + m * 16 + fr) * LROW + ks * 32 + fq * 8); \
            _Pragma("unroll") for (int n = 0; n < 4; ++n) { \
                const s16x4 lo_ = __builtin_amdgcn_ds_read_tr16_b64_v4i16((LAS s16x4*)(cB + rdo[0][n] + ks * 8192)); \
                const s16x4 hi_ = __builtin_amdgcn_ds_read_tr16_b64_v4i16((LAS s16x4*)(cB + rdo[1][n] + ks * 8192)); \
                bfr[n] = __builtin_shufflevector(lo_, hi_, 0, 1, 2, 3, 4, 5, 6, 7); } \
            _Pragma("unroll") for (int m = 0; m < 4; ++m) \
            _Pragma("unroll") for (int n = 0; n < 4; ++n) \
                acc[m][n] = __builtin_amdgcn_mfma_f32_16x16x32_bf16(af[m], bfr[n], acc[m][n], 0, 0, 0); \
        } } while (0)
        GL_F32(0, ra0, rb0);
        GL_F32(BK, ra1, rb1);
        LW_F32(0, ra0, rb0);
        if (2 < nk) GL_F32(2 * BK, ra0, rb0);
        __syncthreads();
        for (int kt = 0; kt < nk; kt += 2) {
            LW_F32(1, ra1, rb1);
            if (kt + 3 < nk) GL_F32((kt + 3) * BK, ra1, rb1);
            COMPUTE_KN(0);
            __syncthreads();
            if (kt + 2 < nk) LW_F32(0, ra0, rb0);
            if (kt + 4 < nk) GL_F32((kt + 4) * BK, ra0, rb0);
            COMPUTE_KN(1);
            __syncthreads();
        }
#undef GL_F32
#undef LW_F32
#undef COMPUTE_KN
    } else {
        const __amdgpu_buffer_rsrc_t rB = make_rsrc(Bv);
        unsigned bo[2];
#pragma unroll
        for (int i = 0; i < 2; ++i) bo[i] = ((unsigned)bsel(ar0 + 64 * i) * (unsigned)ldb + ac * 8) * 2u;
        u32x4 ra0[NA], ra1[NA], rb0[2], rb1[2];
#define GL_BF(k0, RA, RB) do { \
        _Pragma("unroll") for (int i = 0; i < NA; ++i) RA[i] = bload16(rA, ao[i], (unsigned)(k0) * 2u); \
        _Pragma("unroll") for (int i = 0; i < 2; ++i) RB[i] = bload16(rB, bo[i], (unsigned)(k0) * 2u); } while (0)
#define LW_BF(buf, RA, RB) do { \
        u16* sb_ = lds + (buf) * GEMM_BUF; \
        _Pragma("unroll") for (int i = 0; i < NA; ++i) *(u32x4*)(sb_ + sa_w + 64 * i * LROW) = RA[i]; \
        _Pragma("unroll") for (int i = 0; i < 2; ++i) *(u32x4*)(sb_ + SB0 + sa_w + 64 * i * LROW) = RB[i]; } while (0)
        GL_BF(0, ra0, rb0);
        GL_BF(BK, ra1, rb1);
        LW_BF(0, ra0, rb0);
        if (2 < nk) GL_BF(2 * BK, ra0, rb0);
        __syncthreads();
        for (int kt = 0; kt < nk; kt += 2) {
            LW_BF(1, ra1, rb1);
            if (kt + 3 < nk) GL_BF((kt + 3) * BK, ra1, rb1);
            GEMM_COMPUTE(0);
            __syncthreads();
            if (kt + 2 < nk) LW_BF(0, ra0, rb0);
            if (kt + 4 < nk) GL_BF((kt + 4) * BK, ra0, rb0);
            GEMM_COMPUTE(1);
            __syncthreads();
        }
#undef GL_BF
#undef LW_BF
    }
#undef GEMM_COMPUTE
}
__device__ __forceinline__ bool ksplit_reduce(Acc& acc, u16* lds) {
    const int tid = ltid(), lane = tid & 63;
    const int wid = __builtin_amdgcn_readfirstlane(tid >> 6);
    float* f = (float*)lds + (wid & 3) * 4096 + lane;
    if (wid >= 4) {
#pragma unroll
        for (int m = 0; m < 4; ++m)
#pragma unroll
            for (int n = 0; n < 4; ++n)
#pragma unroll
                for (int j = 0; j < 4; ++j) f[((m * 4 + n) * 4 + j) * 64] = acc[m][n][j];
    }
    __syncthreads();
    if (wid < 4) {
#pragma unroll
        for (int m = 0; m < 4; ++m)
#pragma unroll
            for (int n = 0; n < 4; ++n)
#pragma unroll
                for (int j = 0; j < 4; ++j) acc[m][n][j] += f[((m * 4 + n) * 4 + j) * 64];
    }
    return wid < 4;
}

struct Params {
    const float* x; const int* pos; const float* router_w; const float* router_b;
    const float* w_in0; const float* q_norm; const float* w_uq; const float* kv_norm; const float* w_ukv; const float* w_out0;
    const float* w_in1; const float* gn_g; const float* gn_b; const float* w_out1;
    const float* ln_mix_g[2]; const float* ln_mix_b[2];
    const float* moe_wg[2]; const float* moe_wu[2]; const float* moe_wd[2];
    const float* sh_g[2]; const float* sh_u[2]; const float* sh_d[2];
    const float* ln_ffn_g[2]; const float* ln_ffn_b[2];
    float* out;
    unsigned* bar; unsigned* ctl;
    float* cosA; float* sinA; float* cosR; float* sinR;
    u16* xb; float* H0;
    u16* cqn; u16* ckvn; u16* kpe; u16* qb; u16* kb; u16* vb; u16* iqb; u16* ikb; float* iwf;
    u16* qa; u16* ka; u16* vaT;
    float* scores; u16* sel; u16* outcat;
    float* ybuf; float* xa; u16* xab; u16* xlb; u16* whT; u16* wlT; float* y2; float* xc; u16* xcb;
    int* tok_e; float* tok_g; int* list; u16* hbuf; u16* hsh; u16* yr;
    u16* qr; u16* qx; u16* kr; u16* kzT; u16* v1T; u16* sg; u16* KVt; u16* innerG; u16* obuf; u16* gated;
    int out_size; int pad_;
};
typedef const __attribute__((address_space(4))) Params* KP;
__device__ __forceinline__ KP getp() { KP kp = (KP)__builtin_amdgcn_kernarg_segment_ptr(); asm volatile("" : "+s"(kp)); return kp; }
#define CTL_FLAGS 0
#define CTL_QUEUE 16
#define CTL_CNT0 64
#define CTL_CNT1 128
#define CTL_WORDS 256

struct RowId { int base; __device__ __forceinline__ int operator()(int r) const { return base + r; } };
struct ColOff { int c0;
    __device__ __forceinline__ const float* base(const float* B, int) const { return B; }
    __device__ __forceinline__ unsigned off4(int hsel, int g4) const { return (unsigned)(c0 + hsel * 64 + g4 * 4); }
    __device__ __forceinline__ int vcol4(int hsel, int g4) const { return hsel * 64 + g4 * 4; } };
struct ColClampOff { int c0, n;
    __device__ __forceinline__ const float* base(const float* B, int) const { return B; }
    __device__ __forceinline__ unsigned off4(int hsel, int g4) const { const int c = c0 + hsel * 64 + g4 * 4; return (unsigned)(c < n - 4 ? c : n - 4); }
    __device__ __forceinline__ int vcol4(int hsel, int g4) const { return hsel * 64 + g4 * 4; } };

__device__ __forceinline__ void ph_prep(KP p) {
    const int gtid = blockIdx.x * NT + ltid(), gsz = gridDim.x * NT;
    for (size_t i = gtid; i < (size_t)T_ * D_ / 4; i += gsz) {
        float4 v = ((const float4*)p->x)[i];
        u32x2 o; o.x = pack2(v.x, v.y); o.y = pack2(v.z, v.w);
        ((u32x2*)p->xb)[i] = o;
    }
    for (int idx = gtid; idx < D_ * 64; idx += gsz) {
        const int k = idx >> 6, e = idx & 63;
        const float w = p->router_w[idx];
        const u16 hi = f2bf(w);
        p->whT[(size_t)e * D_ + k] = hi;
        p->wlT[(size_t)e * D_ + k] = f2bf(w - bf2f(hi));
    }
    const double inv2pi = 0.15915494309189535;
    for (int idx = gtid; idx < T_ * 32; idx += gsz) {
        const int t = idx >> 5, i = idx & 31;
        const float inv = (float)exp2(-(double)i * (18.931568569324174 / 32.0));
        double rev = (double)p->pos[t] * (double)inv * inv2pi;
        rev -= floor(rev);
        p->cosA[idx] = __builtin_amdgcn_cosf((float)rev);
        p->sinA[idx] = __builtin_amdgcn_sinf((float)rev);
    }
    for (int idx = gtid; idx < T_ * 128; idx += gsz) {
        const int t = idx >> 7, i = idx & 127;
        const float inv = (float)exp2(-(double)i * (13.287712379549449 / 128.0));
        double rev = (double)p->pos[t] * (double)inv * inv2pi;
        rev -= floor(rev);
        p->cosR[idx] = __builtin_amdgcn_cosf((float)rev);
        p->sinR[idx] = __builtin_amdgcn_sinf((float)rev);
    }
}

struct EpiF32 {
    float* C; int ldc; int row0, col0, ncols;
    __device__ __forceinline__ void operator()(Acc& acc, int wr0, int wc0, int fr, int fq) const {
#pragma unroll
        for (int m = 0; m < 4; ++m)
#pragma unroll
            for (int n = 0; n < 4; ++n) {
                const int c = col0 + wc0 + n * 16 + fr;
                if (c < ncols) {
#pragma unroll
                    for (int j = 0; j < 4; ++j)
                        C[(size_t)(row0 + wr0 + m * 16 + fq * 4 + j) * ldc + c] = acc[m][n][j];
                }
            }
    }
};
struct EpiBF16 {
    u16* C; int ldc; int row0, col0;
    __device__ __forceinline__ void operator()(Acc& acc, int wr0, int wc0, int fr, int fq) const {
#pragma unroll
        for (int m = 0; m < 4; ++m)
#pragma unroll
            for (int n = 0; n < 4; ++n) {
                const int c = col0 + wc0 + n * 16 + fr;
#pragma unroll
                for (int j = 0; j < 4; ++j)
                    C[(size_t)(row0 + wr0 + m * 16 + fq * 4 + j) * ldc + c] = f2bf(acc[m][n][j]);
            }
    }
};
struct EpiResid {
    float* C; const float* X; int ldc; int row0, col0;
    __device__ __forceinline__ void operator()(Acc& acc, int wr0, int wc0, int fr, int fq) const {
#pragma unroll
        for (int m = 0; m < 4; ++m)
#pragma unroll
            for (int n = 0; n < 4; ++n) {
                const int c = col0 + wc0 + n * 16 + fr;
#pragma unroll
                for (int j = 0; j < 4; ++j) {
                    const size_t o = (size_t)(row0 + wr0 + m * 16 + fq * 4 + j) * ldc + c;
                    C[o] = ALPHA_ * X[o] + acc[m][n][j];
                }
            }
    }
};

__device__ __forceinline__ void ph_post0(KP p) {
    const int lane = ltid() & 63;
    const int gw = (blockIdx.x * NT + ltid()) >> 6, nw = (gridDim.x * NT) >> 6;
    const float qscale = 0.08838834764831845f * LOG2E_;
    for (int t = gw; t < T_; t += nw) {
        const float* h = p->H0 + (size_t)t * IN_AB;
        const float* ca = p->cosA + t * 32;
        const float* sa = p->sinA + t * 32;
        {
            float v[8]; float ss = 0.f;
#pragma unroll
            for (int j = 0; j < 8; ++j) { v[j] = h[lane + 64 * j]; ss += v[j] * v[j]; }
            ss = wave_sum(ss);
            const float r = rsqrtf(ss * (1.f / 512.f) + 1e-6f);
#pragma unroll
            for (int j = 0; j < 8; ++j) p->cqn[(size_t)t * 512 + lane + 64 * j] = f2bf(v[j] * r * p->q_norm[lane + 64 * j]);
        }
        {
            float v[4]; float ss = 0.f;
#pragma unroll
            for (int j = 0; j < 4; ++j) { v[j] = h[512 + lane + 64 * j]; ss += v[j] * v[j]; }
            ss = wave_sum(ss);
            const float r = rsqrtf(ss * (1.f / 256.f) + 1e-6f);
#pragma unroll
            for (int j = 0; j < 4; ++j) p->ckvn[(size_t)t * 256 + lane + 64 * j] = f2bf(v[j] * r * p->kv_norm[lane + 64 * j]);
        }
        {
            const int i = lane & 31;
            const float c = ca[i], s = sa[i];
            const float x1 = h[768 + i], x2 = h[768 + 32 + i];
            p->kpe[(size_t)t * 64 + lane] = f2bf(lane < 32 ? x1 * c - x2 * s : x1 * s + x2 * c);
        }
#pragma unroll 4
        for (int j = 0; j < 16; ++j) {
            const int e = lane + 64 * j, hd = e >> 7, d = e & 127;
            float o;
            if (d < 32) {
                const int i = d & 15;
                const float c = ca[2 * i], s = sa[2 * i];
                const float x1 = h[832 + hd * 128 + i], x2 = h[832 + hd * 128 + 16 + i];
                o = d < 16 ? x1 * c - x2 * s : x1 * s + x2 * c;
            } else o = h[832 + e];
            p->qb[(size_t)t * 1024 + e] = f2bf(o * qscale);
        }
#pragma unroll
        for (int j = 0; j < 4; ++j) {
            const int e = lane + 64 * j, hd = e >> 7, d = e & 127;
            float o;
            if (d < 32) {
                const int i = d & 15;
                const float c = ca[2 * i], s = sa[2 * i];
                const float x1 = h[1856 + hd * 128 + i], x2 = h[1856 + hd * 128 + 16 + i];
                o = d < 16 ? x1 * c - x2 * s : x1 * s + x2 * c;
            } else o = h[1856 + e];
            p->kb[(size_t)t * 256 + e] = f2bf(o);
            p->vb[(size_t)t * 256 + e] = f2bf(h[2112 + e]);
        }
#pragma unroll 4
        for (int j = 0; j < 16; ++j) {
            const int e = lane + 64 * j, hd = e >> 6, d = e & 63;
            float o;
            if (d < 16) {
                const int i = d & 7;
                const float c = ca[4 * i], s = sa[4 * i];
                const float x1 = h[2368 + hd * 64 + i], x2 = h[2368 + hd * 64 + 8 + i];
                o = d < 8 ? x1 * c - x2 * s : x1 * s + x2 * c;
            } else o = h[2368 + e];
            p->iqb[(size_t)t * 1024 + e] = f2bf(o);
        }
        {
            const int d = lane;
            float o;
            if (d < 16) {
                const int i = d & 7;
                const float c = ca[4 * i], s = sa[4 * i];
                const float x1 = h[3392 + i], x2 = h[3392 + 8 + i];
                o = d < 8 ? x1 * c - x2 * s : x1 * s + x2 * c;
            } else o = h[3392 + d];
            p->ikb[(size_t)t * 64 + d] = f2bf(o);
        }
        if (lane < 16) p->iwf[t * 16 + lane] = h[3456 + lane] * 0.03125f;
    }
}

struct EpiQa {
    u16* C; const float* ca; const float* sa; int row0, col0;
    __device__ __forceinline__ void operator()(Acc& acc, int wr0, int wc0, int fr, int fq) const {
        const float sc = 0.07216878364870323f * LOG2E_;
        const int cbase = col0 + wc0;
        const bool rope = (cbase % 192) == 128;
#pragma unroll
        for (int m = 0; m < 4; ++m)
#pragma unroll
            for (int j = 0; j < 4; ++j) {
                const int r = row0 + wr0 + m * 16 + fq * 4 + j;
                float v[4];
#pragma unroll
                for (int n = 0; n < 4; ++n) v[n] = acc[m][n][j];
                if (rope) {
#pragma unroll
                    for (int n = 0; n < 2; ++n) {
                        const int i = n * 16 + fr;
                        const float c = ca[r * 32 + i], s = sa[r * 32 + i];
                        const float x1 = v[n], x2 = v[n + 2];
                        v[n] = x1 * c - x2 * s; v[n + 2] = x1 * s + x2 * c;
                    }
                }
#pragma unroll
                for (int n = 0; n < 4; ++n) C[(size_t)r * 1536 + cbase + n * 16 + fr] = f2bf(v[n] * sc);
            }
    }
};
struct EpiKva {
    u16* ka; u16* vaT; int row0, col0;
    __device__ __forceinline__ void operator()(Acc& acc, int wr0, int wc0, int fr, int fq) const {
        const int cbase = col0 + wc0;
        const int hd = cbase >> 8, within = cbase & 255;
#pragma unroll
        for (int m = 0; m < 4; ++m) {
            const int r = row0 + wr0 + m * 16 + fq * 4;
#pragma unroll
            for (int n = 0; n < 4; ++n) {
                const int c = within + n * 16 + fr;
                if (within < 128) {
#pragma unroll
                    for (int j = 0; j < 4; ++j) ka[(size_t)(r + j) * 1024 + hd * 128 + c] = f2bf(acc[m][n][j]);
                } else {
                    u32x2 o; o.x = pack2(acc[m][n][0], acc[m][n][1]); o.y = pack2(acc[m][n][2], acc[m][n][3]);
                    *(u32x2*)(vaT + (size_t)(hd * 128 + (c - 128)) * T_ + r) = o;
                }
            }
        }
    }
};

__device__ __forceinline__ void indexer_tile(KP p, int qt, int kt) {
    const int lane = ltid() & 63, wid = (ltid() >> 6) & 3;
    const int wr = wid >> 1, wc = wid & 1, fr = lane & 15, fq = lane >> 4;
    const int k0 = kt * 128 + wr * 64, q0 = qt * 128 + wc * 64;
    bf16x8 af[4][2];
#pragma unroll
    for (int m = 0; m < 4; ++m)
#pragma unroll
        for (int ks = 0; ks < 2; ++ks)
            af[m][ks] = *(const bf16x8*)(p->ikb + (size_t)(k0 + m * 16 + fr) * 64 + ks * 32 + fq * 8);
    Acc sc; acc_zero(sc);
    for (int h = 0; h < 16; ++h) {
        bf16x8 bq[4][2]; float w[4];
#pragma unroll
        for (int n = 0; n < 4; ++n) {
            const size_t qrow = (size_t)(q0 + n * 16 + fr);
            bq[n][0] = *(const bf16x8*)(p->iqb + qrow * 1024 + h * 64 + fq * 8);
            bq[n][1] = *(const bf16x8*)(p->iqb + qrow * 1024 + h * 64 + 32 + fq * 8);
            w[n] = p->iwf[qrow * 16 + h];
        }
#pragma unroll
        for (int m = 0; m < 4; ++m)
#pragma unroll
            for (int n = 0; n < 4; ++n) {
                f32x4 d = (f32x4){0.f, 0.f, 0.f, 0.f};
                d = __builtin_amdgcn_mfma_f32_16x16x32_bf16(af[m][0], bq[n][0], d, 0, 0, 0);
                d = __builtin_amdgcn_mfma_f32_16x16x32_bf16(af[m][1], bq[n][1], d, 0, 0, 0);
#pragma unroll
                for (int j = 0; j < 4; ++j) sc[m][n][j] += w[n] * fmaxf(d[j], 0.f);
            }
    }
#pragma unroll
    for (int m = 0; m < 4; ++m)
#pragma unroll
        for (int n = 0; n < 4; ++n)
            *(f32x4*)(p->scores + (size_t)(q0 + n * 16 + fr) * T_ + k0 + m * 16 + fq * 4) = sc[m][n];
}

__device__ __forceinline__ unsigned fkey(float f) {
    const unsigned u = __float_as_uint(f);
    return (u & 0x80000000u) ? ~u : (u | 0x80000000u);
}
__device__ __forceinline__ void ph_topk(KP p) {
    const int lane = ltid() & 63;
    const int gw = __builtin_amdgcn_readfirstlane((blockIdx.x * NT + ltid()) >> 6), nw = (gridDim.x * NT) >> 6;
    for (int qq = gw; qq < T_ / 2; qq += nw)
    for (int sside = 0; sside < 2; ++sside) {
        const int q = sside ? (T_ - 1 - qq) : qq;
        u16* so = p->sel + (size_t)q * 256;
        if (q < 256) {
#pragma unroll
            for (int i = 0; i < 4; ++i) { const int s = lane + 64 * i; so[s] = (u16)(s <= q ? s : 0); }
            continue;
        }
        const int ng = (q >> 10) + 1;
        unsigned key[128];
        const float* row = p->scores + (size_t)q * T_;
#pragma unroll
        for (int g = 0; g < 8; ++g) {
            if (g < ng) {
#pragma unroll
                for (int i = 0; i < 16; ++i) {
                    const int idx = lane + 64 * (g * 16 + i);
                    key[g * 16 + i] = idx <= q ? fkey(row[idx]) : 0u;
                }
            } else {
#pragma unroll
                for (int i = 0; i < 16; ++i) key[g * 16 + i] = 0u;
            }
        }
        unsigned prefix = 0u;
        for (int b = 31; b >= 0; --b) {
            const unsigned cand = prefix | (1u << b);
            int cnt = 0;
#pragma unroll
            for (int g = 0; g < 8; ++g) {
                if (g < ng) {
#pragma unroll
                    for (int i = 0; i < 16; ++i) cnt += __builtin_popcountll(__ballot(key[g * 16 + i] >= cand));
                }
            }
            if (cnt >= 256) prefix = cand;
            if (cnt == 256) break;
        }
        int base = 0;
#pragma unroll
        for (int g = 0; g < 8; ++g) {
            if (g < ng) {
#pragma unroll
                for (int i = 0; i < 16; ++i) {
                    const bool gt = key[g * 16 + i] > prefix;
                    const unsigned long long m = __ballot(gt);
                    if (gt) {
                        const int pos = base + (int)__builtin_amdgcn_mbcnt_hi((unsigned)(m >> 32), __builtin_amdgcn_mbcnt_lo((unsigned)m, 0u));
                        so[pos] = (u16)(lane + 64 * (g * 16 + i));
                    }
                    base += __builtin_popcountll(m);
                }
            }
        }
#pragma unroll
        for (int g = 0; g < 8; ++g) {
            if (g < ng && base < 256) {
#pragma unroll
                for (int i = 0; i < 16; ++i) {
                    const bool eq = key[g * 16 + i] == prefix;
                    const unsigned long long m = __ballot(eq);
                    if (eq) {
                        const int pos = base + (int)__builtin_amdgcn_mbcnt_hi((unsigned)(m >> 32), __builtin_amdgcn_mbcnt_lo((unsigned)m, 0u));
                        if (pos < 256) so[pos] = (u16)(lane + 64 * (g * 16 + i));
                    }
                    base += __builtin_popcountll(m);
                }
            }
        }
    }
}
#define KROW 208
#define VROW 80
#define ATT_LDS_BYTES (64 * KROW * 2 + 128 * VROW * 2)

__device__ __forceinline__ void mla_item(KP p, int h, int qb, u16* lds) {
    const int tid = ltid() & 255, lane = tid & 63, wid = tid >> 6, fr = lane & 15, fq = lane >> 4;
    u16* sK = lds;
    u16* sV = lds + 64 * KROW;
    const int q0 = qb * 128;
    bf16x8 qf[2][6];
#pragma unroll
    for (int nq = 0; nq < 2; ++nq)
#pragma unroll
        for (int kc = 0; kc < 6; ++kc)
            qf[nq][kc] = *(const bf16x8*)(p->qa + (size_t)(q0 + wid * 32 + nq * 16 + fr) * 1536 + h * 192 + kc * 32 + fq * 8);
    f32x4 O[8][2];
#pragma unroll
    for (int m = 0; m < 8; ++m) { O[m][0] = (f32x4){0.f, 0.f, 0.f, 0.f}; O[m][1] = (f32x4){0.f, 0.f, 0.f, 0.f}; }
    float mrun[2] = {-1e30f, -1e30f}, lrun[2] = {0.f, 0.f};

    const int k0t = tid >> 4, k1t = tid >> 3;
    const u16* kpn = p->ka + (size_t)k0t * 1024 + h * 128 + (tid & 15) * 8;
    const u16* kpr = p->kpe + (size_t)k1t * 64 + (tid & 7) * 8;
    const u16* vpp = p->vaT + (size_t)(h * 128 + k1t) * T_ + (tid & 7) * 8;
    const int kln = (((k0t >> 2) & 1) * 16 + (k0t >> 3) * 4 + (k0t & 3)) * KROW + (tid & 15) * 8;
    const int klr = (((k1t >> 2) & 1) * 16 + (k1t >> 3) * 4 + (k1t & 3)) * KROW + 128 + (tid & 7) * 8;
    const int vl0 = k1t * VROW + (tid & 7) * 8;
    u32x4 kreg[6], vreg[4];
    const int ntiles = 2 * qb + 2;
#define ATT_GLOAD(kt) do { \
    _Pragma("unroll") for (int i = 0; i < 4; ++i) kreg[i] = *(const u32x4*)(kpn + (size_t)((kt) * 64 + 16 * i) * 1024); \
    _Pragma("unroll") for (int i = 0; i < 2; ++i) kreg[4 + i] = *(const u32x4*)(kpr + (size_t)((kt) * 64 + 32 * i) * 64); \
    _Pragma("unroll") for (int i = 0; i < 4; ++i) vreg[i] = *(const u32x4*)(vpp + (size_t)(32 * i) * T_ + (kt) * 64); } while (0)
    ATT_GLOAD(0);
    for (int kt = 0; kt < ntiles; ++kt) {
#pragma unroll
        for (int i = 0; i < 4; ++i) *(u32x4*)(sK + kln + (8 * (i & 1) + 32 * (i >> 1)) * KROW) = kreg[i];
#pragma unroll
        for (int i = 0; i < 2; ++i) *(u32x4*)(sK + klr + 32 * i * KROW) = kreg[4 + i];
#pragma unroll
        for (int i = 0; i < 4; ++i) *(u32x4*)(sV + vl0 + 32 * i * VROW) = vreg[i];
        __syncthreads();
        if (kt + 1 < ntiles) ATT_GLOAD(kt + 1);
        f32x4 s[2][4];
#pragma unroll
        for (int n = 0; n < 4; ++n) { s[0][n] = (f32x4){0.f, 0.f, 0.f, 0.f}; s[1][n] = (f32x4){0.f, 0.f, 0.f, 0.f}; }
#pragma unroll
        for (int kc = 0; kc < 6; ++kc)
#pragma unroll
            for (int n = 0; n < 4; ++n) {
                const bf16x8 a = *(const bf16x8*)(sK + (n * 16 + fr) * KROW + kc * 32 + fq * 8);
                s[0][n] = __builtin_amdgcn_mfma_f32_16x16x32_bf16(a, qf[0][kc], s[0][n], 0, 0, 0);
                s[1][n] = __builtin_amdgcn_mfma_f32_16x16x32_bf16(a, qf[1][kc], s[1][n], 0, 0, 0);
            }
        if (kt >= ntiles - 2) {
#pragma unroll
            for (int nq = 0; nq < 2; ++nq) {
                const int qi = q0 + wid * 32 + nq * 16 + fr;
#pragma unroll
                for (int n = 0; n < 4; ++n)
#pragma unroll
                    for (int j = 0; j < 4; ++j) {
                        const int ki = kt * 64 + (n >> 1) * 32 + fq * 8 + (n & 1) * 4 + j;
                        if (ki > qi) s[nq][n][j] = -1e30f;
                    }
            }
        }
        bf16x8 pf[2][2];
#pragma unroll
        for (int nq = 0; nq < 2; ++nq) {
            float mx = -1e30f;
#pragma unroll
            for (int n = 0; n < 4; ++n)
#pragma unroll
                for (int j = 0; j < 4; ++j) mx = fmaxf(mx, s[nq][n][j]);
            mx = fmaxf(mx, __shfl_xor(mx, 16));
            mx = fmaxf(mx, __shfl_xor(mx, 32));
            const float mnew = fmaxf(mrun[nq], mx);
            const float al = exp2f(mrun[nq] - mnew);
            mrun[nq] = mnew;
            float ps = 0.f;
#pragma unroll
            for (int n = 0; n < 4; ++n)
#pragma unroll
                for (int j = 0; j < 4; ++j) { const float e = exp2f(s[nq][n][j] - mnew); s[nq][n][j] = e; ps += e; }
            lrun[nq] = lrun[nq] * al + ps;
#pragma unroll
            for (int m = 0; m < 8; ++m) O[m][nq] *= al;
#pragma unroll
            for (int c = 0; c < 2; ++c) {
                u32x4 w;
                w.x = pack2(s[nq][2 * c][0], s[nq][2 * c][1]);
                w.y = pack2(s[nq][2 * c][2], s[nq][2 * c][3]);
                w.z = pack2(s[nq][2 * c + 1][0], s[nq][2 * c + 1][1]);
                w.w = pack2(s[nq][2 * c + 1][2], s[nq][2 * c + 1][3]);
                pf[nq][c] = *(bf16x8*)&w;
            }
        }
#pragma unroll
        for (int m = 0; m < 8; ++m)
#pragma unroll
            for (int c = 0; c < 2; ++c) {
                const bf16x8 a = *(const bf16x8*)(sV + (m * 16 + fr) * VROW + c * 32 + fq * 8);
                O[m][0] = __builtin_amdgcn_mfma_f32_16x16x32_bf16(a, pf[0][c], O[m][0], 0, 0, 0);
                O[m][1] = __builtin_amdgcn_mfma_f32_16x16x32_bf16(a, pf[1][c], O[m][1], 0, 0, 0);
            }
        __syncthreads();
    }
#undef ATT_GLOAD
#pragma unroll
    for (int nq = 0; nq < 2; ++nq) {
        float l = lrun[nq];
        l += __shfl_xor(l, 16);
        l += __shfl_xor(l, 32);
        const float il = 1.f / l;
        const int qi = q0 + wid * 32 + nq * 16 + fr;
#pragma unroll
        for (int m = 0; m < 8; ++m) {
            u32x2 o;
            o.x = pack2(O[m][nq][0] * il, O[m][nq][1] * il);
            o.y = pack2(O[m][nq][2] * il, O[m][nq][3] * il);
            *(u32x2*)(p->outcat + (size_t)qi * 2048 + h * 128 + m * 16 + fq * 4) = o;
        }
    }
}

#define DSA_WLDS 5632
__device__ __forceinline__ void dsa_task(KP p, int q, int g, unsigned char* wl) {
    const int lane = ltid() & 63;
    u16* sQ = (u16*)wl;
    float* sP = (float*)(wl + 1024);
    u16* sS = (u16*)(wl + 1024 + 4096);
    const int nsel = q < 255 ? q + 1 : 256;
    {
        const u16* qsrc = p->qb + (size_t)q * 1024 + g * 512;
        *(u32x4*)(sQ + lane * 8) = *(const u32x4*)(qsrc + lane * 8);
        *(u32x2*)(sS + lane * 4) = *(const u32x2*)(p->sel + (size_t)q * 256 + lane * 4);
    }
    __builtin_amdgcn_s_waitcnt(0);
    float sc[4][4];
    float mx[4] = {-1e30f, -1e30f, -1e30f, -1e30f};
#pragma unroll
    for (int r = 0; r < 4; ++r) {
        const int slot = lane + 64 * r;
        float a0 = 0.f, a1 = 0.f, a2 = 0.f, a3 = 0.f;
        if (slot < nsel) {
            const int ki = sS[slot];
            const u16* kr = p->kb + (size_t)ki * 256 + g * 128;
#pragma unroll
            for (int c = 0; c < 16; ++c) {
                const u32x4 kv = *(const u32x4*)(kr + c * 8);
                const u32x4 q0v = *(const u32x4*)(sQ + 0 * 128 + c * 8);
                const u32x4 q1v = *(const u32x4*)(sQ + 1 * 128 + c * 8);
                const u32x4 q2v = *(const u32x4*)(sQ + 2 * 128 + c * 8);
                const u32x4 q3v = *(const u32x4*)(sQ + 3 * 128 + c * 8);
#pragma unroll
                for (int e = 0; e < 4; ++e) {
                    const unsigned kk = kv[e];
                    const bf16x2_t kb2 = *(const bf16x2_t*)&kk;
                    unsigned t0 = q0v[e], t1 = q1v[e], t2 = q2v[e], t3 = q3v[e];
                    a0 = __builtin_amdgcn_fdot2_f32_bf16(kb2, *(const bf16x2_t*)&t0, a0, false);
                    a1 = __builtin_amdgcn_fdot2_f32_bf16(kb2, *(const bf16x2_t*)&t1, a1, false);
                    a2 = __builtin_amdgcn_fdot2_f32_bf16(kb2, *(const bf16x2_t*)&t2, a2, false);
                    a3 = __builtin_amdgcn_fdot2_f32_bf16(kb2, *(const bf16x2_t*)&t3, a3, false);
                }
            }
        } else { a0 = a1 = a2 = a3 = -1e30f; }
        sc[r][0] = a0; sc[r][1] = a1; sc[r][2] = a2; sc[r][3] = a3;
        mx[0] = fmaxf(mx[0], a0); mx[1] = fmaxf(mx[1], a1); mx[2] = fmaxf(mx[2], a2); mx[3] = fmaxf(mx[3], a3);
    }
    float ls[4];
#pragma unroll
    for (int hh = 0; hh < 4; ++hh) {
        const float m = wave_max(mx[hh]);
        float s = 0.f;
#pragma unroll
        for (int r = 0; r < 4; ++r) { const float e = exp2f(sc[r][hh] - m); sc[r][hh] = e; s += e; }
        ls[hh] = wave_sum(s);
    }
#pragma unroll
    for (int r = 0; r < 4; ++r) {
        f32x4 pv = {sc[r][0], sc[r][1], sc[r][2], sc[r][3]};
        *(f32x4*)(sP + (lane + 64 * r) * 4) = pv;
    }
    __builtin_amdgcn_s_waitcnt(0);
    float o[4][8];
#pragma unroll
    for (int hh = 0; hh < 4; ++hh)
#pragma unroll
        for (int d = 0; d < 8; ++d) o[hh][d] = 0.f;
    const int kg = lane >> 4, dc = lane & 15;
    const u16* vbase = p->vb + g * 128 + dc * 8;
    const int nit = (nsel + 3) >> 2;
    for (int it = 0; it < nit; it += 4) {
        u32x4 vv[4]; f32x4 pp[4];
#pragma unroll
        for (int u = 0; u < 4; ++u) {
            if (it + u < nit) {
                const int slot = (it + u) * 4 + kg;
                const int ki = sS[slot];
                vv[u] = *(const u32x4*)(vbase + (size_t)ki * 256);
                pp[u] = *(const f32x4*)(sP + slot * 4);
            } else { vv[u] = (u32x4){0u, 0u, 0u, 0u}; pp[u] = (f32x4){0.f, 0.f, 0.f, 0.f}; }
        }
#pragma unroll
        for (int u = 0; u < 4; ++u)
#pragma unroll
            for (int e = 0; e < 4; ++e) {
                const float v0 = __uint_as_float(vv[u][e] << 16), v1 = __uint_as_float(vv[u][e] & 0xffff0000u);
#pragma unroll
                for (int hh = 0; hh < 4; ++hh) { o[hh][2 * e] += pp[u][hh] * v0; o[hh][2 * e + 1] += pp[u][hh] * v1; }
            }
    }
#pragma unroll
    for (int hh = 0; hh < 4; ++hh)
#pragma unroll
        for (int d = 0; d < 8; ++d) {
            float v = o[hh][d];
            v += __shfl_xor(v, 16);
            v += __shfl_xor(v, 32);
            o[hh][d] = v;
        }
    if (kg == 0) {
#pragma unroll
        for (int hh = 0; hh < 4; ++hh) {
            const float il = 1.f / ls[hh];
            u32x4 w;
            w.x = pack2(o[hh][0] * il, o[hh][1] * il); w.y = pack2(o[hh][2] * il, o[hh][3] * il);
            w.z = pack2(o[hh][4] * il, o[hh][5] * il); w.w = pack2(o[hh][6] * il, o[hh][7] * il);
            *(u32x4*)(p->outcat + (size_t)q * 2048 + 1024 + (g * 4 + hh) * 128 + dc * 8) = w;
        }
    }
    __builtin_amdgcn_s_waitcnt(0);
}

__device__ __forceinline__ void ph_attn(KP p, unsigned char* smem, unsigned* misc, int qword = CTL_QUEUE, int lo = 0, int hi = 768) {
    const int tid = ltid(), wid = tid >> 6;
    for (;;) {
        __syncthreads();
        if (tid == 0) misc[0] = atomicAdd(&p->ctl[qword], 1u);
        __syncthreads();
        const int it = (int)misc[0] + lo;
        if (it >= hi) break;
        if (it < 256) {
            const int half = wid >> 2;
            mla_item(p, (it & 3) * 2 + half, 63 - (it >> 2), (u16*)(smem + half * ATT_LDS_BYTES));
        } else {
            const int base = (it - 256) * 16;
            for (int k = 0; k < 4; ++k) {
                const int task = wid * 4 + k;
                dsa_task(p, base + (task >> 1), task & 1, smem + wid * DSA_WLDS);
            }
        }
    }
}
template <bool ADD_ROUTED, bool ROUTE, bool WRITE_B>
__device__ __forceinline__ void ph_ln(KP p, const float* Y, const float* g, const float* b,
                                      float* XF, u16* XB, u16* XL) {
    const int lane = ltid() & 63;
    const int gw = (blockIdx.x * NT + ltid()) >> 6, nw = (gridDim.x * NT) >> 6;
    for (int t = gw; t < T_; t += nw) {
        float v[32];
        const float* y = Y + (size_t)t * D_;
        float sum = 0.f;
#pragma unroll
        for (int j = 0; j < 8; ++j) {
            const f32x4 a = *(const f32x4*)(y + j * 256 + lane * 4);
            v[4 * j] = a[0]; v[4 * j + 1] = a[1]; v[4 * j + 2] = a[2]; v[4 * j + 3] = a[3];
        }
        if constexpr (ADD_ROUTED) {
            const u16* r0 = p->yr + (size_t)(2 * t) * D_;
            const u16* r1 = r0 + D_;
#pragma unroll
            for (int j = 0; j < 8; ++j) {
                const u32x2 a = *(const u32x2*)(r0 + j * 256 + lane * 4);
                const u32x2 c = *(const u32x2*)(r1 + j * 256 + lane * 4);
                v[4 * j]     += __uint_as_float(a.x << 16) + __uint_as_float(c.x << 16);
                v[4 * j + 1] += __uint_as_float(a.x & 0xffff0000u) + __uint_as_float(c.x & 0xffff0000u);
                v[4 * j + 2] += __uint_as_float(a.y << 16) + __uint_as_float(c.y << 16);
                v[4 * j + 3] += __uint_as_float(a.y & 0xffff0000u) + __uint_as_float(c.y & 0xffff0000u);
            }
        }
#pragma unroll
        for (int i = 0; i < 32; ++i) sum += v[i];
        const float mu = wave_sum(sum) * (1.f / 2048.f);
        float var = 0.f;
#pragma unroll
        for (int i = 0; i < 32; ++i) { const float d = v[i] - mu; var += d * d; }
        var = wave_sum(var) * (1.f / 2048.f);
        const float rs = rsqrtf(var + 1e-5f);
#pragma unroll
        for (int j = 0; j < 8; ++j) {
            const int c = j * 256 + lane * 4;
            const f32x4 gg = *(const f32x4*)(g + c), bb = *(const f32x4*)(b + c);
            f32x4 o;
#pragma unroll
            for (int e = 0; e < 4; ++e) o[e] = (v[4 * j + e] - mu) * rs * gg[e] + bb[e];
            *(f32x4*)(XF + (size_t)t * D_ + c) = o;
            if constexpr (WRITE_B) {
                u32x2 w; w.x = pack2(o[0], o[1]); w.y = pack2(o[2], o[3]);
                *(u32x2*)(XB + (size_t)t * D_ + c) = w;
                if constexpr (ROUTE) {
                    u32x2 wl;
                    wl.x = pack2(o[0] - __uint_as_float(w.x << 16), o[1] - __uint_as_float(w.x & 0xffff0000u));
                    wl.y = pack2(o[2] - __uint_as_float(w.y << 16), o[3] - __uint_as_float(w.y & 0xffff0000u));
                    *(u32x2*)(XL + (size_t)t * D_ + c) = wl;
                }
            }
        }
    }
}

__device__ __forceinline__ void route_token(KP p, int t, float logit, int lane, unsigned* cnt, int* list) {
    const float sc = 1.f / (1.f + __expf(-logit));
    const float bi = sc + p->router_b[lane];
    float m1 = bi;
    m1 = fmaxf(m1, __shfl_xor(m1, 1)); m1 = fmaxf(m1, __shfl_xor(m1, 2)); m1 = fmaxf(m1, __shfl_xor(m1, 4));
    const int seg = lane >> 3;
    unsigned long long bal = __ballot(bi == m1);
    const int f1 = __builtin_ctz((unsigned)((bal >> (seg * 8)) & 0xffull));
    const float b2 = ((lane & 7) == f1) ? -1e30f : bi;
    float m2 = b2;
    m2 = fmaxf(m2, __shfl_xor(m2, 1)); m2 = fmaxf(m2, __shfl_xor(m2, 2)); m2 = fmaxf(m2, __shfl_xor(m2, 4));
    bal = __ballot(b2 == m2);
    const int f2 = __builtin_ctz((unsigned)((bal >> (seg * 8)) & 0xffull));
    const float gs = m1 + m2;
    float gm = gs;
    gm = fmaxf(gm, __shfl_xor(gm, 8)); gm = fmaxf(gm, __shfl_xor(gm, 16)); gm = fmaxf(gm, __shfl_xor(gm, 32));
    bal = __ballot(gs == gm);
    const int gsel = (int)(__builtin_ctzll(bal) >> 3);
    const int e0 = gsel * 8 + __shfl(f1, gsel * 8);
    const int e1 = gsel * 8 + __shfl(f2, gsel * 8);
    const float s0 = __shfl(sc, e0), s1 = __shfl(sc, e1);
    if (lane == 0) {
        const float inv = 1.f / (s0 + s1);
        const unsigned p0 = atomicAdd(&cnt[e0], 1u);
        const unsigned p1 = atomicAdd(&cnt[e1], 1u);
        list[e0 * T_ + p0] = 2 * t;
        list[e1 * T_ + p1] = 2 * t + 1;
        p->tok_g[2 * t] = s0 * inv;
        p->tok_g[2 * t + 1] = s1 * inv;
    }
}

__device__ __forceinline__ void ph_router(KP p, unsigned char* smem, unsigned* cnt, int* list) {
    const int tid = ltid(), lane = tid & 63, wid = tid >> 6, grp = wid >> 2, kq = wid & 3, fr = lane & 15, fq = lane >> 4;
    float* part = (float*)smem;
    for (int blk = blockIdx.x; blk < T_ / 32; blk += gridDim.x) {
        const int t0 = blk * 32 + grp * 16;
        f32x4 acc[4];
#pragma unroll
        for (int c = 0; c < 4; ++c) acc[c] = (f32x4){0.f, 0.f, 0.f, 0.f};
        const u16* ah = p->xab + (size_t)(t0 + fr) * D_ + kq * 512 + fq * 8;
        const u16* al = p->xlb + (size_t)(t0 + fr) * D_ + kq * 512 + fq * 8;
        const u16* bh = p->whT + (size_t)fr * D_ + kq * 512 + fq * 8;
        const u16* bl = p->wlT + (size_t)fr * D_ + kq * 512 + fq * 8;
#pragma unroll 2
        for (int s = 0; s < 16; ++s) {
            const bf16x8 xh = *(const bf16x8*)(ah + 32 * s), xl = *(const bf16x8*)(al + 32 * s);
#pragma unroll
            for (int c = 0; c < 4; ++c) {
                const bf16x8 wh = *(const bf16x8*)(bh + (size_t)c * 16 * D_ + 32 * s);
                const bf16x8 wl = *(const bf16x8*)(bl + (size_t)c * 16 * D_ + 32 * s);
                acc[c] = __builtin_amdgcn_mfma_f32_16x16x32_bf16(xh, wh, acc[c], 0, 0, 0);
                acc[c] = __builtin_amdgcn_mfma_f32_16x16x32_bf16(xh, wl, acc[c], 0, 0, 0);
                acc[c] = __builtin_amdgcn_mfma_f32_16x16x32_bf16(xl, wh, acc[c], 0, 0, 0);
            }
        }
        float* mine = part + (grp * 4 + kq) * 1024;
#pragma unroll
        for (int c = 0; c < 4; ++c)
#pragma unroll
            for (int j = 0; j < 4; ++j) mine[(4 * fq + j) * 64 + 16 * c + fr] = acc[c][j];
        __syncthreads();
#pragma unroll 1
        for (int tt = 0; tt < 4; ++tt) {
            const int tok = 4 * kq + tt;
            const float* q = part + (grp * 4) * 1024 + tok * 64 + lane;
            const float logit = (q[0] + q[1024]) + (q[2048] + q[3072]);
            route_token(p, t0 + tok, logit, lane, cnt, list);
        }
        __syncthreads();
    }
}

struct ColGateUp { int c0; const float* up;
    __device__ __forceinline__ const float* base(const float* B, int hsel) const { return hsel ? up : B; }
    __device__ __forceinline__ unsigned off4(int hsel, int g4) const { return (unsigned)(c0 + g4 * 4); }
    __device__ __forceinline__ int vcol4(int hsel, int g4) const { const int r = g4 * 4; return (r >> 5) * 64 + hsel * 32 + (r & 31); } };
struct RowList { const int* lst; int m0, n; __device__ __forceinline__ int operator()(int r) const { const int i = m0 + r; return lst[i < n ? i : n - 1] >> 1; } };
struct EpiSwiglu {
    u16* C; int ldc; int row0, c0, nrows;
    __device__ __forceinline__ void operator()(Acc& acc, int wr0, int wc0, int fr, int fq) const {
        const int cb = c0 + (wc0 >> 1);
#pragma unroll
        for (int m = 0; m < 4; ++m)
#pragma unroll
            for (int j = 0; j < 4; ++j) {
                const int r = wr0 + m * 16 + fq * 4 + j;
                if (r < nrows) {
#pragma unroll
                    for (int n = 0; n < 2; ++n)
                        C[(size_t)(row0 + r) * ldc + cb + n * 16 + fr] = f2bf(silu_f(acc[m][n][j]) * acc[m][n + 2][j]);
                }
            }
    }
};
struct EpiDownRouted {
    u16* yr; const int* lst; const float* tg; int m0, n, col0;
    __device__ __forceinline__ void operator()(Acc& acc, int wr0, int wc0, int fr, int fq) const {
#pragma unroll
        for (int m = 0; m < 4; ++m)
#pragma unroll
            for (int j = 0; j < 4; ++j) {
                const int i = m0 + wr0 + m * 16 + fq * 4 + j;
                if (i < n) {
                    const int slot = lst[i];
                    const float gt = tg[slot];
#pragma unroll
                    for (int nn = 0; nn < 4; ++nn)
                        yr[(size_t)slot * D_ + col0 + wc0 + nn * 16 + fr] = f2bf(gt * acc[m][nn][j]);
                }
            }
    }
};

struct RowH { int base, mx; __device__ __forceinline__ int operator()(int r) const { const int i = base + r; return i < mx ? i : mx; } };
__device__ __forceinline__ void moe_prefix(const unsigned* cnt, int* s_tp, int* s_off) {
    __syncthreads();
    if (ltid() == 0) {
        int tp = 0, off = 0;
        for (int e = 0; e < 64; ++e) {
            const int n = (int)__hip_atomic_load(&cnt[e], __ATOMIC_RELAXED, __HIP_MEMORY_SCOPE_AGENT);
            s_tp[e] = tp; s_off[e] = off;
            tp += (n + 255) >> 8; off += n;
        }
        s_tp[64] = tp; s_off[64] = off;
    }
    __syncthreads();
}

struct RowGen { const int* lst; int m0, n, base; __device__ __forceinline__ int operator()(int r) const {
    if (lst) { const int i = m0 + r; return lst[i < n ? i : n - 1] >> 1; }
    return base + r; } };

template <int L>
__device__ __forceinline__ void ph_moe_up(KP p, const u16* X, unsigned char* smem, int* s_tp, int* s_off) {
    u16* lds = (u16*)smem;
    const unsigned* cnt = p->ctl + (L == 0 ? CTL_CNT0 : CTL_CNT1);
    moe_prefix(cnt, s_tp, s_off);
    const int nrt = s_tp[64] * 8;
    const int nsh = 32 * 16;
            for (int t = blockIdx.x; t < nrt + nsh; t += gridDim.x) {
        Acc acc; acc_zero(acc);
        RowGen rg; const float* W; int ldb; ColGateUp cg; EpiSwiglu ep;
        if (t < nrt) {
            const int mtile = t >> 3, nt = t & 7;
            int e = 0;
            for (int s = 32; s > 0; s >>= 1) if (e + s < 64 && s_tp[e + s] <= mtile) e += s;
            const int n = s_off[e + 1] - s_off[e], m0 = (mtile - s_tp[e]) * 256;
            W = p->moe_wg[L] + (size_t)e * D_ * 512; ldb = 512;
            rg = RowGen{p->list + e * T_, m0, n, 0};
            cg = ColGateUp{nt * 64, p->moe_wu[L] + (size_t)e * D_ * 512};
            ep = EpiSwiglu{p->hbuf, 512, s_off[e] + m0, nt * 64, n - m0};
        } else {
            const int u = t - nrt, mt = u >> 4, nt = u & 15;
            W = p->sh_g[L]; ldb = 1024;
            rg = RowGen{nullptr, 0, 0, mt * 256};
            cg = ColGateUp{nt * 64, p->sh_u[L]};
            ep = EpiSwiglu{p->hsh, 1024, mt * 256, nt * 64, 256};
        }
        gemm_accum<B_F32_KN, false>(acc, X, D_, rg, W, ldb, cg, D_, lds);
        ep(acc, (ltid() >> 7) * 64, ((ltid() >> 6) & 1) * 64, ltid() & 15, (ltid() & 63) >> 4);
    }
}

template <int L>
__device__ __forceinline__ void ph_moe_down(KP p, const float* XF, unsigned char* smem, int* s_tp, int* s_off) {
    u16* lds = (u16*)smem;
    const unsigned* cnt = p->ctl + (L == 0 ? CTL_CNT0 : CTL_CNT1);
    moe_prefix(cnt, s_tp, s_off);
    const int nrt = s_tp[64] * 16, nsh = 32 * 16;
    for (int t = blockIdx.x; t < nrt + nsh; t += gridDim.x) {
        Acc acc; acc_zero(acc);
        const int wr0 = (ltid() >> 7) * 64, wc0 = ((ltid() >> 6) & 1) * 64, fr = ltid() & 15, fq = (ltid() & 63) >> 4;
        const bool routed = t < nrt;
        const u16* A; int lda, K; RowH rh; const float* W; int nt;
        int e = 0, n = 0, m0 = 0, mt = 0;
        if (routed) {
            const int mtile = t >> 4; nt = t & 15;
            for (int s = 32; s > 0; s >>= 1) if (e + s < 64 && s_tp[e + s] <= mtile) e += s;
            n = s_off[e + 1] - s_off[e]; m0 = (mtile - s_tp[e]) * 256;
            A = p->hbuf; lda = 512; K = 512; rh = RowH{s_off[e] + m0, 2 * T_ - 1};
            W = p->moe_wd[L] + (size_t)e * 512 * D_;
        } else {
            const int u = t - nrt; mt = u >> 4; nt = u & 15;
            A = p->hsh; lda = 1024; K = 1024; rh = RowH{mt * 256, T_ - 1};
            W = p->sh_d[L];
        }
        gemm_accum<B_F32_KN, false>(acc, A, lda, rh, W, D_, ColOff{nt * 128}, K, lds);
        if (routed) EpiDownRouted{p->yr, p->list + e * T_, p->tok_g, m0, n, nt * 128}(acc, wr0, wc0, fr, fq);
        else EpiResid{p->y2, XF, D_, mt * 256, nt * 128}(acc, wr0, wc0, fr, fq);
    }
}
struct ColRot { int cbase; bool rot;
    __device__ __forceinline__ const float* base(const float* B, int) const { return B; }
    __device__ __forceinline__ unsigned off4(int hsel, int g4) const { const int v = hsel * 64 + g4 * 4; const int s = v >> 6, u = v & 63;
        return rot ? (unsigned)(cbase + s * 32 + (u < 32 ? u : 128 + (u - 32))) : (unsigned)(cbase + v); }
    __device__ __forceinline__ int vcol4(int hsel, int g4) const { return hsel * 64 + g4 * 4; } };

__device__ __forceinline__ float ret_log2g(int h) { return log1pf(-exp2f(-5.f - (float)h)) * LOG2E_; }

struct EpiRetQK {
    KP p; int row0; int hd; int tp; bool isk;
    __device__ __forceinline__ void operator()(Acc& acc, int wr0, int wc0, int fr, int fq) const {
        const float l2g = ret_log2g(hd);
        const int dbase = tp * 64 + (wc0 >> 1);
#pragma unroll
        for (int m = 0; m < 4; ++m) {
            const int r0 = row0 + wr0 + m * 16 + fq * 4;
#pragma unroll
            for (int n = 0; n < 2; ++n) {
                const int i = dbase + n * 16 + fr;
                float lo[4], hi[4];
#pragma unroll
                for (int j = 0; j < 4; ++j) {
                    const int t = r0 + j;
                    const float c = p->cosR[t * 128 + i], s = p->sinR[t * 128 + i];
                    const float x1 = acc[m][n][j], x2 = acc[m][n + 2][j];
                    lo[j] = x1 * c - x2 * s; hi[j] = x1 * s + x2 * c;
                }
                if (!isk) {
#pragma unroll
                    for (int j = 0; j < 4; ++j) {
                        const int t = r0 + j;
                        const float xi = exp2f((float)((t & 127) + 1) * l2g);
                        const size_t o = (size_t)t * 2048 + hd * 256 + i;
                        p->qr[o] = f2bf(lo[j]); p->qr[o + 128] = f2bf(hi[j]);
                        p->qx[o] = f2bf(lo[j] * xi); p->qx[o + 128] = f2bf(hi[j] * xi);
                    }
                } else {
                    float zl[4], zh[4];
#pragma unroll
                    for (int j = 0; j < 4; ++j) {
                        const int t = r0 + j;
                        const float ze = exp2f((float)(127 - (t & 127)) * l2g);
                        lo[j] *= 0.0625f; hi[j] *= 0.0625f;
                        const size_t o = (size_t)t * 2048 + hd * 256 + i;
                        p->kr[o] = f2bf(lo[j]); p->kr[o + 128] = f2bf(hi[j]);
                        zl[j] = lo[j] * ze; zh[j] = hi[j] * ze;
                    }
                    u32x2 a, b;
                    a.x = pack2(zl[0], zl[1]); a.y = pack2(zl[2], zl[3]);
                    b.x = pack2(zh[0], zh[1]); b.y = pack2(zh[2], zh[3]);
                    *(u32x2*)(p->kzT + (size_t)(hd * 256 + i) * T_ + r0) = a;
                    *(u32x2*)(p->kzT + (size_t)(hd * 256 + i + 128) * T_ + r0) = b;
                }
            }
        }
    }
};
struct EpiRetV {
    u16* vT; int row0, col0;
    __device__ __forceinline__ void operator()(Acc& acc, int wr0, int wc0, int fr, int fq) const {
#pragma unroll
        for (int m = 0; m < 4; ++m) {
            const int r0 = row0 + wr0 + m * 16 + fq * 4;
#pragma unroll
            for (int n = 0; n < 4; ++n) {
                u32x2 o; o.x = pack2(acc[m][n][0], acc[m][n][1]); o.y = pack2(acc[m][n][2], acc[m][n][3]);
                *(u32x2*)(vT + (size_t)(col0 + wc0 + n * 16 + fr) * T_ + r0) = o;
            }
        }
    }
};
struct EpiSilu {
    u16* C; int ldc; int row0, col0;
    __device__ __forceinline__ void operator()(Acc& acc, int wr0, int wc0, int fr, int fq) const {
#pragma unroll
        for (int m = 0; m < 4; ++m)
#pragma unroll
            for (int n = 0; n < 4; ++n)
#pragma unroll
                for (int j = 0; j < 4; ++j)
                    C[(size_t)(row0 + wr0 + m * 16 + fq * 4 + j) * ldc + col0 + wc0 + n * 16 + fr] = f2bf(silu_f(acc[m][n][j]));
    }
};
struct EpiInner {
    u16* C; int hd;
    __device__ __forceinline__ void operator()(Acc& acc, int wr0, int wc0, int fr, int fq) const {
        const float l2g = ret_log2g(hd);
#pragma unroll
        for (int m = 0; m < 4; ++m)
#pragma unroll
            for (int n = 0; n < 4; ++n)
#pragma unroll
                for (int j = 0; j < 4; ++j) {
                    const int i = wr0 + m * 16 + fq * 4 + j, k = wc0 + n * 16 + fr;
                    const float d = i >= k ? exp2f((float)(i - k) * l2g) : 0.f;
                    C[i * 128 + k] = f2bf(acc[m][n][j] * d);
                }
    }
};

#define WR0_ ((ltid() >> 7) * 64)
#define WC0_ (((ltid() >> 6) & 1) * 64)
#define FR_ (ltid() & 15)
#define FQ_ ((ltid() & 63) >> 4)

__device__ __forceinline__ void ph_l1_in(KP p, u16* lds) {
    const int ntm = T_ / BM, ntn = IN_C / BN;
    for (int t = blockIdx.x; t < ntm * ntn; t += gridDim.x) {
        const int nt = t / ntm, mt = t % ntm;
        Acc acc; acc_zero(acc);
        const bool isk = nt >= 16;
        const int u = nt & 15, hd = u >> 1, tp = u & 1;
        const ColRot cr = nt < 32 ? ColRot{(isk ? 2048 : 0) + hd * 256 + tp * 64, true} : ColRot{nt * BN, false};
        gemm_accum<B_F32_KN, false>(acc, p->xcb, D_, RowId{mt * BM}, p->w_in1, IN_C, cr, D_, lds);
        if (nt < 32) EpiRetQK{p, mt * BM, hd, tp, isk}(acc, WR0_, WC0_, FR_, FQ_);
        else if (nt < 64) EpiRetV{p->v1T, mt * BM, (nt - 32) * BN}(acc, WR0_, WC0_, FR_, FQ_);
        else EpiSilu{p->sg, 4096, mt * BM, (nt - 64) * BN}(acc, WR0_, WC0_, FR_, FQ_);
    }
}

__device__ __forceinline__ void ph_ret_a(KP p, u16* lds) {
    const int nkv = 8 * 64 * 4, nin = 8 * 64;
    for (int t = blockIdx.x; t < nkv + nin; t += gridDim.x) {
        Acc acc; acc_zero(acc);
        if (t < nkv) {
            const int hc = t >> 2, sub = t & 3, hd = hc >> 6, c = hc & 63, mt = sub >> 1, nt = sub & 1;
            gemm_accum<B_BF16_NK, false>(acc, p->v1T + c * 128, T_, RowId{hd * 512 + mt * 256}, p->kzT + c * 128, T_, RowId{hd * 256 + nt * 128}, 128, lds);
            EpiBF16{p->KVt + (size_t)hc * 512 * 256, 256, mt * 256, nt * 128}(acc, WR0_, WC0_, FR_, FQ_);
        } else {
            const int hc = t - nkv, hd = hc >> 6, c = hc & 63;
            gemm_accum<B_BF16_NK, true>(acc, p->qr + hd * 256, 2048, RowId{c * 128}, p->kr + hd * 256, 2048, RowId{c * 128}, 256, lds);
            if (ksplit_reduce(acc, lds)) EpiInner{p->innerG + (size_t)hc * 128 * 128, hd}(acc, WR0_, WC0_, FR_, FQ_);
        }
    }
}
__device__ __forceinline__ void ph_ret_b(KP p) {
    const int gtid = blockIdx.x * NT + ltid(), gsz = gridDim.x * NT;
    for (int e = gtid; e < 8 * 512 * 256 / 8; e += gsz) {
        const int hd = e / (512 * 256 / 8);
        const int within = e - hd * (512 * 256 / 8);
        const float g128 = exp2f(128.f * ret_log2g(hd));
        u16* base = p->KVt + (size_t)hd * 64 * 512 * 256 + (size_t)within * 8;
        float r[8];
#pragma unroll
        for (int i = 0; i < 8; ++i) r[i] = 0.f;
#pragma unroll 4
        for (int c = 0; c < 64; ++c) {
            u32x4* ptr = (u32x4*)(base + (size_t)c * 512 * 256);
            const u32x4 in = *ptr;
            u32x4 o;
            o.x = pack2(r[0], r[1]); o.y = pack2(r[2], r[3]); o.z = pack2(r[4], r[5]); o.w = pack2(r[6], r[7]);
            *ptr = o;
#pragma unroll
            for (int i = 0; i < 4; ++i) {
                r[2 * i] = r[2 * i] * g128 + __uint_as_float(in[i] << 16);
                r[2 * i + 1] = r[2 * i + 1] * g128 + __uint_as_float(in[i] & 0xffff0000u);
            }
        }
    }
}
__device__ __forceinline__ void ph_ret_c(KP p, u16* lds) {
    for (int t = blockIdx.x; t < 8 * 64 * 4; t += gridDim.x) {
        const int hc = t >> 2, nt = t & 3, hd = hc >> 6, c = hc & 63;
        Acc acc; acc_zero(acc);
        gemm_accum<B_BF16_NK, true>(acc, p->innerG + (size_t)hc * 128 * 128, 128, RowId{0}, p->v1T + c * 128, T_, RowId{hd * 512 + nt * 128}, 128, lds);
        gemm_accum<B_BF16_NK, true>(acc, p->qx + hd * 256, 2048, RowId{c * 128}, p->KVt + (size_t)hc * 512 * 256, 256, RowId{nt * 128}, 256, lds);
        if (ksplit_reduce(acc, lds)) EpiBF16{p->obuf, 4096, c * 128, hd * 512 + nt * 128}(acc, WR0_, WC0_, FR_, FQ_);
    }
}
__device__ __forceinline__ void ph_gn(KP p) {
    const int lane = ltid() & 63;
    const int gw = (blockIdx.x * NT + ltid()) >> 6, nw = (gridDim.x * NT) >> 6;
    for (int r = gw; r < T_ * 8; r += nw) {
        const int hd = r & 7;
        const size_t off = (size_t)(r >> 3) * 4096 + hd * 512 + lane * 8;
        const u32x4 in = *(const u32x4*)(p->obuf + off);
        float v[8];
#pragma unroll
        for (int i = 0; i < 4; ++i) { v[2 * i] = __uint_as_float(in[i] << 16); v[2 * i + 1] = __uint_as_float(in[i] & 0xffff0000u); }
        float s = 0.f;
#pragma unroll
        for (int i = 0; i < 8; ++i) s += v[i];
        const float mu = wave_sum(s) * (1.f / 512.f);
        float var = 0.f;
#pragma unroll
        for (int i = 0; i < 8; ++i) { const float d = v[i] - mu; var += d * d; }
        var = wave_sum(var) * (1.f / 512.f);
        const float rs = rsqrtf(var + 1e-5f);
        const u32x4 gin = *(const u32x4*)(p->sg + off);
        const float* gg = p->gn_g + hd * 512 + lane * 8;
        const float* gb = p->gn_b + hd * 512 + lane * 8;
        float o[8];
#pragma unroll
        for (int i = 0; i < 8; ++i) {
            const float sgv = (i & 1) ? __uint_as_float(gin[i >> 1] & 0xffff0000u) : __uint_as_float(gin[i >> 1] << 16);
            o[i] = ((v[i] - mu) * rs * gg[i] + gb[i]) * sgv;
        }
        u32x4 w; w.x = pack2(o[0], o[1]); w.y = pack2(o[2], o[3]); w.z = pack2(o[4], o[5]); w.w = pack2(o[6], o[7]);
        *(u32x4*)(p->gated + off) = w;
    }
}
#define MAXLDS_(a, b) ((a) > (b) ? (a) : (b))
#define PHASE_LDS MAXLDS_(MAXLDS_(GEMM_LDS_BYTES, 2 * ATT_LDS_BYTES), 8 * 8192)
#define LDS_TOTAL (PHASE_LDS + 16 + 16 + 65 * 4 * 2 + 8)

__global__ void __launch_bounds__(NT, 2) mega(Params kparams) {
    extern __shared__ __attribute__((aligned(16))) unsigned char smem[];
    u16* lds = (u16*)smem;
    uint4* xbw = (uint4*)(smem + PHASE_LDS);
    unsigned* misc = (unsigned*)(smem + PHASE_LDS + 16);
    int* s_tp = (int*)(smem + PHASE_LDS + 32);
    int* s_off = s_tp + 65;
    if (threadIdx.x == 0) *xbw = make_uint4(0u, 0u, 0u, 0u);
    __syncthreads();
    XcdBarrier bar = xcd_barrier_post(getp()->bar, (volatile LAS unsigned*)xbw);

    ph_prep(getp());
    xcd_barrier(bar);
    {
        KP p = getp();
        const int ntn = (IN_AB + BN - 1) / BN, ntm = T_ / BM;
        for (int t = blockIdx.x; t < ntn * ntm; t += gridDim.x) {
            const int nt = t / ntm, mt = t % ntm;
            Acc acc; acc_zero(acc);
            gemm_accum<B_F32_KN, false>(acc, p->xb, D_, RowId{mt * BM}, p->w_in0, IN_AB, ColClampOff{nt * BN, IN_AB}, D_, lds);
            EpiF32{p->H0, IN_AB, mt * BM, nt * BN, IN_AB}(acc, WR0_, WC0_, FR_, FQ_);
        }
    }
    xcd_barrier(bar);
    ph_post0(getp());
    xcd_barrier(bar);
    {
        KP p = getp();
        const int ntm = T_ / BM;
        const int n1 = ntm * 12, n2 = ntm * 16, n3 = 64 * 65 / 4;
        for (int t = blockIdx.x; t < n1 + n2 + n3; t += gridDim.x) {
            if (t < n1 + n2) {
                const bool isq = t < n1;
                const int u = isq ? t : t - n1, nt = u / ntm, mt = u % ntm;
                Acc acc; acc_zero(acc);
                gemm_accum<B_F32_KN, false>(acc, isq ? p->cqn : p->ckvn, isq ? 512 : 256, RowId{mt * BM}, isq ? p->w_uq : p->w_ukv,
                                     isq ? 1536 : 2048, ColOff{nt * BN}, isq ? 512 : 256, lds);
                if (isq) EpiQa{p->qa, p->cosA, p->sinA, mt * BM, nt * BN}(acc, WR0_, WC0_, FR_, FQ_);
                else EpiKva{p->ka, p->vaT, mt * BM, nt * BN}(acc, WR0_, WC0_, FR_, FQ_);
            } else {
                const int u = 2 * (t - n1 - n2) + (int)(threadIdx.x >> 8);
                int qt = (int)((sqrtf(8.f * (float)u + 1.f) - 1.f) * 0.5f);
                while ((qt + 1) * (qt + 2) / 2 <= u) ++qt;
                while (qt * (qt + 1) / 2 > u) --qt;
                const int kt = u - qt * (qt + 1) / 2;
                indexer_tile(p, qt, kt);
            }
        }
    }
    xcd_barrier(bar);
    ph_topk(getp());
    xcd_barrier(bar);
    ph_attn(getp(), smem, misc);
    xcd_barrier(bar);
    {
        KP p = getp();
        const int ntm = T_ / BM;
        for (int t = blockIdx.x; t < ntm * 16; t += gridDim.x) {
            const int nt = t / ntm, mt = t % ntm;
            Acc acc; acc_zero(acc);
            gemm_accum<B_F32_KN, false>(acc, p->outcat, D_, RowId{mt * BM}, p->w_out0, D_, ColOff{nt * BN}, D_, lds);
            EpiResid{p->ybuf, p->x, D_, mt * BM, nt * BN}(acc, WR0_, WC0_, FR_, FQ_);
        }
    }
    xcd_barrier(bar);
    { KP p = getp(); ph_ln<false, true, true>(p, p->ybuf, p->ln_mix_g[0], p->ln_mix_b[0], p->xa, p->xab, p->xlb); }
    xcd_barrier(bar);
    { KP p = getp(); ph_router(p, smem, p->ctl + CTL_CNT0, p->list); }
    xcd_barrier(bar);
    { KP p = getp(); ph_moe_up<0>(p, p->xab, smem, s_tp, s_off); }
    xcd_barrier(bar);
    { KP p = getp(); ph_moe_down<0>(p, p->xa, smem, s_tp, s_off); }
    xcd_barrier(bar);
    { KP p = getp(); ph_ln<true, false, true>(p, p->y2, p->ln_ffn_g[0], p->ln_ffn_b[0], p->xc, p->xcb, nullptr); }
    xcd_barrier(bar);
    ph_l1_in(getp(), lds);
    xcd_barrier(bar);
    ph_ret_a(getp(), lds);
    xcd_barrier(bar);
    ph_ret_b(getp());
    xcd_barrier(bar);
    ph_ret_c(getp(), lds);
    xcd_barrier(bar);
    ph_gn(getp());
    xcd_barrier(bar);
    {
        KP p = getp();
        const int ntm = T_ / BM;
        for (int t = blockIdx.x; t < ntm * 16; t += gridDim.x) {
            const int nt = t / ntm, mt = t % ntm;
            Acc acc; acc_zero(acc);
            gemm_accum<B_F32_KN, false>(acc, p->gated, 4096, RowId{mt * BM}, p->w_out1, D_, ColOff{nt * BN}, 4096, lds);
            EpiResid{p->ybuf, p->xc, D_, mt * BM, nt * BN}(acc, WR0_, WC0_, FR_, FQ_);
        }
    }
    xcd_barrier(bar);
    { KP p = getp(); ph_ln<false, true, true>(p, p->ybuf, p->ln_mix_g[1], p->ln_mix_b[1], p->xa, p->xab, p->xlb); }
    xcd_barrier(bar);
    { KP p = getp(); ph_router(p, smem, p->ctl + CTL_CNT1, p->list); }
    xcd_barrier(bar);
    { KP p = getp(); ph_moe_up<1>(p, p->xab, smem, s_tp, s_off); }
    xcd_barrier(bar);
    { KP p = getp(); ph_moe_down<1>(p, p->xa, smem, s_tp, s_off); }
    xcd_barrier(bar);
    { KP p = getp(); ph_ln<true, false, false>(p, p->y2, p->ln_ffn_g[1], p->ln_ffn_b[1], p->out, nullptr, nullptr); }
    {
        KP p = getp();
        if (xb_ld(&p->bar[XB_TMO])) {
            asm volatile("s_waitcnt vmcnt(0)" ::: "memory");
            for (int i = blockIdx.x * NT + ltid(); i < p->out_size; i += gridDim.x * NT) p->out[i] = __uint_as_float(0x7fc00000u);
        }
    }
}

extern "C" void kernel_launch(void* const* d_in, const int* in_sizes, int n_in,
                              void* d_out, int out_size, void* d_ws, size_t ws_size,
                              hipStream_t stream) {
    const size_t kDynLds = LDS_TOTAL;
    static int grid = 0;
    if (!grid) {
        int dev = 0, cus = 0, per_cu = 0;
        (void)hipGetDevice(&dev);
        (void)hipDeviceGetAttribute(&cus, hipDeviceAttributeMultiprocessorCount, dev);
        (void)hipFuncSetAttribute((const void*)mega, hipFuncAttributeMaxDynamicSharedMemorySize, (int)kDynLds);
        (void)hipOccupancyMaxActiveBlocksPerMultiprocessor(&per_cu, mega, NT, kDynLds);
        grid = cus * (per_cu >= 1 ? 1 : 0);
    }
    unsigned char* ws = (unsigned char*)d_ws;
    size_t off = 0;
    auto take = [&](size_t bytes) { void* q = ws + off; off += (bytes + 255) & ~(size_t)255; return q; };
    Params p{};
    p.bar = (unsigned*)take(XCD_BAR_WORDS * 4);
    p.ctl = (unsigned*)take(CTL_WORDS * 4);
    const size_t ctl_bytes = off;
    (void)hipMemsetAsync(ws, 0, ctl_bytes, stream);
    auto F = [&](int i) { return (const float*)d_in[i]; };
    p.x = F(0); p.pos = (const int*)d_in[1]; p.router_w = F(2); p.router_b = F(3);
    p.w_in0 = F(4); p.q_norm = F(5); p.w_uq = F(6); p.kv_norm = F(7); p.w_ukv = F(8); p.w_out0 = F(9);
    p.w_in1 = F(10); p.gn_g = F(11); p.gn_b = F(12); p.w_out1 = F(13);
    for (int l = 0; l < 2; ++l) {
        const int b = 14 + 10 * l;
        p.ln_mix_g[l] = F(b); p.ln_mix_b[l] = F(b + 1);
        p.moe_wg[l] = F(b + 2); p.moe_wu[l] = F(b + 3); p.moe_wd[l] = F(b + 4);
        p.sh_g[l] = F(b + 5); p.sh_u[l] = F(b + 6); p.sh_d[l] = F(b + 7);
        p.ln_ffn_g[l] = F(b + 8); p.ln_ffn_b[l] = F(b + 9);
    }
    p.out = (float*)d_out;
    const size_t T = T_;
    p.cosA = (float*)take(T * 32 * 4); p.sinA = (float*)take(T * 32 * 4);
    p.cosR = (float*)take(T * 128 * 4); p.sinR = (float*)take(T * 128 * 4);
    p.xb = (u16*)take(T * 2048 * 2); p.H0 = (float*)take(T * IN_AB * 4);
    p.cqn = (u16*)take(T * 512 * 2); p.ckvn = (u16*)take(T * 256 * 2); p.kpe = (u16*)take(T * 64 * 2);
    p.qb = (u16*)take(T * 1024 * 2); p.kb = (u16*)take(T * 256 * 2); p.vb = (u16*)take(T * 256 * 2);
    p.iqb = (u16*)take(T * 1024 * 2); p.ikb = (u16*)take(T * 64 * 2); p.iwf = (float*)take(T * 16 * 4);
    p.qa = (u16*)take(T * 1536 * 2); p.ka = (u16*)take(T * 1024 * 2); p.vaT = (u16*)take(T * 1024 * 2);
    p.scores = (float*)take(T * T * 4); p.sel = (u16*)take(T * 256 * 2); p.outcat = (u16*)take(T * 2048 * 2);
    p.ybuf = (float*)take(T * 2048 * 4); p.xa = (float*)take(T * 2048 * 4); p.xab = (u16*)take(T * 2048 * 2); p.xlb = (u16*)take(T * 2048 * 2); p.whT = (u16*)take(64 * 2048 * 2); p.wlT = (u16*)take(64 * 2048 * 2);
    p.y2 = (float*)take(T * 2048 * 4); p.xc = (float*)take(T * 2048 * 4); p.xcb = (u16*)take(T * 2048 * 2);
    p.tok_e = (int*)take(T * 2 * 4); p.tok_g = (float*)take(T * 2 * 4); p.list = (int*)take(2 * 64 * T * 4);
    p.hbuf = (u16*)take(T * 2 * 512 * 2); p.hsh = (u16*)take(T * 1024 * 2); p.yr = (u16*)take(T * 2 * 2048 * 2);
    p.qr = (u16*)take(T * 2048 * 2); p.qx = (u16*)take(T * 2048 * 2); p.kr = (u16*)take(T * 2048 * 2);
    p.kzT = (u16*)take(T * 2048 * 2); p.v1T = (u16*)take(T * 4096 * 2); p.sg = (u16*)take(T * 4096 * 2);
    p.innerG = (u16*)take((size_t)8 * 64 * 128 * 128 * 2);
    {
        unsigned char* sbase = (unsigned char*)p.scores;
        p.KVt = (u16*)sbase; p.obuf = (u16*)(sbase + ((size_t)128 << 20)); p.gated = (u16*)(sbase + ((size_t)192 << 20));
    }
    p.out_size = out_size; p.pad_ = 0;
    if (off > ws_size) return;
    mega<<<dim3(grid), dim3(NT), kDynLds, stream>>>(p);
}
```

```cpp
#include <hip/hip_runtime.h>
#include <stdint.h>

typedef unsigned short u16;
typedef __attribute__((ext_vector_type(8))) short bf16x8;
typedef __attribute__((ext_vector_type(4))) float f32x4;
typedef __attribute__((ext_vector_type(2))) float f32x2;
typedef __attribute__((ext_vector_type(4))) unsigned u32x4;
typedef __attribute__((ext_vector_type(2))) unsigned u32x2;
typedef __attribute__((ext_vector_type(2))) __bf16 bf16x2_t;
typedef __attribute__((ext_vector_type(4))) short s16x4;

#define XB_TMO      128
#define XB_XCNT(j)  (256  + 64 * (j))
#define XB_XSUB(j)  (1280 + 64 * (j))
#define XB_XGEN(j)  (2304 + 64 * (j))
#define XB_TOP      3328
#define XB_TOPGEN   3392
#define XCD_BAR_WORDS 3456
#define XB_SPIN_CAP (1u << 22)
#define LAS __attribute__((address_space(3)))

__device__ __forceinline__ unsigned xb_ld(unsigned* p)              { return __hip_atomic_load(p, __ATOMIC_RELAXED, __HIP_MEMORY_SCOPE_AGENT); }
__device__ __forceinline__ unsigned xb_add(unsigned* p, unsigned v) { return __hip_atomic_fetch_add(p, v, __ATOMIC_RELAXED, __HIP_MEMORY_SCOPE_AGENT); }
__device__ __forceinline__ unsigned xb_xcc_id() { return (unsigned)__builtin_amdgcn_s_getreg((3 << 11) | 20) & 0xFu; }
#define XB_SPIN(cond, bar) do { unsigned _sp = 0; while (cond) { __builtin_amdgcn_s_sleep(1); \
    if ((++_sp & 255u) == 0u) { if (xb_ld(&(bar)[XB_TMO])) break; if (_sp > XB_SPIN_CAP) { atomicAdd(&(bar)[XB_TMO], 1u); break; } } } } while (0)

struct XcdBarrier { unsigned* bar; unsigned x; volatile LAS unsigned* st; };

__device__ __forceinline__ XcdBarrier xcd_barrier_post(unsigned* bar, volatile LAS unsigned* st) {
    XcdBarrier b; b.bar = bar; b.x = xb_xcc_id(); b.st = st;
    if (threadIdx.x == 0) (void)xb_add(&bar[XB_XCNT(b.x)], 1u);
    return b;
}
__device__ __forceinline__ void xcd_barrier_complete(unsigned* bar, unsigned x, unsigned& nloc, unsigned& nx) {
    const unsigned G = gridDim.x * gridDim.y * gridDim.z;
    unsigned sum, cnt, mine, sp = 0u;
    for (;;) {
        sum = 0u; cnt = 0u; mine = 0u;
#pragma unroll
        for (unsigned j = 0; j < 16; ++j) { const unsigned c = xb_ld(&bar[XB_XCNT(j)]); sum += c; cnt += (c > 0u) ? 1u : 0u; mine = (j == x) ? c : mine; }
        if (sum == G) break;
        __builtin_amdgcn_s_sleep(1);
        if ((++sp & 255u) == 0u) { if (xb_ld(&bar[XB_TMO])) break; if (sp > XB_SPIN_CAP) { atomicAdd(&bar[XB_TMO], 1u); break; } }
    }
    nloc = mine > 0u ? mine : 1u; nx = cnt > 0u ? cnt : 1u;
}
__device__ __forceinline__ void xcd_barrier(const XcdBarrier& b) {
    asm volatile("s_waitcnt vmcnt(0)" ::: "memory");
    __syncthreads();
    if (threadIdx.x == 0) {
        unsigned* bar = b.bar;
        __builtin_amdgcn_s_waitcnt(0);
        unsigned nloc = b.st[0], nx = b.st[1];
        if (nloc == 0u) { xcd_barrier_complete(bar, b.x, nloc, nx); b.st[0] = nloc; b.st[1] = nx; }
        const unsigned old = xb_add(&bar[XB_XSUB(b.x)], 1u);
        const unsigned gen = old / nloc;
        if (old + 1u == (gen + 1u) * nloc) {
            __builtin_amdgcn_fence(__ATOMIC_RELEASE, "agent");
            asm volatile("s_waitcnt vmcnt(0)" ::: "memory");
            const unsigned og = xb_add(&bar[XB_TOP], 1u);
            const unsigned tg = og / nx;
            if (og + 1u == (tg + 1u) * nx) xb_add(&bar[XB_TOPGEN], 1u);
            else XB_SPIN(xb_ld(&bar[XB_TOPGEN]) == tg, bar);
            __builtin_amdgcn_fence(__ATOMIC_ACQUIRE, "agent");
            xb_add(&bar[XB_XGEN(b.x)], 1u);
            asm volatile("s_waitcnt vmcnt(0)" ::: "memory");
        } else {
            XB_SPIN(xb_ld(&bar[XB_XGEN(b.x)]) == gen, bar);
            __builtin_amdgcn_fence(__ATOMIC_ACQUIRE, "agent");
            asm volatile("s_waitcnt vmcnt(0)" ::: "memory");
        }
    }
    __syncthreads();
}

__device__ __forceinline__ int ltid() { int t = threadIdx.x; asm volatile("" : "+v"(t)); return t; }
__device__ __forceinline__ u16 f2bf(float f) {
    unsigned u = __float_as_uint(f);
    u += 0x7fffu + ((u >> 16) & 1u);
    return (u16)(u >> 16);
}
__device__ __forceinline__ float bf2f(u16 h) { return __uint_as_float(((unsigned)h) << 16); }
__device__ __forceinline__ unsigned pack2(float a, float b) {
    f32x2 v = {a, b};
    bf16x2_t r = __builtin_convertvector(v, bf16x2_t);
    return *(unsigned*)&r;
}

__device__ __forceinline__ float wave_sum(float v) {
#pragma unroll
    for (int o = 32; o > 0; o >>= 1) v += __shfl_xor(v, o);
    return v;
}
__device__ __forceinline__ float wave_max(float v) {
#pragma unroll
    for (int o = 32; o > 0; o >>= 1) v = fmaxf(v, __shfl_xor(v, o));
    return v;
}
__device__ __forceinline__ int wave_isum(int v) {
#pragma unroll
    for (int o = 32; o > 0; o >>= 1) v += __shfl_xor(v, o);
    return v;
}
__device__ __forceinline__ float silu_f(float x) { return x / (1.f + __expf(-x)); }

#define T_ 8192
#define D_ 2048
#define IN_AB 3472
#define IN_C 12288
#define NT 512
#define ALPHA_ 1.4142135623730951f
#define LOG2E_ 1.4426950408889634f

#define BM 256
#define BN 128
#define BK 64
#define LROW 80
#define GEMM_BUF (BM * LROW + BN * LROW)
#define GEMM_LDS_BYTES (2 * GEMM_BUF * 2)

#define B_F32_KN 0
#define B_BF16_NK 1
#define B_BF16_KN 2

typedef f32x4 Acc[4][4];

__device__ __forceinline__ __amdgpu_buffer_rsrc_t make_rsrc(const void* p) {
    const unsigned long long a = (unsigned long long)p;
    const unsigned lo = __builtin_amdgcn_readfirstlane((unsigned)a), hi = __builtin_amdgcn_readfirstlane((unsigned)(a >> 32));
    return __builtin_amdgcn_make_buffer_rsrc((void*)(((unsigned long long)hi << 32) | lo), 0, 0x7fffffff, 0x00020000);
}
__device__ __forceinline__ u32x4 bload16(__amdgpu_buffer_rsrc_t r, unsigned voff, unsigned soff) {
    return __builtin_amdgcn_raw_buffer_load_b128(r, (int)voff, (int)soff, 0);
}

__device__ __forceinline__ void acc_zero(Acc& acc) {
#pragma unroll
    for (int m = 0; m < 4; ++m)
#pragma unroll
        for (int n = 0; n < 4; ++n) acc[m][n] = (f32x4){0.f, 0.f, 0.f, 0.f};
}

template <int BMODE, bool KS, class ARow, class BSel>
__device__ __forceinline__ void gemm_accum(Acc& acc, const u16* __restrict__ A, int lda, ARow arow,
                                           const void* __restrict__ Bv, int ldb, BSel bsel,
                                           int K, u16* lds) {
    const int tid = ltid(), lane = tid & 63;
    const int wid = __builtin_amdgcn_readfirstlane(tid >> 6);
    const int wr = KS ? ((wid & 3) >> 1) : (wid >> 1), wc = wid & 1, fr = lane & 15, fq = lane >> 4;
    constexpr int NA = KS ? 2 : 4;
    const int ac = tid & 7, ar0 = tid >> 3;
    unsigned ao[NA];
#pragma unroll
    for (int i = 0; i < NA; ++i) ao[i] = ((unsigned)arow(ar0 + 64 * i) * (unsigned)lda + ac * 8) * 2u;
    const int nk = K / BK;
    const int sa_w = ar0 * LROW + ac * 8;
    constexpr int SB0 = BM * LROW;
    const __amdgpu_buffer_rsrc_t rA = make_rsrc(A);

#define MMA16(AF, BF) do { \
        _Pragma("unroll") for (int m = 0; m < 4; ++m) \
        _Pragma("unroll") for (int n = 0; n < 4; ++n) \
            acc[m][n] = __builtin_amdgcn_mfma_f32_16x16x32_bf16(AF[m], BF[n], acc[m][n], 0, 0, 0); } while (0)
#define MEMFENCE_ asm volatile("" ::: "memory")
#define GEMM_COMPUTE(buf) do { \
        const u16* sA = lds + (buf) * GEMM_BUF; const u16* sB = sA + SB0; \
        _Pragma("unroll") for (int ks = 0; ks < 2; ++ks) { \
            if (KS && ks != (wid >> 2)) continue; \
            bf16x8 af[4], bfr[4]; \
            _Pragma("unroll") for (int m = 0; m < 4; ++m) af[m] = *(const bf16x8*)(sA + (wr * 64 + m * 16 + fr) * LROW + ks * 32 + fq * 8); \
            _Pragma("unroll") for (int n = 0; n < 4; ++n) bfr[n] = *(const bf16x8*)(sB + (wc * 64 + n * 16 + fr) * LROW + ks * 32 + fq * 8); \
            _Pragma("unroll") for (int m = 0; m < 4; ++m) \
            _Pragma("unroll") for (int n = 0; n < 4; ++n) \
                acc[m][n] = __builtin_amdgcn_mfma_f32_16x16x32_bf16(af[m], bfr[n], acc[m][n], 0, 0, 0); \
        } } while (0)

    __syncthreads();

#define FRAG_KN(buf, ks, AF, BF) do { \
        const u16* sA = lds + (buf) * GEMM_BUF; \
        const LAS char* cB = (const LAS char*)(lds + (buf) * GEMM_BUF); \
        _Pragma("unroll") for (int m = 0; m < 4; ++m) AF[m] = *(const bf16x8*)(sA + (wr * 64 + m * 16 + fr) * LROW + (ks) * 32 + fq * 8); \
        _Pragma("unroll") for (int n = 0; n < 4; ++n) { \
            const s16x4 lo_ = __builtin_amdgcn_ds_read_tr16_b64_v4i16((LAS s16x4*)(cB + rdo[0][n] + (ks) * 8192)); \
            const s16x4 hi_ = __builtin_amdgcn_ds_read_tr16_b64_v4i16((LAS s16x4*)(cB + rdo[1][n] + (ks) * 8192)); \
            BF[n] = __builtin_shufflevector(lo_, hi_, 0, 1, 2, 3, 4, 5, 6, 7); } } while (0)
    if constexpr (BMODE == B_BF16_KN) {
        const int ch8 = tid & 7, kr = tid >> 3;
        const __amdgpu_buffer_rsrc_t rB0 = make_rsrc(bsel.base16((const u16*)Bv, 0));
        const __amdgpu_buffer_rsrc_t rB1 = make_rsrc(bsel.base16((const u16*)Bv, 1));
        const unsigned ldb2 = (unsigned)ldb * 2u;
        const unsigned bof0 = (unsigned)kr * ldb2 + bsel.off8(0, ch8) * 2u, bof1 = (unsigned)kr * ldb2 + bsel.off8(1, ch8) * 2u;
        const int xw = ((kr & 3) << 2) | ((kr >> 2) & 3);
        const int sbw0 = SB0 * 2 + kr * 256 + 16 * (bsel.vchunk(0, ch8) ^ xw);
        const int sbw1 = SB0 * 2 + kr * 256 + 16 * (bsel.vchunk(1, ch8) ^ xw);
        int rdo[2][4];
#pragma unroll
        for (int t = 0; t < 2; ++t) {
            const int xr = ((fr >> 2) << 2) | ((2 * fq + t) & 3);
#pragma unroll
            for (int n = 0; n < 4; ++n)
                rdo[t][n] = SB0 * 2 + (8 * fq + 4 * t + (fr >> 2)) * 256 + 16 * ((2 * (wc * 4 + n) + ((fr & 3) >> 1)) ^ xr) + 8 * (fr & 1);
        }
        u32x4 ra0[NA], ra1[NA]; u32x4 rb0[2], rb1[2];
#define GL_KB(k0, RA, RB) do { \
        _Pragma("unroll") for (int i = 0; i < NA; ++i) RA[i] = bload16(rA, ao[i], (unsigned)(k0) * 2u); \
        const unsigned s0_ = (unsigned)(k0) * ldb2; \
        RB[0] = bload16(rB0, bof0, s0_); RB[1] = bload16(rB1, bof1, s0_); } while (0)
#define LW_KB(buf, RA, RB) do { \
        u16* sb_ = lds + (buf) * GEMM_BUF; \
        _Pragma("unroll") for (int i = 0; i < NA; ++i) *(u32x4*)(sb_ + sa_w + 64 * i * LROW) = RA[i]; \
        char* cb_ = (char*)sb_; \
        *(u32x4*)(cb_ + sbw0) = RB[0]; *(u32x4*)(cb_ + sbw1) = RB[1]; } while (0)
        GL_KB(0, ra0, rb0);
        GL_KB(BK, ra1, rb1);
        LW_KB(0, ra0, rb0);
        if (2 < nk) GL_KB(2 * BK, ra0, rb0);
        __syncthreads();
        bf16x8 af0[4], bf0[4], af1[4], bf1[4];
        for (int kt = 0; kt < nk; kt += 2) {
            if (!KS) { FRAG_KN(0, 0, af0, bf0); } else { FRAG_KN(0, (wid >> 2), af0, bf0); }
            MEMFENCE_;
            LW_KB(1, ra1, rb1);
            if (kt + 3 < nk) GL_KB((kt + 3) * BK, ra1, rb1);
            MEMFENCE_;
            if (!KS) FRAG_KN(0, 1, af1, bf1);
            MMA16(af0, bf0);
            if (!KS) MMA16(af1, bf1);
            __syncthreads();
            if (!KS) { FRAG_KN(1, 0, af0, bf0); } else { FRAG_KN(1, (wid >> 2), af0, bf0); }
            MEMFENCE_;
            if (kt + 2 < nk) LW_KB(0, ra0, rb0);
            if (kt + 4 < nk) GL_KB((kt + 4) * BK, ra0, rb0);
            MEMFENCE_;
            if (!KS) FRAG_KN(1, 1, af1, bf1);
            MMA16(af0, bf0);
            if (!KS) MMA16(af1, bf1);
            __syncthreads();
        }
#undef GL_KB
#undef LW_KB
    } else if constexpr (BMODE == B_F32_KN) {
        const int g4 = tid & 15, kr = tid >> 4;
        const __amdgpu_buffer_rsrc_t rB0 = make_rsrc(bsel.base((const float*)Bv, 0));
        const __amdgpu_buffer_rsrc_t rB1 = make_rsrc(bsel.base((const float*)Bv, 1));
        const unsigned ldb4 = (unsigned)ldb * 4u;
        const unsigned bof0 = (unsigned)kr * ldb4 + bsel.off4(0, g4) * 4u, bof1 = (unsigned)kr * ldb4 + bsel.off4(1, g4) * 4u;
        const int xw = ((kr & 3) << 2) | ((kr >> 2) & 3);
        const int v00 = bsel.vcol4(0, g4), v01 = bsel.vcol4(1, g4);
        const int sbw0 = SB0 * 2 + kr * 256 + 16 * ((v00 >> 3) ^ xw) + 8 * ((v00 >> 2) & 1);
        const int sbw1 = SB0 * 2 + kr * 256 + 16 * ((v01 >> 3) ^ xw) + 8 * ((v01 >> 2) & 1);
        int rdo[2][4];
#pragma unroll
        for (int t = 0; t < 2; ++t) {
            const int xr = ((fr >> 2) << 2) | ((2 * fq + t) & 3);
#pragma unroll
            for (int n = 0; n < 4; ++n)
                rdo[t][n] = SB0 * 2 + (8 * fq + 4 * t + (fr >> 2)) * 256 + 16 * ((2 * (wc * 4 + n) + ((fr & 3) >> 1)) ^ xr) + 8 * (fr & 1);
        }
        u32x4 ra0[NA], ra1[NA]; u32x4 rb0[4], rb1[4];
#define PK4_(V) (w_.x = pack2(__uint_as_float(V[0]), __uint_as_float(V[1])), w_.y = pack2(__uint_as_float(V[2]), __uint_as_float(V[3])))
#define GL_F32(k0, RA, RB) do { \
        _Pragma("unroll") for (int i = 0; i < NA; ++i) RA[i] = bload16(rA, ao[i], (unsigned)(k0) * 2u); \
        const unsigned s0_ = (unsigned)(k0) * ldb4, s1_ = s0_ + 32u * ldb4; \
        RB[0] = bload16(rB0, bof0, s0_); RB[1] = bload16(rB1, bof1, s0_); \
        RB[2] = bload16(rB0, bof0, s1_); RB[3] = bload16(rB1, bof1, s1_); } while (0)
#define LW_F32(buf, RA, RB) do { \
        u16* sb_ = lds + (buf) * GEMM_BUF; \
        _Pragma("unroll") for (int i = 0; i < NA; ++i) *(u32x4*)(sb_ + sa_w + 64 * i * LROW) = RA[i]; \
        char* cb_ = (char*)sb_; \
        u32x2 w_; \
        PK4_(RB[0]); *(u32x2*)(cb_ + sbw0) = w_; \
        PK4_(RB[1]); *(u32x2*)(cb_ + sbw1) = w_; \
        PK4_(RB[2]); *(u32x2*)(cb_ + sbw0 + 32 * 256) = w_; \
        PK4_(RB[3]); *(u32x2*)(cb_ + sbw1 + 32 * 256) = w_; } while (0)
        GL_F32(0, ra0, rb0);
        GL_F32(BK, ra1, rb1);
        LW_F32(0, ra0, rb0);
        if (2 < nk) GL_F32(2 * BK, ra0, rb0);
        __syncthreads();
        bf16x8 af0[4], bf0[4], af1[4], bf1[4];
        for (int kt = 0; kt < nk; kt += 2) {
            if (!KS) { FRAG_KN(0, 0, af0, bf0); } else { FRAG_KN(0, (wid >> 2), af0, bf0); }
            MEMFENCE_;
            LW_F32(1, ra1, rb1);
            if (kt + 3 < nk) GL_F32((kt + 3) * BK, ra1, rb1);
            MEMFENCE_;
            if (!KS) FRAG_KN(0, 1, af1, bf1);
            MMA16(af0, bf0);
            if (!KS) MMA16(af1, bf1);
            __syncthreads();
            if (!KS) { FRAG_KN(1, 0, af0, bf0); } else { FRAG_KN(1, (wid >> 2), af0, bf0); }
            MEMFENCE_;
            if (kt + 2 < nk) LW_F32(0, ra0, rb0);
            if (kt + 4 < nk) GL_F32((kt + 4) * BK, ra0, rb0);
            MEMFENCE_;
            if (!KS) FRAG_KN(1, 1, af1, bf1);
            MMA16(af0, bf0);
            if (!KS) MMA16(af1, bf1);
            __syncthreads();
        }
#undef GL_F32
#undef LW_F32
    } else {
        const __amdgpu_buffer_rsrc_t rB = make_rsrc(Bv);
        unsigned bo[2];
#pragma unroll
        for (int i = 0; i < 2; ++i) bo[i] = ((unsigned)bsel(ar0 + 64 * i) * (unsigned)ldb + ac * 8) * 2u;
        u32x4 ra0[NA], ra1[NA], rb0[2], rb1[2];
#define GL_BF(k0, RA, RB) do { \
        _Pragma("unroll") for (int i = 0; i < NA; ++i) RA[i] = bload16(rA, ao[i], (unsigned)(k0) * 2u); \
        _Pragma("unroll") for (int i = 0; i < 2; ++i) RB[i] = bload16(rB, bo[i], (unsigned)(k0) * 2u); } while (0)
#define LW_BF(buf, RA, RB) do { \
        u16* sb_ = lds + (buf) * GEMM_BUF; \
        _Pragma("unroll") for (int i = 0; i < NA; ++i) *(u32x4*)(sb_ + sa_w + 64 * i * LROW) = RA[i]; \
        _Pragma("unroll") for (int i = 0; i < 2; ++i) *(u32x4*)(sb_ + SB0 + sa_w + 64 * i * LROW) = RB[i]; } while (0)
        GL_BF(0, ra0, rb0);
        GL_BF(BK, ra1, rb1);
        LW_BF(0, ra0, rb0);
        if (2 < nk) GL_BF(2 * BK, ra0, rb0);
        __syncthreads();
#define FRAG_NK(buf, ks, AF, BF) do { \
        const u16* sA = lds + (buf) * GEMM_BUF; const u16* sB = sA + SB0; \
        _Pragma("unroll") for (int m = 0; m < 4; ++m) AF[m] = *(const bf16x8*)(sA + (wr * 64 + m * 16 + fr) * LROW + (ks) * 32 + fq * 8); \
        _Pragma("unroll") for (int n = 0; n < 4; ++n) BF[n] = *(const bf16x8*)(sB + (wc * 64 + n * 16 + fr) * LROW + (ks) * 32 + fq * 8); } while (0)
        bf16x8 af0[4], bf0[4], af1[4], bf1[4];
        for (int kt = 0; kt < nk; kt += 2) {
            if (!KS) { FRAG_NK(0, 0, af0, bf0); } else { FRAG_NK(0, (wid >> 2), af0, bf0); }
            MEMFENCE_;
            LW_BF(1, ra1, rb1);
            if (kt + 3 < nk) GL_BF((kt + 3) * BK, ra1, rb1);
            MEMFENCE_;
            if (!KS) FRAG_NK(0, 1, af1, bf1);
            MMA16(af0, bf0);
            if (!KS) MMA16(af1, bf1);
            __syncthreads();
            if (!KS) { FRAG_NK(1, 0, af0, bf0); } else { FRAG_NK(1, (wid >> 2), af0, bf0); }
            MEMFENCE_;
            if (kt + 2 < nk) LW_BF(0, ra0, rb0);
            if (kt + 4 < nk) GL_BF((kt + 4) * BK, ra0, rb0);
            MEMFENCE_;
            if (!KS) FRAG_NK(1, 1, af1, bf1);
            MMA16(af0, bf0);
            if (!KS) MMA16(af1, bf1);
            __syncthreads();
        }
#undef FRAG_NK
#undef GL_BF
#undef LW_BF
    }
#undef GEMM_COMPUTE
#undef FRAG_KN
}
__device__ __forceinline__ bool ksplit_reduce(Acc& acc, u16* lds) {
    const int tid = ltid(), lane = tid & 63;
    const int wid = __builtin_amdgcn_readfirstlane(tid >> 6);
    float* f = (float*)lds + (wid & 3) * 4096 + lane;
    if (wid >= 4) {
#pragma unroll
        for (int m = 0; m < 4; ++m)
#pragma unroll
            for (int n = 0; n < 4; ++n)
#pragma unroll
                for (int j = 0; j < 4; ++j) f[((m * 4 + n) * 4 + j) * 64] = acc[m][n][j];
    }
    __syncthreads();
    if (wid < 4) {
#pragma unroll
        for (int m = 0; m < 4; ++m)
#pragma unroll
            for (int n = 0; n < 4; ++n)
#pragma unroll
                for (int j = 0; j < 4; ++j) acc[m][n][j] += f[((m * 4 + n) * 4 + j) * 64];
    }
    return wid < 4;
}


#define STG_LD 68
#define STG_WAVE_BYTES (32 * STG_LD * 4)
#define WR0_ ((ltid() >> 7) * 64)
#define WC0_ (((ltid() >> 6) & 1) * 64)
template <class F>
__device__ __forceinline__ void stage_rows(Acc& acc, unsigned char* stage_base, F f) {
    const int tid = ltid(), lane = tid & 63, wid = tid >> 6, fr = lane & 15, fq = lane >> 4;
    float* st = (float*)(stage_base + wid * STG_WAVE_BYTES);
#pragma unroll
    for (int h = 0; h < 2; ++h) {
#pragma unroll
        for (int mm = 0; mm < 2; ++mm)
#pragma unroll
            for (int n = 0; n < 4; ++n)
#pragma unroll
                for (int j = 0; j < 4; ++j) st[(mm * 16 + fq * 4 + j) * STG_LD + n * 16 + fr] = acc[2 * h + mm][n][j];
        __builtin_amdgcn_s_waitcnt(0xc07f);
#pragma unroll
        for (int i = 0; i < 8; ++i) {
            const int r = (lane >> 4) + 4 * i, c4 = (lane & 15) * 4;
            const f32x4 v = *(const f32x4*)(st + r * STG_LD + c4);
            f(h * 32 + r, c4, v);
        }
        __builtin_amdgcn_s_waitcnt(0xc07f);
    }
}
template <class F>
__device__ __forceinline__ void stage_pairs(Acc& acc, unsigned char* stage_base, F f) {
    const int tid = ltid(), lane = tid & 63, wid = tid >> 6, fr = lane & 15, fq = lane >> 4;
    float* st = (float*)(stage_base + wid * STG_WAVE_BYTES);
#pragma unroll
    for (int h = 0; h < 2; ++h) {
#pragma unroll
        for (int mm = 0; mm < 2; ++mm)
#pragma unroll
            for (int n = 0; n < 4; ++n)
#pragma unroll
                for (int j = 0; j < 4; ++j) st[(mm * 16 + fq * 4 + j) * STG_LD + n * 16 + fr] = acc[2 * h + mm][n][j];
        __builtin_amdgcn_s_waitcnt(0xc07f);
#pragma unroll
        for (int i = 0; i < 4; ++i) {
            const int r = (lane >> 3) + 8 * i, c4 = (lane & 7) * 4;
            const f32x4 lo = *(const f32x4*)(st + r * STG_LD + c4);
            const f32x4 hi = *(const f32x4*)(st + r * STG_LD + c4 + 32);
            f(h * 32 + r, c4, lo, hi);
        }
        __builtin_amdgcn_s_waitcnt(0xc07f);
    }
}
__device__ __forceinline__ u32x2 pack4(f32x4 v) { u32x2 w; w.x = pack2(v[0], v[1]); w.y = pack2(v[2], v[3]); return w; }

struct Params {
    const float* x; const int* pos; const float* router_w; const float* router_b;
    const float* w_in0; const float* q_norm; const float* w_uq; const float* kv_norm; const float* w_ukv; const float* w_out0;
    const float* w_in1; const float* gn_g; const float* gn_b; const float* w_out1;
    const float* ln_mix_g[2]; const float* ln_mix_b[2];
    const float* moe_wg[2]; const float* moe_wu[2]; const float* moe_wd[2];
    const float* sh_g[2]; const float* sh_u[2]; const float* sh_d[2];
    const float* ln_ffn_g[2]; const float* ln_ffn_b[2];
    float* out;
    u16* w_in0b; u16* w_uqb; u16* w_ukvb; u16* w_out0b; u16* w_in1b; u16* w_out1b; u16* sh_gb[2]; u16* sh_ub[2]; u16* sh_db[2];
    unsigned* bar; unsigned* ctl;
    float* cosA; float* sinA; float* cosR; float* sinR;
    u16* xb; u16* H0;
    u16* cqn; u16* ckvn; u16* kpe; u16* qb; u16* kb; u16* vb; u16* iqb; u16* ikb; float* iwf;
    u16* qa; u16* ka; u16* vaT;
    float* scores; u16* sel; u16* outcat; float* mla_po; float* mla_ml;
    u16* ybuf; u16* xab; u16* xlb; u16* whT; u16* wlT; u16* y2; u16* xcb;
    int* tok_e; float* tok_g; int* list; u16* hbuf; u16* hsh; u16* yr;
    u16* qr; u16* qx; u16* kr; u16* kzT; u16* v1T; u16* sg; u16* KVt; u16* innerG; u16* obuf; u16* gated;
    int out_size; int pad_;
};
typedef const __attribute__((address_space(4))) Params* KP;
__device__ __forceinline__ KP getp() { KP kp = (KP)__builtin_amdgcn_kernarg_segment_ptr(); asm volatile("" : "+s"(kp)); return kp; }
#define CTL_FLAGS 0
#define CTL_QUEUE 16
#define CNT_STRIDE 32
#define CTL_CNT0 64
#define CTL_CNT1 (64 + 64 * CNT_STRIDE)
#define CTL_CNTX (64 + 128 * CNT_STRIDE)
#define CTL_WORDS (64 + 192 * CNT_STRIDE)

struct RowId { int base; __device__ __forceinline__ int operator()(int r) const { return base + r; } };
struct ColOff { int c0;
    __device__ __forceinline__ const u16* base16(const u16* B, int) const { return B; }
    __device__ __forceinline__ unsigned off8(int hsel, int ch8) const { return (unsigned)(c0 + hsel * 64 + ch8 * 8); }
    __device__ __forceinline__ int vchunk(int hsel, int ch8) const { return hsel * 8 + ch8; }
    __device__ __forceinline__ const float* base(const float* B, int) const { return B; }
    __device__ __forceinline__ unsigned off4(int hsel, int g4) const { return (unsigned)(c0 + hsel * 64 + g4 * 4); }
    __device__ __forceinline__ int vcol4(int hsel, int g4) const { return hsel * 64 + g4 * 4; } };
struct ColClampOff { int c0, n;
    __device__ __forceinline__ const u16* base16(const u16* B, int) const { return B; }
    __device__ __forceinline__ unsigned off8(int hsel, int ch8) const { const int c = c0 + hsel * 64 + ch8 * 8; return (unsigned)(c < n - 8 ? c : n - 8); }
    __device__ __forceinline__ int vchunk(int hsel, int ch8) const { return hsel * 8 + ch8; }
    __device__ __forceinline__ const float* base(const float* B, int) const { return B; }
    __device__ __forceinline__ unsigned off4(int hsel, int g4) const { const int c = c0 + hsel * 64 + g4 * 4; return (unsigned)(c < n - 4 ? c : n - 4); }
    __device__ __forceinline__ int vcol4(int hsel, int g4) const { return hsel * 64 + g4 * 4; } };

__device__ __forceinline__ void ph_prep(KP p) {
    const int gtid = blockIdx.x * NT + ltid(), gsz = gridDim.x * NT;
    for (size_t i = gtid; i < (size_t)T_ * D_ / 4; i += gsz) {
        float4 v = ((const float4*)p->x)[i];
        u32x2 o; o.x = pack2(v.x, v.y); o.y = pack2(v.z, v.w);
        ((u32x2*)p->xb)[i] = o;
    }
    for (int idx = gtid; idx < D_ * 64; idx += gsz) {
        const int k = idx >> 6, e = idx & 63;
        const float w = p->router_w[idx];
        const u16 hi = f2bf(w);
        p->whT[(size_t)e * D_ + k] = hi;
        p->wlT[(size_t)e * D_ + k] = f2bf(w - bf2f(hi));
    }
    {
        auto cvt = [&](const float* src, u16* dst, size_t n) {
            for (size_t i = gtid; i < n / 8; i += gsz) {
                const f32x4 a = ((const f32x4*)src)[2 * i], b = ((const f32x4*)src)[2 * i + 1];
                u32x4 o; o.x = pack2(a[0], a[1]); o.y = pack2(a[2], a[3]); o.z = pack2(b[0], b[1]); o.w = pack2(b[2], b[3]);
                ((u32x4*)dst)[i] = o;
            }
        };
        cvt(p->w_in0, p->w_in0b, (size_t)D_ * IN_AB);
        cvt(p->w_uq, p->w_uqb, (size_t)512 * 1536);
        cvt(p->w_ukv, p->w_ukvb, (size_t)256 * 2048);
        cvt(p->w_out0, p->w_out0b, (size_t)D_ * D_);
        cvt(p->w_in1, p->w_in1b, (size_t)D_ * IN_C);
        cvt(p->w_out1, p->w_out1b, (size_t)4096 * D_);
        for (int l = 0; l < 2; ++l) {
            cvt(p->sh_g[l], p->sh_gb[l], (size_t)D_ * 1024);
            cvt(p->sh_u[l], p->sh_ub[l], (size_t)D_ * 1024);
            cvt(p->sh_d[l], p->sh_db[l], (size_t)1024 * D_);
        }
    }
    const double inv2pi = 0.15915494309189535;
    for (int idx = gtid; idx < T_ * 32; idx += gsz) {
        const int t = idx >> 5, i = idx & 31;
        const float inv = (float)exp2(-(double)i * (18.931568569324174 / 32.0));
        double rev = (double)p->pos[t] * (double)inv * inv2pi;
        rev -= floor(rev);
        p->cosA[idx] = __builtin_amdgcn_cosf((float)rev);
        p->sinA[idx] = __builtin_amdgcn_sinf((float)rev);
    }
    for (int idx = gtid; idx < T_ * 128; idx += gsz) {
        const int t = idx >> 7, i = idx & 127;
        const float inv = (float)exp2(-(double)i * (13.287712379549449 / 128.0));
        double rev = (double)p->pos[t] * (double)inv * inv2pi;
        rev -= floor(rev);
        p->cosR[idx] = __builtin_amdgcn_cosf((float)rev);
        p->sinR[idx] = __builtin_amdgcn_sinf((float)rev);
    }
}

struct EpiF32 {
    float* C; int ldc; int row0, col0, ncols;
    __device__ __forceinline__ void operator()(Acc& acc, unsigned char* stg) const {
        const int rb = row0 + WR0_, cb = col0 + WC0_;
        float* Cp = C; const int ld = ldc, nc = ncols;
        stage_rows(acc, stg, [=](int r, int c4, f32x4 v) {
            const int c = cb + c4;
            if (c < nc) *(f32x4*)(Cp + (size_t)(rb + r) * ld + c) = v;
        });
    }
};
struct EpiBF16N {
    u16* C; int ldc; int row0, col0, ncols;
    __device__ __forceinline__ void operator()(Acc& acc, unsigned char* stg) const {
        const int rb = row0 + WR0_, cb = col0 + WC0_;
        u16* Cp = C; const int ld = ldc, nc = ncols;
        stage_rows(acc, stg, [=](int r, int c4, f32x4 v) {
            const int c = cb + c4;
            if (c < nc) *(u32x2*)(Cp + (size_t)(rb + r) * ld + c) = pack4(v);
        });
    }
};
struct EpiBF16 {
    u16* C; int ldc; int row0, col0;
    __device__ __forceinline__ void operator()(Acc& acc, unsigned char* stg) const {
        const int rb = row0 + WR0_, cb = col0 + WC0_;
        u16* Cp = C; const int ld = ldc;
        stage_rows(acc, stg, [=](int r, int c4, f32x4 v) { *(u32x2*)(Cp + (size_t)(rb + r) * ld + cb + c4) = pack4(v); });
    }
};
template <bool XB>
struct EpiResid {
    u16* C; const void* X; int ldc; int row0, col0;
    __device__ __forceinline__ void operator()(Acc& acc, unsigned char* stg) const {
        const int rb = row0 + WR0_, cb = col0 + WC0_;
        u16* Cp = C; const void* Xp = X; const int ld = ldc;
        stage_rows(acc, stg, [=](int r, int c4, f32x4 v) {
            const size_t o = (size_t)(rb + r) * ld + cb + c4;
            f32x4 x;
            if constexpr (XB) {
                const u32x2 xr = *(const u32x2*)((const u16*)Xp + o);
                x[0] = __uint_as_float(xr.x << 16); x[1] = __uint_as_float(xr.x & 0xffff0000u);
                x[2] = __uint_as_float(xr.y << 16); x[3] = __uint_as_float(xr.y & 0xffff0000u);
            } else x = *(const f32x4*)((const float*)Xp + o);
            *(u32x2*)(Cp + o) = pack4(x * ALPHA_ + v);
        });
    }
};

__device__ __forceinline__ void ph_post0(KP p) {
    const int lane = ltid() & 63;
    const int gw = (blockIdx.x * NT + ltid()) >> 6, nw = (gridDim.x * NT) >> 6;
    const float qscale = 0.08838834764831845f * LOG2E_;
    for (int t = gw; t < T_; t += nw) {
        const u16* hb = p->H0 + (size_t)t * IN_AB;
#define h_(i) bf2f(hb[i])
        const float* ca = p->cosA + t * 32;
        const float* sa = p->sinA + t * 32;
        {
            float v[8]; float ss = 0.f;
#pragma unroll
            for (int j = 0; j < 8; ++j) { v[j] = h_(lane + 64 * j); ss += v[j] * v[j]; }
            ss = wave_sum(ss);
            const float r = rsqrtf(ss * (1.f / 512.f) + 1e-6f);
#pragma unroll
            for (int j = 0; j < 8; ++j) p->cqn[(size_t)t * 512 + lane + 64 * j] = f2bf(v[j] * r * p->q_norm[lane + 64 * j]);
        }
        {
            float v[4]; float ss = 0.f;
#pragma unroll
            for (int j = 0; j < 4; ++j) { v[j] = h_(512 + lane + 64 * j); ss += v[j] * v[j]; }
            ss = wave_sum(ss);
            const float r = rsqrtf(ss * (1.f / 256.f) + 1e-6f);
#pragma unroll
            for (int j = 0; j < 4; ++j) p->ckvn[(size_t)t * 256 + lane + 64 * j] = f2bf(v[j] * r * p->kv_norm[lane + 64 * j]);
        }
        {
            const int i = lane & 31;
            const float c = ca[i], s = sa[i];
            const float x1 = h_(768 + i), x2 = h_(768 + 32 + i);
            p->kpe[(size_t)t * 64 + lane] = f2bf(lane < 32 ? x1 * c - x2 * s : x1 * s + x2 * c);
        }
#pragma unroll 4
        for (int j = 0; j < 16; ++j) {
            const int e = lane + 64 * j, hd = e >> 7, d = e & 127;
            float o;
            if (d < 32) {
                const int i = d & 15;
                const float c = ca[2 * i], s = sa[2 * i];
                const float x1 = h_(832 + hd * 128 + i), x2 = h_(832 + hd * 128 + 16 + i);
                o = d < 16 ? x1 * c - x2 * s : x1 * s + x2 * c;
            } else o = h_(832 + e);
            p->qb[(size_t)t * 1024 + e] = f2bf(o * qscale);
        }
#pragma unroll
        for (int j = 0; j < 4; ++j) {
            const int e = lane + 64 * j, hd = e >> 7, d = e & 127;
            float o;
            if (d < 32) {
                const int i = d & 15;
                const float c = ca[2 * i], s = sa[2 * i];
                const float x1 = h_(1856 + hd * 128 + i), x2 = h_(1856 + hd * 128 + 16 + i);
                o = d < 16 ? x1 * c - x2 * s : x1 * s + x2 * c;
            } else o = h_(1856 + e);
            p->kb[(size_t)t * 256 + e] = f2bf(o);
            p->vb[(size_t)t * 256 + e] = f2bf(h_(2112 + e));
        }
#pragma unroll 4
        for (int j = 0; j < 16; ++j) {
            const int e = lane + 64 * j, hd = e >> 6, d = e & 63;
            float o;
            if (d < 16) {
                const int i = d & 7;
                const float c = ca[4 * i], s = sa[4 * i];
                const float x1 = h_(2368 + hd * 64 + i), x2 = h_(2368 + hd * 64 + 8 + i);
                o = d < 8 ? x1 * c - x2 * s : x1 * s + x2 * c;
            } else o = h_(2368 + e);
            p->iqb[(size_t)t * 1024 + e] = f2bf(o);
        }
        {
            const int d = lane;
            float o;
            if (d < 16) {
                const int i = d & 7;
                const float c = ca[4 * i], s = sa[4 * i];
                const float x1 = h_(3392 + i), x2 = h_(3392 + 8 + i);
                o = d < 8 ? x1 * c - x2 * s : x1 * s + x2 * c;
            } else o = h_(3392 + d);
            p->ikb[(size_t)t * 64 + d] = f2bf(o);
        }
        if (lane < 16) p->iwf[t * 16 + lane] = h_(3456 + lane) * 0.03125f;
    }
#undef h_
}

struct EpiQa {
    u16* C; const float* ca; const float* sa; int row0, col0;
    __device__ __forceinline__ void operator()(Acc& acc, unsigned char* stg) const {
        const float sc = 0.07216878364870323f * LOG2E_;
        const int rb = row0 + WR0_, cbase = col0 + WC0_;
        const bool rope = (cbase % 192) == 128;
        u16* Cp = C; const float* cap = ca; const float* sap = sa;
        stage_pairs(acc, stg, [=](int r, int c4, f32x4 lo, f32x4 hi) {
            const int t = rb + r;
            if (rope) {
                const f32x4 c = *(const f32x4*)(cap + t * 32 + c4), s = *(const f32x4*)(sap + t * 32 + c4);
                const f32x4 a = lo * c - hi * s, b = lo * s + hi * c;
                lo = a; hi = b;
            }
            *(u32x2*)(Cp + (size_t)t * 1536 + cbase + c4) = pack4(lo * sc);
            *(u32x2*)(Cp + (size_t)t * 1536 + cbase + c4 + 32) = pack4(hi * sc);
        });
    }
};
struct EpiKva {
    u16* ka; u16* vaT; int row0, col0;
    __device__ __forceinline__ void operator()(Acc& acc, unsigned char* stg) const {
        const int cbase = col0 + WC0_;
        const int hd = cbase >> 8, within = cbase & 255;
        if (within < 128) {
            const int rb = row0 + WR0_;
            u16* kp = ka + hd * 128 + within;
            stage_rows(acc, stg, [=](int r, int c4, f32x4 v) { *(u32x2*)(kp + (size_t)(rb + r) * 1024 + c4) = pack4(v); });
        } else {
            const int lane = ltid() & 63, fr = lane & 15, fq = lane >> 4;
#pragma unroll
            for (int m = 0; m < 4; ++m) {
                const int r = row0 + WR0_ + m * 16 + fq * 4;
#pragma unroll
                for (int n = 0; n < 4; ++n) {
                    const int c = within - 128 + n * 16 + fr;
                    u32x2 o; o.x = pack2(acc[m][n][0], acc[m][n][1]); o.y = pack2(acc[m][n][2], acc[m][n][3]);
                    *(u32x2*)(vaT + (size_t)(hd * 128 + c) * T_ + r) = o;
                }
            }
        }
    }
};

__device__ __forceinline__ void indexer_tile(KP p, int qt, int kt) {
    const int lane = ltid() & 63, wid = (ltid() >> 6) & 3;
    const int wr = wid >> 1, wc = wid & 1, fr = lane & 15, fq = lane >> 4;
    const int k0 = kt * 128 + wr * 64, q0 = qt * 128 + wc * 64;
    bf16x8 af[4][2];
#pragma unroll
    for (int m = 0; m < 4; ++m)
#pragma unroll
        for (int ks = 0; ks < 2; ++ks)
            af[m][ks] = *(const bf16x8*)(p->ikb + (size_t)(k0 + m * 16 + fr) * 64 + ks * 32 + fq * 8);
    Acc sc; acc_zero(sc);
    for (int h = 0; h < 16; ++h) {
        bf16x8 bq[4][2]; float w[4];
#pragma unroll
        for (int n = 0; n < 4; ++n) {
            const size_t qrow = (size_t)(q0 + n * 16 + fr);
            bq[n][0] = *(const bf16x8*)(p->iqb + qrow * 1024 + h * 64 + fq * 8);
            bq[n][1] = *(const bf16x8*)(p->iqb + qrow * 1024 + h * 64 + 32 + fq * 8);
            w[n] = p->iwf[qrow * 16 + h];
        }
#pragma unroll
        for (int m = 0; m < 4; ++m)
#pragma unroll
            for (int n = 0; n < 4; ++n) {
                f32x4 d = (f32x4){0.f, 0.f, 0.f, 0.f};
                d = __builtin_amdgcn_mfma_f32_16x16x32_bf16(af[m][0], bq[n][0], d, 0, 0, 0);
                d = __builtin_amdgcn_mfma_f32_16x16x32_bf16(af[m][1], bq[n][1], d, 0, 0, 0);
#pragma unroll
                for (int j = 0; j < 4; ++j) sc[m][n][j] += w[n] * fmaxf(d[j], 0.f);
            }
    }
#pragma unroll
    for (int m = 0; m < 4; ++m)
#pragma unroll
        for (int n = 0; n < 4; ++n)
            *(f32x4*)(p->scores + (size_t)(q0 + n * 16 + fr) * T_ + k0 + m * 16 + fq * 4) = sc[m][n];
}

__device__ __forceinline__ unsigned fkey(float f) {
    const unsigned u = __float_as_uint(f);
    return (u & 0x80000000u) ? ~u : (u | 0x80000000u);
}
#define TOPK_WLDS (1024 * 4 + 1024 * 2)
__device__ __forceinline__ void ph_topk(KP p, unsigned char* smem) {
    const int lane = ltid() & 63, wid = ltid() >> 6;
    const int gw = __builtin_amdgcn_readfirstlane((blockIdx.x * NT + ltid()) >> 6), nw = (gridDim.x * NT) >> 6;
    unsigned* ckey = (unsigned*)(smem + wid * TOPK_WLDS);
    u16* cidx = (u16*)(smem + wid * TOPK_WLDS + 4096);
    for (int qq = gw; qq < T_ / 2; qq += nw)
    for (int sside = 0; sside < 2; ++sside) {
        const int q = sside ? (T_ - 1 - qq) : qq;
        u16* so = p->sel + (size_t)q * 256;
        if (q < 256) {
#pragma unroll
            for (int i = 0; i < 4; ++i) { const int s = lane + 64 * i; so[s] = (u16)(s <= q ? s : 0); }
            continue;
        }
        const int ng = (q >> 10) + 1;
        unsigned key[128];
        const float* row = p->scores + (size_t)q * T_;
#pragma unroll
        for (int g = 0; g < 8; ++g) {
            if (g < ng) {
#pragma unroll
                for (int i = 0; i < 16; ++i) {
                    const int idx = lane + 64 * (g * 16 + i);
                    key[g * 16 + i] = idx <= q ? fkey(row[idx]) : 0u;
                }
            } else {
#pragma unroll
                for (int i = 0; i < 16; ++i) key[g * 16 + i] = 0u;
            }
        }
        unsigned prefix = 0u;
        int C = q + 1, b = 31;
        bool exact = false;
        for (; b >= 0 && C > 1024; --b) {
            const unsigned cand = prefix | (1u << b);
            int cnt = 0;
#pragma unroll
            for (int g = 0; g < 8; ++g) {
                if (g < ng) {
#pragma unroll
                    for (int i = 0; i < 16; ++i) cnt += __builtin_popcountll(__ballot(key[g * 16 + i] >= cand));
                }
            }
            if (cnt >= 256) { prefix = cand; C = cnt; }
            if (cnt == 256) { exact = true; --b; break; }
        }
        if (C > 1024) {
            int wp = 0;
#pragma unroll
            for (int g = 0; g < 8; ++g) {
                if (g < ng) {
#pragma unroll
                    for (int i = 0; i < 16; ++i) {
                        const bool gt = key[g * 16 + i] > prefix;
                        const unsigned long long m = __ballot(gt);
                        if (gt) so[wp + (int)__builtin_amdgcn_mbcnt_hi((unsigned)(m >> 32), __builtin_amdgcn_mbcnt_lo((unsigned)m, 0u))] = (u16)(lane + 64 * (g * 16 + i));
                        wp += __builtin_popcountll(m);
                    }
                }
            }
#pragma unroll
            for (int g = 0; g < 8; ++g) {
                if (g < ng && wp < 256) {
#pragma unroll
                    for (int i = 0; i < 16; ++i) {
                        const bool eq = key[g * 16 + i] == prefix && (lane + 64 * (g * 16 + i)) <= q;
                        const unsigned long long m = __ballot(eq);
                        if (eq) {
                            const int pos = wp + (int)__builtin_amdgcn_mbcnt_hi((unsigned)(m >> 32), __builtin_amdgcn_mbcnt_lo((unsigned)m, 0u));
                            if (pos < 256) so[pos] = (u16)(lane + 64 * (g * 16 + i));
                        }
                        wp += __builtin_popcountll(m);
                    }
                }
            }
            continue;
        }
        int base = 0;
#pragma unroll
        for (int g = 0; g < 8; ++g) {
            if (g < ng) {
#pragma unroll
                for (int i = 0; i < 16; ++i) {
                    const bool ge = key[g * 16 + i] >= prefix && (lane + 64 * (g * 16 + i)) <= q;
                    const unsigned long long m = __ballot(ge);
                    if (ge) {
                        const int pos = base + (int)__builtin_amdgcn_mbcnt_hi((unsigned)(m >> 32), __builtin_amdgcn_mbcnt_lo((unsigned)m, 0u));
                        ckey[pos] = key[g * 16 + i]; cidx[pos] = (u16)(lane + 64 * (g * 16 + i));
                    }
                    base += __builtin_popcountll(m);
                }
            }
        }
        __builtin_amdgcn_s_waitcnt(0xc07f);
        unsigned ck[16];
#pragma unroll
        for (int i = 0; i < 16; ++i) {
            const int s = lane + 64 * i;
            ck[i] = s < base ? ckey[s] : 0u;
        }
        if (!exact) {
            for (; b >= 0; --b) {
                const unsigned cand = prefix | (1u << b);
                int cnt = 0;
#pragma unroll
                for (int i = 0; i < 16; ++i) cnt += __builtin_popcountll(__ballot(ck[i] >= cand));
                if (cnt >= 256) prefix = cand;
                if (cnt == 256) break;
            }
        }
        int wpos = 0;
#pragma unroll
        for (int i = 0; i < 16; ++i) {
            const bool gt = ck[i] > prefix;
            const unsigned long long m = __ballot(gt);
            if (gt) so[wpos + (int)__builtin_amdgcn_mbcnt_hi((unsigned)(m >> 32), __builtin_amdgcn_mbcnt_lo((unsigned)m, 0u))] = cidx[lane + 64 * i];
            wpos += __builtin_popcountll(m);
        }
#pragma unroll
        for (int i = 0; i < 16; ++i) {
            if (wpos < 256) {
                const bool eq = ck[i] == prefix && (lane + 64 * i) < base;
                const unsigned long long m = __ballot(eq);
                if (eq) {
                    const int pos = wpos + (int)__builtin_amdgcn_mbcnt_hi((unsigned)(m >> 32), __builtin_amdgcn_mbcnt_lo((unsigned)m, 0u));
                    if (pos < 256) so[pos] = cidx[lane + 64 * i];
                }
                wpos += __builtin_popcountll(m);
            }
        }
        __builtin_amdgcn_s_waitcnt(0xc07f);
    }
}

#define KROW 208
#define VROW 80
#define ATT_LDS_BYTES (64 * KROW * 2 + 128 * VROW * 2)

__device__ __forceinline__ void mla_item(KP p, int h, int qb, u16* lds, int seg) {
    const int tid = ltid(), lane = tid & 63, wid = tid >> 6, fr = lane & 15, fq = lane >> 4;
    u16* sK = lds;
    u16* sV = lds + 64 * KROW;
    const int q0 = qb * 256;
    bf16x8 qf[2][6];
#pragma unroll
    for (int nq = 0; nq < 2; ++nq)
#pragma unroll
        for (int kc = 0; kc < 6; ++kc)
            qf[nq][kc] = *(const bf16x8*)(p->qa + (size_t)(q0 + wid * 32 + nq * 16 + fr) * 1536 + h * 192 + kc * 32 + fq * 8);
    f32x4 O[8][2];
#pragma unroll
    for (int m = 0; m < 8; ++m) { O[m][0] = (f32x4){0.f, 0.f, 0.f, 0.f}; O[m][1] = (f32x4){0.f, 0.f, 0.f, 0.f}; }
    float mrun[2] = {-1e30f, -1e30f}, lrun[2] = {0.f, 0.f};

    const int k0t = tid >> 4, k1t = tid >> 3;
    const u16* kpn = p->ka + (size_t)k0t * 1024 + h * 128 + (tid & 15) * 8;
    const u16* kpr = p->kpe + (size_t)k1t * 64 + (tid & 7) * 8;
    const u16* vpp = p->vaT + (size_t)(h * 128 + k1t) * T_ + (tid & 7) * 8;
    const int kln = (((k0t >> 2) & 1) * 16 + (k0t >> 3) * 4 + (k0t & 3)) * KROW + (tid & 15) * 8;
    const int e1 = k1t & 31;
    const int klr = ((k1t >> 5) * 32 + ((e1 >> 2) & 1) * 16 + (e1 >> 3) * 4 + (e1 & 3)) * KROW + 128 + (tid & 7) * 8;
    const int vl0 = k1t * VROW + (tid & 7) * 8;
    u32x4 kreg[3], vreg[2];
    const int ntiles = 4 * qb + 4;
    const int kt_lo = seg == 1 ? ntiles / 2 : 0, kt_hi = seg == 0 ? ntiles / 2 : ntiles;
#define ATT_GLOAD(kt) do { \
    _Pragma("unroll") for (int i = 0; i < 2; ++i) kreg[i] = *(const u32x4*)(kpn + (size_t)((kt) * 64 + 32 * i) * 1024); \
    kreg[2] = *(const u32x4*)(kpr + (size_t)((kt) * 64) * 64); \
    _Pragma("unroll") for (int i = 0; i < 2; ++i) vreg[i] = *(const u32x4*)(vpp + (size_t)(64 * i) * T_ + (kt) * 64); } while (0)
    ATT_GLOAD(kt_lo);
    for (int kt = kt_lo; kt < kt_hi; ++kt) {
#pragma unroll
        for (int i = 0; i < 2; ++i) *(u32x4*)(sK + kln + 32 * i * KROW) = kreg[i];
        *(u32x4*)(sK + klr) = kreg[2];
#pragma unroll
        for (int i = 0; i < 2; ++i) *(u32x4*)(sV + vl0 + 64 * i * VROW) = vreg[i];
        __syncthreads();
        if (kt + 1 < kt_hi) ATT_GLOAD(kt + 1);
        if (kt * 64 > q0 + wid * 32 + 31) { __syncthreads(); continue; }
        f32x4 s[2][4];
#pragma unroll
        for (int n = 0; n < 4; ++n) { s[0][n] = (f32x4){0.f, 0.f, 0.f, 0.f}; s[1][n] = (f32x4){0.f, 0.f, 0.f, 0.f}; }
#pragma unroll
        for (int kc = 0; kc < 6; ++kc)
#pragma unroll
            for (int n = 0; n < 4; ++n) {
                const bf16x8 a = *(const bf16x8*)(sK + (n * 16 + fr) * KROW + kc * 32 + fq * 8);
                s[0][n] = __builtin_amdgcn_mfma_f32_16x16x32_bf16(a, qf[0][kc], s[0][n], 0, 0, 0);
                s[1][n] = __builtin_amdgcn_mfma_f32_16x16x32_bf16(a, qf[1][kc], s[1][n], 0, 0, 0);
            }
        if (kt >= ntiles - 4) {
#pragma unroll
            for (int nq = 0; nq < 2; ++nq) {
                const int qi = q0 + wid * 32 + nq * 16 + fr;
#pragma unroll
                for (int n = 0; n < 4; ++n)
#pragma unroll
                    for (int j = 0; j < 4; ++j) {
                        const int ki = kt * 64 + (n >> 1) * 32 + fq * 8 + (n & 1) * 4 + j;
                        if (ki > qi) s[nq][n][j] = -1e30f;
                    }
            }
        }
        bf16x8 pf[2][2];
#pragma unroll
        for (int nq = 0; nq < 2; ++nq) {
            float mx = -1e30f;
#pragma unroll
            for (int n = 0; n < 4; ++n)
#pragma unroll
                for (int j = 0; j < 4; ++j) mx = fmaxf(mx, s[nq][n][j]);
            mx = fmaxf(mx, __shfl_xor(mx, 16));
            mx = fmaxf(mx, __shfl_xor(mx, 32));
            const float mnew = fmaxf(mrun[nq], mx);
            const float al = __builtin_amdgcn_exp2f(mrun[nq] - mnew);
            mrun[nq] = mnew;
            float ps = 0.f;
#pragma unroll
            for (int n = 0; n < 4; ++n)
#pragma unroll
                for (int j = 0; j < 4; ++j) { const float e = __builtin_amdgcn_exp2f(s[nq][n][j] - mnew); s[nq][n][j] = e; ps += e; }
            lrun[nq] = lrun[nq] * al + ps;
            if (__ballot(al != 1.0f) != 0ull) {
#pragma unroll
                for (int m = 0; m < 8; ++m) O[m][nq] *= al;
            }
#pragma unroll
            for (int c = 0; c < 2; ++c) {
                u32x4 w;
                w.x = pack2(s[nq][2 * c][0], s[nq][2 * c][1]);
                w.y = pack2(s[nq][2 * c][2], s[nq][2 * c][3]);
                w.z = pack2(s[nq][2 * c + 1][0], s[nq][2 * c + 1][1]);
                w.w = pack2(s[nq][2 * c + 1][2], s[nq][2 * c + 1][3]);
                pf[nq][c] = *(bf16x8*)&w;
            }
        }
#pragma unroll
        for (int m = 0; m < 8; ++m)
#pragma unroll
            for (int c = 0; c < 2; ++c) {
                const bf16x8 a = *(const bf16x8*)(sV + (m * 16 + fr) * VROW + c * 32 + fq * 8);
                O[m][0] = __builtin_amdgcn_mfma_f32_16x16x32_bf16(a, pf[0][c], O[m][0], 0, 0, 0);
                O[m][1] = __builtin_amdgcn_mfma_f32_16x16x32_bf16(a, pf[1][c], O[m][1], 0, 0, 0);
            }
        __syncthreads();
    }
#undef ATT_GLOAD
#pragma unroll
    for (int nq = 0; nq < 2; ++nq) {
        float l = lrun[nq];
        l += __shfl_xor(l, 16);
        l += __shfl_xor(l, 32);
        const int qi = q0 + wid * 32 + nq * 16 + fr;
        if (seg < 0) {
            const float il = 1.f / l;
#pragma unroll
            for (int m = 0; m < 8; ++m) {
                u32x2 o;
                o.x = pack2(O[m][nq][0] * il, O[m][nq][1] * il);
                o.y = pack2(O[m][nq][2] * il, O[m][nq][3] * il);
                *(u32x2*)(p->outcat + (size_t)qi * 2048 + h * 128 + m * 16 + fq * 4) = o;
            }
        } else {
            const size_t slot = (size_t)((h * 16 + (qb - 16)) * 2 + seg);
            float* po = p->mla_po + (slot * 256 + (qi - q0)) * 128;
#pragma unroll
            for (int m = 0; m < 8; ++m) *(f32x4*)(po + m * 16 + fq * 4) = O[m][nq];
            if (fq == 0) { p->mla_ml[(slot * 256 + (qi - q0)) * 2] = mrun[nq]; p->mla_ml[(slot * 256 + (qi - q0)) * 2 + 1] = l; }
        }
    }
}

__device__ __forceinline__ void ph_mla_merge(KP p) {
    const int gtid = blockIdx.x * NT + ltid(), gsz = gridDim.x * NT;
    for (int i = gtid; i < 128 * 256 * 32; i += gsz) {
        const int d4 = i & 31, qq = (i >> 5) & 255, item = i >> 13;
        const int h = item >> 4, qb = 16 + (item & 15);
        const size_t s0 = (size_t)(item * 2) * 256 + qq, s1 = s0 + 256;
        const float m0 = p->mla_ml[s0 * 2], l0 = p->mla_ml[s0 * 2 + 1], m1 = p->mla_ml[s1 * 2], l1 = p->mla_ml[s1 * 2 + 1];
        const float m = fmaxf(m0, m1);
        const float w0 = __builtin_amdgcn_exp2f(m0 - m), w1 = __builtin_amdgcn_exp2f(m1 - m);
        const float il = 1.f / (l0 * w0 + l1 * w1);
        const f32x4 a = *(const f32x4*)(p->mla_po + s0 * 128 + d4 * 4), b = *(const f32x4*)(p->mla_po + s1 * 128 + d4 * 4);
        const f32x4 o = (a * w0 + b * w1) * il;
        *(u32x2*)(p->outcat + (size_t)(qb * 256 + qq) * 2048 + h * 128 + d4 * 4) = pack4(o);
    }
}

#define DSA_WLDS 5632
__device__ __forceinline__ void dsa_task(KP p, int q, int g, unsigned char* wl) {
    const int lane = ltid() & 63;
    u16* sQ = (u16*)wl;
    float* sP = (float*)(wl + 1024);
    u16* sS = (u16*)(wl + 1024 + 4096);
    const int nsel = q < 255 ? q + 1 : 256;
    {
        const u16* qsrc = p->qb + (size_t)q * 1024 + g * 512;
        *(u32x4*)(sQ + lane * 8) = *(const u32x4*)(qsrc + lane * 8);
        *(u32x2*)(sS + lane * 4) = *(const u32x2*)(p->sel + (size_t)q * 256 + lane * 4);
    }
    __builtin_amdgcn_s_waitcnt(0);
    float sc[4][4];
    float mx[4] = {-1e30f, -1e30f, -1e30f, -1e30f};
#pragma unroll
    for (int r = 0; r < 4; ++r) {
        const int slot = lane + 64 * r;
        float a0 = 0.f, a1 = 0.f, a2 = 0.f, a3 = 0.f;
        if (slot < nsel) {
            const int ki = sS[slot];
            const u16* kr = p->kb + (size_t)ki * 256 + g * 128;
#pragma unroll
            for (int c = 0; c < 16; ++c) {
                const u32x4 kv = *(const u32x4*)(kr + c * 8);
                const u32x4 q0v = *(const u32x4*)(sQ + 0 * 128 + c * 8);
                const u32x4 q1v = *(const u32x4*)(sQ + 1 * 128 + c * 8);
                const u32x4 q2v = *(const u32x4*)(sQ + 2 * 128 + c * 8);
                const u32x4 q3v = *(const u32x4*)(sQ + 3 * 128 + c * 8);
#pragma unroll
                for (int e = 0; e < 4; ++e) {
                    const unsigned kk = kv[e];
                    const bf16x2_t kb2 = *(const bf16x2_t*)&kk;
                    unsigned t0 = q0v[e], t1 = q1v[e], t2 = q2v[e], t3 = q3v[e];
                    a0 = __builtin_amdgcn_fdot2_f32_bf16(kb2, *(const bf16x2_t*)&t0, a0, false);
                    a1 = __builtin_amdgcn_fdot2_f32_bf16(kb2, *(const bf16x2_t*)&t1, a1, false);
                    a2 = __builtin_amdgcn_fdot2_f32_bf16(kb2, *(const bf16x2_t*)&t2, a2, false);
                    a3 = __builtin_amdgcn_fdot2_f32_bf16(kb2, *(const bf16x2_t*)&t3, a3, false);
                }
            }
        } else { a0 = a1 = a2 = a3 = -1e30f; }
        sc[r][0] = a0; sc[r][1] = a1; sc[r][2] = a2; sc[r][3] = a3;
        mx[0] = fmaxf(mx[0], a0); mx[1] = fmaxf(mx[1], a1); mx[2] = fmaxf(mx[2], a2); mx[3] = fmaxf(mx[3], a3);
    }
    float ls[4];
#pragma unroll
    for (int hh = 0; hh < 4; ++hh) {
        const float m = wave_max(mx[hh]);
        float s = 0.f;
#pragma unroll
        for (int r = 0; r < 4; ++r) { const float e = exp2f(sc[r][hh] - m); sc[r][hh] = e; s += e; }
        ls[hh] = wave_sum(s);
    }
#pragma unroll
    for (int r = 0; r < 4; ++r) {
        f32x4 pv = {sc[r][0], sc[r][1], sc[r][2], sc[r][3]};
        *(f32x4*)(sP + (lane + 64 * r) * 4) = pv;
    }
    __builtin_amdgcn_s_waitcnt(0);
    float o[4][8];
#pragma unroll
    for (int hh = 0; hh < 4; ++hh)
#pragma unroll
        for (int d = 0; d < 8; ++d) o[hh][d] = 0.f;
    const int kg = lane >> 4, dc = lane & 15;
    const u16* vbase = p->vb + g * 128 + dc * 8;
    const int nit = (nsel + 3) >> 2;
    for (int it = 0; it < nit; it += 4) {
        u32x4 vv[4]; f32x4 pp[4];
#pragma unroll
        for (int u = 0; u < 4; ++u) {
            if (it + u < nit) {
                const int slot = (it + u) * 4 + kg;
                const int ki = sS[slot];
                vv[u] = *(const u32x4*)(vbase + (size_t)ki * 256);
                pp[u] = *(const f32x4*)(sP + slot * 4);
            } else { vv[u] = (u32x4){0u, 0u, 0u, 0u}; pp[u] = (f32x4){0.f, 0.f, 0.f, 0.f}; }
        }
#pragma unroll
        for (int u = 0; u < 4; ++u)
#pragma unroll
            for (int e = 0; e < 4; ++e) {
                const float v0 = __uint_as_float(vv[u][e] << 16), v1 = __uint_as_float(vv[u][e] & 0xffff0000u);
#pragma unroll
                for (int hh = 0; hh < 4; ++hh) { o[hh][2 * e] += pp[u][hh] * v0; o[hh][2 * e + 1] += pp[u][hh] * v1; }
            }
    }
#pragma unroll
    for (int hh = 0; hh < 4; ++hh)
#pragma unroll
        for (int d = 0; d < 8; ++d) {
            float v = o[hh][d];
            v += __shfl_xor(v, 16);
            v += __shfl_xor(v, 32);
            o[hh][d] = v;
        }
    if (kg == 0) {
#pragma unroll
        for (int hh = 0; hh < 4; ++hh) {
            const float il = 1.f / ls[hh];
            u32x4 w;
            w.x = pack2(o[hh][0] * il, o[hh][1] * il); w.y = pack2(o[hh][2] * il, o[hh][3] * il);
            w.z = pack2(o[hh][4] * il, o[hh][5] * il); w.w = pack2(o[hh][6] * il, o[hh][7] * il);
            *(u32x4*)(p->outcat + (size_t)q * 2048 + 1024 + (g * 4 + hh) * 128 + dc * 8) = w;
        }
    }
    __builtin_amdgcn_s_waitcnt(0);
}

#define DSA2_WLDS (8192 + 512)
__device__ __forceinline__ void dsa_task2(KP p, int q, unsigned char* wl, u16* outp, int ldo, int coff) {
    const int lane = ltid() & 63, fr = lane & 15, fq = lane >> 4;
    unsigned char* sV = wl;
    u16* sS = (u16*)(wl + 8192);
    const int nsel = q < 255 ? q + 1 : 256;
    *(u32x2*)(sS + lane * 4) = *(const u32x2*)(p->sel + (size_t)q * 256 + lane * 4);
    const int vch = lane & 15, vr0 = lane >> 4;
    int rdo[2];
#pragma unroll
    for (int t = 0; t < 2; ++t) rdo[t] = (8 * fq + 4 * t + (fr >> 2)) * 256 + 8 * (fr & 1);
    const int xr0 = ((fr >> 2) << 2) | ((2 * fq) & 3), xr1 = ((fr >> 2) << 2) | ((2 * fq + 1) & 3);
    const int hsel = (fr & 3) >> 1;
    __builtin_amdgcn_s_waitcnt(0);
#pragma unroll 1
    for (int g = 0; g < 2; ++g) {
        bf16x8 qf[4];
#pragma unroll
        for (int c = 0; c < 4; ++c) {
            u32x4 v = (u32x4){0u, 0u, 0u, 0u};
            if (fr < 4) v = *(const u32x4*)(p->qb + (size_t)q * 1024 + (g * 4 + fr) * 128 + c * 32 + fq * 8);
            qf[c] = *(bf16x8*)&v;
        }
        f32x4 O[8];
#pragma unroll
        for (int cc = 0; cc < 8; ++cc) O[cc] = (f32x4){0.f, 0.f, 0.f, 0.f};
        float mrun = -1e30f, lrun = 0.f;
        const int nstep = (nsel + 31) >> 5;
        bf16x8 fa0[4], fb0[4], fa1[4], fb1[4];
        u32x4 vv0[8], vv1[8];
#define DSA_LOAD(c, FA, FB, VV) do { \
            const int ka_ = sS[32 * (c) + fr], kb_ = sS[32 * (c) + 16 + fr]; \
            const u16* kra = p->kb + (size_t)ka_ * 256 + g * 128 + fq * 8; \
            const u16* krb = p->kb + (size_t)kb_ * 256 + g * 128 + fq * 8; \
            _Pragma("unroll") for (int cc = 0; cc < 4; ++cc) { FA[cc] = *(const bf16x8*)(kra + cc * 32); FB[cc] = *(const bf16x8*)(krb + cc * 32); } \
            _Pragma("unroll") for (int i = 0; i < 8; ++i) { \
                const int r = vr0 + 4 * i; \
                const int kv = sS[32 * (c) + 16 * ((r >> 2) & 1) + 4 * (r >> 3) + (r & 3)]; \
                VV[i] = *(const u32x4*)(p->vb + (size_t)kv * 256 + g * 128 + vch * 8); } } while (0)
#define DSA_COMP(c, FA, FB, VV) do { \
            f32x4 s0 = (f32x4){0.f, 0.f, 0.f, 0.f}, s1 = (f32x4){0.f, 0.f, 0.f, 0.f}; \
            _Pragma("unroll") for (int cc = 0; cc < 4; ++cc) { \
                s0 = __builtin_amdgcn_mfma_f32_16x16x32_bf16(FA[cc], qf[cc], s0, 0, 0, 0); \
                s1 = __builtin_amdgcn_mfma_f32_16x16x32_bf16(FB[cc], qf[cc], s1, 0, 0, 0); } \
            float mx = -1e30f; \
            _Pragma("unroll") for (int j = 0; j < 4; ++j) { \
                if (32 * (c) + 4 * fq + j >= nsel) s0[j] = -1e30f; \
                if (32 * (c) + 16 + 4 * fq + j >= nsel) s1[j] = -1e30f; \
                mx = fmaxf(mx, fmaxf(s0[j], s1[j])); } \
            mx = fmaxf(mx, __shfl_xor(mx, 16)); \
            mx = fmaxf(mx, __shfl_xor(mx, 32)); \
            const float mnew = fmaxf(mrun, mx); \
            const float al = __builtin_amdgcn_exp2f(mrun - mnew); \
            mrun = mnew; \
            float ps = 0.f; \
            _Pragma("unroll") for (int j = 0; j < 4; ++j) { \
                s0[j] = __builtin_amdgcn_exp2f(s0[j] - mnew); s1[j] = __builtin_amdgcn_exp2f(s1[j] - mnew); \
                ps += s0[j] + s1[j]; } \
            lrun = lrun * al + ps; \
            if (__ballot(al != 1.0f) != 0ull) { _Pragma("unroll") for (int cc = 0; cc < 8; ++cc) O[cc] *= al; } \
            u32x4 pw; \
            pw.x = pack2(s0[0], s0[1]); pw.y = pack2(s0[2], s0[3]); pw.z = pack2(s1[0], s1[1]); pw.w = pack2(s1[2], s1[3]); \
            const bf16x8 pf = *(bf16x8*)&pw; \
            _Pragma("unroll") for (int i = 0; i < 8; ++i) { \
                const int r = vr0 + 4 * i; \
                *(u32x4*)(sV + r * 256 + 16 * (vch ^ (((r & 3) << 2) | ((r >> 2) & 3)))) = VV[i]; } \
            __builtin_amdgcn_s_waitcnt(0xc07f); \
            _Pragma("unroll") for (int cc = 0; cc < 8; ++cc) { \
                const s16x4 lo_ = __builtin_amdgcn_ds_read_tr16_b64_v4i16((LAS s16x4*)(sV + rdo[0] + 16 * ((2 * cc + hsel) ^ xr0))); \
                const s16x4 hi_ = __builtin_amdgcn_ds_read_tr16_b64_v4i16((LAS s16x4*)(sV + rdo[1] + 16 * ((2 * cc + hsel) ^ xr1))); \
                const bf16x8 vf = __builtin_shufflevector(lo_, hi_, 0, 1, 2, 3, 4, 5, 6, 7); \
                O[cc] = __builtin_amdgcn_mfma_f32_16x16x32_bf16(vf, pf, O[cc], 0, 0, 0); } \
            __builtin_amdgcn_s_waitcnt(0xc07f); } while (0)
        DSA_LOAD(0, fa0, fb0, vv0);
#pragma unroll 1
        for (int c = 0; c < nstep; c += 2) {
            if (c + 1 < nstep) DSA_LOAD(c + 1, fa1, fb1, vv1);
            DSA_COMP(c, fa0, fb0, vv0);
            if (c + 1 < nstep) {
                if (c + 2 < nstep) DSA_LOAD(c + 2, fa0, fb0, vv0);
                DSA_COMP(c + 1, fa1, fb1, vv1);
            }
        }
#undef DSA_LOAD
#undef DSA_COMP
        float l = lrun;
        l += __shfl_xor(l, 16);
        l += __shfl_xor(l, 32);
        if (fr < 4) {
            const float il = 1.f / l;
            u16* dst = outp + (size_t)q * ldo + coff + (g * 4 + fr) * 128 + 4 * fq;
#pragma unroll
            for (int cc = 0; cc < 8; ++cc) {
                u32x2 w; w.x = pack2(O[cc][0] * il, O[cc][1] * il); w.y = pack2(O[cc][2] * il, O[cc][3] * il);
                *(u32x2*)(dst + 16 * cc) = w;
            }
        }
    }
    __builtin_amdgcn_s_waitcnt(0);
}

#define ATT_NMLA 384
__device__ const unsigned char mla_order[48] = {31, 63, 79, 30, 62, 29, 61, 78, 28, 60, 27, 59, 77, 26, 58, 25, 57, 76, 24, 56, 23, 55, 75, 22, 54, 21, 53, 74, 20, 52, 19, 51, 73, 18, 50, 17, 49, 72, 16, 48, 71, 70, 69, 68, 67, 66, 65, 64};
__device__ __forceinline__ void ph_attn(KP p, unsigned char* smem, unsigned* misc, int qword = CTL_QUEUE, int lo = 0, int hi = ATT_NMLA + 512) {
    const int tid = ltid(), wid = tid >> 6;
    for (;;) {
        __syncthreads();
        if (tid == 0) misc[0] = atomicAdd(&p->ctl[qword], 1u);
        __syncthreads();
        const int it = (int)misc[0] + lo;
        if (it >= hi) break;
        if (it < ATT_NMLA) {
            const int e = mla_order[it >> 3];
            const int sg = e >> 5;
            mla_item(p, it & 7, e & 31, (u16*)smem, sg == 2 ? -1 : sg);
        } else {
            const int base = (it - ATT_NMLA) * 16;
#ifdef DSA_VALU
            for (int k = 0; k < 4; ++k) {
                const int task = wid * 4 + k;
                dsa_task(p, base + (task >> 1), task & 1, smem + wid * DSA_WLDS);
            }
#else
            for (int k = 0; k < 2; ++k) dsa_task2(p, base + wid * 2 + k, smem + wid * DSA2_WLDS, p->outcat, 2048, 1024);
#endif
        }
    }
}
template <bool ADD_ROUTED, bool ROUTE, bool WRITE_B, bool WRITE_F>
__device__ __forceinline__ void ph_ln(KP p, const u16* Y, const float* g, const float* b, float* XF, u16* XB, u16* XL) {
    const int lane = ltid() & 63;
    const int gw = (blockIdx.x * NT + ltid()) >> 6, nw = (gridDim.x * NT) >> 6;
    for (int t = gw; t < T_; t += nw) {
        float v[32];
        const u16* y = Y + (size_t)t * D_;
        float sum = 0.f;
#pragma unroll
        for (int j = 0; j < 8; ++j) {
            const u32x2 a = *(const u32x2*)(y + j * 256 + lane * 4);
            v[4 * j] = __uint_as_float(a.x << 16); v[4 * j + 1] = __uint_as_float(a.x & 0xffff0000u);
            v[4 * j + 2] = __uint_as_float(a.y << 16); v[4 * j + 3] = __uint_as_float(a.y & 0xffff0000u);
        }
        if constexpr (ADD_ROUTED) {
            const u16* r0 = p->yr + (size_t)(2 * t) * D_;
            const u16* r1 = r0 + D_;
#pragma unroll
            for (int j = 0; j < 8; ++j) {
                const u32x2 a = *(const u32x2*)(r0 + j * 256 + lane * 4);
                const u32x2 c = *(const u32x2*)(r1 + j * 256 + lane * 4);
                v[4 * j]     += __uint_as_float(a.x << 16) + __uint_as_float(c.x << 16);
                v[4 * j + 1] += __uint_as_float(a.x & 0xffff0000u) + __uint_as_float(c.x & 0xffff0000u);
                v[4 * j + 2] += __uint_as_float(a.y << 16) + __uint_as_float(c.y << 16);
                v[4 * j + 3] += __uint_as_float(a.y & 0xffff0000u) + __uint_as_float(c.y & 0xffff0000u);
            }
        }
#pragma unroll
        for (int i = 0; i < 32; ++i) sum += v[i];
        const float mu = wave_sum(sum) * (1.f / 2048.f);
        float var = 0.f;
#pragma unroll
        for (int i = 0; i < 32; ++i) { const float d = v[i] - mu; var += d * d; }
        var = wave_sum(var) * (1.f / 2048.f);
        const float rs = rsqrtf(var + 1e-5f);
#pragma unroll
        for (int j = 0; j < 8; ++j) {
            const int c = j * 256 + lane * 4;
            const f32x4 gg = *(const f32x4*)(g + c), bb = *(const f32x4*)(b + c);
            f32x4 o;
#pragma unroll
            for (int e = 0; e < 4; ++e) o[e] = (v[4 * j + e] - mu) * rs * gg[e] + bb[e];
            if constexpr (WRITE_F) *(f32x4*)(XF + (size_t)t * D_ + c) = o;
            if constexpr (WRITE_B) {
                u32x2 w; w.x = pack2(o[0], o[1]); w.y = pack2(o[2], o[3]);
                *(u32x2*)(XB + (size_t)t * D_ + c) = w;
                if constexpr (ROUTE) {
                    u32x2 wl;
                    wl.x = pack2(o[0] - __uint_as_float(w.x << 16), o[1] - __uint_as_float(w.x & 0xffff0000u));
                    wl.y = pack2(o[2] - __uint_as_float(w.y << 16), o[3] - __uint_as_float(w.y & 0xffff0000u));
                    *(u32x2*)(XL + (size_t)t * D_ + c) = wl;
                }
            }
        }
    }
}

__device__ __forceinline__ void route_token(KP p, int t, float logit, int lane, unsigned* cnt, int* list) {
    const float sc = 1.f / (1.f + __expf(-logit));
    const float bi = sc + p->router_b[lane];
    float m1 = bi;
    m1 = fmaxf(m1, __shfl_xor(m1, 1)); m1 = fmaxf(m1, __shfl_xor(m1, 2)); m1 = fmaxf(m1, __shfl_xor(m1, 4));
    const int seg = lane >> 3;
    unsigned long long bal = __ballot(bi == m1);
    const int f1 = __builtin_ctz((unsigned)((bal >> (seg * 8)) & 0xffull));
    const float b2 = ((lane & 7) == f1) ? -1e30f : bi;
    float m2 = b2;
    m2 = fmaxf(m2, __shfl_xor(m2, 1)); m2 = fmaxf(m2, __shfl_xor(m2, 2)); m2 = fmaxf(m2, __shfl_xor(m2, 4));
    bal = __ballot(b2 == m2);
    const int f2 = __builtin_ctz((unsigned)((bal >> (seg * 8)) & 0xffull));
    const float gs = m1 + m2;
    float gm = gs;
    gm = fmaxf(gm, __shfl_xor(gm, 8)); gm = fmaxf(gm, __shfl_xor(gm, 16)); gm = fmaxf(gm, __shfl_xor(gm, 32));
    bal = __ballot(gs == gm);
    const int gsel = (int)(__builtin_ctzll(bal) >> 3);
    const int e0 = gsel * 8 + __shfl(f1, gsel * 8);
    const int e1 = gsel * 8 + __shfl(f2, gsel * 8);
    const float s0 = __shfl(sc, e0), s1 = __shfl(sc, e1);
    if (lane == 0) {
        const float inv = 1.f / (s0 + s1);
        const unsigned p0 = atomicAdd(&cnt[e0 * CNT_STRIDE], 1u);
        const unsigned p1 = atomicAdd(&cnt[e1 * CNT_STRIDE], 1u);
        list[e0 * T_ + p0] = 2 * t;
        list[e1 * T_ + p1] = 2 * t + 1;
        p->tok_g[2 * t] = s0 * inv;
        p->tok_g[2 * t + 1] = s1 * inv;
    }
}

__device__ __forceinline__ void ph_router(KP p, unsigned char* smem, unsigned* cnt, int* list) {
    const int tid = ltid(), lane = tid & 63, wid = tid >> 6, grp = wid >> 2, kq = wid & 3, fr = lane & 15, fq = lane >> 4;
    float* part = (float*)smem;
    for (int blk = blockIdx.x; blk < T_ / 32; blk += gridDim.x) {
        const int t0 = blk * 32 + grp * 16;
        f32x4 acc[4];
#pragma unroll
        for (int c = 0; c < 4; ++c) acc[c] = (f32x4){0.f, 0.f, 0.f, 0.f};
        const u16* ah = p->xab + (size_t)(t0 + fr) * D_ + kq * 512 + fq * 8;
        const u16* al = p->xlb + (size_t)(t0 + fr) * D_ + kq * 512 + fq * 8;
        const u16* bh = p->whT + (size_t)fr * D_ + kq * 512 + fq * 8;
        const u16* bl = p->wlT + (size_t)fr * D_ + kq * 512 + fq * 8;
#pragma unroll 2
        for (int s = 0; s < 16; ++s) {
            const bf16x8 xh = *(const bf16x8*)(ah + 32 * s), xl = *(const bf16x8*)(al + 32 * s);
#pragma unroll
            for (int c = 0; c < 4; ++c) {
                const bf16x8 wh = *(const bf16x8*)(bh + (size_t)c * 16 * D_ + 32 * s);
                const bf16x8 wl = *(const bf16x8*)(bl + (size_t)c * 16 * D_ + 32 * s);
                acc[c] = __builtin_amdgcn_mfma_f32_16x16x32_bf16(xh, wh, acc[c], 0, 0, 0);
                acc[c] = __builtin_amdgcn_mfma_f32_16x16x32_bf16(xh, wl, acc[c], 0, 0, 0);
                acc[c] = __builtin_amdgcn_mfma_f32_16x16x32_bf16(xl, wh, acc[c], 0, 0, 0);
            }
        }
        float* mine = part + (grp * 4 + kq) * 1024;
#pragma unroll
        for (int c = 0; c < 4; ++c)
#pragma unroll
            for (int j = 0; j < 4; ++j) mine[(4 * fq + j) * 64 + 16 * c + fr] = acc[c][j];
        __syncthreads();
#pragma unroll 1
        for (int tt = 0; tt < 4; ++tt) {
            const int tok = 4 * kq + tt;
            const float* q = part + (grp * 4) * 1024 + tok * 64 + lane;
            const float logit = (q[0] + q[1024]) + (q[2048] + q[3072]);
            route_token(p, t0 + tok, logit, lane, cnt, list);
        }
        __syncthreads();
    }
}

struct ColGateUp16 { int c0; const u16* up;
    __device__ __forceinline__ const u16* base16(const u16* B, int hsel) const { return hsel ? up : B; }
    __device__ __forceinline__ unsigned off8(int hsel, int ch8) const { return (unsigned)(c0 + ch8 * 8); }
    __device__ __forceinline__ int vchunk(int hsel, int ch8) const { const int r = ch8 * 8; return ((r >> 5) * 64 + hsel * 32 + (r & 31)) >> 3; } };
struct ColGateUp { int c0; const float* up;
    __device__ __forceinline__ const float* base(const float* B, int hsel) const { return hsel ? up : B; }
    __device__ __forceinline__ unsigned off4(int hsel, int g4) const { return (unsigned)(c0 + g4 * 4); }
    __device__ __forceinline__ int vcol4(int hsel, int g4) const { const int r = g4 * 4; return (r >> 5) * 64 + hsel * 32 + (r & 31); } };
struct RowList { const int* lst; int m0, n; __device__ __forceinline__ int operator()(int r) const { const int i = m0 + r; return lst[i < n ? i : n - 1] >> 1; } };
struct EpiSwiglu {
    u16* C; int ldc; int row0, c0, nrows;
    __device__ __forceinline__ void operator()(Acc& acc, unsigned char* stg) const {
        const int wr0 = WR0_, cb = c0 + (WC0_ >> 1);
        u16* Cp = C; const int ld = ldc, rbase = row0, nr = nrows;
        stage_pairs(acc, stg, [=](int r, int c4, f32x4 g, f32x4 u) {
            const int rr = wr0 + r;
            if (rr < nr) {
                f32x4 o;
#pragma unroll
                for (int e = 0; e < 4; ++e) o[e] = silu_f(g[e]) * u[e];
                *(u32x2*)(Cp + (size_t)(rbase + rr) * ld + cb + c4) = pack4(o);
            }
        });
    }
};
struct EpiDownRouted {
    u16* yr; const int* lst; const float* tg; int m0, n, col0;
    __device__ __forceinline__ void operator()(Acc& acc, unsigned char* stg) const {
        const int wr0 = WR0_, cb = col0 + WC0_;
        u16* yp = yr; const int* lp = lst; const float* tgp = tg; const int mm0 = m0, nn = n;
        stage_rows(acc, stg, [=](int r, int c4, f32x4 v) {
            const int i = mm0 + wr0 + r;
            if (i < nn) {
                const int slot = lp[i];
                const float gt = tgp[slot];
                *(u32x2*)(yp + (size_t)slot * D_ + cb + c4) = pack4(v * gt);
            }
        });
    }
};

struct RowH { int base, mx; __device__ __forceinline__ int operator()(int r) const { const int i = base + r; return i < mx ? i : mx; } };
__device__ __forceinline__ void moe_prefix(const unsigned* cnt, int* s_tp, int* s_off) {
    __syncthreads();
    if (ltid() == 0) {
        int tp = 0, off = 0;
        for (int e = 0; e < 64; ++e) {
            const int n = (int)__hip_atomic_load(&cnt[e * CNT_STRIDE], __ATOMIC_RELAXED, __HIP_MEMORY_SCOPE_AGENT);
            s_tp[e] = tp; s_off[e] = off;
            tp += (n + 255) >> 8; off += n;
        }
        s_tp[64] = tp; s_off[64] = off;
    }
    __syncthreads();
}

struct RowGen { const int* lst; int m0, n, base; __device__ __forceinline__ int operator()(int r) const {
    if (lst) { const int i = m0 + r; return lst[i < n ? i : n - 1] >> 1; }
    return base + r; } };

template <int L>
__device__ __forceinline__ void ph_moe_up(KP p, const u16* X, unsigned char* smem, int* s_tp, int* s_off) {
    u16* lds = (u16*)smem;
    const unsigned* cnt = p->ctl + (L == 0 ? CTL_CNT0 : CTL_CNT1);
    moe_prefix(cnt, s_tp, s_off);
    const int nrt = s_tp[64] * 8;
    const int nsh = 32 * 16;
            for (int t = blockIdx.x; t < nrt + nsh; t += gridDim.x) {
        Acc acc; acc_zero(acc);
        if (t < nrt) {
            const int mtile = t >> 3, nt = t & 7;
            int e = 0;
            for (int s = 32; s > 0; s >>= 1) if (e + s < 64 && s_tp[e + s] <= mtile) e += s;
            const int n = s_off[e + 1] - s_off[e], m0 = (mtile - s_tp[e]) * 256;
            gemm_accum<B_F32_KN, false>(acc, X, D_, RowGen{p->list + e * T_, m0, n, 0}, p->moe_wg[L] + (size_t)e * D_ * 512, 512,
                                        ColGateUp{nt * 64, p->moe_wu[L] + (size_t)e * D_ * 512}, D_, lds);
            EpiSwiglu{p->hbuf, 512, s_off[e] + m0, nt * 64, n - m0}(acc, smem);
        } else {
            const int u = t - nrt, mt = u >> 4, nt = u & 15;
            gemm_accum<B_BF16_KN, false>(acc, X, D_, RowId{mt * 256}, p->sh_gb[L], 1024, ColGateUp16{nt * 64, p->sh_ub[L]}, D_, lds);
            EpiSwiglu{p->hsh, 1024, mt * 256, nt * 64, 256}(acc, smem);
        }
    }
}

template <int L>
__device__ __forceinline__ void ph_moe_down(KP p, const u16* XBres, unsigned char* smem, int* s_tp, int* s_off) {
    u16* lds = (u16*)smem;
    const unsigned* cnt = p->ctl + (L == 0 ? CTL_CNT0 : CTL_CNT1);
    moe_prefix(cnt, s_tp, s_off);
    const int nrt = s_tp[64] * 16, nsh = 32 * 16;
    for (int t = blockIdx.x; t < nrt + nsh; t += gridDim.x) {
        Acc acc; acc_zero(acc);
        if (t < nrt) {
            const int mtile = t >> 4, nt = t & 15;
            int e = 0;
            for (int s = 32; s > 0; s >>= 1) if (e + s < 64 && s_tp[e + s] <= mtile) e += s;
            const int n = s_off[e + 1] - s_off[e], m0 = (mtile - s_tp[e]) * 256;
            gemm_accum<B_F32_KN, false>(acc, p->hbuf, 512, RowH{s_off[e] + m0, 2 * T_ - 1}, p->moe_wd[L] + (size_t)e * 512 * D_, D_, ColOff{nt * 128}, 512, lds);
            EpiDownRouted{p->yr, p->list + e * T_, p->tok_g, m0, n, nt * 128}(acc, smem);
        } else {
            const int u = t - nrt, mt = u >> 4, nt = u & 15;
            gemm_accum<B_BF16_KN, false>(acc, p->hsh, 1024, RowId{mt * 256}, p->sh_db[L], D_, ColOff{nt * 128}, 1024, lds);
            EpiResid<true>{p->y2, XBres, D_, mt * 256, nt * 128}(acc, smem);
        }
    }
}
struct ColRot { int cbase; bool rot;
    __device__ __forceinline__ const u16* base16(const u16* B, int) const { return B; }
    __device__ __forceinline__ unsigned off8(int hsel, int ch8) const { const int v = hsel * 64 + ch8 * 8; const int s = v >> 6, u = v & 63;
        return rot ? (unsigned)(cbase + s * 32 + (u < 32 ? u : 128 + (u - 32))) : (unsigned)(cbase + v); }
    __device__ __forceinline__ int vchunk(int hsel, int ch8) const { return hsel * 8 + ch8; }
    __device__ __forceinline__ const float* base(const float* B, int) const { return B; }
    __device__ __forceinline__ unsigned off4(int hsel, int g4) const { const int v = hsel * 64 + g4 * 4; const int s = v >> 6, u = v & 63;
        return rot ? (unsigned)(cbase + s * 32 + (u < 32 ? u : 128 + (u - 32))) : (unsigned)(cbase + v); }
    __device__ __forceinline__ int vcol4(int hsel, int g4) const { return hsel * 64 + g4 * 4; } };

__device__ __forceinline__ float ret_log2g(int h) { return log1pf(-exp2f(-5.f - (float)h)) * LOG2E_; }

struct EpiRetQK {
    KP p; int row0; int hd; int tp; bool isk;
    __device__ __forceinline__ void operator()(Acc& acc, unsigned char* stg) const {
        const float l2g = ret_log2g(hd);
        const int wc0 = WC0_, rb = row0 + WR0_;
        const int dbase = tp * 64 + (wc0 >> 1);
        const float* cR = p->cosR; const float* sR = p->sinR;
        const int hoff = hd * 256 + dbase;
        if (!isk) {
            u16* qr = p->qr; u16* qx = p->qx;
            stage_pairs(acc, stg, [=](int r, int c4, f32x4 x1, f32x4 x2) {
                const int t = rb + r;
                const f32x4 c = *(const f32x4*)(cR + t * 128 + dbase + c4), s = *(const f32x4*)(sR + t * 128 + dbase + c4);
                const f32x4 lo = x1 * c - x2 * s, hi = x1 * s + x2 * c;
                const float xi = exp2f((float)((t & 127) + 1) * l2g);
                const size_t o = (size_t)t * 2048 + hoff + c4;
                *(u32x2*)(qr + o) = pack4(lo); *(u32x2*)(qr + o + 128) = pack4(hi);
                *(u32x2*)(qx + o) = pack4(lo * xi); *(u32x2*)(qx + o + 128) = pack4(hi * xi);
            });
        } else {
            const int lane = ltid() & 63, fr = lane & 15, fq = lane >> 4;
#pragma unroll
            for (int m = 0; m < 4; ++m) {
                const int r0 = rb + m * 16 + fq * 4;
#pragma unroll
                for (int n = 0; n < 2; ++n) {
                    const int i = dbase + n * 16 + fr;
                    float zl[4], zh[4];
#pragma unroll
                    for (int j = 0; j < 4; ++j) {
                        const int t = r0 + j;
                        const float c = cR[t * 128 + i], s = sR[t * 128 + i];
                        const float x1 = acc[m][n][j], x2 = acc[m][n + 2][j];
                        const float ze = exp2f((float)(127 - (t & 127)) * l2g) * 0.0625f;
                        zl[j] = (x1 * c - x2 * s) * ze; zh[j] = (x1 * s + x2 * c) * ze;
                    }
                    u32x2 a, b;
                    a.x = pack2(zl[0], zl[1]); a.y = pack2(zl[2], zl[3]);
                    b.x = pack2(zh[0], zh[1]); b.y = pack2(zh[2], zh[3]);
                    *(u32x2*)(p->kzT + (size_t)(hd * 256 + i) * T_ + r0) = a;
                    *(u32x2*)(p->kzT + (size_t)(hd * 256 + i + 128) * T_ + r0) = b;
                }
            }
            u16* kr = p->kr;
            stage_pairs(acc, stg, [=](int r, int c4, f32x4 x1, f32x4 x2) {
                const int t = rb + r;
                const f32x4 c = *(const f32x4*)(cR + t * 128 + dbase + c4), s = *(const f32x4*)(sR + t * 128 + dbase + c4);
                const f32x4 lo = (x1 * c - x2 * s) * 0.0625f, hi = (x1 * s + x2 * c) * 0.0625f;
                const size_t o = (size_t)t * 2048 + hoff + c4;
                *(u32x2*)(kr + o) = pack4(lo); *(u32x2*)(kr + o + 128) = pack4(hi);
            });
        }
    }
};
struct EpiRetV {
    u16* vT; int row0, col0;
    __device__ __forceinline__ void operator()(Acc& acc, unsigned char* stg) const {
        const int lane = ltid() & 63, fr = lane & 15, fq = lane >> 4, wr0 = WR0_, wc0 = WC0_;
#pragma unroll
        for (int m = 0; m < 4; ++m) {
            const int r0 = row0 + wr0 + m * 16 + fq * 4;
#pragma unroll
            for (int n = 0; n < 4; ++n) {
                u32x2 o; o.x = pack2(acc[m][n][0], acc[m][n][1]); o.y = pack2(acc[m][n][2], acc[m][n][3]);
                *(u32x2*)(vT + (size_t)(col0 + wc0 + n * 16 + fr) * T_ + r0) = o;
            }
        }
    }
};
struct EpiSilu {
    u16* C; int ldc; int row0, col0;
    __device__ __forceinline__ void operator()(Acc& acc, unsigned char* stg) const {
        const int rb = row0 + WR0_, cb = col0 + WC0_;
        u16* Cp = C; const int ld = ldc;
        stage_rows(acc, stg, [=](int r, int c4, f32x4 v) {
            f32x4 o;
#pragma unroll
            for (int e = 0; e < 4; ++e) o[e] = silu_f(v[e]);
            *(u32x2*)(Cp + (size_t)(rb + r) * ld + cb + c4) = pack4(o);
        });
    }
};
struct EpiInner {
    u16* C; int hd;
    __device__ __forceinline__ void operator()(Acc& acc, unsigned char* stg) const {
        const float l2g = ret_log2g(hd);
        const int wr0 = WR0_, wc0 = WC0_;
        u16* Cp = C;
        stage_rows(acc, stg, [=](int r, int c4, f32x4 v) {
            const int i = wr0 + r;
            f32x4 o;
#pragma unroll
            for (int e = 0; e < 4; ++e) { const int k = wc0 + c4 + e; o[e] = i >= k ? v[e] * exp2f((float)(i - k) * l2g) : 0.f; }
            *(u32x2*)(Cp + i * 128 + wc0 + c4) = pack4(o);
        });
    }
};


__device__ __forceinline__ void ph_l1_in(KP p, u16* lds) {
    const int ntm = T_ / BM, ntn = IN_C / BN;
    for (int t = blockIdx.x; t < ntm * ntn; t += gridDim.x) {
        const int nt = t / ntm, mt = t % ntm;
        Acc acc; acc_zero(acc);
        const bool isk = nt >= 16;
        const int u = nt & 15, hd = u >> 1, tp = u & 1;
        const ColRot cr = nt < 32 ? ColRot{(isk ? 2048 : 0) + hd * 256 + tp * 64, true} : ColRot{nt * BN, false};
        gemm_accum<B_BF16_KN, false>(acc, p->xcb, D_, RowId{mt * BM}, p->w_in1b, IN_C, cr, D_, lds);
        if (nt < 32) EpiRetQK{p, mt * BM, hd, tp, isk}(acc, (unsigned char*)lds);
        else if (nt < 64) EpiRetV{p->v1T, mt * BM, (nt - 32) * BN}(acc, (unsigned char*)lds);
        else EpiSilu{p->sg, 4096, mt * BM, (nt - 64) * BN}(acc, (unsigned char*)lds);
    }
}

__device__ __forceinline__ void ph_ret_a(KP p, u16* lds) {
    const int nkv = 8 * 64 * 4, nin = 8 * 64;
    for (int t = blockIdx.x; t < nkv + nin; t += gridDim.x) {
        Acc acc; acc_zero(acc);
        if (t < nkv) {
            const int hc = t >> 2, sub = t & 3, hd = hc >> 6, c = hc & 63, mt = sub >> 1, nt = sub & 1;
            gemm_accum<B_BF16_NK, false>(acc, p->v1T + c * 128, T_, RowId{hd * 512 + mt * 256}, p->kzT + c * 128, T_, RowId{hd * 256 + nt * 128}, 128, lds);
            EpiBF16{p->KVt + (size_t)hc * 512 * 256, 256, mt * 256, nt * 128}(acc, (unsigned char*)lds);
        } else {
            const int hc = t - nkv, hd = hc >> 6, c = hc & 63;
            gemm_accum<B_BF16_NK, true>(acc, p->qr + hd * 256, 2048, RowId{c * 128}, p->kr + hd * 256, 2048, RowId{c * 128}, 256, lds);
            if (ksplit_reduce(acc, lds)) EpiInner{p->innerG + (size_t)hc * 128 * 128, hd}(acc, (unsigned char*)lds + 65536);
        }
    }
}
__device__ __forceinline__ void ph_ret_b(KP p) {
    const int gtid = blockIdx.x * NT + ltid(), gsz = gridDim.x * NT;
    for (int e = gtid; e < 8 * 512 * 256 / 8; e += gsz) {
        const int hd = e / (512 * 256 / 8);
        const int within = e - hd * (512 * 256 / 8);
        const float g128 = exp2f(128.f * ret_log2g(hd));
        u16* base = p->KVt + (size_t)hd * 64 * 512 * 256 + (size_t)within * 8;
        float r[8];
#pragma unroll
        for (int i = 0; i < 8; ++i) r[i] = 0.f;
#pragma unroll 4
        for (int c = 0; c < 64; ++c) {
            u32x4* ptr = (u32x4*)(base + (size_t)c * 512 * 256);
            const u32x4 in = *ptr;
            u32x4 o;
            o.x = pack2(r[0], r[1]); o.y = pack2(r[2], r[3]); o.z = pack2(r[4], r[5]); o.w = pack2(r[6], r[7]);
            *ptr = o;
#pragma unroll
            for (int i = 0; i < 4; ++i) {
                r[2 * i] = r[2 * i] * g128 + __uint_as_float(in[i] << 16);
                r[2 * i + 1] = r[2 * i + 1] * g128 + __uint_as_float(in[i] & 0xffff0000u);
            }
        }
    }
}
__device__ __forceinline__ void ph_ret_c(KP p, u16* lds) {
    for (int t = blockIdx.x; t < 8 * 64 * 4; t += gridDim.x) {
        const int hc = t >> 2, nt = t & 3, hd = hc >> 6, c = hc & 63;
        Acc acc; acc_zero(acc);
        gemm_accum<B_BF16_NK, true>(acc, p->innerG + (size_t)hc * 128 * 128, 128, RowId{0}, p->v1T + c * 128, T_, RowId{hd * 512 + nt * 128}, 128, lds);
        gemm_accum<B_BF16_NK, true>(acc, p->qx + hd * 256, 2048, RowId{c * 128}, p->KVt + (size_t)hc * 512 * 256, 256, RowId{nt * 128}, 256, lds);
        if (ksplit_reduce(acc, lds)) EpiBF16{p->obuf, 4096, c * 128, hd * 512 + nt * 128}(acc, (unsigned char*)lds + 65536);
    }
}
__device__ __forceinline__ void ph_gn(KP p) {
    const int lane = ltid() & 63;
    const int gw = (blockIdx.x * NT + ltid()) >> 6, nw = (gridDim.x * NT) >> 6;
    for (int r = gw; r < T_ * 8; r += nw) {
        const int hd = r & 7;
        const size_t off = (size_t)(r >> 3) * 4096 + hd * 512 + lane * 8;
        const u32x4 in = *(const u32x4*)(p->obuf + off);
        float v[8];
#pragma unroll
        for (int i = 0; i < 4; ++i) { v[2 * i] = __uint_as_float(in[i] << 16); v[2 * i + 1] = __uint_as_float(in[i] & 0xffff0000u); }
        float s = 0.f;
#pragma unroll
        for (int i = 0; i < 8; ++i) s += v[i];
        const float mu = wave_sum(s) * (1.f / 512.f);
        float var = 0.f;
#pragma unroll
        for (int i = 0; i < 8; ++i) { const float d = v[i] - mu; var += d * d; }
        var = wave_sum(var) * (1.f / 512.f);
        const float rs = rsqrtf(var + 1e-5f);
        const u32x4 gin = *(const u32x4*)(p->sg + off);
        const float* gg = p->gn_g + hd * 512 + lane * 8;
        const float* gb = p->gn_b + hd * 512 + lane * 8;
        float o[8];
#pragma unroll
        for (int i = 0; i < 8; ++i) {
            const float sgv = (i & 1) ? __uint_as_float(gin[i >> 1] & 0xffff0000u) : __uint_as_float(gin[i >> 1] << 16);
            o[i] = ((v[i] - mu) * rs * gg[i] + gb[i]) * sgv;
        }
        u32x4 w; w.x = pack2(o[0], o[1]); w.y = pack2(o[2], o[3]); w.z = pack2(o[4], o[5]); w.w = pack2(o[6], o[7]);
        *(u32x4*)(p->gated + off) = w;
    }
}
#define MAXLDS_(a, b) ((a) > (b) ? (a) : (b))
#define PHASE_LDS MAXLDS_(MAXLDS_(GEMM_LDS_BYTES, 2 * ATT_LDS_BYTES), 8 * 8192)
#define LDS_TOTAL (PHASE_LDS + 16 + 16 + 65 * 4 * 2 + 8)

__global__ void __launch_bounds__(NT, 2) mega(Params kparams) {
    extern __shared__ __attribute__((aligned(16))) unsigned char smem[];
    u16* lds = (u16*)smem;
    uint4* xbw = (uint4*)(smem + PHASE_LDS);
    unsigned* misc = (unsigned*)(smem + PHASE_LDS + 16);
    int* s_tp = (int*)(smem + PHASE_LDS + 32);
    int* s_off = s_tp + 65;
    if (threadIdx.x == 0) *xbw = make_uint4(0u, 0u, 0u, 0u);
    __syncthreads();
    XcdBarrier bar = xcd_barrier_post(getp()->bar, (volatile LAS unsigned*)xbw);

    ph_prep(getp());
    xcd_barrier(bar);
    {
        KP p = getp();
        const int ntn = (IN_AB + BN - 1) / BN, ntm = T_ / BM;
        for (int t = blockIdx.x; t < ntn * ntm; t += gridDim.x) {
            const int nt = t / ntm, mt = t % ntm;
            Acc acc; acc_zero(acc);
            gemm_accum<B_BF16_KN, false>(acc, p->xb, D_, RowId{mt * BM}, p->w_in0b, IN_AB, ColClampOff{nt * BN, IN_AB}, D_, lds);
            EpiBF16N{p->H0, IN_AB, mt * BM, nt * BN, IN_AB}(acc, smem);
        }
    }
    xcd_barrier(bar);
    ph_post0(getp());
    xcd_barrier(bar);
    {
        KP p = getp();
        const int ntm = T_ / BM;
        const int n1 = ntm * 12, n2 = ntm * 16, n3 = 64 * 65 / 4;
        for (int t = blockIdx.x; t < n1 + n2 + n3; t += gridDim.x) {
            if (t < n1 + n2) {
                const bool isq = t < n1;
                const int u = isq ? t : t - n1, nt = u / ntm, mt = u % ntm;
                Acc acc; acc_zero(acc);
                gemm_accum<B_BF16_KN, false>(acc, isq ? p->cqn : p->ckvn, isq ? 512 : 256, RowId{mt * BM}, isq ? p->w_uqb : p->w_ukvb,
                                     isq ? 1536 : 2048, ColOff{nt * BN}, isq ? 512 : 256, lds);
                if (isq) EpiQa{p->qa, p->cosA, p->sinA, mt * BM, nt * BN}(acc, smem);
                else EpiKva{p->ka, p->vaT, mt * BM, nt * BN}(acc, smem);
            } else {
                const int u = 2 * (t - n1 - n2) + (int)(threadIdx.x >> 8);
                int qt = (int)((sqrtf(8.f * (float)u + 1.f) - 1.f) * 0.5f);
                while ((qt + 1) * (qt + 2) / 2 <= u) ++qt;
                while (qt * (qt + 1) / 2 > u) --qt;
                const int kt = u - qt * (qt + 1) / 2;
                indexer_tile(p, qt, kt);
            }
        }
    }
    xcd_barrier(bar);
    ph_topk(getp(), smem);
    xcd_barrier(bar);
    ph_attn(getp(), smem, misc);
    xcd_barrier(bar);
    ph_mla_merge(getp());
    xcd_barrier(bar);
    {
        KP p = getp();
        const int ntm = T_ / BM;
        for (int t = blockIdx.x; t < ntm * 16; t += gridDim.x) {
            const int nt = t / ntm, mt = t % ntm;
            Acc acc; acc_zero(acc);
            gemm_accum<B_BF16_KN, false>(acc, p->outcat, D_, RowId{mt * BM}, p->w_out0b, D_, ColOff{nt * BN}, D_, lds);
            EpiResid<false>{p->ybuf, p->x, D_, mt * BM, nt * BN}(acc, smem);
        }
    }
    xcd_barrier(bar);
    { KP p = getp(); ph_ln<false, true, true, false>(p, p->ybuf, p->ln_mix_g[0], p->ln_mix_b[0], nullptr, p->xab, p->xlb); }
    xcd_barrier(bar);
    { KP p = getp(); ph_router(p, smem, p->ctl + CTL_CNT0, p->list); }
    xcd_barrier(bar);
    { KP p = getp(); ph_moe_up<0>(p, p->xab, smem, s_tp, s_off); }
    xcd_barrier(bar);
    { KP p = getp(); ph_moe_down<0>(p, p->xab, smem, s_tp, s_off); }
    xcd_barrier(bar);
    { KP p = getp(); ph_ln<true, false, true, false>(p, p->y2, p->ln_ffn_g[0], p->ln_ffn_b[0], nullptr, p->xcb, nullptr); }
    xcd_barrier(bar);
    ph_l1_in(getp(), lds);
    xcd_barrier(bar);
    ph_ret_a(getp(), lds);
    xcd_barrier(bar);
    ph_ret_b(getp());
    xcd_barrier(bar);
    ph_ret_c(getp(), lds);
    xcd_barrier(bar);
    ph_gn(getp());
    xcd_barrier(bar);
    {
        KP p = getp();
        const int ntm = T_ / BM;
        for (int t = blockIdx.x; t < ntm * 16; t += gridDim.x) {
            const int nt = t / ntm, mt = t % ntm;
            Acc acc; acc_zero(acc);
            gemm_accum<B_BF16_KN, false>(acc, p->gated, 4096, RowId{mt * BM}, p->w_out1b, D_, ColOff{nt * BN}, 4096, lds);
            EpiResid<true>{p->ybuf, p->xcb, D_, mt * BM, nt * BN}(acc, smem);
        }
    }
    xcd_barrier(bar);
    { KP p = getp(); ph_ln<false, true, true, false>(p, p->ybuf, p->ln_mix_g[1], p->ln_mix_b[1], nullptr, p->xab, p->xlb); }
    xcd_barrier(bar);
    { KP p = getp(); ph_router(p, smem, p->ctl + CTL_CNT1, p->list); }
    xcd_barrier(bar);
    { KP p = getp(); ph_moe_up<1>(p, p->xab, smem, s_tp, s_off); }
    xcd_barrier(bar);
    { KP p = getp(); ph_moe_down<1>(p, p->xab, smem, s_tp, s_off); }
    xcd_barrier(bar);
    { KP p = getp(); ph_ln<true, false, false, true>(p, p->y2, p->ln_ffn_g[1], p->ln_ffn_b[1], p->out, nullptr, nullptr); }
    {
        KP p = getp();
        if (xb_ld(&p->bar[XB_TMO])) {
            asm volatile("s_waitcnt vmcnt(0)" ::: "memory");
            for (int i = blockIdx.x * NT + ltid(); i < p->out_size; i += gridDim.x * NT) p->out[i] = __uint_as_float(0x7fc00000u);
        }
    }
}

extern "C" void kernel_launch(void* const* d_in, const int* in_sizes, int n_in,
                              void* d_out, int out_size, void* d_ws, size_t ws_size,
                              hipStream_t stream) {
    const size_t kDynLds = LDS_TOTAL;
    static int grid = 0;
    if (!grid) {
        int dev = 0, cus = 0, per_cu = 0;
        (void)hipGetDevice(&dev);
        (void)hipDeviceGetAttribute(&cus, hipDeviceAttributeMultiprocessorCount, dev);
        (void)hipFuncSetAttribute((const void*)mega, hipFuncAttributeMaxDynamicSharedMemorySize, (int)kDynLds);
        (void)hipOccupancyMaxActiveBlocksPerMultiprocessor(&per_cu, mega, NT, kDynLds);
        grid = cus * (per_cu >= 1 ? 1 : 0);
    }
    unsigned char* ws = (unsigned char*)d_ws;
    size_t off = 0;
    auto take = [&](size_t bytes) { void* q = ws + off; off += (bytes + 255) & ~(size_t)255; return q; };
    Params p{};
    p.bar = (unsigned*)take(XCD_BAR_WORDS * 4);
    p.ctl = (unsigned*)take(CTL_WORDS * 4);
    const size_t ctl_bytes = off;
    (void)hipMemsetAsync(ws, 0, ctl_bytes, stream);
    auto F = [&](int i) { return (const float*)d_in[i]; };
    p.x = F(0); p.pos = (const int*)d_in[1]; p.router_w = F(2); p.router_b = F(3);
    p.w_in0 = F(4); p.q_norm = F(5); p.w_uq = F(6); p.kv_norm = F(7); p.w_ukv = F(8); p.w_out0 = F(9);
    p.w_in1 = F(10); p.gn_g = F(11); p.gn_b = F(12); p.w_out1 = F(13);
    for (int l = 0; l < 2; ++l) {
        const int b = 14 + 10 * l;
        p.ln_mix_g[l] = F(b); p.ln_mix_b[l] = F(b + 1);
        p.moe_wg[l] = F(b + 2); p.moe_wu[l] = F(b + 3); p.moe_wd[l] = F(b + 4);
        p.sh_g[l] = F(b + 5); p.sh_u[l] = F(b + 6); p.sh_d[l] = F(b + 7);
        p.ln_ffn_g[l] = F(b + 8); p.ln_ffn_b[l] = F(b + 9);
    }
    p.out = (float*)d_out;
    p.w_in0b = (u16*)take((size_t)D_ * IN_AB * 2); p.w_uqb = (u16*)take(512 * 1536 * 2); p.w_ukvb = (u16*)take(256 * 2048 * 2);
    p.w_out0b = (u16*)take((size_t)D_ * D_ * 2); p.w_in1b = (u16*)take((size_t)D_ * IN_C * 2); p.w_out1b = (u16*)take((size_t)4096 * D_ * 2);
    for (int l = 0; l < 2; ++l) { p.sh_gb[l] = (u16*)take((size_t)D_ * 1024 * 2); p.sh_ub[l] = (u16*)take((size_t)D_ * 1024 * 2); p.sh_db[l] = (u16*)take((size_t)1024 * D_ * 2); }
    const size_t T = T_;
    p.cosA = (float*)take(T * 32 * 4); p.sinA = (float*)take(T * 32 * 4);
    p.cosR = (float*)take(T * 128 * 4); p.sinR = (float*)take(T * 128 * 4);
    p.xb = (u16*)take(T * 2048 * 2); p.H0 = (u16*)take(T * IN_AB * 2);
    p.cqn = (u16*)take(T * 512 * 2); p.ckvn = (u16*)take(T * 256 * 2); p.kpe = (u16*)take(T * 64 * 2);
    p.qb = (u16*)take(T * 1024 * 2); p.kb = (u16*)take(T * 256 * 2); p.vb = (u16*)take(T * 256 * 2);
    p.iqb = (u16*)take(T * 1024 * 2); p.ikb = (u16*)take(T * 64 * 2); p.iwf = (float*)take(T * 16 * 4);
    p.qa = (u16*)take(T * 1536 * 2); p.ka = (u16*)take(T * 1024 * 2); p.vaT = (u16*)take(T * 1024 * 2);
    p.scores = (float*)take(T * T * 4); p.sel = (u16*)take(T * 256 * 2); p.outcat = (u16*)take(T * 2048 * 2); p.mla_po = (float*)take((size_t)256 * 256 * 128 * 4); p.mla_ml = (float*)take((size_t)256 * 256 * 2 * 4);
    p.ybuf = (u16*)take(T * 2048 * 2); p.xab = (u16*)take(T * 2048 * 2); p.xlb = (u16*)take(T * 2048 * 2); p.whT = (u16*)take(64 * 2048 * 2); p.wlT = (u16*)take(64 * 2048 * 2);
    p.y2 = (u16*)take(T * 2048 * 2); p.xcb = (u16*)take(T * 2048 * 2);
    p.tok_e = (int*)take(T * 2 * 4); p.tok_g = (float*)take(T * 2 * 4); p.list = (int*)take(2 * 64 * T * 4);
    p.hbuf = (u16*)take(T * 2 * 512 * 2); p.hsh = (u16*)take(T * 1024 * 2); p.yr = (u16*)take(T * 2 * 2048 * 2);
    p.qr = (u16*)take(T * 2048 * 2); p.qx = (u16*)take(T * 2048 * 2); p.kr = (u16*)take(T * 2048 * 2);
    p.kzT = (u16*)take(T * 2048 * 2); p.v1T = (u16*)take(T * 4096 * 2); p.sg = (u16*)take(T * 4096 * 2);
    p.innerG = (u16*)take((size_t)8 * 64 * 128 * 128 * 2);
    {
        unsigned char* sbase = (unsigned char*)p.scores;
        p.KVt = (u16*)sbase; p.obuf = (u16*)(sbase + ((size_t)128 << 20)); p.gated = (u16*)(sbase + ((size_t)192 << 20));
    }
    p.out_size = out_size; p.pad_ = 0;
    if (off > ws_size) return;
    mega<<<dim3(grid), dim3(NT), kDynLds, stream>>>(p);
}
```

```cpp
#include <hip/hip_runtime.h>
#include <stdint.h>

typedef unsigned short u16;
typedef __attribute__((ext_vector_type(8))) short bf16x8;
typedef __attribute__((ext_vector_type(4))) float f32x4;
typedef __attribute__((ext_vector_type(2))) float f32x2;
typedef __attribute__((ext_vector_type(4))) unsigned u32x4;
typedef __attribute__((ext_vector_type(2))) unsigned u32x2;
typedef __attribute__((ext_vector_type(2))) __bf16 bf16x2_t;
typedef __attribute__((ext_vector_type(4))) short s16x4;

#define XB_TMO      128
#define XB_XCNT(j)  (256  + 64 * (j))
#define XB_XSUB(j)  (1280 + 64 * (j))
#define XB_XGEN(j)  (2304 + 64 * (j))
#define XB_TOP      3328
#define XB_TOPGEN   3392
#define XCD_BAR_WORDS 3456
#define XB_SPIN_CAP (1u << 22)
#define LAS __attribute__((address_space(3)))

__device__ __forceinline__ unsigned xb_ld(unsigned* p)              { return __hip_atomic_load(p, __ATOMIC_RELAXED, __HIP_MEMORY_SCOPE_AGENT); }
__device__ __forceinline__ unsigned xb_add(unsigned* p, unsigned v) { return __hip_atomic_fetch_add(p, v, __ATOMIC_RELAXED, __HIP_MEMORY_SCOPE_AGENT); }
__device__ __forceinline__ unsigned xb_xcc_id() { return (unsigned)__builtin_amdgcn_s_getreg((3 << 11) | 20) & 0xFu; }
#define XB_SPIN(cond, bar) do { unsigned _sp = 0; while (cond) { __builtin_amdgcn_s_sleep(1); \
    if ((++_sp & 255u) == 0u) { if (xb_ld(&(bar)[XB_TMO])) break; if (_sp > XB_SPIN_CAP) { atomicAdd(&(bar)[XB_TMO], 1u); break; } } } } while (0)

struct XcdBarrier { unsigned* bar; unsigned x; volatile LAS unsigned* st; };

__device__ __forceinline__ XcdBarrier xcd_barrier_post(unsigned* bar, volatile LAS unsigned* st) {
    XcdBarrier b; b.bar = bar; b.x = xb_xcc_id(); b.st = st;
    if (threadIdx.x == 0) (void)xb_add(&bar[XB_XCNT(b.x)], 1u);
    return b;
}
__device__ __forceinline__ void xcd_barrier_complete(unsigned* bar, unsigned x, unsigned& nloc, unsigned& nx) {
    const unsigned G = gridDim.x * gridDim.y * gridDim.z;
    unsigned sum, cnt, mine, sp = 0u;
    for (;;) {
        sum = 0u; cnt = 0u; mine = 0u;
#pragma unroll
        for (unsigned j = 0; j < 16; ++j) { const unsigned c = xb_ld(&bar[XB_XCNT(j)]); sum += c; cnt += (c > 0u) ? 1u : 0u; mine = (j == x) ? c : mine; }
        if (sum == G) break;
        __builtin_amdgcn_s_sleep(1);
        if ((++sp & 255u) == 0u) { if (xb_ld(&bar[XB_TMO])) break; if (sp > XB_SPIN_CAP) { atomicAdd(&bar[XB_TMO], 1u); break; } }
    }
    nloc = mine > 0u ? mine : 1u; nx = cnt > 0u ? cnt : 1u;
}
__device__ __forceinline__ void xcd_barrier(const XcdBarrier& b) {
    asm volatile("s_waitcnt vmcnt(0)" ::: "memory");
    __syncthreads();
    if (threadIdx.x == 0) {
        unsigned* bar = b.bar;
        __builtin_amdgcn_s_waitcnt(0);
        unsigned nloc = b.st[0], nx = b.st[1];
        if (nloc == 0u) { xcd_barrier_complete(bar, b.x, nloc, nx); b.st[0] = nloc; b.st[1] = nx; }
        const unsigned old = xb_add(&bar[XB_XSUB(b.x)], 1u);
        const unsigned gen = old / nloc;
        if (old + 1u == (gen + 1u) * nloc) {
            __builtin_amdgcn_fence(__ATOMIC_RELEASE, "agent");
            asm volatile("s_waitcnt vmcnt(0)" ::: "memory");
            const unsigned og = xb_add(&bar[XB_TOP], 1u);
            const unsigned tg = og / nx;
            if (og + 1u == (tg + 1u) * nx) xb_add(&bar[XB_TOPGEN], 1u);
            else XB_SPIN(xb_ld(&bar[XB_TOPGEN]) == tg, bar);
            __builtin_amdgcn_fence(__ATOMIC_ACQUIRE, "agent");
            xb_add(&bar[XB_XGEN(b.x)], 1u);
            asm volatile("s_waitcnt vmcnt(0)" ::: "memory");
        } else {
            XB_SPIN(xb_ld(&bar[XB_XGEN(b.x)]) == gen, bar);
            __builtin_amdgcn_fence(__ATOMIC_ACQUIRE, "agent");
            asm volatile("s_waitcnt vmcnt(0)" ::: "memory");
        }
    }
    __syncthreads();
}

__device__ __forceinline__ int ltid() { int t = threadIdx.x; asm volatile("" : "+v"(t)); return t; }
__device__ __forceinline__ u16 f2bf(float f) {
    unsigned u = __float_as_uint(f);
    u += 0x7fffu + ((u >> 16) & 1u);
    return (u16)(u >> 16);
}
__device__ __forceinline__ float bf2f(u16 h) { return __uint_as_float(((unsigned)h) << 16); }
__device__ __forceinline__ unsigned pack2(float a, float b) {
    f32x2 v = {a, b};
    bf16x2_t r = __builtin_convertvector(v, bf16x2_t);
    return *(unsigned*)&r;
}

namespace pg8 {
#define PG8_LAS __attribute__((address_space(3)))
typedef unsigned short bf16_t;
typedef short bf16x8 __attribute__((ext_vector_type(8)));
typedef float f32x4 __attribute__((ext_vector_type(4)));
typedef unsigned u32x4 __attribute__((ext_vector_type(4)));
constexpr int BM = 256, BK = 64, HALF = 128, HTB = HALF * BK * 2  , STAGE_BYTES = 8 * HTB, NXCD = 8, WGM = 8;

__host__ __device__ __forceinline__ int lds_byte(int r, int c) { const int st = (r >> 4) * 2 + (c >> 5), rr = r & 15, cc = c & 31, ob = rr * 64 + cc * 2; return st * 1024 + (ob ^ (((ob >> 9) & 1) << 5)); }
__host__ __device__ __forceinline__ void stage_rc(int b, int& R, int& C) { const int st = b / 1024, sb = b % 1024, swz = sb ^ (((sb >> 9) & 1) << 5); R = (st >> 1) * 16 + swz / 64; C = (st & 1) * 32 + (swz % 64) / 2; }
__host__ __device__ __forceinline__ int perm32(int rho) { const int n = rho >> 4, i = rho & 15; return 8 * (i >> 2) + 4 * n + (i & 3); }

struct Unit { int pm, pn; };
struct Gemm { const bf16_t* A; const bf16_t* Bt; int M, N, K; };

struct StaticOrder {
    int nM, nN, nwg, G, c;
    __host__ __device__ void init(int M, int N, int G_, int c_) { nM = M / BM; nN = N / BM; nwg = nM * nN; G = G_; c = c_; }
    __host__ __device__ bool next(int i, Unit& u) const {
        const long L = (long)i * G + c; if (L >= nwg) return false;
        int wgid = (int)L; { const int q = nwg / NXCD, r = nwg % NXCD, xcd = wgid % NXCD, off = wgid / NXCD; wgid = (xcd < r ? xcd * (q + 1) : r * (q + 1) + (xcd - r) * q) + off; }
        const int nig = WGM * nN, gid = wgid / nig, fm = gid * WGM, gsz = (nM - fm) < WGM ? (nM - fm) : WGM;
        u.pm = fm + ((wgid % nig) % gsz); u.pn = (wgid % nig) / gsz; return true;
    }
    __device__ __forceinline__ void a_ready(const Unit&) const {}
    __device__ __forceinline__ void done(const Unit&) const {}
};
__device__ __forceinline__ unsigned cvt_pk_bf16(float lo, float hi) { unsigned r; asm volatile("v_cvt_pk_bf16_f32 %0, %1, %2" : "=v"(r) : "v"(lo), "v"(hi)); return r; }
template <class Epi, class Sched, bool STAMP = false>
__device__ __forceinline__ void gemm_phase(PG8_LAS unsigned char* lds, const Gemm g, const Sched& S, const Epi& E, unsigned long long* stamps) {
    const int tid = ltid(), wid = __builtin_amdgcn_readfirstlane(tid >> 6), lane = tid & 63, wr = wid >> 2, wc = wid & 3, fr = lane & 15, fq = lane >> 4;
    const int K = g.K, nt = K / BK;
    int ts_lo = 0, ts_hi = 0, nts = 0; const unsigned long long rt_entry = STAMP ? (unsigned long long)wall_clock64() : 0ull;
#define PG8_STAMP() do { if (STAMP && wid == 0 && nts < 64) { const unsigned long long _c = (unsigned long long)clock64(); \
        ts_lo = (lane == nts) ? (int)(unsigned)_c : ts_lo; ts_hi = (lane == nts) ? (int)(unsigned)(_c >> 32) : ts_hi; ++nts; } } while (0)
    PG8_STAMP();
    unsigned voffA[2], voffB[2];
#pragma unroll
    for (int i = 0; i < 2; ++i) { int R, C; stage_rc(tid * 16 + i * 8192, R, C); const int Rb = Epi::PERM ? ((R & ~31) + perm32(R & 31)) : R;
        voffA[i] = (unsigned)(R * K + C) * 2u; voffB[i] = (unsigned)(Rb * K + C) * 2u; }
    const size_t kstep = (size_t)(BK * 2);
    const size_t hstep = (size_t)HALF * K * 2;
    const size_t tstep = 2 * hstep;
    const unsigned ldsw = (unsigned)wid * 1024u;
    const int aoff = lds_byte(wr * 64 + fr, fq * 8), boff = lds_byte(wc * 32 + fr, fq * 8);
#define PG8_SA(b, h) (((b) * 2 + (h)) * HTB)
#define PG8_SB(b, h) ((4 + (b) * 2 + (h)) * HTB)
#define PG8_STAGE(bufoff, gbase, voff) do { _Pragma("unroll") for (int _i = 0; _i < 2; ++_i) \
        __builtin_amdgcn_global_load_lds((const unsigned*)((const char*)(gbase) + (voff)[_i]), (PG8_LAS unsigned*)(lds + (bufoff) + ldsw + _i * 8192), 16, 0, 0); } while (0)
#define PG8_LDA(dst, b, h) do { _Pragma("unroll") for (int m = 0; m < 4; ++m) _Pragma("unroll") for (int k = 0; k < 2; ++k) dst[m][k] = *(const PG8_LAS bf16x8*)(lds + PG8_SA(b, h) + aoff + m * 2048 + k * 1024); } while (0)
#define PG8_LDB(dst, b, h) do { _Pragma("unroll") for (int n = 0; n < 2; ++n) _Pragma("unroll") for (int k = 0; k < 2; ++k) dst[n][k] = *(const PG8_LAS bf16x8*)(lds + PG8_SB(b, h) + boff + n * 2048 + k * 1024); } while (0)
#define PG8_MMA(ai, bj, At, Bt) do { __builtin_amdgcn_s_setprio(1); _Pragma("unroll") for (int m = 0; m < 4; ++m) _Pragma("unroll") for (int n = 0; n < 2; ++n) _Pragma("unroll") for (int k = 0; k < 2; ++k) \
        acc[ai][bj][m][n] = __builtin_amdgcn_mfma_f32_16x16x32_bf16(Bt[n][k], At[m][k], acc[ai][bj][m][n], 0, 0, 0); __builtin_amdgcn_s_setprio(0); } while (0)
#define PG8_WAIT_V(n) asm volatile("s_waitcnt vmcnt(" #n ")" ::: "memory")
#define PG8_WAIT_L(n) asm volatile("s_waitcnt lgkmcnt(" #n ")" ::: "memory")
#define PG8_BAR __builtin_amdgcn_s_barrier()
#define PG8_SCHED __builtin_amdgcn_sched_barrier(0)
    Unit cur, nxt; int ui = 0;
    if (!S.next(0, cur)) return;
    f32x4 acc[2][2][4][2];
#pragma unroll
    for (int a = 0; a < 2; ++a)
#pragma unroll
        for (int b = 0; b < 2; ++b)
#pragma unroll
            for (int m = 0; m < 4; ++m)
#pragma unroll
                for (int n = 0; n < 2; ++n) acc[a][b][m][n] = (f32x4){0.f, 0.f, 0.f, 0.f};
    bf16x8 At[4][2], B0[2][2], B1[2][2];
    const char* cA = (const char*)g.A + (size_t)cur.pm * tstep; const char* cB = (const char*)g.Bt + (size_t)cur.pn * tstep;
    S.a_ready(cur);
    PG8_STAGE(PG8_SB(0, 0), cB, voffB); PG8_STAGE(PG8_SA(0, 0), cA, voffA); PG8_STAGE(PG8_SB(0, 1), cB + hstep, voffB); PG8_STAGE(PG8_SA(0, 1), cA + hstep, voffA);
    if (wr == 1) PG8_BAR;
    PG8_WAIT_V(4); PG8_BAR;
    PG8_STAGE(PG8_SB(1, 0), cB + kstep, voffB); PG8_STAGE(PG8_SA(1, 0), cA + kstep, voffA); PG8_STAGE(PG8_SB(1, 1), cB + hstep + kstep, voffB);
    PG8_WAIT_V(6); PG8_BAR;
    PG8_STAMP();
    for (;;) {
        const bool has_next = S.next(ui + 1, nxt);
        const char* nA = has_next ? (const char*)g.A + (size_t)nxt.pm * tstep : cA; const char* nB = has_next ? (const char*)g.Bt + (size_t)nxt.pn * tstep : cB;
        for (int t = 0; t < nt; t += 2) {
            const bool last = (t == nt - 2);
            const char* a1 = cA + (size_t)(t + 1) * kstep;
            const char* a2 = last ? nA : cA + (size_t)(t + 2) * kstep; const char* b2 = last ? nB : cB + (size_t)(t + 2) * kstep;
            const char* a3 = a2 + kstep; const char* b3 = b2 + kstep;
            if (last && has_next) S.a_ready(nxt);
            PG8_LDB(B0, 0, 0); PG8_SCHED; PG8_LDA(At, 0, 0); PG8_STAGE(PG8_SA(1, 1), a1 + hstep, voffA);
            PG8_WAIT_L(8); PG8_BAR; PG8_WAIT_L(0); PG8_MMA(0, 0, At, B0); PG8_BAR; PG8_SCHED;
            PG8_LDB(B1, 0, 1); PG8_STAGE(PG8_SB(0, 0), b2, voffB);
            PG8_BAR; PG8_WAIT_L(0); PG8_MMA(0, 1, At, B1); PG8_BAR;
            PG8_LDA(At, 0, 1); PG8_STAGE(PG8_SA(0, 0), a2, voffA);
            PG8_BAR; PG8_WAIT_L(0); PG8_MMA(1, 0, At, B0); PG8_BAR; PG8_SCHED;
            PG8_STAGE(PG8_SB(0, 1), b2 + hstep, voffB);
            PG8_WAIT_V(6); PG8_BAR; PG8_MMA(1, 1, At, B1); PG8_BAR;
            PG8_LDB(B0, 1, 0); PG8_SCHED; PG8_LDA(At, 1, 0); PG8_STAGE(PG8_SA(0, 1), a2 + hstep, voffA);
            PG8_WAIT_L(8); PG8_BAR; PG8_WAIT_L(0); PG8_MMA(0, 0, At, B0); PG8_BAR; PG8_SCHED;
            PG8_LDB(B1, 1, 1); PG8_STAGE(PG8_SB(1, 0), b3, voffB);
            PG8_BAR; PG8_WAIT_L(0); PG8_MMA(0, 1, At, B1); PG8_BAR;
            PG8_LDA(At, 1, 1); PG8_STAGE(PG8_SA(1, 0), a3, voffA);
            PG8_BAR; PG8_WAIT_L(0); PG8_MMA(1, 0, At, B0); PG8_BAR; PG8_SCHED;
            PG8_STAGE(PG8_SB(1, 1), b3 + hstep, voffB);
            PG8_WAIT_V(6); PG8_BAR; PG8_MMA(1, 1, At, B1); PG8_BAR;
        }
        PG8_STAMP();
        if constexpr (!Epi::AFTER_DRAIN) { E(acc, cur, wr, wc, fr, fq); S.done(cur); }
        PG8_STAMP();
        if (!has_next) break;
#pragma unroll
        for (int a = 0; a < 2; ++a)
#pragma unroll
            for (int b = 0; b < 2; ++b)
#pragma unroll
                for (int m = 0; m < 4; ++m)
#pragma unroll
                    for (int n = 0; n < 2; ++n) acc[a][b][m][n] = (f32x4){0.f, 0.f, 0.f, 0.f};
        cur = nxt; cA = nA; cB = nB; ++ui;
    }
    PG8_WAIT_V(0);
    if (wr == 0) PG8_BAR;
    PG8_BAR;
    if constexpr (Epi::AFTER_DRAIN) { E.fused(acc, cur, wr, wc, fr, fq, lds, wid, lane); S.done(cur); }
    PG8_STAMP();
    if (STAMP && wid == 0) { stamps[lane] = lane < nts ? (((unsigned long long)(unsigned)ts_hi << 32) | (unsigned)ts_lo) : 0ull;
        if (lane == 62) stamps[62] = rt_entry; if (lane == 63) stamps[63] = (unsigned long long)wall_clock64(); }
#undef PG8_STAMP
#undef PG8_SA
#undef PG8_SB
#undef PG8_STAGE
#undef PG8_LDA
#undef PG8_LDB
#undef PG8_MMA
#undef PG8_WAIT_V
#undef PG8_WAIT_L
#undef PG8_BAR
#undef PG8_SCHED
}
}

__device__ __forceinline__ float wave_sum(float v) {
#pragma unroll
    for (int o = 32; o > 0; o >>= 1) v += __shfl_xor(v, o);
    return v;
}
__device__ __forceinline__ float wave_max(float v) {
#pragma unroll
    for (int o = 32; o > 0; o >>= 1) v = fmaxf(v, __shfl_xor(v, o));
    return v;
}
__device__ __forceinline__ int wave_isum(int v) {
#pragma unroll
    for (int o = 32; o > 0; o >>= 1) v += __shfl_xor(v, o);
    return v;
}
__device__ __forceinline__ float silu_f(float x) { return x / (1.f + __expf(-x)); }

#define T_ 8192
#define D_ 2048
#define IN_AB 3472
#define IN_C 12288
#define NT 512
#define ALPHA_ 1.4142135623730951f
#define LOG2E_ 1.4426950408889634f

#define BM 256
#define BN 128
#define BK 64
#define LROW 80
#define GEMM_BUF (BM * LROW + BN * LROW)
#define GEMM_LDS_BYTES (2 * GEMM_BUF * 2)

#define B_F32_KN 0
#define B_BF16_NK 1
#define B_BF16_KN 2

typedef f32x4 Acc[4][4];

__device__ __forceinline__ __amdgpu_buffer_rsrc_t make_rsrc(const void* p) {
    const unsigned long long a = (unsigned long long)p;
    const unsigned lo = __builtin_amdgcn_readfirstlane((unsigned)a), hi = __builtin_amdgcn_readfirstlane((unsigned)(a >> 32));
    return __builtin_amdgcn_make_buffer_rsrc((void*)(((unsigned long long)hi << 32) | lo), 0, 0x7fffffff, 0x00020000);
}
__device__ __forceinline__ u32x4 bload16(__amdgpu_buffer_rsrc_t r, unsigned voff, unsigned soff) {
    return __builtin_amdgcn_raw_buffer_load_b128(r, (int)voff, (int)soff, 0);
}

__device__ __forceinline__ void acc_zero(Acc& acc) {
#pragma unroll
    for (int m = 0; m < 4; ++m)
#pragma unroll
        for (int n = 0; n < 4; ++n) acc[m][n] = (f32x4){0.f, 0.f, 0.f, 0.f};
}

template <int BMODE, bool KS, bool LONGK = false, class ARow, class BSel>
__device__ __forceinline__ void gemm_accum(Acc& acc, const u16* __restrict__ A, int lda, ARow arow,
                                           const void* __restrict__ Bv, int ldb, BSel bsel,
                                           int K, u16* lds) {
    const int tid = ltid(), lane = tid & 63;
    const int wid = __builtin_amdgcn_readfirstlane(tid >> 6);
    const int wr = KS ? ((wid & 3) >> 1) : (wid >> 1), wc = wid & 1, fr = lane & 15, fq = lane >> 4;
    constexpr int NA = KS ? 2 : 4;
    const int ac = tid & 7, ar0 = tid >> 3;
    unsigned ao[NA];
#pragma unroll
    for (int i = 0; i < NA; ++i) ao[i] = ((unsigned)arow(ar0 + 64 * i) * (unsigned)lda + ac * 8) * 2u;
    const int nk = K / BK;
    const int sa_w = ar0 * LROW + ac * 8;
    constexpr int SB0 = BM * LROW;
    const __amdgpu_buffer_rsrc_t rA = make_rsrc(A);

#define MMA16(AF, BF) do { \
        __builtin_amdgcn_s_setprio(1); \
        _Pragma("unroll") for (int m = 0; m < 4; ++m) \
        _Pragma("unroll") for (int n = 0; n < 4; ++n) \
            acc[m][n] = __builtin_amdgcn_mfma_f32_16x16x32_bf16(AF[m], BF[n], acc[m][n], 0, 0, 0); \
        __builtin_amdgcn_s_setprio(0); } while (0)
#define MEMFENCE_ asm volatile("" ::: "memory")
#define GEMM_COMPUTE(buf) do { \
        const u16* sA = lds + (buf) * GEMM_BUF; const u16* sB = sA + SB0; \
        _Pragma("unroll") for (int ks = 0; ks < 2; ++ks) { \
            if (KS && ks != (wid >> 2)) continue; \
            bf16x8 af[4], bfr[4]; \
            _Pragma("unroll") for (int m = 0; m < 4; ++m) af[m] = *(const bf16x8*)(sA + (wr * 64 + m * 16 + fr) * LROW + ks * 32 + fq * 8); \
            _Pragma("unroll") for (int n = 0; n < 4; ++n) bfr[n] = *(const bf16x8*)(sB + (wc * 64 + n * 16 + fr) * LROW + ks * 32 + fq * 8); \
            _Pragma("unroll") for (int m = 0; m < 4; ++m) \
            _Pragma("unroll") for (int n = 0; n < 4; ++n) \
                acc[m][n] = __builtin_amdgcn_mfma_f32_16x16x32_bf16(af[m], bfr[n], acc[m][n], 0, 0, 0); \
        } } while (0)

    __syncthreads();

#define FRAG_KN(buf, ks, AF, BF) do { \
        const u16* sA = lds + (buf) * GEMM_BUF; \
        const LAS char* cB = (const LAS char*)(lds + (buf) * GEMM_BUF); \
        _Pragma("unroll") for (int m = 0; m < 4; ++m) AF[m] = *(const bf16x8*)(sA + (wr * 64 + m * 16 + fr) * LROW + (ks) * 32 + fq * 8); \
        _Pragma("unroll") for (int n = 0; n < 4; ++n) { \
            const s16x4 lo_ = __builtin_amdgcn_ds_read_tr16_b64_v4i16((LAS s16x4*)(cB + rdo[0][n] + (ks) * 8192)); \
            const s16x4 hi_ = __builtin_amdgcn_ds_read_tr16_b64_v4i16((LAS s16x4*)(cB + rdo[1][n] + (ks) * 8192)); \
            BF[n] = __builtin_shufflevector(lo_, hi_, 0, 1, 2, 3, 4, 5, 6, 7); } } while (0)
    if constexpr (BMODE == B_BF16_KN) {
        const int ch8 = tid & 7, kr = tid >> 3;
        const __amdgpu_buffer_rsrc_t rB0 = make_rsrc(bsel.base16((const u16*)Bv, 0));
        const __amdgpu_buffer_rsrc_t rB1 = make_rsrc(bsel.base16((const u16*)Bv, 1));
        const unsigned ldb2 = (unsigned)ldb * 2u;
        const unsigned bof0 = (unsigned)kr * ldb2 + bsel.off8(0, ch8) * 2u, bof1 = (unsigned)kr * ldb2 + bsel.off8(1, ch8) * 2u;
        const int xw = ((kr & 3) << 2) | ((kr >> 2) & 3);
        const int sbw0 = SB0 * 2 + kr * 256 + 16 * (bsel.vchunk(0, ch8) ^ xw);
        const int sbw1 = SB0 * 2 + kr * 256 + 16 * (bsel.vchunk(1, ch8) ^ xw);
        int rdo[2][4];
#pragma unroll
        for (int t = 0; t < 2; ++t) {
            const int xr = ((fr >> 2) << 2) | ((2 * fq + t) & 3);
#pragma unroll
            for (int n = 0; n < 4; ++n)
                rdo[t][n] = SB0 * 2 + (8 * fq + 4 * t + (fr >> 2)) * 256 + 16 * ((2 * (wc * 4 + n) + ((fr & 3) >> 1)) ^ xr) + 8 * (fr & 1);
        }
        u32x4 ra0[NA], ra1[NA]; u32x4 rb0[2], rb1[2];
#define GL_KB(k0, RA, RB) do { \
        _Pragma("unroll") for (int i = 0; i < NA; ++i) RA[i] = bload16(rA, ao[i], (unsigned)(k0) * 2u); \
        const unsigned s0_ = (unsigned)(k0) * ldb2; \
        RB[0] = bload16(rB0, bof0, s0_); RB[1] = bload16(rB1, bof1, s0_); } while (0)
#define LW_KB(buf, RA, RB) do { \
        u16* sb_ = lds + (buf) * GEMM_BUF; \
        _Pragma("unroll") for (int i = 0; i < NA; ++i) *(u32x4*)(sb_ + sa_w + 64 * i * LROW) = RA[i]; \
        char* cb_ = (char*)sb_; \
        *(u32x4*)(cb_ + sbw0) = RB[0]; *(u32x4*)(cb_ + sbw1) = RB[1]; } while (0)
        GL_KB(0, ra0, rb0);
        GL_KB(BK, ra1, rb1);
        LW_KB(0, ra0, rb0);
        if (LONGK || 2 < nk) GL_KB((2 < nk ? 2 : nk - 1) * BK, ra0, rb0);
        __syncthreads();
        bf16x8 af0[4], bf0[4], af1[4], bf1[4];
        for (int kt = 0; kt < nk; kt += 2) {
            if (!KS) { FRAG_KN(0, 0, af0, bf0); } else { FRAG_KN(0, (wid >> 2), af0, bf0); }
            MEMFENCE_;
            LW_KB(1, ra1, rb1);
            if (LONGK || kt + 3 < nk) GL_KB((kt + 3 < nk ? kt + 3 : nk - 1) * BK, ra1, rb1);
            MEMFENCE_;
            if (!KS) FRAG_KN(0, 1, af1, bf1);
            MMA16(af0, bf0);
            if (!KS) MMA16(af1, bf1);
            __syncthreads();
            if (!KS) { FRAG_KN(1, 0, af0, bf0); } else { FRAG_KN(1, (wid >> 2), af0, bf0); }
            MEMFENCE_;
            if (LONGK || kt + 2 < nk) LW_KB(0, ra0, rb0);
            if (LONGK || kt + 4 < nk) GL_KB((kt + 4 < nk ? kt + 4 : nk - 1) * BK, ra0, rb0);
            MEMFENCE_;
            if (!KS) FRAG_KN(1, 1, af1, bf1);
            MMA16(af0, bf0);
            if (!KS) MMA16(af1, bf1);
            __syncthreads();
        }
#undef GL_KB
#undef LW_KB
    } else if constexpr (BMODE == B_F32_KN) {
        const int g4 = tid & 15, kr = tid >> 4;
        const __amdgpu_buffer_rsrc_t rB0 = make_rsrc(bsel.base((const float*)Bv, 0));
        const __amdgpu_buffer_rsrc_t rB1 = make_rsrc(bsel.base((const float*)Bv, 1));
        const unsigned ldb4 = (unsigned)ldb * 4u;
        const unsigned bof0 = (unsigned)kr * ldb4 + bsel.off4(0, g4) * 4u, bof1 = (unsigned)kr * ldb4 + bsel.off4(1, g4) * 4u;
        const int xw = ((kr & 3) << 2) | ((kr >> 2) & 3);
        const int v00 = bsel.vcol4(0, g4), v01 = bsel.vcol4(1, g4);
        const int sbw0 = SB0 * 2 + kr * 256 + 16 * ((v00 >> 3) ^ xw) + 8 * ((v00 >> 2) & 1);
        const int sbw1 = SB0 * 2 + kr * 256 + 16 * ((v01 >> 3) ^ xw) + 8 * ((v01 >> 2) & 1);
        int rdo[2][4];
#pragma unroll
        for (int t = 0; t < 2; ++t) {
            const int xr = ((fr >> 2) << 2) | ((2 * fq + t) & 3);
#pragma unroll
            for (int n = 0; n < 4; ++n)
                rdo[t][n] = SB0 * 2 + (8 * fq + 4 * t + (fr >> 2)) * 256 + 16 * ((2 * (wc * 4 + n) + ((fr & 3) >> 1)) ^ xr) + 8 * (fr & 1);
        }
        u32x4 ra0[NA], ra1[NA]; u32x4 rb0[4], rb1[4];
#define PK4_(V) (w_.x = pack2(__uint_as_float(V[0]), __uint_as_float(V[1])), w_.y = pack2(__uint_as_float(V[2]), __uint_as_float(V[3])))
#define GL_F32(k0, RA, RB) do { \
        _Pragma("unroll") for (int i = 0; i < NA; ++i) RA[i] = bload16(rA, ao[i], (unsigned)(k0) * 2u); \
        const unsigned s0_ = (unsigned)(k0) * ldb4, s1_ = s0_ + 32u * ldb4; \
        RB[0] = bload16(rB0, bof0, s0_); RB[1] = bload16(rB1, bof1, s0_); \
        RB[2] = bload16(rB0, bof0, s1_); RB[3] = bload16(rB1, bof1, s1_); } while (0)
#define LW_F32(buf, RA, RB) do { \
        u16* sb_ = lds + (buf) * GEMM_BUF; \
        _Pragma("unroll") for (int i = 0; i < NA; ++i) *(u32x4*)(sb_ + sa_w + 64 * i * LROW) = RA[i]; \
        char* cb_ = (char*)sb_; \
        u32x2 w_; \
        PK4_(RB[0]); *(u32x2*)(cb_ + sbw0) = w_; \
        PK4_(RB[1]); *(u32x2*)(cb_ + sbw1) = w_; \
        PK4_(RB[2]); *(u32x2*)(cb_ + sbw0 + 32 * 256) = w_; \
        PK4_(RB[3]); *(u32x2*)(cb_ + sbw1 + 32 * 256) = w_; } while (0)
        GL_F32(0, ra0, rb0);
        GL_F32(BK, ra1, rb1);
        LW_F32(0, ra0, rb0);
        if (LONGK || 2 < nk) GL_F32((2 < nk ? 2 : nk - 1) * BK, ra0, rb0);
        __syncthreads();
        bf16x8 af0[4], bf0[4], af1[4], bf1[4];
        for (int kt = 0; kt < nk; kt += 2) {
            if (!KS) { FRAG_KN(0, 0, af0, bf0); } else { FRAG_KN(0, (wid >> 2), af0, bf0); }
            MEMFENCE_;
            LW_F32(1, ra1, rb1);
            if (LONGK || kt + 3 < nk) GL_F32((kt + 3 < nk ? kt + 3 : nk - 1) * BK, ra1, rb1);
            MEMFENCE_;
            if (!KS) FRAG_KN(0, 1, af1, bf1);
            MMA16(af0, bf0);
            if (!KS) MMA16(af1, bf1);
            __syncthreads();
            if (!KS) { FRAG_KN(1, 0, af0, bf0); } else { FRAG_KN(1, (wid >> 2), af0, bf0); }
            MEMFENCE_;
            if (LONGK || kt + 2 < nk) LW_F32(0, ra0, rb0);
            if (LONGK || kt + 4 < nk) GL_F32((kt + 4 < nk ? kt + 4 : nk - 1) * BK, ra0, rb0);
            MEMFENCE_;
            if (!KS) FRAG_KN(1, 1, af1, bf1);
            MMA16(af0, bf0);
            if (!KS) MMA16(af1, bf1);
            __syncthreads();
        }
#undef GL_F32
#undef LW_F32
    } else {
        const __amdgpu_buffer_rsrc_t rB = make_rsrc(Bv);
        unsigned bo[2];
#pragma unroll
        for (int i = 0; i < 2; ++i) bo[i] = ((unsigned)bsel(ar0 + 64 * i) * (unsigned)ldb + ac * 8) * 2u;
        u32x4 ra0[NA], ra1[NA], rb0[2], rb1[2];
#define GL_BF(k0, RA, RB) do { \
        _Pragma("unroll") for (int i = 0; i < NA; ++i) RA[i] = bload16(rA, ao[i], (unsigned)(k0) * 2u); \
        _Pragma("unroll") for (int i = 0; i < 2; ++i) RB[i] = bload16(rB, bo[i], (unsigned)(k0) * 2u); } while (0)
#define LW_BF(buf, RA, RB) do { \
        u16* sb_ = lds + (buf) * GEMM_BUF; \
        _Pragma("unroll") for (int i = 0; i < NA; ++i) *(u32x4*)(sb_ + sa_w + 64 * i * LROW) = RA[i]; \
        _Pragma("unroll") for (int i = 0; i < 2; ++i) *(u32x4*)(sb_ + SB0 + sa_w + 64 * i * LROW) = RB[i]; } while (0)
        GL_BF(0, ra0, rb0);
        GL_BF(BK, ra1, rb1);
        LW_BF(0, ra0, rb0);
        if (LONGK || 2 < nk) GL_BF((2 < nk ? 2 : nk - 1) * BK, ra0, rb0);
        __syncthreads();
#define FRAG_NK(buf, ks, AF, BF) do { \
        const u16* sA = lds + (buf) * GEMM_BUF; const u16* sB = sA + SB0; \
        _Pragma("unroll") for (int m = 0; m < 4; ++m) AF[m] = *(const bf16x8*)(sA + (wr * 64 + m * 16 + fr) * LROW + (ks) * 32 + fq * 8); \
        _Pragma("unroll") for (int n = 0; n < 4; ++n) BF[n] = *(const bf16x8*)(sB + (wc * 64 + n * 16 + fr) * LROW + (ks) * 32 + fq * 8); } while (0)
        bf16x8 af0[4], bf0[4], af1[4], bf1[4];
        for (int kt = 0; kt < nk; kt += 2) {
            if (!KS) { FRAG_NK(0, 0, af0, bf0); } else { FRAG_NK(0, (wid >> 2), af0, bf0); }
            MEMFENCE_;
            LW_BF(1, ra1, rb1);
            if (LONGK || kt + 3 < nk) GL_BF((kt + 3 < nk ? kt + 3 : nk - 1) * BK, ra1, rb1);
            MEMFENCE_;
            if (!KS) FRAG_NK(0, 1, af1, bf1);
            MMA16(af0, bf0);
            if (!KS) MMA16(af1, bf1);
            __syncthreads();
            if (!KS) { FRAG_NK(1, 0, af0, bf0); } else { FRAG_NK(1, (wid >> 2), af0, bf0); }
            MEMFENCE_;
            if (LONGK || kt + 2 < nk) LW_BF(0, ra0, rb0);
            if (LONGK || kt + 4 < nk) GL_BF((kt + 4 < nk ? kt + 4 : nk - 1) * BK, ra0, rb0);
            MEMFENCE_;
            if (!KS) FRAG_NK(1, 1, af1, bf1);
            MMA16(af0, bf0);
            if (!KS) MMA16(af1, bf1);
            __syncthreads();
        }
#undef FRAG_NK
#undef GL_BF
#undef LW_BF
    }
#undef GEMM_COMPUTE
#undef FRAG_KN
}

__device__ __forceinline__ void gemm_kk128(Acc& acc, const u16* __restrict__ Akm, int lda, const u16* __restrict__ Bkn, int ldb, u16* lds) {
    const int tid = ltid(), lane = tid & 63;
    const int wid = __builtin_amdgcn_readfirstlane(tid >> 6);
    const int wr = wid >> 1, wc = wid & 1, fr = lane & 15, fq = lane >> 4;
    char* sA = (char*)lds;
    char* sB = (char*)lds + 65536;
    __syncthreads();
    {
        u32x4 ra[8], rb[4];
#pragma unroll
        for (int i = 0; i < 8; ++i) { const int k = (tid >> 5) + 16 * i, ch = tid & 31; ra[i] = *(const u32x4*)(Akm + (size_t)k * lda + ch * 8); }
#pragma unroll
        for (int i = 0; i < 4; ++i) { const int k = (tid >> 4) + 32 * i, ch = tid & 15; rb[i] = *(const u32x4*)(Bkn + (size_t)k * ldb + ch * 8); }
#pragma unroll
        for (int i = 0; i < 8; ++i) { const int k = (tid >> 5) + 16 * i, ch = tid & 31; const int x = ((k & 3) << 2) | ((k >> 2) & 3);
            *(u32x4*)(sA + k * 512 + 16 * (ch ^ x)) = ra[i]; }
#pragma unroll
        for (int i = 0; i < 4; ++i) { const int k = (tid >> 4) + 32 * i, ch = tid & 15; const int x = ((k & 3) << 2) | ((k >> 2) & 3);
            *(u32x4*)(sB + k * 256 + 16 * (ch ^ x)) = rb[i]; }
    }
    __syncthreads();
    const LAS char* cA = (const LAS char*)sA; const LAS char* cB = (const LAS char*)sB;
#pragma unroll
    for (int ks = 0; ks < 4; ++ks) {
        bf16x8 af[4], bfr[4];
#pragma unroll
        for (int t = 0; t < 2; ++t) { }
#pragma unroll
        for (int m = 0; m < 4; ++m) {
            const int row0 = 32 * ks + 8 * fq + (fr >> 2), xr0 = ((fr >> 2) << 2) | ((2 * fq) & 3), xr1 = ((fr >> 2) << 2) | ((2 * fq + 1) & 3);
            const int chunk = 2 * (wr * 4 + m) + ((fr & 3) >> 1);
            const s16x4 lo_ = __builtin_amdgcn_ds_read_tr16_b64_v4i16((LAS s16x4*)(cA + row0 * 512 + 16 * (chunk ^ xr0) + 8 * (fr & 1)));
            const s16x4 hi_ = __builtin_amdgcn_ds_read_tr16_b64_v4i16((LAS s16x4*)(cA + (row0 + 4) * 512 + 16 * (chunk ^ xr1) + 8 * (fr & 1)));
            af[m] = __builtin_shufflevector(lo_, hi_, 0, 1, 2, 3, 4, 5, 6, 7);
        }
#pragma unroll
        for (int n = 0; n < 4; ++n) {
            const int row0 = 32 * ks + 8 * fq + (fr >> 2), xr0 = ((fr >> 2) << 2) | ((2 * fq) & 3), xr1 = ((fr >> 2) << 2) | ((2 * fq + 1) & 3);
            const int chunk = 2 * (wc * 4 + n) + ((fr & 3) >> 1);
            const s16x4 lo_ = __builtin_amdgcn_ds_read_tr16_b64_v4i16((LAS s16x4*)(cB + row0 * 256 + 16 * (chunk ^ xr0) + 8 * (fr & 1)));
            const s16x4 hi_ = __builtin_amdgcn_ds_read_tr16_b64_v4i16((LAS s16x4*)(cB + (row0 + 4) * 256 + 16 * (chunk ^ xr1) + 8 * (fr & 1)));
            bfr[n] = __builtin_shufflevector(lo_, hi_, 0, 1, 2, 3, 4, 5, 6, 7);
        }
#pragma unroll
        for (int m = 0; m < 4; ++m)
#pragma unroll
            for (int n = 0; n < 4; ++n) acc[m][n] = __builtin_amdgcn_mfma_f32_16x16x32_bf16(af[m], bfr[n], acc[m][n], 0, 0, 0);
    }
    __syncthreads();
}

__device__ __forceinline__ bool ksplit_reduce(Acc& acc, u16* lds) {
    const int tid = ltid(), lane = tid & 63;
    const int wid = __builtin_amdgcn_readfirstlane(tid >> 6);
    float* f = (float*)lds + (wid & 3) * 4096 + lane;
    if (wid >= 4) {
#pragma unroll
        for (int m = 0; m < 4; ++m)
#pragma unroll
            for (int n = 0; n < 4; ++n)
#pragma unroll
                for (int j = 0; j < 4; ++j) f[((m * 4 + n) * 4 + j) * 64] = acc[m][n][j];
    }
    __syncthreads();
    if (wid < 4) {
#pragma unroll
        for (int m = 0; m < 4; ++m)
#pragma unroll
            for (int n = 0; n < 4; ++n)
#pragma unroll
                for (int j = 0; j < 4; ++j) acc[m][n][j] += f[((m * 4 + n) * 4 + j) * 64];
    }
    return wid < 4;
}


#define STG_LD 68
#define STG_WAVE_BYTES (32 * STG_LD * 4)
#define WR0_ ((ltid() >> 7) * 64)
#define WC0_ (((ltid() >> 6) & 1) * 64)
template <class F>
__device__ __forceinline__ void stage_rows(Acc& acc, unsigned char* stage_base, F f) {
    const int tid = ltid(), lane = tid & 63, wid = tid >> 6, fr = lane & 15, fq = lane >> 4;
    float* st = (float*)(stage_base + wid * STG_WAVE_BYTES);
#pragma unroll
    for (int h = 0; h < 2; ++h) {
#pragma unroll
        for (int mm = 0; mm < 2; ++mm)
#pragma unroll
            for (int n = 0; n < 4; ++n)
#pragma unroll
                for (int j = 0; j < 4; ++j) st[(mm * 16 + fq * 4 + j) * STG_LD + n * 16 + fr] = acc[2 * h + mm][n][j];
        __builtin_amdgcn_s_waitcnt(0xc07f);
#pragma unroll
        for (int i = 0; i < 8; ++i) {
            const int r = (lane >> 4) + 4 * i, c4 = (lane & 15) * 4;
            const f32x4 v = *(const f32x4*)(st + r * STG_LD + c4);
            f(h * 32 + r, c4, v);
        }
        __builtin_amdgcn_s_waitcnt(0xc07f);
    }
}
template <class F>
__device__ __forceinline__ void stage_pairs(Acc& acc, unsigned char* stage_base, F f) {
    const int tid = ltid(), lane = tid & 63, wid = tid >> 6, fr = lane & 15, fq = lane >> 4;
    float* st = (float*)(stage_base + wid * STG_WAVE_BYTES);
#pragma unroll
    for (int h = 0; h < 2; ++h) {
#pragma unroll
        for (int mm = 0; mm < 2; ++mm)
#pragma unroll
            for (int n = 0; n < 4; ++n)
#pragma unroll
                for (int j = 0; j < 4; ++j) st[(mm * 16 + fq * 4 + j) * STG_LD + n * 16 + fr] = acc[2 * h + mm][n][j];
        __builtin_amdgcn_s_waitcnt(0xc07f);
#pragma unroll
        for (int i = 0; i < 4; ++i) {
            const int r = (lane >> 3) + 8 * i, c4 = (lane & 7) * 4;
            const f32x4 lo = *(const f32x4*)(st + r * STG_LD + c4);
            const f32x4 hi = *(const f32x4*)(st + r * STG_LD + c4 + 32);
            f(h * 32 + r, c4, lo, hi);
        }
        __builtin_amdgcn_s_waitcnt(0xc07f);
    }
}

template <class AUX, class PRE, class F>
__device__ __forceinline__ void stage_rows_pre(Acc& acc, unsigned char* stage_base, PRE pre, F f) {
    const int tid = ltid(), lane = tid & 63, wid = tid >> 6, fr = lane & 15, fq = lane >> 4;
    float* st = (float*)(stage_base + wid * STG_WAVE_BYTES);
#pragma unroll
    for (int h = 0; h < 2; ++h) {
        AUX aux[8];
#pragma unroll
        for (int i = 0; i < 8; ++i) aux[i] = pre(h * 32 + (lane >> 4) + 4 * i, (lane & 15) * 4);
#pragma unroll
        for (int mm = 0; mm < 2; ++mm)
#pragma unroll
            for (int n = 0; n < 4; ++n)
#pragma unroll
                for (int j = 0; j < 4; ++j) st[(mm * 16 + fq * 4 + j) * STG_LD + n * 16 + fr] = acc[2 * h + mm][n][j];
        __builtin_amdgcn_s_waitcnt(0xc07f);
        f32x4 v[8];
#pragma unroll
        for (int i = 0; i < 8; ++i) v[i] = *(const f32x4*)(st + ((lane >> 4) + 4 * i) * STG_LD + (lane & 15) * 4);
        asm volatile("" ::: "memory");
#pragma unroll
        for (int i = 0; i < 8; ++i) f(h * 32 + (lane >> 4) + 4 * i, (lane & 15) * 4, v[i], aux[i]);
        __builtin_amdgcn_s_waitcnt(0xc07f);
    }
}
template <class AUX, class PRE, class F>
__device__ __forceinline__ void stage_pairs_pre(Acc& acc, unsigned char* stage_base, PRE pre, F f) {
    const int tid = ltid(), lane = tid & 63, wid = tid >> 6, fr = lane & 15, fq = lane >> 4;
    float* st = (float*)(stage_base + wid * STG_WAVE_BYTES);
#pragma unroll
    for (int h = 0; h < 2; ++h) {
        AUX aux[4];
#pragma unroll
        for (int i = 0; i < 4; ++i) aux[i] = pre(h * 32 + (lane >> 3) + 8 * i, (lane & 7) * 4);
#pragma unroll
        for (int mm = 0; mm < 2; ++mm)
#pragma unroll
            for (int n = 0; n < 4; ++n)
#pragma unroll
                for (int j = 0; j < 4; ++j) st[(mm * 16 + fq * 4 + j) * STG_LD + n * 16 + fr] = acc[2 * h + mm][n][j];
        __builtin_amdgcn_s_waitcnt(0xc07f);
        f32x4 lo[4], hi[4];
#pragma unroll
        for (int i = 0; i < 4; ++i) {
            lo[i] = *(const f32x4*)(st + ((lane >> 3) + 8 * i) * STG_LD + (lane & 7) * 4);
            hi[i] = *(const f32x4*)(st + ((lane >> 3) + 8 * i) * STG_LD + (lane & 7) * 4 + 32);
        }
        asm volatile("" ::: "memory");
#pragma unroll
        for (int i = 0; i < 4; ++i) f(h * 32 + (lane >> 3) + 8 * i, (lane & 7) * 4, lo[i], hi[i], aux[i]);
        __builtin_amdgcn_s_waitcnt(0xc07f);
    }
}
__device__ __forceinline__ u32x2 pack4(f32x4 v) { u32x2 w; w.x = pack2(v[0], v[1]); w.y = pack2(v[2], v[3]); return w; }

struct Params {
    const float* x; const int* pos; const float* router_w; const float* router_b;
    const float* w_in0; const float* q_norm; const float* w_uq; const float* kv_norm; const float* w_ukv; const float* w_out0;
    const float* w_in1; const float* gn_g; const float* gn_b; const float* w_out1;
    const float* ln_mix_g[2]; const float* ln_mix_b[2];
    const float* moe_wg[2]; const float* moe_wu[2]; const float* moe_wd[2];
    const float* sh_g[2]; const float* sh_u[2]; const float* sh_d[2];
    const float* ln_ffn_g[2]; const float* ln_ffn_b[2];
    float* out;
    u16* w_in0b; u16* w_uqb; u16* w_ukvb; u16* w_out0b; u16* w_in1b; u16* w_out1b; u16* w_out1t; u16* w_out0t; u16* w_in1t; u16* w_in0t; u16* sh_gut[2]; u16* sh_dt[2]; u16* sh_gb[2]; u16* sh_ub[2]; u16* sh_db[2];
    unsigned* bar; unsigned* ctl;
    float* cosA; float* sinA; float* cosR; float* sinR;
    u16* xb; u16* H0;
    u16* cqn; u16* ckvn; u16* kpe; u16* qb; u16* kb; u16* vb; u16* iqb; u16* ikb; float* iwf;
    u16* qa; u16* ka; u16* vaT;
    float* scores; u16* sel; u16* outcat; float* mla_po; float* mla_ml;
    u16* ybuf; u16* xab; u16* xlb; u16* whT; u16* wlT; u16* y2; u16* xcb;
    int* tok_e; float* tok_g; int* list; u16* hbuf; u16* hsh; u16* yr;
    u16* qr; u16* qx; u16* kr; u16* kzT; u16* v1; u16* kz; u16* sg; u16* KVt; u16* innerG; u16* obuf; u16* gated;
    int out_size; int pad_;
};
typedef const __attribute__((address_space(4))) Params* KP;
__device__ __forceinline__ KP getp() { KP kp = (KP)__builtin_amdgcn_kernarg_segment_ptr(); asm volatile("" : "+s"(kp)); return kp; }
#define CTL_FLAGS 0
#define CTL_QUEUE 16
#define CNT_STRIDE 32
#define CTL_CNT0 64
#define CTL_CNT1 (64 + 64 * CNT_STRIDE)
#define CTL_CNTX (64 + 128 * CNT_STRIDE)
#define CTL_WORDS (64 + 192 * CNT_STRIDE)

struct RowId { int base; __device__ __forceinline__ int operator()(int r) const { return base + r; } };
struct ColOff { int c0;
    __device__ __forceinline__ const u16* base16(const u16* B, int) const { return B; }
    __device__ __forceinline__ unsigned off8(int hsel, int ch8) const { return (unsigned)(c0 + hsel * 64 + ch8 * 8); }
    __device__ __forceinline__ int vchunk(int hsel, int ch8) const { return hsel * 8 + ch8; }
    __device__ __forceinline__ const float* base(const float* B, int) const { return B; }
    __device__ __forceinline__ unsigned off4(int hsel, int g4) const { return (unsigned)(c0 + hsel * 64 + g4 * 4); }
    __device__ __forceinline__ int vcol4(int hsel, int g4) const { return hsel * 64 + g4 * 4; } };
struct ColClampOff { int c0, n;
    __device__ __forceinline__ const u16* base16(const u16* B, int) const { return B; }
    __device__ __forceinline__ unsigned off8(int hsel, int ch8) const { const int c = c0 + hsel * 64 + ch8 * 8; return (unsigned)(c < n - 8 ? c : n - 8); }
    __device__ __forceinline__ int vchunk(int hsel, int ch8) const { return hsel * 8 + ch8; }
    __device__ __forceinline__ const float* base(const float* B, int) const { return B; }
    __device__ __forceinline__ unsigned off4(int hsel, int g4) const { const int c = c0 + hsel * 64 + g4 * 4; return (unsigned)(c < n - 4 ? c : n - 4); }
    __device__ __forceinline__ int vcol4(int hsel, int g4) const { return hsel * 64 + g4 * 4; } };

__device__ __forceinline__ void ph_prep(KP p) {
    const int gtid = blockIdx.x * NT + ltid(), gsz = gridDim.x * NT;
    for (size_t i = gtid; i < (size_t)T_ * D_ / 4; i += gsz) {
        float4 v = ((const float4*)p->x)[i];
        u32x2 o; o.x = pack2(v.x, v.y); o.y = pack2(v.z, v.w);
        ((u32x2*)p->xb)[i] = o;
    }
    for (int idx = gtid; idx < D_ * 64; idx += gsz) {
        const int k = idx >> 6, e = idx & 63;
        const float w = p->router_w[idx];
        const u16 hi = f2bf(w);
        p->whT[(size_t)e * D_ + k] = hi;
        p->wlT[(size_t)e * D_ + k] = f2bf(w - bf2f(hi));
    }
    {
        auto cvt = [&](const float* src, u16* dst, size_t n) {
            for (size_t i = gtid; i < n / 8; i += gsz) {
                const f32x4 a = ((const f32x4*)src)[2 * i], b = ((const f32x4*)src)[2 * i + 1];
                u32x4 o; o.x = pack2(a[0], a[1]); o.y = pack2(a[2], a[3]); o.z = pack2(b[0], b[1]); o.w = pack2(b[2], b[3]);
                ((u32x4*)dst)[i] = o;
            }
        };
        cvt(p->w_uq, p->w_uqb, (size_t)512 * 1536);
        cvt(p->w_ukv, p->w_ukvb, (size_t)256 * 2048);
    }
    const double inv2pi = 0.15915494309189535;
    for (int idx = gtid; idx < T_ * 32; idx += gsz) {
        const int t = idx >> 5, i = idx & 31;
        const float inv = (float)exp2(-(double)i * (18.931568569324174 / 32.0));
        double rev = (double)p->pos[t] * (double)inv * inv2pi;
        rev -= floor(rev);
        p->cosA[idx] = __builtin_amdgcn_cosf((float)rev);
        p->sinA[idx] = __builtin_amdgcn_sinf((float)rev);
    }
    for (int idx = gtid; idx < T_ * 128; idx += gsz) {
        const int t = idx >> 7, i = idx & 127;
        const float inv = (float)exp2(-(double)i * (13.287712379549449 / 128.0));
        double rev = (double)p->pos[t] * (double)inv * inv2pi;
        rev -= floor(rev);
        p->cosR[idx] = __builtin_amdgcn_cosf((float)rev);
        p->sinR[idx] = __builtin_amdgcn_sinf((float)rev);
    }
}

struct EpiF32 {
    float* C; int ldc; int row0, col0, ncols;
    __device__ __forceinline__ void operator()(Acc& acc, unsigned char* stg) const {
        const int rb = row0 + WR0_, cb = col0 + WC0_;
        float* Cp = C; const int ld = ldc, nc = ncols;
        stage_rows(acc, stg, [=](int r, int c4, f32x4 v) {
            const int c = cb + c4;
            if (c < nc) *(f32x4*)(Cp + (size_t)(rb + r) * ld + c) = v;
        });
    }
};
struct EpiBF16N {
    u16* C; int ldc; int row0, col0, ncols;
    __device__ __forceinline__ void operator()(Acc& acc, unsigned char* stg) const {
        const int rb = row0 + WR0_, cb = col0 + WC0_;
        u16* Cp = C; const int ld = ldc, nc = ncols;
        stage_rows(acc, stg, [=](int r, int c4, f32x4 v) {
            const int c = cb + c4;
            if (c < nc) *(u32x2*)(Cp + (size_t)(rb + r) * ld + c) = pack4(v);
        });
    }
};
struct EpiBF16 {
    u16* C; int ldc; int row0, col0;
    __device__ __forceinline__ void operator()(Acc& acc, unsigned char* stg) const {
        const int rb = row0 + WR0_, cb = col0 + WC0_;
        u16* Cp = C; const int ld = ldc;
        stage_rows(acc, stg, [=](int r, int c4, f32x4 v) { *(u32x2*)(Cp + (size_t)(rb + r) * ld + cb + c4) = pack4(v); });
    }
};
template <bool XB>
struct EpiResid {
    u16* C; const void* X; int ldc; int row0, col0;
    __device__ __forceinline__ void operator()(Acc& acc, unsigned char* stg) const {
        const int rb = row0 + WR0_, cb = col0 + WC0_;
        u16* Cp = C; const void* Xp = X; const int ld = ldc;
        stage_rows_pre<f32x4>(acc, stg,
            [=](int r, int c4) -> f32x4 {
                const size_t o = (size_t)(rb + r) * ld + cb + c4;
                f32x4 x;
                if constexpr (XB) {
                    const u32x2 xr = *(const u32x2*)((const u16*)Xp + o);
                    x[0] = __uint_as_float(xr.x << 16); x[1] = __uint_as_float(xr.x & 0xffff0000u);
                    x[2] = __uint_as_float(xr.y << 16); x[3] = __uint_as_float(xr.y & 0xffff0000u);
                } else x = *(const f32x4*)((const float*)Xp + o);
                return x; },
            [=](int r, int c4, f32x4 v, f32x4 x) {
                *(u32x2*)(Cp + (size_t)(rb + r) * ld + cb + c4) = pack4(x * ALPHA_ + v); });
    }
};

__device__ __forceinline__ void ph_post0(KP p) {
    const int lane = ltid() & 63;
    const int gw = (blockIdx.x * NT + ltid()) >> 6, nw = (gridDim.x * NT) >> 6;
    const float qscale = 0.08838834764831845f * LOG2E_;
    for (int t = gw; t < T_; t += nw) {
        const u16* hb = p->H0 + (size_t)t * IN_AB;
#define h_(i) bf2f(hb[i])
        const float* ca = p->cosA + t * 32;
        const float* sa = p->sinA + t * 32;
        {
            float v[8]; float ss = 0.f;
#pragma unroll
            for (int j = 0; j < 8; ++j) { v[j] = h_(lane + 64 * j); ss += v[j] * v[j]; }
            ss = wave_sum(ss);
            const float r = rsqrtf(ss * (1.f / 512.f) + 1e-6f);
#pragma unroll
            for (int j = 0; j < 8; ++j) p->cqn[(size_t)t * 512 + lane + 64 * j] = f2bf(v[j] * r * p->q_norm[lane + 64 * j]);
        }
        {
            float v[4]; float ss = 0.f;
#pragma unroll
            for (int j = 0; j < 4; ++j) { v[j] = h_(512 + lane + 64 * j); ss += v[j] * v[j]; }
            ss = wave_sum(ss);
            const float r = rsqrtf(ss * (1.f / 256.f) + 1e-6f);
#pragma unroll
            for (int j = 0; j < 4; ++j) p->ckvn[(size_t)t * 256 + lane + 64 * j] = f2bf(v[j] * r * p->kv_norm[lane + 64 * j]);
        }
        {
            const int i = lane & 31;
            const float c = ca[i], s = sa[i];
            const float x1 = h_(768 + i), x2 = h_(768 + 32 + i);
            p->kpe[(size_t)t * 64 + lane] = f2bf(lane < 32 ? x1 * c - x2 * s : x1 * s + x2 * c);
        }
#pragma unroll 4
        for (int j = 0; j < 16; ++j) {
            const int e = lane + 64 * j, hd = e >> 7, d = e & 127;
            float o;
            if (d < 32) {
                const int i = d & 15;
                const float c = ca[2 * i], s = sa[2 * i];
                const float x1 = h_(832 + hd * 128 + i), x2 = h_(832 + hd * 128 + 16 + i);
                o = d < 16 ? x1 * c - x2 * s : x1 * s + x2 * c;
            } else o = h_(832 + e);
            p->qb[(size_t)t * 1024 + e] = f2bf(o * qscale);
        }
#pragma unroll
        for (int j = 0; j < 4; ++j) {
            const int e = lane + 64 * j, hd = e >> 7, d = e & 127;
            float o;
            if (d < 32) {
                const int i = d & 15;
                const float c = ca[2 * i], s = sa[2 * i];
                const float x1 = h_(1856 + hd * 128 + i), x2 = h_(1856 + hd * 128 + 16 + i);
                o = d < 16 ? x1 * c - x2 * s : x1 * s + x2 * c;
            } else o = h_(1856 + e);
            p->kb[(size_t)t * 256 + e] = f2bf(o);
            p->vb[(size_t)t * 256 + e] = f2bf(h_(2112 + e));
        }
#pragma unroll 4
        for (int j = 0; j < 16; ++j) {
            const int e = lane + 64 * j, hd = e >> 6, d = e & 63;
            float o;
            if (d < 16) {
                const int i = d & 7;
                const float c = ca[4 * i], s = sa[4 * i];
                const float x1 = h_(2368 + hd * 64 + i), x2 = h_(2368 + hd * 64 + 8 + i);
                o = d < 8 ? x1 * c - x2 * s : x1 * s + x2 * c;
            } else o = h_(2368 + e);
            p->iqb[(size_t)t * 1024 + e] = f2bf(o);
        }
        {
            const int d = lane;
            float o;
            if (d < 16) {
                const int i = d & 7;
                const float c = ca[4 * i], s = sa[4 * i];
                const float x1 = h_(3392 + i), x2 = h_(3392 + 8 + i);
                o = d < 8 ? x1 * c - x2 * s : x1 * s + x2 * c;
            } else o = h_(3392 + d);
            p->ikb[(size_t)t * 64 + d] = f2bf(o);
        }
        if (lane < 16) p->iwf[t * 16 + lane] = h_(3456 + lane) * 0.03125f;
    }
#undef h_
}

struct CS8 { f32x4 c, s; };
struct EpiQa {
    u16* C; const float* ca; const float* sa; int row0, col0;
    __device__ __forceinline__ void operator()(Acc& acc, unsigned char* stg) const {
        const float sc = 0.07216878364870323f * LOG2E_;
        const int rb = row0 + WR0_, cbase = col0 + WC0_;
        const bool rope = (cbase % 192) == 128;
        u16* Cp = C; const float* cap = ca; const float* sap = sa;
        stage_pairs_pre<CS8>(acc, stg,
            [=](int r, int c4) -> CS8 {
                CS8 t; t.c = (f32x4){1.f, 1.f, 1.f, 1.f}; t.s = (f32x4){0.f, 0.f, 0.f, 0.f};
                if (rope) { t.c = *(const f32x4*)(cap + (rb + r) * 32 + c4); t.s = *(const f32x4*)(sap + (rb + r) * 32 + c4); }
                return t; },
            [=](int r, int c4, f32x4 lo, f32x4 hi, CS8 t) {
                const int tt = rb + r;
                const f32x4 a = lo * t.c - hi * t.s, b = lo * t.s + hi * t.c;
                *(u32x2*)(Cp + (size_t)tt * 1536 + cbase + c4) = pack4(a * sc);
                *(u32x2*)(Cp + (size_t)tt * 1536 + cbase + c4 + 32) = pack4(b * sc); });
    }
};
struct EpiKva {
    u16* ka; u16* vaT; int row0, col0;
    __device__ __forceinline__ void operator()(Acc& acc, unsigned char* stg) const {
        const int cbase = col0 + WC0_;
        const int hd = cbase >> 8, within = cbase & 255;
        if (within < 128) {
            const int rb = row0 + WR0_;
            u16* kp = ka + hd * 128 + within;
            stage_rows(acc, stg, [=](int r, int c4, f32x4 v) { *(u32x2*)(kp + (size_t)(rb + r) * 1024 + c4) = pack4(v); });
        } else {
            const int lane = ltid() & 63, fr = lane & 15, fq = lane >> 4;
#pragma unroll
            for (int m = 0; m < 4; ++m) {
                const int r = row0 + WR0_ + m * 16 + fq * 4;
#pragma unroll
                for (int n = 0; n < 4; ++n) {
                    const int c = within - 128 + n * 16 + fr;
                    u32x2 o; o.x = pack2(acc[m][n][0], acc[m][n][1]); o.y = pack2(acc[m][n][2], acc[m][n][3]);
                    *(u32x2*)(vaT + (size_t)(hd * 128 + c) * T_ + r) = o;
                }
            }
        }
    }
};

__device__ __forceinline__ void indexer_tile(KP p, int qt, int kt) {
    const int lane = ltid() & 63, wid = (ltid() >> 6) & 3;
    const int wr = wid >> 1, wc = wid & 1, fr = lane & 15, fq = lane >> 4;
    const int k0 = kt * 128 + wr * 64, q0 = qt * 128 + wc * 64;
    bf16x8 af[4][2];
#pragma unroll
    for (int m = 0; m < 4; ++m)
#pragma unroll
        for (int ks = 0; ks < 2; ++ks)
            af[m][ks] = *(const bf16x8*)(p->ikb + (size_t)(k0 + m * 16 + fr) * 64 + ks * 32 + fq * 8);
    Acc sc; acc_zero(sc);
    for (int h = 0; h < 16; ++h) {
        bf16x8 bq[4][2]; float w[4];
#pragma unroll
        for (int n = 0; n < 4; ++n) {
            const size_t qrow = (size_t)(q0 + n * 16 + fr);
            bq[n][0] = *(const bf16x8*)(p->iqb + qrow * 1024 + h * 64 + fq * 8);
            bq[n][1] = *(const bf16x8*)(p->iqb + qrow * 1024 + h * 64 + 32 + fq * 8);
            w[n] = p->iwf[qrow * 16 + h];
        }
#pragma unroll
        for (int m = 0; m < 4; ++m)
#pragma unroll
            for (int n = 0; n < 4; ++n) {
                f32x4 d = (f32x4){0.f, 0.f, 0.f, 0.f};
                d = __builtin_amdgcn_mfma_f32_16x16x32_bf16(af[m][0], bq[n][0], d, 0, 0, 0);
                d = __builtin_amdgcn_mfma_f32_16x16x32_bf16(af[m][1], bq[n][1], d, 0, 0, 0);
#pragma unroll
                for (int j = 0; j < 4; ++j) sc[m][n][j] += w[n] * fmaxf(d[j], 0.f);
            }
    }
#pragma unroll
    for (int m = 0; m < 4; ++m)
#pragma unroll
        for (int n = 0; n < 4; ++n)
            *(f32x4*)(p->scores + (size_t)(q0 + n * 16 + fr) * T_ + k0 + m * 16 + fq * 4) = sc[m][n];
}

__device__ __forceinline__ unsigned fkey(float f) {
    const unsigned u = __float_as_uint(f);
    return (u & 0x80000000u) ? ~u : (u | 0x80000000u);
}
#define TOPK_WLDS (1024 * 4 + 1024 * 2)
__device__ __forceinline__ void ph_topk(KP p, unsigned char* smem) {
    const int lane = ltid() & 63, wid = ltid() >> 6;
    const int gw = __builtin_amdgcn_readfirstlane((blockIdx.x * NT + ltid()) >> 6), nw = (gridDim.x * NT) >> 6;
    unsigned* ckey = (unsigned*)(smem + wid * TOPK_WLDS);
    u16* cidx = (u16*)(smem + wid * TOPK_WLDS + 4096);
    for (int qq = gw; qq < T_ / 2; qq += nw)
    for (int sside = 0; sside < 2; ++sside) {
        const int q = sside ? (T_ - 1 - qq) : qq;
        u16* so = p->sel + (size_t)q * 256;
        if (q < 256) {
#pragma unroll
            for (int i = 0; i < 4; ++i) { const int s = lane + 64 * i; so[s] = (u16)(s <= q ? s : 0); }
            continue;
        }
        const int ng = (q >> 10) + 1;
        unsigned key[128];
        const float* row = p->scores + (size_t)q * T_;
#pragma unroll
        for (int g = 0; g < 8; ++g) {
            if (g < ng) {
#pragma unroll
                for (int i = 0; i < 16; ++i) {
                    const int idx = lane + 64 * (g * 16 + i);
                    key[g * 16 + i] = idx <= q ? fkey(row[idx]) : 0u;
                }
            } else {
#pragma unroll
                for (int i = 0; i < 16; ++i) key[g * 16 + i] = 0u;
            }
        }
        unsigned prefix = 0u;
        int C = q + 1, b = 31;
        bool exact = false;
        for (; b >= 0 && C > 1024; --b) {
            const unsigned cand = prefix | (1u << b);
            int cnt = 0;
#pragma unroll
            for (int g = 0; g < 8; ++g) {
                if (g < ng) {
#pragma unroll
                    for (int i = 0; i < 16; ++i) cnt += __builtin_popcountll(__ballot(key[g * 16 + i] >= cand));
                }
            }
            if (cnt >= 256) { prefix = cand; C = cnt; }
            if (cnt == 256) { exact = true; --b; break; }
        }
        if (C > 1024) {
            int wp = 0;
#pragma unroll
            for (int g = 0; g < 8; ++g) {
                if (g < ng) {
#pragma unroll
                    for (int i = 0; i < 16; ++i) {
                        const bool gt = key[g * 16 + i] > prefix;
                        const unsigned long long m = __ballot(gt);
                        if (gt) so[wp + (int)__builtin_amdgcn_mbcnt_hi((unsigned)(m >> 32), __builtin_amdgcn_mbcnt_lo((unsigned)m, 0u))] = (u16)(lane + 64 * (g * 16 + i));
                        wp += __builtin_popcountll(m);
                    }
                }
            }
#pragma unroll
            for (int g = 0; g < 8; ++g) {
                if (g < ng && wp < 256) {
#pragma unroll
                    for (int i = 0; i < 16; ++i) {
                        const bool eq = key[g * 16 + i] == prefix && (lane + 64 * (g * 16 + i)) <= q;
                        const unsigned long long m = __ballot(eq);
                        if (eq) {
                            const int pos = wp + (int)__builtin_amdgcn_mbcnt_hi((unsigned)(m >> 32), __builtin_amdgcn_mbcnt_lo((unsigned)m, 0u));
                            if (pos < 256) so[pos] = (u16)(lane + 64 * (g * 16 + i));
                        }
                        wp += __builtin_popcountll(m);
                    }
                }
            }
            continue;
        }
        int base = 0;
#pragma unroll
        for (int g = 0; g < 8; ++g) {
            if (g < ng) {
#pragma unroll
                for (int i = 0; i < 16; ++i) {
                    const bool ge = key[g * 16 + i] >= prefix && (lane + 64 * (g * 16 + i)) <= q;
                    const unsigned long long m = __ballot(ge);
                    if (ge) {
                        const int pos = base + (int)__builtin_amdgcn_mbcnt_hi((unsigned)(m >> 32), __builtin_amdgcn_mbcnt_lo((unsigned)m, 0u));
                        ckey[pos] = key[g * 16 + i]; cidx[pos] = (u16)(lane + 64 * (g * 16 + i));
                    }
                    base += __builtin_popcountll(m);
                }
            }
        }
        __builtin_amdgcn_s_waitcnt(0xc07f);
        unsigned ck[16];
#pragma unroll
        for (int i = 0; i < 16; ++i) {
            const int s = lane + 64 * i;
            ck[i] = s < base ? ckey[s] : 0u;
        }
        if (!exact) {
            for (; b >= 0; --b) {
                const unsigned cand = prefix | (1u << b);
                int cnt = 0;
#pragma unroll
                for (int i = 0; i < 16; ++i) cnt += __builtin_popcountll(__ballot(ck[i] >= cand));
                if (cnt >= 256) prefix = cand;
                if (cnt == 256) break;
            }
        }
        int wpos = 0;
#pragma unroll
        for (int i = 0; i < 16; ++i) {
            const bool gt = ck[i] > prefix;
            const unsigned long long m = __ballot(gt);
            if (gt) so[wpos + (int)__builtin_amdgcn_mbcnt_hi((unsigned)(m >> 32), __builtin_amdgcn_mbcnt_lo((unsigned)m, 0u))] = cidx[lane + 64 * i];
            wpos += __builtin_popcountll(m);
        }
#pragma unroll
        for (int i = 0; i < 16; ++i) {
            if (wpos < 256) {
                const bool eq = ck[i] == prefix && (lane + 64 * i) < base;
                const unsigned long long m = __ballot(eq);
                if (eq) {
                    const int pos = wpos + (int)__builtin_amdgcn_mbcnt_hi((unsigned)(m >> 32), __builtin_amdgcn_mbcnt_lo((unsigned)m, 0u));
                    if (pos < 256) so[pos] = cidx[lane + 64 * i];
                }
                wpos += __builtin_popcountll(m);
            }
        }
        __builtin_amdgcn_s_waitcnt(0xc07f);
    }
}

#define KROW 208
#define VROW 80
#define ATT_LDS_BYTES (64 * KROW * 2 + 128 * VROW * 2)

__device__ __forceinline__ void mla_item(KP p, int h, int qb, u16* lds, int seg) {
    const int tid = ltid(), lane = tid & 63, wid = tid >> 6, fr = lane & 15, fq = lane >> 4;
    u16* sK = lds;
    u16* sV = lds + 64 * KROW;
    const int q0 = qb * 256;
    bf16x8 qf[2][6];
#pragma unroll
    for (int nq = 0; nq < 2; ++nq)
#pragma unroll
        for (int kc = 0; kc < 6; ++kc)
            qf[nq][kc] = *(const bf16x8*)(p->qa + (size_t)(q0 + wid * 32 + nq * 16 + fr) * 1536 + h * 192 + kc * 32 + fq * 8);
    f32x4 O[8][2];
#pragma unroll
    for (int m = 0; m < 8; ++m) { O[m][0] = (f32x4){0.f, 0.f, 0.f, 0.f}; O[m][1] = (f32x4){0.f, 0.f, 0.f, 0.f}; }
    float mrun[2] = {-1e30f, -1e30f}, lrun[2] = {0.f, 0.f};

    const int k0t = tid >> 4, k1t = tid >> 3;
    const u16* kpn = p->ka + (size_t)k0t * 1024 + h * 128 + (tid & 15) * 8;
    const u16* kpr = p->kpe + (size_t)k1t * 64 + (tid & 7) * 8;
    const u16* vpp = p->vaT + (size_t)(h * 128 + k1t) * T_ + (tid & 7) * 8;
    const int kln = (((k0t >> 2) & 1) * 16 + (k0t >> 3) * 4 + (k0t & 3)) * KROW + (tid & 15) * 8;
    const int e1 = k1t & 31;
    const int klr = ((k1t >> 5) * 32 + ((e1 >> 2) & 1) * 16 + (e1 >> 3) * 4 + (e1 & 3)) * KROW + 128 + (tid & 7) * 8;
    const int vl0 = k1t * VROW + (tid & 7) * 8;
    u32x4 kreg[3], vreg[2];
    const int ntiles = 4 * qb + 4;
    const int kt_lo = seg == 1 ? ntiles / 2 : 0, kt_hi = seg == 0 ? ntiles / 2 : ntiles;
#define ATT_GLOAD(kt) do { \
    _Pragma("unroll") for (int i = 0; i < 2; ++i) kreg[i] = *(const u32x4*)(kpn + (size_t)((kt) * 64 + 32 * i) * 1024); \
    kreg[2] = *(const u32x4*)(kpr + (size_t)((kt) * 64) * 64); \
    _Pragma("unroll") for (int i = 0; i < 2; ++i) vreg[i] = *(const u32x4*)(vpp + (size_t)(64 * i) * T_ + (kt) * 64); } while (0)
    ATT_GLOAD(kt_lo);
    for (int kt = kt_lo; kt < kt_hi; ++kt) {
#pragma unroll
        for (int i = 0; i < 2; ++i) *(u32x4*)(sK + kln + 32 * i * KROW) = kreg[i];
        *(u32x4*)(sK + klr) = kreg[2];
#pragma unroll
        for (int i = 0; i < 2; ++i) *(u32x4*)(sV + vl0 + 64 * i * VROW) = vreg[i];
        __syncthreads();
        if (kt + 1 < kt_hi) ATT_GLOAD(kt + 1);
        if (kt * 64 > q0 + wid * 32 + 31) { __syncthreads(); continue; }
        f32x4 s[2][4];
#pragma unroll
        for (int n = 0; n < 4; ++n) { s[0][n] = (f32x4){0.f, 0.f, 0.f, 0.f}; s[1][n] = (f32x4){0.f, 0.f, 0.f, 0.f}; }
#pragma unroll
        for (int kc = 0; kc < 6; ++kc)
#pragma unroll
            for (int n = 0; n < 4; ++n) {
                const bf16x8 a = *(const bf16x8*)(sK + (n * 16 + fr) * KROW + kc * 32 + fq * 8);
                s[0][n] = __builtin_amdgcn_mfma_f32_16x16x32_bf16(a, qf[0][kc], s[0][n], 0, 0, 0);
                s[1][n] = __builtin_amdgcn_mfma_f32_16x16x32_bf16(a, qf[1][kc], s[1][n], 0, 0, 0);
            }
        if (kt >= ntiles - 4) {
#pragma unroll
            for (int nq = 0; nq < 2; ++nq) {
                const int qi = q0 + wid * 32 + nq * 16 + fr;
#pragma unroll
                for (int n = 0; n < 4; ++n)
#pragma unroll
                    for (int j = 0; j < 4; ++j) {
                        const int ki = kt * 64 + (n >> 1) * 32 + fq * 8 + (n & 1) * 4 + j;
                        if (ki > qi) s[nq][n][j] = -1e30f;
                    }
            }
        }
        bf16x8 pf[2][2];
#pragma unroll
        for (int nq = 0; nq < 2; ++nq) {
            float mx = -1e30f;
#pragma unroll
            for (int n = 0; n < 4; ++n)
#pragma unroll
                for (int j = 0; j < 4; ++j) mx = fmaxf(mx, s[nq][n][j]);
            mx = fmaxf(mx, __shfl_xor(mx, 16));
            mx = fmaxf(mx, __shfl_xor(mx, 32));
            const float mnew = fmaxf(mrun[nq], mx);
            const float al = __builtin_amdgcn_exp2f(mrun[nq] - mnew);
            mrun[nq] = mnew;
            float ps = 0.f;
#pragma unroll
            for (int n = 0; n < 4; ++n)
#pragma unroll
                for (int j = 0; j < 4; ++j) { const float e = __builtin_amdgcn_exp2f(s[nq][n][j] - mnew); s[nq][n][j] = e; ps += e; }
            lrun[nq] = lrun[nq] * al + ps;
            if (__ballot(al != 1.0f) != 0ull) {
#pragma unroll
                for (int m = 0; m < 8; ++m) O[m][nq] *= al;
            }
#pragma unroll
            for (int c = 0; c < 2; ++c) {
                u32x4 w;
                w.x = pack2(s[nq][2 * c][0], s[nq][2 * c][1]);
                w.y = pack2(s[nq][2 * c][2], s[nq][2 * c][3]);
                w.z = pack2(s[nq][2 * c + 1][0], s[nq][2 * c + 1][1]);
                w.w = pack2(s[nq][2 * c + 1][2], s[nq][2 * c + 1][3]);
                pf[nq][c] = *(bf16x8*)&w;
            }
        }
#pragma unroll
        for (int m = 0; m < 8; ++m)
#pragma unroll
            for (int c = 0; c < 2; ++c) {
                const bf16x8 a = *(const bf16x8*)(sV + (m * 16 + fr) * VROW + c * 32 + fq * 8);
                O[m][0] = __builtin_amdgcn_mfma_f32_16x16x32_bf16(a, pf[0][c], O[m][0], 0, 0, 0);
                O[m][1] = __builtin_amdgcn_mfma_f32_16x16x32_bf16(a, pf[1][c], O[m][1], 0, 0, 0);
            }
        __syncthreads();
    }
#undef ATT_GLOAD
#pragma unroll
    for (int nq = 0; nq < 2; ++nq) {
        float l = lrun[nq];
        l += __shfl_xor(l, 16);
        l += __shfl_xor(l, 32);
        const int qi = q0 + wid * 32 + nq * 16 + fr;
        if (seg < 0) {
            const float il = 1.f / l;
#pragma unroll
            for (int m = 0; m < 8; ++m) {
                u32x2 o;
                o.x = pack2(O[m][nq][0] * il, O[m][nq][1] * il);
                o.y = pack2(O[m][nq][2] * il, O[m][nq][3] * il);
                *(u32x2*)(p->outcat + (size_t)qi * 2048 + h * 128 + m * 16 + fq * 4) = o;
            }
        } else {
            const size_t slot = (size_t)((h * 16 + (qb - 16)) * 2 + seg);
            float* po = p->mla_po + (slot * 256 + (qi - q0)) * 128;
#pragma unroll
            for (int m = 0; m < 8; ++m) *(f32x4*)(po + m * 16 + fq * 4) = O[m][nq];
            if (fq == 0) { p->mla_ml[(slot * 256 + (qi - q0)) * 2] = mrun[nq]; p->mla_ml[(slot * 256 + (qi - q0)) * 2 + 1] = l; }
        }
    }
}

__device__ __forceinline__ void ph_mla_merge(KP p) {
    const int gtid = blockIdx.x * NT + ltid(), gsz = gridDim.x * NT;
    for (int i = gtid; i < 128 * 256 * 32; i += gsz) {
        const int d4 = i & 31, qq = (i >> 5) & 255, item = i >> 13;
        const int h = item >> 4, qb = 16 + (item & 15);
        const size_t s0 = (size_t)(item * 2) * 256 + qq, s1 = s0 + 256;
        const float m0 = p->mla_ml[s0 * 2], l0 = p->mla_ml[s0 * 2 + 1], m1 = p->mla_ml[s1 * 2], l1 = p->mla_ml[s1 * 2 + 1];
        const float m = fmaxf(m0, m1);
        const float w0 = __builtin_amdgcn_exp2f(m0 - m), w1 = __builtin_amdgcn_exp2f(m1 - m);
        const float il = 1.f / (l0 * w0 + l1 * w1);
        const f32x4 a = *(const f32x4*)(p->mla_po + s0 * 128 + d4 * 4), b = *(const f32x4*)(p->mla_po + s1 * 128 + d4 * 4);
        const f32x4 o = (a * w0 + b * w1) * il;
        *(u32x2*)(p->outcat + (size_t)(qb * 256 + qq) * 2048 + h * 128 + d4 * 4) = pack4(o);
    }
}

#define DSA_WLDS 5632
__device__ __forceinline__ void dsa_task(KP p, int q, int g, unsigned char* wl) {
    const int lane = ltid() & 63;
    u16* sQ = (u16*)wl;
    float* sP = (float*)(wl + 1024);
    u16* sS = (u16*)(wl + 1024 + 4096);
    const int nsel = q < 255 ? q + 1 : 256;
    {
        const u16* qsrc = p->qb + (size_t)q * 1024 + g * 512;
        *(u32x4*)(sQ + lane * 8) = *(const u32x4*)(qsrc + lane * 8);
        *(u32x2*)(sS + lane * 4) = *(const u32x2*)(p->sel + (size_t)q * 256 + lane * 4);
    }
    __builtin_amdgcn_s_waitcnt(0);
    float sc[4][4];
    float mx[4] = {-1e30f, -1e30f, -1e30f, -1e30f};
#pragma unroll
    for (int r = 0; r < 4; ++r) {
        const int slot = lane + 64 * r;
        float a0 = 0.f, a1 = 0.f, a2 = 0.f, a3 = 0.f;
        if (slot < nsel) {
            const int ki = sS[slot];
            const u16* kr = p->kb + (size_t)ki * 256 + g * 128;
#pragma unroll
            for (int c = 0; c < 16; ++c) {
                const u32x4 kv = *(const u32x4*)(kr + c * 8);
                const u32x4 q0v = *(const u32x4*)(sQ + 0 * 128 + c * 8);
                const u32x4 q1v = *(const u32x4*)(sQ + 1 * 128 + c * 8);
                const u32x4 q2v = *(const u32x4*)(sQ + 2 * 128 + c * 8);
                const u32x4 q3v = *(const u32x4*)(sQ + 3 * 128 + c * 8);
#pragma unroll
                for (int e = 0; e < 4; ++e) {
                    const unsigned kk = kv[e];
                    const bf16x2_t kb2 = *(const bf16x2_t*)&kk;
                    unsigned t0 = q0v[e], t1 = q1v[e], t2 = q2v[e], t3 = q3v[e];
                    a0 = __builtin_amdgcn_fdot2_f32_bf16(kb2, *(const bf16x2_t*)&t0, a0, false);
                    a1 = __builtin_amdgcn_fdot2_f32_bf16(kb2, *(const bf16x2_t*)&t1, a1, false);
                    a2 = __builtin_amdgcn_fdot2_f32_bf16(kb2, *(const bf16x2_t*)&t2, a2, false);
                    a3 = __builtin_amdgcn_fdot2_f32_bf16(kb2, *(const bf16x2_t*)&t3, a3, false);
                }
            }
        } else { a0 = a1 = a2 = a3 = -1e30f; }
        sc[r][0] = a0; sc[r][1] = a1; sc[r][2] = a2; sc[r][3] = a3;
        mx[0] = fmaxf(mx[0], a0); mx[1] = fmaxf(mx[1], a1); mx[2] = fmaxf(mx[2], a2); mx[3] = fmaxf(mx[3], a3);
    }
    float ls[4];
#pragma unroll
    for (int hh = 0; hh < 4; ++hh) {
        const float m = wave_max(mx[hh]);
        float s = 0.f;
#pragma unroll
        for (int r = 0; r < 4; ++r) { const float e = exp2f(sc[r][hh] - m); sc[r][hh] = e; s += e; }
        ls[hh] = wave_sum(s);
    }
#pragma unroll
    for (int r = 0; r < 4; ++r) {
        f32x4 pv = {sc[r][0], sc[r][1], sc[r][2], sc[r][3]};
        *(f32x4*)(sP + (lane + 64 * r) * 4) = pv;
    }
    __builtin_amdgcn_s_waitcnt(0);
    float o[4][8];
#pragma unroll
    for (int hh = 0; hh < 4; ++hh)
#pragma unroll
        for (int d = 0; d < 8; ++d) o[hh][d] = 0.f;
    const int kg = lane >> 4, dc = lane & 15;
    const u16* vbase = p->vb + g * 128 + dc * 8;
    const int nit = (nsel + 3) >> 2;
    for (int it = 0; it < nit; it += 4) {
        u32x4 vv[4]; f32x4 pp[4];
#pragma unroll
        for (int u = 0; u < 4; ++u) {
            if (it + u < nit) {
                const int slot = (it + u) * 4 + kg;
                const int ki = sS[slot];
                vv[u] = *(const u32x4*)(vbase + (size_t)ki * 256);
                pp[u] = *(const f32x4*)(sP + slot * 4);
            } else { vv[u] = (u32x4){0u, 0u, 0u, 0u}; pp[u] = (f32x4){0.f, 0.f, 0.f, 0.f}; }
        }
#pragma unroll
        for (int u = 0; u < 4; ++u)
#pragma unroll
            for (int e = 0; e < 4; ++e) {
                const float v0 = __uint_as_float(vv[u][e] << 16), v1 = __uint_as_float(vv[u][e] & 0xffff0000u);
#pragma unroll
                for (int hh = 0; hh < 4; ++hh) { o[hh][2 * e] += pp[u][hh] * v0; o[hh][2 * e + 1] += pp[u][hh] * v1; }
            }
    }
#pragma unroll
    for (int hh = 0; hh < 4; ++hh)
#pragma unroll
        for (int d = 0; d < 8; ++d) {
            float v = o[hh][d];
            v += __shfl_xor(v, 16);
            v += __shfl_xor(v, 32);
            o[hh][d] = v;
        }
    if (kg == 0) {
#pragma unroll
        for (int hh = 0; hh < 4; ++hh) {
            const float il = 1.f / ls[hh];
            u32x4 w;
            w.x = pack2(o[hh][0] * il, o[hh][1] * il); w.y = pack2(o[hh][2] * il, o[hh][3] * il);
            w.z = pack2(o[hh][4] * il, o[hh][5] * il); w.w = pack2(o[hh][6] * il, o[hh][7] * il);
            *(u32x4*)(p->outcat + (size_t)q * 2048 + 1024 + (g * 4 + hh) * 128 + dc * 8) = w;
        }
    }
    __builtin_amdgcn_s_waitcnt(0);
}

#define DSA2_WLDS (8192 + 512)
__device__ __forceinline__ void dsa_task2(KP p, int q, unsigned char* wl, u16* outp, int ldo, int coff) {
    const int lane = ltid() & 63, fr = lane & 15, fq = lane >> 4;
    unsigned char* sV = wl;
    u16* sS = (u16*)(wl + 8192);
    const int nsel = q < 255 ? q + 1 : 256;
    *(u32x2*)(sS + lane * 4) = *(const u32x2*)(p->sel + (size_t)q * 256 + lane * 4);
    const int vch = lane & 15, vr0 = lane >> 4;
    int rdo[2];
#pragma unroll
    for (int t = 0; t < 2; ++t) rdo[t] = (8 * fq + 4 * t + (fr >> 2)) * 256 + 8 * (fr & 1);
    const int xr0 = ((fr >> 2) << 2) | ((2 * fq) & 3), xr1 = ((fr >> 2) << 2) | ((2 * fq + 1) & 3);
    const int hsel = (fr & 3) >> 1;
    __builtin_amdgcn_s_waitcnt(0);
#pragma unroll 1
    for (int g = 0; g < 2; ++g) {
        bf16x8 qf[4];
#pragma unroll
        for (int c = 0; c < 4; ++c) {
            u32x4 v = (u32x4){0u, 0u, 0u, 0u};
            if (fr < 4) v = *(const u32x4*)(p->qb + (size_t)q * 1024 + (g * 4 + fr) * 128 + c * 32 + fq * 8);
            qf[c] = *(bf16x8*)&v;
        }
        f32x4 O[8];
#pragma unroll
        for (int cc = 0; cc < 8; ++cc) O[cc] = (f32x4){0.f, 0.f, 0.f, 0.f};
        float mrun = -1e30f, lrun = 0.f;
        const int nstep = (nsel + 31) >> 5;
        bf16x8 fa0[4], fb0[4], fa1[4], fb1[4];
        u32x4 vv0[8], vv1[8];
#define DSA_LOAD(c, FA, FB, VV) do { \
            const int ka_ = sS[32 * (c) + fr], kb_ = sS[32 * (c) + 16 + fr]; \
            const u16* kra = p->kb + (size_t)ka_ * 256 + g * 128 + fq * 8; \
            const u16* krb = p->kb + (size_t)kb_ * 256 + g * 128 + fq * 8; \
            _Pragma("unroll") for (int cc = 0; cc < 4; ++cc) { FA[cc] = *(const bf16x8*)(kra + cc * 32); FB[cc] = *(const bf16x8*)(krb + cc * 32); } \
            _Pragma("unroll") for (int i = 0; i < 8; ++i) { \
                const int r = vr0 + 4 * i; \
                const int kv = sS[32 * (c) + 16 * ((r >> 2) & 1) + 4 * (r >> 3) + (r & 3)]; \
                VV[i] = *(const u32x4*)(p->vb + (size_t)kv * 256 + g * 128 + vch * 8); } } while (0)
#define DSA_COMP(c, FA, FB, VV) do { \
            f32x4 s0 = (f32x4){0.f, 0.f, 0.f, 0.f}, s1 = (f32x4){0.f, 0.f, 0.f, 0.f}; \
            _Pragma("unroll") for (int cc = 0; cc < 4; ++cc) { \
                s0 = __builtin_amdgcn_mfma_f32_16x16x32_bf16(FA[cc], qf[cc], s0, 0, 0, 0); \
                s1 = __builtin_amdgcn_mfma_f32_16x16x32_bf16(FB[cc], qf[cc], s1, 0, 0, 0); } \
            float mx = -1e30f; \
            _Pragma("unroll") for (int j = 0; j < 4; ++j) { \
                if (32 * (c) + 4 * fq + j >= nsel) s0[j] = -1e30f; \
                if (32 * (c) + 16 + 4 * fq + j >= nsel) s1[j] = -1e30f; \
                mx = fmaxf(mx, fmaxf(s0[j], s1[j])); } \
            mx = fmaxf(mx, __shfl_xor(mx, 16)); \
            mx = fmaxf(mx, __shfl_xor(mx, 32)); \
            const float mnew = fmaxf(mrun, mx); \
            const float al = __builtin_amdgcn_exp2f(mrun - mnew); \
            mrun = mnew; \
            float ps = 0.f; \
            _Pragma("unroll") for (int j = 0; j < 4; ++j) { \
                s0[j] = __builtin_amdgcn_exp2f(s0[j] - mnew); s1[j] = __builtin_amdgcn_exp2f(s1[j] - mnew); \
                ps += s0[j] + s1[j]; } \
            lrun = lrun * al + ps; \
            if (__ballot(al != 1.0f) != 0ull) { _Pragma("unroll") for (int cc = 0; cc < 8; ++cc) O[cc] *= al; } \
            u32x4 pw; \
            pw.x = pack2(s0[0], s0[1]); pw.y = pack2(s0[2], s0[3]); pw.z = pack2(s1[0], s1[1]); pw.w = pack2(s1[2], s1[3]); \
            const bf16x8 pf = *(bf16x8*)&pw; \
            _Pragma("unroll") for (int i = 0; i < 8; ++i) { \
                const int r = vr0 + 4 * i; \
                *(u32x4*)(sV + r * 256 + 16 * (vch ^ (((r & 3) << 2) | ((r >> 2) & 3)))) = VV[i]; } \
            __builtin_amdgcn_s_waitcnt(0xc07f); \
            _Pragma("unroll") for (int cc = 0; cc < 8; ++cc) { \
                const s16x4 lo_ = __builtin_amdgcn_ds_read_tr16_b64_v4i16((LAS s16x4*)(sV + rdo[0] + 16 * ((2 * cc + hsel) ^ xr0))); \
                const s16x4 hi_ = __builtin_amdgcn_ds_read_tr16_b64_v4i16((LAS s16x4*)(sV + rdo[1] + 16 * ((2 * cc + hsel) ^ xr1))); \
                const bf16x8 vf = __builtin_shufflevector(lo_, hi_, 0, 1, 2, 3, 4, 5, 6, 7); \
                O[cc] = __builtin_amdgcn_mfma_f32_16x16x32_bf16(vf, pf, O[cc], 0, 0, 0); } \
            __builtin_amdgcn_s_waitcnt(0xc07f); } while (0)
        DSA_LOAD(0, fa0, fb0, vv0);
#pragma unroll 1
        for (int c = 0; c < nstep; c += 2) {
            if (c + 1 < nstep) DSA_LOAD(c + 1, fa1, fb1, vv1);
            DSA_COMP(c, fa0, fb0, vv0);
            if (c + 1 < nstep) {
                if (c + 2 < nstep) DSA_LOAD(c + 2, fa0, fb0, vv0);
                DSA_COMP(c + 1, fa1, fb1, vv1);
            }
        }
#undef DSA_LOAD
#undef DSA_COMP
        float l = lrun;
        l += __shfl_xor(l, 16);
        l += __shfl_xor(l, 32);
        if (fr < 4) {
            const float il = 1.f / l;
            u16* dst = outp + (size_t)q * ldo + coff + (g * 4 + fr) * 128 + 4 * fq;
#pragma unroll
            for (int cc = 0; cc < 8; ++cc) {
                u32x2 w; w.x = pack2(O[cc][0] * il, O[cc][1] * il); w.y = pack2(O[cc][2] * il, O[cc][3] * il);
                *(u32x2*)(dst + 16 * cc) = w;
            }
        }
    }
    __builtin_amdgcn_s_waitcnt(0);
}

#define ATT_NMLA 384
#define CVT_CHUNK (256 * 1024)
#define CVT_N_OUT0 16
#define CVT_N_IN1 96
#define CVT_N_OUT1 32
#define CVT_N_SH 8
#define ATT_NCVT (CVT_N_OUT0 + CVT_N_IN1 + CVT_N_OUT1 + 6 * CVT_N_SH)
template <int RMAP = 0>
__device__ __forceinline__ void cvtT_block(const float* src, u16* dst, int K, int N, int kb, int nb, unsigned char* smem) {
    const int tid = ltid();
    u16* t = (u16*)smem;
    __syncthreads();
#pragma unroll
    for (int i = 0; i < 8; ++i) {
        const int k = (tid >> 6) + 8 * i, n4 = (tid & 63) * 4;
        f32x4 v = (f32x4){0.f, 0.f, 0.f, 0.f};
        if (nb * 256 + n4 < N) v = *(const f32x4*)(src + (size_t)(kb * 64 + k) * N + nb * 256 + n4);
#pragma unroll
        for (int e = 0; e < 4; ++e) t[(n4 + e) * 72 + k] = f2bf(v[e]);
    }
    __syncthreads();
#pragma unroll
    for (int i = 0; i < 4; ++i) {
        const int n = (tid >> 3) + 64 * i, ch = tid & 7;
        const int drow = RMAP == 0 ? nb * 256 + n : 512 * nb + (n >> 7) * 256 + 128 * (RMAP - 1) + (n & 127);
        *(u32x4*)(dst + (size_t)drow * K + kb * 64 + ch * 8) = *(const u32x4*)(t + n * 72 + ch * 8);
    }
}
#define CVT_NT_OUT1 (64 * 8)
#define CVT_NT_OUT0 (32 * 8)
#define CVT_NT_IN1 (32 * 48)
#define CVT_NT_SHGU (32 * 4)
#define CVT_NT_SHD (16 * 8)
#define CVT_NT_SH (2 * CVT_NT_SHGU + CVT_NT_SHD)
__device__ __forceinline__ void cvt_item(KP p, int c, unsigned char* smem) {
    if (c >= ATT_NCVT) {
        int u = c - ATT_NCVT;
        if (u < CVT_NT_OUT1) { cvtT_block(p->w_out1, p->w_out1t, 4096, 2048, u >> 3, u & 7, smem); return; }
        u -= CVT_NT_OUT1;
        if (u < CVT_NT_OUT0) { cvtT_block(p->w_out0, p->w_out0t, 2048, 2048, u >> 3, u & 7, smem); return; }
        u -= CVT_NT_OUT0;
        if (u < CVT_NT_IN1) { cvtT_block(p->w_in1, p->w_in1t, 2048, IN_C, u / 48, u % 48, smem); return; }
        u -= CVT_NT_IN1;
        const int l = u / CVT_NT_SH; u -= l * CVT_NT_SH;
        if (u < CVT_NT_SHGU) { cvtT_block<1>(p->sh_g[l], p->sh_gut[l], 2048, 1024, u >> 2, u & 3, smem); return; }
        u -= CVT_NT_SHGU;
        if (u < CVT_NT_SHGU) { cvtT_block<2>(p->sh_u[l], p->sh_gut[l], 2048, 1024, u >> 2, u & 3, smem); return; }
        u -= CVT_NT_SHGU;
        cvtT_block(p->sh_d[l], p->sh_dt[l], 1024, 2048, u >> 3, u & 7, smem); return;
    }
    const float* src; u16* dst;
    if (c < CVT_N_OUT0) { return; }
    else if ((c -= CVT_N_OUT0) < CVT_N_IN1) { return; }
    else if ((c -= CVT_N_IN1) < CVT_N_OUT1) { return; }
    else {
        return;
        c -= CVT_N_OUT1;
        const int which = c / CVT_N_SH; c -= which * CVT_N_SH;
        const int l = which / 3, m = which % 3;
        src = m == 0 ? p->sh_g[l] : (m == 1 ? p->sh_u[l] : p->sh_d[l]);
        dst = m == 0 ? p->sh_gb[l] : (m == 1 ? p->sh_ub[l] : p->sh_db[l]);
    }
    const size_t base = (size_t)c * CVT_CHUNK;
    for (int i = ltid(); i < CVT_CHUNK / 8; i += NT) {
        const f32x4 a = *(const f32x4*)(src + base + (size_t)i * 8), b = *(const f32x4*)(src + base + (size_t)i * 8 + 4);
        u32x4 o; o.x = pack2(a[0], a[1]); o.y = pack2(a[2], a[3]); o.z = pack2(b[0], b[1]); o.w = pack2(b[2], b[3]);
        *(u32x4*)(dst + base + (size_t)i * 8) = o;
    }
}
__device__ const unsigned char mla_order[48] = {31, 63, 79, 30, 62, 29, 61, 78, 28, 60, 27, 59, 77, 26, 58, 25, 57, 76, 24, 56, 23, 55, 75, 22, 54, 21, 53, 74, 20, 52, 19, 51, 73, 18, 50, 17, 49, 72, 16, 48, 71, 70, 69, 68, 67, 66, 65, 64};
__device__ __forceinline__ void ph_attn(KP p, unsigned char* smem, unsigned* misc, int qword = CTL_QUEUE, int lo = 0, int hi = ATT_NMLA + 512 + ATT_NCVT + CVT_NT_OUT1 + CVT_NT_OUT0 + CVT_NT_IN1 + 2 * CVT_NT_SH) {
    const int tid = ltid(), wid = tid >> 6;
    for (;;) {
        __syncthreads();
        if (tid == 0) misc[0] = atomicAdd(&p->ctl[qword], 1u);
        __syncthreads();
        const int it = (int)misc[0] + lo;
        if (it >= hi) break;
        if (it < ATT_NMLA) {
            const int e = mla_order[it >> 3];
            const int sg = e >> 5;
            mla_item(p, it & 7, e & 31, (u16*)smem, sg == 2 ? -1 : sg);
        } else if (it >= ATT_NMLA + 512) {
            cvt_item(p, it - ATT_NMLA - 512, smem);
        } else {
            const int base = (it - ATT_NMLA) * 16;
#ifdef DSA_VALU
            for (int k = 0; k < 4; ++k) {
                const int task = wid * 4 + k;
                dsa_task(p, base + (task >> 1), task & 1, smem + wid * DSA_WLDS);
            }
#else
            for (int k = 0; k < 2; ++k) dsa_task2(p, base + wid * 2 + k, smem + wid * DSA2_WLDS, p->outcat, 2048, 1024);
#endif
        }
    }
}
__device__ __forceinline__ float ret_log2g(int h);

struct PgEpiResid {
    static constexpr bool PERM = true, AFTER_DRAIN = false;
    u16* C; const u16* X; int ldc;
    __device__ __forceinline__ void operator()(const pg8::f32x4 (&acc)[2][2][4][2], const pg8::Unit& u, int wr, int wc, int fr, int fq) const {
        const int row0 = u.pm * 256 + wr * 64 + fr, col0 = u.pn * 256 + wc * 32 + 8 * fq;
#pragma unroll
        for (int ai = 0; ai < 2; ++ai) {
            u32x4 xv[4][2];
#pragma unroll
            for (int m = 0; m < 4; ++m)
#pragma unroll
                for (int bj = 0; bj < 2; ++bj) xv[m][bj] = *(const u32x4*)(X + (size_t)(row0 + ai * 128 + m * 16) * ldc + col0 + bj * 128);
#pragma unroll
            for (int m = 0; m < 4; ++m)
#pragma unroll
                for (int bj = 0; bj < 2; ++bj) {
                    const pg8::f32x4 v0 = acc[ai][bj][m][0], v1 = acc[ai][bj][m][1];
                    const u32x4 x = xv[m][bj];
                    u32x4 w;
                    w.x = pack2(__uint_as_float(x.x << 16) * ALPHA_ + v0[0], __uint_as_float(x.x & 0xffff0000u) * ALPHA_ + v0[1]);
                    w.y = pack2(__uint_as_float(x.y << 16) * ALPHA_ + v0[2], __uint_as_float(x.y & 0xffff0000u) * ALPHA_ + v0[3]);
                    w.z = pack2(__uint_as_float(x.z << 16) * ALPHA_ + v1[0], __uint_as_float(x.z & 0xffff0000u) * ALPHA_ + v1[1]);
                    w.w = pack2(__uint_as_float(x.w << 16) * ALPHA_ + v1[2], __uint_as_float(x.w & 0xffff0000u) * ALPHA_ + v1[3]);
                    *(u32x4*)(C + (size_t)(row0 + ai * 128 + m * 16) * ldc + col0 + bj * 128) = w;
                }
        }
    }
};

struct PgEpiResidF {
    static constexpr bool PERM = true, AFTER_DRAIN = false;
    u16* C; const float* X; int ldc;
    __device__ __forceinline__ void operator()(const pg8::f32x4 (&acc)[2][2][4][2], const pg8::Unit& u, int wr, int wc, int fr, int fq) const {
        const int row0 = u.pm * 256 + wr * 64 + fr, col0 = u.pn * 256 + wc * 32 + 8 * fq;
#pragma unroll
        for (int ai = 0; ai < 2; ++ai)
#pragma unroll
            for (int m = 0; m < 4; ++m) {
                f32x4 xv[2][2];
#pragma unroll
                for (int bj = 0; bj < 2; ++bj) {
                    const float* xp = X + (size_t)(row0 + ai * 128 + m * 16) * ldc + col0 + bj * 128;
                    xv[bj][0] = *(const f32x4*)xp; xv[bj][1] = *(const f32x4*)(xp + 4);
                }
#pragma unroll
                for (int bj = 0; bj < 2; ++bj) {
                    const f32x4 a = xv[bj][0] * ALPHA_ + acc[ai][bj][m][0], b = xv[bj][1] * ALPHA_ + acc[ai][bj][m][1];
                    u32x4 w; w.x = pack2(a[0], a[1]); w.y = pack2(a[2], a[3]); w.z = pack2(b[0], b[1]); w.w = pack2(b[2], b[3]);
                    *(u32x4*)(C + (size_t)(row0 + ai * 128 + m * 16) * ldc + col0 + bj * 128) = w;
                }
                asm volatile("" ::: "memory");
            }
    }
};
struct PgEpiL1 {
    static constexpr bool PERM = true, AFTER_DRAIN = false;
    KP p;
    __device__ __forceinline__ void operator()(const pg8::f32x4 (&acc)[2][2][4][2], const pg8::Unit& u, int wr, int wc, int fr, int fq) const {
        const int row0 = u.pm * 256 + wr * 64 + fr, ci = wc * 32 + 8 * fq;
        const int pn = u.pn;
        if (pn < 16) {
            const bool isk = pn >= 8; const int hd = pn & 7;
            const float l2g = ret_log2g(hd);
            const float* cR = p->cosR; const float* sR = p->sinR;
#pragma unroll
            for (int ai = 0; ai < 2; ++ai)
#pragma unroll
                for (int m = 0; m < 4; ++m) {
                    const int t = row0 + ai * 128 + m * 16;
                    const float dec = isk ? exp2f((float)(127 - (t & 127)) * l2g) : exp2f((float)((t & 127) + 1) * l2g);
                    f32x4 lo[2], hi[2];
#pragma unroll
                    for (int n = 0; n < 2; ++n) {
                        const f32x4 c = *(const f32x4*)(cR + t * 128 + ci + 4 * n), s = *(const f32x4*)(sR + t * 128 + ci + 4 * n);
                        const f32x4 x1 = acc[ai][0][m][n], x2 = acc[ai][1][m][n];
                        lo[n] = x1 * c - x2 * s; hi[n] = x1 * s + x2 * c;
                        if (isk) { lo[n] *= 0.0625f; hi[n] *= 0.0625f; }
                    }
                    const size_t o = (size_t)t * 2048 + hd * 256 + ci;
                    u16* d0 = isk ? p->kr : p->qr; u16* d1 = isk ? p->kz : p->qx;
                    u32x4 w;
                    w.x = pack2(lo[0][0], lo[0][1]); w.y = pack2(lo[0][2], lo[0][3]); w.z = pack2(lo[1][0], lo[1][1]); w.w = pack2(lo[1][2], lo[1][3]);
                    *(u32x4*)(d0 + o) = w;
                    w.x = pack2(hi[0][0], hi[0][1]); w.y = pack2(hi[0][2], hi[0][3]); w.z = pack2(hi[1][0], hi[1][1]); w.w = pack2(hi[1][2], hi[1][3]);
                    *(u32x4*)(d0 + o + 128) = w;
                    lo[0] *= dec; lo[1] *= dec; hi[0] *= dec; hi[1] *= dec;
                    w.x = pack2(lo[0][0], lo[0][1]); w.y = pack2(lo[0][2], lo[0][3]); w.z = pack2(lo[1][0], lo[1][1]); w.w = pack2(lo[1][2], lo[1][3]);
                    *(u32x4*)(d1 + o) = w;
                    w.x = pack2(hi[0][0], hi[0][1]); w.y = pack2(hi[0][2], hi[0][3]); w.z = pack2(hi[1][0], hi[1][1]); w.w = pack2(hi[1][2], hi[1][3]);
                    *(u32x4*)(d1 + o + 128) = w;
                    asm volatile("" ::: "memory");
                }
        } else {
            const bool isg = pn >= 32;
            u16* dst = isg ? p->sg : p->v1;
            const int cbase = (isg ? pn - 32 : pn - 16) * 256 + ci;
#pragma unroll
            for (int ai = 0; ai < 2; ++ai)
#pragma unroll
                for (int m = 0; m < 4; ++m)
#pragma unroll
                    for (int bj = 0; bj < 2; ++bj) {
                        f32x4 a = acc[ai][bj][m][0], b = acc[ai][bj][m][1];
                        if (isg) {
#pragma unroll
                            for (int e = 0; e < 4; ++e) { a[e] = silu_f(a[e]); b[e] = silu_f(b[e]); }
                        }
                        u32x4 w; w.x = pack2(a[0], a[1]); w.y = pack2(a[2], a[3]); w.z = pack2(b[0], b[1]); w.w = pack2(b[2], b[3]);
                        *(u32x4*)(dst + (size_t)(row0 + ai * 128 + m * 16) * 4096 + cbase + bj * 128) = w;
                    }
        }
    }
};

struct PgEpiBf16N {
    static constexpr bool PERM = true, AFTER_DRAIN = false;
    u16* C; int ldc; int ncols;
    __device__ __forceinline__ void operator()(const pg8::f32x4 (&acc)[2][2][4][2], const pg8::Unit& u, int wr, int wc, int fr, int fq) const {
        const int row0 = u.pm * 256 + wr * 64 + fr, col0 = u.pn * 256 + wc * 32 + 8 * fq;
#pragma unroll
        for (int ai = 0; ai < 2; ++ai)
#pragma unroll
            for (int m = 0; m < 4; ++m)
#pragma unroll
                for (int bj = 0; bj < 2; ++bj) {
                    const int c = col0 + bj * 128;
                    if (c < ncols) {
                        const pg8::f32x4 a = acc[ai][bj][m][0], b = acc[ai][bj][m][1];
                        u32x4 w; w.x = pack2(a[0], a[1]); w.y = pack2(a[2], a[3]); w.z = pack2(b[0], b[1]); w.w = pack2(b[2], b[3]);
                        *(u32x4*)(C + (size_t)(row0 + ai * 128 + m * 16) * ldc + c) = w;
                    }
                }
    }
};
struct PgEpiSwiglu {
    static constexpr bool PERM = true, AFTER_DRAIN = false;
    u16* C; int ldc;
    __device__ __forceinline__ void operator()(const pg8::f32x4 (&acc)[2][2][4][2], const pg8::Unit& u, int wr, int wc, int fr, int fq) const {
        const int row0 = u.pm * 256 + wr * 64 + fr, col0 = u.pn * 128 + wc * 32 + 8 * fq;
#pragma unroll
        for (int ai = 0; ai < 2; ++ai)
#pragma unroll
            for (int m = 0; m < 4; ++m) {
                const pg8::f32x4 g0 = acc[ai][0][m][0], g1 = acc[ai][0][m][1], u0 = acc[ai][1][m][0], u1 = acc[ai][1][m][1];
                float o[8];
#pragma unroll
                for (int e = 0; e < 4; ++e) { o[e] = silu_f(g0[e]) * u0[e]; o[4 + e] = silu_f(g1[e]) * u1[e]; }
                u32x4 w; w.x = pack2(o[0], o[1]); w.y = pack2(o[2], o[3]); w.z = pack2(o[4], o[5]); w.w = pack2(o[6], o[7]);
                *(u32x4*)(C + (size_t)(row0 + ai * 128 + m * 16) * ldc + col0) = w;
            }
    }
};
template <bool ADD_ROUTED, bool ROUTE, bool WRITE_B, bool WRITE_F>
__device__ __forceinline__ void ph_ln(KP p, const u16* Y, const float* g, const float* b, float* XF, u16* XB, u16* XL) {
    const int lane = ltid() & 63;
    const int gw = (blockIdx.x * NT + ltid()) >> 6, nw = (gridDim.x * NT) >> 6;
    for (int t = gw; t < T_; t += nw) {
        float v[32];
        const u16* y = Y + (size_t)t * D_;
        float sum = 0.f;
#pragma unroll
        for (int j = 0; j < 8; ++j) {
            const u32x2 a = *(const u32x2*)(y + j * 256 + lane * 4);
            v[4 * j] = __uint_as_float(a.x << 16); v[4 * j + 1] = __uint_as_float(a.x & 0xffff0000u);
            v[4 * j + 2] = __uint_as_float(a.y << 16); v[4 * j + 3] = __uint_as_float(a.y & 0xffff0000u);
        }
        if constexpr (ADD_ROUTED) {
            const u16* r0 = p->yr + (size_t)(2 * t) * D_;
            const u16* r1 = r0 + D_;
#pragma unroll
            for (int j = 0; j < 8; ++j) {
                const u32x2 a = *(const u32x2*)(r0 + j * 256 + lane * 4);
                const u32x2 c = *(const u32x2*)(r1 + j * 256 + lane * 4);
                v[4 * j]     += __uint_as_float(a.x << 16) + __uint_as_float(c.x << 16);
                v[4 * j + 1] += __uint_as_float(a.x & 0xffff0000u) + __uint_as_float(c.x & 0xffff0000u);
                v[4 * j + 2] += __uint_as_float(a.y << 16) + __uint_as_float(c.y << 16);
                v[4 * j + 3] += __uint_as_float(a.y & 0xffff0000u) + __uint_as_float(c.y & 0xffff0000u);
            }
        }
#pragma unroll
        for (int i = 0; i < 32; ++i) sum += v[i];
        const float mu = wave_sum(sum) * (1.f / 2048.f);
        float var = 0.f;
#pragma unroll
        for (int i = 0; i < 32; ++i) { const float d = v[i] - mu; var += d * d; }
        var = wave_sum(var) * (1.f / 2048.f);
        const float rs = rsqrtf(var + 1e-5f);
#pragma unroll
        for (int j = 0; j < 8; ++j) {
            const int c = j * 256 + lane * 4;
            const f32x4 gg = *(const f32x4*)(g + c), bb = *(const f32x4*)(b + c);
            f32x4 o;
#pragma unroll
            for (int e = 0; e < 4; ++e) o[e] = (v[4 * j + e] - mu) * rs * gg[e] + bb[e];
            if constexpr (WRITE_F) *(f32x4*)(XF + (size_t)t * D_ + c) = o;
            if constexpr (WRITE_B) {
                u32x2 w; w.x = pack2(o[0], o[1]); w.y = pack2(o[2], o[3]);
                *(u32x2*)(XB + (size_t)t * D_ + c) = w;
                if constexpr (ROUTE) {
                    u32x2 wl;
                    wl.x = pack2(o[0] - __uint_as_float(w.x << 16), o[1] - __uint_as_float(w.x & 0xffff0000u));
                    wl.y = pack2(o[2] - __uint_as_float(w.y << 16), o[3] - __uint_as_float(w.y & 0xffff0000u));
                    *(u32x2*)(XL + (size_t)t * D_ + c) = wl;
                }
            }
        }
    }
}

__device__ __forceinline__ void route_token(KP p, int t, float logit, int lane, unsigned* cnt, int* list) {
    const float sc = 1.f / (1.f + __expf(-logit));
    const float bi = sc + p->router_b[lane];
    float m1 = bi;
    m1 = fmaxf(m1, __shfl_xor(m1, 1)); m1 = fmaxf(m1, __shfl_xor(m1, 2)); m1 = fmaxf(m1, __shfl_xor(m1, 4));
    const int seg = lane >> 3;
    unsigned long long bal = __ballot(bi == m1);
    const int f1 = __builtin_ctz((unsigned)((bal >> (seg * 8)) & 0xffull));
    const float b2 = ((lane & 7) == f1) ? -1e30f : bi;
    float m2 = b2;
    m2 = fmaxf(m2, __shfl_xor(m2, 1)); m2 = fmaxf(m2, __shfl_xor(m2, 2)); m2 = fmaxf(m2, __shfl_xor(m2, 4));
    bal = __ballot(b2 == m2);
    const int f2 = __builtin_ctz((unsigned)((bal >> (seg * 8)) & 0xffull));
    const float gs = m1 + m2;
    float gm = gs;
    gm = fmaxf(gm, __shfl_xor(gm, 8)); gm = fmaxf(gm, __shfl_xor(gm, 16)); gm = fmaxf(gm, __shfl_xor(gm, 32));
    bal = __ballot(gs == gm);
    const int gsel = (int)(__builtin_ctzll(bal) >> 3);
    const int e0 = gsel * 8 + __shfl(f1, gsel * 8);
    const int e1 = gsel * 8 + __shfl(f2, gsel * 8);
    const float s0 = __shfl(sc, e0), s1 = __shfl(sc, e1);
    if (lane == 0) {
        const float inv = 1.f / (s0 + s1);
        const unsigned p0 = atomicAdd(&cnt[e0 * CNT_STRIDE], 1u);
        const unsigned p1 = atomicAdd(&cnt[e1 * CNT_STRIDE], 1u);
        list[e0 * T_ + p0] = 2 * t;
        list[e1 * T_ + p1] = 2 * t + 1;
        p->tok_g[2 * t] = s0 * inv;
        p->tok_g[2 * t + 1] = s1 * inv;
    }
}

__device__ __forceinline__ void ph_router(KP p, unsigned char* smem, unsigned* cnt, int* list) {
    const int tid = ltid(), lane = tid & 63, wid = tid >> 6, grp = wid >> 2, kq = wid & 3, fr = lane & 15, fq = lane >> 4;
    float* part = (float*)smem;
    for (int blk = blockIdx.x; blk < T_ / 32; blk += gridDim.x) {
        const int t0 = blk * 32 + grp * 16;
        f32x4 acc[4];
#pragma unroll
        for (int c = 0; c < 4; ++c) acc[c] = (f32x4){0.f, 0.f, 0.f, 0.f};
        const u16* ah = p->xab + (size_t)(t0 + fr) * D_ + kq * 512 + fq * 8;
        const u16* al = p->xlb + (size_t)(t0 + fr) * D_ + kq * 512 + fq * 8;
        const u16* bh = p->whT + (size_t)fr * D_ + kq * 512 + fq * 8;
        const u16* bl = p->wlT + (size_t)fr * D_ + kq * 512 + fq * 8;
#pragma unroll 2
        for (int s = 0; s < 16; ++s) {
            const bf16x8 xh = *(const bf16x8*)(ah + 32 * s), xl = *(const bf16x8*)(al + 32 * s);
#pragma unroll
            for (int c = 0; c < 4; ++c) {
                const bf16x8 wh = *(const bf16x8*)(bh + (size_t)c * 16 * D_ + 32 * s);
                const bf16x8 wl = *(const bf16x8*)(bl + (size_t)c * 16 * D_ + 32 * s);
                acc[c] = __builtin_amdgcn_mfma_f32_16x16x32_bf16(xh, wh, acc[c], 0, 0, 0);
                acc[c] = __builtin_amdgcn_mfma_f32_16x16x32_bf16(xh, wl, acc[c], 0, 0, 0);
                acc[c] = __builtin_amdgcn_mfma_f32_16x16x32_bf16(xl, wh, acc[c], 0, 0, 0);
            }
        }
        float* mine = part + (grp * 4 + kq) * 1024;
#pragma unroll
        for (int c = 0; c < 4; ++c)
#pragma unroll
            for (int j = 0; j < 4; ++j) mine[(4 * fq + j) * 64 + 16 * c + fr] = acc[c][j];
        __syncthreads();
#pragma unroll 1
        for (int tt = 0; tt < 4; ++tt) {
            const int tok = 4 * kq + tt;
            const float* q = part + (grp * 4) * 1024 + tok * 64 + lane;
            const float logit = (q[0] + q[1024]) + (q[2048] + q[3072]);
            route_token(p, t0 + tok, logit, lane, cnt, list);
        }
        __syncthreads();
    }
}

struct ColGateUp16 { int c0; const u16* up;
    __device__ __forceinline__ const u16* base16(const u16* B, int hsel) const { return hsel ? up : B; }
    __device__ __forceinline__ unsigned off8(int hsel, int ch8) const { return (unsigned)(c0 + ch8 * 8); }
    __device__ __forceinline__ int vchunk(int hsel, int ch8) const { const int r = ch8 * 8; return ((r >> 5) * 64 + hsel * 32 + (r & 31)) >> 3; } };
struct ColGateUp { int c0; const float* up;
    __device__ __forceinline__ const float* base(const float* B, int hsel) const { return hsel ? up : B; }
    __device__ __forceinline__ unsigned off4(int hsel, int g4) const { return (unsigned)(c0 + g4 * 4); }
    __device__ __forceinline__ int vcol4(int hsel, int g4) const { const int r = g4 * 4; return (r >> 5) * 64 + hsel * 32 + (r & 31); } };
struct RowList { const int* lst; int m0, n; __device__ __forceinline__ int operator()(int r) const { const int i = m0 + r; return lst[i < n ? i : n - 1] >> 1; } };
struct EpiSwiglu {
    u16* C; int ldc; int row0, c0, nrows;
    __device__ __forceinline__ void operator()(Acc& acc, unsigned char* stg) const {
        const int wr0 = WR0_, cb = c0 + (WC0_ >> 1);
        u16* Cp = C; const int ld = ldc, rbase = row0, nr = nrows;
        stage_pairs(acc, stg, [=](int r, int c4, f32x4 g, f32x4 u) {
            const int rr = wr0 + r;
            if (rr < nr) {
                f32x4 o;
#pragma unroll
                for (int e = 0; e < 4; ++e) o[e] = silu_f(g[e]) * u[e];
                *(u32x2*)(Cp + (size_t)(rbase + rr) * ld + cb + c4) = pack4(o);
            }
        });
    }
};
struct SlotGate { int slot; float g; };
struct EpiDownRouted {
    u16* yr; const int* lst; const float* tg; int m0, n, col0;
    __device__ __forceinline__ void operator()(Acc& acc, unsigned char* stg) const {
        const int wr0 = WR0_, cb = col0 + WC0_;
        u16* yp = yr; const int* lp = lst; const float* tgp = tg; const int mm0 = m0, nn = n;
        stage_rows_pre<SlotGate>(acc, stg,
            [=](int r, int c4) -> SlotGate {
                const int i = mm0 + wr0 + r;
                SlotGate sg; sg.slot = -1; sg.g = 0.f;
                if (i < nn) { sg.slot = lp[i]; sg.g = tgp[sg.slot]; }
                return sg; },
            [=](int r, int c4, f32x4 v, SlotGate sg) {
                if (sg.slot >= 0) *(u32x2*)(yp + (size_t)sg.slot * D_ + cb + c4) = pack4(v * sg.g); });
    }
};

struct RowH { int base, mx; __device__ __forceinline__ int operator()(int r) const { const int i = base + r; return i < mx ? i : mx; } };
__device__ __forceinline__ void moe_prefix(const unsigned* cnt, int* s_tp, int* s_off) {
    __syncthreads();
    if (ltid() == 0) {
        int tp = 0, off = 0;
        for (int e = 0; e < 64; ++e) {
            const int n = (int)__hip_atomic_load(&cnt[e * CNT_STRIDE], __ATOMIC_RELAXED, __HIP_MEMORY_SCOPE_AGENT);
            s_tp[e] = tp; s_off[e] = off;
            tp += (n + 255) >> 8; off += n;
        }
        s_tp[64] = tp; s_off[64] = off;
    }
    __syncthreads();
}

struct RowGen { const int* lst; int m0, n, base; __device__ __forceinline__ int operator()(int r) const {
    if (lst) { const int i = m0 + r; return lst[i < n ? i : n - 1] >> 1; }
    return base + r; } };

template <int L>
__device__ __forceinline__ void ph_moe_up(KP p, const u16* X, unsigned char* smem, int* s_tp, int* s_off) {
    u16* lds = (u16*)smem;
    const unsigned* cnt = p->ctl + (L == 0 ? CTL_CNT0 : CTL_CNT1);
    moe_prefix(cnt, s_tp, s_off);
    {
        __syncthreads();
        pg8::Gemm g; g.A = X; g.Bt = p->sh_gut[L]; g.M = T_; g.N = 2048; g.K = D_;
        pg8::StaticOrder S; S.init(T_, 2048, (int)gridDim.x, (int)blockIdx.x);
        pg8::gemm_phase<PgEpiSwiglu, pg8::StaticOrder>((PG8_LAS unsigned char*)smem, g, S, PgEpiSwiglu{p->hsh, 1024}, nullptr);
        __syncthreads();
    }
    const int nrt = s_tp[64] * 8;
    const int nsh = 0;
            for (int t = blockIdx.x; t < nrt + nsh; t += gridDim.x) {
        Acc acc; acc_zero(acc);
        if (t < nrt) {
            const int mtile = t >> 3, nt = t & 7;
            int e = 0;
            for (int s = 32; s > 0; s >>= 1) if (e + s < 64 && s_tp[e + s] <= mtile) e += s;
            const int n = s_off[e + 1] - s_off[e], m0 = (mtile - s_tp[e]) * 256;
            gemm_accum<B_F32_KN, false>(acc, X, D_, RowGen{p->list + e * T_, m0, n, 0}, p->moe_wg[L] + (size_t)e * D_ * 512, 512,
                                        ColGateUp{nt * 64, p->moe_wu[L] + (size_t)e * D_ * 512}, D_, lds);
            EpiSwiglu{p->hbuf, 512, s_off[e] + m0, nt * 64, n - m0}(acc, smem);
        } else {
            const int u = t - nrt, mt = u >> 4, nt = u & 15;
            gemm_accum<B_BF16_KN, false>(acc, X, D_, RowId{mt * 256}, p->sh_gb[L], 1024, ColGateUp16{nt * 64, p->sh_ub[L]}, D_, lds);
            EpiSwiglu{p->hsh, 1024, mt * 256, nt * 64, 256}(acc, smem);
        }
    }
}

template <int L>
__device__ __forceinline__ void ph_moe_down(KP p, const u16* XBres, unsigned char* smem, int* s_tp, int* s_off) {
    u16* lds = (u16*)smem;
    const unsigned* cnt = p->ctl + (L == 0 ? CTL_CNT0 : CTL_CNT1);
    moe_prefix(cnt, s_tp, s_off);
    {
        __syncthreads();
        pg8::Gemm g; g.A = p->hsh; g.Bt = p->sh_dt[L]; g.M = T_; g.N = D_; g.K = 1024;
        pg8::StaticOrder S; S.init(T_, D_, (int)gridDim.x, (int)blockIdx.x);
        pg8::gemm_phase<PgEpiResid, pg8::StaticOrder>((PG8_LAS unsigned char*)smem, g, S, PgEpiResid{p->y2, XBres, D_}, nullptr);
        __syncthreads();
    }
    const int nrt = s_tp[64] * 16, nsh = 0;
    for (int t = blockIdx.x; t < nrt + nsh; t += gridDim.x) {
        Acc acc; acc_zero(acc);
        if (t < nrt) {
            const int mtile = t >> 4, nt = t & 15;
            int e = 0;
            for (int s = 32; s > 0; s >>= 1) if (e + s < 64 && s_tp[e + s] <= mtile) e += s;
            const int n = s_off[e + 1] - s_off[e], m0 = (mtile - s_tp[e]) * 256;
            gemm_accum<B_F32_KN, false>(acc, p->hbuf, 512, RowH{s_off[e] + m0, 2 * T_ - 1}, p->moe_wd[L] + (size_t)e * 512 * D_, D_, ColOff{nt * 128}, 512, lds);
            EpiDownRouted{p->yr, p->list + e * T_, p->tok_g, m0, n, nt * 128}(acc, smem);
        } else {
            const int u = t - nrt, mt = u >> 4, nt = u & 15;
            gemm_accum<B_BF16_KN, false>(acc, p->hsh, 1024, RowId{mt * 256}, p->sh_db[L], D_, ColOff{nt * 128}, 1024, lds);
            EpiResid<true>{p->y2, XBres, D_, mt * 256, nt * 128}(acc, smem);
        }
    }
}
struct ColRot { int cbase; bool rot;
    __device__ __forceinline__ const u16* base16(const u16* B, int) const { return B; }
    __device__ __forceinline__ unsigned off8(int hsel, int ch8) const { const int v = hsel * 64 + ch8 * 8; const int s = v >> 6, u = v & 63;
        return rot ? (unsigned)(cbase + s * 32 + (u < 32 ? u : 128 + (u - 32))) : (unsigned)(cbase + v); }
    __device__ __forceinline__ int vchunk(int hsel, int ch8) const { return hsel * 8 + ch8; }
    __device__ __forceinline__ const float* base(const float* B, int) const { return B; }
    __device__ __forceinline__ unsigned off4(int hsel, int g4) const { const int v = hsel * 64 + g4 * 4; const int s = v >> 6, u = v & 63;
        return rot ? (unsigned)(cbase + s * 32 + (u < 32 ? u : 128 + (u - 32))) : (unsigned)(cbase + v); }
    __device__ __forceinline__ int vcol4(int hsel, int g4) const { return hsel * 64 + g4 * 4; } };

__device__ __forceinline__ float ret_log2g(int h) { return log1pf(-exp2f(-5.f - (float)h)) * LOG2E_; }

struct EpiRetQK {
    KP p; int row0; int hd; int tp; bool isk;
    __device__ __forceinline__ void operator()(Acc& acc, unsigned char* stg) const {
        const float l2g = ret_log2g(hd);
        const int wc0 = WC0_, rb = row0 + WR0_;
        const int dbase = tp * 64 + (wc0 >> 1);
        const float* cR = p->cosR; const float* sR = p->sinR;
        const int hoff = hd * 256 + dbase;
        if (!isk) {
            u16* qr = p->qr; u16* qx = p->qx;
            stage_pairs_pre<CS8>(acc, stg,
              [=](int r, int c4) -> CS8 { CS8 t; t.c = *(const f32x4*)(cR + (rb + r) * 128 + dbase + c4); t.s = *(const f32x4*)(sR + (rb + r) * 128 + dbase + c4); return t; },
              [=](int r, int c4, f32x4 x1, f32x4 x2, CS8 cs) {
                const int t = rb + r;
                const f32x4 c = cs.c, s = cs.s;
                const f32x4 lo = x1 * c - x2 * s, hi = x1 * s + x2 * c;
                const float xi = exp2f((float)((t & 127) + 1) * l2g);
                const size_t o = (size_t)t * 2048 + hoff + c4;
                *(u32x2*)(qr + o) = pack4(lo); *(u32x2*)(qr + o + 128) = pack4(hi);
                *(u32x2*)(qx + o) = pack4(lo * xi); *(u32x2*)(qx + o + 128) = pack4(hi * xi);
            });
        } else {
            const int lane = ltid() & 63, fr = lane & 15, fq = lane >> 4;
#pragma unroll
            for (int m = 0; m < 4; ++m) {
                const int r0 = rb + m * 16 + fq * 4;
#pragma unroll
                for (int n = 0; n < 2; ++n) {
                    const int i = dbase + n * 16 + fr;
                    float zl[4], zh[4];
#pragma unroll
                    for (int j = 0; j < 4; ++j) {
                        const int t = r0 + j;
                        const float c = cR[t * 128 + i], s = sR[t * 128 + i];
                        const float x1 = acc[m][n][j], x2 = acc[m][n + 2][j];
                        const float ze = exp2f((float)(127 - (t & 127)) * l2g) * 0.0625f;
                        zl[j] = (x1 * c - x2 * s) * ze; zh[j] = (x1 * s + x2 * c) * ze;
                    }
                    u32x2 a, b;
                    a.x = pack2(zl[0], zl[1]); a.y = pack2(zl[2], zl[3]);
                    b.x = pack2(zh[0], zh[1]); b.y = pack2(zh[2], zh[3]);
                    *(u32x2*)(p->kzT + (size_t)(hd * 256 + i) * T_ + r0) = a;
                    *(u32x2*)(p->kzT + (size_t)(hd * 256 + i + 128) * T_ + r0) = b;
                }
            }
            u16* kr = p->kr;
            stage_pairs_pre<CS8>(acc, stg,
              [=](int r, int c4) -> CS8 { CS8 t; t.c = *(const f32x4*)(cR + (rb + r) * 128 + dbase + c4); t.s = *(const f32x4*)(sR + (rb + r) * 128 + dbase + c4); return t; },
              [=](int r, int c4, f32x4 x1, f32x4 x2, CS8 cs) {
                const int t = rb + r;
                const f32x4 c = cs.c, s = cs.s;
                const f32x4 lo = (x1 * c - x2 * s) * 0.0625f, hi = (x1 * s + x2 * c) * 0.0625f;
                const size_t o = (size_t)t * 2048 + hoff + c4;
                *(u32x2*)(kr + o) = pack4(lo); *(u32x2*)(kr + o + 128) = pack4(hi);
            });
        }
    }
};
struct EpiRetV {
    u16* vT; int row0, col0;
    __device__ __forceinline__ void operator()(Acc& acc, unsigned char* stg) const {
        const int lane = ltid() & 63, fr = lane & 15, fq = lane >> 4, wr0 = WR0_, wc0 = WC0_;
#pragma unroll
        for (int m = 0; m < 4; ++m) {
            const int r0 = row0 + wr0 + m * 16 + fq * 4;
#pragma unroll
            for (int n = 0; n < 4; ++n) {
                u32x2 o; o.x = pack2(acc[m][n][0], acc[m][n][1]); o.y = pack2(acc[m][n][2], acc[m][n][3]);
                *(u32x2*)(vT + (size_t)(col0 + wc0 + n * 16 + fr) * T_ + r0) = o;
            }
        }
    }
};
struct EpiSilu {
    u16* C; int ldc; int row0, col0;
    __device__ __forceinline__ void operator()(Acc& acc, unsigned char* stg) const {
        const int rb = row0 + WR0_, cb = col0 + WC0_;
        u16* Cp = C; const int ld = ldc;
        stage_rows(acc, stg, [=](int r, int c4, f32x4 v) {
            f32x4 o;
#pragma unroll
            for (int e = 0; e < 4; ++e) o[e] = silu_f(v[e]);
            *(u32x2*)(Cp + (size_t)(rb + r) * ld + cb + c4) = pack4(o);
        });
    }
};
struct EpiInner {
    u16* C; int hd;
    __device__ __forceinline__ void operator()(Acc& acc, unsigned char* stg) const {
        const float l2g = ret_log2g(hd);
        const int wr0 = WR0_, wc0 = WC0_;
        u16* Cp = C;
        stage_rows(acc, stg, [=](int r, int c4, f32x4 v) {
            const int i = wr0 + r;
            f32x4 o;
#pragma unroll
            for (int e = 0; e < 4; ++e) { const int k = wc0 + c4 + e; o[e] = i >= k ? v[e] * exp2f((float)(i - k) * l2g) : 0.f; }
            *(u32x2*)(Cp + i * 128 + wc0 + c4) = pack4(o);
        });
    }
};


__device__ __forceinline__ void ph_ret_a(KP p, u16* lds) {
    const int nkv = 8 * 64 * 4, nin = 8 * 64;
    for (int t = blockIdx.x; t < nkv + nin; t += gridDim.x) {
        Acc acc; acc_zero(acc);
        if (t < nkv) {
            const int hc = t >> 2, nt = t & 3, hd = hc >> 6, c = hc & 63;
            gemm_kk128(acc, p->kz + (size_t)(c * 128) * 2048 + hd * 256, 2048, p->v1 + (size_t)(c * 128) * 4096 + hd * 512 + nt * 128, 4096, lds);
            EpiBF16{p->KVt + (size_t)hc * 512 * 256, 512, 0, nt * 128}(acc, (unsigned char*)lds);
        } else {
            const int hc = t - nkv, hd = hc >> 6, c = hc & 63;
            gemm_accum<B_BF16_NK, true>(acc, p->qr + hd * 256, 2048, RowId{c * 128}, p->kr + hd * 256, 2048, RowId{c * 128}, 256, lds);
            if (ksplit_reduce(acc, lds)) EpiInner{p->innerG + (size_t)hc * 128 * 128, hd}(acc, (unsigned char*)lds + 65536);
        }
    }
}
__device__ __forceinline__ void ph_ret_b(KP p) {
    const int gtid = blockIdx.x * NT + ltid(), gsz = gridDim.x * NT;
    for (int e = gtid; e < 8 * 512 * 256 / 8; e += gsz) {
        const int hd = e / (512 * 256 / 8);
        const int within = e - hd * (512 * 256 / 8);
        const float g128 = exp2f(128.f * ret_log2g(hd));
        u16* base = p->KVt + (size_t)hd * 64 * 512 * 256 + (size_t)within * 8;
        float r[8];
#pragma unroll
        for (int i = 0; i < 8; ++i) r[i] = 0.f;
#pragma unroll 4
        for (int c = 0; c < 64; ++c) {
            u32x4* ptr = (u32x4*)(base + (size_t)c * 512 * 256);
            const u32x4 in = *ptr;
            u32x4 o;
            o.x = pack2(r[0], r[1]); o.y = pack2(r[2], r[3]); o.z = pack2(r[4], r[5]); o.w = pack2(r[6], r[7]);
            *ptr = o;
#pragma unroll
            for (int i = 0; i < 4; ++i) {
                r[2 * i] = r[2 * i] * g128 + __uint_as_float(in[i] << 16);
                r[2 * i + 1] = r[2 * i + 1] * g128 + __uint_as_float(in[i] & 0xffff0000u);
            }
        }
    }
}
__device__ __forceinline__ void ph_ret_c(KP p, u16* lds) {
    for (int t = blockIdx.x; t < 8 * 64 * 4; t += gridDim.x) {
        const int hc = t >> 2, nt = t & 3, hd = hc >> 6, c = hc & 63;
        Acc acc; acc_zero(acc);
        gemm_accum<B_BF16_KN, true>(acc, p->innerG + (size_t)hc * 128 * 128, 128, RowId{0}, p->v1 + (size_t)(c * 128) * 4096, 4096, ColOff{hd * 512 + nt * 128}, 128, lds);
        gemm_accum<B_BF16_KN, true>(acc, p->qx + hd * 256, 2048, RowId{c * 128}, p->KVt + (size_t)hc * 512 * 256, 512, ColOff{nt * 128}, 256, lds);
        if (ksplit_reduce(acc, lds)) EpiBF16{p->obuf, 4096, c * 128, hd * 512 + nt * 128}(acc, (unsigned char*)lds + 65536);
    }
}
__device__ __forceinline__ void ph_gn(KP p) {
    const int lane = ltid() & 63;
    const int gw = (blockIdx.x * NT + ltid()) >> 6, nw = (gridDim.x * NT) >> 6;
    for (int r = gw; r < T_ * 8; r += nw) {
        const int hd = r & 7;
        const size_t off = (size_t)(r >> 3) * 4096 + hd * 512 + lane * 8;
        const u32x4 in = *(const u32x4*)(p->obuf + off);
        float v[8];
#pragma unroll
        for (int i = 0; i < 4; ++i) { v[2 * i] = __uint_as_float(in[i] << 16); v[2 * i + 1] = __uint_as_float(in[i] & 0xffff0000u); }
        float s = 0.f;
#pragma unroll
        for (int i = 0; i < 8; ++i) s += v[i];
        const float mu = wave_sum(s) * (1.f / 512.f);
        float var = 0.f;
#pragma unroll
        for (int i = 0; i < 8; ++i) { const float d = v[i] - mu; var += d * d; }
        var = wave_sum(var) * (1.f / 512.f);
        const float rs = rsqrtf(var + 1e-5f);
        const u32x4 gin = *(const u32x4*)(p->sg + off);
        const float* gg = p->gn_g + hd * 512 + lane * 8;
        const float* gb = p->gn_b + hd * 512 + lane * 8;
        float o[8];
#pragma unroll
        for (int i = 0; i < 8; ++i) {
            const float sgv = (i & 1) ? __uint_as_float(gin[i >> 1] & 0xffff0000u) : __uint_as_float(gin[i >> 1] << 16);
            o[i] = ((v[i] - mu) * rs * gg[i] + gb[i]) * sgv;
        }
        u32x4 w; w.x = pack2(o[0], o[1]); w.y = pack2(o[2], o[3]); w.z = pack2(o[4], o[5]); w.w = pack2(o[6], o[7]);
        *(u32x4*)(p->gated + off) = w;
    }
}

#define MAXLDS_(a, b) ((a) > (b) ? (a) : (b))
#define PHASE_LDS MAXLDS_(MAXLDS_(MAXLDS_(GEMM_LDS_BYTES, 2 * ATT_LDS_BYTES), 8 * 8192), 131072)
#define LDS_TOTAL (PHASE_LDS + 16 + 16 + 65 * 4 * 2 + 8)

__global__ void __launch_bounds__(NT, 2) mega(Params kparams) {
    extern __shared__ __attribute__((aligned(16))) unsigned char smem[];
    u16* lds = (u16*)smem;
    uint4* xbw = (uint4*)(smem + PHASE_LDS);
    unsigned* misc = (unsigned*)(smem + PHASE_LDS + 16);
    int* s_tp = (int*)(smem + PHASE_LDS + 32);
    int* s_off = s_tp + 65;
    if (threadIdx.x == 0) *xbw = make_uint4(0u, 0u, 0u, 0u);
    __syncthreads();
    XcdBarrier bar = xcd_barrier_post(getp()->bar, (volatile LAS unsigned*)xbw);

    ph_prep(getp());
    {
        KP p = getp();
        for (int u = blockIdx.x; u < 32 * 14; u += gridDim.x) cvtT_block(p->w_in0, p->w_in0t, 2048, IN_AB, u / 14, u % 14, smem);
    }
    xcd_barrier(bar);
    {
        KP p = getp();
        __syncthreads();
        pg8::Gemm g; g.A = p->xb; g.Bt = p->w_in0t; g.M = T_; g.N = 3584; g.K = D_;
        pg8::StaticOrder S; S.init(T_, 3584, (int)gridDim.x, (int)blockIdx.x);
        pg8::gemm_phase<PgEpiBf16N, pg8::StaticOrder>((PG8_LAS unsigned char*)smem, g, S, PgEpiBf16N{p->H0, IN_AB, IN_AB}, nullptr);
        __syncthreads();
    }
    xcd_barrier(bar);
    ph_post0(getp());
    xcd_barrier(bar);
    {
        KP p = getp();
        const int ntm = T_ / BM;
        const int n1 = ntm * 12, n2 = ntm * 16, n3 = 64 * 65 / 4;
        for (;;) {
            __syncthreads();
            if (threadIdx.x == 0) misc[0] = atomicAdd(&p->ctl[CTL_QUEUE + 2], 1u);
            __syncthreads();
            const int it = (int)misc[0];
            if (it >= n1 + n2 + n3) break;
            if (it >= n3) {
                const int t = it - n3;
                const bool isq = t < n1;
                const int u = isq ? t : t - n1, nt = u / ntm, mt = u % ntm;
                Acc acc; acc_zero(acc);
                gemm_accum<B_BF16_KN, false>(acc, isq ? p->cqn : p->ckvn, isq ? 512 : 256, RowId{mt * BM}, isq ? p->w_uqb : p->w_ukvb,
                                     isq ? 1536 : 2048, ColOff{nt * BN}, isq ? 512 : 256, lds);
                if (isq) EpiQa{p->qa, p->cosA, p->sinA, mt * BM, nt * BN}(acc, smem);
                else EpiKva{p->ka, p->vaT, mt * BM, nt * BN}(acc, smem);
            } else {
                const int u = 2 * (n3 - 1 - it) + (int)(threadIdx.x >> 8);
                int qt = (int)((sqrtf(8.f * (float)u + 1.f) - 1.f) * 0.5f);
                while ((qt + 1) * (qt + 2) / 2 <= u) ++qt;
                while (qt * (qt + 1) / 2 > u) --qt;
                const int kt = u - qt * (qt + 1) / 2;
                indexer_tile(p, qt, kt);
            }
        }
    }
    xcd_barrier(bar);
    ph_topk(getp(), smem);
    xcd_barrier(bar);
    ph_attn(getp(), smem, misc);
    xcd_barrier(bar);
    ph_mla_merge(getp());
    xcd_barrier(bar);
    {
        KP p = getp();
        __syncthreads();
        pg8::Gemm g; g.A = p->outcat; g.Bt = p->w_out0t; g.M = T_; g.N = D_; g.K = D_;
        pg8::StaticOrder S; S.init(T_, D_, (int)gridDim.x, (int)blockIdx.x);
        pg8::gemm_phase<PgEpiResidF, pg8::StaticOrder>((PG8_LAS unsigned char*)smem, g, S, PgEpiResidF{p->ybuf, p->x, D_}, nullptr);
        __syncthreads();
    }
    xcd_barrier(bar);
    { KP p = getp(); ph_ln<false, true, true, false>(p, p->ybuf, p->ln_mix_g[0], p->ln_mix_b[0], nullptr, p->xab, p->xlb); }
    xcd_barrier(bar);
    { KP p = getp(); ph_router(p, smem, p->ctl + CTL_CNT0, p->list); }
    xcd_barrier(bar);
    { KP p = getp(); ph_moe_up<0>(p, p->xab, smem, s_tp, s_off); }
    xcd_barrier(bar);
    { KP p = getp(); ph_moe_down<0>(p, p->xab, smem, s_tp, s_off); }
    xcd_barrier(bar);
    { KP p = getp(); ph_ln<true, false, true, false>(p, p->y2, p->ln_ffn_g[0], p->ln_ffn_b[0], nullptr, p->xcb, nullptr); }
    xcd_barrier(bar);
    {
        KP p = getp();
        __syncthreads();
        pg8::Gemm g; g.A = p->xcb; g.Bt = p->w_in1t; g.M = T_; g.N = IN_C; g.K = D_;
        pg8::StaticOrder S; S.init(T_, IN_C, (int)gridDim.x, (int)blockIdx.x);
        pg8::gemm_phase<PgEpiL1, pg8::StaticOrder>((PG8_LAS unsigned char*)smem, g, S, PgEpiL1{p}, nullptr);
        __syncthreads();
    }
    xcd_barrier(bar);
    ph_ret_a(getp(), lds);
    xcd_barrier(bar);
    ph_ret_b(getp());
    xcd_barrier(bar);
    ph_ret_c(getp(), lds);
    xcd_barrier(bar);
    ph_gn(getp());
    xcd_barrier(bar);
    {
        KP p = getp();
        __syncthreads();
        pg8::Gemm g; g.A = p->gated; g.Bt = p->w_out1t; g.M = T_; g.N = D_; g.K = 4096;
        pg8::StaticOrder S; S.init(T_, D_, (int)gridDim.x, (int)blockIdx.x);
        pg8::gemm_phase<PgEpiResid, pg8::StaticOrder>((PG8_LAS unsigned char*)smem, g, S, PgEpiResid{p->ybuf, p->xcb, D_}, nullptr);
        __syncthreads();
    }
    xcd_barrier(bar);
    { KP p = getp(); ph_ln<false, true, true, false>(p, p->ybuf, p->ln_mix_g[1], p->ln_mix_b[1], nullptr, p->xab, p->xlb); }
    xcd_barrier(bar);
    { KP p = getp(); ph_router(p, smem, p->ctl + CTL_CNT1, p->list); }
    xcd_barrier(bar);
    { KP p = getp(); ph_moe_up<1>(p, p->xab, smem, s_tp, s_off); }
    xcd_barrier(bar);
    { KP p = getp(); ph_moe_down<1>(p, p->xab, smem, s_tp, s_off); }
    xcd_barrier(bar);
    { KP p = getp(); ph_ln<true, false, false, true>(p, p->y2, p->ln_ffn_g[1], p->ln_ffn_b[1], p->out, nullptr, nullptr); }
    {
        KP p = getp();
        if (xb_ld(&p->bar[XB_TMO])) {
            asm volatile("s_waitcnt vmcnt(0)" ::: "memory");
            for (int i = blockIdx.x * NT + ltid(); i < p->out_size; i += gridDim.x * NT) p->out[i] = __uint_as_float(0x7fc00000u);
        }
    }
}

extern "C" void kernel_launch(void* const* d_in, const int* in_sizes, int n_in,
                              void* d_out, int out_size, void* d_ws, size_t ws_size,
                              hipStream_t stream) {
    const size_t kDynLds = LDS_TOTAL;
    static int grid = 0;
    if (!grid) {
        int dev = 0, cus = 0, per_cu = 0;
        (void)hipGetDevice(&dev);
        (void)hipDeviceGetAttribute(&cus, hipDeviceAttributeMultiprocessorCount, dev);
        (void)hipFuncSetAttribute((const void*)mega, hipFuncAttributeMaxDynamicSharedMemorySize, (int)kDynLds);
        (void)hipOccupancyMaxActiveBlocksPerMultiprocessor(&per_cu, mega, NT, kDynLds);
        grid = cus * (per_cu >= 1 ? 1 : 0);
    }
    unsigned char* ws = (unsigned char*)d_ws;
    size_t off = 0;
    auto take = [&](size_t bytes) { void* q = ws + off; off += (bytes + 255) & ~(size_t)255; return q; };
    Params p{};
    p.bar = (unsigned*)take(XCD_BAR_WORDS * 4);
    p.ctl = (unsigned*)take(CTL_WORDS * 4);
    const size_t ctl_bytes = off;
    (void)hipMemsetAsync(ws, 0, ctl_bytes, stream);
    auto F = [&](int i) { return (const float*)d_in[i]; };
    p.x = F(0); p.pos = (const int*)d_in[1]; p.router_w = F(2); p.router_b = F(3);
    p.w_in0 = F(4); p.q_norm = F(5); p.w_uq = F(6); p.kv_norm = F(7); p.w_ukv = F(8); p.w_out0 = F(9);
    p.w_in1 = F(10); p.gn_g = F(11); p.gn_b = F(12); p.w_out1 = F(13);
    for (int l = 0; l < 2; ++l) {
        const int b = 14 + 10 * l;
        p.ln_mix_g[l] = F(b); p.ln_mix_b[l] = F(b + 1);
        p.moe_wg[l] = F(b + 2); p.moe_wu[l] = F(b + 3); p.moe_wd[l] = F(b + 4);
        p.sh_g[l] = F(b + 5); p.sh_u[l] = F(b + 6); p.sh_d[l] = F(b + 7);
        p.ln_ffn_g[l] = F(b + 8); p.ln_ffn_b[l] = F(b + 9);
    }
    p.out = (float*)d_out;
    p.w_in0b = nullptr; p.w_in0t = (u16*)take((size_t)3584 * D_ * 2); p.w_uqb = (u16*)take(512 * 1536 * 2); p.w_ukvb = (u16*)take(256 * 2048 * 2);
    p.w_out0b = nullptr; p.w_in1b = nullptr; p.w_out1b = nullptr; p.w_out1t = (u16*)take((size_t)4096 * D_ * 2); p.w_out0t = (u16*)take((size_t)D_ * D_ * 2); p.w_in1t = (u16*)take((size_t)D_ * IN_C * 2);
    for (int l = 0; l < 2; ++l) { p.sh_gb[l] = nullptr; p.sh_ub[l] = nullptr; p.sh_db[l] = nullptr; p.sh_gut[l] = (u16*)take((size_t)2048 * D_ * 2); p.sh_dt[l] = (u16*)take((size_t)D_ * 1024 * 2); }
    const size_t T = T_;
    p.cosA = (float*)take(T * 32 * 4); p.sinA = (float*)take(T * 32 * 4);
    p.cosR = (float*)take(T * 128 * 4); p.sinR = (float*)take(T * 128 * 4);
    p.xb = (u16*)take(T * 2048 * 2); p.H0 = (u16*)take(T * IN_AB * 2);
    p.cqn = (u16*)take(T * 512 * 2); p.ckvn = (u16*)take(T * 256 * 2); p.kpe = (u16*)take(T * 64 * 2);
    p.qb = (u16*)take(T * 1024 * 2); p.kb = (u16*)take(T * 256 * 2); p.vb = (u16*)take(T * 256 * 2);
    p.iqb = (u16*)take(T * 1024 * 2); p.ikb = (u16*)take(T * 64 * 2); p.iwf = (float*)take(T * 16 * 4);
    p.qa = (u16*)take(T * 1536 * 2); p.ka = (u16*)take(T * 1024 * 2); p.vaT = (u16*)take(T * 1024 * 2);
    p.scores = (float*)take(T * T * 4); p.sel = (u16*)take(T * 256 * 2); p.outcat = (u16*)take(T * 2048 * 2); p.mla_po = (float*)take((size_t)256 * 256 * 128 * 4); p.mla_ml = (float*)take((size_t)256 * 256 * 2 * 4);
    p.ybuf = (u16*)take(T * 2048 * 2); p.xab = (u16*)take(T * 2048 * 2); p.xlb = (u16*)take(T * 2048 * 2); p.whT = (u16*)take(64 * 2048 * 2); p.wlT = (u16*)take(64 * 2048 * 2);
    p.y2 = (u16*)take(T * 2048 * 2); p.xcb = (u16*)take(T * 2048 * 2);
    p.tok_e = (int*)take(T * 2 * 4); p.tok_g = (float*)take(T * 2 * 4); p.list = (int*)take(2 * 64 * T * 4);
    p.hbuf = (u16*)take(T * 2 * 512 * 2); p.hsh = (u16*)take(T * 1024 * 2); p.yr = (u16*)take(T * 2 * 2048 * 2);
    p.qr = (u16*)take(T * 2048 * 2); p.qx = (u16*)take(T * 2048 * 2); p.kr = (u16*)take(T * 2048 * 2);
    p.kzT = nullptr; p.kz = (u16*)take(T * 2048 * 2); p.v1 = (u16*)take(T * 4096 * 2); p.sg = (u16*)take(T * 4096 * 2);
    p.innerG = (u16*)take((size_t)8 * 64 * 128 * 128 * 2);
    {
        unsigned char* sbase = (unsigned char*)p.scores;
        p.KVt = (u16*)sbase; p.obuf = (u16*)(sbase + ((size_t)128 << 20)); p.gated = (u16*)(sbase + ((size_t)192 << 20));
    }
    p.out_size = out_size; p.pad_ = 0;
    if (off > ws_size) return;
    mega<<<dim3(grid), dim3(NT), kDynLds, stream>>>(p);
}
```

```cpp
#include <hip/hip_runtime.h>
#include <stdint.h>

typedef unsigned short u16;
typedef __attribute__((ext_vector_type(8))) short bf16x8;
typedef __attribute__((ext_vector_type(4))) float f32x4;
typedef __attribute__((ext_vector_type(2))) float f32x2;
typedef __attribute__((ext_vector_type(4))) unsigned u32x4;
typedef __attribute__((ext_vector_type(2))) unsigned u32x2;
typedef __attribute__((ext_vector_type(2))) __bf16 bf16x2_t;
typedef __attribute__((ext_vector_type(4))) short s16x4;

#define XB_TMO      128
#define XB_XCNT(j)  (256  + 64 * (j))
#define XB_XSUB(j)  (1280 + 64 * (j))
#define XB_XGEN(j)  (2304 + 64 * (j))
#define XB_TOP      3328
#define XB_TOPGEN   3392
#define XCD_BAR_WORDS 3456
#define XB_SPIN_CAP (1u << 22)
#define LAS __attribute__((address_space(3)))

__device__ __forceinline__ unsigned xb_ld(unsigned* p)              { return __hip_atomic_load(p, __ATOMIC_RELAXED, __HIP_MEMORY_SCOPE_AGENT); }
__device__ __forceinline__ unsigned xb_add(unsigned* p, unsigned v) { return __hip_atomic_fetch_add(p, v, __ATOMIC_RELAXED, __HIP_MEMORY_SCOPE_AGENT); }
__device__ __forceinline__ unsigned xb_xcc_id() { return (unsigned)__builtin_amdgcn_s_getreg((3 << 11) | 20) & 0xFu; }
#define XB_SPIN(cond, bar) do { unsigned _sp = 0; while (cond) { __builtin_amdgcn_s_sleep(1); \
    if ((++_sp & 255u) == 0u) { if (xb_ld(&(bar)[XB_TMO])) break; if (_sp > XB_SPIN_CAP) { atomicAdd(&(bar)[XB_TMO], 1u); break; } } } } while (0)

struct XcdBarrier { unsigned* bar; unsigned x; volatile LAS unsigned* st; };

__device__ __forceinline__ XcdBarrier xcd_barrier_post(unsigned* bar, volatile LAS unsigned* st) {
    XcdBarrier b; b.bar = bar; b.x = xb_xcc_id(); b.st = st;
    if (threadIdx.x == 0) (void)xb_add(&bar[XB_XCNT(b.x)], 1u);
    return b;
}
__device__ __forceinline__ void xcd_barrier_complete(unsigned* bar, unsigned x, unsigned& nloc, unsigned& nx) {
    const unsigned G = gridDim.x * gridDim.y * gridDim.z;
    unsigned sum, cnt, mine, sp = 0u;
    for (;;) {
        sum = 0u; cnt = 0u; mine = 0u;
#pragma unroll
        for (unsigned j = 0; j < 16; ++j) { const unsigned c = xb_ld(&bar[XB_XCNT(j)]); sum += c; cnt += (c > 0u) ? 1u : 0u; mine = (j == x) ? c : mine; }
        if (sum == G) break;
        __builtin_amdgcn_s_sleep(1);
        if ((++sp & 255u) == 0u) { if (xb_ld(&bar[XB_TMO])) break; if (sp > XB_SPIN_CAP) { atomicAdd(&bar[XB_TMO], 1u); break; } }
    }
    nloc = mine > 0u ? mine : 1u; nx = cnt > 0u ? cnt : 1u;
}
__device__ __forceinline__ void xcd_barrier(const XcdBarrier& b) {
    asm volatile("s_waitcnt vmcnt(0)" ::: "memory");
    __syncthreads();
    if (threadIdx.x == 0) {
        unsigned* bar = b.bar;
        __builtin_amdgcn_s_waitcnt(0);
        unsigned nloc = b.st[0], nx = b.st[1];
        if (nloc == 0u) { xcd_barrier_complete(bar, b.x, nloc, nx); b.st[0] = nloc; b.st[1] = nx; }
        const unsigned old = xb_add(&bar[XB_XSUB(b.x)], 1u);
        const unsigned gen = old / nloc;
        if (old + 1u == (gen + 1u) * nloc) {
            __builtin_amdgcn_fence(__ATOMIC_RELEASE, "agent");
            asm volatile("s_waitcnt vmcnt(0)" ::: "memory");
            const unsigned og = xb_add(&bar[XB_TOP], 1u);
            const unsigned tg = og / nx;
            if (og + 1u == (tg + 1u) * nx) xb_add(&bar[XB_TOPGEN], 1u);
            else XB_SPIN(xb_ld(&bar[XB_TOPGEN]) == tg, bar);
            __builtin_amdgcn_fence(__ATOMIC_ACQUIRE, "agent");
            xb_add(&bar[XB_XGEN(b.x)], 1u);
            asm volatile("s_waitcnt vmcnt(0)" ::: "memory");
        } else {
            XB_SPIN(xb_ld(&bar[XB_XGEN(b.x)]) == gen, bar);
            __builtin_amdgcn_fence(__ATOMIC_ACQUIRE, "agent");
            asm volatile("s_waitcnt vmcnt(0)" ::: "memory");
        }
    }
    __syncthreads();
}

__device__ __forceinline__ int ltid() { int t = threadIdx.x; asm volatile("" : "+v"(t)); return t; }
__device__ __forceinline__ u16 f2bf(float f) {
    unsigned u = __float_as_uint(f);
    u += 0x7fffu + ((u >> 16) & 1u);
    return (u16)(u >> 16);
}
__device__ __forceinline__ float bf2f(u16 h) { return __uint_as_float(((unsigned)h) << 16); }
__device__ __forceinline__ unsigned pack2(float a, float b) {
    f32x2 v = {a, b};
    bf16x2_t r = __builtin_convertvector(v, bf16x2_t);
    return *(unsigned*)&r;
}

namespace pg8 {
#define PG8_LAS __attribute__((address_space(3)))
typedef unsigned short bf16_t;
typedef short bf16x8 __attribute__((ext_vector_type(8)));
typedef float f32x4 __attribute__((ext_vector_type(4)));
typedef unsigned u32x4 __attribute__((ext_vector_type(4)));
constexpr int BM = 256, BK = 64, HALF = 128, HTB = HALF * BK * 2  , STAGE_BYTES = 8 * HTB, NXCD = 8, WGM = 8;

__host__ __device__ __forceinline__ int lds_byte(int r, int c) { const int st = (r >> 4) * 2 + (c >> 5), rr = r & 15, cc = c & 31, ob = rr * 64 + cc * 2; return st * 1024 + (ob ^ (((ob >> 9) & 1) << 5)); }
__host__ __device__ __forceinline__ void stage_rc(int b, int& R, int& C) { const int st = b / 1024, sb = b % 1024, swz = sb ^ (((sb >> 9) & 1) << 5); R = (st >> 1) * 16 + swz / 64; C = (st & 1) * 32 + (swz % 64) / 2; }
__host__ __device__ __forceinline__ int perm32(int rho) { const int n = rho >> 4, i = rho & 15; return 8 * (i >> 2) + 4 * n + (i & 3); }

struct Unit { int pm, pn; };
struct Gemm { const bf16_t* A; const bf16_t* Bt; int M, N, K; };

struct StaticOrder {
    int nM, nN, nwg, G, c;
    __host__ __device__ void init(int M, int N, int G_, int c_) { nM = M / BM; nN = N / BM; nwg = nM * nN; G = G_; c = c_; }
    __host__ __device__ bool next(int i, Unit& u) const {
        const long L = (long)i * G + c; if (L >= nwg) return false;
        int wgid = (int)L; { const int q = nwg / NXCD, r = nwg % NXCD, xcd = wgid % NXCD, off = wgid / NXCD; wgid = (xcd < r ? xcd * (q + 1) : r * (q + 1) + (xcd - r) * q) + off; }
        const int nig = WGM * nN, gid = wgid / nig, fm = gid * WGM, gsz = (nM - fm) < WGM ? (nM - fm) : WGM;
        u.pm = fm + ((wgid % nig) % gsz); u.pn = (wgid % nig) / gsz; return true;
    }
    __device__ __forceinline__ void a_ready(const Unit&) const {}
    __device__ __forceinline__ void done(const Unit&) const {}
};
__device__ __forceinline__ unsigned cvt_pk_bf16(float lo, float hi) { unsigned r; asm volatile("v_cvt_pk_bf16_f32 %0, %1, %2" : "=v"(r) : "v"(lo), "v"(hi)); return r; }
template <class Epi, class Sched, bool STAMP = false>
__device__ __forceinline__ void gemm_phase(PG8_LAS unsigned char* lds, const Gemm g, const Sched& S, const Epi& E, unsigned long long* stamps) {
    const int tid = ltid(), wid = __builtin_amdgcn_readfirstlane(tid >> 6), lane = tid & 63, wr = wid >> 2, wc = wid & 3, fr = lane & 15, fq = lane >> 4;
    const int K = g.K, nt = K / BK;
    int ts_lo = 0, ts_hi = 0, nts = 0; const unsigned long long rt_entry = STAMP ? (unsigned long long)wall_clock64() : 0ull;
#define PG8_STAMP() do { if (STAMP && wid == 0 && nts < 64) { const unsigned long long _c = (unsigned long long)clock64(); \
        ts_lo = (lane == nts) ? (int)(unsigned)_c : ts_lo; ts_hi = (lane == nts) ? (int)(unsigned)(_c >> 32) : ts_hi; ++nts; } } while (0)
    PG8_STAMP();
    unsigned voffA[2], voffB[2];
#pragma unroll
    for (int i = 0; i < 2; ++i) { int R, C; stage_rc(tid * 16 + i * 8192, R, C); const int Rb = Epi::PERM ? ((R & ~31) + perm32(R & 31)) : R;
        voffA[i] = (unsigned)(R * K + C) * 2u; voffB[i] = (unsigned)(Rb * K + C) * 2u; }
    const size_t kstep = (size_t)(BK * 2);
    const size_t hstep = (size_t)HALF * K * 2;
    const size_t tstep = 2 * hstep;
    const unsigned ldsw = (unsigned)wid * 1024u;
    const int aoff = lds_byte(wr * 64 + fr, fq * 8), boff = lds_byte(wc * 32 + fr, fq * 8);
#define PG8_SA(b, h) (((b) * 2 + (h)) * HTB)
#define PG8_SB(b, h) ((4 + (b) * 2 + (h)) * HTB)
#define PG8_STAGE(bufoff, gbase, voff) do { _Pragma("unroll") for (int _i = 0; _i < 2; ++_i) \
        __builtin_amdgcn_global_load_lds((const unsigned*)((const char*)(gbase) + (voff)[_i]), (PG8_LAS unsigned*)(lds + (bufoff) + ldsw + _i * 8192), 16, 0, 0); } while (0)
#define PG8_LDA(dst, b, h) do { _Pragma("unroll") for (int m = 0; m < 4; ++m) _Pragma("unroll") for (int k = 0; k < 2; ++k) dst[m][k] = *(const PG8_LAS bf16x8*)(lds + PG8_SA(b, h) + aoff + m * 2048 + k * 1024); } while (0)
#define PG8_LDB(dst, b, h) do { _Pragma("unroll") for (int n = 0; n < 2; ++n) _Pragma("unroll") for (int k = 0; k < 2; ++k) dst[n][k] = *(const PG8_LAS bf16x8*)(lds + PG8_SB(b, h) + boff + n * 2048 + k * 1024); } while (0)
#define PG8_MMA(ai, bj, At, Bt) do { __builtin_amdgcn_s_setprio(1); _Pragma("unroll") for (int m = 0; m < 4; ++m) _Pragma("unroll") for (int n = 0; n < 2; ++n) _Pragma("unroll") for (int k = 0; k < 2; ++k) \
        acc[ai][bj][m][n] = __builtin_amdgcn_mfma_f32_16x16x32_bf16(Bt[n][k], At[m][k], acc[ai][bj][m][n], 0, 0, 0); __builtin_amdgcn_s_setprio(0); } while (0)
#define PG8_WAIT_V(n) asm volatile("s_waitcnt vmcnt(" #n ")" ::: "memory")
#define PG8_WAIT_L(n) asm volatile("s_waitcnt lgkmcnt(" #n ")" ::: "memory")
#define PG8_BAR __builtin_amdgcn_s_barrier()
#define PG8_SCHED __builtin_amdgcn_sched_barrier(0)
    Unit cur, nxt; int ui = 0;
    if (!S.next(0, cur)) return;
    f32x4 acc[2][2][4][2];
#pragma unroll
    for (int a = 0; a < 2; ++a)
#pragma unroll
        for (int b = 0; b < 2; ++b)
#pragma unroll
            for (int m = 0; m < 4; ++m)
#pragma unroll
                for (int n = 0; n < 2; ++n) acc[a][b][m][n] = (f32x4){0.f, 0.f, 0.f, 0.f};
    bf16x8 At[4][2], B0[2][2], B1[2][2];
    const char* cA = (const char*)g.A + (size_t)cur.pm * tstep; const char* cB = (const char*)g.Bt + (size_t)cur.pn * tstep;
    S.a_ready(cur);
    PG8_STAGE(PG8_SB(0, 0), cB, voffB); PG8_STAGE(PG8_SA(0, 0), cA, voffA); PG8_STAGE(PG8_SB(0, 1), cB + hstep, voffB); PG8_STAGE(PG8_SA(0, 1), cA + hstep, voffA);
    if (wr == 1) PG8_BAR;
    PG8_WAIT_V(4); PG8_BAR;
    PG8_STAGE(PG8_SB(1, 0), cB + kstep, voffB); PG8_STAGE(PG8_SA(1, 0), cA + kstep, voffA); PG8_STAGE(PG8_SB(1, 1), cB + hstep + kstep, voffB);
    PG8_WAIT_V(6); PG8_BAR;
    PG8_STAMP();
    for (;;) {
        const bool has_next = S.next(ui + 1, nxt);
        const char* nA = has_next ? (const char*)g.A + (size_t)nxt.pm * tstep : cA; const char* nB = has_next ? (const char*)g.Bt + (size_t)nxt.pn * tstep : cB;
        for (int t = 0; t < nt; t += 2) {
            const bool last = (t == nt - 2);
            const char* a1 = cA + (size_t)(t + 1) * kstep;
            const char* a2 = last ? nA : cA + (size_t)(t + 2) * kstep; const char* b2 = last ? nB : cB + (size_t)(t + 2) * kstep;
            const char* a3 = a2 + kstep; const char* b3 = b2 + kstep;
            if (last && has_next) S.a_ready(nxt);
            PG8_LDB(B0, 0, 0); PG8_SCHED; PG8_LDA(At, 0, 0); PG8_STAGE(PG8_SA(1, 1), a1 + hstep, voffA);
            PG8_WAIT_L(8); PG8_BAR; PG8_WAIT_L(0); PG8_MMA(0, 0, At, B0); PG8_BAR; PG8_SCHED;
            PG8_LDB(B1, 0, 1); PG8_STAGE(PG8_SB(0, 0), b2, voffB);
            PG8_BAR; PG8_WAIT_L(0); PG8_MMA(0, 1, At, B1); PG8_BAR;
            PG8_LDA(At, 0, 1); PG8_STAGE(PG8_SA(0, 0), a2, voffA);
            PG8_BAR; PG8_WAIT_L(0); PG8_MMA(1, 0, At, B0); PG8_BAR; PG8_SCHED;
            PG8_STAGE(PG8_SB(0, 1), b2 + hstep, voffB);
            PG8_WAIT_V(6); PG8_BAR; PG8_MMA(1, 1, At, B1); PG8_BAR;
            PG8_LDB(B0, 1, 0); PG8_SCHED; PG8_LDA(At, 1, 0); PG8_STAGE(PG8_SA(0, 1), a2 + hstep, voffA);
            PG8_WAIT_L(8); PG8_BAR; PG8_WAIT_L(0); PG8_MMA(0, 0, At, B0); PG8_BAR; PG8_SCHED;
            PG8_LDB(B1, 1, 1); PG8_STAGE(PG8_SB(1, 0), b3, voffB);
            PG8_BAR; PG8_WAIT_L(0); PG8_MMA(0, 1, At, B1); PG8_BAR;
            PG8_LDA(At, 1, 1); PG8_STAGE(PG8_SA(1, 0), a3, voffA);
            PG8_BAR; PG8_WAIT_L(0); PG8_MMA(1, 0, At, B0); PG8_BAR; PG8_SCHED;
            PG8_STAGE(PG8_SB(1, 1), b3 + hstep, voffB);
            PG8_WAIT_V(6); PG8_BAR; PG8_MMA(1, 1, At, B1); PG8_BAR;
        }
        PG8_STAMP();
        if constexpr (!Epi::AFTER_DRAIN) { E(acc, cur, wr, wc, fr, fq); S.done(cur); }
        PG8_STAMP();
        if (!has_next) break;
#pragma unroll
        for (int a = 0; a < 2; ++a)
#pragma unroll
            for (int b = 0; b < 2; ++b)
#pragma unroll
                for (int m = 0; m < 4; ++m)
#pragma unroll
                    for (int n = 0; n < 2; ++n) acc[a][b][m][n] = (f32x4){0.f, 0.f, 0.f, 0.f};
        cur = nxt; cA = nA; cB = nB; ++ui;
    }
    PG8_WAIT_V(0);
    if (wr == 0) PG8_BAR;
    PG8_BAR;
    if constexpr (Epi::AFTER_DRAIN) { E.fused(acc, cur, wr, wc, fr, fq, lds, wid, lane); S.done(cur); }
    PG8_STAMP();
    if (STAMP && wid == 0) { stamps[lane] = lane < nts ? (((unsigned long long)(unsigned)ts_hi << 32) | (unsigned)ts_lo) : 0ull;
        if (lane == 62) stamps[62] = rt_entry; if (lane == 63) stamps[63] = (unsigned long long)wall_clock64(); }
#undef PG8_STAMP
#undef PG8_SA
#undef PG8_SB
#undef PG8_STAGE
#undef PG8_LDA
#undef PG8_LDB
#undef PG8_MMA
#undef PG8_WAIT_V
#undef PG8_WAIT_L
#undef PG8_BAR
#undef PG8_SCHED
}
}

__device__ __forceinline__ float wave_sum(float v) {
#pragma unroll
    for (int o = 32; o > 0; o >>= 1) v += __shfl_xor(v, o);
    return v;
}
__device__ __forceinline__ float wave_max(float v) {
#pragma unroll
    for (int o = 32; o > 0; o >>= 1) v = fmaxf(v, __shfl_xor(v, o));
    return v;
}
__device__ __forceinline__ int wave_isum(int v) {
#pragma unroll
    for (int o = 32; o > 0; o >>= 1) v += __shfl_xor(v, o);
    return v;
}
__device__ __forceinline__ float silu_f(float x) { return x / (1.f + __expf(-x)); }

#define T_ 8192
#define D_ 2048
#define IN_AB 3472
#define IN_C 12288
#define NT 512
#define ALPHA_ 1.4142135623730951f
#define LOG2E_ 1.4426950408889634f

#define BM 256
#define BN 128
#define BK 64
#define LROW 80
#define GEMM_BUF (BM * LROW + BN * LROW)
#define GEMM_LDS_BYTES (2 * GEMM_BUF * 2)

#define B_F32_KN 0
#define B_BF16_NK 1
#define B_BF16_KN 2

typedef f32x4 Acc[4][4];

__device__ __forceinline__ __amdgpu_buffer_rsrc_t make_rsrc(const void* p) {
    const unsigned long long a = (unsigned long long)p;
    const unsigned lo = __builtin_amdgcn_readfirstlane((unsigned)a), hi = __builtin_amdgcn_readfirstlane((unsigned)(a >> 32));
    return __builtin_amdgcn_make_buffer_rsrc((void*)(((unsigned long long)hi << 32) | lo), 0, 0x7fffffff, 0x00020000);
}
__device__ __forceinline__ u32x4 bload16(__amdgpu_buffer_rsrc_t r, unsigned voff, unsigned soff) {
    return __builtin_amdgcn_raw_buffer_load_b128(r, (int)voff, (int)soff, 0);
}

__device__ __forceinline__ void acc_zero(Acc& acc) {
#pragma unroll
    for (int m = 0; m < 4; ++m)
#pragma unroll
        for (int n = 0; n < 4; ++n) acc[m][n] = (f32x4){0.f, 0.f, 0.f, 0.f};
}

template <int BMODE, bool KS, bool LONGK = false, class ARow, class BSel>
__device__ __forceinline__ void gemm_accum(Acc& acc, const u16* __restrict__ A, int lda, ARow arow,
                                           const void* __restrict__ Bv, int ldb, BSel bsel,
                                           int K, u16* lds) {
    const int tid = ltid(), lane = tid & 63;
    const int wid = __builtin_amdgcn_readfirstlane(tid >> 6);
    const int wr = KS ? ((wid & 3) >> 1) : (wid >> 1), wc = wid & 1, fr = lane & 15, fq = lane >> 4;
    constexpr int NA = KS ? 2 : 4;
    const int ac = tid & 7, ar0 = tid >> 3;
    unsigned ao[NA];
#pragma unroll
    for (int i = 0; i < NA; ++i) ao[i] = ((unsigned)arow(ar0 + 64 * i) * (unsigned)lda + ac * 8) * 2u;
    const int nk = K / BK;
    const int sa_w = ar0 * LROW + ac * 8;
    constexpr int SB0 = BM * LROW;
    const __amdgpu_buffer_rsrc_t rA = make_rsrc(A);

#define MMA16(AF, BF) do { \
        __builtin_amdgcn_s_setprio(1); \
        _Pragma("unroll") for (int m = 0; m < 4; ++m) \
        _Pragma("unroll") for (int n = 0; n < 4; ++n) \
            acc[m][n] = __builtin_amdgcn_mfma_f32_16x16x32_bf16(AF[m], BF[n], acc[m][n], 0, 0, 0); \
        __builtin_amdgcn_s_setprio(0); } while (0)
#define MEMFENCE_ asm volatile("" ::: "memory")
#define GEMM_COMPUTE(buf) do { \
        const u16* sA = lds + (buf) * GEMM_BUF; const u16* sB = sA + SB0; \
        _Pragma("unroll") for (int ks = 0; ks < 2; ++ks) { \
            if (KS && ks != (wid >> 2)) continue; \
            bf16x8 af[4], bfr[4]; \
            _Pragma("unroll") for (int m = 0; m < 4; ++m) af[m] = *(const bf16x8*)(sA + (wr * 64 + m * 16 + fr) * LROW + ks * 32 + fq * 8); \
            _Pragma("unroll") for (int n = 0; n < 4; ++n) bfr[n] = *(const bf16x8*)(sB + (wc * 64 + n * 16 + fr) * LROW + ks * 32 + fq * 8); \
            _Pragma("unroll") for (int m = 0; m < 4; ++m) \
            _Pragma("unroll") for (int n = 0; n < 4; ++n) \
                acc[m][n] = __builtin_amdgcn_mfma_f32_16x16x32_bf16(af[m], bfr[n], acc[m][n], 0, 0, 0); \
        } } while (0)

    __syncthreads();

#define FRAG_KN(buf, ks, AF, BF) do { \
        const u16* sA = lds + (buf) * GEMM_BUF; \
        const LAS char* cB = (const LAS char*)(lds + (buf) * GEMM_BUF); \
        _Pragma("unroll") for (int m = 0; m < 4; ++m) AF[m] = *(const bf16x8*)(sA + (wr * 64 + m * 16 + fr) * LROW + (ks) * 32 + fq * 8); \
        _Pragma("unroll") for (int n = 0; n < 4; ++n) { \
            const s16x4 lo_ = __builtin_amdgcn_ds_read_tr16_b64_v4i16((LAS s16x4*)(cB + rdo[0][n] + (ks) * 8192)); \
            const s16x4 hi_ = __builtin_amdgcn_ds_read_tr16_b64_v4i16((LAS s16x4*)(cB + rdo[1][n] + (ks) * 8192)); \
            BF[n] = __builtin_shufflevector(lo_, hi_, 0, 1, 2, 3, 4, 5, 6, 7); } } while (0)
    if constexpr (BMODE == B_BF16_KN) {
        const int ch8 = tid & 7, kr = tid >> 3;
        const __amdgpu_buffer_rsrc_t rB0 = make_rsrc(bsel.base16((const u16*)Bv, 0));
        const __amdgpu_buffer_rsrc_t rB1 = make_rsrc(bsel.base16((const u16*)Bv, 1));
        const unsigned ldb2 = (unsigned)ldb * 2u;
        const unsigned bof0 = (unsigned)kr * ldb2 + bsel.off8(0, ch8) * 2u, bof1 = (unsigned)kr * ldb2 + bsel.off8(1, ch8) * 2u;
        const int xw = ((kr & 3) << 2) | ((kr >> 2) & 3);
        const int sbw0 = SB0 * 2 + kr * 256 + 16 * (bsel.vchunk(0, ch8) ^ xw);
        const int sbw1 = SB0 * 2 + kr * 256 + 16 * (bsel.vchunk(1, ch8) ^ xw);
        int rdo[2][4];
#pragma unroll
        for (int t = 0; t < 2; ++t) {
            const int xr = ((fr >> 2) << 2) | ((2 * fq + t) & 3);
#pragma unroll
            for (int n = 0; n < 4; ++n)
                rdo[t][n] = SB0 * 2 + (8 * fq + 4 * t + (fr >> 2)) * 256 + 16 * ((2 * (wc * 4 + n) + ((fr & 3) >> 1)) ^ xr) + 8 * (fr & 1);
        }
        u32x4 ra0[NA], ra1[NA]; u32x4 rb0[2], rb1[2];
#define GL_KB(k0, RA, RB) do { \
        _Pragma("unroll") for (int i = 0; i < NA; ++i) RA[i] = bload16(rA, ao[i], (unsigned)(k0) * 2u); \
        const unsigned s0_ = (unsigned)(k0) * ldb2; \
        RB[0] = bload16(rB0, bof0, s0_); RB[1] = bload16(rB1, bof1, s0_); } while (0)
#define LW_KB(buf, RA, RB) do { \
        u16* sb_ = lds + (buf) * GEMM_BUF; \
        _Pragma("unroll") for (int i = 0; i < NA; ++i) *(u32x4*)(sb_ + sa_w + 64 * i * LROW) = RA[i]; \
        char* cb_ = (char*)sb_; \
        *(u32x4*)(cb_ + sbw0) = RB[0]; *(u32x4*)(cb_ + sbw1) = RB[1]; } while (0)
        GL_KB(0, ra0, rb0);
        GL_KB(BK, ra1, rb1);
        LW_KB(0, ra0, rb0);
        if (LONGK || 2 < nk) GL_KB((2 < nk ? 2 : nk - 1) * BK, ra0, rb0);
        __syncthreads();
        bf16x8 af0[4], bf0[4], af1[4], bf1[4];
        for (int kt = 0; kt < nk; kt += 2) {
            if (!KS) { FRAG_KN(0, 0, af0, bf0); } else { FRAG_KN(0, (wid >> 2), af0, bf0); }
            MEMFENCE_;
            LW_KB(1, ra1, rb1);
            if (LONGK || kt + 3 < nk) GL_KB((kt + 3 < nk ? kt + 3 : nk - 1) * BK, ra1, rb1);
            MEMFENCE_;
            if (!KS) FRAG_KN(0, 1, af1, bf1);
            MMA16(af0, bf0);
            if (!KS) MMA16(af1, bf1);
            __syncthreads();
            if (!KS) { FRAG_KN(1, 0, af0, bf0); } else { FRAG_KN(1, (wid >> 2), af0, bf0); }
            MEMFENCE_;
            if (LONGK || kt + 2 < nk) LW_KB(0, ra0, rb0);
            if (LONGK || kt + 4 < nk) GL_KB((kt + 4 < nk ? kt + 4 : nk - 1) * BK, ra0, rb0);
            MEMFENCE_;
            if (!KS) FRAG_KN(1, 1, af1, bf1);
            MMA16(af0, bf0);
            if (!KS) MMA16(af1, bf1);
            __syncthreads();
        }
#undef GL_KB
#undef LW_KB
    } else if constexpr (BMODE == B_F32_KN) {
        const int g4 = tid & 15, kr = tid >> 4;
        const __amdgpu_buffer_rsrc_t rB0 = make_rsrc(bsel.base((const float*)Bv, 0));
        const __amdgpu_buffer_rsrc_t rB1 = make_rsrc(bsel.base((const float*)Bv, 1));
        const unsigned ldb4 = (unsigned)ldb * 4u;
        const unsigned bof0 = (unsigned)kr * ldb4 + bsel.off4(0, g4) * 4u, bof1 = (unsigned)kr * ldb4 + bsel.off4(1, g4) * 4u;
        const int xw = ((kr & 3) << 2) | ((kr >> 2) & 3);
        const int v00 = bsel.vcol4(0, g4), v01 = bsel.vcol4(1, g4);
        const int sbw0 = SB0 * 2 + kr * 256 + 16 * ((v00 >> 3) ^ xw) + 8 * ((v00 >> 2) & 1);
        const int sbw1 = SB0 * 2 + kr * 256 + 16 * ((v01 >> 3) ^ xw) + 8 * ((v01 >> 2) & 1);
        int rdo[2][4];
#pragma unroll
        for (int t = 0; t < 2; ++t) {
            const int xr = ((fr >> 2) << 2) | ((2 * fq + t) & 3);
#pragma unroll
            for (int n = 0; n < 4; ++n)
                rdo[t][n] = SB0 * 2 + (8 * fq + 4 * t + (fr >> 2)) * 256 + 16 * ((2 * (wc * 4 + n) + ((fr & 3) >> 1)) ^ xr) + 8 * (fr & 1);
        }
        u32x4 ra0[NA], ra1[NA]; u32x4 rb0[4], rb1[4];
#define PK4_(V) (w_.x = pack2(__uint_as_float(V[0]), __uint_as_float(V[1])), w_.y = pack2(__uint_as_float(V[2]), __uint_as_float(V[3])))
#define GL_F32(k0, RA, RB) do { \
        _Pragma("unroll") for (int i = 0; i < NA; ++i) RA[i] = bload16(rA, ao[i], (unsigned)(k0) * 2u); \
        const unsigned s0_ = (unsigned)(k0) * ldb4, s1_ = s0_ + 32u * ldb4; \
        RB[0] = bload16(rB0, bof0, s0_); RB[1] = bload16(rB1, bof1, s0_); \
        RB[2] = bload16(rB0, bof0, s1_); RB[3] = bload16(rB1, bof1, s1_); } while (0)
#define LW_F32(buf, RA, RB) do { \
        u16* sb_ = lds + (buf) * GEMM_BUF; \
        _Pragma("unroll") for (int i = 0; i < NA; ++i) *(u32x4*)(sb_ + sa_w + 64 * i * LROW) = RA[i]; \
        char* cb_ = (char*)sb_; \
        u32x2 w_; \
        PK4_(RB[0]); *(u32x2*)(cb_ + sbw0) = w_; \
        PK4_(RB[1]); *(u32x2*)(cb_ + sbw1) = w_; \
        PK4_(RB[2]); *(u32x2*)(cb_ + sbw0 + 32 * 256) = w_; \
        PK4_(RB[3]); *(u32x2*)(cb_ + sbw1 + 32 * 256) = w_; } while (0)
        GL_F32(0, ra0, rb0);
        GL_F32(BK, ra1, rb1);
        LW_F32(0, ra0, rb0);
        if (LONGK || 2 < nk) GL_F32((2 < nk ? 2 : nk - 1) * BK, ra0, rb0);
        __syncthreads();
        bf16x8 af0[4], bf0[4], af1[4], bf1[4];
        for (int kt = 0; kt < nk; kt += 2) {
            if (!KS) { FRAG_KN(0, 0, af0, bf0); } else { FRAG_KN(0, (wid >> 2), af0, bf0); }
            MEMFENCE_;
            LW_F32(1, ra1, rb1);
            if (LONGK || kt + 3 < nk) GL_F32((kt + 3 < nk ? kt + 3 : nk - 1) * BK, ra1, rb1);
            MEMFENCE_;
            if (!KS) FRAG_KN(0, 1, af1, bf1);
            MMA16(af0, bf0);
            if (!KS) MMA16(af1, bf1);
            __syncthreads();
            if (!KS) { FRAG_KN(1, 0, af0, bf0); } else { FRAG_KN(1, (wid >> 2), af0, bf0); }
            MEMFENCE_;
            if (LONGK || kt + 2 < nk) LW_F32(0, ra0, rb0);
            if (LONGK || kt + 4 < nk) GL_F32((kt + 4 < nk ? kt + 4 : nk - 1) * BK, ra0, rb0);
            MEMFENCE_;
            if (!KS) FRAG_KN(1, 1, af1, bf1);
            MMA16(af0, bf0);
            if (!KS) MMA16(af1, bf1);
            __syncthreads();
        }
#undef GL_F32
#undef LW_F32
    } else {
        const __amdgpu_buffer_rsrc_t rB = make_rsrc(Bv);
        unsigned bo[2];
#pragma unroll
        for (int i = 0; i < 2; ++i) bo[i] = ((unsigned)bsel(ar0 + 64 * i) * (unsigned)ldb + ac * 8) * 2u;
        u32x4 ra0[NA], ra1[NA], rb0[2], rb1[2];
#define GL_BF(k0, RA, RB) do { \
        _Pragma("unroll") for (int i = 0; i < NA; ++i) RA[i] = bload16(rA, ao[i], (unsigned)(k0) * 2u); \
        _Pragma("unroll") for (int i = 0; i < 2; ++i) RB[i] = bload16(rB, bo[i], (unsigned)(k0) * 2u); } while (0)
#define LW_BF(buf, RA, RB) do { \
        u16* sb_ = lds + (buf) * GEMM_BUF; \
        _Pragma("unroll") for (int i = 0; i < NA; ++i) *(u32x4*)(sb_ + sa_w + 64 * i * LROW) = RA[i]; \
        _Pragma("unroll") for (int i = 0; i < 2; ++i) *(u32x4*)(sb_ + SB0 + sa_w + 64 * i * LROW) = RB[i]; } while (0)
        GL_BF(0, ra0, rb0);
        GL_BF(BK, ra1, rb1);
        LW_BF(0, ra0, rb0);
        if (LONGK || 2 < nk) GL_BF((2 < nk ? 2 : nk - 1) * BK, ra0, rb0);
        __syncthreads();
#define FRAG_NK(buf, ks, AF, BF) do { \
        const u16* sA = lds + (buf) * GEMM_BUF; const u16* sB = sA + SB0; \
        _Pragma("unroll") for (int m = 0; m < 4; ++m) AF[m] = *(const bf16x8*)(sA + (wr * 64 + m * 16 + fr) * LROW + (ks) * 32 + fq * 8); \
        _Pragma("unroll") for (int n = 0; n < 4; ++n) BF[n] = *(const bf16x8*)(sB + (wc * 64 + n * 16 + fr) * LROW + (ks) * 32 + fq * 8); } while (0)
        bf16x8 af0[4], bf0[4], af1[4], bf1[4];
        for (int kt = 0; kt < nk; kt += 2) {
            if (!KS) { FRAG_NK(0, 0, af0, bf0); } else { FRAG_NK(0, (wid >> 2), af0, bf0); }
            MEMFENCE_;
            LW_BF(1, ra1, rb1);
            if (LONGK || kt + 3 < nk) GL_BF((kt + 3 < nk ? kt + 3 : nk - 1) * BK, ra1, rb1);
            MEMFENCE_;
            if (!KS) FRAG_NK(0, 1, af1, bf1);
            MMA16(af0, bf0);
            if (!KS) MMA16(af1, bf1);
            __syncthreads();
            if (!KS) { FRAG_NK(1, 0, af0, bf0); } else { FRAG_NK(1, (wid >> 2), af0, bf0); }
            MEMFENCE_;
            if (LONGK || kt + 2 < nk) LW_BF(0, ra0, rb0);
            if (LONGK || kt + 4 < nk) GL_BF((kt + 4 < nk ? kt + 4 : nk - 1) * BK, ra0, rb0);
            MEMFENCE_;
            if (!KS) FRAG_NK(1, 1, af1, bf1);
            MMA16(af0, bf0);
            if (!KS) MMA16(af1, bf1);
            __syncthreads();
        }
#undef FRAG_NK
#undef GL_BF
#undef LW_BF
    }
#undef GEMM_COMPUTE
#undef FRAG_KN
}

__device__ __forceinline__ void gemm_kk128(Acc& acc, const u16* __restrict__ Akm, int lda, const u16* __restrict__ Bkn, int ldb, u16* lds) {
    const int tid = ltid(), lane = tid & 63;
    const int wid = __builtin_amdgcn_readfirstlane(tid >> 6);
    const int wr = wid >> 1, wc = wid & 1, fr = lane & 15, fq = lane >> 4;
    char* sA = (char*)lds;
    char* sB = (char*)lds + 65536;
    __syncthreads();
    {
        u32x4 ra[8], rb[4];
#pragma unroll
        for (int i = 0; i < 8; ++i) { const int k = (tid >> 5) + 16 * i, ch = tid & 31; ra[i] = *(const u32x4*)(Akm + (size_t)k * lda + ch * 8); }
#pragma unroll
        for (int i = 0; i < 4; ++i) { const int k = (tid >> 4) + 32 * i, ch = tid & 15; rb[i] = *(const u32x4*)(Bkn + (size_t)k * ldb + ch * 8); }
#pragma unroll
        for (int i = 0; i < 8; ++i) { const int k = (tid >> 5) + 16 * i, ch = tid & 31; const int x = ((k & 3) << 2) | ((k >> 2) & 3);
            *(u32x4*)(sA + k * 512 + 16 * (ch ^ x)) = ra[i]; }
#pragma unroll
        for (int i = 0; i < 4; ++i) { const int k = (tid >> 4) + 32 * i, ch = tid & 15; const int x = ((k & 3) << 2) | ((k >> 2) & 3);
            *(u32x4*)(sB + k * 256 + 16 * (ch ^ x)) = rb[i]; }
    }
    __syncthreads();
    const LAS char* cA = (const LAS char*)sA; const LAS char* cB = (const LAS char*)sB;
#pragma unroll
    for (int ks = 0; ks < 4; ++ks) {
        bf16x8 af[4], bfr[4];
#pragma unroll
        for (int t = 0; t < 2; ++t) { }
#pragma unroll
        for (int m = 0; m < 4; ++m) {
            const int row0 = 32 * ks + 8 * fq + (fr >> 2), xr0 = ((fr >> 2) << 2) | ((2 * fq) & 3), xr1 = ((fr >> 2) << 2) | ((2 * fq + 1) & 3);
            const int chunk = 2 * (wr * 4 + m) + ((fr & 3) >> 1);
            const s16x4 lo_ = __builtin_amdgcn_ds_read_tr16_b64_v4i16((LAS s16x4*)(cA + row0 * 512 + 16 * (chunk ^ xr0) + 8 * (fr & 1)));
            const s16x4 hi_ = __builtin_amdgcn_ds_read_tr16_b64_v4i16((LAS s16x4*)(cA + (row0 + 4) * 512 + 16 * (chunk ^ xr1) + 8 * (fr & 1)));
            af[m] = __builtin_shufflevector(lo_, hi_, 0, 1, 2, 3, 4, 5, 6, 7);
        }
#pragma unroll
        for (int n = 0; n < 4; ++n) {
            const int row0 = 32 * ks + 8 * fq + (fr >> 2), xr0 = ((fr >> 2) << 2) | ((2 * fq) & 3), xr1 = ((fr >> 2) << 2) | ((2 * fq + 1) & 3);
            const int chunk = 2 * (wc * 4 + n) + ((fr & 3) >> 1);
            const s16x4 lo_ = __builtin_amdgcn_ds_read_tr16_b64_v4i16((LAS s16x4*)(cB + row0 * 256 + 16 * (chunk ^ xr0) + 8 * (fr & 1)));
            const s16x4 hi_ = __builtin_amdgcn_ds_read_tr16_b64_v4i16((LAS s16x4*)(cB + (row0 + 4) * 256 + 16 * (chunk ^ xr1) + 8 * (fr & 1)));
            bfr[n] = __builtin_shufflevector(lo_, hi_, 0, 1, 2, 3, 4, 5, 6, 7);
        }
#pragma unroll
        for (int m = 0; m < 4; ++m)
#pragma unroll
            for (int n = 0; n < 4; ++n) acc[m][n] = __builtin_amdgcn_mfma_f32_16x16x32_bf16(af[m], bfr[n], acc[m][n], 0, 0, 0);
    }
    __syncthreads();
}

__device__ __forceinline__ bool ksplit_reduce(Acc& acc, u16* lds) {
    const int tid = ltid(), lane = tid & 63;
    const int wid = __builtin_amdgcn_readfirstlane(tid >> 6);
    float* f = (float*)lds + (wid & 3) * 4096 + lane;
    if (wid >= 4) {
#pragma unroll
        for (int m = 0; m < 4; ++m)
#pragma unroll
            for (int n = 0; n < 4; ++n)
#pragma unroll
                for (int j = 0; j < 4; ++j) f[((m * 4 + n) * 4 + j) * 64] = acc[m][n][j];
    }
    __syncthreads();
    if (wid < 4) {
#pragma unroll
        for (int m = 0; m < 4; ++m)
#pragma unroll
            for (int n = 0; n < 4; ++n)
#pragma unroll
                for (int j = 0; j < 4; ++j) acc[m][n][j] += f[((m * 4 + n) * 4 + j) * 64];
    }
    return wid < 4;
}


#define STG_LD 68
#define STG_WAVE_BYTES (32 * STG_LD * 4)
#define WR0_ ((ltid() >> 7) * 64)
#define WC0_ (((ltid() >> 6) & 1) * 64)
template <class F>
__device__ __forceinline__ void stage_rows(Acc& acc, unsigned char* stage_base, F f) {
    const int tid = ltid(), lane = tid & 63, wid = tid >> 6, fr = lane & 15, fq = lane >> 4;
    float* st = (float*)(stage_base + wid * STG_WAVE_BYTES);
#pragma unroll
    for (int h = 0; h < 2; ++h) {
#pragma unroll
        for (int mm = 0; mm < 2; ++mm)
#pragma unroll
            for (int n = 0; n < 4; ++n)
#pragma unroll
                for (int j = 0; j < 4; ++j) st[(mm * 16 + fq * 4 + j) * STG_LD + n * 16 + fr] = acc[2 * h + mm][n][j];
        __builtin_amdgcn_s_waitcnt(0xc07f);
#pragma unroll
        for (int i = 0; i < 8; ++i) {
            const int r = (lane >> 4) + 4 * i, c4 = (lane & 15) * 4;
            const f32x4 v = *(const f32x4*)(st + r * STG_LD + c4);
            f(h * 32 + r, c4, v);
        }
        __builtin_amdgcn_s_waitcnt(0xc07f);
    }
}
template <class F>
__device__ __forceinline__ void stage_pairs(Acc& acc, unsigned char* stage_base, F f) {
    const int tid = ltid(), lane = tid & 63, wid = tid >> 6, fr = lane & 15, fq = lane >> 4;
    float* st = (float*)(stage_base + wid * STG_WAVE_BYTES);
#pragma unroll
    for (int h = 0; h < 2; ++h) {
#pragma unroll
        for (int mm = 0; mm < 2; ++mm)
#pragma unroll
            for (int n = 0; n < 4; ++n)
#pragma unroll
                for (int j = 0; j < 4; ++j) st[(mm * 16 + fq * 4 + j) * STG_LD + n * 16 + fr] = acc[2 * h + mm][n][j];
        __builtin_amdgcn_s_waitcnt(0xc07f);
#pragma unroll
        for (int i = 0; i < 4; ++i) {
            const int r = (lane >> 3) + 8 * i, c4 = (lane & 7) * 4;
            const f32x4 lo = *(const f32x4*)(st + r * STG_LD + c4);
            const f32x4 hi = *(const f32x4*)(st + r * STG_LD + c4 + 32);
            f(h * 32 + r, c4, lo, hi);
        }
        __builtin_amdgcn_s_waitcnt(0xc07f);
    }
}

template <class AUX, class PRE, class F>
__device__ __forceinline__ void stage_rows_pre(Acc& acc, unsigned char* stage_base, PRE pre, F f) {
    const int tid = ltid(), lane = tid & 63, wid = tid >> 6, fr = lane & 15, fq = lane >> 4;
    float* st = (float*)(stage_base + wid * STG_WAVE_BYTES);
#pragma unroll
    for (int h = 0; h < 2; ++h) {
        AUX aux[8];
#pragma unroll
        for (int i = 0; i < 8; ++i) aux[i] = pre(h * 32 + (lane >> 4) + 4 * i, (lane & 15) * 4);
#pragma unroll
        for (int mm = 0; mm < 2; ++mm)
#pragma unroll
            for (int n = 0; n < 4; ++n)
#pragma unroll
                for (int j = 0; j < 4; ++j) st[(mm * 16 + fq * 4 + j) * STG_LD + n * 16 + fr] = acc[2 * h + mm][n][j];
        __builtin_amdgcn_s_waitcnt(0xc07f);
        f32x4 v[8];
#pragma unroll
        for (int i = 0; i < 8; ++i) v[i] = *(const f32x4*)(st + ((lane >> 4) + 4 * i) * STG_LD + (lane & 15) * 4);
        asm volatile("" ::: "memory");
#pragma unroll
        for (int i = 0; i < 8; ++i) f(h * 32 + (lane >> 4) + 4 * i, (lane & 15) * 4, v[i], aux[i]);
        __builtin_amdgcn_s_waitcnt(0xc07f);
    }
}
template <class AUX, class PRE, class F>
__device__ __forceinline__ void stage_pairs_pre(Acc& acc, unsigned char* stage_base, PRE pre, F f) {
    const int tid = ltid(), lane = tid & 63, wid = tid >> 6, fr = lane & 15, fq = lane >> 4;
    float* st = (float*)(stage_base + wid * STG_WAVE_BYTES);
#pragma unroll
    for (int h = 0; h < 2; ++h) {
        AUX aux[4];
#pragma unroll
        for (int i = 0; i < 4; ++i) aux[i] = pre(h * 32 + (lane >> 3) + 8 * i, (lane & 7) * 4);
#pragma unroll
        for (int mm = 0; mm < 2; ++mm)
#pragma unroll
            for (int n = 0; n < 4; ++n)
#pragma unroll
                for (int j = 0; j < 4; ++j) st[(mm * 16 + fq * 4 + j) * STG_LD + n * 16 + fr] = acc[2 * h + mm][n][j];
        __builtin_amdgcn_s_waitcnt(0xc07f);
        f32x4 lo[4], hi[4];
#pragma unroll
        for (int i = 0; i < 4; ++i) {
            lo[i] = *(const f32x4*)(st + ((lane >> 3) + 8 * i) * STG_LD + (lane & 7) * 4);
            hi[i] = *(const f32x4*)(st + ((lane >> 3) + 8 * i) * STG_LD + (lane & 7) * 4 + 32);
        }
        asm volatile("" ::: "memory");
#pragma unroll
        for (int i = 0; i < 4; ++i) f(h * 32 + (lane >> 3) + 8 * i, (lane & 7) * 4, lo[i], hi[i], aux[i]);
        __builtin_amdgcn_s_waitcnt(0xc07f);
    }
}
__device__ __forceinline__ u32x2 pack4(f32x4 v) { u32x2 w; w.x = pack2(v[0], v[1]); w.y = pack2(v[2], v[3]); return w; }

struct Params {
    const float* x; const int* pos; const float* router_w; const float* router_b;
    const float* w_in0; const float* q_norm; const float* w_uq; const float* kv_norm; const float* w_ukv; const float* w_out0;
    const float* w_in1; const float* gn_g; const float* gn_b; const float* w_out1;
    const float* ln_mix_g[2]; const float* ln_mix_b[2];
    const float* moe_wg[2]; const float* moe_wu[2]; const float* moe_wd[2];
    const float* sh_g[2]; const float* sh_u[2]; const float* sh_d[2];
    const float* ln_ffn_g[2]; const float* ln_ffn_b[2];
    float* out;
    u16* w_in0b; u16* w_uqb; u16* w_ukvb; u16* w_out0b; u16* w_in1b; u16* w_out1b; u16* w_out1t; u16* w_out0t; u16* w_in1t; u16* w_in0t; u16* sh_gut[2]; u16* sh_dt[2]; u16* sh_gb[2]; u16* sh_ub[2]; u16* sh_db[2];
    unsigned* bar; unsigned* ctl;
    float* cosA; float* sinA; float* cosR; float* sinR;
    u16* xb; u16* H0;
    u16* cqn; u16* ckvn; u16* kpe; u16* qb; u16* kb; u16* vb; u16* iqb; u16* ikb; float* iwf;
    u16* qa; u16* ka; u16* vaT;
    float* scores; u16* sel; u16* outcat; float* mla_po; float* mla_ml;
    u16* ybuf; u16* xab; u16* xlb; u16* whT; u16* wlT; u16* y2; u16* xcb;
    int* tok_e; float* tok_g; int* list; u16* hbuf; u16* hsh; u16* yr;
    u16* qr; u16* qx; u16* kr; u16* kzT; u16* v1; u16* kz; u16* sg; u16* KVt; u16* innerG; u16* obuf; u16* gated;
    int out_size; int pad_;
};
typedef const __attribute__((address_space(4))) Params* KP;
__device__ __forceinline__ KP getp() { KP kp = (KP)__builtin_amdgcn_kernarg_segment_ptr(); asm volatile("" : "+s"(kp)); return kp; }
#define CTL_FLAGS 0
#define CTL_QUEUE 16
#define CNT_STRIDE 32
#define CTL_CNT0 64
#define CTL_CNT1 (64 + 64 * CNT_STRIDE)
#define CTL_CNTX (64 + 128 * CNT_STRIDE)
#define CTL_WORDS (64 + 192 * CNT_STRIDE)

struct RowId { int base; __device__ __forceinline__ int operator()(int r) const { return base + r; } };
struct ColOff { int c0;
    __device__ __forceinline__ const u16* base16(const u16* B, int) const { return B; }
    __device__ __forceinline__ unsigned off8(int hsel, int ch8) const { return (unsigned)(c0 + hsel * 64 + ch8 * 8); }
    __device__ __forceinline__ int vchunk(int hsel, int ch8) const { return hsel * 8 + ch8; }
    __device__ __forceinline__ const float* base(const float* B, int) const { return B; }
    __device__ __forceinline__ unsigned off4(int hsel, int g4) const { return (unsigned)(c0 + hsel * 64 + g4 * 4); }
    __device__ __forceinline__ int vcol4(int hsel, int g4) const { return hsel * 64 + g4 * 4; } };
struct ColClampOff { int c0, n;
    __device__ __forceinline__ const u16* base16(const u16* B, int) const { return B; }
    __device__ __forceinline__ unsigned off8(int hsel, int ch8) const { const int c = c0 + hsel * 64 + ch8 * 8; return (unsigned)(c < n - 8 ? c : n - 8); }
    __device__ __forceinline__ int vchunk(int hsel, int ch8) const { return hsel * 8 + ch8; }
    __device__ __forceinline__ const float* base(const float* B, int) const { return B; }
    __device__ __forceinline__ unsigned off4(int hsel, int g4) const { const int c = c0 + hsel * 64 + g4 * 4; return (unsigned)(c < n - 4 ? c : n - 4); }
    __device__ __forceinline__ int vcol4(int hsel, int g4) const { return hsel * 64 + g4 * 4; } };

__device__ __forceinline__ void ph_prep(KP p) {
    const int gtid = blockIdx.x * NT + ltid(), gsz = gridDim.x * NT;
    for (size_t i = gtid; i < (size_t)T_ * D_ / 4; i += gsz) {
        float4 v = ((const float4*)p->x)[i];
        u32x2 o; o.x = pack2(v.x, v.y); o.y = pack2(v.z, v.w);
        ((u32x2*)p->xb)[i] = o;
    }
    for (int idx = gtid; idx < D_ * 64; idx += gsz) {
        const int k = idx >> 6, e = idx & 63;
        const float w = p->router_w[idx];
        const u16 hi = f2bf(w);
        p->whT[(size_t)e * D_ + k] = hi;
        p->wlT[(size_t)e * D_ + k] = f2bf(w - bf2f(hi));
    }
    {
        auto cvt = [&](const float* src, u16* dst, size_t n) {
            for (size_t i = gtid; i < n / 8; i += gsz) {
                const f32x4 a = ((const f32x4*)src)[2 * i], b = ((const f32x4*)src)[2 * i + 1];
                u32x4 o; o.x = pack2(a[0], a[1]); o.y = pack2(a[2], a[3]); o.z = pack2(b[0], b[1]); o.w = pack2(b[2], b[3]);
                ((u32x4*)dst)[i] = o;
            }
        };
        cvt(p->w_uq, p->w_uqb, (size_t)512 * 1536);
        cvt(p->w_ukv, p->w_ukvb, (size_t)256 * 2048);
    }
    const double inv2pi = 0.15915494309189535;
    for (int idx = gtid; idx < T_ * 32; idx += gsz) {
        const int t = idx >> 5, i = idx & 31;
        const float inv = (float)exp2(-(double)i * (18.931568569324174 / 32.0));
        double rev = (double)p->pos[t] * (double)inv * inv2pi;
        rev -= floor(rev);
        p->cosA[idx] = __builtin_amdgcn_cosf((float)rev);
        p->sinA[idx] = __builtin_amdgcn_sinf((float)rev);
    }
    for (int idx = gtid; idx < T_ * 128; idx += gsz) {
        const int t = idx >> 7, i = idx & 127;
        const float inv = (float)exp2(-(double)i * (13.287712379549449 / 128.0));
        double rev = (double)p->pos[t] * (double)inv * inv2pi;
        rev -= floor(rev);
        p->cosR[idx] = __builtin_amdgcn_cosf((float)rev);
        p->sinR[idx] = __builtin_amdgcn_sinf((float)rev);
    }
}

struct EpiF32 {
    float* C; int ldc; int row0, col0, ncols;
    __device__ __forceinline__ void operator()(Acc& acc, unsigned char* stg) const {
        const int rb = row0 + WR0_, cb = col0 + WC0_;
        float* Cp = C; const int ld = ldc, nc = ncols;
        stage_rows(acc, stg, [=](int r, int c4, f32x4 v) {
            const int c = cb + c4;
            if (c < nc) *(f32x4*)(Cp + (size_t)(rb + r) * ld + c) = v;
        });
    }
};
struct EpiBF16N {
    u16* C; int ldc; int row0, col0, ncols;
    __device__ __forceinline__ void operator()(Acc& acc, unsigned char* stg) const {
        const int rb = row0 + WR0_, cb = col0 + WC0_;
        u16* Cp = C; const int ld = ldc, nc = ncols;
        stage_rows(acc, stg, [=](int r, int c4, f32x4 v) {
            const int c = cb + c4;
            if (c < nc) *(u32x2*)(Cp + (size_t)(rb + r) * ld + c) = pack4(v);
        });
    }
};
struct EpiBF16 {
    u16* C; int ldc; int row0, col0;
    __device__ __forceinline__ void operator()(Acc& acc, unsigned char* stg) const {
        const int rb = row0 + WR0_, cb = col0 + WC0_;
        u16* Cp = C; const int ld = ldc;
        stage_rows(acc, stg, [=](int r, int c4, f32x4 v) { *(u32x2*)(Cp + (size_t)(rb + r) * ld + cb + c4) = pack4(v); });
    }
};
template <bool XB>
struct EpiResid {
    u16* C; const void* X; int ldc; int row0, col0;
    __device__ __forceinline__ void operator()(Acc& acc, unsigned char* stg) const {
        const int rb = row0 + WR0_, cb = col0 + WC0_;
        u16* Cp = C; const void* Xp = X; const int ld = ldc;
        stage_rows_pre<f32x4>(acc, stg,
            [=](int r, int c4) -> f32x4 {
                const size_t o = (size_t)(rb + r) * ld + cb + c4;
                f32x4 x;
                if constexpr (XB) {
                    const u32x2 xr = *(const u32x2*)((const u16*)Xp + o);
                    x[0] = __uint_as_float(xr.x << 16); x[1] = __uint_as_float(xr.x & 0xffff0000u);
                    x[2] = __uint_as_float(xr.y << 16); x[3] = __uint_as_float(xr.y & 0xffff0000u);
                } else x = *(const f32x4*)((const float*)Xp + o);
                return x; },
            [=](int r, int c4, f32x4 v, f32x4 x) {
                *(u32x2*)(Cp + (size_t)(rb + r) * ld + cb + c4) = pack4(x * ALPHA_ + v); });
    }
};

__device__ __forceinline__ void ph_post0(KP p) {
    const int lane = ltid() & 63;
    const int gw = (blockIdx.x * NT + ltid()) >> 6, nw = (gridDim.x * NT) >> 6;
    const float qscale = 0.08838834764831845f * LOG2E_;
    for (int t = gw; t < T_; t += nw) {
        const u16* hb = p->H0 + (size_t)t * IN_AB;
#define h_(i) bf2f(hb[i])
        const float* ca = p->cosA + t * 32;
        const float* sa = p->sinA + t * 32;
        {
            float v[8]; float ss = 0.f;
#pragma unroll
            for (int j = 0; j < 8; ++j) { v[j] = h_(lane + 64 * j); ss += v[j] * v[j]; }
            ss = wave_sum(ss);
            const float r = rsqrtf(ss * (1.f / 512.f) + 1e-6f);
#pragma unroll
            for (int j = 0; j < 8; ++j) p->cqn[(size_t)t * 512 + lane + 64 * j] = f2bf(v[j] * r * p->q_norm[lane + 64 * j]);
        }
        {
            float v[4]; float ss = 0.f;
#pragma unroll
            for (int j = 0; j < 4; ++j) { v[j] = h_(512 + lane + 64 * j); ss += v[j] * v[j]; }
            ss = wave_sum(ss);
            const float r = rsqrtf(ss * (1.f / 256.f) + 1e-6f);
#pragma unroll
            for (int j = 0; j < 4; ++j) p->ckvn[(size_t)t * 256 + lane + 64 * j] = f2bf(v[j] * r * p->kv_norm[lane + 64 * j]);
        }
        {
            const int i = lane & 31;
            const float c = ca[i], s = sa[i];
            const float x1 = h_(768 + i), x2 = h_(768 + 32 + i);
            p->kpe[(size_t)t * 64 + lane] = f2bf(lane < 32 ? x1 * c - x2 * s : x1 * s + x2 * c);
        }
#pragma unroll 4
        for (int j = 0; j < 16; ++j) {
            const int e = lane + 64 * j, hd = e >> 7, d = e & 127;
            float o;
            if (d < 32) {
                const int i = d & 15;
                const float c = ca[2 * i], s = sa[2 * i];
                const float x1 = h_(832 + hd * 128 + i), x2 = h_(832 + hd * 128 + 16 + i);
                o = d < 16 ? x1 * c - x2 * s : x1 * s + x2 * c;
            } else o = h_(832 + e);
            p->qb[(size_t)t * 1024 + e] = f2bf(o * qscale);
        }
#pragma unroll
        for (int j = 0; j < 4; ++j) {
            const int e = lane + 64 * j, hd = e >> 7, d = e & 127;
            float o;
            if (d < 32) {
                const int i = d & 15;
                const float c = ca[2 * i], s = sa[2 * i];
                const float x1 = h_(1856 + hd * 128 + i), x2 = h_(1856 + hd * 128 + 16 + i);
                o = d < 16 ? x1 * c - x2 * s : x1 * s + x2 * c;
            } else o = h_(1856 + e);
            p->kb[(size_t)t * 256 + e] = f2bf(o);
            p->vb[(size_t)t * 256 + e] = f2bf(h_(2112 + e));
        }
#pragma unroll 4
        for (int j = 0; j < 16; ++j) {
            const int e = lane + 64 * j, hd = e >> 6, d = e & 63;
            float o;
            if (d < 16) {
                const int i = d & 7;
                const float c = ca[4 * i], s = sa[4 * i];
                const float x1 = h_(2368 + hd * 64 + i), x2 = h_(2368 + hd * 64 + 8 + i);
                o = d < 8 ? x1 * c - x2 * s : x1 * s + x2 * c;
            } else o = h_(2368 + e);
            p->iqb[(size_t)t * 1024 + e] = f2bf(o);
        }
        {
            const int d = lane;
            float o;
            if (d < 16) {
                const int i = d & 7;
                const float c = ca[4 * i], s = sa[4 * i];
                const float x1 = h_(3392 + i), x2 = h_(3392 + 8 + i);
                o = d < 8 ? x1 * c - x2 * s : x1 * s + x2 * c;
            } else o = h_(3392 + d);
            p->ikb[(size_t)t * 64 + d] = f2bf(o);
        }
        if (lane < 16) p->iwf[t * 16 + lane] = h_(3456 + lane) * 0.03125f;
    }
#undef h_
}

struct CS8 { f32x4 c, s; };
struct EpiQa {
    u16* C; const float* ca; const float* sa; int row0, col0;
    __device__ __forceinline__ void operator()(Acc& acc, unsigned char* stg) const {
        const float sc = 0.07216878364870323f * LOG2E_;
        const int rb = row0 + WR0_, cbase = col0 + WC0_;
        const bool rope = (cbase % 192) == 128;
        u16* Cp = C; const float* cap = ca; const float* sap = sa;
        stage_pairs_pre<CS8>(acc, stg,
            [=](int r, int c4) -> CS8 {
                CS8 t; t.c = (f32x4){1.f, 1.f, 1.f, 1.f}; t.s = (f32x4){0.f, 0.f, 0.f, 0.f};
                if (rope) { t.c = *(const f32x4*)(cap + (rb + r) * 32 + c4); t.s = *(const f32x4*)(sap + (rb + r) * 32 + c4); }
                return t; },
            [=](int r, int c4, f32x4 lo, f32x4 hi, CS8 t) {
                const int tt = rb + r;
                const f32x4 a = lo * t.c - hi * t.s, b = lo * t.s + hi * t.c;
                *(u32x2*)(Cp + (size_t)tt * 1536 + cbase + c4) = pack4(a * sc);
                *(u32x2*)(Cp + (size_t)tt * 1536 + cbase + c4 + 32) = pack4(b * sc); });
    }
};
struct EpiKva {
    u16* ka; u16* vaT; int row0, col0;
    __device__ __forceinline__ void operator()(Acc& acc, unsigned char* stg) const {
        const int cbase = col0 + WC0_;
        const int hd = cbase >> 8, within = cbase & 255;
        if (within < 128) {
            const int rb = row0 + WR0_;
            u16* kp = ka + hd * 128 + within;
            stage_rows(acc, stg, [=](int r, int c4, f32x4 v) { *(u32x2*)(kp + (size_t)(rb + r) * 1024 + c4) = pack4(v); });
        } else {
            const int lane = ltid() & 63, fr = lane & 15, fq = lane >> 4;
#pragma unroll
            for (int m = 0; m < 4; ++m) {
                const int r = row0 + WR0_ + m * 16 + fq * 4;
#pragma unroll
                for (int n = 0; n < 4; ++n) {
                    const int c = within - 128 + n * 16 + fr;
                    u32x2 o; o.x = pack2(acc[m][n][0], acc[m][n][1]); o.y = pack2(acc[m][n][2], acc[m][n][3]);
                    *(u32x2*)(vaT + (size_t)(hd * 128 + c) * T_ + r) = o;
                }
            }
        }
    }
};

__device__ __forceinline__ void indexer_tile(KP p, int qt, int kt) {
    const int lane = ltid() & 63, wid = (ltid() >> 6) & 3;
    const int wr = wid >> 1, wc = wid & 1, fr = lane & 15, fq = lane >> 4;
    const int k0 = kt * 128 + wr * 64, q0 = qt * 128 + wc * 64;
    bf16x8 af[4][2];
#pragma unroll
    for (int m = 0; m < 4; ++m)
#pragma unroll
        for (int ks = 0; ks < 2; ++ks)
            af[m][ks] = *(const bf16x8*)(p->ikb + (size_t)(k0 + m * 16 + fr) * 64 + ks * 32 + fq * 8);
    Acc sc; acc_zero(sc);
    for (int h = 0; h < 16; ++h) {
        bf16x8 bq[4][2]; float w[4];
#pragma unroll
        for (int n = 0; n < 4; ++n) {
            const size_t qrow = (size_t)(q0 + n * 16 + fr);
            bq[n][0] = *(const bf16x8*)(p->iqb + qrow * 1024 + h * 64 + fq * 8);
            bq[n][1] = *(const bf16x8*)(p->iqb + qrow * 1024 + h * 64 + 32 + fq * 8);
            w[n] = p->iwf[qrow * 16 + h];
        }
#pragma unroll
        for (int m = 0; m < 4; ++m)
#pragma unroll
            for (int n = 0; n < 4; ++n) {
                f32x4 d = (f32x4){0.f, 0.f, 0.f, 0.f};
                d = __builtin_amdgcn_mfma_f32_16x16x32_bf16(af[m][0], bq[n][0], d, 0, 0, 0);
                d = __builtin_amdgcn_mfma_f32_16x16x32_bf16(af[m][1], bq[n][1], d, 0, 0, 0);
#pragma unroll
                for (int j = 0; j < 4; ++j) sc[m][n][j] += w[n] * fmaxf(d[j], 0.f);
            }
    }
#pragma unroll
    for (int m = 0; m < 4; ++m)
#pragma unroll
        for (int n = 0; n < 4; ++n)
            *(f32x4*)(p->scores + (size_t)(q0 + n * 16 + fr) * T_ + k0 + m * 16 + fq * 4) = sc[m][n];
}

__device__ __forceinline__ void indexer_item(KP p, int g) {
    const int lane = ltid() & 63, wid = __builtin_amdgcn_readfirstlane(ltid() >> 6);
    const int fr = lane & 15, fq = lane >> 4;
    const int q0 = g * 16, nkb = g + 1;
    bf16x8 bq[16][2]; float w[16];
    {
        const u16* qrow = p->iqb + (size_t)(q0 + fr) * 1024 + fq * 8;
#pragma unroll
        for (int h = 0; h < 16; ++h) { bq[h][0] = *(const bf16x8*)(qrow + h * 64); bq[h][1] = *(const bf16x8*)(qrow + h * 64 + 32); }
        const float* wrow = p->iwf + (size_t)(q0 + fr) * 16;
#pragma unroll
        for (int h4 = 0; h4 < 4; ++h4) {
            const f32x4 wv = *(const f32x4*)(wrow + h4 * 4);
#pragma unroll
            for (int j = 0; j < 4; ++j) w[h4 * 4 + j] = wv[j];
        }
    }
    const u16* kbase = p->ikb + (size_t)fr * 64 + fq * 8;
    float* srow = p->scores + (size_t)(q0 + fr) * T_ + 4 * fq;
#define IDX_LOAD(A, kb_) do { const int kc_ = (kb_) < nkb ? (kb_) : nkb - 1; \
        A[0] = *(const bf16x8*)(kbase + (size_t)kc_ * 1024); A[1] = *(const bf16x8*)(kbase + (size_t)kc_ * 1024 + 32); } while (0)
#define IDX_COMP(A, kb_) do { if ((kb_) < nkb) { \
        f32x4 sc_ = (f32x4){0.f, 0.f, 0.f, 0.f}; \
        _Pragma("unroll") for (int h = 0; h < 16; ++h) { \
            f32x4 d_ = (f32x4){0.f, 0.f, 0.f, 0.f}; \
            d_ = __builtin_amdgcn_mfma_f32_16x16x32_bf16(A[0], bq[h][0], d_, 0, 0, 0); \
            d_ = __builtin_amdgcn_mfma_f32_16x16x32_bf16(A[1], bq[h][1], d_, 0, 0, 0); \
            _Pragma("unroll") for (int j = 0; j < 4; ++j) sc_[j] += w[h] * fmaxf(d_[j], 0.f); } \
        *(f32x4*)(srow + (size_t)(kb_) * 16) = sc_; } } while (0)
    bf16x8 a0[2], a1[2], a2[2], a3[2];
    int kb = wid;
    IDX_LOAD(a0, kb); IDX_LOAD(a1, kb + 8); IDX_LOAD(a2, kb + 16); IDX_LOAD(a3, kb + 24);
    for (; kb < nkb; kb += 32) {
        IDX_COMP(a0, kb); IDX_LOAD(a0, kb + 32);
        IDX_COMP(a1, kb + 8); IDX_LOAD(a1, kb + 40);
        IDX_COMP(a2, kb + 16); IDX_LOAD(a2, kb + 48);
        IDX_COMP(a3, kb + 24); IDX_LOAD(a3, kb + 56);
    }
#undef IDX_LOAD
#undef IDX_COMP
}

__device__ __forceinline__ unsigned fkey(float f) {
    const unsigned u = __float_as_uint(f);
    return (u & 0x80000000u) ? ~u : (u | 0x80000000u);
}
#define TOPK_WLDS (1024 * 4 + 1024 * 2)
__device__ __forceinline__ void ph_topk(KP p, unsigned char* smem) {
    const int lane = ltid() & 63, wid = ltid() >> 6;
    const int gw = __builtin_amdgcn_readfirstlane((blockIdx.x * NT + ltid()) >> 6), nw = (gridDim.x * NT) >> 6;
    unsigned* ckey = (unsigned*)(smem + wid * TOPK_WLDS);
    u16* cidx = (u16*)(smem + wid * TOPK_WLDS + 4096);
    for (int qq = gw; qq < T_ / 2; qq += nw)
    for (int sside = 0; sside < 2; ++sside) {
        const int q = sside ? (T_ - 1 - qq) : qq;
        u16* so = p->sel + (size_t)q * 256;
        if (q < 256) {
#pragma unroll
            for (int i = 0; i < 4; ++i) { const int s = lane + 64 * i; so[s] = (u16)(s <= q ? s : 0); }
            continue;
        }
        const int ng = (q >> 10) + 1;
        unsigned key[128];
        const float* row = p->scores + (size_t)q * T_;
        unsigned gm[4] = {0u, 0u, 0u, 0u};
#pragma unroll
        for (int g = 0; g < 8; ++g) {
            if (g < ng) {
#pragma unroll
                for (int i = 0; i < 16; ++i) {
                    const int idx = lane + 64 * (g * 16 + i);
                    const unsigned kx = idx <= q ? fkey(row[idx]) : 0u;
                    key[g * 16 + i] = kx;
                    gm[i & 3] = kx > gm[i & 3] ? kx : gm[i & 3];
                }
            } else {
#pragma unroll
                for (int i = 0; i < 16; ++i) key[g * 16 + i] = 0u;
            }
        }
        unsigned Lk = gm[0] < gm[1] ? gm[0] : gm[1], Mk = gm[0] > gm[1] ? gm[0] : gm[1];
        { const unsigned l2 = gm[2] < gm[3] ? gm[2] : gm[3], m2 = gm[2] > gm[3] ? gm[2] : gm[3];
          Lk = Lk < l2 ? Lk : l2; Mk = Mk > m2 ? Mk : m2; }
#pragma unroll
        for (int o = 32; o > 0; o >>= 1) {
            const unsigned lo_ = (unsigned)__shfl_xor((int)Lk, o), mo_ = (unsigned)__shfl_xor((int)Mk, o);
            Lk = Lk < lo_ ? Lk : lo_; Mk = Mk > mo_ ? Mk : mo_;
        }
        Lk = (unsigned)__builtin_amdgcn_readfirstlane((int)Lk); Mk = (unsigned)__builtin_amdgcn_readfirstlane((int)Mk);
        unsigned prefix = 0u;
        int C = q + 1, b = 31;
        bool exact = false;
        if (Lk == Mk) { prefix = Mk; b = -1; }
        else { b = 31 - __builtin_clz(Lk ^ Mk); prefix = Mk & ~((2u << b) - 1u); }
        if (b < 31) {
            int cnt = 0;
#pragma unroll
            for (int g = 0; g < 8; ++g) {
                if (g < ng) {
#pragma unroll
                    for (int i = 0; i < 16; ++i) cnt += __builtin_popcountll(__ballot(key[g * 16 + i] >= prefix));
                }
            }
            C = cnt;
            if (cnt == 256) { exact = true; b = -1; }
        }
        for (; b >= 0 && C > 1024; --b) {
            const unsigned cand = prefix | (1u << b);
            int cnt = 0;
#pragma unroll
            for (int g = 0; g < 8; ++g) {
                if (g < ng) {
#pragma unroll
                    for (int i = 0; i < 16; ++i) cnt += __builtin_popcountll(__ballot(key[g * 16 + i] >= cand));
                }
            }
            if (cnt >= 256) { prefix = cand; C = cnt; }
            if (cnt == 256) { exact = true; --b; break; }
        }
        if (C > 1024) {
            int wp = 0;
#pragma unroll
            for (int g = 0; g < 8; ++g) {
                if (g < ng) {
#pragma unroll
                    for (int i = 0; i < 16; ++i) {
                        const bool gt = key[g * 16 + i] > prefix;
                        const unsigned long long m = __ballot(gt);
                        if (gt) so[wp + (int)__builtin_amdgcn_mbcnt_hi((unsigned)(m >> 32), __builtin_amdgcn_mbcnt_lo((unsigned)m, 0u))] = (u16)(lane + 64 * (g * 16 + i));
                        wp += __builtin_popcountll(m);
                    }
                }
            }
#pragma unroll
            for (int g = 0; g < 8; ++g) {
                if (g < ng && wp < 256) {
#pragma unroll
                    for (int i = 0; i < 16; ++i) {
                        const bool eq = key[g * 16 + i] == prefix && (lane + 64 * (g * 16 + i)) <= q;
                        const unsigned long long m = __ballot(eq);
                        if (eq) {
                            const int pos = wp + (int)__builtin_amdgcn_mbcnt_hi((unsigned)(m >> 32), __builtin_amdgcn_mbcnt_lo((unsigned)m, 0u));
                            if (pos < 256) so[pos] = (u16)(lane + 64 * (g * 16 + i));
                        }
                        wp += __builtin_popcountll(m);
                    }
                }
            }
            continue;
        }
        int base = 0;
#pragma unroll
        for (int g = 0; g < 8; ++g) {
            if (g < ng) {
#pragma unroll
                for (int i = 0; i < 16; ++i) {
                    const bool ge = key[g * 16 + i] >= prefix && (lane + 64 * (g * 16 + i)) <= q;
                    const unsigned long long m = __ballot(ge);
                    if (ge) {
                        const int pos = base + (int)__builtin_amdgcn_mbcnt_hi((unsigned)(m >> 32), __builtin_amdgcn_mbcnt_lo((unsigned)m, 0u));
                        ckey[pos] = key[g * 16 + i]; cidx[pos] = (u16)(lane + 64 * (g * 16 + i));
                    }
                    base += __builtin_popcountll(m);
                }
            }
        }
        __builtin_amdgcn_s_waitcnt(0xc07f);
        unsigned ck[16];
#pragma unroll
        for (int i = 0; i < 16; ++i) {
            const int s = lane + 64 * i;
            ck[i] = s < base ? ckey[s] : 0u;
        }
        if (!exact) {
            for (; b >= 0; --b) {
                const unsigned cand = prefix | (1u << b);
                int cnt = 0;
#pragma unroll
                for (int i = 0; i < 16; ++i) cnt += __builtin_popcountll(__ballot(ck[i] >= cand));
                if (cnt >= 256) prefix = cand;
                if (cnt == 256) break;
            }
        }
        int wpos = 0;
#pragma unroll
        for (int i = 0; i < 16; ++i) {
            const bool gt = ck[i] > prefix;
            const unsigned long long m = __ballot(gt);
            if (gt) so[wpos + (int)__builtin_amdgcn_mbcnt_hi((unsigned)(m >> 32), __builtin_amdgcn_mbcnt_lo((unsigned)m, 0u))] = cidx[lane + 64 * i];
            wpos += __builtin_popcountll(m);
        }
#pragma unroll
        for (int i = 0; i < 16; ++i) {
            if (wpos < 256) {
                const bool eq = ck[i] == prefix && (lane + 64 * i) < base;
                const unsigned long long m = __ballot(eq);
                if (eq) {
                    const int pos = wpos + (int)__builtin_amdgcn_mbcnt_hi((unsigned)(m >> 32), __builtin_amdgcn_mbcnt_lo((unsigned)m, 0u));
                    if (pos < 256) so[pos] = cidx[lane + 64 * i];
                }
                wpos += __builtin_popcountll(m);
            }
        }
        __builtin_amdgcn_s_waitcnt(0xc07f);
    }
}

#define KROW 208
#define VROW 80
#define ATT_LDS_BYTES (64 * KROW * 2 + 128 * VROW * 2)

__device__ __forceinline__ void mla_item(KP p, int h, int qb, u16* lds, int seg) {
    const int tid = ltid(), lane = tid & 63, wid = tid >> 6, fr = lane & 15, fq = lane >> 4;
    u16* sK = lds;
    u16* sV = lds + 64 * KROW;
    const int q0 = qb * 256;
    bf16x8 qf[2][6];
#pragma unroll
    for (int nq = 0; nq < 2; ++nq)
#pragma unroll
        for (int kc = 0; kc < 6; ++kc)
            qf[nq][kc] = *(const bf16x8*)(p->qa + (size_t)(q0 + wid * 32 + nq * 16 + fr) * 1536 + h * 192 + kc * 32 + fq * 8);
    f32x4 O[8][2];
#pragma unroll
    for (int m = 0; m < 8; ++m) { O[m][0] = (f32x4){0.f, 0.f, 0.f, 0.f}; O[m][1] = (f32x4){0.f, 0.f, 0.f, 0.f}; }
    float mrun[2] = {-1e30f, -1e30f}, lrun[2] = {0.f, 0.f};

    const int k0t = tid >> 4, k1t = tid >> 3;
    const u16* kpn = p->ka + (size_t)k0t * 1024 + h * 128 + (tid & 15) * 8;
    const u16* kpr = p->kpe + (size_t)k1t * 64 + (tid & 7) * 8;
    const u16* vpp = p->vaT + (size_t)(h * 128 + k1t) * T_ + (tid & 7) * 8;
    const int kln = (((k0t >> 2) & 1) * 16 + (k0t >> 3) * 4 + (k0t & 3)) * KROW + (tid & 15) * 8;
    const int e1 = k1t & 31;
    const int klr = ((k1t >> 5) * 32 + ((e1 >> 2) & 1) * 16 + (e1 >> 3) * 4 + (e1 & 3)) * KROW + 128 + (tid & 7) * 8;
    const int vl0 = k1t * VROW + (tid & 7) * 8;
    u32x4 kreg[3], vreg[2];
    const int ntiles = 4 * qb + 4;
    const int kt_lo = seg == 1 ? ntiles / 2 : 0, kt_hi = seg == 0 ? ntiles / 2 : ntiles;
#define ATT_GLOAD(kt) do { \
    _Pragma("unroll") for (int i = 0; i < 2; ++i) kreg[i] = *(const u32x4*)(kpn + (size_t)((kt) * 64 + 32 * i) * 1024); \
    kreg[2] = *(const u32x4*)(kpr + (size_t)((kt) * 64) * 64); \
    _Pragma("unroll") for (int i = 0; i < 2; ++i) vreg[i] = *(const u32x4*)(vpp + (size_t)(64 * i) * T_ + (kt) * 64); } while (0)
#define ATT_LWRITE(buf) do { \
        u16* sK_ = lds + (buf) * (ATT_LDS_BYTES / 2); u16* sV_ = sK_ + 64 * KROW; \
        _Pragma("unroll") for (int i = 0; i < 2; ++i) *(u32x4*)(sK_ + kln + 32 * i * KROW) = kreg[i]; \
        *(u32x4*)(sK_ + klr) = kreg[2]; \
        _Pragma("unroll") for (int i = 0; i < 2; ++i) *(u32x4*)(sV_ + vl0 + 64 * i * VROW) = vreg[i]; } while (0)
    ATT_GLOAD(kt_lo);
    __syncthreads();
    ATT_LWRITE(0);
    if (kt_lo + 1 < kt_hi) ATT_GLOAD(kt_lo + 1);
    __syncthreads();
    for (int kt = kt_lo; kt < kt_hi; ++kt) {
        const int cb = (kt - kt_lo) & 1;
        sK = lds + cb * (ATT_LDS_BYTES / 2);
        sV = sK + 64 * KROW;
        if (kt * 64 > q0 + wid * 32 + 31) {
            if (kt + 1 < kt_hi) ATT_LWRITE(cb ^ 1);
            if (kt + 2 < kt_hi) ATT_GLOAD(kt + 2);
            __syncthreads(); continue;
        }
        f32x4 s[2][4];
#pragma unroll
        for (int n = 0; n < 4; ++n) { s[0][n] = (f32x4){0.f, 0.f, 0.f, 0.f}; s[1][n] = (f32x4){0.f, 0.f, 0.f, 0.f}; }
#pragma unroll
        for (int kc = 0; kc < 6; ++kc)
#pragma unroll
            for (int n = 0; n < 4; ++n) {
                const bf16x8 a = *(const bf16x8*)(sK + (n * 16 + fr) * KROW + kc * 32 + fq * 8);
                s[0][n] = __builtin_amdgcn_mfma_f32_16x16x32_bf16(a, qf[0][kc], s[0][n], 0, 0, 0);
                s[1][n] = __builtin_amdgcn_mfma_f32_16x16x32_bf16(a, qf[1][kc], s[1][n], 0, 0, 0);
            }
        if (kt + 1 < kt_hi) ATT_LWRITE(cb ^ 1);
        if (kt + 2 < kt_hi) ATT_GLOAD(kt + 2);
        if (kt >= ntiles - 4) {
#pragma unroll
            for (int nq = 0; nq < 2; ++nq) {
                const int qi = q0 + wid * 32 + nq * 16 + fr;
#pragma unroll
                for (int n = 0; n < 4; ++n)
#pragma unroll
                    for (int j = 0; j < 4; ++j) {
                        const int ki = kt * 64 + (n >> 1) * 32 + fq * 8 + (n & 1) * 4 + j;
                        if (ki > qi) s[nq][n][j] = -1e30f;
                    }
            }
        }
        bf16x8 pf[2][2];
#pragma unroll
        for (int nq = 0; nq < 2; ++nq) {
            float mx = -1e30f;
#pragma unroll
            for (int n = 0; n < 4; ++n)
#pragma unroll
                for (int j = 0; j < 4; ++j) mx = fmaxf(mx, s[nq][n][j]);
            mx = fmaxf(mx, __shfl_xor(mx, 16));
            mx = fmaxf(mx, __shfl_xor(mx, 32));
            const float mnew = fmaxf(mrun[nq], mx);
            const float al = __builtin_amdgcn_exp2f(mrun[nq] - mnew);
            mrun[nq] = mnew;
            float ps = 0.f;
#pragma unroll
            for (int n = 0; n < 4; ++n)
#pragma unroll
                for (int j = 0; j < 4; ++j) { const float e = __builtin_amdgcn_exp2f(s[nq][n][j] - mnew); s[nq][n][j] = e; ps += e; }
            lrun[nq] = lrun[nq] * al + ps;
            if (__ballot(al != 1.0f) != 0ull) {
#pragma unroll
                for (int m = 0; m < 8; ++m) O[m][nq] *= al;
            }
#pragma unroll
            for (int c = 0; c < 2; ++c) {
                u32x4 w;
                w.x = pack2(s[nq][2 * c][0], s[nq][2 * c][1]);
                w.y = pack2(s[nq][2 * c][2], s[nq][2 * c][3]);
                w.z = pack2(s[nq][2 * c + 1][0], s[nq][2 * c + 1][1]);
                w.w = pack2(s[nq][2 * c + 1][2], s[nq][2 * c + 1][3]);
                pf[nq][c] = *(bf16x8*)&w;
            }
        }
#pragma unroll
        for (int m = 0; m < 8; ++m)
#pragma unroll
            for (int c = 0; c < 2; ++c) {
                const bf16x8 a = *(const bf16x8*)(sV + (m * 16 + fr) * VROW + c * 32 + fq * 8);
                O[m][0] = __builtin_amdgcn_mfma_f32_16x16x32_bf16(a, pf[0][c], O[m][0], 0, 0, 0);
                O[m][1] = __builtin_amdgcn_mfma_f32_16x16x32_bf16(a, pf[1][c], O[m][1], 0, 0, 0);
            }
        __syncthreads();
    }
#undef ATT_GLOAD
#undef ATT_LWRITE
#pragma unroll
    for (int nq = 0; nq < 2; ++nq) {
        float l = lrun[nq];
        l += __shfl_xor(l, 16);
        l += __shfl_xor(l, 32);
        const int qi = q0 + wid * 32 + nq * 16 + fr;
        if (seg < 0) {
            const float il = 1.f / l;
#pragma unroll
            for (int m = 0; m < 8; ++m) {
                u32x2 o;
                o.x = pack2(O[m][nq][0] * il, O[m][nq][1] * il);
                o.y = pack2(O[m][nq][2] * il, O[m][nq][3] * il);
                *(u32x2*)(p->outcat + (size_t)qi * 2048 + h * 128 + m * 16 + fq * 4) = o;
            }
        } else {
            const size_t slot = (size_t)((h * 16 + (qb - 16)) * 2 + seg);
            float* po = p->mla_po + (slot * 256 + (qi - q0)) * 128;
#pragma unroll
            for (int m = 0; m < 8; ++m) *(f32x4*)(po + m * 16 + fq * 4) = O[m][nq];
            if (fq == 0) { p->mla_ml[(slot * 256 + (qi - q0)) * 2] = mrun[nq]; p->mla_ml[(slot * 256 + (qi - q0)) * 2 + 1] = l; }
        }
    }
}

__device__ __forceinline__ void ph_mla_merge(KP p) {
    const int gtid = blockIdx.x * NT + ltid(), gsz = gridDim.x * NT;
    for (int i = gtid; i < 128 * 256 * 32; i += gsz) {
        const int d4 = i & 31, qq = (i >> 5) & 255, item = i >> 13;
        const int h = item >> 4, qb = 16 + (item & 15);
        const size_t s0 = (size_t)(item * 2) * 256 + qq, s1 = s0 + 256;
        const float m0 = p->mla_ml[s0 * 2], l0 = p->mla_ml[s0 * 2 + 1], m1 = p->mla_ml[s1 * 2], l1 = p->mla_ml[s1 * 2 + 1];
        const float m = fmaxf(m0, m1);
        const float w0 = __builtin_amdgcn_exp2f(m0 - m), w1 = __builtin_amdgcn_exp2f(m1 - m);
        const float il = 1.f / (l0 * w0 + l1 * w1);
        const f32x4 a = *(const f32x4*)(p->mla_po + s0 * 128 + d4 * 4), b = *(const f32x4*)(p->mla_po + s1 * 128 + d4 * 4);
        const f32x4 o = (a * w0 + b * w1) * il;
        *(u32x2*)(p->outcat + (size_t)(qb * 256 + qq) * 2048 + h * 128 + d4 * 4) = pack4(o);
    }
}

#define DSA_WLDS 5632
__device__ __forceinline__ void dsa_task(KP p, int q, int g, unsigned char* wl) {
    const int lane = ltid() & 63;
    u16* sQ = (u16*)wl;
    float* sP = (float*)(wl + 1024);
    u16* sS = (u16*)(wl + 1024 + 4096);
    const int nsel = q < 255 ? q + 1 : 256;
    {
        const u16* qsrc = p->qb + (size_t)q * 1024 + g * 512;
        *(u32x4*)(sQ + lane * 8) = *(const u32x4*)(qsrc + lane * 8);
        *(u32x2*)(sS + lane * 4) = *(const u32x2*)(p->sel + (size_t)q * 256 + lane * 4);
    }
    __builtin_amdgcn_s_waitcnt(0);
    float sc[4][4];
    float mx[4] = {-1e30f, -1e30f, -1e30f, -1e30f};
#pragma unroll
    for (int r = 0; r < 4; ++r) {
        const int slot = lane + 64 * r;
        float a0 = 0.f, a1 = 0.f, a2 = 0.f, a3 = 0.f;
        if (slot < nsel) {
            const int ki = sS[slot];
            const u16* kr = p->kb + (size_t)ki * 256 + g * 128;
#pragma unroll
            for (int c = 0; c < 16; ++c) {
                const u32x4 kv = *(const u32x4*)(kr + c * 8);
                const u32x4 q0v = *(const u32x4*)(sQ + 0 * 128 + c * 8);
                const u32x4 q1v = *(const u32x4*)(sQ + 1 * 128 + c * 8);
                const u32x4 q2v = *(const u32x4*)(sQ + 2 * 128 + c * 8);
                const u32x4 q3v = *(const u32x4*)(sQ + 3 * 128 + c * 8);
#pragma unroll
                for (int e = 0; e < 4; ++e) {
                    const unsigned kk = kv[e];
                    const bf16x2_t kb2 = *(const bf16x2_t*)&kk;
                    unsigned t0 = q0v[e], t1 = q1v[e], t2 = q2v[e], t3 = q3v[e];
                    a0 = __builtin_amdgcn_fdot2_f32_bf16(kb2, *(const bf16x2_t*)&t0, a0, false);
                    a1 = __builtin_amdgcn_fdot2_f32_bf16(kb2, *(const bf16x2_t*)&t1, a1, false);
                    a2 = __builtin_amdgcn_fdot2_f32_bf16(kb2, *(const bf16x2_t*)&t2, a2, false);
                    a3 = __builtin_amdgcn_fdot2_f32_bf16(kb2, *(const bf16x2_t*)&t3, a3, false);
                }
            }
        } else { a0 = a1 = a2 = a3 = -1e30f; }
        sc[r][0] = a0; sc[r][1] = a1; sc[r][2] = a2; sc[r][3] = a3;
        mx[0] = fmaxf(mx[0], a0); mx[1] = fmaxf(mx[1], a1); mx[2] = fmaxf(mx[2], a2); mx[3] = fmaxf(mx[3], a3);
    }
    float ls[4];
#pragma unroll
    for (int hh = 0; hh < 4; ++hh) {
        const float m = wave_max(mx[hh]);
        float s = 0.f;
#pragma unroll
        for (int r = 0; r < 4; ++r) { const float e = exp2f(sc[r][hh] - m); sc[r][hh] = e; s += e; }
        ls[hh] = wave_sum(s);
    }
#pragma unroll
    for (int r = 0; r < 4; ++r) {
        f32x4 pv = {sc[r][0], sc[r][1], sc[r][2], sc[r][3]};
        *(f32x4*)(sP + (lane + 64 * r) * 4) = pv;
    }
    __builtin_amdgcn_s_waitcnt(0);
    float o[4][8];
#pragma unroll
    for (int hh = 0; hh < 4; ++hh)
#pragma unroll
        for (int d = 0; d < 8; ++d) o[hh][d] = 0.f;
    const int kg = lane >> 4, dc = lane & 15;
    const u16* vbase = p->vb + g * 128 + dc * 8;
    const int nit = (nsel + 3) >> 2;
    for (int it = 0; it < nit; it += 4) {
        u32x4 vv[4]; f32x4 pp[4];
#pragma unroll
        for (int u = 0; u < 4; ++u) {
            if (it + u < nit) {
                const int slot = (it + u) * 4 + kg;
                const int ki = sS[slot];
                vv[u] = *(const u32x4*)(vbase + (size_t)ki * 256);
                pp[u] = *(const f32x4*)(sP + slot * 4);
            } else { vv[u] = (u32x4){0u, 0u, 0u, 0u}; pp[u] = (f32x4){0.f, 0.f, 0.f, 0.f}; }
        }
#pragma unroll
        for (int u = 0; u < 4; ++u)
#pragma unroll
            for (int e = 0; e < 4; ++e) {
                const float v0 = __uint_as_float(vv[u][e] << 16), v1 = __uint_as_float(vv[u][e] & 0xffff0000u);
#pragma unroll
                for (int hh = 0; hh < 4; ++hh) { o[hh][2 * e] += pp[u][hh] * v0; o[hh][2 * e + 1] += pp[u][hh] * v1; }
            }
    }
#pragma unroll
    for (int hh = 0; hh < 4; ++hh)
#pragma unroll
        for (int d = 0; d < 8; ++d) {
            float v = o[hh][d];
            v += __shfl_xor(v, 16);
            v += __shfl_xor(v, 32);
            o[hh][d] = v;
        }
    if (kg == 0) {
#pragma unroll
        for (int hh = 0; hh < 4; ++hh) {
            const float il = 1.f / ls[hh];
            u32x4 w;
            w.x = pack2(o[hh][0] * il, o[hh][1] * il); w.y = pack2(o[hh][2] * il, o[hh][3] * il);
            w.z = pack2(o[hh][4] * il, o[hh][5] * il); w.w = pack2(o[hh][6] * il, o[hh][7] * il);
            *(u32x4*)(p->outcat + (size_t)q * 2048 + 1024 + (g * 4 + hh) * 128 + dc * 8) = w;
        }
    }
    __builtin_amdgcn_s_waitcnt(0);
}

#define DSA2_WLDS (8192 + 512)
__device__ __forceinline__ void dsa_task2(KP p, int q, unsigned char* wl, u16* outp, int ldo, int coff) {
    const int lane = ltid() & 63, fr = lane & 15, fq = lane >> 4;
    unsigned char* sV = wl;
    u16* sS = (u16*)(wl + 8192);
    const int nsel = q < 255 ? q + 1 : 256;
    *(u32x2*)(sS + lane * 4) = *(const u32x2*)(p->sel + (size_t)q * 256 + lane * 4);
    const int vch = lane & 15, vr0 = lane >> 4;
    int rdo[2];
#pragma unroll
    for (int t = 0; t < 2; ++t) rdo[t] = (8 * fq + 4 * t + (fr >> 2)) * 256 + 8 * (fr & 1);
    const int xr0 = ((fr >> 2) << 2) | ((2 * fq) & 3), xr1 = ((fr >> 2) << 2) | ((2 * fq + 1) & 3);
    const int hsel = (fr & 3) >> 1;
    __builtin_amdgcn_s_waitcnt(0);
#pragma unroll 1
    for (int g = 0; g < 2; ++g) {
        bf16x8 qf[4];
#pragma unroll
        for (int c = 0; c < 4; ++c) {
            u32x4 v = (u32x4){0u, 0u, 0u, 0u};
            if (fr < 4) v = *(const u32x4*)(p->qb + (size_t)q * 1024 + (g * 4 + fr) * 128 + c * 32 + fq * 8);
            qf[c] = *(bf16x8*)&v;
        }
        f32x4 O[8];
#pragma unroll
        for (int cc = 0; cc < 8; ++cc) O[cc] = (f32x4){0.f, 0.f, 0.f, 0.f};
        float mrun = -1e30f, lrun = 0.f;
        const int nstep = (nsel + 31) >> 5;
        bf16x8 fa0[4], fb0[4], fa1[4], fb1[4];
        u32x4 vv0[8], vv1[8];
#define DSA_LOAD(c, FA, FB, VV) do { \
            const int ka_ = sS[32 * (c) + fr], kb_ = sS[32 * (c) + 16 + fr]; \
            const u16* kra = p->kb + (size_t)ka_ * 256 + g * 128 + fq * 8; \
            const u16* krb = p->kb + (size_t)kb_ * 256 + g * 128 + fq * 8; \
            _Pragma("unroll") for (int cc = 0; cc < 4; ++cc) { FA[cc] = *(const bf16x8*)(kra + cc * 32); FB[cc] = *(const bf16x8*)(krb + cc * 32); } \
            _Pragma("unroll") for (int i = 0; i < 8; ++i) { \
                const int r = vr0 + 4 * i; \
                const int kv = sS[32 * (c) + 16 * ((r >> 2) & 1) + 4 * (r >> 3) + (r & 3)]; \
                VV[i] = *(const u32x4*)(p->vb + (size_t)kv * 256 + g * 128 + vch * 8); } } while (0)
#define DSA_COMP(c, FA, FB, VV) do { \
            f32x4 s0 = (f32x4){0.f, 0.f, 0.f, 0.f}, s1 = (f32x4){0.f, 0.f, 0.f, 0.f}; \
            _Pragma("unroll") for (int cc = 0; cc < 4; ++cc) { \
                s0 = __builtin_amdgcn_mfma_f32_16x16x32_bf16(FA[cc], qf[cc], s0, 0, 0, 0); \
                s1 = __builtin_amdgcn_mfma_f32_16x16x32_bf16(FB[cc], qf[cc], s1, 0, 0, 0); } \
            float mx = -1e30f; \
            _Pragma("unroll") for (int j = 0; j < 4; ++j) { \
                if (32 * (c) + 4 * fq + j >= nsel) s0[j] = -1e30f; \
                if (32 * (c) + 16 + 4 * fq + j >= nsel) s1[j] = -1e30f; \
                mx = fmaxf(mx, fmaxf(s0[j], s1[j])); } \
            mx = fmaxf(mx, __shfl_xor(mx, 16)); \
            mx = fmaxf(mx, __shfl_xor(mx, 32)); \
            const float mnew = fmaxf(mrun, mx); \
            const float al = __builtin_amdgcn_exp2f(mrun - mnew); \
            mrun = mnew; \
            float ps = 0.f; \
            _Pragma("unroll") for (int j = 0; j < 4; ++j) { \
                s0[j] = __builtin_amdgcn_exp2f(s0[j] - mnew); s1[j] = __builtin_amdgcn_exp2f(s1[j] - mnew); \
                ps += s0[j] + s1[j]; } \
            lrun = lrun * al + ps; \
            if (__ballot(al != 1.0f) != 0ull) { _Pragma("unroll") for (int cc = 0; cc < 8; ++cc) O[cc] *= al; } \
            u32x4 pw; \
            pw.x = pack2(s0[0], s0[1]); pw.y = pack2(s0[2], s0[3]); pw.z = pack2(s1[0], s1[1]); pw.w = pack2(s1[2], s1[3]); \
            const bf16x8 pf = *(bf16x8*)&pw; \
            _Pragma("unroll") for (int i = 0; i < 8; ++i) { \
                const int r = vr0 + 4 * i; \
                *(u32x4*)(sV + r * 256 + 16 * (vch ^ (((r & 3) << 2) | ((r >> 2) & 3)))) = VV[i]; } \
            __builtin_amdgcn_s_waitcnt(0xc07f); \
            _Pragma("unroll") for (int cc = 0; cc < 8; ++cc) { \
                const s16x4 lo_ = __builtin_amdgcn_ds_read_tr16_b64_v4i16((LAS s16x4*)(sV + rdo[0] + 16 * ((2 * cc + hsel) ^ xr0))); \
                const s16x4 hi_ = __builtin_amdgcn_ds_read_tr16_b64_v4i16((LAS s16x4*)(sV + rdo[1] + 16 * ((2 * cc + hsel) ^ xr1))); \
                const bf16x8 vf = __builtin_shufflevector(lo_, hi_, 0, 1, 2, 3, 4, 5, 6, 7); \
                O[cc] = __builtin_amdgcn_mfma_f32_16x16x32_bf16(vf, pf, O[cc], 0, 0, 0); } \
            __builtin_amdgcn_s_waitcnt(0xc07f); } while (0)
        DSA_LOAD(0, fa0, fb0, vv0);
#pragma unroll 1
        for (int c = 0; c < nstep; c += 2) {
            if (c + 1 < nstep) DSA_LOAD(c + 1, fa1, fb1, vv1);
            DSA_COMP(c, fa0, fb0, vv0);
            if (c + 1 < nstep) {
                if (c + 2 < nstep) DSA_LOAD(c + 2, fa0, fb0, vv0);
                DSA_COMP(c + 1, fa1, fb1, vv1);
            }
        }
#undef DSA_LOAD
#undef DSA_COMP
        float l = lrun;
        l += __shfl_xor(l, 16);
        l += __shfl_xor(l, 32);
        if (fr < 4) {
            const float il = 1.f / l;
            u16* dst = outp + (size_t)q * ldo + coff + (g * 4 + fr) * 128 + 4 * fq;
#pragma unroll
            for (int cc = 0; cc < 8; ++cc) {
                u32x2 w; w.x = pack2(O[cc][0] * il, O[cc][1] * il); w.y = pack2(O[cc][2] * il, O[cc][3] * il);
                *(u32x2*)(dst + 16 * cc) = w;
            }
        }
    }
    __builtin_amdgcn_s_waitcnt(0);
}

#define ATT_NMLA 384
#define CVT_CHUNK (256 * 1024)
#define CVT_N_OUT0 16
#define CVT_N_IN1 96
#define CVT_N_OUT1 32
#define CVT_N_SH 8
#define ATT_NCVT (CVT_N_OUT0 + CVT_N_IN1 + CVT_N_OUT1 + 6 * CVT_N_SH)
template <int RMAP = 0>
__device__ __forceinline__ void cvtT_block(const float* src, u16* dst, int K, int N, int kb, int nb, unsigned char* smem) {
    const int tid = ltid();
    u16* t = (u16*)smem;
    __syncthreads();
#pragma unroll
    for (int i = 0; i < 8; ++i) {
        const int k = (tid >> 6) + 8 * i, n4 = (tid & 63) * 4;
        f32x4 v = (f32x4){0.f, 0.f, 0.f, 0.f};
        if (nb * 256 + n4 < N) v = *(const f32x4*)(src + (size_t)(kb * 64 + k) * N + nb * 256 + n4);
#pragma unroll
        for (int e = 0; e < 4; ++e) t[(n4 + e) * 72 + k] = f2bf(v[e]);
    }
    __syncthreads();
#pragma unroll
    for (int i = 0; i < 4; ++i) {
        const int n = (tid >> 3) + 64 * i, ch = tid & 7;
        const int drow = RMAP == 0 ? nb * 256 + n : 512 * nb + (n >> 7) * 256 + 128 * (RMAP - 1) + (n & 127);
        *(u32x4*)(dst + (size_t)drow * K + kb * 64 + ch * 8) = *(const u32x4*)(t + n * 72 + ch * 8);
    }
}
#define CVT_NT_OUT1 (64 * 8)
#define CVT_NT_OUT0 (32 * 8)
#define CVT_NT_IN1 (32 * 48)
#define CVT_NT_SHGU (32 * 4)
#define CVT_NT_SHD (16 * 8)
#define CVT_NT_SH (2 * CVT_NT_SHGU + CVT_NT_SHD)
__device__ __forceinline__ void cvt_item(KP p, int c, unsigned char* smem) {
    if (c >= ATT_NCVT) {
        int u = c - ATT_NCVT;
        if (u < CVT_NT_OUT1) { cvtT_block(p->w_out1, p->w_out1t, 4096, 2048, u >> 3, u & 7, smem); return; }
        u -= CVT_NT_OUT1;
        if (u < CVT_NT_OUT0) { cvtT_block(p->w_out0, p->w_out0t, 2048, 2048, u >> 3, u & 7, smem); return; }
        u -= CVT_NT_OUT0;
        if (u < CVT_NT_IN1) { cvtT_block(p->w_in1, p->w_in1t, 2048, IN_C, u / 48, u % 48, smem); return; }
        u -= CVT_NT_IN1;
        const int l = u / CVT_NT_SH; u -= l * CVT_NT_SH;
        if (u < CVT_NT_SHGU) { cvtT_block<1>(p->sh_g[l], p->sh_gut[l], 2048, 1024, u >> 2, u & 3, smem); return; }
        u -= CVT_NT_SHGU;
        if (u < CVT_NT_SHGU) { cvtT_block<2>(p->sh_u[l], p->sh_gut[l], 2048, 1024, u >> 2, u & 3, smem); return; }
        u -= CVT_NT_SHGU;
        cvtT_block(p->sh_d[l], p->sh_dt[l], 1024, 2048, u >> 3, u & 7, smem); return;
    }
    const float* src; u16* dst;
    if (c < CVT_N_OUT0) { return; }
    else if ((c -= CVT_N_OUT0) < CVT_N_IN1) { return; }
    else if ((c -= CVT_N_IN1) < CVT_N_OUT1) { return; }
    else {
        return;
        c -= CVT_N_OUT1;
        const int which = c / CVT_N_SH; c -= which * CVT_N_SH;
        const int l = which / 3, m = which % 3;
        src = m == 0 ? p->sh_g[l] : (m == 1 ? p->sh_u[l] : p->sh_d[l]);
        dst = m == 0 ? p->sh_gb[l] : (m == 1 ? p->sh_ub[l] : p->sh_db[l]);
    }
    const size_t base = (size_t)c * CVT_CHUNK;
    for (int i = ltid(); i < CVT_CHUNK / 8; i += NT) {
        const f32x4 a = *(const f32x4*)(src + base + (size_t)i * 8), b = *(const f32x4*)(src + base + (size_t)i * 8 + 4);
        u32x4 o; o.x = pack2(a[0], a[1]); o.y = pack2(a[2], a[3]); o.z = pack2(b[0], b[1]); o.w = pack2(b[2], b[3]);
        *(u32x4*)(dst + base + (size_t)i * 8) = o;
    }
}
__device__ const unsigned char mla_order[48] = {31, 63, 79, 30, 62, 29, 61, 78, 28, 60, 27, 59, 77, 26, 58, 25, 57, 76, 24, 56, 23, 55, 75, 22, 54, 21, 53, 74, 20, 52, 19, 51, 73, 18, 50, 17, 49, 72, 16, 48, 71, 70, 69, 68, 67, 66, 65, 64};
#define ATT_NTOTAL (ATT_NMLA + 512 + ATT_NCVT + CVT_NT_OUT1 + CVT_NT_OUT0 + CVT_NT_IN1 + 2 * CVT_NT_SH)
__device__ __forceinline__ void ph_attn(KP p, unsigned char* smem, unsigned* misc, int qword = CTL_QUEUE, int lo = 0, int hi = ATT_NTOTAL) {
    const int tid = ltid(), wid = tid >> 6;
    for (;;) {
        __syncthreads();
        if (tid == 0) misc[0] = atomicAdd(&p->ctl[qword], 1u);
        __syncthreads();
        const int it = (int)misc[0] + lo;
        if (it >= hi) break;
        if (it < ATT_NMLA) {
            const int e = mla_order[it >> 3];
            const int sg = e >> 5;
            mla_item(p, it & 7, e & 31, (u16*)smem, sg == 2 ? -1 : sg);
        } else if (it >= ATT_NMLA + 512) {
            cvt_item(p, it - ATT_NMLA - 512, smem);
        } else {
            const int base = (it - ATT_NMLA) * 16;
#ifdef DSA_VALU
            for (int k = 0; k < 4; ++k) {
                const int task = wid * 4 + k;
                dsa_task(p, base + (task >> 1), task & 1, smem + wid * DSA_WLDS);
            }
#else
            for (int k = 0; k < 2; ++k) dsa_task2(p, base + wid * 2 + k, smem + wid * DSA2_WLDS, p->outcat, 2048, 1024);
#endif
        }
    }
}
__device__ __forceinline__ float ret_log2g(int h);

struct PgEpiResid {
    static constexpr bool PERM = true, AFTER_DRAIN = false;
    u16* C; const u16* X; int ldc;
    __device__ __forceinline__ void operator()(const pg8::f32x4 (&acc)[2][2][4][2], const pg8::Unit& u, int wr, int wc, int fr, int fq) const {
        const int row0 = u.pm * 256 + wr * 64 + fr, col0 = u.pn * 256 + wc * 32 + 8 * fq;
#pragma unroll
        for (int ai = 0; ai < 2; ++ai) {
            u32x4 xv[4][2];
#pragma unroll
            for (int m = 0; m < 4; ++m)
#pragma unroll
                for (int bj = 0; bj < 2; ++bj) xv[m][bj] = *(const u32x4*)(X + (size_t)(row0 + ai * 128 + m * 16) * ldc + col0 + bj * 128);
#pragma unroll
            for (int m = 0; m < 4; ++m)
#pragma unroll
                for (int bj = 0; bj < 2; ++bj) {
                    const pg8::f32x4 v0 = acc[ai][bj][m][0], v1 = acc[ai][bj][m][1];
                    const u32x4 x = xv[m][bj];
                    u32x4 w;
                    w.x = pack2(__uint_as_float(x.x << 16) * ALPHA_ + v0[0], __uint_as_float(x.x & 0xffff0000u) * ALPHA_ + v0[1]);
                    w.y = pack2(__uint_as_float(x.y << 16) * ALPHA_ + v0[2], __uint_as_float(x.y & 0xffff0000u) * ALPHA_ + v0[3]);
                    w.z = pack2(__uint_as_float(x.z << 16) * ALPHA_ + v1[0], __uint_as_float(x.z & 0xffff0000u) * ALPHA_ + v1[1]);
                    w.w = pack2(__uint_as_float(x.w << 16) * ALPHA_ + v1[2], __uint_as_float(x.w & 0xffff0000u) * ALPHA_ + v1[3]);
                    *(u32x4*)(C + (size_t)(row0 + ai * 128 + m * 16) * ldc + col0 + bj * 128) = w;
                }
        }
    }
};

struct PgEpiResidF {
    static constexpr bool PERM = true, AFTER_DRAIN = false;
    u16* C; const float* X; int ldc;
    __device__ __forceinline__ void operator()(const pg8::f32x4 (&acc)[2][2][4][2], const pg8::Unit& u, int wr, int wc, int fr, int fq) const {
        const int row0 = u.pm * 256 + wr * 64 + fr, col0 = u.pn * 256 + wc * 32 + 8 * fq;
#pragma unroll
        for (int ai = 0; ai < 2; ++ai)
#pragma unroll
            for (int m = 0; m < 4; ++m) {
                f32x4 xv[2][2];
#pragma unroll
                for (int bj = 0; bj < 2; ++bj) {
                    const float* xp = X + (size_t)(row0 + ai * 128 + m * 16) * ldc + col0 + bj * 128;
                    xv[bj][0] = *(const f32x4*)xp; xv[bj][1] = *(const f32x4*)(xp + 4);
                }
#pragma unroll
                for (int bj = 0; bj < 2; ++bj) {
                    const f32x4 a = xv[bj][0] * ALPHA_ + acc[ai][bj][m][0], b = xv[bj][1] * ALPHA_ + acc[ai][bj][m][1];
                    u32x4 w; w.x = pack2(a[0], a[1]); w.y = pack2(a[2], a[3]); w.z = pack2(b[0], b[1]); w.w = pack2(b[2], b[3]);
                    *(u32x4*)(C + (size_t)(row0 + ai * 128 + m * 16) * ldc + col0 + bj * 128) = w;
                }
                asm volatile("" ::: "memory");
            }
    }
};
struct PgEpiL1 {
    static constexpr bool PERM = true, AFTER_DRAIN = false;
    KP p;
    __device__ __forceinline__ void operator()(const pg8::f32x4 (&acc)[2][2][4][2], const pg8::Unit& u, int wr, int wc, int fr, int fq) const {
        const int row0 = u.pm * 256 + wr * 64 + fr, ci = wc * 32 + 8 * fq;
        const int pn = u.pn;
        if (pn < 16) {
            const bool isk = pn >= 8; const int hd = pn & 7;
            const float l2g = ret_log2g(hd);
            const float* cR = p->cosR; const float* sR = p->sinR;
#pragma unroll
            for (int ai = 0; ai < 2; ++ai)
#pragma unroll
                for (int m = 0; m < 4; ++m) {
                    const int t = row0 + ai * 128 + m * 16;
                    const float dec = isk ? exp2f((float)(127 - (t & 127)) * l2g) : exp2f((float)((t & 127) + 1) * l2g);
                    f32x4 lo[2], hi[2];
#pragma unroll
                    for (int n = 0; n < 2; ++n) {
                        const f32x4 c = *(const f32x4*)(cR + t * 128 + ci + 4 * n), s = *(const f32x4*)(sR + t * 128 + ci + 4 * n);
                        const f32x4 x1 = acc[ai][0][m][n], x2 = acc[ai][1][m][n];
                        lo[n] = x1 * c - x2 * s; hi[n] = x1 * s + x2 * c;
                        if (isk) { lo[n] *= 0.0625f; hi[n] *= 0.0625f; }
                    }
                    const size_t o = (size_t)t * 2048 + hd * 256 + ci;
                    u16* d0 = isk ? p->kr : p->qr; u16* d1 = isk ? p->kz : p->qx;
                    u32x4 w;
                    w.x = pack2(lo[0][0], lo[0][1]); w.y = pack2(lo[0][2], lo[0][3]); w.z = pack2(lo[1][0], lo[1][1]); w.w = pack2(lo[1][2], lo[1][3]);
                    *(u32x4*)(d0 + o) = w;
                    w.x = pack2(hi[0][0], hi[0][1]); w.y = pack2(hi[0][2], hi[0][3]); w.z = pack2(hi[1][0], hi[1][1]); w.w = pack2(hi[1][2], hi[1][3]);
                    *(u32x4*)(d0 + o + 128) = w;
                    lo[0] *= dec; lo[1] *= dec; hi[0] *= dec; hi[1] *= dec;
                    w.x = pack2(lo[0][0], lo[0][1]); w.y = pack2(lo[0][2], lo[0][3]); w.z = pack2(lo[1][0], lo[1][1]); w.w = pack2(lo[1][2], lo[1][3]);
                    *(u32x4*)(d1 + o) = w;
                    w.x = pack2(hi[0][0], hi[0][1]); w.y = pack2(hi[0][2], hi[0][3]); w.z = pack2(hi[1][0], hi[1][1]); w.w = pack2(hi[1][2], hi[1][3]);
                    *(u32x4*)(d1 + o + 128) = w;
                    asm volatile("" ::: "memory");
                }
        } else {
            const bool isg = pn >= 32;
            u16* dst = isg ? p->sg : p->v1;
            const int cbase = (isg ? pn - 32 : pn - 16) * 256 + ci;
#pragma unroll
            for (int ai = 0; ai < 2; ++ai)
#pragma unroll
                for (int m = 0; m < 4; ++m)
#pragma unroll
                    for (int bj = 0; bj < 2; ++bj) {
                        f32x4 a = acc[ai][bj][m][0], b = acc[ai][bj][m][1];
                        if (isg) {
#pragma unroll
                            for (int e = 0; e < 4; ++e) { a[e] = silu_f(a[e]); b[e] = silu_f(b[e]); }
                        }
                        u32x4 w; w.x = pack2(a[0], a[1]); w.y = pack2(a[2], a[3]); w.z = pack2(b[0], b[1]); w.w = pack2(b[2], b[3]);
                        *(u32x4*)(dst + (size_t)(row0 + ai * 128 + m * 16) * 4096 + cbase + bj * 128) = w;
                    }
        }
    }
};

struct PgEpiBf16N {
    static constexpr bool PERM = true, AFTER_DRAIN = false;
    u16* C; int ldc; int ncols;
    __device__ __forceinline__ void operator()(const pg8::f32x4 (&acc)[2][2][4][2], const pg8::Unit& u, int wr, int wc, int fr, int fq) const {
        const int row0 = u.pm * 256 + wr * 64 + fr, col0 = u.pn * 256 + wc * 32 + 8 * fq;
#pragma unroll
        for (int ai = 0; ai < 2; ++ai)
#pragma unroll
            for (int m = 0; m < 4; ++m)
#pragma unroll
                for (int bj = 0; bj < 2; ++bj) {
                    const int c = col0 + bj * 128;
                    if (c < ncols) {
                        const pg8::f32x4 a = acc[ai][bj][m][0], b = acc[ai][bj][m][1];
                        u32x4 w; w.x = pack2(a[0], a[1]); w.y = pack2(a[2], a[3]); w.z = pack2(b[0], b[1]); w.w = pack2(b[2], b[3]);
                        *(u32x4*)(C + (size_t)(row0 + ai * 128 + m * 16) * ldc + c) = w;
                    }
                }
    }
};
struct PgEpiSwiglu {
    static constexpr bool PERM = true, AFTER_DRAIN = false;
    u16* C; int ldc;
    __device__ __forceinline__ void operator()(const pg8::f32x4 (&acc)[2][2][4][2], const pg8::Unit& u, int wr, int wc, int fr, int fq) const {
        const int row0 = u.pm * 256 + wr * 64 + fr, col0 = u.pn * 128 + wc * 32 + 8 * fq;
#pragma unroll
        for (int ai = 0; ai < 2; ++ai)
#pragma unroll
            for (int m = 0; m < 4; ++m) {
                const pg8::f32x4 g0 = acc[ai][0][m][0], g1 = acc[ai][0][m][1], u0 = acc[ai][1][m][0], u1 = acc[ai][1][m][1];
                float o[8];
#pragma unroll
                for (int e = 0; e < 4; ++e) { o[e] = silu_f(g0[e]) * u0[e]; o[4 + e] = silu_f(g1[e]) * u1[e]; }
                u32x4 w; w.x = pack2(o[0], o[1]); w.y = pack2(o[2], o[3]); w.z = pack2(o[4], o[5]); w.w = pack2(o[6], o[7]);
                *(u32x4*)(C + (size_t)(row0 + ai * 128 + m * 16) * ldc + col0) = w;
            }
    }
};
template <bool ADD_ROUTED, bool ROUTE, bool WRITE_B, bool WRITE_F>
__device__ __forceinline__ void ph_ln(KP p, const u16* Y, const float* g, const float* b, float* XF, u16* XB, u16* XL) {
    const int lane = ltid() & 63;
    const int gw = (blockIdx.x * NT + ltid()) >> 6, nw = (gridDim.x * NT) >> 6;
    for (int t0 = gw; t0 < T_; t0 += 2 * nw) {
        u32x2 raw[2][8], r0raw[2][8], r1raw[2][8];
#pragma unroll
        for (int rr = 0; rr < 2; ++rr) {
            const int t = t0 + rr * nw < T_ ? t0 + rr * nw : t0;
            const u16* y = Y + (size_t)t * D_;
#pragma unroll
            for (int j = 0; j < 8; ++j) raw[rr][j] = *(const u32x2*)(y + j * 256 + lane * 4);
            if constexpr (ADD_ROUTED) {
                const u16* r0 = p->yr + (size_t)(2 * t) * D_;
                const u16* r1 = r0 + D_;
#pragma unroll
                for (int j = 0; j < 8; ++j) { r0raw[rr][j] = *(const u32x2*)(r0 + j * 256 + lane * 4); r1raw[rr][j] = *(const u32x2*)(r1 + j * 256 + lane * 4); }
            }
        }
#pragma unroll
        for (int rr = 0; rr < 2; ++rr) {
            const int t = t0 + rr * nw;
            if (t >= T_) break;
            float v[32];
            float sum = 0.f;
#pragma unroll
            for (int j = 0; j < 8; ++j) {
                const u32x2 a = raw[rr][j];
                v[4 * j] = __uint_as_float(a.x << 16); v[4 * j + 1] = __uint_as_float(a.x & 0xffff0000u);
                v[4 * j + 2] = __uint_as_float(a.y << 16); v[4 * j + 3] = __uint_as_float(a.y & 0xffff0000u);
            }
            if constexpr (ADD_ROUTED) {
#pragma unroll
                for (int j = 0; j < 8; ++j) {
                    const u32x2 a = r0raw[rr][j], c = r1raw[rr][j];
                    v[4 * j]     += __uint_as_float(a.x << 16) + __uint_as_float(c.x << 16);
                    v[4 * j + 1] += __uint_as_float(a.x & 0xffff0000u) + __uint_as_float(c.x & 0xffff0000u);
                    v[4 * j + 2] += __uint_as_float(a.y << 16) + __uint_as_float(c.y << 16);
                    v[4 * j + 3] += __uint_as_float(a.y & 0xffff0000u) + __uint_as_float(c.y & 0xffff0000u);
                }
            }
#pragma unroll
            for (int i = 0; i < 32; ++i) sum += v[i];
            const float mu = wave_sum(sum) * (1.f / 2048.f);
            float var = 0.f;
#pragma unroll
            for (int i = 0; i < 32; ++i) { const float d = v[i] - mu; var += d * d; }
            var = wave_sum(var) * (1.f / 2048.f);
            const float rs = rsqrtf(var + 1e-5f);
#pragma unroll
            for (int j = 0; j < 8; ++j) {
                const int c = j * 256 + lane * 4;
                const f32x4 gg = *(const f32x4*)(g + c), bb = *(const f32x4*)(b + c);
                f32x4 o;
#pragma unroll
                for (int e = 0; e < 4; ++e) o[e] = (v[4 * j + e] - mu) * rs * gg[e] + bb[e];
                if constexpr (WRITE_F) *(f32x4*)(XF + (size_t)t * D_ + c) = o;
                if constexpr (WRITE_B) {
                    u32x2 w; w.x = pack2(o[0], o[1]); w.y = pack2(o[2], o[3]);
                    *(u32x2*)(XB + (size_t)t * D_ + c) = w;
                    if constexpr (ROUTE) {
                        u32x2 wl;
                        wl.x = pack2(o[0] - __uint_as_float(w.x << 16), o[1] - __uint_as_float(w.x & 0xffff0000u));
                        wl.y = pack2(o[2] - __uint_as_float(w.y << 16), o[3] - __uint_as_float(w.y & 0xffff0000u));
                        *(u32x2*)(XL + (size_t)t * D_ + c) = wl;
                    }
                }
            }
        }
    }
}

__device__ __forceinline__ void route_token(KP p, int t, float logit, int lane, unsigned* cnt, int* list) {
    const float sc = 1.f / (1.f + __expf(-logit));
    const float bi = sc + p->router_b[lane];
    float m1 = bi;
    m1 = fmaxf(m1, __shfl_xor(m1, 1)); m1 = fmaxf(m1, __shfl_xor(m1, 2)); m1 = fmaxf(m1, __shfl_xor(m1, 4));
    const int seg = lane >> 3;
    unsigned long long bal = __ballot(bi == m1);
    const int f1 = __builtin_ctz((unsigned)((bal >> (seg * 8)) & 0xffull));
    const float b2 = ((lane & 7) == f1) ? -1e30f : bi;
    float m2 = b2;
    m2 = fmaxf(m2, __shfl_xor(m2, 1)); m2 = fmaxf(m2, __shfl_xor(m2, 2)); m2 = fmaxf(m2, __shfl_xor(m2, 4));
    bal = __ballot(b2 == m2);
    const int f2 = __builtin_ctz((unsigned)((bal >> (seg * 8)) & 0xffull));
    const float gs = m1 + m2;
    float gm = gs;
    gm = fmaxf(gm, __shfl_xor(gm, 8)); gm = fmaxf(gm, __shfl_xor(gm, 16)); gm = fmaxf(gm, __shfl_xor(gm, 32));
    bal = __ballot(gs == gm);
    const int gsel = (int)(__builtin_ctzll(bal) >> 3);
    const int e0 = gsel * 8 + __shfl(f1, gsel * 8);
    const int e1 = gsel * 8 + __shfl(f2, gsel * 8);
    const float s0 = __shfl(sc, e0), s1 = __shfl(sc, e1);
    if (lane == 0) {
        const float inv = 1.f / (s0 + s1);
        const unsigned p0 = atomicAdd(&cnt[e0 * CNT_STRIDE], 1u);
        const unsigned p1 = atomicAdd(&cnt[e1 * CNT_STRIDE], 1u);
        list[e0 * T_ + p0] = 2 * t;
        list[e1 * T_ + p1] = 2 * t + 1;
        p->tok_g[2 * t] = s0 * inv;
        p->tok_g[2 * t + 1] = s1 * inv;
    }
}

__device__ __forceinline__ void ph_router(KP p, unsigned char* smem, unsigned* cnt, int* list) {
    const int tid = ltid(), lane = tid & 63, wid = tid >> 6, grp = wid >> 2, kq = wid & 3, fr = lane & 15, fq = lane >> 4;
    float* part = (float*)smem;
    for (int blk = blockIdx.x; blk < T_ / 32; blk += gridDim.x) {
        const int t0 = blk * 32 + grp * 16;
        f32x4 acc[4];
#pragma unroll
        for (int c = 0; c < 4; ++c) acc[c] = (f32x4){0.f, 0.f, 0.f, 0.f};
        const u16* ah = p->xab + (size_t)(t0 + fr) * D_ + kq * 512 + fq * 8;
        const u16* al = p->xlb + (size_t)(t0 + fr) * D_ + kq * 512 + fq * 8;
        const u16* bh = p->whT + (size_t)fr * D_ + kq * 512 + fq * 8;
        const u16* bl = p->wlT + (size_t)fr * D_ + kq * 512 + fq * 8;
#pragma unroll 2
        for (int s = 0; s < 16; ++s) {
            const bf16x8 xh = *(const bf16x8*)(ah + 32 * s), xl = *(const bf16x8*)(al + 32 * s);
#pragma unroll
            for (int c = 0; c < 4; ++c) {
                const bf16x8 wh = *(const bf16x8*)(bh + (size_t)c * 16 * D_ + 32 * s);
                const bf16x8 wl = *(const bf16x8*)(bl + (size_t)c * 16 * D_ + 32 * s);
                acc[c] = __builtin_amdgcn_mfma_f32_16x16x32_bf16(xh, wh, acc[c], 0, 0, 0);
                acc[c] = __builtin_amdgcn_mfma_f32_16x16x32_bf16(xh, wl, acc[c], 0, 0, 0);
                acc[c] = __builtin_amdgcn_mfma_f32_16x16x32_bf16(xl, wh, acc[c], 0, 0, 0);
            }
        }
        float* mine = part + (grp * 4 + kq) * 1024;
#pragma unroll
        for (int c = 0; c < 4; ++c)
#pragma unroll
            for (int j = 0; j < 4; ++j) mine[(4 * fq + j) * 64 + 16 * c + fr] = acc[c][j];
        __syncthreads();
#pragma unroll
        for (int tt = 0; tt < 4; ++tt) {
            const int tok = 4 * kq + tt;
            const float* q = part + (grp * 4) * 1024 + tok * 64 + lane;
            const float logit = (q[0] + q[1024]) + (q[2048] + q[3072]);
            route_token(p, t0 + tok, logit, lane, cnt, list);
        }
        __syncthreads();
    }
}

struct ColGateUp16 { int c0; const u16* up;
    __device__ __forceinline__ const u16* base16(const u16* B, int hsel) const { return hsel ? up : B; }
    __device__ __forceinline__ unsigned off8(int hsel, int ch8) const { return (unsigned)(c0 + ch8 * 8); }
    __device__ __forceinline__ int vchunk(int hsel, int ch8) const { const int r = ch8 * 8; return ((r >> 5) * 64 + hsel * 32 + (r & 31)) >> 3; } };
struct ColGateUp { int c0; const float* up;
    __device__ __forceinline__ const float* base(const float* B, int hsel) const { return hsel ? up : B; }
    __device__ __forceinline__ unsigned off4(int hsel, int g4) const { return (unsigned)(c0 + g4 * 4); }
    __device__ __forceinline__ int vcol4(int hsel, int g4) const { const int r = g4 * 4; return (r >> 5) * 64 + hsel * 32 + (r & 31); } };
struct RowList { const int* lst; int m0, n; __device__ __forceinline__ int operator()(int r) const { const int i = m0 + r; return lst[i < n ? i : n - 1] >> 1; } };
struct EpiSwiglu {
    u16* C; int ldc; int row0, c0, nrows;
    __device__ __forceinline__ void operator()(Acc& acc, unsigned char* stg) const {
        const int wr0 = WR0_, cb = c0 + (WC0_ >> 1);
        u16* Cp = C; const int ld = ldc, rbase = row0, nr = nrows;
        stage_pairs(acc, stg, [=](int r, int c4, f32x4 g, f32x4 u) {
            const int rr = wr0 + r;
            if (rr < nr) {
                f32x4 o;
#pragma unroll
                for (int e = 0; e < 4; ++e) o[e] = silu_f(g[e]) * u[e];
                *(u32x2*)(Cp + (size_t)(rbase + rr) * ld + cb + c4) = pack4(o);
            }
        });
    }
};
struct SlotGate { int slot; float g; };
struct EpiDownRouted {
    u16* yr; const int* lst; const float* tg; int m0, n, col0;
    __device__ __forceinline__ void operator()(Acc& acc, unsigned char* stg) const {
        const int wr0 = WR0_, cb = col0 + WC0_;
        u16* yp = yr; const int* lp = lst; const float* tgp = tg; const int mm0 = m0, nn = n;
        stage_rows_pre<SlotGate>(acc, stg,
            [=](int r, int c4) -> SlotGate {
                const int i = mm0 + wr0 + r;
                SlotGate sg; sg.slot = -1; sg.g = 0.f;
                if (i < nn) { sg.slot = lp[i]; sg.g = tgp[sg.slot]; }
                return sg; },
            [=](int r, int c4, f32x4 v, SlotGate sg) {
                if (sg.slot >= 0) *(u32x2*)(yp + (size_t)sg.slot * D_ + cb + c4) = pack4(v * sg.g); });
    }
};

struct RowH { int base, mx; __device__ __forceinline__ int operator()(int r) const { const int i = base + r; return i < mx ? i : mx; } };
__device__ __forceinline__ void moe_prefix(const unsigned* cnt, int* s_tp, int* s_off) {
    __syncthreads();
    if (ltid() == 0) {
        int tp = 0, off = 0;
        for (int e = 0; e < 64; ++e) {
            const int n = (int)__hip_atomic_load(&cnt[e * CNT_STRIDE], __ATOMIC_RELAXED, __HIP_MEMORY_SCOPE_AGENT);
            s_tp[e] = tp; s_off[e] = off;
            tp += (n + 255) >> 8; off += n;
        }
        s_tp[64] = tp; s_off[64] = off;
    }
    __syncthreads();
}

struct RowGen { const int* lst; int m0, n, base; __device__ __forceinline__ int operator()(int r) const {
    if (lst) { const int i = m0 + r; return lst[i < n ? i : n - 1] >> 1; }
    return base + r; } };

template <int L>
__device__ __forceinline__ void ph_moe_up(KP p, const u16* X, unsigned char* smem, int* s_tp, int* s_off) {
    u16* lds = (u16*)smem;
    const unsigned* cnt = p->ctl + (L == 0 ? CTL_CNT0 : CTL_CNT1);
    moe_prefix(cnt, s_tp, s_off);
    {
        __syncthreads();
        pg8::Gemm g; g.A = X; g.Bt = p->sh_gut[L]; g.M = T_; g.N = 2048; g.K = D_;
        pg8::StaticOrder S; S.init(T_, 2048, (int)gridDim.x, (int)blockIdx.x);
        pg8::gemm_phase<PgEpiSwiglu, pg8::StaticOrder>((PG8_LAS unsigned char*)smem, g, S, PgEpiSwiglu{p->hsh, 1024}, nullptr);
        __syncthreads();
    }
    const int nrt = s_tp[64] * 8;
    const int nsh = 0;
            for (int t = blockIdx.x; t < nrt + nsh; t += gridDim.x) {
        Acc acc; acc_zero(acc);
        if (t < nrt) {
            const int mtile = t >> 3, nt = t & 7;
            int e = 0;
            for (int s = 32; s > 0; s >>= 1) if (e + s < 64 && s_tp[e + s] <= mtile) e += s;
            const int n = s_off[e + 1] - s_off[e], m0 = (mtile - s_tp[e]) * 256;
            gemm_accum<B_F32_KN, false>(acc, X, D_, RowGen{p->list + e * T_, m0, n, 0}, p->moe_wg[L] + (size_t)e * D_ * 512, 512,
                                        ColGateUp{nt * 64, p->moe_wu[L] + (size_t)e * D_ * 512}, D_, lds);
            EpiSwiglu{p->hbuf, 512, s_off[e] + m0, nt * 64, n - m0}(acc, smem);
        } else {
            const int u = t - nrt, mt = u >> 4, nt = u & 15;
            gemm_accum<B_BF16_KN, false>(acc, X, D_, RowId{mt * 256}, p->sh_gb[L], 1024, ColGateUp16{nt * 64, p->sh_ub[L]}, D_, lds);
            EpiSwiglu{p->hsh, 1024, mt * 256, nt * 64, 256}(acc, smem);
        }
    }
}

template <int L>
__device__ __forceinline__ void ph_moe_down(KP p, const u16* XBres, unsigned char* smem, int* s_tp, int* s_off) {
    u16* lds = (u16*)smem;
    const unsigned* cnt = p->ctl + (L == 0 ? CTL_CNT0 : CTL_CNT1);
    moe_prefix(cnt, s_tp, s_off);
    {
        __syncthreads();
        pg8::Gemm g; g.A = p->hsh; g.Bt = p->sh_dt[L]; g.M = T_; g.N = D_; g.K = 1024;
        pg8::StaticOrder S; S.init(T_, D_, (int)gridDim.x, (int)blockIdx.x);
        pg8::gemm_phase<PgEpiResid, pg8::StaticOrder>((PG8_LAS unsigned char*)smem, g, S, PgEpiResid{p->y2, XBres, D_}, nullptr);
        __syncthreads();
    }
    const int nrt = s_tp[64] * 16, nsh = 0;
    for (int t = blockIdx.x; t < nrt + nsh; t += gridDim.x) {
        Acc acc; acc_zero(acc);
        if (t < nrt) {
            const int mtile = t >> 4, nt = t & 15;
            int e = 0;
            for (int s = 32; s > 0; s >>= 1) if (e + s < 64 && s_tp[e + s] <= mtile) e += s;
            const int n = s_off[e + 1] - s_off[e], m0 = (mtile - s_tp[e]) * 256;
            gemm_accum<B_F32_KN, false>(acc, p->hbuf, 512, RowH{s_off[e] + m0, 2 * T_ - 1}, p->moe_wd[L] + (size_t)e * 512 * D_, D_, ColOff{nt * 128}, 512, lds);
            EpiDownRouted{p->yr, p->list + e * T_, p->tok_g, m0, n, nt * 128}(acc, smem);
        } else {
            const int u = t - nrt, mt = u >> 4, nt = u & 15;
            gemm_accum<B_BF16_KN, false>(acc, p->hsh, 1024, RowId{mt * 256}, p->sh_db[L], D_, ColOff{nt * 128}, 1024, lds);
            EpiResid<true>{p->y2, XBres, D_, mt * 256, nt * 128}(acc, smem);
        }
    }
}
struct ColRot { int cbase; bool rot;
    __device__ __forceinline__ const u16* base16(const u16* B, int) const { return B; }
    __device__ __forceinline__ unsigned off8(int hsel, int ch8) const { const int v = hsel * 64 + ch8 * 8; const int s = v >> 6, u = v & 63;
        return rot ? (unsigned)(cbase + s * 32 + (u < 32 ? u : 128 + (u - 32))) : (unsigned)(cbase + v); }
    __device__ __forceinline__ int vchunk(int hsel, int ch8) const { return hsel * 8 + ch8; }
    __device__ __forceinline__ const float* base(const float* B, int) const { return B; }
    __device__ __forceinline__ unsigned off4(int hsel, int g4) const { const int v = hsel * 64 + g4 * 4; const int s = v >> 6, u = v & 63;
        return rot ? (unsigned)(cbase + s * 32 + (u < 32 ? u : 128 + (u - 32))) : (unsigned)(cbase + v); }
    __device__ __forceinline__ int vcol4(int hsel, int g4) const { return hsel * 64 + g4 * 4; } };

__device__ __forceinline__ float ret_log2g(int h) { return log1pf(-exp2f(-5.f - (float)h)) * LOG2E_; }

struct EpiRetQK {
    KP p; int row0; int hd; int tp; bool isk;
    __device__ __forceinline__ void operator()(Acc& acc, unsigned char* stg) const {
        const float l2g = ret_log2g(hd);
        const int wc0 = WC0_, rb = row0 + WR0_;
        const int dbase = tp * 64 + (wc0 >> 1);
        const float* cR = p->cosR; const float* sR = p->sinR;
        const int hoff = hd * 256 + dbase;
        if (!isk) {
            u16* qr = p->qr; u16* qx = p->qx;
            stage_pairs_pre<CS8>(acc, stg,
              [=](int r, int c4) -> CS8 { CS8 t; t.c = *(const f32x4*)(cR + (rb + r) * 128 + dbase + c4); t.s = *(const f32x4*)(sR + (rb + r) * 128 + dbase + c4); return t; },
              [=](int r, int c4, f32x4 x1, f32x4 x2, CS8 cs) {
                const int t = rb + r;
                const f32x4 c = cs.c, s = cs.s;
                const f32x4 lo = x1 * c - x2 * s, hi = x1 * s + x2 * c;
                const float xi = exp2f((float)((t & 127) + 1) * l2g);
                const size_t o = (size_t)t * 2048 + hoff + c4;
                *(u32x2*)(qr + o) = pack4(lo); *(u32x2*)(qr + o + 128) = pack4(hi);
                *(u32x2*)(qx + o) = pack4(lo * xi); *(u32x2*)(qx + o + 128) = pack4(hi * xi);
            });
        } else {
            const int lane = ltid() & 63, fr = lane & 15, fq = lane >> 4;
#pragma unroll
            for (int m = 0; m < 4; ++m) {
                const int r0 = rb + m * 16 + fq * 4;
#pragma unroll
                for (int n = 0; n < 2; ++n) {
                    const int i = dbase + n * 16 + fr;
                    float zl[4], zh[4];
#pragma unroll
                    for (int j = 0; j < 4; ++j) {
                        const int t = r0 + j;
                        const float c = cR[t * 128 + i], s = sR[t * 128 + i];
                        const float x1 = acc[m][n][j], x2 = acc[m][n + 2][j];
                        const float ze = exp2f((float)(127 - (t & 127)) * l2g) * 0.0625f;
                        zl[j] = (x1 * c - x2 * s) * ze; zh[j] = (x1 * s + x2 * c) * ze;
                    }
                    u32x2 a, b;
                    a.x = pack2(zl[0], zl[1]); a.y = pack2(zl[2], zl[3]);
                    b.x = pack2(zh[0], zh[1]); b.y = pack2(zh[2], zh[3]);
                    *(u32x2*)(p->kzT + (size_t)(hd * 256 + i) * T_ + r0) = a;
                    *(u32x2*)(p->kzT + (size_t)(hd * 256 + i + 128) * T_ + r0) = b;
                }
            }
            u16* kr = p->kr;
            stage_pairs_pre<CS8>(acc, stg,
              [=](int r, int c4) -> CS8 { CS8 t; t.c = *(const f32x4*)(cR + (rb + r) * 128 + dbase + c4); t.s = *(const f32x4*)(sR + (rb + r) * 128 + dbase + c4); return t; },
              [=](int r, int c4, f32x4 x1, f32x4 x2, CS8 cs) {
                const int t = rb + r;
                const f32x4 c = cs.c, s = cs.s;
                const f32x4 lo = (x1 * c - x2 * s) * 0.0625f, hi = (x1 * s + x2 * c) * 0.0625f;
                const size_t o = (size_t)t * 2048 + hoff + c4;
                *(u32x2*)(kr + o) = pack4(lo); *(u32x2*)(kr + o + 128) = pack4(hi);
            });
        }
    }
};
struct EpiRetV {
    u16* vT; int row0, col0;
    __device__ __forceinline__ void operator()(Acc& acc, unsigned char* stg) const {
        const int lane = ltid() & 63, fr = lane & 15, fq = lane >> 4, wr0 = WR0_, wc0 = WC0_;
#pragma unroll
        for (int m = 0; m < 4; ++m) {
            const int r0 = row0 + wr0 + m * 16 + fq * 4;
#pragma unroll
            for (int n = 0; n < 4; ++n) {
                u32x2 o; o.x = pack2(acc[m][n][0], acc[m][n][1]); o.y = pack2(acc[m][n][2], acc[m][n][3]);
                *(u32x2*)(vT + (size_t)(col0 + wc0 + n * 16 + fr) * T_ + r0) = o;
            }
        }
    }
};
struct EpiSilu {
    u16* C; int ldc; int row0, col0;
    __device__ __forceinline__ void operator()(Acc& acc, unsigned char* stg) const {
        const int rb = row0 + WR0_, cb = col0 + WC0_;
        u16* Cp = C; const int ld = ldc;
        stage_rows(acc, stg, [=](int r, int c4, f32x4 v) {
            f32x4 o;
#pragma unroll
            for (int e = 0; e < 4; ++e) o[e] = silu_f(v[e]);
            *(u32x2*)(Cp + (size_t)(rb + r) * ld + cb + c4) = pack4(o);
        });
    }
};
struct EpiInner {
    u16* C; int hd;
    __device__ __forceinline__ void operator()(Acc& acc, unsigned char* stg) const {
        const float l2g = ret_log2g(hd);
        const int wr0 = WR0_, wc0 = WC0_;
        u16* Cp = C;
        stage_rows(acc, stg, [=](int r, int c4, f32x4 v) {
            const int i = wr0 + r;
            f32x4 o;
#pragma unroll
            for (int e = 0; e < 4; ++e) { const int k = wc0 + c4 + e; o[e] = i >= k ? v[e] * exp2f((float)(i - k) * l2g) : 0.f; }
            *(u32x2*)(Cp + i * 128 + wc0 + c4) = pack4(o);
        });
    }
};


__device__ __forceinline__ void ph_ret_a(KP p, u16* lds) {
    const int nkv = 8 * 64 * 4, nin = 8 * 64;
    for (int t = blockIdx.x; t < nkv + nin; t += gridDim.x) {
        Acc acc; acc_zero(acc);
        if (t < nkv) {
            const int hc = t >> 2, nt = t & 3, hd = hc >> 6, c = hc & 63;
            gemm_kk128(acc, p->kz + (size_t)(c * 128) * 2048 + hd * 256, 2048, p->v1 + (size_t)(c * 128) * 4096 + hd * 512 + nt * 128, 4096, lds);
            EpiBF16{p->KVt + (size_t)hc * 512 * 256, 512, 0, nt * 128}(acc, (unsigned char*)lds);
        } else {
            const int hc = t - nkv, hd = hc >> 6, c = hc & 63;
            gemm_accum<B_BF16_NK, true>(acc, p->qr + hd * 256, 2048, RowId{c * 128}, p->kr + hd * 256, 2048, RowId{c * 128}, 256, lds);
            if (ksplit_reduce(acc, lds)) EpiInner{p->innerG + (size_t)hc * 128 * 128, hd}(acc, (unsigned char*)lds + 65536);
        }
    }
}
__device__ __forceinline__ void ph_ret_b(KP p) {
    const int gtid = blockIdx.x * NT + ltid(), gsz = gridDim.x * NT;
    for (int e = gtid; e < 8 * 512 * 256 / 8; e += gsz) {
        const int hd = e / (512 * 256 / 8);
        const int within = e - hd * (512 * 256 / 8);
        const float g128 = exp2f(128.f * ret_log2g(hd));
        u16* base = p->KVt + (size_t)hd * 64 * 512 * 256 + (size_t)within * 8;
        float r[8];
#pragma unroll
        for (int i = 0; i < 8; ++i) r[i] = 0.f;
#pragma unroll 4
        for (int c = 0; c < 64; ++c) {
            u32x4* ptr = (u32x4*)(base + (size_t)c * 512 * 256);
            const u32x4 in = *ptr;
            u32x4 o;
            o.x = pack2(r[0], r[1]); o.y = pack2(r[2], r[3]); o.z = pack2(r[4], r[5]); o.w = pack2(r[6], r[7]);
            *ptr = o;
#pragma unroll
            for (int i = 0; i < 4; ++i) {
                r[2 * i] = r[2 * i] * g128 + __uint_as_float(in[i] << 16);
                r[2 * i + 1] = r[2 * i + 1] * g128 + __uint_as_float(in[i] & 0xffff0000u);
            }
        }
    }
}
__device__ __forceinline__ void ph_ret_c(KP p, u16* lds) {
    for (int t = blockIdx.x; t < 8 * 64 * 4; t += gridDim.x) {
        const int hc = t >> 2, nt = t & 3, hd = hc >> 6, c = hc & 63;
        Acc acc; acc_zero(acc);
        gemm_accum<B_BF16_KN, true>(acc, p->innerG + (size_t)hc * 128 * 128, 128, RowId{0}, p->v1 + (size_t)(c * 128) * 4096, 4096, ColOff{hd * 512 + nt * 128}, 128, lds);
        gemm_accum<B_BF16_KN, true>(acc, p->qx + hd * 256, 2048, RowId{c * 128}, p->KVt + (size_t)hc * 512 * 256, 512, ColOff{nt * 128}, 256, lds);
        if (ksplit_reduce(acc, lds)) EpiBF16{p->obuf, 4096, c * 128, hd * 512 + nt * 128}(acc, (unsigned char*)lds + 65536);
    }
}
__device__ __forceinline__ void ph_gn(KP p) {
    const int lane = ltid() & 63;
    const int gw = (blockIdx.x * NT + ltid()) >> 6, nw = (gridDim.x * NT) >> 6;
    for (int r = gw; r < T_ * 8; r += nw) {
        const int hd = r & 7;
        const size_t off = (size_t)(r >> 3) * 4096 + hd * 512 + lane * 8;
        const u32x4 in = *(const u32x4*)(p->obuf + off);
        float v[8];
#pragma unroll
        for (int i = 0; i < 4; ++i) { v[2 * i] = __uint_as_float(in[i] << 16); v[2 * i + 1] = __uint_as_float(in[i] & 0xffff0000u); }
        float s = 0.f;
#pragma unroll
        for (int i = 0; i < 8; ++i) s += v[i];
        const float mu = wave_sum(s) * (1.f / 512.f);
        float var = 0.f;
#pragma unroll
        for (int i = 0; i < 8; ++i) { const float d = v[i] - mu; var += d * d; }
        var = wave_sum(var) * (1.f / 512.f);
        const float rs = rsqrtf(var + 1e-5f);
        const u32x4 gin = *(const u32x4*)(p->sg + off);
        const float* gg = p->gn_g + hd * 512 + lane * 8;
        const float* gb = p->gn_b + hd * 512 + lane * 8;
        float o[8];
#pragma unroll
        for (int i = 0; i < 8; ++i) {
            const float sgv = (i & 1) ? __uint_as_float(gin[i >> 1] & 0xffff0000u) : __uint_as_float(gin[i >> 1] << 16);
            o[i] = ((v[i] - mu) * rs * gg[i] + gb[i]) * sgv;
        }
        u32x4 w; w.x = pack2(o[0], o[1]); w.y = pack2(o[2], o[3]); w.z = pack2(o[4], o[5]); w.w = pack2(o[6], o[7]);
        *(u32x4*)(p->gated + off) = w;
    }
}

#define MAXLDS_(a, b) ((a) > (b) ? (a) : (b))
#define PHASE_LDS MAXLDS_(MAXLDS_(MAXLDS_(GEMM_LDS_BYTES, 2 * ATT_LDS_BYTES), 8 * 8192), 131072)
#define LDS_TOTAL (PHASE_LDS + 16 + 16 + 65 * 4 * 2 + 8)

__global__ void __launch_bounds__(NT, 2) mega(Params kparams) {
    extern __shared__ __attribute__((aligned(16))) unsigned char smem[];
    u16* lds = (u16*)smem;
    uint4* xbw = (uint4*)(smem + PHASE_LDS);
    unsigned* misc = (unsigned*)(smem + PHASE_LDS + 16);
    int* s_tp = (int*)(smem + PHASE_LDS + 32);
    int* s_off = s_tp + 65;
    if (threadIdx.x == 0) *xbw = make_uint4(0u, 0u, 0u, 0u);
    __syncthreads();
    XcdBarrier bar = xcd_barrier_post(getp()->bar, (volatile LAS unsigned*)xbw);

    ph_prep(getp());
    {
        KP p = getp();
        for (int u = blockIdx.x; u < 32 * 14; u += gridDim.x) cvtT_block(p->w_in0, p->w_in0t, 2048, IN_AB, u / 14, u % 14, smem);
    }
    xcd_barrier(bar);
    {
        KP p = getp();
        __syncthreads();
        pg8::Gemm g; g.A = p->xb; g.Bt = p->w_in0t; g.M = T_; g.N = 3584; g.K = D_;
        pg8::StaticOrder S; S.init(T_, 3584, (int)gridDim.x, (int)blockIdx.x);
        pg8::gemm_phase<PgEpiBf16N, pg8::StaticOrder>((PG8_LAS unsigned char*)smem, g, S, PgEpiBf16N{p->H0, IN_AB, IN_AB}, nullptr);
        __syncthreads();
    }
    xcd_barrier(bar);
    ph_post0(getp());
    xcd_barrier(bar);
    {
        KP p = getp();
        const int ntm = T_ / BM;
        const int n1 = ntm * 12, n2 = ntm * 16, n3 = T_ / 16;
        for (;;) {
            __syncthreads();
            if (threadIdx.x == 0) misc[0] = atomicAdd(&p->ctl[CTL_QUEUE + 2], 1u);
            __syncthreads();
            const int it = (int)misc[0];
            if (it >= n1 + n2 + n3) break;
            if (it >= n3) {
                const int t = it - n3;
                const bool isq = t < n1;
                const int u = isq ? t : t - n1, nt = u / ntm, mt = u % ntm;
                Acc acc; acc_zero(acc);
                gemm_accum<B_BF16_KN, false>(acc, isq ? p->cqn : p->ckvn, isq ? 512 : 256, RowId{mt * BM}, isq ? p->w_uqb : p->w_ukvb,
                                     isq ? 1536 : 2048, ColOff{nt * BN}, isq ? 512 : 256, lds);
                if (isq) EpiQa{p->qa, p->cosA, p->sinA, mt * BM, nt * BN}(acc, smem);
                else EpiKva{p->ka, p->vaT, mt * BM, nt * BN}(acc, smem);
            } else {
                indexer_item(p, n3 - 1 - it);
            }
        }
    }
    xcd_barrier(bar);
    ph_topk(getp(), smem);
    xcd_barrier(bar);
    ph_attn(getp(), smem, misc);
    xcd_barrier(bar);
    ph_mla_merge(getp());
    xcd_barrier(bar);
    {
        KP p = getp();
        __syncthreads();
        pg8::Gemm g; g.A = p->outcat; g.Bt = p->w_out0t; g.M = T_; g.N = D_; g.K = D_;
        pg8::StaticOrder S; S.init(T_, D_, (int)gridDim.x, (int)blockIdx.x);
        pg8::gemm_phase<PgEpiResidF, pg8::StaticOrder>((PG8_LAS unsigned char*)smem, g, S, PgEpiResidF{p->ybuf, p->x, D_}, nullptr);
        __syncthreads();
    }
    xcd_barrier(bar);
    { KP p = getp(); ph_ln<false, true, true, false>(p, p->ybuf, p->ln_mix_g[0], p->ln_mix_b[0], nullptr, p->xab, p->xlb); }
    xcd_barrier(bar);
    { KP p = getp(); ph_router(p, smem, p->ctl + CTL_CNT0, p->list); }
    xcd_barrier(bar);
    { KP p = getp(); ph_moe_up<0>(p, p->xab, smem, s_tp, s_off); }
    xcd_barrier(bar);
    { KP p = getp(); ph_moe_down<0>(p, p->xab, smem, s_tp, s_off); }
    xcd_barrier(bar);
    { KP p = getp(); ph_ln<true, false, true, false>(p, p->y2, p->ln_ffn_g[0], p->ln_ffn_b[0], nullptr, p->xcb, nullptr); }
    xcd_barrier(bar);
    {
        KP p = getp();
        __syncthreads();
        pg8::Gemm g; g.A = p->xcb; g.Bt = p->w_in1t; g.M = T_; g.N = IN_C; g.K = D_;
        pg8::StaticOrder S; S.init(T_, IN_C, (int)gridDim.x, (int)blockIdx.x);
        pg8::gemm_phase<PgEpiL1, pg8::StaticOrder>((PG8_LAS unsigned char*)smem, g, S, PgEpiL1{p}, nullptr);
        __syncthreads();
    }
    xcd_barrier(bar);
    ph_ret_a(getp(), lds);
    xcd_barrier(bar);
    ph_ret_b(getp());
    xcd_barrier(bar);
    ph_ret_c(getp(), lds);
    xcd_barrier(bar);
    ph_gn(getp());
    xcd_barrier(bar);
    {
        KP p = getp();
        __syncthreads();
        pg8::Gemm g; g.A = p->gated; g.Bt = p->w_out1t; g.M = T_; g.N = D_; g.K = 4096;
        pg8::StaticOrder S; S.init(T_, D_, (int)gridDim.x, (int)blockIdx.x);
        pg8::gemm_phase<PgEpiResid, pg8::StaticOrder>((PG8_LAS unsigned char*)smem, g, S, PgEpiResid{p->ybuf, p->xcb, D_}, nullptr);
        __syncthreads();
    }
    xcd_barrier(bar);
    { KP p = getp(); ph_ln<false, true, true, false>(p, p->ybuf, p->ln_mix_g[1], p->ln_mix_b[1], nullptr, p->xab, p->xlb); }
    xcd_barrier(bar);
    { KP p = getp(); ph_router(p, smem, p->ctl + CTL_CNT1, p->list); }
    xcd_barrier(bar);
    { KP p = getp(); ph_moe_up<1>(p, p->xab, smem, s_tp, s_off); }
    xcd_barrier(bar);
    { KP p = getp(); ph_moe_down<1>(p, p->xab, smem, s_tp, s_off); }
    xcd_barrier(bar);
    { KP p = getp(); ph_ln<true, false, false, true>(p, p->y2, p->ln_ffn_g[1], p->ln_ffn_b[1], p->out, nullptr, nullptr); }
    {
        KP p = getp();
        if (xb_ld(&p->bar[XB_TMO])) {
            asm volatile("s_waitcnt vmcnt(0)" ::: "memory");
            for (int i = blockIdx.x * NT + ltid(); i < p->out_size; i += gridDim.x * NT) p->out[i] = __uint_as_float(0x7fc00000u);
        }
    }
}

extern "C" void kernel_launch(void* const* d_in, const int* in_sizes, int n_in,
                              void* d_out, int out_size, void* d_ws, size_t ws_size,
                              hipStream_t stream) {
    const size_t kDynLds = LDS_TOTAL;
    static int grid = 0;
    if (!grid) {
        int dev = 0, cus = 0, per_cu = 0;
        (void)hipGetDevice(&dev);
        (void)hipDeviceGetAttribute(&cus, hipDeviceAttributeMultiprocessorCount, dev);
        (void)hipFuncSetAttribute((const void*)mega, hipFuncAttributeMaxDynamicSharedMemorySize, (int)kDynLds);
        (void)hipOccupancyMaxActiveBlocksPerMultiprocessor(&per_cu, mega, NT, kDynLds);
        grid = cus * (per_cu >= 1 ? 1 : 0);
    }
    unsigned char* ws = (unsigned char*)d_ws;
    size_t off = 0;
    auto take = [&](size_t bytes) { void* q = ws + off; off += (bytes + 255) & ~(size_t)255; return q; };
    Params p{};
    p.bar = (unsigned*)take(XCD_BAR_WORDS * 4);
    p.ctl = (unsigned*)take(CTL_WORDS * 4);
    const size_t ctl_bytes = off;
    (void)hipMemsetAsync(ws, 0, ctl_bytes, stream);
    auto F = [&](int i) { return (const float*)d_in[i]; };
    p.x = F(0); p.pos = (const int*)d_in[1]; p.router_w = F(2); p.router_b = F(3);
    p.w_in0 = F(4); p.q_norm = F(5); p.w_uq = F(6); p.kv_norm = F(7); p.w_ukv = F(8); p.w_out0 = F(9);
    p.w_in1 = F(10); p.gn_g = F(11); p.gn_b = F(12); p.w_out1 = F(13);
    for (int l = 0; l < 2; ++l) {
        const int b = 14 + 10 * l;
        p.ln_mix_g[l] = F(b); p.ln_mix_b[l] = F(b + 1);
        p.moe_wg[l] = F(b + 2); p.moe_wu[l] = F(b + 3); p.moe_wd[l] = F(b + 4);
        p.sh_g[l] = F(b + 5); p.sh_u[l] = F(b + 6); p.sh_d[l] = F(b + 7);
        p.ln_ffn_g[l] = F(b + 8); p.ln_ffn_b[l] = F(b + 9);
    }
    p.out = (float*)d_out;
    p.w_in0b = nullptr; p.w_in0t = (u16*)take((size_t)3584 * D_ * 2); p.w_uqb = (u16*)take(512 * 1536 * 2); p.w_ukvb = (u16*)take(256 * 2048 * 2);
    p.w_out0b = nullptr; p.w_in1b = nullptr; p.w_out1b = nullptr; p.w_out1t = (u16*)take((size_t)4096 * D_ * 2); p.w_out0t = (u16*)take((size_t)D_ * D_ * 2); p.w_in1t = (u16*)take((size_t)D_ * IN_C * 2);
    for (int l = 0; l < 2; ++l) { p.sh_gb[l] = nullptr; p.sh_ub[l] = nullptr; p.sh_db[l] = nullptr; p.sh_gut[l] = (u16*)take((size_t)2048 * D_ * 2); p.sh_dt[l] = (u16*)take((size_t)D_ * 1024 * 2); }
    const size_t T = T_;
    p.cosA = (float*)take(T * 32 * 4); p.sinA = (float*)take(T * 32 * 4);
    p.cosR = (float*)take(T * 128 * 4); p.sinR = (float*)take(T * 128 * 4);
    p.xb = (u16*)take(T * 2048 * 2); p.H0 = (u16*)take(T * IN_AB * 2);
    p.cqn = (u16*)take(T * 512 * 2); p.ckvn = (u16*)take(T * 256 * 2); p.kpe = (u16*)take(T * 64 * 2);
    p.qb = (u16*)take(T * 1024 * 2); p.kb = (u16*)take(T * 256 * 2); p.vb = (u16*)take(T * 256 * 2);
    p.iqb = (u16*)take(T * 1024 * 2); p.ikb = (u16*)take(T * 64 * 2); p.iwf = (float*)take(T * 16 * 4);
    p.qa = (u16*)take(T * 1536 * 2); p.ka = (u16*)take(T * 1024 * 2); p.vaT = (u16*)take(T * 1024 * 2);
    p.scores = (float*)take(T * T * 4); p.sel = (u16*)take(T * 256 * 2); p.outcat = (u16*)take(T * 2048 * 2); p.mla_po = (float*)take((size_t)256 * 256 * 128 * 4); p.mla_ml = (float*)take((size_t)256 * 256 * 2 * 4);
    p.ybuf = (u16*)take(T * 2048 * 2); p.xab = (u16*)take(T * 2048 * 2); p.xlb = (u16*)take(T * 2048 * 2); p.whT = (u16*)take(64 * 2048 * 2); p.wlT = (u16*)take(64 * 2048 * 2);
    p.y2 = (u16*)take(T * 2048 * 2); p.xcb = (u16*)take(T * 2048 * 2);
    p.tok_e = (int*)take(T * 2 * 4); p.tok_g = (float*)take(T * 2 * 4); p.list = (int*)take(2 * 64 * T * 4);
    p.hbuf = (u16*)take(T * 2 * 512 * 2); p.hsh = (u16*)take(T * 1024 * 2); p.yr = (u16*)take(T * 2 * 2048 * 2);
    p.qr = (u16*)take(T * 2048 * 2); p.qx = (u16*)take(T * 2048 * 2); p.kr = (u16*)take(T * 2048 * 2);
    p.kzT = nullptr; p.kz = (u16*)take(T * 2048 * 2); p.v1 = (u16*)take(T * 4096 * 2); p.sg = (u16*)take(T * 4096 * 2);
    p.innerG = (u16*)take((size_t)8 * 64 * 128 * 128 * 2);
    {
        unsigned char* sbase = (unsigned char*)p.scores;
        p.KVt = (u16*)sbase; p.obuf = (u16*)(sbase + ((size_t)128 << 20)); p.gated = (u16*)(sbase + ((size_t)192 << 20));
    }
    p.out_size = out_size; p.pad_ = 0;
    if (off > ws_size) return;
    mega<<<dim3(grid), dim3(NT), kDynLds, stream>>>(p);
}
```

```cpp
#include <hip/hip_runtime.h>
#include <stdint.h>

typedef unsigned short u16;
typedef __attribute__((ext_vector_type(8))) short bf16x8;
typedef __attribute__((ext_vector_type(4))) float f32x4;
typedef __attribute__((ext_vector_type(2))) float f32x2;
typedef __attribute__((ext_vector_type(4))) unsigned u32x4;
typedef __attribute__((ext_vector_type(2))) unsigned u32x2;
typedef __attribute__((ext_vector_type(2))) __bf16 bf16x2_t;
typedef __attribute__((ext_vector_type(4))) short s16x4;

#define XB_TMO      128
#define XB_XCNT(j)  (256  + 64 * (j))
#define XB_XSUB(j)  (1280 + 64 * (j))
#define XB_XGEN(j)  (2304 + 64 * (j))
#define XB_TOP      3328
#define XB_TOPGEN   3392
#define XCD_BAR_WORDS 3456
#define XB_SPIN_CAP (1u << 22)
#define LAS __attribute__((address_space(3)))

__device__ __forceinline__ unsigned xb_ld(unsigned* p)              { return __hip_atomic_load(p, __ATOMIC_RELAXED, __HIP_MEMORY_SCOPE_AGENT); }
__device__ __forceinline__ unsigned xb_add(unsigned* p, unsigned v) { return __hip_atomic_fetch_add(p, v, __ATOMIC_RELAXED, __HIP_MEMORY_SCOPE_AGENT); }
__device__ __forceinline__ unsigned xb_xcc_id() { return (unsigned)__builtin_amdgcn_s_getreg((3 << 11) | 20) & 0xFu; }
#define XB_SPIN(cond, bar) do { unsigned _sp = 0; while (cond) { __builtin_amdgcn_s_sleep(1); \
    if ((++_sp & 255u) == 0u) { if (xb_ld(&(bar)[XB_TMO])) break; if (_sp > XB_SPIN_CAP) { atomicAdd(&(bar)[XB_TMO], 1u); break; } } } } while (0)

struct XcdBarrier { unsigned* bar; unsigned x; volatile LAS unsigned* st; };

__device__ __forceinline__ XcdBarrier xcd_barrier_post(unsigned* bar, volatile LAS unsigned* st) {
    XcdBarrier b; b.bar = bar; b.x = xb_xcc_id(); b.st = st;
    if (threadIdx.x == 0) (void)xb_add(&bar[XB_XCNT(b.x)], 1u);
    return b;
}
__device__ __forceinline__ void xcd_barrier_complete(unsigned* bar, unsigned x, unsigned& nloc, unsigned& nx) {
    const unsigned G = gridDim.x * gridDim.y * gridDim.z;
    unsigned sum, cnt, mine, sp = 0u;
    for (;;) {
        sum = 0u; cnt = 0u; mine = 0u;
#pragma unroll
        for (unsigned j = 0; j < 16; ++j) { const unsigned c = xb_ld(&bar[XB_XCNT(j)]); sum += c; cnt += (c > 0u) ? 1u : 0u; mine = (j == x) ? c : mine; }
        if (sum == G) break;
        __builtin_amdgcn_s_sleep(1);
        if ((++sp & 255u) == 0u) { if (xb_ld(&bar[XB_TMO])) break; if (sp > XB_SPIN_CAP) { atomicAdd(&bar[XB_TMO], 1u); break; } }
    }
    nloc = mine > 0u ? mine : 1u; nx = cnt > 0u ? cnt : 1u;
}
__device__ __forceinline__ void xcd_barrier(const XcdBarrier& b) {
    asm volatile("s_waitcnt vmcnt(0)" ::: "memory");
    __syncthreads();
    if (threadIdx.x == 0) {
        unsigned* bar = b.bar;
        __builtin_amdgcn_s_waitcnt(0);
        unsigned nloc = b.st[0], nx = b.st[1];
        if (nloc == 0u) { xcd_barrier_complete(bar, b.x, nloc, nx); b.st[0] = nloc; b.st[1] = nx; }
        const unsigned old = xb_add(&bar[XB_XSUB(b.x)], 1u);
        const unsigned gen = old / nloc;
        if (old + 1u == (gen + 1u) * nloc) {
            __builtin_amdgcn_fence(__ATOMIC_RELEASE, "agent");
            asm volatile("s_waitcnt vmcnt(0)" ::: "memory");
            const unsigned og = xb_add(&bar[XB_TOP], 1u);
            const unsigned tg = og / nx;
            if (og + 1u == (tg + 1u) * nx) xb_add(&bar[XB_TOPGEN], 1u);
            else XB_SPIN(xb_ld(&bar[XB_TOPGEN]) == tg, bar);
            __builtin_amdgcn_fence(__ATOMIC_ACQUIRE, "agent");
            xb_add(&bar[XB_XGEN(b.x)], 1u);
            asm volatile("s_waitcnt vmcnt(0)" ::: "memory");
        } else {
            XB_SPIN(xb_ld(&bar[XB_XGEN(b.x)]) == gen, bar);
            __builtin_amdgcn_fence(__ATOMIC_ACQUIRE, "agent");
            asm volatile("s_waitcnt vmcnt(0)" ::: "memory");
        }
    }
    __syncthreads();
}

__device__ __forceinline__ int ltid() { int t = threadIdx.x; asm volatile("" : "+v"(t)); return t; }
__device__ __forceinline__ u16 f2bf(float f) {
    unsigned u = __float_as_uint(f);
    u += 0x7fffu + ((u >> 16) & 1u);
    return (u16)(u >> 16);
}
__device__ __forceinline__ float bf2f(u16 h) { return __uint_as_float(((unsigned)h) << 16); }
__device__ __forceinline__ unsigned pack2(float a, float b) {
    f32x2 v = {a, b};
    bf16x2_t r = __builtin_convertvector(v, bf16x2_t);
    return *(unsigned*)&r;
}

namespace pg8 {
#define PG8_LAS __attribute__((address_space(3)))
typedef unsigned short bf16_t;
typedef short bf16x8 __attribute__((ext_vector_type(8)));
typedef float f32x4 __attribute__((ext_vector_type(4)));
typedef unsigned u32x4 __attribute__((ext_vector_type(4)));
constexpr int BM = 256, BK = 64, HALF = 128, HTB = HALF * BK * 2  , STAGE_BYTES = 8 * HTB, NXCD = 8, WGM = 8;

__host__ __device__ __forceinline__ int lds_byte(int r, int c) { const int st = (r >> 4) * 2 + (c >> 5), rr = r & 15, cc = c & 31, ob = rr * 64 + cc * 2; return st * 1024 + (ob ^ (((ob >> 9) & 1) << 5)); }
__host__ __device__ __forceinline__ void stage_rc(int b, int& R, int& C) { const int st = b / 1024, sb = b % 1024, swz = sb ^ (((sb >> 9) & 1) << 5); R = (st >> 1) * 16 + swz / 64; C = (st & 1) * 32 + (swz % 64) / 2; }
__host__ __device__ __forceinline__ int perm32(int rho) { const int n = rho >> 4, i = rho & 15; return 8 * (i >> 2) + 4 * n + (i & 3); }

struct Unit { int pm, pn; };
struct Gemm { const bf16_t* A; const bf16_t* Bt; int M, N, K; };

struct StaticOrder {
    int nM, nN, nwg, G, c;
    __host__ __device__ void init(int M, int N, int G_, int c_) { nM = M / BM; nN = N / BM; nwg = nM * nN; G = G_; c = c_; }
    __host__ __device__ bool next(int i, Unit& u) const {
        const long L = (long)i * G + c; if (L >= nwg) return false;
        int wgid = (int)L; { const int q = nwg / NXCD, r = nwg % NXCD, xcd = wgid % NXCD, off = wgid / NXCD; wgid = (xcd < r ? xcd * (q + 1) : r * (q + 1) + (xcd - r) * q) + off; }
        const int nig = WGM * nN, gid = wgid / nig, fm = gid * WGM, gsz = (nM - fm) < WGM ? (nM - fm) : WGM;
        u.pm = fm + ((wgid % nig) % gsz); u.pn = (wgid % nig) / gsz; return true;
    }
    __device__ __forceinline__ void a_ready(const Unit&) const {}
    __device__ __forceinline__ void done(const Unit&) const {}
};
__device__ __forceinline__ unsigned cvt_pk_bf16(float lo, float hi) { unsigned r; asm volatile("v_cvt_pk_bf16_f32 %0, %1, %2" : "=v"(r) : "v"(lo), "v"(hi)); return r; }
template <class Epi, class Sched, bool STAMP = false>
__device__ __forceinline__ void gemm_phase(PG8_LAS unsigned char* lds, const Gemm g, const Sched& S, const Epi& E, unsigned long long* stamps) {
    const int tid = ltid(), wid = __builtin_amdgcn_readfirstlane(tid >> 6), lane = tid & 63, wr = wid >> 2, wc = wid & 3, fr = lane & 15, fq = lane >> 4;
    const int K = g.K, nt = K / BK;
    int ts_lo = 0, ts_hi = 0, nts = 0; const unsigned long long rt_entry = STAMP ? (unsigned long long)wall_clock64() : 0ull;
#define PG8_STAMP() do { if (STAMP && wid == 0 && nts < 64) { const unsigned long long _c = (unsigned long long)clock64(); \
        ts_lo = (lane == nts) ? (int)(unsigned)_c : ts_lo; ts_hi = (lane == nts) ? (int)(unsigned)(_c >> 32) : ts_hi; ++nts; } } while (0)
    PG8_STAMP();
    unsigned voffA[2], voffB[2];
#pragma unroll
    for (int i = 0; i < 2; ++i) { int R, C; stage_rc(tid * 16 + i * 8192, R, C); const int Rb = Epi::PERM ? ((R & ~31) + perm32(R & 31)) : R;
        voffA[i] = (unsigned)(R * K + C) * 2u; voffB[i] = (unsigned)(Rb * K + C) * 2u; }
    const size_t kstep = (size_t)(BK * 2);
    const size_t hstep = (size_t)HALF * K * 2;
    const size_t tstep = 2 * hstep;
    const unsigned ldsw = (unsigned)wid * 1024u;
    const int aoff = lds_byte(wr * 64 + fr, fq * 8), boff = lds_byte(wc * 32 + fr, fq * 8);
#define PG8_SA(b, h) (((b) * 2 + (h)) * HTB)
#define PG8_SB(b, h) ((4 + (b) * 2 + (h)) * HTB)
#define PG8_STAGE(bufoff, gbase, voff) do { _Pragma("unroll") for (int _i = 0; _i < 2; ++_i) \
        __builtin_amdgcn_global_load_lds((const unsigned*)((const char*)(gbase) + (voff)[_i]), (PG8_LAS unsigned*)(lds + (bufoff) + ldsw + _i * 8192), 16, 0, 0); } while (0)
#define PG8_LDA(dst, b, h) do { _Pragma("unroll") for (int m = 0; m < 4; ++m) _Pragma("unroll") for (int k = 0; k < 2; ++k) dst[m][k] = *(const PG8_LAS bf16x8*)(lds + PG8_SA(b, h) + aoff + m * 2048 + k * 1024); } while (0)
#define PG8_LDB(dst, b, h) do { _Pragma("unroll") for (int n = 0; n < 2; ++n) _Pragma("unroll") for (int k = 0; k < 2; ++k) dst[n][k] = *(const PG8_LAS bf16x8*)(lds + PG8_SB(b, h) + boff + n * 2048 + k * 1024); } while (0)
#define PG8_MMA(ai, bj, At, Bt) do { __builtin_amdgcn_s_setprio(1); _Pragma("unroll") for (int m = 0; m < 4; ++m) _Pragma("unroll") for (int n = 0; n < 2; ++n) _Pragma("unroll") for (int k = 0; k < 2; ++k) \
        acc[ai][bj][m][n] = __builtin_amdgcn_mfma_f32_16x16x32_bf16(Bt[n][k], At[m][k], acc[ai][bj][m][n], 0, 0, 0); __builtin_amdgcn_s_setprio(0); } while (0)
#define PG8_WAIT_V(n) asm volatile("s_waitcnt vmcnt(" #n ")" ::: "memory")
#define PG8_WAIT_L(n) asm volatile("s_waitcnt lgkmcnt(" #n ")" ::: "memory")
#define PG8_BAR __builtin_amdgcn_s_barrier()
#define PG8_SCHED __builtin_amdgcn_sched_barrier(0)
    Unit cur, nxt; int ui = 0;
    if (!S.next(0, cur)) return;
    f32x4 acc[2][2][4][2];
#pragma unroll
    for (int a = 0; a < 2; ++a)
#pragma unroll
        for (int b = 0; b < 2; ++b)
#pragma unroll
            for (int m = 0; m < 4; ++m)
#pragma unroll
                for (int n = 0; n < 2; ++n) acc[a][b][m][n] = (f32x4){0.f, 0.f, 0.f, 0.f};
    bf16x8 At[4][2], B0[2][2], B1[2][2];
    const char* cA = (const char*)g.A + (size_t)cur.pm * tstep; const char* cB = (const char*)g.Bt + (size_t)cur.pn * tstep;
    S.a_ready(cur);
    PG8_STAGE(PG8_SB(0, 0), cB, voffB); PG8_STAGE(PG8_SA(0, 0), cA, voffA); PG8_STAGE(PG8_SB(0, 1), cB + hstep, voffB); PG8_STAGE(PG8_SA(0, 1), cA + hstep, voffA);
    if (wr == 1) PG8_BAR;
    PG8_WAIT_V(4); PG8_BAR;
    PG8_STAGE(PG8_SB(1, 0), cB + kstep, voffB); PG8_STAGE(PG8_SA(1, 0), cA + kstep, voffA); PG8_STAGE(PG8_SB(1, 1), cB + hstep + kstep, voffB);
    PG8_WAIT_V(6); PG8_BAR;
    PG8_STAMP();
    for (;;) {
        const bool has_next = S.next(ui + 1, nxt);
        const char* nA = has_next ? (const char*)g.A + (size_t)nxt.pm * tstep : cA; const char* nB = has_next ? (const char*)g.Bt + (size_t)nxt.pn * tstep : cB;
        for (int t = 0; t < nt; t += 2) {
            const bool last = (t == nt - 2);
            const char* a1 = cA + (size_t)(t + 1) * kstep;
            const char* a2 = last ? nA : cA + (size_t)(t + 2) * kstep; const char* b2 = last ? nB : cB + (size_t)(t + 2) * kstep;
            const char* a3 = a2 + kstep; const char* b3 = b2 + kstep;
            if (last && has_next) S.a_ready(nxt);
            PG8_LDB(B0, 0, 0); PG8_SCHED; PG8_LDA(At, 0, 0); PG8_STAGE(PG8_SA(1, 1), a1 + hstep, voffA);
            PG8_WAIT_L(8); PG8_BAR; PG8_WAIT_L(0); PG8_MMA(0, 0, At, B0); PG8_BAR; PG8_SCHED;
            PG8_LDB(B1, 0, 1); PG8_STAGE(PG8_SB(0, 0), b2, voffB);
            PG8_BAR; PG8_WAIT_L(0); PG8_MMA(0, 1, At, B1); PG8_BAR;
            PG8_LDA(At, 0, 1); PG8_STAGE(PG8_SA(0, 0), a2, voffA);
            PG8_BAR; PG8_WAIT_L(0); PG8_MMA(1, 0, At, B0); PG8_BAR; PG8_SCHED;
            PG8_STAGE(PG8_SB(0, 1), b2 + hstep, voffB);
            PG8_WAIT_V(6); PG8_BAR; PG8_MMA(1, 1, At, B1); PG8_BAR;
            PG8_LDB(B0, 1, 0); PG8_SCHED; PG8_LDA(At, 1, 0); PG8_STAGE(PG8_SA(0, 1), a2 + hstep, voffA);
            PG8_WAIT_L(8); PG8_BAR; PG8_WAIT_L(0); PG8_MMA(0, 0, At, B0); PG8_BAR; PG8_SCHED;
            PG8_LDB(B1, 1, 1); PG8_STAGE(PG8_SB(1, 0), b3, voffB);
            PG8_BAR; PG8_WAIT_L(0); PG8_MMA(0, 1, At, B1); PG8_BAR;
            PG8_LDA(At, 1, 1); PG8_STAGE(PG8_SA(1, 0), a3, voffA);
            PG8_BAR; PG8_WAIT_L(0); PG8_MMA(1, 0, At, B0); PG8_BAR; PG8_SCHED;
            PG8_STAGE(PG8_SB(1, 1), b3 + hstep, voffB);
            PG8_WAIT_V(6); PG8_BAR; PG8_MMA(1, 1, At, B1); PG8_BAR;
        }
        PG8_STAMP();
        if constexpr (!Epi::AFTER_DRAIN) { E(acc, cur, wr, wc, fr, fq); S.done(cur); }
        PG8_STAMP();
        if (!has_next) break;
#pragma unroll
        for (int a = 0; a < 2; ++a)
#pragma unroll
            for (int b = 0; b < 2; ++b)
#pragma unroll
                for (int m = 0; m < 4; ++m)
#pragma unroll
                    for (int n = 0; n < 2; ++n) acc[a][b][m][n] = (f32x4){0.f, 0.f, 0.f, 0.f};
        cur = nxt; cA = nA; cB = nB; ++ui;
    }
    PG8_WAIT_V(0);
    if (wr == 0) PG8_BAR;
    PG8_BAR;
    if constexpr (Epi::AFTER_DRAIN) { E.fused(acc, cur, wr, wc, fr, fq, lds, wid, lane); S.done(cur); }
    PG8_STAMP();
    if (STAMP && wid == 0) { stamps[lane] = lane < nts ? (((unsigned long long)(unsigned)ts_hi << 32) | (unsigned)ts_lo) : 0ull;
        if (lane == 62) stamps[62] = rt_entry; if (lane == 63) stamps[63] = (unsigned long long)wall_clock64(); }
#undef PG8_STAMP
#undef PG8_SA
#undef PG8_SB
#undef PG8_STAGE
#undef PG8_LDA
#undef PG8_LDB
#undef PG8_MMA
#undef PG8_WAIT_V
#undef PG8_WAIT_L
#undef PG8_BAR
#undef PG8_SCHED
}
}

__device__ __forceinline__ float wave_sum(float v) {
#pragma unroll
    for (int o = 32; o > 0; o >>= 1) v += __shfl_xor(v, o);
    return v;
}
__device__ __forceinline__ float wave_max(float v) {
#pragma unroll
    for (int o = 32; o > 0; o >>= 1) v = fmaxf(v, __shfl_xor(v, o));
    return v;
}
__device__ __forceinline__ int wave_isum(int v) {
#pragma unroll
    for (int o = 32; o > 0; o >>= 1) v += __shfl_xor(v, o);
    return v;
}
__device__ __forceinline__ float silu_f(float x) { return x / (1.f + __expf(-x)); }

#define T_ 8192
#define D_ 2048
#define IN_AB 3472
#define IN_C 12288
#define NT 512
#define ALPHA_ 1.4142135623730951f
#define LOG2E_ 1.4426950408889634f

#define BM 256
#define BN 128
#define BK 64
#define LROW 80
#define GEMM_BUF (BM * LROW + BN * LROW)
#define GEMM_LDS_BYTES (2 * GEMM_BUF * 2)

#define B_F32_KN 0
#define B_BF16_NK 1
#define B_BF16_KN 2

typedef f32x4 Acc[4][4];

__device__ __forceinline__ __amdgpu_buffer_rsrc_t make_rsrc(const void* p) {
    const unsigned long long a = (unsigned long long)p;
    const unsigned lo = __builtin_amdgcn_readfirstlane((unsigned)a), hi = __builtin_amdgcn_readfirstlane((unsigned)(a >> 32));
    return __builtin_amdgcn_make_buffer_rsrc((void*)(((unsigned long long)hi << 32) | lo), 0, 0x7fffffff, 0x00020000);
}
__device__ __forceinline__ u32x4 bload16(__amdgpu_buffer_rsrc_t r, unsigned voff, unsigned soff) {
    return __builtin_amdgcn_raw_buffer_load_b128(r, (int)voff, (int)soff, 0);
}

__device__ __forceinline__ void acc_zero(Acc& acc) {
#pragma unroll
    for (int m = 0; m < 4; ++m)
#pragma unroll
        for (int n = 0; n < 4; ++n) acc[m][n] = (f32x4){0.f, 0.f, 0.f, 0.f};
}

template <int BMODE, bool KS, bool LONGK = false, class ARow, class BSel>
__device__ __forceinline__ void gemm_accum(Acc& acc, const u16* __restrict__ A, int lda, ARow arow,
                                           const void* __restrict__ Bv, int ldb, BSel bsel,
                                           int K, u16* lds) {
    const int tid = ltid(), lane = tid & 63;
    const int wid = __builtin_amdgcn_readfirstlane(tid >> 6);
    const int wr = KS ? ((wid & 3) >> 1) : (wid >> 1), wc = wid & 1, fr = lane & 15, fq = lane >> 4;
    constexpr int NA = KS ? 2 : 4;
    const int ac = tid & 7, ar0 = tid >> 3;
    unsigned ao[NA];
#pragma unroll
    for (int i = 0; i < NA; ++i) ao[i] = ((unsigned)arow(ar0 + 64 * i) * (unsigned)lda + ac * 8) * 2u;
    const int nk = K / BK;
    const int sa_w = ar0 * LROW + ac * 8;
    constexpr int SB0 = BM * LROW;
    const __amdgpu_buffer_rsrc_t rA = make_rsrc(A);

#define MMA16(AF, BF) do { \
        __builtin_amdgcn_s_setprio(1); \
        _Pragma("unroll") for (int m = 0; m < 4; ++m) \
        _Pragma("unroll") for (int n = 0; n < 4; ++n) \
            acc[m][n] = __builtin_amdgcn_mfma_f32_16x16x32_bf16(AF[m], BF[n], acc[m][n], 0, 0, 0); \
        __builtin_amdgcn_s_setprio(0); } while (0)
#define MEMFENCE_ asm volatile("" ::: "memory")
#define GEMM_COMPUTE(buf) do { \
        const u16* sA = lds + (buf) * GEMM_BUF; const u16* sB = sA + SB0; \
        _Pragma("unroll") for (int ks = 0; ks < 2; ++ks) { \
            if (KS && ks != (wid >> 2)) continue; \
            bf16x8 af[4], bfr[4]; \
            _Pragma("unroll") for (int m = 0; m < 4; ++m) af[m] = *(const bf16x8*)(sA + (wr * 64 + m * 16 + fr) * LROW + ks * 32 + fq * 8); \
            _Pragma("unroll") for (int n = 0; n < 4; ++n) bfr[n] = *(const bf16x8*)(sB + (wc * 64 + n * 16 + fr) * LROW + ks * 32 + fq * 8); \
            _Pragma("unroll") for (int m = 0; m < 4; ++m) \
            _Pragma("unroll") for (int n = 0; n < 4; ++n) \
                acc[m][n] = __builtin_amdgcn_mfma_f32_16x16x32_bf16(af[m], bfr[n], acc[m][n], 0, 0, 0); \
        } } while (0)

    __syncthreads();

#define FRAG_KN(buf, ks, AF, BF) do { \
        const u16* sA = lds + (buf) * GEMM_BUF; \
        const LAS char* cB = (const LAS char*)(lds + (buf) * GEMM_BUF); \
        _Pragma("unroll") for (int m = 0; m < 4; ++m) AF[m] = *(const bf16x8*)(sA + (wr * 64 + m * 16 + fr) * LROW + (ks) * 32 + fq * 8); \
        _Pragma("unroll") for (int n = 0; n < 4; ++n) { \
            const s16x4 lo_ = __builtin_amdgcn_ds_read_tr16_b64_v4i16((LAS s16x4*)(cB + rdo[0][n] + (ks) * 8192)); \
            const s16x4 hi_ = __builtin_amdgcn_ds_read_tr16_b64_v4i16((LAS s16x4*)(cB + rdo[1][n] + (ks) * 8192)); \
            BF[n] = __builtin_shufflevector(lo_, hi_, 0, 1, 2, 3, 4, 5, 6, 7); } } while (0)
    if constexpr (BMODE == B_BF16_KN) {
        const int ch8 = tid & 7, kr = tid >> 3;
        const __amdgpu_buffer_rsrc_t rB0 = make_rsrc(bsel.base16((const u16*)Bv, 0));
        const __amdgpu_buffer_rsrc_t rB1 = make_rsrc(bsel.base16((const u16*)Bv, 1));
        const unsigned ldb2 = (unsigned)ldb * 2u;
        const unsigned bof0 = (unsigned)kr * ldb2 + bsel.off8(0, ch8) * 2u, bof1 = (unsigned)kr * ldb2 + bsel.off8(1, ch8) * 2u;
        const int xw = ((kr & 3) << 2) | ((kr >> 2) & 3);
        const int sbw0 = SB0 * 2 + kr * 256 + 16 * (bsel.vchunk(0, ch8) ^ xw);
        const int sbw1 = SB0 * 2 + kr * 256 + 16 * (bsel.vchunk(1, ch8) ^ xw);
        int rdo[2][4];
#pragma unroll
        for (int t = 0; t < 2; ++t) {
            const int xr = ((fr >> 2) << 2) | ((2 * fq + t) & 3);
#pragma unroll
            for (int n = 0; n < 4; ++n)
                rdo[t][n] = SB0 * 2 + (8 * fq + 4 * t + (fr >> 2)) * 256 + 16 * ((2 * (wc * 4 + n) + ((fr & 3) >> 1)) ^ xr) + 8 * (fr & 1);
        }
        u32x4 ra0[NA], ra1[NA]; u32x4 rb0[2], rb1[2];
#define GL_KB(k0, RA, RB) do { \
        _Pragma("unroll") for (int i = 0; i < NA; ++i) RA[i] = bload16(rA, ao[i], (unsigned)(k0) * 2u); \
        const unsigned s0_ = (unsigned)(k0) * ldb2; \
        RB[0] = bload16(rB0, bof0, s0_); RB[1] = bload16(rB1, bof1, s0_); } while (0)
#define LW_KB(buf, RA, RB) do { \
        u16* sb_ = lds + (buf) * GEMM_BUF; \
        _Pragma("unroll") for (int i = 0; i < NA; ++i) *(u32x4*)(sb_ + sa_w + 64 * i * LROW) = RA[i]; \
        char* cb_ = (char*)sb_; \
        *(u32x4*)(cb_ + sbw0) = RB[0]; *(u32x4*)(cb_ + sbw1) = RB[1]; } while (0)
        GL_KB(0, ra0, rb0);
        GL_KB(BK, ra1, rb1);
        LW_KB(0, ra0, rb0);
        if (LONGK || 2 < nk) GL_KB((2 < nk ? 2 : nk - 1) * BK, ra0, rb0);
        __syncthreads();
        bf16x8 af0[4], bf0[4], af1[4], bf1[4];
        for (int kt = 0; kt < nk; kt += 2) {
            if (!KS) { FRAG_KN(0, 0, af0, bf0); } else { FRAG_KN(0, (wid >> 2), af0, bf0); }
            MEMFENCE_;
            LW_KB(1, ra1, rb1);
            if (LONGK || kt + 3 < nk) GL_KB((kt + 3 < nk ? kt + 3 : nk - 1) * BK, ra1, rb1);
            MEMFENCE_;
            if (!KS) FRAG_KN(0, 1, af1, bf1);
            MMA16(af0, bf0);
            if (!KS) MMA16(af1, bf1);
            __syncthreads();
            if (!KS) { FRAG_KN(1, 0, af0, bf0); } else { FRAG_KN(1, (wid >> 2), af0, bf0); }
            MEMFENCE_;
            if (LONGK || kt + 2 < nk) LW_KB(0, ra0, rb0);
            if (LONGK || kt + 4 < nk) GL_KB((kt + 4 < nk ? kt + 4 : nk - 1) * BK, ra0, rb0);
            MEMFENCE_;
            if (!KS) FRAG_KN(1, 1, af1, bf1);
            MMA16(af0, bf0);
            if (!KS) MMA16(af1, bf1);
            __syncthreads();
        }
#undef GL_KB
#undef LW_KB
    } else if constexpr (BMODE == B_F32_KN) {
        const int g4 = tid & 15, kr = tid >> 4;
        const __amdgpu_buffer_rsrc_t rB0 = make_rsrc(bsel.base((const float*)Bv, 0));
        const __amdgpu_buffer_rsrc_t rB1 = make_rsrc(bsel.base((const float*)Bv, 1));
        const unsigned ldb4 = (unsigned)ldb * 4u;
        const unsigned bof0 = (unsigned)kr * ldb4 + bsel.off4(0, g4) * 4u, bof1 = (unsigned)kr * ldb4 + bsel.off4(1, g4) * 4u;
        const int xw = ((kr & 3) << 2) | ((kr >> 2) & 3);
        const int v00 = bsel.vcol4(0, g4), v01 = bsel.vcol4(1, g4);
        const int sbw0 = SB0 * 2 + kr * 256 + 16 * ((v00 >> 3) ^ xw) + 8 * ((v00 >> 2) & 1);
        const int sbw1 = SB0 * 2 + kr * 256 + 16 * ((v01 >> 3) ^ xw) + 8 * ((v01 >> 2) & 1);
        int rdo[2][4];
#pragma unroll
        for (int t = 0; t < 2; ++t) {
            const int xr = ((fr >> 2) << 2) | ((2 * fq + t) & 3);
#pragma unroll
            for (int n = 0; n < 4; ++n)
                rdo[t][n] = SB0 * 2 + (8 * fq + 4 * t + (fr >> 2)) * 256 + 16 * ((2 * (wc * 4 + n) + ((fr & 3) >> 1)) ^ xr) + 8 * (fr & 1);
        }
        u32x4 ra0[NA], ra1[NA]; u32x4 rb0[4], rb1[4];
#define PK4_(V) (w_.x = pack2(__uint_as_float(V[0]), __uint_as_float(V[1])), w_.y = pack2(__uint_as_float(V[2]), __uint_as_float(V[3])))
#define GL_F32(k0, RA, RB) do { \
        _Pragma("unroll") for (int i = 0; i < NA; ++i) RA[i] = bload16(rA, ao[i], (unsigned)(k0) * 2u); \
        const unsigned s0_ = (unsigned)(k0) * ldb4, s1_ = s0_ + 32u * ldb4; \
        RB[0] = bload16(rB0, bof0, s0_); RB[1] = bload16(rB1, bof1, s0_); \
        RB[2] = bload16(rB0, bof0, s1_); RB[3] = bload16(rB1, bof1, s1_); } while (0)
#define LW_F32(buf, RA, RB) do { \
        u16* sb_ = lds + (buf) * GEMM_BUF; \
        _Pragma("unroll") for (int i = 0; i < NA; ++i) *(u32x4*)(sb_ + sa_w + 64 * i * LROW) = RA[i]; \
        char* cb_ = (char*)sb_; \
        u32x2 w_; \
        PK4_(RB[0]); *(u32x2*)(cb_ + sbw0) = w_; \
        PK4_(RB[1]); *(u32x2*)(cb_ + sbw1) = w_; \
        PK4_(RB[2]); *(u32x2*)(cb_ + sbw0 + 32 * 256) = w_; \
        PK4_(RB[3]); *(u32x2*)(cb_ + sbw1 + 32 * 256) = w_; } while (0)
        GL_F32(0, ra0, rb0);
        GL_F32(BK, ra1, rb1);
        LW_F32(0, ra0, rb0);
        if (LONGK || 2 < nk) GL_F32((2 < nk ? 2 : nk - 1) * BK, ra0, rb0);
        __syncthreads();
        bf16x8 af0[4], bf0[4], af1[4], bf1[4];
        for (int kt = 0; kt < nk; kt += 2) {
            if (!KS) { FRAG_KN(0, 0, af0, bf0); } else { FRAG_KN(0, (wid >> 2), af0, bf0); }
            MEMFENCE_;
            LW_F32(1, ra1, rb1);
            if (LONGK || kt + 3 < nk) GL_F32((kt + 3 < nk ? kt + 3 : nk - 1) * BK, ra1, rb1);
            MEMFENCE_;
            if (!KS) FRAG_KN(0, 1, af1, bf1);
            MMA16(af0, bf0);
            if (!KS) MMA16(af1, bf1);
            __syncthreads();
            if (!KS) { FRAG_KN(1, 0, af0, bf0); } else { FRAG_KN(1, (wid >> 2), af0, bf0); }
            MEMFENCE_;
            if (LONGK || kt + 2 < nk) LW_F32(0, ra0, rb0);
            if (LONGK || kt + 4 < nk) GL_F32((kt + 4 < nk ? kt + 4 : nk - 1) * BK, ra0, rb0);
            MEMFENCE_;
            if (!KS) FRAG_KN(1, 1, af1, bf1);
            MMA16(af0, bf0);
            if (!KS) MMA16(af1, bf1);
            __syncthreads();
        }
#undef GL_F32
#undef LW_F32
    } else {
        const __amdgpu_buffer_rsrc_t rB = make_rsrc(Bv);
        unsigned bo[2];
#pragma unroll
        for (int i = 0; i < 2; ++i) bo[i] = ((unsigned)bsel(ar0 + 64 * i) * (unsigned)ldb + ac * 8) * 2u;
        u32x4 ra0[NA], ra1[NA], rb0[2], rb1[2];
#define GL_BF(k0, RA, RB) do { \
        _Pragma("unroll") for (int i = 0; i < NA; ++i) RA[i] = bload16(rA, ao[i], (unsigned)(k0) * 2u); \
        _Pragma("unroll") for (int i = 0; i < 2; ++i) RB[i] = bload16(rB, bo[i], (unsigned)(k0) * 2u); } while (0)
#define LW_BF(buf, RA, RB) do { \
        u16* sb_ = lds + (buf) * GEMM_BUF; \
        _Pragma("unroll") for (int i = 0; i < NA; ++i) *(u32x4*)(sb_ + sa_w + 64 * i * LROW) = RA[i]; \
        _Pragma("unroll") for (int i = 0; i < 2; ++i) *(u32x4*)(sb_ + SB0 + sa_w + 64 * i * LROW) = RB[i]; } while (0)
        GL_BF(0, ra0, rb0);
        GL_BF(BK, ra1, rb1);
        LW_BF(0, ra0, rb0);
        if (LONGK || 2 < nk) GL_BF((2 < nk ? 2 : nk - 1) * BK, ra0, rb0);
        __syncthreads();
#define FRAG_NK(buf, ks, AF, BF) do { \
        const u16* sA = lds + (buf) * GEMM_BUF; const u16* sB = sA + SB0; \
        _Pragma("unroll") for (int m = 0; m < 4; ++m) AF[m] = *(const bf16x8*)(sA + (wr * 64 + m * 16 + fr) * LROW + (ks) * 32 + fq * 8); \
        _Pragma("unroll") for (int n = 0; n < 4; ++n) BF[n] = *(const bf16x8*)(sB + (wc * 64 + n * 16 + fr) * LROW + (ks) * 32 + fq * 8); } while (0)
        bf16x8 af0[4], bf0[4], af1[4], bf1[4];
        for (int kt = 0; kt < nk; kt += 2) {
            if (!KS) { FRAG_NK(0, 0, af0, bf0); } else { FRAG_NK(0, (wid >> 2), af0, bf0); }
            MEMFENCE_;
            LW_BF(1, ra1, rb1);
            if (LONGK || kt + 3 < nk) GL_BF((kt + 3 < nk ? kt + 3 : nk - 1) * BK, ra1, rb1);
            MEMFENCE_;
            if (!KS) FRAG_NK(0, 1, af1, bf1);
            MMA16(af0, bf0);
            if (!KS) MMA16(af1, bf1);
            __syncthreads();
            if (!KS) { FRAG_NK(1, 0, af0, bf0); } else { FRAG_NK(1, (wid >> 2), af0, bf0); }
            MEMFENCE_;
            if (LONGK || kt + 2 < nk) LW_BF(0, ra0, rb0);
            if (LONGK || kt + 4 < nk) GL_BF((kt + 4 < nk ? kt + 4 : nk - 1) * BK, ra0, rb0);
            MEMFENCE_;
            if (!KS) FRAG_NK(1, 1, af1, bf1);
            MMA16(af0, bf0);
            if (!KS) MMA16(af1, bf1);
            __syncthreads();
        }
#undef FRAG_NK
#undef GL_BF
#undef LW_BF
    }
#undef GEMM_COMPUTE
#undef FRAG_KN
}

__device__ __forceinline__ void gemm_kk128(Acc& acc, const u16* __restrict__ Akm, int lda, const u16* __restrict__ Bkn, int ldb, u16* lds) {
    const int tid = ltid(), lane = tid & 63;
    const int wid = __builtin_amdgcn_readfirstlane(tid >> 6);
    const int wr = wid >> 1, wc = wid & 1, fr = lane & 15, fq = lane >> 4;
    char* sA = (char*)lds;
    char* sB = (char*)lds + 65536;
    __syncthreads();
    {
        u32x4 ra[8], rb[4];
#pragma unroll
        for (int i = 0; i < 8; ++i) { const int k = (tid >> 5) + 16 * i, ch = tid & 31; ra[i] = *(const u32x4*)(Akm + (size_t)k * lda + ch * 8); }
#pragma unroll
        for (int i = 0; i < 4; ++i) { const int k = (tid >> 4) + 32 * i, ch = tid & 15; rb[i] = *(const u32x4*)(Bkn + (size_t)k * ldb + ch * 8); }
#pragma unroll
        for (int i = 0; i < 8; ++i) { const int k = (tid >> 5) + 16 * i, ch = tid & 31; const int x = ((k & 3) << 2) | ((k >> 2) & 3);
            *(u32x4*)(sA + k * 512 + 16 * (ch ^ x)) = ra[i]; }
#pragma unroll
        for (int i = 0; i < 4; ++i) { const int k = (tid >> 4) + 32 * i, ch = tid & 15; const int x = ((k & 3) << 2) | ((k >> 2) & 3);
            *(u32x4*)(sB + k * 256 + 16 * (ch ^ x)) = rb[i]; }
    }
    __syncthreads();
    const LAS char* cA = (const LAS char*)sA; const LAS char* cB = (const LAS char*)sB;
#pragma unroll
    for (int ks = 0; ks < 4; ++ks) {
        bf16x8 af[4], bfr[4];
#pragma unroll
        for (int t = 0; t < 2; ++t) { }
#pragma unroll
        for (int m = 0; m < 4; ++m) {
            const int row0 = 32 * ks + 8 * fq + (fr >> 2), xr0 = ((fr >> 2) << 2) | ((2 * fq) & 3), xr1 = ((fr >> 2) << 2) | ((2 * fq + 1) & 3);
            const int chunk = 2 * (wr * 4 + m) + ((fr & 3) >> 1);
            const s16x4 lo_ = __builtin_amdgcn_ds_read_tr16_b64_v4i16((LAS s16x4*)(cA + row0 * 512 + 16 * (chunk ^ xr0) + 8 * (fr & 1)));
            const s16x4 hi_ = __builtin_amdgcn_ds_read_tr16_b64_v4i16((LAS s16x4*)(cA + (row0 + 4) * 512 + 16 * (chunk ^ xr1) + 8 * (fr & 1)));
            af[m] = __builtin_shufflevector(lo_, hi_, 0, 1, 2, 3, 4, 5, 6, 7);
        }
#pragma unroll
        for (int n = 0; n < 4; ++n) {
            const int row0 = 32 * ks + 8 * fq + (fr >> 2), xr0 = ((fr >> 2) << 2) | ((2 * fq) & 3), xr1 = ((fr >> 2) << 2) | ((2 * fq + 1) & 3);
            const int chunk = 2 * (wc * 4 + n) + ((fr & 3) >> 1);
            const s16x4 lo_ = __builtin_amdgcn_ds_read_tr16_b64_v4i16((LAS s16x4*)(cB + row0 * 256 + 16 * (chunk ^ xr0) + 8 * (fr & 1)));
            const s16x4 hi_ = __builtin_amdgcn_ds_read_tr16_b64_v4i16((LAS s16x4*)(cB + (row0 + 4) * 256 + 16 * (chunk ^ xr1) + 8 * (fr & 1)));
            bfr[n] = __builtin_shufflevector(lo_, hi_, 0, 1, 2, 3, 4, 5, 6, 7);
        }
#pragma unroll
        for (int m = 0; m < 4; ++m)
#pragma unroll
            for (int n = 0; n < 4; ++n) acc[m][n] = __builtin_amdgcn_mfma_f32_16x16x32_bf16(af[m], bfr[n], acc[m][n], 0, 0, 0);
    }
    __syncthreads();
}

__device__ __forceinline__ bool ksplit_reduce(Acc& acc, u16* lds) {
    const int tid = ltid(), lane = tid & 63;
    const int wid = __builtin_amdgcn_readfirstlane(tid >> 6);
    float* f = (float*)lds + (wid & 3) * 4096 + lane;
    if (wid >= 4) {
#pragma unroll
        for (int m = 0; m < 4; ++m)
#pragma unroll
            for (int n = 0; n < 4; ++n)
#pragma unroll
                for (int j = 0; j < 4; ++j) f[((m * 4 + n) * 4 + j) * 64] = acc[m][n][j];
    }
    __syncthreads();
    if (wid < 4) {
#pragma unroll
        for (int m = 0; m < 4; ++m)
#pragma unroll
            for (int n = 0; n < 4; ++n)
#pragma unroll
                for (int j = 0; j < 4; ++j) acc[m][n][j] += f[((m * 4 + n) * 4 + j) * 64];
    }
    return wid < 4;
}


#define STG_LD 68
#define STG_WAVE_BYTES (32 * STG_LD * 4)
#define WR0_ ((ltid() >> 7) * 64)
#define WC0_ (((ltid() >> 6) & 1) * 64)
template <class F>
__device__ __forceinline__ void stage_rows(Acc& acc, unsigned char* stage_base, F f) {
    const int tid = ltid(), lane = tid & 63, wid = tid >> 6, fr = lane & 15, fq = lane >> 4;
    float* st = (float*)(stage_base + wid * STG_WAVE_BYTES);
#pragma unroll
    for (int h = 0; h < 2; ++h) {
#pragma unroll
        for (int mm = 0; mm < 2; ++mm)
#pragma unroll
            for (int n = 0; n < 4; ++n)
#pragma unroll
                for (int j = 0; j < 4; ++j) st[(mm * 16 + fq * 4 + j) * STG_LD + n * 16 + fr] = acc[2 * h + mm][n][j];
        __builtin_amdgcn_s_waitcnt(0xc07f);
#pragma unroll
        for (int i = 0; i < 8; ++i) {
            const int r = (lane >> 4) + 4 * i, c4 = (lane & 15) * 4;
            const f32x4 v = *(const f32x4*)(st + r * STG_LD + c4);
            f(h * 32 + r, c4, v);
        }
        __builtin_amdgcn_s_waitcnt(0xc07f);
    }
}
template <class F>
__device__ __forceinline__ void stage_pairs(Acc& acc, unsigned char* stage_base, F f) {
    const int tid = ltid(), lane = tid & 63, wid = tid >> 6, fr = lane & 15, fq = lane >> 4;
    float* st = (float*)(stage_base + wid * STG_WAVE_BYTES);
#pragma unroll
    for (int h = 0; h < 2; ++h) {
#pragma unroll
        for (int mm = 0; mm < 2; ++mm)
#pragma unroll
            for (int n = 0; n < 4; ++n)
#pragma unroll
                for (int j = 0; j < 4; ++j) st[(mm * 16 + fq * 4 + j) * STG_LD + n * 16 + fr] = acc[2 * h + mm][n][j];
        __builtin_amdgcn_s_waitcnt(0xc07f);
#pragma unroll
        for (int i = 0; i < 4; ++i) {
            const int r = (lane >> 3) + 8 * i, c4 = (lane & 7) * 4;
            const f32x4 lo = *(const f32x4*)(st + r * STG_LD + c4);
            const f32x4 hi = *(const f32x4*)(st + r * STG_LD + c4 + 32);
            f(h * 32 + r, c4, lo, hi);
        }
        __builtin_amdgcn_s_waitcnt(0xc07f);
    }
}

template <class AUX, class PRE, class F>
__device__ __forceinline__ void stage_rows_pre(Acc& acc, unsigned char* stage_base, PRE pre, F f) {
    const int tid = ltid(), lane = tid & 63, wid = tid >> 6, fr = lane & 15, fq = lane >> 4;
    float* st = (float*)(stage_base + wid * STG_WAVE_BYTES);
#pragma unroll
    for (int h = 0; h < 2; ++h) {
        AUX aux[8];
#pragma unroll
        for (int i = 0; i < 8; ++i) aux[i] = pre(h * 32 + (lane >> 4) + 4 * i, (lane & 15) * 4);
#pragma unroll
        for (int mm = 0; mm < 2; ++mm)
#pragma unroll
            for (int n = 0; n < 4; ++n)
#pragma unroll
                for (int j = 0; j < 4; ++j) st[(mm * 16 + fq * 4 + j) * STG_LD + n * 16 + fr] = acc[2 * h + mm][n][j];
        __builtin_amdgcn_s_waitcnt(0xc07f);
        f32x4 v[8];
#pragma unroll
        for (int i = 0; i < 8; ++i) v[i] = *(const f32x4*)(st + ((lane >> 4) + 4 * i) * STG_LD + (lane & 15) * 4);
        asm volatile("" ::: "memory");
#pragma unroll
        for (int i = 0; i < 8; ++i) f(h * 32 + (lane >> 4) + 4 * i, (lane & 15) * 4, v[i], aux[i]);
        __builtin_amdgcn_s_waitcnt(0xc07f);
    }
}
template <class AUX, class PRE, class F>
__device__ __forceinline__ void stage_pairs_pre(Acc& acc, unsigned char* stage_base, PRE pre, F f) {
    const int tid = ltid(), lane = tid & 63, wid = tid >> 6, fr = lane & 15, fq = lane >> 4;
    float* st = (float*)(stage_base + wid * STG_WAVE_BYTES);
#pragma unroll
    for (int h = 0; h < 2; ++h) {
        AUX aux[4];
#pragma unroll
        for (int i = 0; i < 4; ++i) aux[i] = pre(h * 32 + (lane >> 3) + 8 * i, (lane & 7) * 4);
#pragma unroll
        for (int mm = 0; mm < 2; ++mm)
#pragma unroll
            for (int n = 0; n < 4; ++n)
#pragma unroll
                for (int j = 0; j < 4; ++j) st[(mm * 16 + fq * 4 + j) * STG_LD + n * 16 + fr] = acc[2 * h + mm][n][j];
        __builtin_amdgcn_s_waitcnt(0xc07f);
        f32x4 lo[4], hi[4];
#pragma unroll
        for (int i = 0; i < 4; ++i) {
            lo[i] = *(const f32x4*)(st + ((lane >> 3) + 8 * i) * STG_LD + (lane & 7) * 4);
            hi[i] = *(const f32x4*)(st + ((lane >> 3) + 8 * i) * STG_LD + (lane & 7) * 4 + 32);
        }
        asm volatile("" ::: "memory");
#pragma unroll
        for (int i = 0; i < 4; ++i) f(h * 32 + (lane >> 3) + 8 * i, (lane & 7) * 4, lo[i], hi[i], aux[i]);
        __builtin_amdgcn_s_waitcnt(0xc07f);
    }
}
__device__ __forceinline__ u32x2 pack4(f32x4 v) { u32x2 w; w.x = pack2(v[0], v[1]); w.y = pack2(v[2], v[3]); return w; }

struct Params {
    const float* x; const int* pos; const float* router_w; const float* router_b;
    const float* w_in0; const float* q_norm; const float* w_uq; const float* kv_norm; const float* w_ukv; const float* w_out0;
    const float* w_in1; const float* gn_g; const float* gn_b; const float* w_out1;
    const float* ln_mix_g[2]; const float* ln_mix_b[2];
    const float* moe_wg[2]; const float* moe_wu[2]; const float* moe_wd[2];
    const float* sh_g[2]; const float* sh_u[2]; const float* sh_d[2];
    const float* ln_ffn_g[2]; const float* ln_ffn_b[2];
    float* out;
    u16* w_in0b; u16* w_uqb; u16* w_ukvb; u16* w_out0b; u16* w_in1b; u16* w_out1b; u16* w_out1t; u16* w_out0t; u16* w_in1t; u16* w_in0t; u16* sh_gut[2]; u16* sh_dt[2]; u16* sh_gb[2]; u16* sh_ub[2]; u16* sh_db[2];
    unsigned* bar; unsigned* ctl;
    float* cosA; float* sinA; float* cosR; float* sinR;
    u16* xb; u16* H0;
    u16* cqn; u16* ckvn; u16* kpe; u16* qb; u16* kb; u16* vb; u16* iqb; u16* ikb; float* iwf;
    u16* qa; u16* ka; u16* vaT;
    float* scores; u16* sel; u16* outcat; float* mla_po; float* mla_ml;
    u16* ybuf; u16* xab; u16* xlb; u16* whT; u16* wlT; u16* y2; u16* xcb;
    int* tok_e; float* tok_g; int* list; u16* hbuf; u16* hsh; u16* yr;
    u16* qr; u16* qx; u16* kr; u16* kzT; u16* v1; u16* kz; u16* sg; u16* KVt; u16* innerG; u16* obuf; u16* gated;
    int out_size; int pad_;
};
typedef const __attribute__((address_space(4))) Params* KP;
__device__ __forceinline__ KP getp() { KP kp = (KP)__builtin_amdgcn_kernarg_segment_ptr(); asm volatile("" : "+s"(kp)); return kp; }
#define CTL_FLAGS 0
#define CTL_QUEUE 16
#define CNT_STRIDE 32
#define CTL_CNT0 64
#define CTL_CNT1 (64 + 64 * CNT_STRIDE)
#define CTL_CNTX (64 + 128 * CNT_STRIDE)
#define CTL_WORDS (64 + 192 * CNT_STRIDE)

struct RowId { int base; __device__ __forceinline__ int operator()(int r) const { return base + r; } };
struct ColOff { int c0;
    __device__ __forceinline__ const u16* base16(const u16* B, int) const { return B; }
    __device__ __forceinline__ unsigned off8(int hsel, int ch8) const { return (unsigned)(c0 + hsel * 64 + ch8 * 8); }
    __device__ __forceinline__ int vchunk(int hsel, int ch8) const { return hsel * 8 + ch8; }
    __device__ __forceinline__ const float* base(const float* B, int) const { return B; }
    __device__ __forceinline__ unsigned off4(int hsel, int g4) const { return (unsigned)(c0 + hsel * 64 + g4 * 4); }
    __device__ __forceinline__ int vcol4(int hsel, int g4) const { return hsel * 64 + g4 * 4; } };
struct ColClampOff { int c0, n;
    __device__ __forceinline__ const u16* base16(const u16* B, int) const { return B; }
    __device__ __forceinline__ unsigned off8(int hsel, int ch8) const { const int c = c0 + hsel * 64 + ch8 * 8; return (unsigned)(c < n - 8 ? c : n - 8); }
    __device__ __forceinline__ int vchunk(int hsel, int ch8) const { return hsel * 8 + ch8; }
    __device__ __forceinline__ const float* base(const float* B, int) const { return B; }
    __device__ __forceinline__ unsigned off4(int hsel, int g4) const { const int c = c0 + hsel * 64 + g4 * 4; return (unsigned)(c < n - 4 ? c : n - 4); }
    __device__ __forceinline__ int vcol4(int hsel, int g4) const { return hsel * 64 + g4 * 4; } };

__device__ __forceinline__ void ph_prep(KP p) {
    const int gtid = blockIdx.x * NT + ltid(), gsz = gridDim.x * NT;
    {
        const size_t n4 = (size_t)T_ * D_ / 4;
        for (size_t i0 = gtid; i0 < n4; i0 += (size_t)8 * gsz) {
            float4 v[8];
#pragma unroll
            for (int u = 0; u < 8; ++u) { const size_t i = i0 + (size_t)u * gsz; v[u] = ((const float4*)p->x)[i < n4 ? i : i0]; }
#pragma unroll
            for (int u = 0; u < 8; ++u) {
                const size_t i = i0 + (size_t)u * gsz;
                u32x2 o; o.x = pack2(v[u].x, v[u].y); o.y = pack2(v[u].z, v[u].w);
                if (i < n4) ((u32x2*)p->xb)[i] = o;
            }
        }
    }
    for (int idx = gtid; idx < D_ * 64; idx += gsz) {
        const int k = idx >> 6, e = idx & 63;
        const float w = p->router_w[idx];
        const u16 hi = f2bf(w);
        p->whT[(size_t)e * D_ + k] = hi;
        p->wlT[(size_t)e * D_ + k] = f2bf(w - bf2f(hi));
    }
    {
        auto cvt = [&](const float* src, u16* dst, size_t n) {
            for (size_t i = gtid; i < n / 8; i += gsz) {
                const f32x4 a = ((const f32x4*)src)[2 * i], b = ((const f32x4*)src)[2 * i + 1];
                u32x4 o; o.x = pack2(a[0], a[1]); o.y = pack2(a[2], a[3]); o.z = pack2(b[0], b[1]); o.w = pack2(b[2], b[3]);
                ((u32x4*)dst)[i] = o;
            }
        };
        cvt(p->w_uq, p->w_uqb, (size_t)512 * 1536);
        cvt(p->w_ukv, p->w_ukvb, (size_t)256 * 2048);
    }
    const double inv2pi = 0.15915494309189535;
    for (int idx = gtid; idx < T_ * 32; idx += gsz) {
        const int t = idx >> 5, i = idx & 31;
        const float inv = (float)exp2(-(double)i * (18.931568569324174 / 32.0));
        double rev = (double)p->pos[t] * (double)inv * inv2pi;
        rev -= floor(rev);
        p->cosA[idx] = __builtin_amdgcn_cosf((float)rev);
        p->sinA[idx] = __builtin_amdgcn_sinf((float)rev);
    }
    for (int idx = gtid; idx < T_ * 128; idx += gsz) {
        const int t = idx >> 7, i = idx & 127;
        const float inv = (float)exp2(-(double)i * (13.287712379549449 / 128.0));
        double rev = (double)p->pos[t] * (double)inv * inv2pi;
        rev -= floor(rev);
        p->cosR[idx] = __builtin_amdgcn_cosf((float)rev);
        p->sinR[idx] = __builtin_amdgcn_sinf((float)rev);
    }
}

struct EpiF32 {
    float* C; int ldc; int row0, col0, ncols;
    __device__ __forceinline__ void operator()(Acc& acc, unsigned char* stg) const {
        const int rb = row0 + WR0_, cb = col0 + WC0_;
        float* Cp = C; const int ld = ldc, nc = ncols;
        stage_rows(acc, stg, [=](int r, int c4, f32x4 v) {
            const int c = cb + c4;
            if (c < nc) *(f32x4*)(Cp + (size_t)(rb + r) * ld + c) = v;
        });
    }
};
struct EpiBF16N {
    u16* C; int ldc; int row0, col0, ncols;
    __device__ __forceinline__ void operator()(Acc& acc, unsigned char* stg) const {
        const int rb = row0 + WR0_, cb = col0 + WC0_;
        u16* Cp = C; const int ld = ldc, nc = ncols;
        stage_rows(acc, stg, [=](int r, int c4, f32x4 v) {
            const int c = cb + c4;
            if (c < nc) *(u32x2*)(Cp + (size_t)(rb + r) * ld + c) = pack4(v);
        });
    }
};
struct EpiBF16 {
    u16* C; int ldc; int row0, col0;
    __device__ __forceinline__ void operator()(Acc& acc, unsigned char* stg) const {
        const int rb = row0 + WR0_, cb = col0 + WC0_;
        u16* Cp = C; const int ld = ldc;
        stage_rows(acc, stg, [=](int r, int c4, f32x4 v) { *(u32x2*)(Cp + (size_t)(rb + r) * ld + cb + c4) = pack4(v); });
    }
};
template <bool XB>
struct EpiResid {
    u16* C; const void* X; int ldc; int row0, col0;
    __device__ __forceinline__ void operator()(Acc& acc, unsigned char* stg) const {
        const int rb = row0 + WR0_, cb = col0 + WC0_;
        u16* Cp = C; const void* Xp = X; const int ld = ldc;
        stage_rows_pre<f32x4>(acc, stg,
            [=](int r, int c4) -> f32x4 {
                const size_t o = (size_t)(rb + r) * ld + cb + c4;
                f32x4 x;
                if constexpr (XB) {
                    const u32x2 xr = *(const u32x2*)((const u16*)Xp + o);
                    x[0] = __uint_as_float(xr.x << 16); x[1] = __uint_as_float(xr.x & 0xffff0000u);
                    x[2] = __uint_as_float(xr.y << 16); x[3] = __uint_as_float(xr.y & 0xffff0000u);
                } else x = *(const f32x4*)((const float*)Xp + o);
                return x; },
            [=](int r, int c4, f32x4 v, f32x4 x) {
                *(u32x2*)(Cp + (size_t)(rb + r) * ld + cb + c4) = pack4(x * ALPHA_ + v); });
    }
};

__device__ __forceinline__ void ph_post0(KP p) {
    const int lane = ltid() & 63;
    const int gw = (blockIdx.x * NT + ltid()) >> 6, nw = (gridDim.x * NT) >> 6;
    const float qscale = 0.08838834764831845f * LOG2E_;
    const int dq = lane, d7 = lane & 127;
    const float qn[8] = {p->q_norm[lane], p->q_norm[lane + 64], p->q_norm[lane + 128], p->q_norm[lane + 192],
                         p->q_norm[lane + 256], p->q_norm[lane + 320], p->q_norm[lane + 384], p->q_norm[lane + 448]};
    const float kn[4] = {p->kv_norm[lane], p->kv_norm[lane + 64], p->kv_norm[lane + 128], p->kv_norm[lane + 192]};
    (void)dq; (void)d7;
    for (int t = gw; t < T_; t += nw) {
        const u16* hb = p->H0 + (size_t)t * IN_AB;
#define h_(i) bf2f(hb[i])
        const float* ca = p->cosA + t * 32;
        const float* sa = p->sinA + t * 32;
        const float c32 = ca[lane & 31], s32 = sa[lane & 31];
        const float c16 = ca[2 * (lane & 15)], s16 = sa[2 * (lane & 15)];
        const float c8 = ca[4 * (lane & 7)], s8 = sa[4 * (lane & 7)];
        float vq[8], vkv[4];
#pragma unroll
        for (int j = 0; j < 8; ++j) vq[j] = h_(lane + 64 * j);
#pragma unroll
        for (int j = 0; j < 4; ++j) vkv[j] = h_(512 + lane + 64 * j);
        const float kx1 = h_(768 + (lane & 31)), kx2 = h_(768 + 32 + (lane & 31));
        float q1[16], q2[16];
#pragma unroll
        for (int j = 0; j < 16; ++j) {
            const int e = lane + 64 * j, hd = e >> 7, d = e & 127, i = d & 15;
            const int i1 = d < 32 ? 832 + hd * 128 + i : 832 + e;
            q1[j] = h_(i1); q2[j] = h_(d < 32 ? i1 + 16 : i1);
        }
        float k1[4], k2[4], vv[4];
#pragma unroll
        for (int j = 0; j < 4; ++j) {
            const int e = lane + 64 * j, hd = e >> 7, d = e & 127, i = d & 15;
            const int i1 = d < 32 ? 1856 + hd * 128 + i : 1856 + e;
            k1[j] = h_(i1); k2[j] = h_(d < 32 ? i1 + 16 : i1);
            vv[j] = h_(2112 + e);
        }
        float iq1[16], iq2[16];
#pragma unroll
        for (int j = 0; j < 16; ++j) {
            const int e = lane + 64 * j, hd = e >> 6, d = e & 63, i = d & 7;
            const int i1 = d < 16 ? 2368 + hd * 64 + i : 2368 + e;
            iq1[j] = h_(i1); iq2[j] = h_(d < 16 ? i1 + 8 : i1);
        }
        const int iki = lane < 16 ? 3392 + (lane & 7) : 3392 + lane;
        const float ik1 = h_(iki), ik2 = h_(lane < 16 ? iki + 8 : iki);
        const float iwv = h_(3456 + (lane & 15));
        {
            float ss = 0.f;
#pragma unroll
            for (int j = 0; j < 8; ++j) ss += vq[j] * vq[j];
            ss = wave_sum(ss);
            const float r = rsqrtf(ss * (1.f / 512.f) + 1e-6f);
#pragma unroll
            for (int j = 0; j < 8; ++j) p->cqn[(size_t)t * 512 + lane + 64 * j] = f2bf(vq[j] * r * qn[j]);
        }
        {
            float ss = 0.f;
#pragma unroll
            for (int j = 0; j < 4; ++j) ss += vkv[j] * vkv[j];
            ss = wave_sum(ss);
            const float r = rsqrtf(ss * (1.f / 256.f) + 1e-6f);
#pragma unroll
            for (int j = 0; j < 4; ++j) p->ckvn[(size_t)t * 256 + lane + 64 * j] = f2bf(vkv[j] * r * kn[j]);
        }
        p->kpe[(size_t)t * 64 + lane] = f2bf(lane < 32 ? kx1 * c32 - kx2 * s32 : kx1 * s32 + kx2 * c32);
#pragma unroll
        for (int j = 0; j < 16; ++j) {
            const int d = (lane + 64 * j) & 127;
            const float m1 = d < 16 ? c16 : (d < 32 ? s16 : 1.f), m2 = d < 16 ? -s16 : (d < 32 ? c16 : 0.f);
            p->qb[(size_t)t * 1024 + lane + 64 * j] = f2bf((q1[j] * m1 + q2[j] * m2) * qscale);
        }
#pragma unroll
        for (int j = 0; j < 4; ++j) {
            const int d = (lane + 64 * j) & 127;
            const float m1 = d < 16 ? c16 : (d < 32 ? s16 : 1.f), m2 = d < 16 ? -s16 : (d < 32 ? c16 : 0.f);
            p->kb[(size_t)t * 256 + lane + 64 * j] = f2bf(k1[j] * m1 + k2[j] * m2);
            p->vb[(size_t)t * 256 + lane + 64 * j] = f2bf(vv[j]);
        }
        {
            const float m1 = lane < 8 ? c8 : (lane < 16 ? s8 : 1.f), m2 = lane < 8 ? -s8 : (lane < 16 ? c8 : 0.f);
#pragma unroll
            for (int j = 0; j < 16; ++j) p->iqb[(size_t)t * 1024 + lane + 64 * j] = f2bf(iq1[j] * m1 + iq2[j] * m2);
            p->ikb[(size_t)t * 64 + lane] = f2bf(ik1 * m1 + ik2 * m2);
        }
        if (lane < 16) p->iwf[t * 16 + lane] = iwv * 0.03125f;
    }
#undef h_
}

struct CS8 { f32x4 c, s; };
struct EpiQa {
    u16* C; const float* ca; const float* sa; int row0, col0;
    __device__ __forceinline__ void operator()(Acc& acc, unsigned char* stg) const {
        const float sc = 0.07216878364870323f * LOG2E_;
        const int rb = row0 + WR0_, cbase = col0 + WC0_;
        const bool rope = (cbase % 192) == 128;
        u16* Cp = C; const float* cap = ca; const float* sap = sa;
        stage_pairs_pre<CS8>(acc, stg,
            [=](int r, int c4) -> CS8 {
                CS8 t; t.c = (f32x4){1.f, 1.f, 1.f, 1.f}; t.s = (f32x4){0.f, 0.f, 0.f, 0.f};
                if (rope) { t.c = *(const f32x4*)(cap + (rb + r) * 32 + c4); t.s = *(const f32x4*)(sap + (rb + r) * 32 + c4); }
                return t; },
            [=](int r, int c4, f32x4 lo, f32x4 hi, CS8 t) {
                const int tt = rb + r;
                const f32x4 a = lo * t.c - hi * t.s, b = lo * t.s + hi * t.c;
                *(u32x2*)(Cp + (size_t)tt * 1536 + cbase + c4) = pack4(a * sc);
                *(u32x2*)(Cp + (size_t)tt * 1536 + cbase + c4 + 32) = pack4(b * sc); });
    }
};
struct EpiKva {
    u16* ka; u16* vaT; int row0, col0;
    __device__ __forceinline__ void operator()(Acc& acc, unsigned char* stg) const {
        const int cbase = col0 + WC0_;
        const int hd = cbase >> 8, within = cbase & 255;
        if (within < 128) {
            const int rb = row0 + WR0_;
            u16* kp = ka + hd * 128 + within;
            stage_rows(acc, stg, [=](int r, int c4, f32x4 v) { *(u32x2*)(kp + (size_t)(rb + r) * 1024 + c4) = pack4(v); });
        } else {
            const int lane = ltid() & 63, fr = lane & 15, fq = lane >> 4;
#pragma unroll
            for (int m = 0; m < 4; ++m) {
                const int r = row0 + WR0_ + m * 16 + fq * 4;
#pragma unroll
                for (int n = 0; n < 4; ++n) {
                    const int c = within - 128 + n * 16 + fr;
                    u32x2 o; o.x = pack2(acc[m][n][0], acc[m][n][1]); o.y = pack2(acc[m][n][2], acc[m][n][3]);
                    *(u32x2*)(vaT + (size_t)(hd * 128 + c) * T_ + r) = o;
                }
            }
        }
    }
};

__device__ __forceinline__ void indexer_tile(KP p, int qt, int kt) {
    const int lane = ltid() & 63, wid = (ltid() >> 6) & 3;
    const int wr = wid >> 1, wc = wid & 1, fr = lane & 15, fq = lane >> 4;
    const int k0 = kt * 128 + wr * 64, q0 = qt * 128 + wc * 64;
    bf16x8 af[4][2];
#pragma unroll
    for (int m = 0; m < 4; ++m)
#pragma unroll
        for (int ks = 0; ks < 2; ++ks)
            af[m][ks] = *(const bf16x8*)(p->ikb + (size_t)(k0 + m * 16 + fr) * 64 + ks * 32 + fq * 8);
    Acc sc; acc_zero(sc);
    for (int h = 0; h < 16; ++h) {
        bf16x8 bq[4][2]; float w[4];
#pragma unroll
        for (int n = 0; n < 4; ++n) {
            const size_t qrow = (size_t)(q0 + n * 16 + fr);
            bq[n][0] = *(const bf16x8*)(p->iqb + qrow * 1024 + h * 64 + fq * 8);
            bq[n][1] = *(const bf16x8*)(p->iqb + qrow * 1024 + h * 64 + 32 + fq * 8);
            w[n] = p->iwf[qrow * 16 + h];
        }
#pragma unroll
        for (int m = 0; m < 4; ++m)
#pragma unroll
            for (int n = 0; n < 4; ++n) {
                f32x4 d = (f32x4){0.f, 0.f, 0.f, 0.f};
                d = __builtin_amdgcn_mfma_f32_16x16x32_bf16(af[m][0], bq[n][0], d, 0, 0, 0);
                d = __builtin_amdgcn_mfma_f32_16x16x32_bf16(af[m][1], bq[n][1], d, 0, 0, 0);
#pragma unroll
                for (int j = 0; j < 4; ++j) sc[m][n][j] += w[n] * fmaxf(d[j], 0.f);
            }
    }
#pragma unroll
    for (int m = 0; m < 4; ++m)
#pragma unroll
        for (int n = 0; n < 4; ++n)
            *(f32x4*)(p->scores + (size_t)(q0 + n * 16 + fr) * T_ + k0 + m * 16 + fq * 4) = sc[m][n];
}

__device__ __forceinline__ void indexer_item(KP p, int g) {
    const int lane = ltid() & 63, wid = __builtin_amdgcn_readfirstlane(ltid() >> 6);
    const int fr = lane & 15, fq = lane >> 4;
    const int q0 = g * 16, nkb = g + 1;
    bf16x8 bq[16][2]; float w[16];
    {
        const u16* qrow = p->iqb + (size_t)(q0 + fr) * 1024 + fq * 8;
#pragma unroll
        for (int h = 0; h < 16; ++h) { bq[h][0] = *(const bf16x8*)(qrow + h * 64); bq[h][1] = *(const bf16x8*)(qrow + h * 64 + 32); }
        const float* wrow = p->iwf + (size_t)(q0 + fr) * 16;
#pragma unroll
        for (int h4 = 0; h4 < 4; ++h4) {
            const f32x4 wv = *(const f32x4*)(wrow + h4 * 4);
#pragma unroll
            for (int j = 0; j < 4; ++j) w[h4 * 4 + j] = wv[j];
        }
    }
    const u16* kbase = p->ikb + (size_t)fr * 64 + fq * 8;
    float* srow = p->scores + (size_t)(q0 + fr) * T_ + 4 * fq;
#define IDX_LOAD(A, kb_) do { const int kc_ = (kb_) < nkb ? (kb_) : nkb - 1; \
        A[0] = *(const bf16x8*)(kbase + (size_t)kc_ * 1024); A[1] = *(const bf16x8*)(kbase + (size_t)kc_ * 1024 + 32); } while (0)
#define IDX_COMP(A, kb_) do { if ((kb_) < nkb) { \
        f32x4 sc_ = (f32x4){0.f, 0.f, 0.f, 0.f}; \
        _Pragma("unroll") for (int h = 0; h < 16; ++h) { \
            f32x4 d_ = (f32x4){0.f, 0.f, 0.f, 0.f}; \
            d_ = __builtin_amdgcn_mfma_f32_16x16x32_bf16(A[0], bq[h][0], d_, 0, 0, 0); \
            d_ = __builtin_amdgcn_mfma_f32_16x16x32_bf16(A[1], bq[h][1], d_, 0, 0, 0); \
            _Pragma("unroll") for (int j = 0; j < 4; ++j) sc_[j] += w[h] * fmaxf(d_[j], 0.f); } \
        *(f32x4*)(srow + (size_t)(kb_) * 16) = sc_; } } while (0)
    bf16x8 a0[2], a1[2], a2[2], a3[2];
    int kb = wid;
    IDX_LOAD(a0, kb); IDX_LOAD(a1, kb + 8); IDX_LOAD(a2, kb + 16); IDX_LOAD(a3, kb + 24);
    for (; kb < nkb; kb += 32) {
        IDX_COMP(a0, kb); IDX_LOAD(a0, kb + 32);
        IDX_COMP(a1, kb + 8); IDX_LOAD(a1, kb + 40);
        IDX_COMP(a2, kb + 16); IDX_LOAD(a2, kb + 48);
        IDX_COMP(a3, kb + 24); IDX_LOAD(a3, kb + 56);
    }
#undef IDX_LOAD
#undef IDX_COMP
}

__device__ __forceinline__ unsigned fkey(float f) {
    const unsigned u = __float_as_uint(f);
    return (u & 0x80000000u) ? ~u : (u | 0x80000000u);
}
#define TOPK_WLDS (1024 * 4 + 1024 * 2)
__device__ __forceinline__ void ph_topk(KP p, unsigned char* smem) {
    const int lane0 = ltid() & 63, wid = ltid() >> 6;
    const int gw = __builtin_amdgcn_readfirstlane((blockIdx.x * NT + ltid()) >> 6), nw = (gridDim.x * NT) >> 6;
    unsigned* ckey = (unsigned*)(smem + wid * TOPK_WLDS);
    u16* cidx = (u16*)(smem + wid * TOPK_WLDS + 4096);
    for (int qq = gw; qq < T_ / 2; qq += nw)
    for (int sside = 0; sside < 2; ++sside) {
        int lane = lane0; asm volatile("" : "+v"(lane));
        const int q = sside ? (T_ - 1 - qq) : qq;
        u16* so = p->sel + (size_t)q * 256;
        if (q < 256) {
#pragma unroll
            for (int i = 0; i < 4; ++i) { const int s = lane + 64 * i; so[s] = (u16)(s <= q ? s : 0); }
            continue;
        }
        const int ng = (q >> 10) + 1;
        unsigned key[128];
        const float* row = p->scores + (size_t)q * T_;
        unsigned gm[4] = {0u, 0u, 0u, 0u};
        const int qml = q - lane;
#pragma unroll
        for (int g = 0; g < 8; ++g) {
            if (g < ng) {
                const float* rg = row + g * 1024 + lane;
#pragma unroll
                for (int i = 0; i < 16; ++i) {
                    const unsigned kx = fkey(rg[64 * i]) & ~(unsigned)((qml - 64 * (g * 16 + i)) >> 31);
                    key[g * 16 + i] = kx;
                    gm[i & 3] = kx > gm[i & 3] ? kx : gm[i & 3];
                }
            } else {
#pragma unroll
                for (int i = 0; i < 16; ++i) key[g * 16 + i] = 0u;
            }
        }
        unsigned Lk = gm[0] < gm[1] ? gm[0] : gm[1], Mk = gm[0] > gm[1] ? gm[0] : gm[1];
        { const unsigned l2 = gm[2] < gm[3] ? gm[2] : gm[3], m2 = gm[2] > gm[3] ? gm[2] : gm[3];
          Lk = Lk < l2 ? Lk : l2; Mk = Mk > m2 ? Mk : m2; }
#pragma unroll
        for (int o = 32; o > 0; o >>= 1) {
            const unsigned lo_ = (unsigned)__shfl_xor((int)Lk, o), mo_ = (unsigned)__shfl_xor((int)Mk, o);
            Lk = Lk < lo_ ? Lk : lo_; Mk = Mk > mo_ ? Mk : mo_;
        }
        Lk = (unsigned)__builtin_amdgcn_readfirstlane((int)Lk); Mk = (unsigned)__builtin_amdgcn_readfirstlane((int)Mk);
        unsigned prefix = 0u;
        int C = q + 1, b = 31;
        bool exact = false;
        if (Lk == Mk) { prefix = Mk; b = -1; }
        else { b = 31 - __builtin_clz(Lk ^ Mk); prefix = Mk & ~((2u << b) - 1u); }
        if (b < 31) {
            int cnt = 0;
#pragma unroll
            for (int g = 0; g < 8; ++g) {
                if (g < ng) {
#pragma unroll
                    for (int i = 0; i < 16; ++i) cnt += __builtin_popcountll(__ballot(key[g * 16 + i] >= prefix));
                }
            }
            C = cnt;
            if (cnt == 256) { exact = true; b = -1; }
        }
        for (; b >= 0 && C > 1024; --b) {
            const unsigned cand = prefix | (1u << b);
            int cnt = 0;
#pragma unroll
            for (int g = 0; g < 8; ++g) {
                if (g < ng) {
#pragma unroll
                    for (int i = 0; i < 16; ++i) cnt += __builtin_popcountll(__ballot(key[g * 16 + i] >= cand));
                }
            }
            if (cnt >= 256) { prefix = cand; C = cnt; }
            if (cnt == 256) { exact = true; --b; break; }
        }
        if (C > 1024) {
            int wp = 0;
#pragma unroll
            for (int g = 0; g < 8; ++g) {
                if (g < ng) {
#pragma unroll
                    for (int i = 0; i < 16; ++i) {
                        const bool gt = key[g * 16 + i] > prefix;
                        const unsigned long long m = __ballot(gt);
                        if (gt) so[wp + (int)__builtin_amdgcn_mbcnt_hi((unsigned)(m >> 32), __builtin_amdgcn_mbcnt_lo((unsigned)m, 0u))] = (u16)(lane + 64 * (g * 16 + i));
                        wp += __builtin_popcountll(m);
                    }
                }
            }
#pragma unroll
            for (int g = 0; g < 8; ++g) {
                if (g < ng && wp < 256) {
#pragma unroll
                    for (int i = 0; i < 16; ++i) {
                        const bool eq = key[g * 16 + i] == prefix && (lane + 64 * (g * 16 + i)) <= q;
                        const unsigned long long m = __ballot(eq);
                        if (eq) {
                            const int pos = wp + (int)__builtin_amdgcn_mbcnt_hi((unsigned)(m >> 32), __builtin_amdgcn_mbcnt_lo((unsigned)m, 0u));
                            if (pos < 256) so[pos] = (u16)(lane + 64 * (g * 16 + i));
                        }
                        wp += __builtin_popcountll(m);
                    }
                }
            }
            continue;
        }
        int base = 0;
#pragma unroll
        for (int g = 0; g < 8; ++g) {
            if (g < ng) {
#pragma unroll
                for (int i = 0; i < 16; ++i) {
                    const bool ge = key[g * 16 + i] >= prefix && (lane + 64 * (g * 16 + i)) <= q;
                    const unsigned long long m = __ballot(ge);
                    if (ge) {
                        const int pos = base + (int)__builtin_amdgcn_mbcnt_hi((unsigned)(m >> 32), __builtin_amdgcn_mbcnt_lo((unsigned)m, 0u));
                        ckey[pos] = key[g * 16 + i]; cidx[pos] = (u16)(lane + 64 * (g * 16 + i));
                    }
                    base += __builtin_popcountll(m);
                }
            }
        }
        __builtin_amdgcn_s_waitcnt(0xc07f);
        unsigned ck[16];
#pragma unroll
        for (int i = 0; i < 16; ++i) {
            const int s = lane + 64 * i;
            ck[i] = s < base ? ckey[s] : 0u;
        }
        if (!exact) {
            for (; b >= 0; --b) {
                const unsigned cand = prefix | (1u << b);
                int cnt = 0;
#pragma unroll
                for (int i = 0; i < 16; ++i) cnt += __builtin_popcountll(__ballot(ck[i] >= cand));
                if (cnt >= 256) prefix = cand;
                if (cnt == 256) break;
            }
        }
        int wpos = 0;
#pragma unroll
        for (int i = 0; i < 16; ++i) {
            const bool gt = ck[i] > prefix;
            const unsigned long long m = __ballot(gt);
            if (gt) so[wpos + (int)__builtin_amdgcn_mbcnt_hi((unsigned)(m >> 32), __builtin_amdgcn_mbcnt_lo((unsigned)m, 0u))] = cidx[lane + 64 * i];
            wpos += __builtin_popcountll(m);
        }
#pragma unroll
        for (int i = 0; i < 16; ++i) {
            if (wpos < 256) {
                const bool eq = ck[i] == prefix && (lane + 64 * i) < base;
                const unsigned long long m = __ballot(eq);
                if (eq) {
                    const int pos = wpos + (int)__builtin_amdgcn_mbcnt_hi((unsigned)(m >> 32), __builtin_amdgcn_mbcnt_lo((unsigned)m, 0u));
                    if (pos < 256) so[pos] = cidx[lane + 64 * i];
                }
                wpos += __builtin_popcountll(m);
            }
        }
        __builtin_amdgcn_s_waitcnt(0xc07f);
    }
}

#define KROW 208
#define VROW 80
#define ATT_LDS_BYTES (64 * KROW * 2 + 128 * VROW * 2)

__device__ __forceinline__ void mla_item(KP p, int h, int qb, u16* lds, int seg) {
    const int tid = ltid(), lane = tid & 63, wid = tid >> 6, fr = lane & 15, fq = lane >> 4;
    u16* sK = lds;
    u16* sV = lds + 64 * KROW;
    const int q0 = qb * 256;
    bf16x8 qf[2][6];
#pragma unroll
    for (int nq = 0; nq < 2; ++nq)
#pragma unroll
        for (int kc = 0; kc < 6; ++kc)
            qf[nq][kc] = *(const bf16x8*)(p->qa + (size_t)(q0 + wid * 32 + nq * 16 + fr) * 1536 + h * 192 + kc * 32 + fq * 8);
    f32x4 O[8][2];
#pragma unroll
    for (int m = 0; m < 8; ++m) { O[m][0] = (f32x4){0.f, 0.f, 0.f, 0.f}; O[m][1] = (f32x4){0.f, 0.f, 0.f, 0.f}; }
    float mrun[2] = {-1e30f, -1e30f}, lrun[2] = {0.f, 0.f};

    const int k0t = tid >> 4, k1t = tid >> 3;
    const u16* kpn = p->ka + (size_t)k0t * 1024 + h * 128 + (tid & 15) * 8;
    const u16* kpr = p->kpe + (size_t)k1t * 64 + (tid & 7) * 8;
    const u16* vpp = p->vaT + (size_t)(h * 128 + k1t) * T_ + (tid & 7) * 8;
    const int kln = (((k0t >> 2) & 1) * 16 + (k0t >> 3) * 4 + (k0t & 3)) * KROW + (tid & 15) * 8;
    const int e1 = k1t & 31;
    const int klr = ((k1t >> 5) * 32 + ((e1 >> 2) & 1) * 16 + (e1 >> 3) * 4 + (e1 & 3)) * KROW + 128 + (tid & 7) * 8;
    const int vl0 = k1t * VROW + (tid & 7) * 8;
    u32x4 kreg[3], vreg[2];
    const int ntiles = 4 * qb + 4;
    const int kt_lo = seg == 1 ? ntiles / 2 : 0, kt_hi = seg == 0 ? ntiles / 2 : ntiles;
#define ATT_GLOAD(kt) do { \
    _Pragma("unroll") for (int i = 0; i < 2; ++i) kreg[i] = *(const u32x4*)(kpn + (size_t)((kt) * 64 + 32 * i) * 1024); \
    kreg[2] = *(const u32x4*)(kpr + (size_t)((kt) * 64) * 64); \
    _Pragma("unroll") for (int i = 0; i < 2; ++i) vreg[i] = *(const u32x4*)(vpp + (size_t)(64 * i) * T_ + (kt) * 64); } while (0)
#define ATT_LWRITE(buf) do { \
        u16* sK_ = lds + (buf) * (ATT_LDS_BYTES / 2); u16* sV_ = sK_ + 64 * KROW; \
        _Pragma("unroll") for (int i = 0; i < 2; ++i) *(u32x4*)(sK_ + kln + 32 * i * KROW) = kreg[i]; \
        *(u32x4*)(sK_ + klr) = kreg[2]; \
        _Pragma("unroll") for (int i = 0; i < 2; ++i) *(u32x4*)(sV_ + vl0 + 64 * i * VROW) = vreg[i]; } while (0)
    ATT_GLOAD(kt_lo);
    __syncthreads();
    ATT_LWRITE(0);
    if (kt_lo + 1 < kt_hi) ATT_GLOAD(kt_lo + 1);
    __syncthreads();
    for (int kt = kt_lo; kt < kt_hi; ++kt) {
        const int cb = (kt - kt_lo) & 1;
        sK = lds + cb * (ATT_LDS_BYTES / 2);
        sV = sK + 64 * KROW;
        if (kt * 64 > q0 + wid * 32 + 31) {
            if (kt + 1 < kt_hi) ATT_LWRITE(cb ^ 1);
            if (kt + 2 < kt_hi) ATT_GLOAD(kt + 2);
            __syncthreads(); continue;
        }
        f32x4 s[2][4];
#pragma unroll
        for (int n = 0; n < 4; ++n) { s[0][n] = (f32x4){0.f, 0.f, 0.f, 0.f}; s[1][n] = (f32x4){0.f, 0.f, 0.f, 0.f}; }
#pragma unroll
        for (int kc = 0; kc < 6; ++kc)
#pragma unroll
            for (int n = 0; n < 4; ++n) {
                const bf16x8 a = *(const bf16x8*)(sK + (n * 16 + fr) * KROW + kc * 32 + fq * 8);
                s[0][n] = __builtin_amdgcn_mfma_f32_16x16x32_bf16(a, qf[0][kc], s[0][n], 0, 0, 0);
                s[1][n] = __builtin_amdgcn_mfma_f32_16x16x32_bf16(a, qf[1][kc], s[1][n], 0, 0, 0);
            }
        if (kt + 1 < kt_hi) ATT_LWRITE(cb ^ 1);
        if (kt + 2 < kt_hi) ATT_GLOAD(kt + 2);
        if (kt >= ntiles - 4) {
#pragma unroll
            for (int nq = 0; nq < 2; ++nq) {
                const int qi = q0 + wid * 32 + nq * 16 + fr;
#pragma unroll
                for (int n = 0; n < 4; ++n)
#pragma unroll
                    for (int j = 0; j < 4; ++j) {
                        const int ki = kt * 64 + (n >> 1) * 32 + fq * 8 + (n & 1) * 4 + j;
                        if (ki > qi) s[nq][n][j] = -1e30f;
                    }
            }
        }
        bf16x8 pf[2][2];
#pragma unroll
        for (int nq = 0; nq < 2; ++nq) {
            float mx = -1e30f;
#pragma unroll
            for (int n = 0; n < 4; ++n)
#pragma unroll
                for (int j = 0; j < 4; ++j) mx = fmaxf(mx, s[nq][n][j]);
            mx = fmaxf(mx, __shfl_xor(mx, 16));
            mx = fmaxf(mx, __shfl_xor(mx, 32));
            const float mnew = fmaxf(mrun[nq], mx);
            const float al = __builtin_amdgcn_exp2f(mrun[nq] - mnew);
            mrun[nq] = mnew;
            float ps = 0.f;
#pragma unroll
            for (int n = 0; n < 4; ++n)
#pragma unroll
                for (int j = 0; j < 4; ++j) { const float e = __builtin_amdgcn_exp2f(s[nq][n][j] - mnew); s[nq][n][j] = e; ps += e; }
            lrun[nq] = lrun[nq] * al + ps;
            if (__ballot(al != 1.0f) != 0ull) {
#pragma unroll
                for (int m = 0; m < 8; ++m) O[m][nq] *= al;
            }
#pragma unroll
            for (int c = 0; c < 2; ++c) {
                u32x4 w;
                w.x = pack2(s[nq][2 * c][0], s[nq][2 * c][1]);
                w.y = pack2(s[nq][2 * c][2], s[nq][2 * c][3]);
                w.z = pack2(s[nq][2 * c + 1][0], s[nq][2 * c + 1][1]);
                w.w = pack2(s[nq][2 * c + 1][2], s[nq][2 * c + 1][3]);
                pf[nq][c] = *(bf16x8*)&w;
            }
        }
#pragma unroll
        for (int m = 0; m < 8; ++m)
#pragma unroll
            for (int c = 0; c < 2; ++c) {
                const bf16x8 a = *(const bf16x8*)(sV + (m * 16 + fr) * VROW + c * 32 + fq * 8);
                O[m][0] = __builtin_amdgcn_mfma_f32_16x16x32_bf16(a, pf[0][c], O[m][0], 0, 0, 0);
                O[m][1] = __builtin_amdgcn_mfma_f32_16x16x32_bf16(a, pf[1][c], O[m][1], 0, 0, 0);
            }
        __syncthreads();
    }
#undef ATT_GLOAD
#undef ATT_LWRITE
#pragma unroll
    for (int nq = 0; nq < 2; ++nq) {
        float l = lrun[nq];
        l += __shfl_xor(l, 16);
        l += __shfl_xor(l, 32);
        const int qi = q0 + wid * 32 + nq * 16 + fr;
        if (seg < 0) {
            const float il = 1.f / l;
#pragma unroll
            for (int m = 0; m < 8; ++m) {
                u32x2 o;
                o.x = pack2(O[m][nq][0] * il, O[m][nq][1] * il);
                o.y = pack2(O[m][nq][2] * il, O[m][nq][3] * il);
                *(u32x2*)(p->outcat + (size_t)qi * 2048 + h * 128 + m * 16 + fq * 4) = o;
            }
        } else {
            const size_t slot = (size_t)((h * 16 + (qb - 16)) * 2 + seg);
            float* po = p->mla_po + (slot * 256 + (qi - q0)) * 128;
#pragma unroll
            for (int m = 0; m < 8; ++m) *(f32x4*)(po + m * 16 + fq * 4) = O[m][nq];
            if (fq == 0) { p->mla_ml[(slot * 256 + (qi - q0)) * 2] = mrun[nq]; p->mla_ml[(slot * 256 + (qi - q0)) * 2 + 1] = l; }
        }
    }
}

__device__ __forceinline__ void ph_mla_merge(KP p) {
    const int gtid = blockIdx.x * NT + ltid(), gsz = gridDim.x * NT;
    for (int i = gtid; i < 128 * 256 * 32; i += gsz) {
        const int d4 = i & 31, qq = (i >> 5) & 255, item = i >> 13;
        const int h = item >> 4, qb = 16 + (item & 15);
        const size_t s0 = (size_t)(item * 2) * 256 + qq, s1 = s0 + 256;
        const float m0 = p->mla_ml[s0 * 2], l0 = p->mla_ml[s0 * 2 + 1], m1 = p->mla_ml[s1 * 2], l1 = p->mla_ml[s1 * 2 + 1];
        const float m = fmaxf(m0, m1);
        const float w0 = __builtin_amdgcn_exp2f(m0 - m), w1 = __builtin_amdgcn_exp2f(m1 - m);
        const float il = 1.f / (l0 * w0 + l1 * w1);
        const f32x4 a = *(const f32x4*)(p->mla_po + s0 * 128 + d4 * 4), b = *(const f32x4*)(p->mla_po + s1 * 128 + d4 * 4);
        const f32x4 o = (a * w0 + b * w1) * il;
        *(u32x2*)(p->outcat + (size_t)(qb * 256 + qq) * 2048 + h * 128 + d4 * 4) = pack4(o);
    }
}

#define DSA_WLDS 5632
__device__ __forceinline__ void dsa_task(KP p, int q, int g, unsigned char* wl) {
    const int lane = ltid() & 63;
    u16* sQ = (u16*)wl;
    float* sP = (float*)(wl + 1024);
    u16* sS = (u16*)(wl + 1024 + 4096);
    const int nsel = q < 255 ? q + 1 : 256;
    {
        const u16* qsrc = p->qb + (size_t)q * 1024 + g * 512;
        *(u32x4*)(sQ + lane * 8) = *(const u32x4*)(qsrc + lane * 8);
        *(u32x2*)(sS + lane * 4) = *(const u32x2*)(p->sel + (size_t)q * 256 + lane * 4);
    }
    __builtin_amdgcn_s_waitcnt(0);
    float sc[4][4];
    float mx[4] = {-1e30f, -1e30f, -1e30f, -1e30f};
#pragma unroll
    for (int r = 0; r < 4; ++r) {
        const int slot = lane + 64 * r;
        float a0 = 0.f, a1 = 0.f, a2 = 0.f, a3 = 0.f;
        if (slot < nsel) {
            const int ki = sS[slot];
            const u16* kr = p->kb + (size_t)ki * 256 + g * 128;
#pragma unroll
            for (int c = 0; c < 16; ++c) {
                const u32x4 kv = *(const u32x4*)(kr + c * 8);
                const u32x4 q0v = *(const u32x4*)(sQ + 0 * 128 + c * 8);
                const u32x4 q1v = *(const u32x4*)(sQ + 1 * 128 + c * 8);
                const u32x4 q2v = *(const u32x4*)(sQ + 2 * 128 + c * 8);
                const u32x4 q3v = *(const u32x4*)(sQ + 3 * 128 + c * 8);
#pragma unroll
                for (int e = 0; e < 4; ++e) {
                    const unsigned kk = kv[e];
                    const bf16x2_t kb2 = *(const bf16x2_t*)&kk;
                    unsigned t0 = q0v[e], t1 = q1v[e], t2 = q2v[e], t3 = q3v[e];
                    a0 = __builtin_amdgcn_fdot2_f32_bf16(kb2, *(const bf16x2_t*)&t0, a0, false);
                    a1 = __builtin_amdgcn_fdot2_f32_bf16(kb2, *(const bf16x2_t*)&t1, a1, false);
                    a2 = __builtin_amdgcn_fdot2_f32_bf16(kb2, *(const bf16x2_t*)&t2, a2, false);
                    a3 = __builtin_amdgcn_fdot2_f32_bf16(kb2, *(const bf16x2_t*)&t3, a3, false);
                }
            }
        } else { a0 = a1 = a2 = a3 = -1e30f; }
        sc[r][0] = a0; sc[r][1] = a1; sc[r][2] = a2; sc[r][3] = a3;
        mx[0] = fmaxf(mx[0], a0); mx[1] = fmaxf(mx[1], a1); mx[2] = fmaxf(mx[2], a2); mx[3] = fmaxf(mx[3], a3);
    }
    float ls[4];
#pragma unroll
    for (int hh = 0; hh < 4; ++hh) {
        const float m = wave_max(mx[hh]);
        float s = 0.f;
#pragma unroll
        for (int r = 0; r < 4; ++r) { const float e = exp2f(sc[r][hh] - m); sc[r][hh] = e; s += e; }
        ls[hh] = wave_sum(s);
    }
#pragma unroll
    for (int r = 0; r < 4; ++r) {
        f32x4 pv = {sc[r][0], sc[r][1], sc[r][2], sc[r][3]};
        *(f32x4*)(sP + (lane + 64 * r) * 4) = pv;
    }
    __builtin_amdgcn_s_waitcnt(0);
    float o[4][8];
#pragma unroll
    for (int hh = 0; hh < 4; ++hh)
#pragma unroll
        for (int d = 0; d < 8; ++d) o[hh][d] = 0.f;
    const int kg = lane >> 4, dc = lane & 15;
    const u16* vbase = p->vb + g * 128 + dc * 8;
    const int nit = (nsel + 3) >> 2;
    for (int it = 0; it < nit; it += 4) {
        u32x4 vv[4]; f32x4 pp[4];
#pragma unroll
        for (int u = 0; u < 4; ++u) {
            if (it + u < nit) {
                const int slot = (it + u) * 4 + kg;
                const int ki = sS[slot];
                vv[u] = *(const u32x4*)(vbase + (size_t)ki * 256);
                pp[u] = *(const f32x4*)(sP + slot * 4);
            } else { vv[u] = (u32x4){0u, 0u, 0u, 0u}; pp[u] = (f32x4){0.f, 0.f, 0.f, 0.f}; }
        }
#pragma unroll
        for (int u = 0; u < 4; ++u)
#pragma unroll
            for (int e = 0; e < 4; ++e) {
                const float v0 = __uint_as_float(vv[u][e] << 16), v1 = __uint_as_float(vv[u][e] & 0xffff0000u);
#pragma unroll
                for (int hh = 0; hh < 4; ++hh) { o[hh][2 * e] += pp[u][hh] * v0; o[hh][2 * e + 1] += pp[u][hh] * v1; }
            }
    }
#pragma unroll
    for (int hh = 0; hh < 4; ++hh)
#pragma unroll
        for (int d = 0; d < 8; ++d) {
            float v = o[hh][d];
            v += __shfl_xor(v, 16);
            v += __shfl_xor(v, 32);
            o[hh][d] = v;
        }
    if (kg == 0) {
#pragma unroll
        for (int hh = 0; hh < 4; ++hh) {
            const float il = 1.f / ls[hh];
            u32x4 w;
            w.x = pack2(o[hh][0] * il, o[hh][1] * il); w.y = pack2(o[hh][2] * il, o[hh][3] * il);
            w.z = pack2(o[hh][4] * il, o[hh][5] * il); w.w = pack2(o[hh][6] * il, o[hh][7] * il);
            *(u32x4*)(p->outcat + (size_t)q * 2048 + 1024 + (g * 4 + hh) * 128 + dc * 8) = w;
        }
    }
    __builtin_amdgcn_s_waitcnt(0);
}

#define DSA2_WLDS (8192 + 512)
__device__ __forceinline__ void dsa_task2(KP p, int q, unsigned char* wl, u16* outp, int ldo, int coff) {
    const int lane = ltid() & 63, fr = lane & 15, fq = lane >> 4;
    unsigned char* sV = wl;
    u16* sS = (u16*)(wl + 8192);
    const int nsel = q < 255 ? q + 1 : 256;
    *(u32x2*)(sS + lane * 4) = *(const u32x2*)(p->sel + (size_t)q * 256 + lane * 4);
    const int vch = lane & 15, vr0 = lane >> 4;
    int rdo[2];
#pragma unroll
    for (int t = 0; t < 2; ++t) rdo[t] = (8 * fq + 4 * t + (fr >> 2)) * 256 + 8 * (fr & 1);
    const int xr0 = ((fr >> 2) << 2) | ((2 * fq) & 3), xr1 = ((fr >> 2) << 2) | ((2 * fq + 1) & 3);
    const int hsel = (fr & 3) >> 1;
    __builtin_amdgcn_s_waitcnt(0);
#pragma unroll 1
    for (int g = 0; g < 2; ++g) {
        bf16x8 qf[4];
#pragma unroll
        for (int c = 0; c < 4; ++c) {
            u32x4 v = (u32x4){0u, 0u, 0u, 0u};
            if (fr < 4) v = *(const u32x4*)(p->qb + (size_t)q * 1024 + (g * 4 + fr) * 128 + c * 32 + fq * 8);
            qf[c] = *(bf16x8*)&v;
        }
        f32x4 O[8];
#pragma unroll
        for (int cc = 0; cc < 8; ++cc) O[cc] = (f32x4){0.f, 0.f, 0.f, 0.f};
        float mrun = -1e30f, lrun = 0.f;
        const int nstep = (nsel + 31) >> 5;
        bf16x8 fa0[4], fb0[4], fa1[4], fb1[4];
        u32x4 vv0[8], vv1[8];
#define DSA_LOAD(c, FA, FB, VV) do { \
            const int ka_ = sS[32 * (c) + fr], kb_ = sS[32 * (c) + 16 + fr]; \
            const u16* kra = p->kb + (size_t)ka_ * 256 + g * 128 + fq * 8; \
            const u16* krb = p->kb + (size_t)kb_ * 256 + g * 128 + fq * 8; \
            _Pragma("unroll") for (int cc = 0; cc < 4; ++cc) { FA[cc] = *(const bf16x8*)(kra + cc * 32); FB[cc] = *(const bf16x8*)(krb + cc * 32); } \
            _Pragma("unroll") for (int i = 0; i < 8; ++i) { \
                const int r = vr0 + 4 * i; \
                const int kv = sS[32 * (c) + 16 * ((r >> 2) & 1) + 4 * (r >> 3) + (r & 3)]; \
                VV[i] = *(const u32x4*)(p->vb + (size_t)kv * 256 + g * 128 + vch * 8); } } while (0)
#define DSA_COMP(c, FA, FB, VV) do { \
            f32x4 s0 = (f32x4){0.f, 0.f, 0.f, 0.f}, s1 = (f32x4){0.f, 0.f, 0.f, 0.f}; \
            _Pragma("unroll") for (int cc = 0; cc < 4; ++cc) { \
                s0 = __builtin_amdgcn_mfma_f32_16x16x32_bf16(FA[cc], qf[cc], s0, 0, 0, 0); \
                s1 = __builtin_amdgcn_mfma_f32_16x16x32_bf16(FB[cc], qf[cc], s1, 0, 0, 0); } \
            float mx = -1e30f; \
            _Pragma("unroll") for (int j = 0; j < 4; ++j) { \
                if (32 * (c) + 4 * fq + j >= nsel) s0[j] = -1e30f; \
                if (32 * (c) + 16 + 4 * fq + j >= nsel) s1[j] = -1e30f; \
                mx = fmaxf(mx, fmaxf(s0[j], s1[j])); } \
            mx = fmaxf(mx, __shfl_xor(mx, 16)); \
            mx = fmaxf(mx, __shfl_xor(mx, 32)); \
            const float mnew = fmaxf(mrun, mx); \
            const float al = __builtin_amdgcn_exp2f(mrun - mnew); \
            mrun = mnew; \
            float ps = 0.f; \
            _Pragma("unroll") for (int j = 0; j < 4; ++j) { \
                s0[j] = __builtin_amdgcn_exp2f(s0[j] - mnew); s1[j] = __builtin_amdgcn_exp2f(s1[j] - mnew); \
                ps += s0[j] + s1[j]; } \
            lrun = lrun * al + ps; \
            if (__ballot(al != 1.0f) != 0ull) { _Pragma("unroll") for (int cc = 0; cc < 8; ++cc) O[cc] *= al; } \
            u32x4 pw; \
            pw.x = pack2(s0[0], s0[1]); pw.y = pack2(s0[2], s0[3]); pw.z = pack2(s1[0], s1[1]); pw.w = pack2(s1[2], s1[3]); \
            const bf16x8 pf = *(bf16x8*)&pw; \
            _Pragma("unroll") for (int i = 0; i < 8; ++i) { \
                const int r = vr0 + 4 * i; \
                *(u32x4*)(sV + r * 256 + 16 * (vch ^ (((r & 3) << 2) | ((r >> 2) & 3)))) = VV[i]; } \
            __builtin_amdgcn_s_waitcnt(0xc07f); \
            _Pragma("unroll") for (int cc = 0; cc < 8; ++cc) { \
                const s16x4 lo_ = __builtin_amdgcn_ds_read_tr16_b64_v4i16((LAS s16x4*)(sV + rdo[0] + 16 * ((2 * cc + hsel) ^ xr0))); \
                const s16x4 hi_ = __builtin_amdgcn_ds_read_tr16_b64_v4i16((LAS s16x4*)(sV + rdo[1] + 16 * ((2 * cc + hsel) ^ xr1))); \
                const bf16x8 vf = __builtin_shufflevector(lo_, hi_, 0, 1, 2, 3, 4, 5, 6, 7); \
                O[cc] = __builtin_amdgcn_mfma_f32_16x16x32_bf16(vf, pf, O[cc], 0, 0, 0); } \
            __builtin_amdgcn_s_waitcnt(0xc07f); } while (0)
        DSA_LOAD(0, fa0, fb0, vv0);
#pragma unroll 1
        for (int c = 0; c < nstep; c += 2) {
            if (c + 1 < nstep) DSA_LOAD(c + 1, fa1, fb1, vv1);
            DSA_COMP(c, fa0, fb0, vv0);
            if (c + 1 < nstep) {
                if (c + 2 < nstep) DSA_LOAD(c + 2, fa0, fb0, vv0);
                DSA_COMP(c + 1, fa1, fb1, vv1);
            }
        }
#undef DSA_LOAD
#undef DSA_COMP
        float l = lrun;
        l += __shfl_xor(l, 16);
        l += __shfl_xor(l, 32);
        if (fr < 4) {
            const float il = 1.f / l;
            u16* dst = outp + (size_t)q * ldo + coff + (g * 4 + fr) * 128 + 4 * fq;
#pragma unroll
            for (int cc = 0; cc < 8; ++cc) {
                u32x2 w; w.x = pack2(O[cc][0] * il, O[cc][1] * il); w.y = pack2(O[cc][2] * il, O[cc][3] * il);
                *(u32x2*)(dst + 16 * cc) = w;
            }
        }
    }
    __builtin_amdgcn_s_waitcnt(0);
}

#define ATT_NMLA 384
#define CVT_CHUNK (256 * 1024)
#define CVT_N_OUT0 16
#define CVT_N_IN1 96
#define CVT_N_OUT1 32
#define CVT_N_SH 8
#define ATT_NCVT (CVT_N_OUT0 + CVT_N_IN1 + CVT_N_OUT1 + 6 * CVT_N_SH)
template <int RMAP = 0>
__device__ __forceinline__ void cvtT_block(const float* src, u16* dst, int K, int N, int kb, int nb, unsigned char* smem) {
    const int tid = ltid();
    u16* t = (u16*)smem;
    __syncthreads();
#pragma unroll
    for (int i = 0; i < 8; ++i) {
        const int k = (tid >> 6) + 8 * i, n4 = (tid & 63) * 4;
        f32x4 v = (f32x4){0.f, 0.f, 0.f, 0.f};
        if (nb * 256 + n4 < N) v = *(const f32x4*)(src + (size_t)(kb * 64 + k) * N + nb * 256 + n4);
#pragma unroll
        for (int e = 0; e < 4; ++e) t[(n4 + e) * 72 + k] = f2bf(v[e]);
    }
    __syncthreads();
#pragma unroll
    for (int i = 0; i < 4; ++i) {
        const int n = (tid >> 3) + 64 * i, ch = tid & 7;
        const int drow = RMAP == 0 ? nb * 256 + n : 512 * nb + (n >> 7) * 256 + 128 * (RMAP - 1) + (n & 127);
        *(u32x4*)(dst + (size_t)drow * K + kb * 64 + ch * 8) = *(const u32x4*)(t + n * 72 + ch * 8);
    }
}
#define CVT_NT_OUT1 (64 * 8)
#define CVT_NT_OUT0 (32 * 8)
#define CVT_NT_IN1 (32 * 48)
#define CVT_NT_SHGU (32 * 4)
#define CVT_NT_SHD (16 * 8)
#define CVT_NT_SH (2 * CVT_NT_SHGU + CVT_NT_SHD)
__device__ __forceinline__ void cvt_item(KP p, int c, unsigned char* smem) {
    if (c >= ATT_NCVT) {
        int u = c - ATT_NCVT;
        if (u < CVT_NT_OUT1) { cvtT_block(p->w_out1, p->w_out1t, 4096, 2048, u >> 3, u & 7, smem); return; }
        u -= CVT_NT_OUT1;
        if (u < CVT_NT_OUT0) { cvtT_block(p->w_out0, p->w_out0t, 2048, 2048, u >> 3, u & 7, smem); return; }
        u -= CVT_NT_OUT0;
        if (u < CVT_NT_IN1) { cvtT_block(p->w_in1, p->w_in1t, 2048, IN_C, u / 48, u % 48, smem); return; }
        u -= CVT_NT_IN1;
        const int l = u / CVT_NT_SH; u -= l * CVT_NT_SH;
        if (u < CVT_NT_SHGU) { cvtT_block<1>(p->sh_g[l], p->sh_gut[l], 2048, 1024, u >> 2, u & 3, smem); return; }
        u -= CVT_NT_SHGU;
        if (u < CVT_NT_SHGU) { cvtT_block<2>(p->sh_u[l], p->sh_gut[l], 2048, 1024, u >> 2, u & 3, smem); return; }
        u -= CVT_NT_SHGU;
        cvtT_block(p->sh_d[l], p->sh_dt[l], 1024, 2048, u >> 3, u & 7, smem); return;
    }
    const float* src; u16* dst;
    if (c < CVT_N_OUT0) { return; }
    else if ((c -= CVT_N_OUT0) < CVT_N_IN1) { return; }
    else if ((c -= CVT_N_IN1) < CVT_N_OUT1) { return; }
    else {
        return;
        c -= CVT_N_OUT1;
        const int which = c / CVT_N_SH; c -= which * CVT_N_SH;
        const int l = which / 3, m = which % 3;
        src = m == 0 ? p->sh_g[l] : (m == 1 ? p->sh_u[l] : p->sh_d[l]);
        dst = m == 0 ? p->sh_gb[l] : (m == 1 ? p->sh_ub[l] : p->sh_db[l]);
    }
    const size_t base = (size_t)c * CVT_CHUNK;
    for (int i = ltid(); i < CVT_CHUNK / 8; i += NT) {
        const f32x4 a = *(const f32x4*)(src + base + (size_t)i * 8), b = *(const f32x4*)(src + base + (size_t)i * 8 + 4);
        u32x4 o; o.x = pack2(a[0], a[1]); o.y = pack2(a[2], a[3]); o.z = pack2(b[0], b[1]); o.w = pack2(b[2], b[3]);
        *(u32x4*)(dst + base + (size_t)i * 8) = o;
    }
}
__device__ const unsigned char mla_order[48] = {31, 63, 79, 30, 62, 29, 61, 78, 28, 60, 27, 59, 77, 26, 58, 25, 57, 76, 24, 56, 23, 55, 75, 22, 54, 21, 53, 74, 20, 52, 19, 51, 73, 18, 50, 17, 49, 72, 16, 48, 71, 70, 69, 68, 67, 66, 65, 64};
#define ATT_NTOTAL (ATT_NMLA + 512 + ATT_NCVT + CVT_NT_OUT1 + CVT_NT_OUT0 + CVT_NT_IN1 + 2 * CVT_NT_SH)
__device__ __forceinline__ void ph_attn(KP p, unsigned char* smem, unsigned* misc, int qword = CTL_QUEUE, int lo = 0, int hi = ATT_NTOTAL) {
    const int tid = ltid(), wid = tid >> 6;
    for (;;) {
        __syncthreads();
        if (tid == 0) misc[0] = atomicAdd(&p->ctl[qword], 1u);
        __syncthreads();
        const int it = (int)misc[0] + lo;
        if (it >= hi) break;
        if (it < ATT_NMLA) {
            const int e = mla_order[it >> 3];
            const int sg = e >> 5;
            mla_item(p, it & 7, e & 31, (u16*)smem, sg == 2 ? -1 : sg);
        } else if (it >= ATT_NMLA + 512) {
            cvt_item(p, it - ATT_NMLA - 512, smem);
        } else {
            const int base = (it - ATT_NMLA) * 16;
#ifdef DSA_VALU
            for (int k = 0; k < 4; ++k) {
                const int task = wid * 4 + k;
                dsa_task(p, base + (task >> 1), task & 1, smem + wid * DSA_WLDS);
            }
#else
            for (int k = 0; k < 2; ++k) dsa_task2(p, base + wid * 2 + k, smem + wid * DSA2_WLDS, p->outcat, 2048, 1024);
#endif
        }
    }
}
__device__ __forceinline__ float ret_log2g(int h);

struct PgEpiResid {
    static constexpr bool PERM = true, AFTER_DRAIN = false;
    u16* C; const u16* X; int ldc;
    __device__ __forceinline__ void operator()(const pg8::f32x4 (&acc)[2][2][4][2], const pg8::Unit& u, int wr, int wc, int fr, int fq) const {
        const int row0 = u.pm * 256 + wr * 64 + fr, col0 = u.pn * 256 + wc * 32 + 8 * fq;
#pragma unroll
        for (int ai = 0; ai < 2; ++ai) {
            u32x4 xv[4][2];
#pragma unroll
            for (int m = 0; m < 4; ++m)
#pragma unroll
                for (int bj = 0; bj < 2; ++bj) xv[m][bj] = *(const u32x4*)(X + (size_t)(row0 + ai * 128 + m * 16) * ldc + col0 + bj * 128);
#pragma unroll
            for (int m = 0; m < 4; ++m)
#pragma unroll
                for (int bj = 0; bj < 2; ++bj) {
                    const pg8::f32x4 v0 = acc[ai][bj][m][0], v1 = acc[ai][bj][m][1];
                    const u32x4 x = xv[m][bj];
                    u32x4 w;
                    w.x = pack2(__uint_as_float(x.x << 16) * ALPHA_ + v0[0], __uint_as_float(x.x & 0xffff0000u) * ALPHA_ + v0[1]);
                    w.y = pack2(__uint_as_float(x.y << 16) * ALPHA_ + v0[2], __uint_as_float(x.y & 0xffff0000u) * ALPHA_ + v0[3]);
                    w.z = pack2(__uint_as_float(x.z << 16) * ALPHA_ + v1[0], __uint_as_float(x.z & 0xffff0000u) * ALPHA_ + v1[1]);
                    w.w = pack2(__uint_as_float(x.w << 16) * ALPHA_ + v1[2], __uint_as_float(x.w & 0xffff0000u) * ALPHA_ + v1[3]);
                    *(u32x4*)(C + (size_t)(row0 + ai * 128 + m * 16) * ldc + col0 + bj * 128) = w;
                }
        }
    }
};

struct PgEpiResidF {
    static constexpr bool PERM = true, AFTER_DRAIN = false;
    u16* C; const float* X; int ldc;
    __device__ __forceinline__ void operator()(const pg8::f32x4 (&acc)[2][2][4][2], const pg8::Unit& u, int wr, int wc, int fr, int fq) const {
        const int row0 = u.pm * 256 + wr * 64 + fr, col0 = u.pn * 256 + wc * 32 + 8 * fq;
#pragma unroll
        for (int ai = 0; ai < 2; ++ai)
#pragma unroll
            for (int m = 0; m < 4; ++m) {
                f32x4 xv[2][2];
#pragma unroll
                for (int bj = 0; bj < 2; ++bj) {
                    const float* xp = X + (size_t)(row0 + ai * 128 + m * 16) * ldc + col0 + bj * 128;
                    xv[bj][0] = *(const f32x4*)xp; xv[bj][1] = *(const f32x4*)(xp + 4);
                }
#pragma unroll
                for (int bj = 0; bj < 2; ++bj) {
                    const f32x4 a = xv[bj][0] * ALPHA_ + acc[ai][bj][m][0], b = xv[bj][1] * ALPHA_ + acc[ai][bj][m][1];
                    u32x4 w; w.x = pack2(a[0], a[1]); w.y = pack2(a[2], a[3]); w.z = pack2(b[0], b[1]); w.w = pack2(b[2], b[3]);
                    *(u32x4*)(C + (size_t)(row0 + ai * 128 + m * 16) * ldc + col0 + bj * 128) = w;
                }
                asm volatile("" ::: "memory");
            }
    }
};
struct PgEpiL1 {
    static constexpr bool PERM = true, AFTER_DRAIN = false;
    KP p;
    __device__ __forceinline__ void operator()(const pg8::f32x4 (&acc)[2][2][4][2], const pg8::Unit& u, int wr, int wc, int fr, int fq) const {
        const int row0 = u.pm * 256 + wr * 64 + fr, ci = wc * 32 + 8 * fq;
        const int pn = u.pn;
        if (pn < 16) {
            const bool isk = pn >= 8; const int hd = pn & 7;
            const float l2g = ret_log2g(hd);
            const float* cR = p->cosR; const float* sR = p->sinR;
#pragma unroll
            for (int ai = 0; ai < 2; ++ai)
#pragma unroll
                for (int m = 0; m < 4; ++m) {
                    const int t = row0 + ai * 128 + m * 16;
                    const float dec = isk ? exp2f((float)(127 - (t & 127)) * l2g) : exp2f((float)((t & 127) + 1) * l2g);
                    f32x4 lo[2], hi[2];
#pragma unroll
                    for (int n = 0; n < 2; ++n) {
                        const f32x4 c = *(const f32x4*)(cR + t * 128 + ci + 4 * n), s = *(const f32x4*)(sR + t * 128 + ci + 4 * n);
                        const f32x4 x1 = acc[ai][0][m][n], x2 = acc[ai][1][m][n];
                        lo[n] = x1 * c - x2 * s; hi[n] = x1 * s + x2 * c;
                        if (isk) { lo[n] *= 0.0625f; hi[n] *= 0.0625f; }
                    }
                    const size_t o = (size_t)t * 2048 + hd * 256 + ci;
                    u16* d0 = isk ? p->kr : p->qr; u16* d1 = isk ? p->kz : p->qx;
                    u32x4 w;
                    w.x = pack2(lo[0][0], lo[0][1]); w.y = pack2(lo[0][2], lo[0][3]); w.z = pack2(lo[1][0], lo[1][1]); w.w = pack2(lo[1][2], lo[1][3]);
                    *(u32x4*)(d0 + o) = w;
                    w.x = pack2(hi[0][0], hi[0][1]); w.y = pack2(hi[0][2], hi[0][3]); w.z = pack2(hi[1][0], hi[1][1]); w.w = pack2(hi[1][2], hi[1][3]);
                    *(u32x4*)(d0 + o + 128) = w;
                    lo[0] *= dec; lo[1] *= dec; hi[0] *= dec; hi[1] *= dec;
                    w.x = pack2(lo[0][0], lo[0][1]); w.y = pack2(lo[0][2], lo[0][3]); w.z = pack2(lo[1][0], lo[1][1]); w.w = pack2(lo[1][2], lo[1][3]);
                    *(u32x4*)(d1 + o) = w;
                    w.x = pack2(hi[0][0], hi[0][1]); w.y = pack2(hi[0][2], hi[0][3]); w.z = pack2(hi[1][0], hi[1][1]); w.w = pack2(hi[1][2], hi[1][3]);
                    *(u32x4*)(d1 + o + 128) = w;
                    asm volatile("" ::: "memory");
                }
        } else {
            const bool isg = pn >= 32;
            u16* dst = isg ? p->sg : p->v1;
            const int cbase = (isg ? pn - 32 : pn - 16) * 256 + ci;
#pragma unroll
            for (int ai = 0; ai < 2; ++ai)
#pragma unroll
                for (int m = 0; m < 4; ++m)
#pragma unroll
                    for (int bj = 0; bj < 2; ++bj) {
                        f32x4 a = acc[ai][bj][m][0], b = acc[ai][bj][m][1];
                        if (isg) {
#pragma unroll
                            for (int e = 0; e < 4; ++e) { a[e] = silu_f(a[e]); b[e] = silu_f(b[e]); }
                        }
                        u32x4 w; w.x = pack2(a[0], a[1]); w.y = pack2(a[2], a[3]); w.z = pack2(b[0], b[1]); w.w = pack2(b[2], b[3]);
                        *(u32x4*)(dst + (size_t)(row0 + ai * 128 + m * 16) * 4096 + cbase + bj * 128) = w;
                    }
        }
    }
};

struct PgEpiBf16N {
    static constexpr bool PERM = true, AFTER_DRAIN = false;
    u16* C; int ldc; int ncols;
    __device__ __forceinline__ void operator()(const pg8::f32x4 (&acc)[2][2][4][2], const pg8::Unit& u, int wr, int wc, int fr, int fq) const {
        const int row0 = u.pm * 256 + wr * 64 + fr, col0 = u.pn * 256 + wc * 32 + 8 * fq;
#pragma unroll
        for (int ai = 0; ai < 2; ++ai)
#pragma unroll
            for (int m = 0; m < 4; ++m)
#pragma unroll
                for (int bj = 0; bj < 2; ++bj) {
                    const int c = col0 + bj * 128;
                    if (c < ncols) {
                        const pg8::f32x4 a = acc[ai][bj][m][0], b = acc[ai][bj][m][1];
                        u32x4 w; w.x = pack2(a[0], a[1]); w.y = pack2(a[2], a[3]); w.z = pack2(b[0], b[1]); w.w = pack2(b[2], b[3]);
                        *(u32x4*)(C + (size_t)(row0 + ai * 128 + m * 16) * ldc + c) = w;
                    }
                }
    }
};
struct PgEpiSwiglu {
    static constexpr bool PERM = true, AFTER_DRAIN = false;
    u16* C; int ldc;
    __device__ __forceinline__ void operator()(const pg8::f32x4 (&acc)[2][2][4][2], const pg8::Unit& u, int wr, int wc, int fr, int fq) const {
        const int row0 = u.pm * 256 + wr * 64 + fr, col0 = u.pn * 128 + wc * 32 + 8 * fq;
#pragma unroll
        for (int ai = 0; ai < 2; ++ai)
#pragma unroll
            for (int m = 0; m < 4; ++m) {
                const pg8::f32x4 g0 = acc[ai][0][m][0], g1 = acc[ai][0][m][1], u0 = acc[ai][1][m][0], u1 = acc[ai][1][m][1];
                float o[8];
#pragma unroll
                for (int e = 0; e < 4; ++e) { o[e] = silu_f(g0[e]) * u0[e]; o[4 + e] = silu_f(g1[e]) * u1[e]; }
                u32x4 w; w.x = pack2(o[0], o[1]); w.y = pack2(o[2], o[3]); w.z = pack2(o[4], o[5]); w.w = pack2(o[6], o[7]);
                *(u32x4*)(C + (size_t)(row0 + ai * 128 + m * 16) * ldc + col0) = w;
            }
    }
};
template <bool ADD_ROUTED, bool ROUTE, bool WRITE_B, bool WRITE_F>
__device__ __forceinline__ void ph_ln(KP p, const u16* Y, const float* g, const float* b, float* XF, u16* XB, u16* XL) {
    const int lane = ltid() & 63;
    const int gw = (blockIdx.x * NT + ltid()) >> 6, nw = (gridDim.x * NT) >> 6;
    f32x4 gg[8], bb[8];
#pragma unroll
    for (int j = 0; j < 8; ++j) { gg[j] = *(const f32x4*)(g + j * 256 + lane * 4); bb[j] = *(const f32x4*)(b + j * 256 + lane * 4); }
    for (int t0 = gw; t0 < T_; t0 += 2 * nw) {
        u32x2 raw[2][8], r0raw[2][8], r1raw[2][8];
#pragma unroll
        for (int rr = 0; rr < 2; ++rr) {
            const int t = t0 + rr * nw < T_ ? t0 + rr * nw : t0;
            const u16* y = Y + (size_t)t * D_;
#pragma unroll
            for (int j = 0; j < 8; ++j) raw[rr][j] = *(const u32x2*)(y + j * 256 + lane * 4);
            if constexpr (ADD_ROUTED) {
                const u16* r0 = p->yr + (size_t)(2 * t) * D_;
                const u16* r1 = r0 + D_;
#pragma unroll
                for (int j = 0; j < 8; ++j) { r0raw[rr][j] = *(const u32x2*)(r0 + j * 256 + lane * 4); r1raw[rr][j] = *(const u32x2*)(r1 + j * 256 + lane * 4); }
            }
        }
#pragma unroll
        for (int rr = 0; rr < 2; ++rr) {
            const int t = t0 + rr * nw;
            if (t >= T_) break;
            float v[32];
            float sum = 0.f;
#pragma unroll
            for (int j = 0; j < 8; ++j) {
                const u32x2 a = raw[rr][j];
                v[4 * j] = __uint_as_float(a.x << 16); v[4 * j + 1] = __uint_as_float(a.x & 0xffff0000u);
                v[4 * j + 2] = __uint_as_float(a.y << 16); v[4 * j + 3] = __uint_as_float(a.y & 0xffff0000u);
            }
            if constexpr (ADD_ROUTED) {
#pragma unroll
                for (int j = 0; j < 8; ++j) {
                    const u32x2 a = r0raw[rr][j], c = r1raw[rr][j];
                    v[4 * j]     += __uint_as_float(a.x << 16) + __uint_as_float(c.x << 16);
                    v[4 * j + 1] += __uint_as_float(a.x & 0xffff0000u) + __uint_as_float(c.x & 0xffff0000u);
                    v[4 * j + 2] += __uint_as_float(a.y << 16) + __uint_as_float(c.y << 16);
                    v[4 * j + 3] += __uint_as_float(a.y & 0xffff0000u) + __uint_as_float(c.y & 0xffff0000u);
                }
            }
#pragma unroll
            for (int i = 0; i < 32; ++i) sum += v[i];
            const float mu = wave_sum(sum) * (1.f / 2048.f);
            float var = 0.f;
#pragma unroll
            for (int i = 0; i < 32; ++i) { const float d = v[i] - mu; var += d * d; }
            var = wave_sum(var) * (1.f / 2048.f);
            const float rs = rsqrtf(var + 1e-5f);
#pragma unroll
            for (int j = 0; j < 8; ++j) {
                const int c = j * 256 + lane * 4;
                f32x4 o;
#pragma unroll
                for (int e = 0; e < 4; ++e) o[e] = (v[4 * j + e] - mu) * rs * gg[j][e] + bb[j][e];
                if constexpr (WRITE_F) *(f32x4*)(XF + (size_t)t * D_ + c) = o;
                if constexpr (WRITE_B) {
                    u32x2 w; w.x = pack2(o[0], o[1]); w.y = pack2(o[2], o[3]);
                    *(u32x2*)(XB + (size_t)t * D_ + c) = w;
                    if constexpr (ROUTE) {
                        u32x2 wl;
                        wl.x = pack2(o[0] - __uint_as_float(w.x << 16), o[1] - __uint_as_float(w.x & 0xffff0000u));
                        wl.y = pack2(o[2] - __uint_as_float(w.y << 16), o[3] - __uint_as_float(w.y & 0xffff0000u));
                        *(u32x2*)(XL + (size_t)t * D_ + c) = wl;
                    }
                }
            }
        }
    }
}

__device__ __forceinline__ void route_token(KP p, int t, float logit, int lane, unsigned* cnt, int* list) {
    const float sc = 1.f / (1.f + __expf(-logit));
    const float bi = sc + p->router_b[lane];
    float m1 = bi;
    m1 = fmaxf(m1, __shfl_xor(m1, 1)); m1 = fmaxf(m1, __shfl_xor(m1, 2)); m1 = fmaxf(m1, __shfl_xor(m1, 4));
    const int seg = lane >> 3;
    unsigned long long bal = __ballot(bi == m1);
    const int f1 = __builtin_ctz((unsigned)((bal >> (seg * 8)) & 0xffull));
    const float b2 = ((lane & 7) == f1) ? -1e30f : bi;
    float m2 = b2;
    m2 = fmaxf(m2, __shfl_xor(m2, 1)); m2 = fmaxf(m2, __shfl_xor(m2, 2)); m2 = fmaxf(m2, __shfl_xor(m2, 4));
    bal = __ballot(b2 == m2);
    const int f2 = __builtin_ctz((unsigned)((bal >> (seg * 8)) & 0xffull));
    const float gs = m1 + m2;
    float gm = gs;
    gm = fmaxf(gm, __shfl_xor(gm, 8)); gm = fmaxf(gm, __shfl_xor(gm, 16)); gm = fmaxf(gm, __shfl_xor(gm, 32));
    bal = __ballot(gs == gm);
    const int gsel = (int)(__builtin_ctzll(bal) >> 3);
    const int e0 = gsel * 8 + __shfl(f1, gsel * 8);
    const int e1 = gsel * 8 + __shfl(f2, gsel * 8);
    const float s0 = __shfl(sc, e0), s1 = __shfl(sc, e1);
    if (lane == 0) {
        const float inv = 1.f / (s0 + s1);
        const unsigned p0 = atomicAdd(&cnt[e0 * CNT_STRIDE], 1u);
        const unsigned p1 = atomicAdd(&cnt[e1 * CNT_STRIDE], 1u);
        list[e0 * T_ + p0] = 2 * t;
        list[e1 * T_ + p1] = 2 * t + 1;
        p->tok_g[2 * t] = s0 * inv;
        p->tok_g[2 * t + 1] = s1 * inv;
    }
}

__device__ __forceinline__ void ph_router(KP p, unsigned char* smem, unsigned* cnt, int* list) {
    const int tid = ltid(), lane = tid & 63, wid = tid >> 6, grp = wid >> 2, kq = wid & 3, fr = lane & 15, fq = lane >> 4;
    float* part = (float*)smem;
    for (int blk = blockIdx.x; blk < T_ / 32; blk += gridDim.x) {
        const int t0 = blk * 32 + grp * 16;
        f32x4 acc[4];
#pragma unroll
        for (int c = 0; c < 4; ++c) acc[c] = (f32x4){0.f, 0.f, 0.f, 0.f};
        const u16* ah = p->xab + (size_t)(t0 + fr) * D_ + kq * 512 + fq * 8;
        const u16* al = p->xlb + (size_t)(t0 + fr) * D_ + kq * 512 + fq * 8;
        const u16* bh = p->whT + (size_t)fr * D_ + kq * 512 + fq * 8;
        const u16* bl = p->wlT + (size_t)fr * D_ + kq * 512 + fq * 8;
#pragma unroll 2
        for (int s = 0; s < 16; ++s) {
            const bf16x8 xh = *(const bf16x8*)(ah + 32 * s), xl = *(const bf16x8*)(al + 32 * s);
#pragma unroll
            for (int c = 0; c < 4; ++c) {
                const bf16x8 wh = *(const bf16x8*)(bh + (size_t)c * 16 * D_ + 32 * s);
                const bf16x8 wl = *(const bf16x8*)(bl + (size_t)c * 16 * D_ + 32 * s);
                acc[c] = __builtin_amdgcn_mfma_f32_16x16x32_bf16(xh, wh, acc[c], 0, 0, 0);
                acc[c] = __builtin_amdgcn_mfma_f32_16x16x32_bf16(xh, wl, acc[c], 0, 0, 0);
                acc[c] = __builtin_amdgcn_mfma_f32_16x16x32_bf16(xl, wh, acc[c], 0, 0, 0);
            }
        }
        float* mine = part + (grp * 4 + kq) * 1024;
#pragma unroll
        for (int c = 0; c < 4; ++c)
#pragma unroll
            for (int j = 0; j < 4; ++j) mine[(4 * fq + j) * 64 + 16 * c + fr] = acc[c][j];
        __syncthreads();
#pragma unroll
        for (int tt = 0; tt < 4; ++tt) {
            const int tok = 4 * kq + tt;
            const float* q = part + (grp * 4) * 1024 + tok * 64 + lane;
            const float logit = (q[0] + q[1024]) + (q[2048] + q[3072]);
            route_token(p, t0 + tok, logit, lane, cnt, list);
        }
        __syncthreads();
    }
}

struct ColGateUp16 { int c0; const u16* up;
    __device__ __forceinline__ const u16* base16(const u16* B, int hsel) const { return hsel ? up : B; }
    __device__ __forceinline__ unsigned off8(int hsel, int ch8) const { return (unsigned)(c0 + ch8 * 8); }
    __device__ __forceinline__ int vchunk(int hsel, int ch8) const { const int r = ch8 * 8; return ((r >> 5) * 64 + hsel * 32 + (r & 31)) >> 3; } };
struct ColGateUp { int c0; const float* up;
    __device__ __forceinline__ const float* base(const float* B, int hsel) const { return hsel ? up : B; }
    __device__ __forceinline__ unsigned off4(int hsel, int g4) const { return (unsigned)(c0 + g4 * 4); }
    __device__ __forceinline__ int vcol4(int hsel, int g4) const { const int r = g4 * 4; return (r >> 5) * 64 + hsel * 32 + (r & 31); } };
struct RowList { const int* lst; int m0, n; __device__ __forceinline__ int operator()(int r) const { const int i = m0 + r; return lst[i < n ? i : n - 1] >> 1; } };
struct EpiSwiglu {
    u16* C; int ldc; int row0, c0, nrows;
    __device__ __forceinline__ void operator()(Acc& acc, unsigned char* stg) const {
        const int wr0 = WR0_, cb = c0 + (WC0_ >> 1);
        u16* Cp = C; const int ld = ldc, rbase = row0, nr = nrows;
        stage_pairs(acc, stg, [=](int r, int c4, f32x4 g, f32x4 u) {
            const int rr = wr0 + r;
            if (rr < nr) {
                f32x4 o;
#pragma unroll
                for (int e = 0; e < 4; ++e) o[e] = silu_f(g[e]) * u[e];
                *(u32x2*)(Cp + (size_t)(rbase + rr) * ld + cb + c4) = pack4(o);
            }
        });
    }
};
struct SlotGate { int slot; float g; };
struct EpiDownRouted {
    u16* yr; const int* lst; const float* tg; int m0, n, col0;
    __device__ __forceinline__ void operator()(Acc& acc, unsigned char* stg) const {
        const int wr0 = WR0_, cb = col0 + WC0_;
        u16* yp = yr; const int* lp = lst; const float* tgp = tg; const int mm0 = m0, nn = n;
        stage_rows_pre<SlotGate>(acc, stg,
            [=](int r, int c4) -> SlotGate {
                const int i = mm0 + wr0 + r;
                const int s_ = lp[i < nn ? i : nn - 1];
                SlotGate sg; sg.g = tgp[s_]; sg.slot = i < nn ? s_ : -1;
                return sg; },
            [=](int r, int c4, f32x4 v, SlotGate sg) {
                if (sg.slot >= 0) *(u32x2*)(yp + (size_t)sg.slot * D_ + cb + c4) = pack4(v * sg.g); });
    }
};

struct RowH { int base, mx; __device__ __forceinline__ int operator()(int r) const { const int i = base + r; return i < mx ? i : mx; } };
__device__ __forceinline__ void moe_prefix(const unsigned* cnt, int* s_tp, int* s_off) {
    __syncthreads();
    if (ltid() == 0) {
        int tp = 0, off = 0;
        for (int e = 0; e < 64; ++e) {
            const int n = (int)__hip_atomic_load(&cnt[e * CNT_STRIDE], __ATOMIC_RELAXED, __HIP_MEMORY_SCOPE_AGENT);
            s_tp[e] = tp; s_off[e] = off;
            tp += (n + 255) >> 8; off += n;
        }
        s_tp[64] = tp; s_off[64] = off;
    }
    __syncthreads();
}

struct RowGen { const int* lst; int m0, n, base; __device__ __forceinline__ int operator()(int r) const {
    const int i = m0 + r; return lst[i < n ? i : n - 1] >> 1; } };

template <int L>
__device__ __forceinline__ void ph_moe_up(KP p, const u16* X, unsigned char* smem, int* s_tp, int* s_off) {
    u16* lds = (u16*)smem;
    const unsigned* cnt = p->ctl + (L == 0 ? CTL_CNT0 : CTL_CNT1);
    moe_prefix(cnt, s_tp, s_off);
    {
        __syncthreads();
        pg8::Gemm g; g.A = X; g.Bt = p->sh_gut[L]; g.M = T_; g.N = 2048; g.K = D_;
        pg8::StaticOrder S; S.init(T_, 2048, (int)gridDim.x, (int)blockIdx.x);
        pg8::gemm_phase<PgEpiSwiglu, pg8::StaticOrder>((PG8_LAS unsigned char*)smem, g, S, PgEpiSwiglu{p->hsh, 1024}, nullptr);
        __syncthreads();
    }
    const int nrt = s_tp[64] * 8;
    const int nsh = 0;
            for (int t = blockIdx.x; t < nrt + nsh; t += gridDim.x) {
        Acc acc; acc_zero(acc);
        if (t < nrt) {
            const int mtile = t >> 3, nt = t & 7;
            int e = 0;
            for (int s = 32; s > 0; s >>= 1) if (e + s < 64 && s_tp[e + s] <= mtile) e += s;
            const int n = s_off[e + 1] - s_off[e], m0 = (mtile - s_tp[e]) * 256;
            gemm_accum<B_F32_KN, false>(acc, X, D_, RowGen{p->list + e * T_, m0, n, 0}, p->moe_wg[L] + (size_t)e * D_ * 512, 512,
                                        ColGateUp{nt * 64, p->moe_wu[L] + (size_t)e * D_ * 512}, D_, lds);
            EpiSwiglu{p->hbuf, 512, s_off[e] + m0, nt * 64, n - m0}(acc, smem);
        } else {
            const int u = t - nrt, mt = u >> 4, nt = u & 15;
            gemm_accum<B_BF16_KN, false>(acc, X, D_, RowId{mt * 256}, p->sh_gb[L], 1024, ColGateUp16{nt * 64, p->sh_ub[L]}, D_, lds);
            EpiSwiglu{p->hsh, 1024, mt * 256, nt * 64, 256}(acc, smem);
        }
    }
}

template <int L>
__device__ __forceinline__ void ph_moe_down(KP p, const u16* XBres, unsigned char* smem, int* s_tp, int* s_off) {
    u16* lds = (u16*)smem;
    const unsigned* cnt = p->ctl + (L == 0 ? CTL_CNT0 : CTL_CNT1);
    moe_prefix(cnt, s_tp, s_off);
    {
        __syncthreads();
        pg8::Gemm g; g.A = p->hsh; g.Bt = p->sh_dt[L]; g.M = T_; g.N = D_; g.K = 1024;
        pg8::StaticOrder S; S.init(T_, D_, (int)gridDim.x, (int)blockIdx.x);
        pg8::gemm_phase<PgEpiResid, pg8::StaticOrder>((PG8_LAS unsigned char*)smem, g, S, PgEpiResid{p->y2, XBres, D_}, nullptr);
        __syncthreads();
    }
    const int nrt = s_tp[64] * 16, nsh = 0;
    for (int t = blockIdx.x; t < nrt + nsh; t += gridDim.x) {
        Acc acc; acc_zero(acc);
        if (t < nrt) {
            const int mtile = t >> 4, nt = t & 15;
            int e = 0;
            for (int s = 32; s > 0; s >>= 1) if (e + s < 64 && s_tp[e + s] <= mtile) e += s;
            const int n = s_off[e + 1] - s_off[e], m0 = (mtile - s_tp[e]) * 256;
            gemm_accum<B_F32_KN, false>(acc, p->hbuf, 512, RowH{s_off[e] + m0, 2 * T_ - 1}, p->moe_wd[L] + (size_t)e * 512 * D_, D_, ColOff{nt * 128}, 512, lds);
            EpiDownRouted{p->yr, p->list + e * T_, p->tok_g, m0, n, nt * 128}(acc, smem);
        } else {
            const int u = t - nrt, mt = u >> 4, nt = u & 15;
            gemm_accum<B_BF16_KN, false>(acc, p->hsh, 1024, RowId{mt * 256}, p->sh_db[L], D_, ColOff{nt * 128}, 1024, lds);
            EpiResid<true>{p->y2, XBres, D_, mt * 256, nt * 128}(acc, smem);
        }
    }
}
struct ColRot { int cbase; bool rot;
    __device__ __forceinline__ const u16* base16(const u16* B, int) const { return B; }
    __device__ __forceinline__ unsigned off8(int hsel, int ch8) const { const int v = hsel * 64 + ch8 * 8; const int s = v >> 6, u = v & 63;
        return rot ? (unsigned)(cbase + s * 32 + (u < 32 ? u : 128 + (u - 32))) : (unsigned)(cbase + v); }
    __device__ __forceinline__ int vchunk(int hsel, int ch8) const { return hsel * 8 + ch8; }
    __device__ __forceinline__ const float* base(const float* B, int) const { return B; }
    __device__ __forceinline__ unsigned off4(int hsel, int g4) const { const int v = hsel * 64 + g4 * 4; const int s = v >> 6, u = v & 63;
        return rot ? (unsigned)(cbase + s * 32 + (u < 32 ? u : 128 + (u - 32))) : (unsigned)(cbase + v); }
    __device__ __forceinline__ int vcol4(int hsel, int g4) const { return hsel * 64 + g4 * 4; } };

__device__ __forceinline__ float ret_log2g(int h) { return log1pf(-exp2f(-5.f - (float)h)) * LOG2E_; }

struct EpiRetQK {
    KP p; int row0; int hd; int tp; bool isk;
    __device__ __forceinline__ void operator()(Acc& acc, unsigned char* stg) const {
        const float l2g = ret_log2g(hd);
        const int wc0 = WC0_, rb = row0 + WR0_;
        const int dbase = tp * 64 + (wc0 >> 1);
        const float* cR = p->cosR; const float* sR = p->sinR;
        const int hoff = hd * 256 + dbase;
        if (!isk) {
            u16* qr = p->qr; u16* qx = p->qx;
            stage_pairs_pre<CS8>(acc, stg,
              [=](int r, int c4) -> CS8 { CS8 t; t.c = *(const f32x4*)(cR + (rb + r) * 128 + dbase + c4); t.s = *(const f32x4*)(sR + (rb + r) * 128 + dbase + c4); return t; },
              [=](int r, int c4, f32x4 x1, f32x4 x2, CS8 cs) {
                const int t = rb + r;
                const f32x4 c = cs.c, s = cs.s;
                const f32x4 lo = x1 * c - x2 * s, hi = x1 * s + x2 * c;
                const float xi = exp2f((float)((t & 127) + 1) * l2g);
                const size_t o = (size_t)t * 2048 + hoff + c4;
                *(u32x2*)(qr + o) = pack4(lo); *(u32x2*)(qr + o + 128) = pack4(hi);
                *(u32x2*)(qx + o) = pack4(lo * xi); *(u32x2*)(qx + o + 128) = pack4(hi * xi);
            });
        } else {
            const int lane = ltid() & 63, fr = lane & 15, fq = lane >> 4;
#pragma unroll
            for (int m = 0; m < 4; ++m) {
                const int r0 = rb + m * 16 + fq * 4;
#pragma unroll
                for (int n = 0; n < 2; ++n) {
                    const int i = dbase + n * 16 + fr;
                    float zl[4], zh[4];
#pragma unroll
                    for (int j = 0; j < 4; ++j) {
                        const int t = r0 + j;
                        const float c = cR[t * 128 + i], s = sR[t * 128 + i];
                        const float x1 = acc[m][n][j], x2 = acc[m][n + 2][j];
                        const float ze = exp2f((float)(127 - (t & 127)) * l2g) * 0.0625f;
                        zl[j] = (x1 * c - x2 * s) * ze; zh[j] = (x1 * s + x2 * c) * ze;
                    }
                    u32x2 a, b;
                    a.x = pack2(zl[0], zl[1]); a.y = pack2(zl[2], zl[3]);
                    b.x = pack2(zh[0], zh[1]); b.y = pack2(zh[2], zh[3]);
                    *(u32x2*)(p->kzT + (size_t)(hd * 256 + i) * T_ + r0) = a;
                    *(u32x2*)(p->kzT + (size_t)(hd * 256 + i + 128) * T_ + r0) = b;
                }
            }
            u16* kr = p->kr;
            stage_pairs_pre<CS8>(acc, stg,
              [=](int r, int c4) -> CS8 { CS8 t; t.c = *(const f32x4*)(cR + (rb + r) * 128 + dbase + c4); t.s = *(const f32x4*)(sR + (rb + r) * 128 + dbase + c4); return t; },
              [=](int r, int c4, f32x4 x1, f32x4 x2, CS8 cs) {
                const int t = rb + r;
                const f32x4 c = cs.c, s = cs.s;
                const f32x4 lo = (x1 * c - x2 * s) * 0.0625f, hi = (x1 * s + x2 * c) * 0.0625f;
                const size_t o = (size_t)t * 2048 + hoff + c4;
                *(u32x2*)(kr + o) = pack4(lo); *(u32x2*)(kr + o + 128) = pack4(hi);
            });
        }
    }
};
struct EpiRetV {
    u16* vT; int row0, col0;
    __device__ __forceinline__ void operator()(Acc& acc, unsigned char* stg) const {
        const int lane = ltid() & 63, fr = lane & 15, fq = lane >> 4, wr0 = WR0_, wc0 = WC0_;
#pragma unroll
        for (int m = 0; m < 4; ++m) {
            const int r0 = row0 + wr0 + m * 16 + fq * 4;
#pragma unroll
            for (int n = 0; n < 4; ++n) {
                u32x2 o; o.x = pack2(acc[m][n][0], acc[m][n][1]); o.y = pack2(acc[m][n][2], acc[m][n][3]);
                *(u32x2*)(vT + (size_t)(col0 + wc0 + n * 16 + fr) * T_ + r0) = o;
            }
        }
    }
};
struct EpiSilu {
    u16* C; int ldc; int row0, col0;
    __device__ __forceinline__ void operator()(Acc& acc, unsigned char* stg) const {
        const int rb = row0 + WR0_, cb = col0 + WC0_;
        u16* Cp = C; const int ld = ldc;
        stage_rows(acc, stg, [=](int r, int c4, f32x4 v) {
            f32x4 o;
#pragma unroll
            for (int e = 0; e < 4; ++e) o[e] = silu_f(v[e]);
            *(u32x2*)(Cp + (size_t)(rb + r) * ld + cb + c4) = pack4(o);
        });
    }
};
struct EpiInner {
    u16* C; int hd;
    __device__ __forceinline__ void operator()(Acc& acc, unsigned char* stg) const {
        const float l2g = ret_log2g(hd);
        const int wr0 = WR0_, wc0 = WC0_;
        u16* Cp = C;
        stage_rows(acc, stg, [=](int r, int c4, f32x4 v) {
            const int i = wr0 + r;
            f32x4 o;
#pragma unroll
            for (int e = 0; e < 4; ++e) { const int k = wc0 + c4 + e; o[e] = i >= k ? v[e] * exp2f((float)(i - k) * l2g) : 0.f; }
            *(u32x2*)(Cp + i * 128 + wc0 + c4) = pack4(o);
        });
    }
};


__device__ __forceinline__ void ph_ret_a(KP p, u16* lds) {
    const int nkv = 8 * 64 * 4, nin = 8 * 64;
    for (int t = blockIdx.x; t < nkv + nin; t += gridDim.x) {
        Acc acc; acc_zero(acc);
        if (t < nkv) {
            const int hc = t >> 2, nt = t & 3, hd = hc >> 6, c = hc & 63;
            gemm_kk128(acc, p->kz + (size_t)(c * 128) * 2048 + hd * 256, 2048, p->v1 + (size_t)(c * 128) * 4096 + hd * 512 + nt * 128, 4096, lds);
            EpiBF16{p->KVt + (size_t)hc * 512 * 256, 512, 0, nt * 128}(acc, (unsigned char*)lds);
        } else {
            const int hc = t - nkv, hd = hc >> 6, c = hc & 63;
            gemm_accum<B_BF16_NK, true>(acc, p->qr + hd * 256, 2048, RowId{c * 128}, p->kr + hd * 256, 2048, RowId{c * 128}, 256, lds);
            if (ksplit_reduce(acc, lds)) EpiInner{p->innerG + (size_t)hc * 128 * 128, hd}(acc, (unsigned char*)lds + 65536);
        }
    }
}
__device__ __forceinline__ void ph_ret_b(KP p) {
    const int gtid = blockIdx.x * NT + ltid(), gsz = gridDim.x * NT;
    for (int e = gtid; e < 8 * 512 * 256 / 8; e += gsz) {
        const int hd = e / (512 * 256 / 8);
        const int within = e - hd * (512 * 256 / 8);
        const float g128 = exp2f(128.f * ret_log2g(hd));
        u16* base = p->KVt + (size_t)hd * 64 * 512 * 256 + (size_t)within * 8;
        float r[8];
#pragma unroll
        for (int i = 0; i < 8; ++i) r[i] = 0.f;
#pragma unroll 4
        for (int c = 0; c < 64; ++c) {
            u32x4* ptr = (u32x4*)(base + (size_t)c * 512 * 256);
            const u32x4 in = *ptr;
            u32x4 o;
            o.x = pack2(r[0], r[1]); o.y = pack2(r[2], r[3]); o.z = pack2(r[4], r[5]); o.w = pack2(r[6], r[7]);
            *ptr = o;
#pragma unroll
            for (int i = 0; i < 4; ++i) {
                r[2 * i] = r[2 * i] * g128 + __uint_as_float(in[i] << 16);
                r[2 * i + 1] = r[2 * i + 1] * g128 + __uint_as_float(in[i] & 0xffff0000u);
            }
        }
    }
}
__device__ __forceinline__ void ph_ret_c(KP p, u16* lds) {
    for (int t = blockIdx.x; t < 8 * 64 * 4; t += gridDim.x) {
        const int hc = t >> 2, nt = t & 3, hd = hc >> 6, c = hc & 63;
        Acc acc; acc_zero(acc);
        gemm_accum<B_BF16_KN, true>(acc, p->innerG + (size_t)hc * 128 * 128, 128, RowId{0}, p->v1 + (size_t)(c * 128) * 4096, 4096, ColOff{hd * 512 + nt * 128}, 128, lds);
        gemm_accum<B_BF16_KN, true>(acc, p->qx + hd * 256, 2048, RowId{c * 128}, p->KVt + (size_t)hc * 512 * 256, 512, ColOff{nt * 128}, 256, lds);
        if (ksplit_reduce(acc, lds)) EpiBF16{p->obuf, 4096, c * 128, hd * 512 + nt * 128}(acc, (unsigned char*)lds + 65536);
    }
}
__device__ __forceinline__ void ph_gn(KP p) {
    const int lane = ltid() & 63;
    const int gw = (blockIdx.x * NT + ltid()) >> 6, nw = (gridDim.x * NT) >> 6;
    for (int r = gw; r < T_ * 8; r += nw) {
        const int hd = r & 7;
        const size_t off = (size_t)(r >> 3) * 4096 + hd * 512 + lane * 8;
        const u32x4 in = *(const u32x4*)(p->obuf + off);
        float v[8];
#pragma unroll
        for (int i = 0; i < 4; ++i) { v[2 * i] = __uint_as_float(in[i] << 16); v[2 * i + 1] = __uint_as_float(in[i] & 0xffff0000u); }
        float s = 0.f;
#pragma unroll
        for (int i = 0; i < 8; ++i) s += v[i];
        const float mu = wave_sum(s) * (1.f / 512.f);
        float var = 0.f;
#pragma unroll
        for (int i = 0; i < 8; ++i) { const float d = v[i] - mu; var += d * d; }
        var = wave_sum(var) * (1.f / 512.f);
        const float rs = rsqrtf(var + 1e-5f);
        const u32x4 gin = *(const u32x4*)(p->sg + off);
        const float* gg = p->gn_g + hd * 512 + lane * 8;
        const float* gb = p->gn_b + hd * 512 + lane * 8;
        float o[8];
#pragma unroll
        for (int i = 0; i < 8; ++i) {
            const float sgv = (i & 1) ? __uint_as_float(gin[i >> 1] & 0xffff0000u) : __uint_as_float(gin[i >> 1] << 16);
            o[i] = ((v[i] - mu) * rs * gg[i] + gb[i]) * sgv;
        }
        u32x4 w; w.x = pack2(o[0], o[1]); w.y = pack2(o[2], o[3]); w.z = pack2(o[4], o[5]); w.w = pack2(o[6], o[7]);
        *(u32x4*)(p->gated + off) = w;
    }
}

#define MAXLDS_(a, b) ((a) > (b) ? (a) : (b))
#define PHASE_LDS MAXLDS_(MAXLDS_(MAXLDS_(GEMM_LDS_BYTES, 2 * ATT_LDS_BYTES), 8 * 8192), 131072)
#define LDS_TOTAL (PHASE_LDS + 16 + 16 + 65 * 4 * 2 + 8)

__global__ void __launch_bounds__(NT, 2) mega(Params kparams) {
    extern __shared__ __attribute__((aligned(16))) unsigned char smem[];
    u16* lds = (u16*)smem;
    uint4* xbw = (uint4*)(smem + PHASE_LDS);
    unsigned* misc = (unsigned*)(smem + PHASE_LDS + 16);
    int* s_tp = (int*)(smem + PHASE_LDS + 32);
    int* s_off = s_tp + 65;
    if (threadIdx.x == 0) *xbw = make_uint4(0u, 0u, 0u, 0u);
    __syncthreads();
    XcdBarrier bar = xcd_barrier_post(getp()->bar, (volatile LAS unsigned*)xbw);

    ph_prep(getp());
    {
        KP p = getp();
        for (int u = blockIdx.x; u < 32 * 14; u += gridDim.x) cvtT_block(p->w_in0, p->w_in0t, 2048, IN_AB, u / 14, u % 14, smem);
    }
    xcd_barrier(bar);
    {
        KP p = getp();
        __syncthreads();
        pg8::Gemm g; g.A = p->xb; g.Bt = p->w_in0t; g.M = T_; g.N = 3584; g.K = D_;
        pg8::StaticOrder S; S.init(T_, 3584, (int)gridDim.x, (int)blockIdx.x);
        pg8::gemm_phase<PgEpiBf16N, pg8::StaticOrder>((PG8_LAS unsigned char*)smem, g, S, PgEpiBf16N{p->H0, IN_AB, IN_AB}, nullptr);
        __syncthreads();
    }
    xcd_barrier(bar);
    ph_post0(getp());
    xcd_barrier(bar);
    {
        KP p = getp();
        const int ntm = T_ / BM;
        const int n1 = ntm * 12, n2 = ntm * 16, n3 = T_ / 16;
        for (;;) {
            __syncthreads();
            if (threadIdx.x == 0) misc[0] = atomicAdd(&p->ctl[CTL_QUEUE + 2], 1u);
            __syncthreads();
            const int it = (int)misc[0];
            if (it >= n1 + n2 + n3) break;
            if (it >= n3) {
                const int t = it - n3;
                const bool isq = t < n1;
                const int u = isq ? t : t - n1, nt = u / ntm, mt = u % ntm;
                Acc acc; acc_zero(acc);
                gemm_accum<B_BF16_KN, false>(acc, isq ? p->cqn : p->ckvn, isq ? 512 : 256, RowId{mt * BM}, isq ? p->w_uqb : p->w_ukvb,
                                     isq ? 1536 : 2048, ColOff{nt * BN}, isq ? 512 : 256, lds);
                if (isq) EpiQa{p->qa, p->cosA, p->sinA, mt * BM, nt * BN}(acc, smem);
                else EpiKva{p->ka, p->vaT, mt * BM, nt * BN}(acc, smem);
            } else {
                indexer_item(p, n3 - 1 - it);
            }
        }
    }
    xcd_barrier(bar);
    ph_topk(getp(), smem);
    xcd_barrier(bar);
    ph_attn(getp(), smem, misc);
    xcd_barrier(bar);
    ph_mla_merge(getp());
    xcd_barrier(bar);
    {
        KP p = getp();
        __syncthreads();
        pg8::Gemm g; g.A = p->outcat; g.Bt = p->w_out0t; g.M = T_; g.N = D_; g.K = D_;
        pg8::StaticOrder S; S.init(T_, D_, (int)gridDim.x, (int)blockIdx.x);
        pg8::gemm_phase<PgEpiResidF, pg8::StaticOrder>((PG8_LAS unsigned char*)smem, g, S, PgEpiResidF{p->ybuf, p->x, D_}, nullptr);
        __syncthreads();
    }
    xcd_barrier(bar);
    { KP p = getp(); ph_ln<false, true, true, false>(p, p->ybuf, p->ln_mix_g[0], p->ln_mix_b[0], nullptr, p->xab, p->xlb); }
    xcd_barrier(bar);
    { KP p = getp(); ph_router(p, smem, p->ctl + CTL_CNT0, p->list); }
    xcd_barrier(bar);
    { KP p = getp(); ph_moe_up<0>(p, p->xab, smem, s_tp, s_off); }
    xcd_barrier(bar);
    { KP p = getp(); ph_moe_down<0>(p, p->xab, smem, s_tp, s_off); }
    xcd_barrier(bar);
    { KP p = getp(); ph_ln<true, false, true, false>(p, p->y2, p->ln_ffn_g[0], p->ln_ffn_b[0], nullptr, p->xcb, nullptr); }
    xcd_barrier(bar);
    {
        KP p = getp();
        __syncthreads();
        pg8::Gemm g; g.A = p->xcb; g.Bt = p->w_in1t; g.M = T_; g.N = IN_C; g.K = D_;
        pg8::StaticOrder S; S.init(T_, IN_C, (int)gridDim.x, (int)blockIdx.x);
        pg8::gemm_phase<PgEpiL1, pg8::StaticOrder>((PG8_LAS unsigned char*)smem, g, S, PgEpiL1{p}, nullptr);
        __syncthreads();
    }
    xcd_barrier(bar);
    ph_ret_a(getp(), lds);
    xcd_barrier(bar);
    ph_ret_b(getp());
    xcd_barrier(bar);
    ph_ret_c(getp(), lds);
    xcd_barrier(bar);
    ph_gn(getp());
    xcd_barrier(bar);
    {
        KP p = getp();
        __syncthreads();
        pg8::Gemm g; g.A = p->gated; g.Bt = p->w_out1t; g.M = T_; g.N = D_; g.K = 4096;
        pg8::StaticOrder S; S.init(T_, D_, (int)gridDim.x, (int)blockIdx.x);
        pg8::gemm_phase<PgEpiResid, pg8::StaticOrder>((PG8_LAS unsigned char*)smem, g, S, PgEpiResid{p->ybuf, p->xcb, D_}, nullptr);
        __syncthreads();
    }
    xcd_barrier(bar);
    { KP p = getp(); ph_ln<false, true, true, false>(p, p->ybuf, p->ln_mix_g[1], p->ln_mix_b[1], nullptr, p->xab, p->xlb); }
    xcd_barrier(bar);
    { KP p = getp(); ph_router(p, smem, p->ctl + CTL_CNT1, p->list); }
    xcd_barrier(bar);
    { KP p = getp(); ph_moe_up<1>(p, p->xab, smem, s_tp, s_off); }
    xcd_barrier(bar);
    { KP p = getp(); ph_moe_down<1>(p, p->xab, smem, s_tp, s_off); }
    xcd_barrier(bar);
    { KP p = getp(); ph_ln<true, false, false, true>(p, p->y2, p->ln_ffn_g[1], p->ln_ffn_b[1], p->out, nullptr, nullptr); }
    {
        KP p = getp();
        if (xb_ld(&p->bar[XB_TMO])) {
            asm volatile("s_waitcnt vmcnt(0)" ::: "memory");
            for (int i = blockIdx.x * NT + ltid(); i < p->out_size; i += gridDim.x * NT) p->out[i] = __uint_as_float(0x7fc00000u);
        }
    }
}

extern "C" void kernel_launch(void* const* d_in, const int* in_sizes, int n_in,
                              void* d_out, int out_size, void* d_ws, size_t ws_size,
                              hipStream_t stream) {
    const size_t kDynLds = LDS_TOTAL;
    static int grid = 0;
    if (!grid) {
        int dev = 0, cus = 0, per_cu = 0;
        (void)hipGetDevice(&dev);
        (void)hipDeviceGetAttribute(&cus, hipDeviceAttributeMultiprocessorCount, dev);
        (void)hipFuncSetAttribute((const void*)mega, hipFuncAttributeMaxDynamicSharedMemorySize, (int)kDynLds);
        (void)hipOccupancyMaxActiveBlocksPerMultiprocessor(&per_cu, mega, NT, kDynLds);
        grid = cus * (per_cu >= 1 ? 1 : 0);
    }
    unsigned char* ws = (unsigned char*)d_ws;
    size_t off = 0;
    auto take = [&](size_t bytes) { void* q = ws + off; off += (bytes + 255) & ~(size_t)255; return q; };
    Params p{};
    p.bar = (unsigned*)take(XCD_BAR_WORDS * 4);
    p.ctl = (unsigned*)take(CTL_WORDS * 4);
    const size_t ctl_bytes = off;
    (void)hipMemsetAsync(ws, 0, ctl_bytes, stream);
    auto F = [&](int i) { return (const float*)d_in[i]; };
    p.x = F(0); p.pos = (const int*)d_in[1]; p.router_w = F(2); p.router_b = F(3);
    p.w_in0 = F(4); p.q_norm = F(5); p.w_uq = F(6); p.kv_norm = F(7); p.w_ukv = F(8); p.w_out0 = F(9);
    p.w_in1 = F(10); p.gn_g = F(11); p.gn_b = F(12); p.w_out1 = F(13);
    for (int l = 0; l < 2; ++l) {
        const int b = 14 + 10 * l;
        p.ln_mix_g[l] = F(b); p.ln_mix_b[l] = F(b + 1);
        p.moe_wg[l] = F(b + 2); p.moe_wu[l] = F(b + 3); p.moe_wd[l] = F(b + 4);
        p.sh_g[l] = F(b + 5); p.sh_u[l] = F(b + 6); p.sh_d[l] = F(b + 7);
        p.ln_ffn_g[l] = F(b + 8); p.ln_ffn_b[l] = F(b + 9);
    }
    p.out = (float*)d_out;
    p.w_in0b = nullptr; p.w_in0t = (u16*)take((size_t)3584 * D_ * 2); p.w_uqb = (u16*)take(512 * 1536 * 2); p.w_ukvb = (u16*)take(256 * 2048 * 2);
    p.w_out0b = nullptr; p.w_in1b = nullptr; p.w_out1b = nullptr; p.w_out1t = (u16*)take((size_t)4096 * D_ * 2); p.w_out0t = (u16*)take((size_t)D_ * D_ * 2); p.w_in1t = (u16*)take((size_t)D_ * IN_C * 2);
    for (int l = 0; l < 2; ++l) { p.sh_gb[l] = nullptr; p.sh_ub[l] = nullptr; p.sh_db[l] = nullptr; p.sh_gut[l] = (u16*)take((size_t)2048 * D_ * 2); p.sh_dt[l] = (u16*)take((size_t)D_ * 1024 * 2); }
    const size_t T = T_;
    p.cosA = (float*)take(T * 32 * 4); p.sinA = (float*)take(T * 32 * 4);
    p.cosR = (float*)take(T * 128 * 4); p.sinR = (float*)take(T * 128 * 4);
    p.xb = (u16*)take(T * 2048 * 2); p.H0 = (u16*)take(T * IN_AB * 2);
    p.cqn = (u16*)take(T * 512 * 2); p.ckvn = (u16*)take(T * 256 * 2); p.kpe = (u16*)take(T * 64 * 2);
    p.qb = (u16*)take(T * 1024 * 2); p.kb = (u16*)take(T * 256 * 2); p.vb = (u16*)take(T * 256 * 2);
    p.iqb = (u16*)take(T * 1024 * 2); p.ikb = (u16*)take(T * 64 * 2); p.iwf = (float*)take(T * 16 * 4);
    p.qa = (u16*)take(T * 1536 * 2); p.ka = (u16*)take(T * 1024 * 2); p.vaT = (u16*)take(T * 1024 * 2);
    p.scores = (float*)take(T * T * 4); p.sel = (u16*)take(T * 256 * 2); p.outcat = (u16*)take(T * 2048 * 2); p.mla_po = (float*)take((size_t)256 * 256 * 128 * 4); p.mla_ml = (float*)take((size_t)256 * 256 * 2 * 4);
    p.ybuf = (u16*)take(T * 2048 * 2); p.xab = (u16*)take(T * 2048 * 2); p.xlb = (u16*)take(T * 2048 * 2); p.whT = (u16*)take(64 * 2048 * 2); p.wlT = (u16*)take(64 * 2048 * 2);
    p.y2 = (u16*)take(T * 2048 * 2); p.xcb = (u16*)take(T * 2048 * 2);
    p.tok_e = (int*)take(T * 2 * 4); p.tok_g = (float*)take(T * 2 * 4); p.list = (int*)take(2 * 64 * T * 4);
    p.hbuf = (u16*)take(T * 2 * 512 * 2); p.hsh = (u16*)take(T * 1024 * 2); p.yr = (u16*)take(T * 2 * 2048 * 2);
    p.qr = (u16*)take(T * 2048 * 2); p.qx = (u16*)take(T * 2048 * 2); p.kr = (u16*)take(T * 2048 * 2);
    p.kzT = nullptr; p.kz = (u16*)take(T * 2048 * 2); p.v1 = (u16*)take(T * 4096 * 2); p.sg = (u16*)take(T * 4096 * 2);
    p.innerG = (u16*)take((size_t)8 * 64 * 128 * 128 * 2);
    {
        unsigned char* sbase = (unsigned char*)p.scores;
        p.KVt = (u16*)sbase; p.obuf = (u16*)(sbase + ((size_t)128 << 20)); p.gated = (u16*)(sbase + ((size_t)192 << 20));
    }
    p.out_size = out_size; p.pad_ = 0;
    if (off > ws_size) return;
    mega<<<dim3(grid), dim3(NT), kDynLds, stream>>>(p);
}
```

```cpp
#include <hip/hip_runtime.h>
#include <stdint.h>

typedef unsigned short u16;
typedef __attribute__((ext_vector_type(8))) short bf16x8;
typedef __attribute__((ext_vector_type(4))) float f32x4;
typedef __attribute__((ext_vector_type(2))) float f32x2;
typedef __attribute__((ext_vector_type(4))) unsigned u32x4;
typedef __attribute__((ext_vector_type(2))) unsigned u32x2;
typedef __attribute__((ext_vector_type(2))) __bf16 bf16x2_t;
typedef __attribute__((ext_vector_type(4))) short s16x4;

#define XB_TMO      128
#define XB_XCNT(j)  (256  + 64 * (j))
#define XB_XSUB(j)  (1280 + 64 * (j))
#define XB_XGEN(j)  (2304 + 64 * (j))
#define XB_TOP      3328
#define XB_TOPGEN   3392
#define XCD_BAR_WORDS 3456
#define XB_SPIN_CAP (1u << 22)
#define LAS __attribute__((address_space(3)))

__device__ __forceinline__ unsigned xb_ld(unsigned* p)              { return __hip_atomic_load(p, __ATOMIC_RELAXED, __HIP_MEMORY_SCOPE_AGENT); }
__device__ __forceinline__ unsigned xb_add(unsigned* p, unsigned v) { return __hip_atomic_fetch_add(p, v, __ATOMIC_RELAXED, __HIP_MEMORY_SCOPE_AGENT); }
__device__ __forceinline__ unsigned xb_xcc_id() { return (unsigned)__builtin_amdgcn_s_getreg((3 << 11) | 20) & 0xFu; }
#define XB_SPIN(cond, bar) do { unsigned _sp = 0; while (cond) { __builtin_amdgcn_s_sleep(1); \
    if ((++_sp & 255u) == 0u) { if (xb_ld(&(bar)[XB_TMO])) break; if (_sp > XB_SPIN_CAP) { atomicAdd(&(bar)[XB_TMO], 1u); break; } } } } while (0)

struct XcdBarrier { unsigned* bar; unsigned x; volatile LAS unsigned* st; };

__device__ __forceinline__ XcdBarrier xcd_barrier_post(unsigned* bar, volatile LAS unsigned* st) {
    XcdBarrier b; b.bar = bar; b.x = xb_xcc_id(); b.st = st;
    if (threadIdx.x == 0) (void)xb_add(&bar[XB_XCNT(b.x)], 1u);
    return b;
}
__device__ __forceinline__ void xcd_barrier_complete(unsigned* bar, unsigned x, unsigned& nloc, unsigned& nx) {
    const unsigned G = gridDim.x * gridDim.y * gridDim.z;
    unsigned sum, cnt, mine, sp = 0u;
    for (;;) {
        sum = 0u; cnt = 0u; mine = 0u;
#pragma unroll
        for (unsigned j = 0; j < 16; ++j) { const unsigned c = xb_ld(&bar[XB_XCNT(j)]); sum += c; cnt += (c > 0u) ? 1u : 0u; mine = (j == x) ? c : mine; }
        if (sum == G) break;
        __builtin_amdgcn_s_sleep(1);
        if ((++sp & 255u) == 0u) { if (xb_ld(&bar[XB_TMO])) break; if (sp > XB_SPIN_CAP) { atomicAdd(&bar[XB_TMO], 1u); break; } }
    }
    nloc = mine > 0u ? mine : 1u; nx = cnt > 0u ? cnt : 1u;
}
__device__ __forceinline__ void xcd_barrier(const XcdBarrier& b) {
    asm volatile("s_waitcnt vmcnt(0)" ::: "memory");
    __syncthreads();
    if (threadIdx.x == 0) {
        unsigned* bar = b.bar;
        __builtin_amdgcn_s_waitcnt(0);
        unsigned nloc = b.st[0], nx = b.st[1];
        if (nloc == 0u) { xcd_barrier_complete(bar, b.x, nloc, nx); b.st[0] = nloc; b.st[1] = nx; }
        const unsigned old = xb_add(&bar[XB_XSUB(b.x)], 1u);
        const unsigned gen = old / nloc;
        if (old + 1u == (gen + 1u) * nloc) {
            __builtin_amdgcn_fence(__ATOMIC_RELEASE, "agent");
            asm volatile("s_waitcnt vmcnt(0)" ::: "memory");
            const unsigned og = xb_add(&bar[XB_TOP], 1u);
            const unsigned tg = og / nx;
            if (og + 1u == (tg + 1u) * nx) xb_add(&bar[XB_TOPGEN], 1u);
            else XB_SPIN(xb_ld(&bar[XB_TOPGEN]) == tg, bar);
            __builtin_amdgcn_fence(__ATOMIC_ACQUIRE, "agent");
            xb_add(&bar[XB_XGEN(b.x)], 1u);
            asm volatile("s_waitcnt vmcnt(0)" ::: "memory");
        } else {
            XB_SPIN(xb_ld(&bar[XB_XGEN(b.x)]) == gen, bar);
            __builtin_amdgcn_fence(__ATOMIC_ACQUIRE, "agent");
            asm volatile("s_waitcnt vmcnt(0)" ::: "memory");
        }
    }
    __syncthreads();
}

__device__ __forceinline__ int ltid() { int t = threadIdx.x; asm volatile("" : "+v"(t)); return t; }
__device__ __forceinline__ u16 f2bf(float f) {
    unsigned u = __float_as_uint(f);
    u += 0x7fffu + ((u >> 16) & 1u);
    return (u16)(u >> 16);
}
__device__ __forceinline__ float bf2f(u16 h) { return __uint_as_float(((unsigned)h) << 16); }
__device__ __forceinline__ unsigned pack2(float a, float b) {
    f32x2 v = {a, b};
    bf16x2_t r = __builtin_convertvector(v, bf16x2_t);
    return *(unsigned*)&r;
}

namespace pg8 {
#define PG8_LAS __attribute__((address_space(3)))
typedef unsigned short bf16_t;
typedef short bf16x8 __attribute__((ext_vector_type(8)));
typedef float f32x4 __attribute__((ext_vector_type(4)));
typedef unsigned u32x4 __attribute__((ext_vector_type(4)));
constexpr int BM = 256, BK = 64, HALF = 128, HTB = HALF * BK * 2  , STAGE_BYTES = 8 * HTB, NXCD = 8, WGM = 8;

__host__ __device__ __forceinline__ int lds_byte(int r, int c) { const int st = (r >> 4) * 2 + (c >> 5), rr = r & 15, cc = c & 31, ob = rr * 64 + cc * 2; return st * 1024 + (ob ^ (((ob >> 9) & 1) << 5)); }
__host__ __device__ __forceinline__ void stage_rc(int b, int& R, int& C) { const int st = b / 1024, sb = b % 1024, swz = sb ^ (((sb >> 9) & 1) << 5); R = (st >> 1) * 16 + swz / 64; C = (st & 1) * 32 + (swz % 64) / 2; }
__host__ __device__ __forceinline__ int perm32(int rho) { const int n = rho >> 4, i = rho & 15; return 8 * (i >> 2) + 4 * n + (i & 3); }

struct Unit { int pm, pn; };
struct Gemm { const bf16_t* A; const bf16_t* Bt; int M, N, K; };

struct StaticOrder {
    int nM, nN, nwg, G, c;
    __host__ __device__ void init(int M, int N, int G_, int c_) { nM = M / BM; nN = N / BM; nwg = nM * nN; G = G_; c = c_; }
    __host__ __device__ bool next(int i, Unit& u) const {
        const long L = (long)i * G + c; if (L >= nwg) return false;
        int wgid = (int)L; { const int q = nwg / NXCD, r = nwg % NXCD, xcd = wgid % NXCD, off = wgid / NXCD; wgid = (xcd < r ? xcd * (q + 1) : r * (q + 1) + (xcd - r) * q) + off; }
        const int nig = WGM * nN, gid = wgid / nig, fm = gid * WGM, gsz = (nM - fm) < WGM ? (nM - fm) : WGM;
        u.pm = fm + ((wgid % nig) % gsz); u.pn = (wgid % nig) / gsz; return true;
    }
    __device__ __forceinline__ void a_ready(const Unit&) const {}
    __device__ __forceinline__ void done(const Unit&) const {}
};
__device__ __forceinline__ unsigned cvt_pk_bf16(float lo, float hi) { unsigned r; asm volatile("v_cvt_pk_bf16_f32 %0, %1, %2" : "=v"(r) : "v"(lo), "v"(hi)); return r; }
template <class Epi, class Sched, bool STAMP = false>
__device__ __forceinline__ void gemm_phase(PG8_LAS unsigned char* lds, const Gemm g, const Sched& S, const Epi& E, unsigned long long* stamps) {
    const int tid = ltid(), wid = __builtin_amdgcn_readfirstlane(tid >> 6), lane = tid & 63, wr = wid >> 2, wc = wid & 3, fr = lane & 15, fq = lane >> 4;
    const int K = g.K, nt = K / BK;
    int ts_lo = 0, ts_hi = 0, nts = 0; const unsigned long long rt_entry = STAMP ? (unsigned long long)wall_clock64() : 0ull;
#define PG8_STAMP() do { if (STAMP && wid == 0 && nts < 64) { const unsigned long long _c = (unsigned long long)clock64(); \
        ts_lo = (lane == nts) ? (int)(unsigned)_c : ts_lo; ts_hi = (lane == nts) ? (int)(unsigned)(_c >> 32) : ts_hi; ++nts; } } while (0)
    PG8_STAMP();
    unsigned voffA[2], voffB[2];
#pragma unroll
    for (int i = 0; i < 2; ++i) { int R, C; stage_rc(tid * 16 + i * 8192, R, C); const int Rb = Epi::PERM ? ((R & ~31) + perm32(R & 31)) : R;
        voffA[i] = (unsigned)(R * K + C) * 2u; voffB[i] = (unsigned)(Rb * K + C) * 2u; }
    const size_t kstep = (size_t)(BK * 2);
    const size_t hstep = (size_t)HALF * K * 2;
    const size_t tstep = 2 * hstep;
    const unsigned ldsw = (unsigned)wid * 1024u;
    const int aoff = lds_byte(wr * 64 + fr, fq * 8), boff = lds_byte(wc * 32 + fr, fq * 8);
#define PG8_SA(b, h) (((b) * 2 + (h)) * HTB)
#define PG8_SB(b, h) ((4 + (b) * 2 + (h)) * HTB)
#define PG8_STAGE(bufoff, gbase, voff) do { _Pragma("unroll") for (int _i = 0; _i < 2; ++_i) \
        __builtin_amdgcn_global_load_lds((const unsigned*)((const char*)(gbase) + (voff)[_i]), (PG8_LAS unsigned*)(lds + (bufoff) + ldsw + _i * 8192), 16, 0, 0); } while (0)
#define PG8_LDA(dst, b, h) do { _Pragma("unroll") for (int m = 0; m < 4; ++m) _Pragma("unroll") for (int k = 0; k < 2; ++k) dst[m][k] = *(const PG8_LAS bf16x8*)(lds + PG8_SA(b, h) + aoff + m * 2048 + k * 1024); } while (0)
#define PG8_LDB(dst, b, h) do { _Pragma("unroll") for (int n = 0; n < 2; ++n) _Pragma("unroll") for (int k = 0; k < 2; ++k) dst[n][k] = *(const PG8_LAS bf16x8*)(lds + PG8_SB(b, h) + boff + n * 2048 + k * 1024); } while (0)
#define PG8_MMA(ai, bj, At, Bt) do { __builtin_amdgcn_s_setprio(1); _Pragma("unroll") for (int m = 0; m < 4; ++m) _Pragma("unroll") for (int n = 0; n < 2; ++n) _Pragma("unroll") for (int k = 0; k < 2; ++k) \
        acc[ai][bj][m][n] = __builtin_amdgcn_mfma_f32_16x16x32_bf16(Bt[n][k], At[m][k], acc[ai][bj][m][n], 0, 0, 0); __builtin_amdgcn_s_setprio(0); } while (0)
#define PG8_WAIT_V(n) asm volatile("s_waitcnt vmcnt(" #n ")" ::: "memory")
#define PG8_WAIT_L(n) asm volatile("s_waitcnt lgkmcnt(" #n ")" ::: "memory")
#define PG8_BAR __builtin_amdgcn_s_barrier()
#define PG8_SCHED __builtin_amdgcn_sched_barrier(0)
    Unit cur, nxt; int ui = 0;
    if (!S.next(0, cur)) return;
    f32x4 acc[2][2][4][2];
#pragma unroll
    for (int a = 0; a < 2; ++a)
#pragma unroll
        for (int b = 0; b < 2; ++b)
#pragma unroll
            for (int m = 0; m < 4; ++m)
#pragma unroll
                for (int n = 0; n < 2; ++n) acc[a][b][m][n] = (f32x4){0.f, 0.f, 0.f, 0.f};
    bf16x8 At[4][2], B0[2][2], B1[2][2];
    const char* cA = (const char*)g.A + (size_t)cur.pm * tstep; const char* cB = (const char*)g.Bt + (size_t)cur.pn * tstep;
    S.a_ready(cur);
    PG8_STAGE(PG8_SB(0, 0), cB, voffB); PG8_STAGE(PG8_SA(0, 0), cA, voffA); PG8_STAGE(PG8_SB(0, 1), cB + hstep, voffB); PG8_STAGE(PG8_SA(0, 1), cA + hstep, voffA);
    if (wr == 1) PG8_BAR;
    PG8_WAIT_V(4); PG8_BAR;
    PG8_STAGE(PG8_SB(1, 0), cB + kstep, voffB); PG8_STAGE(PG8_SA(1, 0), cA + kstep, voffA); PG8_STAGE(PG8_SB(1, 1), cB + hstep + kstep, voffB);
    PG8_WAIT_V(6); PG8_BAR;
    PG8_STAMP();
    for (;;) {
        const bool has_next = S.next(ui + 1, nxt);
        const char* nA = has_next ? (const char*)g.A + (size_t)nxt.pm * tstep : cA; const char* nB = has_next ? (const char*)g.Bt + (size_t)nxt.pn * tstep : cB;
        for (int t = 0; t < nt; t += 2) {
            const bool last = (t == nt - 2);
            const char* a1 = cA + (size_t)(t + 1) * kstep;
            const char* a2 = last ? nA : cA + (size_t)(t + 2) * kstep; const char* b2 = last ? nB : cB + (size_t)(t + 2) * kstep;
            const char* a3 = a2 + kstep; const char* b3 = b2 + kstep;
            if (last && has_next) S.a_ready(nxt);
            PG8_LDB(B0, 0, 0); PG8_SCHED; PG8_LDA(At, 0, 0); PG8_STAGE(PG8_SA(1, 1), a1 + hstep, voffA);
            PG8_WAIT_L(8); PG8_BAR; PG8_WAIT_L(0); PG8_MMA(0, 0, At, B0); PG8_BAR; PG8_SCHED;
            PG8_LDB(B1, 0, 1); PG8_STAGE(PG8_SB(0, 0), b2, voffB);
            PG8_BAR; PG8_WAIT_L(0); PG8_MMA(0, 1, At, B1); PG8_BAR;
            PG8_LDA(At, 0, 1); PG8_STAGE(PG8_SA(0, 0), a2, voffA);
            PG8_BAR; PG8_WAIT_L(0); PG8_MMA(1, 0, At, B0); PG8_BAR; PG8_SCHED;
            PG8_STAGE(PG8_SB(0, 1), b2 + hstep, voffB);
            PG8_WAIT_V(6); PG8_BAR; PG8_MMA(1, 1, At, B1); PG8_BAR;
            PG8_LDB(B0, 1, 0); PG8_SCHED; PG8_LDA(At, 1, 0); PG8_STAGE(PG8_SA(0, 1), a2 + hstep, voffA);
            PG8_WAIT_L(8); PG8_BAR; PG8_WAIT_L(0); PG8_MMA(0, 0, At, B0); PG8_BAR; PG8_SCHED;
            PG8_LDB(B1, 1, 1); PG8_STAGE(PG8_SB(1, 0), b3, voffB);
            PG8_BAR; PG8_WAIT_L(0); PG8_MMA(0, 1, At, B1); PG8_BAR;
            PG8_LDA(At, 1, 1); PG8_STAGE(PG8_SA(1, 0), a3, voffA);
            PG8_BAR; PG8_WAIT_L(0); PG8_MMA(1, 0, At, B0); PG8_BAR; PG8_SCHED;
            PG8_STAGE(PG8_SB(1, 1), b3 + hstep, voffB);
            PG8_WAIT_V(6); PG8_BAR; PG8_MMA(1, 1, At, B1); PG8_BAR;
        }
        PG8_STAMP();
        if constexpr (!Epi::AFTER_DRAIN) { E(acc, cur, wr, wc, fr, fq); S.done(cur); }
        PG8_STAMP();
        if (!has_next) break;
#pragma unroll
        for (int a = 0; a < 2; ++a)
#pragma unroll
            for (int b = 0; b < 2; ++b)
#pragma unroll
                for (int m = 0; m < 4; ++m)
#pragma unroll
                    for (int n = 0; n < 2; ++n) acc[a][b][m][n] = (f32x4){0.f, 0.f, 0.f, 0.f};
        cur = nxt; cA = nA; cB = nB; ++ui;
    }
    PG8_WAIT_V(0);
    if (wr == 0) PG8_BAR;
    PG8_BAR;
    if constexpr (Epi::AFTER_DRAIN) { E.fused(acc, cur, wr, wc, fr, fq, lds, wid, lane); S.done(cur); }
    PG8_STAMP();
    if (STAMP && wid == 0) { stamps[lane] = lane < nts ? (((unsigned long long)(unsigned)ts_hi << 32) | (unsigned)ts_lo) : 0ull;
        if (lane == 62) stamps[62] = rt_entry; if (lane == 63) stamps[63] = (unsigned long long)wall_clock64(); }
#undef PG8_STAMP
#undef PG8_SA
#undef PG8_SB
#undef PG8_STAGE
#undef PG8_LDA
#undef PG8_LDB
#undef PG8_MMA
#undef PG8_WAIT_V
#undef PG8_WAIT_L
#undef PG8_BAR
#undef PG8_SCHED
}
}

__device__ __forceinline__ float wave_sum(float v) {
#pragma unroll
    for (int o = 32; o > 0; o >>= 1) v += __shfl_xor(v, o);
    return v;
}
__device__ __forceinline__ float wave_max(float v) {
#pragma unroll
    for (int o = 32; o > 0; o >>= 1) v = fmaxf(v, __shfl_xor(v, o));
    return v;
}
__device__ __forceinline__ int wave_isum(int v) {
#pragma unroll
    for (int o = 32; o > 0; o >>= 1) v += __shfl_xor(v, o);
    return v;
}
__device__ __forceinline__ float silu_f(float x) { return x / (1.f + __expf(-x)); }

#define T_ 8192
#define D_ 2048
#define IN_AB 3472
#define IN_C 12288
#define NT 512
#define ALPHA_ 1.4142135623730951f
#define LOG2E_ 1.4426950408889634f

#define BM 256
#define BN 128
#define BK 64
#define LROW 80
#define GEMM_BUF (BM * LROW + BN * LROW)
#define GEMM_LDS_BYTES (2 * GEMM_BUF * 2)

#define B_F32_KN 0
#define B_BF16_NK 1
#define B_BF16_KN 2

typedef f32x4 Acc[4][4];

__device__ __forceinline__ __amdgpu_buffer_rsrc_t make_rsrc(const void* p) {
    const unsigned long long a = (unsigned long long)p;
    const unsigned lo = __builtin_amdgcn_readfirstlane((unsigned)a), hi = __builtin_amdgcn_readfirstlane((unsigned)(a >> 32));
    return __builtin_amdgcn_make_buffer_rsrc((void*)(((unsigned long long)hi << 32) | lo), 0, 0x7fffffff, 0x00020000);
}
__device__ __forceinline__ u32x4 bload16(__amdgpu_buffer_rsrc_t r, unsigned voff, unsigned soff) {
    return __builtin_amdgcn_raw_buffer_load_b128(r, (int)voff, (int)soff, 0);
}

__device__ __forceinline__ void acc_zero(Acc& acc) {
#pragma unroll
    for (int m = 0; m < 4; ++m)
#pragma unroll
        for (int n = 0; n < 4; ++n) acc[m][n] = (f32x4){0.f, 0.f, 0.f, 0.f};
}

template <int BMODE, bool KS, bool LONGK = false, class ARow, class BSel>
__device__ __forceinline__ void gemm_accum(Acc& acc, const u16* __restrict__ A, int lda, ARow arow,
                                           const void* __restrict__ Bv, int ldb, BSel bsel,
                                           int K, u16* lds) {
    const int tid = ltid(), lane = tid & 63;
    const int wid = __builtin_amdgcn_readfirstlane(tid >> 6);
    const int wr = KS ? ((wid & 3) >> 1) : (wid >> 1), wc = wid & 1, fr = lane & 15, fq = lane >> 4;
    constexpr int NA = KS ? 2 : 4;
    const int ac = tid & 7, ar0 = tid >> 3;
    unsigned ao[NA];
#pragma unroll
    for (int i = 0; i < NA; ++i) ao[i] = ((unsigned)arow(ar0 + 64 * i) * (unsigned)lda + ac * 8) * 2u;
    const int nk = K / BK;
    const int sa_w = ar0 * LROW + ac * 8;
    constexpr int SB0 = BM * LROW;
    const __amdgpu_buffer_rsrc_t rA = make_rsrc(A);

#define MMA16(AF, BF) do { \
        __builtin_amdgcn_s_setprio(1); \
        _Pragma("unroll") for (int m = 0; m < 4; ++m) \
        _Pragma("unroll") for (int n = 0; n < 4; ++n) \
            acc[m][n] = __builtin_amdgcn_mfma_f32_16x16x32_bf16(AF[m], BF[n], acc[m][n], 0, 0, 0); \
        __builtin_amdgcn_s_setprio(0); } while (0)
#define MEMFENCE_ asm volatile("" ::: "memory")
#define GEMM_COMPUTE(buf) do { \
        const u16* sA = lds + (buf) * GEMM_BUF; const u16* sB = sA + SB0; \
        _Pragma("unroll") for (int ks = 0; ks < 2; ++ks) { \
            if (KS && ks != (wid >> 2)) continue; \
            bf16x8 af[4], bfr[4]; \
            _Pragma("unroll") for (int m = 0; m < 4; ++m) af[m] = *(const bf16x8*)(sA + (wr * 64 + m * 16 + fr) * LROW + ks * 32 + fq * 8); \
            _Pragma("unroll") for (int n = 0; n < 4; ++n) bfr[n] = *(const bf16x8*)(sB + (wc * 64 + n * 16 + fr) * LROW + ks * 32 + fq * 8); \
            _Pragma("unroll") for (int m = 0; m < 4; ++m) \
            _Pragma("unroll") for (int n = 0; n < 4; ++n) \
                acc[m][n] = __builtin_amdgcn_mfma_f32_16x16x32_bf16(af[m], bfr[n], acc[m][n], 0, 0, 0); \
        } } while (0)

    __syncthreads();

#define FRAG_KN(buf, ks, AF, BF) do { \
        const u16* sA = lds + (buf) * GEMM_BUF; \
        const LAS char* cB = (const LAS char*)(lds + (buf) * GEMM_BUF); \
        _Pragma("unroll") for (int m = 0; m < 4; ++m) AF[m] = *(const bf16x8*)(sA + (wr * 64 + m * 16 + fr) * LROW + (ks) * 32 + fq * 8); \
        _Pragma("unroll") for (int n = 0; n < 4; ++n) { \
            const s16x4 lo_ = __builtin_amdgcn_ds_read_tr16_b64_v4i16((LAS s16x4*)(cB + rdo[0][n] + (ks) * 8192)); \
            const s16x4 hi_ = __builtin_amdgcn_ds_read_tr16_b64_v4i16((LAS s16x4*)(cB + rdo[1][n] + (ks) * 8192)); \
            BF[n] = __builtin_shufflevector(lo_, hi_, 0, 1, 2, 3, 4, 5, 6, 7); } } while (0)
    if constexpr (BMODE == B_BF16_KN) {
        const int ch8 = tid & 7, kr = tid >> 3;
        const __amdgpu_buffer_rsrc_t rB0 = make_rsrc(bsel.base16((const u16*)Bv, 0));
        const __amdgpu_buffer_rsrc_t rB1 = make_rsrc(bsel.base16((const u16*)Bv, 1));
        const unsigned ldb2 = (unsigned)ldb * 2u;
        const unsigned bof0 = (unsigned)kr * ldb2 + bsel.off8(0, ch8) * 2u, bof1 = (unsigned)kr * ldb2 + bsel.off8(1, ch8) * 2u;
        const int xw = ((kr & 3) << 2) | ((kr >> 2) & 3);
        const int sbw0 = SB0 * 2 + kr * 256 + 16 * (bsel.vchunk(0, ch8) ^ xw);
        const int sbw1 = SB0 * 2 + kr * 256 + 16 * (bsel.vchunk(1, ch8) ^ xw);
        int rdo[2][4];
#pragma unroll
        for (int t = 0; t < 2; ++t) {
            const int xr = ((fr >> 2) << 2) | ((2 * fq + t) & 3);
#pragma unroll
            for (int n = 0; n < 4; ++n)
                rdo[t][n] = SB0 * 2 + (8 * fq + 4 * t + (fr >> 2)) * 256 + 16 * ((2 * (wc * 4 + n) + ((fr & 3) >> 1)) ^ xr) + 8 * (fr & 1);
        }
        u32x4 ra0[NA], ra1[NA]; u32x4 rb0[2], rb1[2];
#define GL_KB(k0, RA, RB) do { \
        _Pragma("unroll") for (int i = 0; i < NA; ++i) RA[i] = bload16(rA, ao[i], (unsigned)(k0) * 2u); \
        const unsigned s0_ = (unsigned)(k0) * ldb2; \
        RB[0] = bload16(rB0, bof0, s0_); RB[1] = bload16(rB1, bof1, s0_); } while (0)
#define LW_KB(buf, RA, RB) do { \
        u16* sb_ = lds + (buf) * GEMM_BUF; \
        _Pragma("unroll") for (int i = 0; i < NA; ++i) *(u32x4*)(sb_ + sa_w + 64 * i * LROW) = RA[i]; \
        char* cb_ = (char*)sb_; \
        *(u32x4*)(cb_ + sbw0) = RB[0]; *(u32x4*)(cb_ + sbw1) = RB[1]; } while (0)
        GL_KB(0, ra0, rb0);
        GL_KB(BK, ra1, rb1);
        LW_KB(0, ra0, rb0);
        if (LONGK || 2 < nk) GL_KB((2 < nk ? 2 : nk - 1) * BK, ra0, rb0);
        __syncthreads();
        bf16x8 af0[4], bf0[4], af1[4], bf1[4];
        for (int kt = 0; kt < nk; kt += 2) {
            if (!KS) { FRAG_KN(0, 0, af0, bf0); } else { FRAG_KN(0, (wid >> 2), af0, bf0); }
            MEMFENCE_;
            LW_KB(1, ra1, rb1);
            if (LONGK || kt + 3 < nk) GL_KB((kt + 3 < nk ? kt + 3 : nk - 1) * BK, ra1, rb1);
            MEMFENCE_;
            if (!KS) FRAG_KN(0, 1, af1, bf1);
            MMA16(af0, bf0);
            if (!KS) MMA16(af1, bf1);
            __syncthreads();
            if (!KS) { FRAG_KN(1, 0, af0, bf0); } else { FRAG_KN(1, (wid >> 2), af0, bf0); }
            MEMFENCE_;
            if (LONGK || kt + 2 < nk) LW_KB(0, ra0, rb0);
            if (LONGK || kt + 4 < nk) GL_KB((kt + 4 < nk ? kt + 4 : nk - 1) * BK, ra0, rb0);
            MEMFENCE_;
            if (!KS) FRAG_KN(1, 1, af1, bf1);
            MMA16(af0, bf0);
            if (!KS) MMA16(af1, bf1);
            __syncthreads();
        }
#undef GL_KB
#undef LW_KB
    } else if constexpr (BMODE == B_F32_KN) {
        const int g4 = tid & 15, kr = tid >> 4;
        const __amdgpu_buffer_rsrc_t rB0 = make_rsrc(bsel.base((const float*)Bv, 0));
        const __amdgpu_buffer_rsrc_t rB1 = make_rsrc(bsel.base((const float*)Bv, 1));
        const unsigned ldb4 = (unsigned)ldb * 4u;
        const unsigned bof0 = (unsigned)kr * ldb4 + bsel.off4(0, g4) * 4u, bof1 = (unsigned)kr * ldb4 + bsel.off4(1, g4) * 4u;
        const int xw = ((kr & 3) << 2) | ((kr >> 2) & 3);
        const int v00 = bsel.vcol4(0, g4), v01 = bsel.vcol4(1, g4);
        const int sbw0 = SB0 * 2 + kr * 256 + 16 * ((v00 >> 3) ^ xw) + 8 * ((v00 >> 2) & 1);
        const int sbw1 = SB0 * 2 + kr * 256 + 16 * ((v01 >> 3) ^ xw) + 8 * ((v01 >> 2) & 1);
        int rdo[2][4];
#pragma unroll
        for (int t = 0; t < 2; ++t) {
            const int xr = ((fr >> 2) << 2) | ((2 * fq + t) & 3);
#pragma unroll
            for (int n = 0; n < 4; ++n)
                rdo[t][n] = SB0 * 2 + (8 * fq + 4 * t + (fr >> 2)) * 256 + 16 * ((2 * (wc * 4 + n) + ((fr & 3) >> 1)) ^ xr) + 8 * (fr & 1);
        }
        u32x4 ra0[NA], ra1[NA]; u32x4 rb0[4], rb1[4];
#define PK4_(V) (w_.x = pack2(__uint_as_float(V[0]), __uint_as_float(V[1])), w_.y = pack2(__uint_as_float(V[2]), __uint_as_float(V[3])))
#define GL_F32(k0, RA, RB) do { \
        _Pragma("unroll") for (int i = 0; i < NA; ++i) RA[i] = bload16(rA, ao[i], (unsigned)(k0) * 2u); \
        const unsigned s0_ = (unsigned)(k0) * ldb4, s1_ = s0_ + 32u * ldb4; \
        RB[0] = bload16(rB0, bof0, s0_); RB[1] = bload16(rB1, bof1, s0_); \
        RB[2] = bload16(rB0, bof0, s1_); RB[3] = bload16(rB1, bof1, s1_); } while (0)
#define LW_F32(buf, RA, RB) do { \
        u16* sb_ = lds + (buf) * GEMM_BUF; \
        _Pragma("unroll") for (int i = 0; i < NA; ++i) *(u32x4*)(sb_ + sa_w + 64 * i * LROW) = RA[i]; \
        char* cb_ = (char*)sb_; \
        u32x2 w_; \
        PK4_(RB[0]); *(u32x2*)(cb_ + sbw0) = w_; \
        PK4_(RB[1]); *(u32x2*)(cb_ + sbw1) = w_; \
        PK4_(RB[2]); *(u32x2*)(cb_ + sbw0 + 32 * 256) = w_; \
        PK4_(RB[3]); *(u32x2*)(cb_ + sbw1 + 32 * 256) = w_; } while (0)
        GL_F32(0, ra0, rb0);
        GL_F32(BK, ra1, rb1);
        LW_F32(0, ra0, rb0);
        if (LONGK || 2 < nk) GL_F32((2 < nk ? 2 : nk - 1) * BK, ra0, rb0);
        __syncthreads();
        bf16x8 af0[4], bf0[4], af1[4], bf1[4];
        for (int kt = 0; kt < nk; kt += 2) {
            if (!KS) { FRAG_KN(0, 0, af0, bf0); } else { FRAG_KN(0, (wid >> 2), af0, bf0); }
            MEMFENCE_;
            LW_F32(1, ra1, rb1);
            if (LONGK || kt + 3 < nk) GL_F32((kt + 3 < nk ? kt + 3 : nk - 1) * BK, ra1, rb1);
            MEMFENCE_;
            if (!KS) FRAG_KN(0, 1, af1, bf1);
            MMA16(af0, bf0);
            if (!KS) MMA16(af1, bf1);
            __syncthreads();
            if (!KS) { FRAG_KN(1, 0, af0, bf0); } else { FRAG_KN(1, (wid >> 2), af0, bf0); }
            MEMFENCE_;
            if (LONGK || kt + 2 < nk) LW_F32(0, ra0, rb0);
            if (LONGK || kt + 4 < nk) GL_F32((kt + 4 < nk ? kt + 4 : nk - 1) * BK, ra0, rb0);
            MEMFENCE_;
            if (!KS) FRAG_KN(1, 1, af1, bf1);
            MMA16(af0, bf0);
            if (!KS) MMA16(af1, bf1);
            __syncthreads();
        }
#undef GL_F32
#undef LW_F32
    } else {
        const __amdgpu_buffer_rsrc_t rB = make_rsrc(Bv);
        unsigned bo[2];
#pragma unroll
        for (int i = 0; i < 2; ++i) bo[i] = ((unsigned)bsel(ar0 + 64 * i) * (unsigned)ldb + ac * 8) * 2u;
        u32x4 ra0[NA], ra1[NA], rb0[2], rb1[2];
#define GL_BF(k0, RA, RB) do { \
        _Pragma("unroll") for (int i = 0; i < NA; ++i) RA[i] = bload16(rA, ao[i], (unsigned)(k0) * 2u); \
        _Pragma("unroll") for (int i = 0; i < 2; ++i) RB[i] = bload16(rB, bo[i], (unsigned)(k0) * 2u); } while (0)
#define LW_BF(buf, RA, RB) do { \
        u16* sb_ = lds + (buf) * GEMM_BUF; \
        _Pragma("unroll") for (int i = 0; i < NA; ++i) *(u32x4*)(sb_ + sa_w + 64 * i * LROW) = RA[i]; \
        _Pragma("unroll") for (int i = 0; i < 2; ++i) *(u32x4*)(sb_ + SB0 + sa_w + 64 * i * LROW) = RB[i]; } while (0)
        GL_BF(0, ra0, rb0);
        GL_BF(BK, ra1, rb1);
        LW_BF(0, ra0, rb0);
        if (LONGK || 2 < nk) GL_BF((2 < nk ? 2 : nk - 1) * BK, ra0, rb0);
        __syncthreads();
#define FRAG_NK(buf, ks, AF, BF) do { \
        const u16* sA = lds + (buf) * GEMM_BUF; const u16* sB = sA + SB0; \
        _Pragma("unroll") for (int m = 0; m < 4; ++m) AF[m] = *(const bf16x8*)(sA + (wr * 64 + m * 16 + fr) * LROW + (ks) * 32 + fq * 8); \
        _Pragma("unroll") for (int n = 0; n < 4; ++n) BF[n] = *(const bf16x8*)(sB + (wc * 64 + n * 16 + fr) * LROW + (ks) * 32 + fq * 8); } while (0)
        bf16x8 af0[4], bf0[4], af1[4], bf1[4];
        for (int kt = 0; kt < nk; kt += 2) {
            if (!KS) { FRAG_NK(0, 0, af0, bf0); } else { FRAG_NK(0, (wid >> 2), af0, bf0); }
            MEMFENCE_;
            LW_BF(1, ra1, rb1);
            if (LONGK || kt + 3 < nk) GL_BF((kt + 3 < nk ? kt + 3 : nk - 1) * BK, ra1, rb1);
            MEMFENCE_;
            if (!KS) FRAG_NK(0, 1, af1, bf1);
            MMA16(af0, bf0);
            if (!KS) MMA16(af1, bf1);
            __syncthreads();
            if (!KS) { FRAG_NK(1, 0, af0, bf0); } else { FRAG_NK(1, (wid >> 2), af0, bf0); }
            MEMFENCE_;
            if (LONGK || kt + 2 < nk) LW_BF(0, ra0, rb0);
            if (LONGK || kt + 4 < nk) GL_BF((kt + 4 < nk ? kt + 4 : nk - 1) * BK, ra0, rb0);
            MEMFENCE_;
            if (!KS) FRAG_NK(1, 1, af1, bf1);
            MMA16(af0, bf0);
            if (!KS) MMA16(af1, bf1);
            __syncthreads();
        }
#undef FRAG_NK
#undef GL_BF
#undef LW_BF
    }
#undef GEMM_COMPUTE
#undef FRAG_KN
}

__device__ __forceinline__ void gemm_kk128(Acc& acc, const u16* __restrict__ Akm, int lda, const u16* __restrict__ Bkn, int ldb, u16* lds) {
    const int tid = ltid(), lane = tid & 63;
    const int wid = __builtin_amdgcn_readfirstlane(tid >> 6);
    const int wr = wid >> 1, wc = wid & 1, fr = lane & 15, fq = lane >> 4;
    char* sA = (char*)lds;
    char* sB = (char*)lds + 65536;
    __syncthreads();
    {
        u32x4 ra[8], rb[4];
#pragma unroll
        for (int i = 0; i < 8; ++i) { const int k = (tid >> 5) + 16 * i, ch = tid & 31; ra[i] = *(const u32x4*)(Akm + (size_t)k * lda + ch * 8); }
#pragma unroll
        for (int i = 0; i < 4; ++i) { const int k = (tid >> 4) + 32 * i, ch = tid & 15; rb[i] = *(const u32x4*)(Bkn + (size_t)k * ldb + ch * 8); }
#pragma unroll
        for (int i = 0; i < 8; ++i) { const int k = (tid >> 5) + 16 * i, ch = tid & 31; const int x = ((k & 3) << 2) | ((k >> 2) & 3);
            *(u32x4*)(sA + k * 512 + 16 * (ch ^ x)) = ra[i]; }
#pragma unroll
        for (int i = 0; i < 4; ++i) { const int k = (tid >> 4) + 32 * i, ch = tid & 15; const int x = ((k & 3) << 2) | ((k >> 2) & 3);
            *(u32x4*)(sB + k * 256 + 16 * (ch ^ x)) = rb[i]; }
    }
    __syncthreads();
    const LAS char* cA = (const LAS char*)sA; const LAS char* cB = (const LAS char*)sB;
#pragma unroll
    for (int ks = 0; ks < 4; ++ks) {
        bf16x8 af[4], bfr[4];
#pragma unroll
        for (int t = 0; t < 2; ++t) { }
#pragma unroll
        for (int m = 0; m < 4; ++m) {
            const int row0 = 32 * ks + 8 * fq + (fr >> 2), xr0 = ((fr >> 2) << 2) | ((2 * fq) & 3), xr1 = ((fr >> 2) << 2) | ((2 * fq + 1) & 3);
            const int chunk = 2 * (wr * 4 + m) + ((fr & 3) >> 1);
            const s16x4 lo_ = __builtin_amdgcn_ds_read_tr16_b64_v4i16((LAS s16x4*)(cA + row0 * 512 + 16 * (chunk ^ xr0) + 8 * (fr & 1)));
            const s16x4 hi_ = __builtin_amdgcn_ds_read_tr16_b64_v4i16((LAS s16x4*)(cA + (row0 + 4) * 512 + 16 * (chunk ^ xr1) + 8 * (fr & 1)));
            af[m] = __builtin_shufflevector(lo_, hi_, 0, 1, 2, 3, 4, 5, 6, 7);
        }
#pragma unroll
        for (int n = 0; n < 4; ++n) {
            const int row0 = 32 * ks + 8 * fq + (fr >> 2), xr0 = ((fr >> 2) << 2) | ((2 * fq) & 3), xr1 = ((fr >> 2) << 2) | ((2 * fq + 1) & 3);
            const int chunk = 2 * (wc * 4 + n) + ((fr & 3) >> 1);
            const s16x4 lo_ = __builtin_amdgcn_ds_read_tr16_b64_v4i16((LAS s16x4*)(cB + row0 * 256 + 16 * (chunk ^ xr0) + 8 * (fr & 1)));
            const s16x4 hi_ = __builtin_amdgcn_ds_read_tr16_b64_v4i16((LAS s16x4*)(cB + (row0 + 4) * 256 + 16 * (chunk ^ xr1) + 8 * (fr & 1)));
            bfr[n] = __builtin_shufflevector(lo_, hi_, 0, 1, 2, 3, 4, 5, 6, 7);
        }
#pragma unroll
        for (int m = 0; m < 4; ++m)
#pragma unroll
            for (int n = 0; n < 4; ++n) acc[m][n] = __builtin_amdgcn_mfma_f32_16x16x32_bf16(af[m], bfr[n], acc[m][n], 0, 0, 0);
    }
    __syncthreads();
}

__device__ __forceinline__ bool ksplit_reduce(Acc& acc, u16* lds) {
    const int tid = ltid(), lane = tid & 63;
    const int wid = __builtin_amdgcn_readfirstlane(tid >> 6);
    float* f = (float*)lds + (wid & 3) * 4096 + lane;
    if (wid >= 4) {
#pragma unroll
        for (int m = 0; m < 4; ++m)
#pragma unroll
            for (int n = 0; n < 4; ++n)
#pragma unroll
                for (int j = 0; j < 4; ++j) f[((m * 4 + n) * 4 + j) * 64] = acc[m][n][j];
    }
    __syncthreads();
    if (wid < 4) {
#pragma unroll
        for (int m = 0; m < 4; ++m)
#pragma unroll
            for (int n = 0; n < 4; ++n)
#pragma unroll
                for (int j = 0; j < 4; ++j) acc[m][n][j] += f[((m * 4 + n) * 4 + j) * 64];
    }
    return wid < 4;
}


#define STG_LD 68
#define STG_WAVE_BYTES (32 * STG_LD * 4)
#define WR0_ ((ltid() >> 7) * 64)
#define WC0_ (((ltid() >> 6) & 1) * 64)
template <class F>
__device__ __forceinline__ void stage_rows(Acc& acc, unsigned char* stage_base, F f) {
    const int tid = ltid(), lane = tid & 63, wid = tid >> 6, fr = lane & 15, fq = lane >> 4;
    float* st = (float*)(stage_base + wid * STG_WAVE_BYTES);
#pragma unroll
    for (int h = 0; h < 2; ++h) {
#pragma unroll
        for (int mm = 0; mm < 2; ++mm)
#pragma unroll
            for (int n = 0; n < 4; ++n)
#pragma unroll
                for (int j = 0; j < 4; ++j) st[(mm * 16 + fq * 4 + j) * STG_LD + n * 16 + fr] = acc[2 * h + mm][n][j];
        __builtin_amdgcn_s_waitcnt(0xc07f);
#pragma unroll
        for (int i = 0; i < 8; ++i) {
            const int r = (lane >> 4) + 4 * i, c4 = (lane & 15) * 4;
            const f32x4 v = *(const f32x4*)(st + r * STG_LD + c4);
            f(h * 32 + r, c4, v);
        }
        __builtin_amdgcn_s_waitcnt(0xc07f);
    }
}
template <class F>
__device__ __forceinline__ void stage_pairs(Acc& acc, unsigned char* stage_base, F f) {
    const int tid = ltid(), lane = tid & 63, wid = tid >> 6, fr = lane & 15, fq = lane >> 4;
    float* st = (float*)(stage_base + wid * STG_WAVE_BYTES);
#pragma unroll
    for (int h = 0; h < 2; ++h) {
#pragma unroll
        for (int mm = 0; mm < 2; ++mm)
#pragma unroll
            for (int n = 0; n < 4; ++n)
#pragma unroll
                for (int j = 0; j < 4; ++j) st[(mm * 16 + fq * 4 + j) * STG_LD + n * 16 + fr] = acc[2 * h + mm][n][j];
        __builtin_amdgcn_s_waitcnt(0xc07f);
#pragma unroll
        for (int i = 0; i < 4; ++i) {
            const int r = (lane >> 3) + 8 * i, c4 = (lane & 7) * 4;
            const f32x4 lo = *(const f32x4*)(st + r * STG_LD + c4);
            const f32x4 hi = *(const f32x4*)(st + r * STG_LD + c4 + 32);
            f(h * 32 + r, c4, lo, hi);
        }
        __builtin_amdgcn_s_waitcnt(0xc07f);
    }
}

template <class AUX, class PRE, class F>
__device__ __forceinline__ void stage_rows_pre(Acc& acc, unsigned char* stage_base, PRE pre, F f) {
    const int tid = ltid(), lane = tid & 63, wid = tid >> 6, fr = lane & 15, fq = lane >> 4;
    float* st = (float*)(stage_base + wid * STG_WAVE_BYTES);
#pragma unroll
    for (int h = 0; h < 2; ++h) {
        AUX aux[8];
#pragma unroll
        for (int i = 0; i < 8; ++i) aux[i] = pre(h * 32 + (lane >> 4) + 4 * i, (lane & 15) * 4);
#pragma unroll
        for (int mm = 0; mm < 2; ++mm)
#pragma unroll
            for (int n = 0; n < 4; ++n)
#pragma unroll
                for (int j = 0; j < 4; ++j) st[(mm * 16 + fq * 4 + j) * STG_LD + n * 16 + fr] = acc[2 * h + mm][n][j];
        __builtin_amdgcn_s_waitcnt(0xc07f);
        f32x4 v[8];
#pragma unroll
        for (int i = 0; i < 8; ++i) v[i] = *(const f32x4*)(st + ((lane >> 4) + 4 * i) * STG_LD + (lane & 15) * 4);
        asm volatile("" ::: "memory");
#pragma unroll
        for (int i = 0; i < 8; ++i) f(h * 32 + (lane >> 4) + 4 * i, (lane & 15) * 4, v[i], aux[i]);
        __builtin_amdgcn_s_waitcnt(0xc07f);
    }
}
template <class AUX, class PRE, class F>
__device__ __forceinline__ void stage_pairs_pre(Acc& acc, unsigned char* stage_base, PRE pre, F f) {
    const int tid = ltid(), lane = tid & 63, wid = tid >> 6, fr = lane & 15, fq = lane >> 4;
    float* st = (float*)(stage_base + wid * STG_WAVE_BYTES);
#pragma unroll
    for (int h = 0; h < 2; ++h) {
        AUX aux[4];
#pragma unroll
        for (int i = 0; i < 4; ++i) aux[i] = pre(h * 32 + (lane >> 3) + 8 * i, (lane & 7) * 4);
#pragma unroll
        for (int mm = 0; mm < 2; ++mm)
#pragma unroll
            for (int n = 0; n < 4; ++n)
#pragma unroll
                for (int j = 0; j < 4; ++j) st[(mm * 16 + fq * 4 + j) * STG_LD + n * 16 + fr] = acc[2 * h + mm][n][j];
        __builtin_amdgcn_s_waitcnt(0xc07f);
        f32x4 lo[4], hi[4];
#pragma unroll
        for (int i = 0; i < 4; ++i) {
            lo[i] = *(const f32x4*)(st + ((lane >> 3) + 8 * i) * STG_LD + (lane & 7) * 4);
            hi[i] = *(const f32x4*)(st + ((lane >> 3) + 8 * i) * STG_LD + (lane & 7) * 4 + 32);
        }
        asm volatile("" ::: "memory");
#pragma unroll
        for (int i = 0; i < 4; ++i) f(h * 32 + (lane >> 3) + 8 * i, (lane & 7) * 4, lo[i], hi[i], aux[i]);
        __builtin_amdgcn_s_waitcnt(0xc07f);
    }
}
__device__ __forceinline__ u32x2 pack4(f32x4 v) { u32x2 w; w.x = pack2(v[0], v[1]); w.y = pack2(v[2], v[3]); return w; }

struct Params {
    const float* x; const int* pos; const float* router_w; const float* router_b;
    const float* w_in0; const float* q_norm; const float* w_uq; const float* kv_norm; const float* w_ukv; const float* w_out0;
    const float* w_in1; const float* gn_g; const float* gn_b; const float* w_out1;
    const float* ln_mix_g[2]; const float* ln_mix_b[2];
    const float* moe_wg[2]; const float* moe_wu[2]; const float* moe_wd[2];
    const float* sh_g[2]; const float* sh_u[2]; const float* sh_d[2];
    const float* ln_ffn_g[2]; const float* ln_ffn_b[2];
    float* out;
    u16* w_in0b; u16* w_uqb; u16* w_ukvb; u16* w_out0b; u16* w_in1b; u16* w_out1b; u16* w_out1t; u16* w_out0t; u16* w_in1t; u16* w_in0t; u16* sh_gut[2]; u16* sh_dt[2]; u16* sh_gb[2]; u16* sh_ub[2]; u16* sh_db[2];
    unsigned* bar; unsigned* ctl;
    float* cosA; float* sinA; float* cosR; float* sinR;
    u16* xb; u16* H0;
    u16* cqn; u16* ckvn; u16* kpe; u16* qb; u16* kb; u16* vb; u16* iqb; u16* ikb; float* iwf;
    u16* qa; u16* ka; u16* vaT;
    float* scores; u16* sel; u16* outcat; float* mla_po; float* mla_ml;
    u16* ybuf; u16* xab; u16* xlb; u16* whT; u16* wlT; u16* y2; u16* xcb;
    int* tok_e; float* tok_g; int* list; u16* hbuf; u16* hsh; u16* yr;
    u16* qr; u16* qx; u16* kr; u16* kzT; u16* v1; u16* kz; u16* sg; u16* KVt; u16* innerG; u16* obuf; u16* gated;
    int out_size; int pad_;
};
typedef const __attribute__((address_space(4))) Params* KP;
__device__ __forceinline__ KP getp() { KP kp = (KP)__builtin_amdgcn_kernarg_segment_ptr(); asm volatile("" : "+s"(kp)); return kp; }
#define CTL_FLAGS 0
#define CTL_QUEUE 16
#define CNT_STRIDE 32
#define CTL_CNT0 64
#define CTL_CNT1 (64 + 64 * CNT_STRIDE)
#define CTL_CNTX (64 + 128 * CNT_STRIDE)
#define CTL_WORDS (64 + 192 * CNT_STRIDE)

struct RowId { int base; __device__ __forceinline__ int operator()(int r) const { return base + r; } };
struct ColOff { int c0;
    __device__ __forceinline__ const u16* base16(const u16* B, int) const { return B; }
    __device__ __forceinline__ unsigned off8(int hsel, int ch8) const { return (unsigned)(c0 + hsel * 64 + ch8 * 8); }
    __device__ __forceinline__ int vchunk(int hsel, int ch8) const { return hsel * 8 + ch8; }
    __device__ __forceinline__ const float* base(const float* B, int) const { return B; }
    __device__ __forceinline__ unsigned off4(int hsel, int g4) const { return (unsigned)(c0 + hsel * 64 + g4 * 4); }
    __device__ __forceinline__ int vcol4(int hsel, int g4) const { return hsel * 64 + g4 * 4; } };
struct ColClampOff { int c0, n;
    __device__ __forceinline__ const u16* base16(const u16* B, int) const { return B; }
    __device__ __forceinline__ unsigned off8(int hsel, int ch8) const { const int c = c0 + hsel * 64 + ch8 * 8; return (unsigned)(c < n - 8 ? c : n - 8); }
    __device__ __forceinline__ int vchunk(int hsel, int ch8) const { return hsel * 8 + ch8; }
    __device__ __forceinline__ const float* base(const float* B, int) const { return B; }
    __device__ __forceinline__ unsigned off4(int hsel, int g4) const { const int c = c0 + hsel * 64 + g4 * 4; return (unsigned)(c < n - 4 ? c : n - 4); }
    __device__ __forceinline__ int vcol4(int hsel, int g4) const { return hsel * 64 + g4 * 4; } };

__device__ __forceinline__ void ph_prep(KP p) {
    const int gtid = blockIdx.x * NT + ltid(), gsz = gridDim.x * NT;
    {
        const size_t n4 = (size_t)T_ * D_ / 4;
        for (size_t i0 = gtid; i0 < n4; i0 += (size_t)8 * gsz) {
            float4 v[8];
#pragma unroll
            for (int u = 0; u < 8; ++u) { const size_t i = i0 + (size_t)u * gsz; v[u] = ((const float4*)p->x)[i < n4 ? i : i0]; }
#pragma unroll
            for (int u = 0; u < 8; ++u) {
                const size_t i = i0 + (size_t)u * gsz;
                u32x2 o; o.x = pack2(v[u].x, v[u].y); o.y = pack2(v[u].z, v[u].w);
                if (i < n4) ((u32x2*)p->xb)[i] = o;
            }
        }
    }
    for (int idx = gtid; idx < D_ * 64; idx += gsz) {
        const int k = idx >> 6, e = idx & 63;
        const float w = p->router_w[idx];
        const u16 hi = f2bf(w);
        p->whT[(size_t)e * D_ + k] = hi;
        p->wlT[(size_t)e * D_ + k] = f2bf(w - bf2f(hi));
    }
    {
        auto cvt = [&](const float* src, u16* dst, size_t n) {
            for (size_t i = gtid; i < n / 8; i += gsz) {
                const f32x4 a = ((const f32x4*)src)[2 * i], b = ((const f32x4*)src)[2 * i + 1];
                u32x4 o; o.x = pack2(a[0], a[1]); o.y = pack2(a[2], a[3]); o.z = pack2(b[0], b[1]); o.w = pack2(b[2], b[3]);
                ((u32x4*)dst)[i] = o;
            }
        };
        cvt(p->w_uq, p->w_uqb, (size_t)512 * 1536);
        cvt(p->w_ukv, p->w_ukvb, (size_t)256 * 2048);
    }
    const double inv2pi = 0.15915494309189535;
    for (int idx = gtid; idx < T_ * 32; idx += gsz) {
        const int t = idx >> 5, i = idx & 31;
        const float inv = (float)exp2(-(double)i * (18.931568569324174 / 32.0));
        double rev = (double)p->pos[t] * (double)inv * inv2pi;
        rev -= floor(rev);
        p->cosA[idx] = __builtin_amdgcn_cosf((float)rev);
        p->sinA[idx] = __builtin_amdgcn_sinf((float)rev);
    }
    for (int idx = gtid; idx < T_ * 128; idx += gsz) {
        const int t = idx >> 7, i = idx & 127;
        const float inv = (float)exp2(-(double)i * (13.287712379549449 / 128.0));
        double rev = (double)p->pos[t] * (double)inv * inv2pi;
        rev -= floor(rev);
        p->cosR[idx] = __builtin_amdgcn_cosf((float)rev);
        p->sinR[idx] = __builtin_amdgcn_sinf((float)rev);
    }
}

struct EpiF32 {
    float* C; int ldc; int row0, col0, ncols;
    __device__ __forceinline__ void operator()(Acc& acc, unsigned char* stg) const {
        const int rb = row0 + WR0_, cb = col0 + WC0_;
        float* Cp = C; const int ld = ldc, nc = ncols;
        stage_rows(acc, stg, [=](int r, int c4, f32x4 v) {
            const int c = cb + c4;
            if (c < nc) *(f32x4*)(Cp + (size_t)(rb + r) * ld + c) = v;
        });
    }
};
struct EpiBF16N {
    u16* C; int ldc; int row0, col0, ncols;
    __device__ __forceinline__ void operator()(Acc& acc, unsigned char* stg) const {
        const int rb = row0 + WR0_, cb = col0 + WC0_;
        u16* Cp = C; const int ld = ldc, nc = ncols;
        stage_rows(acc, stg, [=](int r, int c4, f32x4 v) {
            const int c = cb + c4;
            if (c < nc) *(u32x2*)(Cp + (size_t)(rb + r) * ld + c) = pack4(v);
        });
    }
};
struct EpiBF16 {
    u16* C; int ldc; int row0, col0;
    __device__ __forceinline__ void operator()(Acc& acc, unsigned char* stg) const {
        const int rb = row0 + WR0_, cb = col0 + WC0_;
        u16* Cp = C; const int ld = ldc;
        stage_rows(acc, stg, [=](int r, int c4, f32x4 v) { *(u32x2*)(Cp + (size_t)(rb + r) * ld + cb + c4) = pack4(v); });
    }
};
template <bool XB>
struct EpiResid {
    u16* C; const void* X; int ldc; int row0, col0;
    __device__ __forceinline__ void operator()(Acc& acc, unsigned char* stg) const {
        const int rb = row0 + WR0_, cb = col0 + WC0_;
        u16* Cp = C; const void* Xp = X; const int ld = ldc;
        stage_rows_pre<f32x4>(acc, stg,
            [=](int r, int c4) -> f32x4 {
                const size_t o = (size_t)(rb + r) * ld + cb + c4;
                f32x4 x;
                if constexpr (XB) {
                    const u32x2 xr = *(const u32x2*)((const u16*)Xp + o);
                    x[0] = __uint_as_float(xr.x << 16); x[1] = __uint_as_float(xr.x & 0xffff0000u);
                    x[2] = __uint_as_float(xr.y << 16); x[3] = __uint_as_float(xr.y & 0xffff0000u);
                } else x = *(const f32x4*)((const float*)Xp + o);
                return x; },
            [=](int r, int c4, f32x4 v, f32x4 x) {
                *(u32x2*)(Cp + (size_t)(rb + r) * ld + cb + c4) = pack4(x * ALPHA_ + v); });
    }
};

__device__ __forceinline__ void ph_post0(KP p) {
    const int lane = ltid() & 63;
    const int gw = (blockIdx.x * NT + ltid()) >> 6, nw = (gridDim.x * NT) >> 6;
    const float qscale = 0.08838834764831845f * LOG2E_;
    const int dq = lane, d7 = lane & 127;
    const float qn[8] = {p->q_norm[lane], p->q_norm[lane + 64], p->q_norm[lane + 128], p->q_norm[lane + 192],
                         p->q_norm[lane + 256], p->q_norm[lane + 320], p->q_norm[lane + 384], p->q_norm[lane + 448]};
    const float kn[4] = {p->kv_norm[lane], p->kv_norm[lane + 64], p->kv_norm[lane + 128], p->kv_norm[lane + 192]};
    (void)dq; (void)d7;
    for (int t = gw; t < T_; t += nw) {
        const u16* hb = p->H0 + (size_t)t * IN_AB;
#define h_(i) bf2f(hb[i])
        const float* ca = p->cosA + t * 32;
        const float* sa = p->sinA + t * 32;
        const float c32 = ca[lane & 31], s32 = sa[lane & 31];
        const float c16 = ca[2 * (lane & 15)], s16 = sa[2 * (lane & 15)];
        const float c8 = ca[4 * (lane & 7)], s8 = sa[4 * (lane & 7)];
        float vq[8], vkv[4];
#pragma unroll
        for (int j = 0; j < 8; ++j) vq[j] = h_(lane + 64 * j);
#pragma unroll
        for (int j = 0; j < 4; ++j) vkv[j] = h_(512 + lane + 64 * j);
        const float kx1 = h_(768 + (lane & 31)), kx2 = h_(768 + 32 + (lane & 31));
        float q1[16], q2[16];
#pragma unroll
        for (int j = 0; j < 16; ++j) {
            const int e = lane + 64 * j, hd = e >> 7, d = e & 127, i = d & 15;
            const int i1 = d < 32 ? 832 + hd * 128 + i : 832 + e;
            q1[j] = h_(i1); q2[j] = h_(d < 32 ? i1 + 16 : i1);
        }
        float k1[4], k2[4], vv[4];
#pragma unroll
        for (int j = 0; j < 4; ++j) {
            const int e = lane + 64 * j, hd = e >> 7, d = e & 127, i = d & 15;
            const int i1 = d < 32 ? 1856 + hd * 128 + i : 1856 + e;
            k1[j] = h_(i1); k2[j] = h_(d < 32 ? i1 + 16 : i1);
            vv[j] = h_(2112 + e);
        }
        float iq1[16], iq2[16];
#pragma unroll
        for (int j = 0; j < 16; ++j) {
            const int e = lane + 64 * j, hd = e >> 6, d = e & 63, i = d & 7;
            const int i1 = d < 16 ? 2368 + hd * 64 + i : 2368 + e;
            iq1[j] = h_(i1); iq2[j] = h_(d < 16 ? i1 + 8 : i1);
        }
        const int iki = lane < 16 ? 3392 + (lane & 7) : 3392 + lane;
        const float ik1 = h_(iki), ik2 = h_(lane < 16 ? iki + 8 : iki);
        const float iwv = h_(3456 + (lane & 15));
        {
            float ss = 0.f;
#pragma unroll
            for (int j = 0; j < 8; ++j) ss += vq[j] * vq[j];
            ss = wave_sum(ss);
            const float r = rsqrtf(ss * (1.f / 512.f) + 1e-6f);
#pragma unroll
            for (int j = 0; j < 8; ++j) p->cqn[(size_t)t * 512 + lane + 64 * j] = f2bf(vq[j] * r * qn[j]);
        }
        {
            float ss = 0.f;
#pragma unroll
            for (int j = 0; j < 4; ++j) ss += vkv[j] * vkv[j];
            ss = wave_sum(ss);
            const float r = rsqrtf(ss * (1.f / 256.f) + 1e-6f);
#pragma unroll
            for (int j = 0; j < 4; ++j) p->ckvn[(size_t)t * 256 + lane + 64 * j] = f2bf(vkv[j] * r * kn[j]);
        }
        p->kpe[(size_t)t * 64 + lane] = f2bf(lane < 32 ? kx1 * c32 - kx2 * s32 : kx1 * s32 + kx2 * c32);
#pragma unroll
        for (int j = 0; j < 16; ++j) {
            const int d = (lane + 64 * j) & 127;
            const float m1 = d < 16 ? c16 : (d < 32 ? s16 : 1.f), m2 = d < 16 ? -s16 : (d < 32 ? c16 : 0.f);
            p->qb[(size_t)t * 1024 + lane + 64 * j] = f2bf((q1[j] * m1 + q2[j] * m2) * qscale);
        }
#pragma unroll
        for (int j = 0; j < 4; ++j) {
            const int d = (lane + 64 * j) & 127;
            const float m1 = d < 16 ? c16 : (d < 32 ? s16 : 1.f), m2 = d < 16 ? -s16 : (d < 32 ? c16 : 0.f);
            p->kb[(size_t)t * 256 + lane + 64 * j] = f2bf(k1[j] * m1 + k2[j] * m2);
            p->vb[(size_t)t * 256 + lane + 64 * j] = f2bf(vv[j]);
        }
        {
            const float m1 = lane < 8 ? c8 : (lane < 16 ? s8 : 1.f), m2 = lane < 8 ? -s8 : (lane < 16 ? c8 : 0.f);
#pragma unroll
            for (int j = 0; j < 16; ++j) p->iqb[(size_t)t * 1024 + lane + 64 * j] = f2bf(iq1[j] * m1 + iq2[j] * m2);
            p->ikb[(size_t)t * 64 + lane] = f2bf(ik1 * m1 + ik2 * m2);
        }
        if (lane < 16) p->iwf[t * 16 + lane] = iwv * 0.03125f;
    }
#undef h_
}

struct CS8 { f32x4 c, s; };
struct EpiQa {
    u16* C; const float* ca; const float* sa; int row0, col0;
    __device__ __forceinline__ void operator()(Acc& acc, unsigned char* stg) const {
        const float sc = 0.07216878364870323f * LOG2E_;
        const int rb = row0 + WR0_, cbase = col0 + WC0_;
        const bool rope = (cbase % 192) == 128;
        u16* Cp = C; const float* cap = ca; const float* sap = sa;
        stage_pairs_pre<CS8>(acc, stg,
            [=](int r, int c4) -> CS8 {
                CS8 t; t.c = (f32x4){1.f, 1.f, 1.f, 1.f}; t.s = (f32x4){0.f, 0.f, 0.f, 0.f};
                if (rope) { t.c = *(const f32x4*)(cap + (rb + r) * 32 + c4); t.s = *(const f32x4*)(sap + (rb + r) * 32 + c4); }
                return t; },
            [=](int r, int c4, f32x4 lo, f32x4 hi, CS8 t) {
                const int tt = rb + r;
                const f32x4 a = lo * t.c - hi * t.s, b = lo * t.s + hi * t.c;
                *(u32x2*)(Cp + (size_t)tt * 1536 + cbase + c4) = pack4(a * sc);
                *(u32x2*)(Cp + (size_t)tt * 1536 + cbase + c4 + 32) = pack4(b * sc); });
    }
};
struct EpiKva {
    u16* ka; u16* vaT; int row0, col0;
    __device__ __forceinline__ void operator()(Acc& acc, unsigned char* stg) const {
        const int cbase = col0 + WC0_;
        const int hd = cbase >> 8, within = cbase & 255;
        if (within < 128) {
            const int rb = row0 + WR0_;
            u16* kp = ka + hd * 128 + within;
            stage_rows(acc, stg, [=](int r, int c4, f32x4 v) { *(u32x2*)(kp + (size_t)(rb + r) * 1024 + c4) = pack4(v); });
        } else {
            const int lane = ltid() & 63, fr = lane & 15, fq = lane >> 4;
#pragma unroll
            for (int m = 0; m < 4; ++m) {
                const int r = row0 + WR0_ + m * 16 + fq * 4;
#pragma unroll
                for (int n = 0; n < 4; ++n) {
                    const int c = within - 128 + n * 16 + fr;
                    u32x2 o; o.x = pack2(acc[m][n][0], acc[m][n][1]); o.y = pack2(acc[m][n][2], acc[m][n][3]);
                    *(u32x2*)(vaT + (size_t)(hd * 128 + c) * T_ + r) = o;
                }
            }
        }
    }
};

__device__ __forceinline__ void indexer_tile(KP p, int qt, int kt) {
    const int lane = ltid() & 63, wid = (ltid() >> 6) & 3;
    const int wr = wid >> 1, wc = wid & 1, fr = lane & 15, fq = lane >> 4;
    const int k0 = kt * 128 + wr * 64, q0 = qt * 128 + wc * 64;
    bf16x8 af[4][2];
#pragma unroll
    for (int m = 0; m < 4; ++m)
#pragma unroll
        for (int ks = 0; ks < 2; ++ks)
            af[m][ks] = *(const bf16x8*)(p->ikb + (size_t)(k0 + m * 16 + fr) * 64 + ks * 32 + fq * 8);
    Acc sc; acc_zero(sc);
    for (int h = 0; h < 16; ++h) {
        bf16x8 bq[4][2]; float w[4];
#pragma unroll
        for (int n = 0; n < 4; ++n) {
            const size_t qrow = (size_t)(q0 + n * 16 + fr);
            bq[n][0] = *(const bf16x8*)(p->iqb + qrow * 1024 + h * 64 + fq * 8);
            bq[n][1] = *(const bf16x8*)(p->iqb + qrow * 1024 + h * 64 + 32 + fq * 8);
            w[n] = p->iwf[qrow * 16 + h];
        }
#pragma unroll
        for (int m = 0; m < 4; ++m)
#pragma unroll
            for (int n = 0; n < 4; ++n) {
                f32x4 d = (f32x4){0.f, 0.f, 0.f, 0.f};
                d = __builtin_amdgcn_mfma_f32_16x16x32_bf16(af[m][0], bq[n][0], d, 0, 0, 0);
                d = __builtin_amdgcn_mfma_f32_16x16x32_bf16(af[m][1], bq[n][1], d, 0, 0, 0);
#pragma unroll
                for (int j = 0; j < 4; ++j) sc[m][n][j] += w[n] * fmaxf(d[j], 0.f);
            }
    }
#pragma unroll
    for (int m = 0; m < 4; ++m)
#pragma unroll
        for (int n = 0; n < 4; ++n)
            *(f32x4*)(p->scores + (size_t)(q0 + n * 16 + fr) * T_ + k0 + m * 16 + fq * 4) = sc[m][n];
}

__device__ __forceinline__ void indexer_item(KP p, int g) {
    const int lane = ltid() & 63, wid = __builtin_amdgcn_readfirstlane(ltid() >> 6);
    const int fr = lane & 15, fq = lane >> 4;
    const int q0 = g * 16, nkb = g + 1;
    bf16x8 bq[16][2]; float w[16];
    {
        const u16* qrow = p->iqb + (size_t)(q0 + fr) * 1024 + fq * 8;
#pragma unroll
        for (int h = 0; h < 16; ++h) { bq[h][0] = *(const bf16x8*)(qrow + h * 64); bq[h][1] = *(const bf16x8*)(qrow + h * 64 + 32); }
        const float* wrow = p->iwf + (size_t)(q0 + fr) * 16;
#pragma unroll
        for (int h4 = 0; h4 < 4; ++h4) {
            const f32x4 wv = *(const f32x4*)(wrow + h4 * 4);
#pragma unroll
            for (int j = 0; j < 4; ++j) w[h4 * 4 + j] = wv[j];
        }
    }
    const u16* kbase = p->ikb + (size_t)fr * 64 + fq * 8;
    float* srow = p->scores + (size_t)(q0 + fr) * T_ + 4 * fq;
#define IDX_LOAD(A, kb_) do { const int kc_ = (kb_) < nkb ? (kb_) : nkb - 1; \
        A[0] = *(const bf16x8*)(kbase + (size_t)kc_ * 1024); A[1] = *(const bf16x8*)(kbase + (size_t)kc_ * 1024 + 32); } while (0)
#define IDX_COMP(A, kb_) do { if ((kb_) < nkb) { \
        f32x4 sc_ = (f32x4){0.f, 0.f, 0.f, 0.f}; \
        _Pragma("unroll") for (int h = 0; h < 16; ++h) { \
            f32x4 d_ = (f32x4){0.f, 0.f, 0.f, 0.f}; \
            d_ = __builtin_amdgcn_mfma_f32_16x16x32_bf16(A[0], bq[h][0], d_, 0, 0, 0); \
            d_ = __builtin_amdgcn_mfma_f32_16x16x32_bf16(A[1], bq[h][1], d_, 0, 0, 0); \
            _Pragma("unroll") for (int j = 0; j < 4; ++j) sc_[j] += w[h] * fmaxf(d_[j], 0.f); } \
        *(f32x4*)(srow + (size_t)(kb_) * 16) = sc_; } } while (0)
    bf16x8 a0[2], a1[2], a2[2], a3[2];
    int kb = wid;
    IDX_LOAD(a0, kb); IDX_LOAD(a1, kb + 8); IDX_LOAD(a2, kb + 16); IDX_LOAD(a3, kb + 24);
    for (; kb < nkb; kb += 32) {
        IDX_COMP(a0, kb); IDX_LOAD(a0, kb + 32);
        IDX_COMP(a1, kb + 8); IDX_LOAD(a1, kb + 40);
        IDX_COMP(a2, kb + 16); IDX_LOAD(a2, kb + 48);
        IDX_COMP(a3, kb + 24); IDX_LOAD(a3, kb + 56);
    }
#undef IDX_LOAD
#undef IDX_COMP
}

__device__ __forceinline__ unsigned fkey(float f) {
    const unsigned u = __float_as_uint(f);
    return (u & 0x80000000u) ? ~u : (u | 0x80000000u);
}
#define TOPK_WLDS (1024 * 4 + 1024 * 2)
__device__ __forceinline__ void ph_topk(KP p, unsigned char* smem) {
    const int lane0 = ltid() & 63, wid = ltid() >> 6;
    const int gw = __builtin_amdgcn_readfirstlane((blockIdx.x * NT + ltid()) >> 6), nw = (gridDim.x * NT) >> 6;
    unsigned* ckey = (unsigned*)(smem + wid * TOPK_WLDS);
    u16* cidx = (u16*)(smem + wid * TOPK_WLDS + 4096);
    for (int qq = gw; qq < T_ / 2; qq += nw)
    for (int sside = 0; sside < 2; ++sside) {
        int lane = lane0; asm volatile("" : "+v"(lane));
        const int q = sside ? (T_ - 1 - qq) : qq;
        u16* so = p->sel + (size_t)q * 256;
        if (q < 256) {
#pragma unroll
            for (int i = 0; i < 4; ++i) { const int s = lane + 64 * i; so[s] = (u16)(s <= q ? s : 0); }
            continue;
        }
        const int ng = (q >> 10) + 1;
        unsigned key[128];
        const float* row = p->scores + (size_t)q * T_;
        unsigned gm[4] = {0u, 0u, 0u, 0u};
        const int qml = q - lane;
#pragma unroll
        for (int g = 0; g < 8; ++g) {
            if (g < ng) {
                const float* rg = row + g * 1024 + lane;
#pragma unroll
                for (int i = 0; i < 16; ++i) {
                    const unsigned kx = fkey(rg[64 * i]) & ~(unsigned)((qml - 64 * (g * 16 + i)) >> 31);
                    key[g * 16 + i] = kx;
                    gm[i & 3] = kx > gm[i & 3] ? kx : gm[i & 3];
                }
            } else {
#pragma unroll
                for (int i = 0; i < 16; ++i) key[g * 16 + i] = 0u;
            }
        }
        unsigned Lk = gm[0] < gm[1] ? gm[0] : gm[1], Mk = gm[0] > gm[1] ? gm[0] : gm[1];
        { const unsigned l2 = gm[2] < gm[3] ? gm[2] : gm[3], m2 = gm[2] > gm[3] ? gm[2] : gm[3];
          Lk = Lk < l2 ? Lk : l2; Mk = Mk > m2 ? Mk : m2; }
#pragma unroll
        for (int o = 32; o > 0; o >>= 1) {
            const unsigned lo_ = (unsigned)__shfl_xor((int)Lk, o), mo_ = (unsigned)__shfl_xor((int)Mk, o);
            Lk = Lk < lo_ ? Lk : lo_; Mk = Mk > mo_ ? Mk : mo_;
        }
        Lk = (unsigned)__builtin_amdgcn_readfirstlane((int)Lk); Mk = (unsigned)__builtin_amdgcn_readfirstlane((int)Mk);
        unsigned prefix = 0u;
        int C = q + 1, b = 31;
        bool exact = false;
        if (Lk == Mk) { prefix = Mk; b = -1; }
        else { b = 31 - __builtin_clz(Lk ^ Mk); prefix = Mk & ~((2u << b) - 1u); }
        if (b < 31) {
            int cnt = 0;
#pragma unroll
            for (int g = 0; g < 8; ++g) {
                if (g < ng) {
#pragma unroll
                    for (int i = 0; i < 16; ++i) cnt += __builtin_popcountll(__ballot(key[g * 16 + i] >= prefix));
                }
            }
            C = cnt;
            if (cnt == 256) { exact = true; b = -1; }
        }
        for (; b >= 0 && C > 1024; --b) {
            const unsigned cand = prefix | (1u << b);
            int cnt = 0;
#pragma unroll
            for (int g = 0; g < 8; ++g) {
                if (g < ng) {
#pragma unroll
                    for (int i = 0; i < 16; ++i) cnt += __builtin_popcountll(__ballot(key[g * 16 + i] >= cand));
                }
            }
            if (cnt >= 256) { prefix = cand; C = cnt; }
            if (cnt == 256) { exact = true; --b; break; }
        }
        if (C > 1024) {
            int wp = 0;
#pragma unroll
            for (int g = 0; g < 8; ++g) {
                if (g < ng) {
#pragma unroll
                    for (int i = 0; i < 16; ++i) {
                        const bool gt = key[g * 16 + i] > prefix;
                        const unsigned long long m = __ballot(gt);
                        if (gt) so[wp + (int)__builtin_amdgcn_mbcnt_hi((unsigned)(m >> 32), __builtin_amdgcn_mbcnt_lo((unsigned)m, 0u))] = (u16)(lane + 64 * (g * 16 + i));
                        wp += __builtin_popcountll(m);
                    }
                }
            }
#pragma unroll
            for (int g = 0; g < 8; ++g) {
                if (g < ng && wp < 256) {
#pragma unroll
                    for (int i = 0; i < 16; ++i) {
                        const bool eq = key[g * 16 + i] == prefix && (lane + 64 * (g * 16 + i)) <= q;
                        const unsigned long long m = __ballot(eq);
                        if (eq) {
                            const int pos = wp + (int)__builtin_amdgcn_mbcnt_hi((unsigned)(m >> 32), __builtin_amdgcn_mbcnt_lo((unsigned)m, 0u));
                            if (pos < 256) so[pos] = (u16)(lane + 64 * (g * 16 + i));
                        }
                        wp += __builtin_popcountll(m);
                    }
                }
            }
            continue;
        }
        int base = 0;
#pragma unroll
        for (int g = 0; g < 8; ++g) {
            if (g < ng) {
#pragma unroll
                for (int i = 0; i < 16; ++i) {
                    const bool ge = key[g * 16 + i] >= prefix && (lane + 64 * (g * 16 + i)) <= q;
                    const unsigned long long m = __ballot(ge);
                    if (ge) {
                        const int pos = base + (int)__builtin_amdgcn_mbcnt_hi((unsigned)(m >> 32), __builtin_amdgcn_mbcnt_lo((unsigned)m, 0u));
                        ckey[pos] = key[g * 16 + i]; cidx[pos] = (u16)(lane + 64 * (g * 16 + i));
                    }
                    base += __builtin_popcountll(m);
                }
            }
        }
        __builtin_amdgcn_s_waitcnt(0xc07f);
        unsigned ck[16];
#pragma unroll
        for (int i = 0; i < 16; ++i) {
            const int s = lane + 64 * i;
            ck[i] = s < base ? ckey[s] : 0u;
        }
        if (!exact) {
            for (; b >= 0; --b) {
                const unsigned cand = prefix | (1u << b);
                int cnt = 0;
#pragma unroll
                for (int i = 0; i < 16; ++i) cnt += __builtin_popcountll(__ballot(ck[i] >= cand));
                if (cnt >= 256) prefix = cand;
                if (cnt == 256) break;
            }
        }
        int wpos = 0;
#pragma unroll
        for (int i = 0; i < 16; ++i) {
            const bool gt = ck[i] > prefix;
            const unsigned long long m = __ballot(gt);
            if (gt) so[wpos + (int)__builtin_amdgcn_mbcnt_hi((unsigned)(m >> 32), __builtin_amdgcn_mbcnt_lo((unsigned)m, 0u))] = cidx[lane + 64 * i];
            wpos += __builtin_popcountll(m);
        }
#pragma unroll
        for (int i = 0; i < 16; ++i) {
            if (wpos < 256) {
                const bool eq = ck[i] == prefix && (lane + 64 * i) < base;
                const unsigned long long m = __ballot(eq);
                if (eq) {
                    const int pos = wpos + (int)__builtin_amdgcn_mbcnt_hi((unsigned)(m >> 32), __builtin_amdgcn_mbcnt_lo((unsigned)m, 0u));
                    if (pos < 256) so[pos] = cidx[lane + 64 * i];
                }
                wpos += __builtin_popcountll(m);
            }
        }
        __builtin_amdgcn_s_waitcnt(0xc07f);
    }
}

#define KROW 208
#define VROW 80
#define ATT_LDS_BYTES (64 * KROW * 2 + 128 * VROW * 2)

__device__ __forceinline__ void mla_item(KP p, int h, int qb, u16* lds, int seg) {
    const int tid = ltid(), lane = tid & 63, wid = tid >> 6, fr = lane & 15, fq = lane >> 4;
    u16* sK = lds;
    u16* sV = lds + 64 * KROW;
    const int q0 = qb * 256;
    bf16x8 qf[2][6];
#pragma unroll
    for (int nq = 0; nq < 2; ++nq)
#pragma unroll
        for (int kc = 0; kc < 6; ++kc)
            qf[nq][kc] = *(const bf16x8*)(p->qa + (size_t)(q0 + wid * 32 + nq * 16 + fr) * 1536 + h * 192 + kc * 32 + fq * 8);
    f32x4 O[8][2];
#pragma unroll
    for (int m = 0; m < 8; ++m) { O[m][0] = (f32x4){0.f, 0.f, 0.f, 0.f}; O[m][1] = (f32x4){0.f, 0.f, 0.f, 0.f}; }
    float mrun[2] = {-1e30f, -1e30f}, lrun[2] = {0.f, 0.f};

    const int k0t = tid >> 4, k1t = tid >> 3;
    const u16* kpn = p->ka + (size_t)k0t * 1024 + h * 128 + (tid & 15) * 8;
    const u16* kpr = p->kpe + (size_t)k1t * 64 + (tid & 7) * 8;
    const u16* vpp = p->vaT + (size_t)(h * 128 + k1t) * T_ + (tid & 7) * 8;
    const int kln = (((k0t >> 2) & 1) * 16 + (k0t >> 3) * 4 + (k0t & 3)) * KROW + (tid & 15) * 8;
    const int e1 = k1t & 31;
    const int klr = ((k1t >> 5) * 32 + ((e1 >> 2) & 1) * 16 + (e1 >> 3) * 4 + (e1 & 3)) * KROW + 128 + (tid & 7) * 8;
    const int vl0 = k1t * VROW + (tid & 7) * 8;
    u32x4 kreg[3], vreg[2];
    const int ntiles = 4 * qb + 4;
    const int kt_lo = seg == 1 ? ntiles / 2 : 0, kt_hi = seg == 0 ? ntiles / 2 : ntiles;
#define ATT_GLOAD(kt) do { \
    _Pragma("unroll") for (int i = 0; i < 2; ++i) kreg[i] = *(const u32x4*)(kpn + (size_t)((kt) * 64 + 32 * i) * 1024); \
    kreg[2] = *(const u32x4*)(kpr + (size_t)((kt) * 64) * 64); \
    _Pragma("unroll") for (int i = 0; i < 2; ++i) vreg[i] = *(const u32x4*)(vpp + (size_t)(64 * i) * T_ + (kt) * 64); } while (0)
#define ATT_LWRITE(buf) do { \
        u16* sK_ = lds + (buf) * (ATT_LDS_BYTES / 2); u16* sV_ = sK_ + 64 * KROW; \
        _Pragma("unroll") for (int i = 0; i < 2; ++i) *(u32x4*)(sK_ + kln + 32 * i * KROW) = kreg[i]; \
        *(u32x4*)(sK_ + klr) = kreg[2]; \
        _Pragma("unroll") for (int i = 0; i < 2; ++i) *(u32x4*)(sV_ + vl0 + 64 * i * VROW) = vreg[i]; } while (0)
    ATT_GLOAD(kt_lo);
    __syncthreads();
    ATT_LWRITE(0);
    if (kt_lo + 1 < kt_hi) ATT_GLOAD(kt_lo + 1);
    __syncthreads();
    for (int kt = kt_lo; kt < kt_hi; ++kt) {
        const int cb = (kt - kt_lo) & 1;
        sK = lds + cb * (ATT_LDS_BYTES / 2);
        sV = sK + 64 * KROW;
        if (kt * 64 > q0 + wid * 32 + 31) {
            if (kt + 1 < kt_hi) ATT_LWRITE(cb ^ 1);
            if (kt + 2 < kt_hi) ATT_GLOAD(kt + 2);
            __syncthreads(); continue;
        }
        f32x4 s[2][4];
#pragma unroll
        for (int n = 0; n < 4; ++n) { s[0][n] = (f32x4){0.f, 0.f, 0.f, 0.f}; s[1][n] = (f32x4){0.f, 0.f, 0.f, 0.f}; }
#pragma unroll
        for (int kc = 0; kc < 6; ++kc)
#pragma unroll
            for (int n = 0; n < 4; ++n) {
                const bf16x8 a = *(const bf16x8*)(sK + (n * 16 + fr) * KROW + kc * 32 + fq * 8);
                s[0][n] = __builtin_amdgcn_mfma_f32_16x16x32_bf16(a, qf[0][kc], s[0][n], 0, 0, 0);
                s[1][n] = __builtin_amdgcn_mfma_f32_16x16x32_bf16(a, qf[1][kc], s[1][n], 0, 0, 0);
            }
        if (kt + 1 < kt_hi) ATT_LWRITE(cb ^ 1);
        if (kt + 2 < kt_hi) ATT_GLOAD(kt + 2);
        if (kt >= ntiles - 4) {
#pragma unroll
            for (int nq = 0; nq < 2; ++nq) {
                const int qi = q0 + wid * 32 + nq * 16 + fr;
#pragma unroll
                for (int n = 0; n < 4; ++n)
#pragma unroll
                    for (int j = 0; j < 4; ++j) {
                        const int ki = kt * 64 + (n >> 1) * 32 + fq * 8 + (n & 1) * 4 + j;
                        if (ki > qi) s[nq][n][j] = -1e30f;
                    }
            }
        }
        bf16x8 pf[2][2];
#pragma unroll
        for (int nq = 0; nq < 2; ++nq) {
            float mx = -1e30f;
#pragma unroll
            for (int n = 0; n < 4; ++n)
#pragma unroll
                for (int j = 0; j < 4; ++j) mx = fmaxf(mx, s[nq][n][j]);
            mx = fmaxf(mx, __shfl_xor(mx, 16));
            mx = fmaxf(mx, __shfl_xor(mx, 32));
            const float mnew = fmaxf(mrun[nq], mx);
            const float al = __builtin_amdgcn_exp2f(mrun[nq] - mnew);
            mrun[nq] = mnew;
            float ps = 0.f;
#pragma unroll
            for (int n = 0; n < 4; ++n)
#pragma unroll
                for (int j = 0; j < 4; ++j) { const float e = __builtin_amdgcn_exp2f(s[nq][n][j] - mnew); s[nq][n][j] = e; ps += e; }
            lrun[nq] = lrun[nq] * al + ps;
            if (__ballot(al != 1.0f) != 0ull) {
#pragma unroll
                for (int m = 0; m < 8; ++m) O[m][nq] *= al;
            }
#pragma unroll
            for (int c = 0; c < 2; ++c) {
                u32x4 w;
                w.x = pack2(s[nq][2 * c][0], s[nq][2 * c][1]);
                w.y = pack2(s[nq][2 * c][2], s[nq][2 * c][3]);
                w.z = pack2(s[nq][2 * c + 1][0], s[nq][2 * c + 1][1]);
                w.w = pack2(s[nq][2 * c + 1][2], s[nq][2 * c + 1][3]);
                pf[nq][c] = *(bf16x8*)&w;
            }
        }
#pragma unroll
        for (int m = 0; m < 8; ++m)
#pragma unroll
            for (int c = 0; c < 2; ++c) {
                const bf16x8 a = *(const bf16x8*)(sV + (m * 16 + fr) * VROW + c * 32 + fq * 8);
                O[m][0] = __builtin_amdgcn_mfma_f32_16x16x32_bf16(a, pf[0][c], O[m][0], 0, 0, 0);
                O[m][1] = __builtin_amdgcn_mfma_f32_16x16x32_bf16(a, pf[1][c], O[m][1], 0, 0, 0);
            }
        __syncthreads();
    }
#undef ATT_GLOAD
#undef ATT_LWRITE
#pragma unroll
    for (int nq = 0; nq < 2; ++nq) {
        float l = lrun[nq];
        l += __shfl_xor(l, 16);
        l += __shfl_xor(l, 32);
        const int qi = q0 + wid * 32 + nq * 16 + fr;
        if (seg < 0) {
            const float il = 1.f / l;
#pragma unroll
            for (int m = 0; m < 8; ++m) {
                u32x2 o;
                o.x = pack2(O[m][nq][0] * il, O[m][nq][1] * il);
                o.y = pack2(O[m][nq][2] * il, O[m][nq][3] * il);
                *(u32x2*)(p->outcat + (size_t)qi * 2048 + h * 128 + m * 16 + fq * 4) = o;
            }
        } else {
            const size_t slot = (size_t)((h * 16 + (qb - 16)) * 2 + seg);
            float* po = p->mla_po + (slot * 256 + (qi - q0)) * 128;
#pragma unroll
            for (int m = 0; m < 8; ++m) *(f32x4*)(po + m * 16 + fq * 4) = O[m][nq];
            if (fq == 0) { p->mla_ml[(slot * 256 + (qi - q0)) * 2] = mrun[nq]; p->mla_ml[(slot * 256 + (qi - q0)) * 2 + 1] = l; }
        }
    }
}

__device__ __forceinline__ void ph_mla_merge(KP p) {
    const int gtid = blockIdx.x * NT + ltid(), gsz = gridDim.x * NT;
    for (int i = gtid; i < 128 * 256 * 32; i += gsz) {
        const int d4 = i & 31, qq = (i >> 5) & 255, item = i >> 13;
        const int h = item >> 4, qb = 16 + (item & 15);
        const size_t s0 = (size_t)(item * 2) * 256 + qq, s1 = s0 + 256;
        const float m0 = p->mla_ml[s0 * 2], l0 = p->mla_ml[s0 * 2 + 1], m1 = p->mla_ml[s1 * 2], l1 = p->mla_ml[s1 * 2 + 1];
        const float m = fmaxf(m0, m1);
        const float w0 = __builtin_amdgcn_exp2f(m0 - m), w1 = __builtin_amdgcn_exp2f(m1 - m);
        const float il = 1.f / (l0 * w0 + l1 * w1);
        const f32x4 a = *(const f32x4*)(p->mla_po + s0 * 128 + d4 * 4), b = *(const f32x4*)(p->mla_po + s1 * 128 + d4 * 4);
        const f32x4 o = (a * w0 + b * w1) * il;
        *(u32x2*)(p->outcat + (size_t)(qb * 256 + qq) * 2048 + h * 128 + d4 * 4) = pack4(o);
    }
}

#define DSA_WLDS 5632
__device__ __forceinline__ void dsa_task(KP p, int q, int g, unsigned char* wl) {
    const int lane = ltid() & 63;
    u16* sQ = (u16*)wl;
    float* sP = (float*)(wl + 1024);
    u16* sS = (u16*)(wl + 1024 + 4096);
    const int nsel = q < 255 ? q + 1 : 256;
    {
        const u16* qsrc = p->qb + (size_t)q * 1024 + g * 512;
        *(u32x4*)(sQ + lane * 8) = *(const u32x4*)(qsrc + lane * 8);
        *(u32x2*)(sS + lane * 4) = *(const u32x2*)(p->sel + (size_t)q * 256 + lane * 4);
    }
    __builtin_amdgcn_s_waitcnt(0);
    float sc[4][4];
    float mx[4] = {-1e30f, -1e30f, -1e30f, -1e30f};
#pragma unroll
    for (int r = 0; r < 4; ++r) {
        const int slot = lane + 64 * r;
        float a0 = 0.f, a1 = 0.f, a2 = 0.f, a3 = 0.f;
        if (slot < nsel) {
            const int ki = sS[slot];
            const u16* kr = p->kb + (size_t)ki * 256 + g * 128;
#pragma unroll
            for (int c = 0; c < 16; ++c) {
                const u32x4 kv = *(const u32x4*)(kr + c * 8);
                const u32x4 q0v = *(const u32x4*)(sQ + 0 * 128 + c * 8);
                const u32x4 q1v = *(const u32x4*)(sQ + 1 * 128 + c * 8);
                const u32x4 q2v = *(const u32x4*)(sQ + 2 * 128 + c * 8);
                const u32x4 q3v = *(const u32x4*)(sQ + 3 * 128 + c * 8);
#pragma unroll
                for (int e = 0; e < 4; ++e) {
                    const unsigned kk = kv[e];
                    const bf16x2_t kb2 = *(const bf16x2_t*)&kk;
                    unsigned t0 = q0v[e], t1 = q1v[e], t2 = q2v[e], t3 = q3v[e];
                    a0 = __builtin_amdgcn_fdot2_f32_bf16(kb2, *(const bf16x2_t*)&t0, a0, false);
                    a1 = __builtin_amdgcn_fdot2_f32_bf16(kb2, *(const bf16x2_t*)&t1, a1, false);
                    a2 = __builtin_amdgcn_fdot2_f32_bf16(kb2, *(const bf16x2_t*)&t2, a2, false);
                    a3 = __builtin_amdgcn_fdot2_f32_bf16(kb2, *(const bf16x2_t*)&t3, a3, false);
                }
            }
        } else { a0 = a1 = a2 = a3 = -1e30f; }
        sc[r][0] = a0; sc[r][1] = a1; sc[r][2] = a2; sc[r][3] = a3;
        mx[0] = fmaxf(mx[0], a0); mx[1] = fmaxf(mx[1], a1); mx[2] = fmaxf(mx[2], a2); mx[3] = fmaxf(mx[3], a3);
    }
    float ls[4];
#pragma unroll
    for (int hh = 0; hh < 4; ++hh) {
        const float m = wave_max(mx[hh]);
        float s = 0.f;
#pragma unroll
        for (int r = 0; r < 4; ++r) { const float e = exp2f(sc[r][hh] - m); sc[r][hh] = e; s += e; }
        ls[hh] = wave_sum(s);
    }
#pragma unroll
    for (int r = 0; r < 4; ++r) {
        f32x4 pv = {sc[r][0], sc[r][1], sc[r][2], sc[r][3]};
        *(f32x4*)(sP + (lane + 64 * r) * 4) = pv;
    }
    __builtin_amdgcn_s_waitcnt(0);
    float o[4][8];
#pragma unroll
    for (int hh = 0; hh < 4; ++hh)
#pragma unroll
        for (int d = 0; d < 8; ++d) o[hh][d] = 0.f;
    const int kg = lane >> 4, dc = lane & 15;
    const u16* vbase = p->vb + g * 128 + dc * 8;
    const int nit = (nsel + 3) >> 2;
    for (int it = 0; it < nit; it += 4) {
        u32x4 vv[4]; f32x4 pp[4];
#pragma unroll
        for (int u = 0; u < 4; ++u) {
            if (it + u < nit) {
                const int slot = (it + u) * 4 + kg;
                const int ki = sS[slot];
                vv[u] = *(const u32x4*)(vbase + (size_t)ki * 256);
                pp[u] = *(const f32x4*)(sP + slot * 4);
            } else { vv[u] = (u32x4){0u, 0u, 0u, 0u}; pp[u] = (f32x4){0.f, 0.f, 0.f, 0.f}; }
        }
#pragma unroll
        for (int u = 0; u < 4; ++u)
#pragma unroll
            for (int e = 0; e < 4; ++e) {
                const float v0 = __uint_as_float(vv[u][e] << 16), v1 = __uint_as_float(vv[u][e] & 0xffff0000u);
#pragma unroll
                for (int hh = 0; hh < 4; ++hh) { o[hh][2 * e] += pp[u][hh] * v0; o[hh][2 * e + 1] += pp[u][hh] * v1; }
            }
    }
#pragma unroll
    for (int hh = 0; hh < 4; ++hh)
#pragma unroll
        for (int d = 0; d < 8; ++d) {
            float v = o[hh][d];
            v += __shfl_xor(v, 16);
            v += __shfl_xor(v, 32);
            o[hh][d] = v;
        }
    if (kg == 0) {
#pragma unroll
        for (int hh = 0; hh < 4; ++hh) {
            const float il = 1.f / ls[hh];
            u32x4 w;
            w.x = pack2(o[hh][0] * il, o[hh][1] * il); w.y = pack2(o[hh][2] * il, o[hh][3] * il);
            w.z = pack2(o[hh][4] * il, o[hh][5] * il); w.w = pack2(o[hh][6] * il, o[hh][7] * il);
            *(u32x4*)(p->outcat + (size_t)q * 2048 + 1024 + (g * 4 + hh) * 128 + dc * 8) = w;
        }
    }
    __builtin_amdgcn_s_waitcnt(0);
}

#define DSA2_WLDS (8192 + 512)
__device__ __forceinline__ void dsa_task2(KP p, int q, unsigned char* wl, u16* outp, int ldo, int coff) {
    const int lane = ltid() & 63, fr = lane & 15, fq = lane >> 4;
    unsigned char* sV = wl;
    u16* sS = (u16*)(wl + 8192);
    const int nsel = q < 255 ? q + 1 : 256;
    *(u32x2*)(sS + lane * 4) = *(const u32x2*)(p->sel + (size_t)q * 256 + lane * 4);
    const int vch = lane & 15, vr0 = lane >> 4;
    int rdo[2];
#pragma unroll
    for (int t = 0; t < 2; ++t) rdo[t] = (8 * fq + 4 * t + (fr >> 2)) * 256 + 8 * (fr & 1);
    const int xr0 = ((fr >> 2) << 2) | ((2 * fq) & 3), xr1 = ((fr >> 2) << 2) | ((2 * fq + 1) & 3);
    const int hsel = (fr & 3) >> 1;
    __builtin_amdgcn_s_waitcnt(0);
#pragma unroll 1
    for (int g = 0; g < 2; ++g) {
        bf16x8 qf[4];
#pragma unroll
        for (int c = 0; c < 4; ++c) {
            u32x4 v = (u32x4){0u, 0u, 0u, 0u};
            if (fr < 4) v = *(const u32x4*)(p->qb + (size_t)q * 1024 + (g * 4 + fr) * 128 + c * 32 + fq * 8);
            qf[c] = *(bf16x8*)&v;
        }
        f32x4 O[8];
#pragma unroll
        for (int cc = 0; cc < 8; ++cc) O[cc] = (f32x4){0.f, 0.f, 0.f, 0.f};
        float mrun = -1e30f, lrun = 0.f;
        const int nstep = (nsel + 31) >> 5;
        bf16x8 fa0[4], fb0[4], fa1[4], fb1[4];
        u32x4 vv0[8], vv1[8];
#define DSA_LOAD(c, FA, FB, VV) do { \
            const int ka_ = sS[32 * (c) + fr], kb_ = sS[32 * (c) + 16 + fr]; \
            const u16* kra = p->kb + (size_t)ka_ * 256 + g * 128 + fq * 8; \
            const u16* krb = p->kb + (size_t)kb_ * 256 + g * 128 + fq * 8; \
            _Pragma("unroll") for (int cc = 0; cc < 4; ++cc) { FA[cc] = *(const bf16x8*)(kra + cc * 32); FB[cc] = *(const bf16x8*)(krb + cc * 32); } \
            _Pragma("unroll") for (int i = 0; i < 8; ++i) { \
                const int r = vr0 + 4 * i; \
                const int kv = sS[32 * (c) + 16 * ((r >> 2) & 1) + 4 * (r >> 3) + (r & 3)]; \
                VV[i] = *(const u32x4*)(p->vb + (size_t)kv * 256 + g * 128 + vch * 8); } } while (0)
#define DSA_COMP(c, FA, FB, VV) do { \
            f32x4 s0 = (f32x4){0.f, 0.f, 0.f, 0.f}, s1 = (f32x4){0.f, 0.f, 0.f, 0.f}; \
            _Pragma("unroll") for (int cc = 0; cc < 4; ++cc) { \
                s0 = __builtin_amdgcn_mfma_f32_16x16x32_bf16(FA[cc], qf[cc], s0, 0, 0, 0); \
                s1 = __builtin_amdgcn_mfma_f32_16x16x32_bf16(FB[cc], qf[cc], s1, 0, 0, 0); } \
            float mx = -1e30f; \
            _Pragma("unroll") for (int j = 0; j < 4; ++j) { \
                if (32 * (c) + 4 * fq + j >= nsel) s0[j] = -1e30f; \
                if (32 * (c) + 16 + 4 * fq + j >= nsel) s1[j] = -1e30f; \
                mx = fmaxf(mx, fmaxf(s0[j], s1[j])); } \
            mx = fmaxf(mx, __shfl_xor(mx, 16)); \
            mx = fmaxf(mx, __shfl_xor(mx, 32)); \
            const float mnew = fmaxf(mrun, mx); \
            const float al = __builtin_amdgcn_exp2f(mrun - mnew); \
            mrun = mnew; \
            float ps = 0.f; \
            _Pragma("unroll") for (int j = 0; j < 4; ++j) { \
                s0[j] = __builtin_amdgcn_exp2f(s0[j] - mnew); s1[j] = __builtin_amdgcn_exp2f(s1[j] - mnew); \
                ps += s0[j] + s1[j]; } \
            lrun = lrun * al + ps; \
            if (__ballot(al != 1.0f) != 0ull) { _Pragma("unroll") for (int cc = 0; cc < 8; ++cc) O[cc] *= al; } \
            u32x4 pw; \
            pw.x = pack2(s0[0], s0[1]); pw.y = pack2(s0[2], s0[3]); pw.z = pack2(s1[0], s1[1]); pw.w = pack2(s1[2], s1[3]); \
            const bf16x8 pf = *(bf16x8*)&pw; \
            _Pragma("unroll") for (int i = 0; i < 8; ++i) { \
                const int r = vr0 + 4 * i; \
                *(u32x4*)(sV + r * 256 + 16 * (vch ^ (((r & 3) << 2) | ((r >> 2) & 3)))) = VV[i]; } \
            __builtin_amdgcn_s_waitcnt(0xc07f); \
            _Pragma("unroll") for (int cc = 0; cc < 8; ++cc) { \
                const s16x4 lo_ = __builtin_amdgcn_ds_read_tr16_b64_v4i16((LAS s16x4*)(sV + rdo[0] + 16 * ((2 * cc + hsel) ^ xr0))); \
                const s16x4 hi_ = __builtin_amdgcn_ds_read_tr16_b64_v4i16((LAS s16x4*)(sV + rdo[1] + 16 * ((2 * cc + hsel) ^ xr1))); \
                const bf16x8 vf = __builtin_shufflevector(lo_, hi_, 0, 1, 2, 3, 4, 5, 6, 7); \
                O[cc] = __builtin_amdgcn_mfma_f32_16x16x32_bf16(vf, pf, O[cc], 0, 0, 0); } \
            __builtin_amdgcn_s_waitcnt(0xc07f); } while (0)
        DSA_LOAD(0, fa0, fb0, vv0);
#pragma unroll 1
        for (int c = 0; c < nstep; c += 2) {
            const int c1 = c + 1 < nstep ? c + 1 : nstep - 1, c2 = c + 2 < nstep ? c + 2 : nstep - 1;
            DSA_LOAD(c1, fa1, fb1, vv1);
            DSA_COMP(c, fa0, fb0, vv0);
            DSA_LOAD(c2, fa0, fb0, vv0);
            if (c + 1 < nstep) DSA_COMP(c + 1, fa1, fb1, vv1);
        }
#undef DSA_LOAD
#undef DSA_COMP
        float l = lrun;
        l += __shfl_xor(l, 16);
        l += __shfl_xor(l, 32);
        if (fr < 4) {
            const float il = 1.f / l;
            u16* dst = outp + (size_t)q * ldo + coff + (g * 4 + fr) * 128 + 4 * fq;
#pragma unroll
            for (int cc = 0; cc < 8; ++cc) {
                u32x2 w; w.x = pack2(O[cc][0] * il, O[cc][1] * il); w.y = pack2(O[cc][2] * il, O[cc][3] * il);
                *(u32x2*)(dst + 16 * cc) = w;
            }
        }
    }
    __builtin_amdgcn_s_waitcnt(0);
}

#define ATT_NMLA 384
#define CVT_CHUNK (256 * 1024)
#define CVT_N_OUT0 16
#define CVT_N_IN1 96
#define CVT_N_OUT1 32
#define CVT_N_SH 8
#define ATT_NCVT (CVT_N_OUT0 + CVT_N_IN1 + CVT_N_OUT1 + 6 * CVT_N_SH)
template <int RMAP = 0>
__device__ __forceinline__ void cvtT_block(const float* src, u16* dst, int K, int N, int kb, int nb, unsigned char* smem) {
    const int tid = ltid();
    u16* t = (u16*)smem;
    __syncthreads();
#pragma unroll
    for (int i = 0; i < 8; ++i) {
        const int k = (tid >> 6) + 8 * i, n4 = (tid & 63) * 4;
        f32x4 v = (f32x4){0.f, 0.f, 0.f, 0.f};
        if (nb * 256 + n4 < N) v = *(const f32x4*)(src + (size_t)(kb * 64 + k) * N + nb * 256 + n4);
#pragma unroll
        for (int e = 0; e < 4; ++e) t[(n4 + e) * 72 + k] = f2bf(v[e]);
    }
    __syncthreads();
#pragma unroll
    for (int i = 0; i < 4; ++i) {
        const int n = (tid >> 3) + 64 * i, ch = tid & 7;
        const int drow = RMAP == 0 ? nb * 256 + n : 512 * nb + (n >> 7) * 256 + 128 * (RMAP - 1) + (n & 127);
        *(u32x4*)(dst + (size_t)drow * K + kb * 64 + ch * 8) = *(const u32x4*)(t + n * 72 + ch * 8);
    }
}
#define CVT_NT_OUT1 (64 * 8)
#define CVT_NT_OUT0 (32 * 8)
#define CVT_NT_IN1 (32 * 48)
#define CVT_NT_SHGU (32 * 4)
#define CVT_NT_SHD (16 * 8)
#define CVT_NT_SH (2 * CVT_NT_SHGU + CVT_NT_SHD)
__device__ __forceinline__ void cvt_item(KP p, int c, unsigned char* smem) {
    if (c >= ATT_NCVT) {
        int u = c - ATT_NCVT;
        if (u < CVT_NT_OUT1) { cvtT_block(p->w_out1, p->w_out1t, 4096, 2048, u >> 3, u & 7, smem); return; }
        u -= CVT_NT_OUT1;
        if (u < CVT_NT_OUT0) { cvtT_block(p->w_out0, p->w_out0t, 2048, 2048, u >> 3, u & 7, smem); return; }
        u -= CVT_NT_OUT0;
        if (u < CVT_NT_IN1) { cvtT_block(p->w_in1, p->w_in1t, 2048, IN_C, u / 48, u % 48, smem); return; }
        u -= CVT_NT_IN1;
        const int l = u / CVT_NT_SH; u -= l * CVT_NT_SH;
        if (u < CVT_NT_SHGU) { cvtT_block<1>(p->sh_g[l], p->sh_gut[l], 2048, 1024, u >> 2, u & 3, smem); return; }
        u -= CVT_NT_SHGU;
        if (u < CVT_NT_SHGU) { cvtT_block<2>(p->sh_u[l], p->sh_gut[l], 2048, 1024, u >> 2, u & 3, smem); return; }
        u -= CVT_NT_SHGU;
        cvtT_block(p->sh_d[l], p->sh_dt[l], 1024, 2048, u >> 3, u & 7, smem); return;
    }
    const float* src; u16* dst;
    if (c < CVT_N_OUT0) { return; }
    else if ((c -= CVT_N_OUT0) < CVT_N_IN1) { return; }
    else if ((c -= CVT_N_IN1) < CVT_N_OUT1) { return; }
    else {
        return;
        c -= CVT_N_OUT1;
        const int which = c / CVT_N_SH; c -= which * CVT_N_SH;
        const int l = which / 3, m = which % 3;
        src = m == 0 ? p->sh_g[l] : (m == 1 ? p->sh_u[l] : p->sh_d[l]);
        dst = m == 0 ? p->sh_gb[l] : (m == 1 ? p->sh_ub[l] : p->sh_db[l]);
    }
    const size_t base = (size_t)c * CVT_CHUNK;
    for (int i = ltid(); i < CVT_CHUNK / 8; i += NT) {
        const f32x4 a = *(const f32x4*)(src + base + (size_t)i * 8), b = *(const f32x4*)(src + base + (size_t)i * 8 + 4);
        u32x4 o; o.x = pack2(a[0], a[1]); o.y = pack2(a[2], a[3]); o.z = pack2(b[0], b[1]); o.w = pack2(b[2], b[3]);
        *(u32x4*)(dst + base + (size_t)i * 8) = o;
    }
}
__device__ const unsigned char mla_order[48] = {31, 63, 79, 30, 62, 29, 61, 78, 28, 60, 27, 59, 77, 26, 58, 25, 57, 76, 24, 56, 23, 55, 75, 22, 54, 21, 53, 74, 20, 52, 19, 51, 73, 18, 50, 17, 49, 72, 16, 48, 71, 70, 69, 68, 67, 66, 65, 64};
#define ATT_NTOTAL (ATT_NMLA + 512 + ATT_NCVT + CVT_NT_OUT1 + CVT_NT_OUT0 + CVT_NT_IN1 + 2 * CVT_NT_SH)
__device__ __forceinline__ void ph_attn(KP p, unsigned char* smem, unsigned* misc, int qword = CTL_QUEUE, int lo = 0, int hi = ATT_NTOTAL) {
    const int tid = ltid(), wid = tid >> 6;
    for (;;) {
        __syncthreads();
        if (tid == 0) misc[0] = atomicAdd(&p->ctl[qword], 1u);
        __syncthreads();
        const int it = (int)misc[0] + lo;
        if (it >= hi) break;
        if (it < ATT_NMLA) {
            const int e = mla_order[it >> 3];
            const int sg = e >> 5;
            mla_item(p, it & 7, e & 31, (u16*)smem, sg == 2 ? -1 : sg);
        } else if (it >= ATT_NMLA + 512) {
            cvt_item(p, it - ATT_NMLA - 512, smem);
        } else {
            const int base = (it - ATT_NMLA) * 16;
#ifdef DSA_VALU
            for (int k = 0; k < 4; ++k) {
                const int task = wid * 4 + k;
                dsa_task(p, base + (task >> 1), task & 1, smem + wid * DSA_WLDS);
            }
#else
            for (int k = 0; k < 2; ++k) dsa_task2(p, base + wid * 2 + k, smem + wid * DSA2_WLDS, p->outcat, 2048, 1024);
#endif
        }
    }
}
__device__ __forceinline__ float ret_log2g(int h);

struct PgEpiResid {
    static constexpr bool PERM = true, AFTER_DRAIN = false;
    u16* C; const u16* X; int ldc;
    __device__ __forceinline__ void operator()(const pg8::f32x4 (&acc)[2][2][4][2], const pg8::Unit& u, int wr, int wc, int fr, int fq) const {
        const int row0 = u.pm * 256 + wr * 64 + fr, col0 = u.pn * 256 + wc * 32 + 8 * fq;
#pragma unroll
        for (int ai = 0; ai < 2; ++ai) {
            u32x4 xv[4][2];
#pragma unroll
            for (int m = 0; m < 4; ++m)
#pragma unroll
                for (int bj = 0; bj < 2; ++bj) xv[m][bj] = *(const u32x4*)(X + (size_t)(row0 + ai * 128 + m * 16) * ldc + col0 + bj * 128);
#pragma unroll
            for (int m = 0; m < 4; ++m)
#pragma unroll
                for (int bj = 0; bj < 2; ++bj) {
                    const pg8::f32x4 v0 = acc[ai][bj][m][0], v1 = acc[ai][bj][m][1];
                    const u32x4 x = xv[m][bj];
                    u32x4 w;
                    w.x = pack2(__uint_as_float(x.x << 16) * ALPHA_ + v0[0], __uint_as_float(x.x & 0xffff0000u) * ALPHA_ + v0[1]);
                    w.y = pack2(__uint_as_float(x.y << 16) * ALPHA_ + v0[2], __uint_as_float(x.y & 0xffff0000u) * ALPHA_ + v0[3]);
                    w.z = pack2(__uint_as_float(x.z << 16) * ALPHA_ + v1[0], __uint_as_float(x.z & 0xffff0000u) * ALPHA_ + v1[1]);
                    w.w = pack2(__uint_as_float(x.w << 16) * ALPHA_ + v1[2], __uint_as_float(x.w & 0xffff0000u) * ALPHA_ + v1[3]);
                    *(u32x4*)(C + (size_t)(row0 + ai * 128 + m * 16) * ldc + col0 + bj * 128) = w;
                }
        }
    }
};

struct PgEpiResidF {
    static constexpr bool PERM = true, AFTER_DRAIN = false;
    u16* C; const float* X; int ldc;
    __device__ __forceinline__ void operator()(const pg8::f32x4 (&acc)[2][2][4][2], const pg8::Unit& u, int wr, int wc, int fr, int fq) const {
        const int row0 = u.pm * 256 + wr * 64 + fr, col0 = u.pn * 256 + wc * 32 + 8 * fq;
#pragma unroll
        for (int ai = 0; ai < 2; ++ai)
#pragma unroll
            for (int m = 0; m < 4; ++m) {
                f32x4 xv[2][2];
#pragma unroll
                for (int bj = 0; bj < 2; ++bj) {
                    const float* xp = X + (size_t)(row0 + ai * 128 + m * 16) * ldc + col0 + bj * 128;
                    xv[bj][0] = *(const f32x4*)xp; xv[bj][1] = *(const f32x4*)(xp + 4);
                }
#pragma unroll
                for (int bj = 0; bj < 2; ++bj) {
                    const f32x4 a = xv[bj][0] * ALPHA_ + acc[ai][bj][m][0], b = xv[bj][1] * ALPHA_ + acc[ai][bj][m][1];
                    u32x4 w; w.x = pack2(a[0], a[1]); w.y = pack2(a[2], a[3]); w.z = pack2(b[0], b[1]); w.w = pack2(b[2], b[3]);
                    *(u32x4*)(C + (size_t)(row0 + ai * 128 + m * 16) * ldc + col0 + bj * 128) = w;
                }
                asm volatile("" ::: "memory");
            }
    }
};
struct PgEpiL1 {
    static constexpr bool PERM = true, AFTER_DRAIN = false;
    KP p;
    __device__ __forceinline__ void operator()(const pg8::f32x4 (&acc)[2][2][4][2], const pg8::Unit& u, int wr, int wc, int fr, int fq) const {
        const int row0 = u.pm * 256 + wr * 64 + fr, ci = wc * 32 + 8 * fq;
        const int pn = u.pn;
        if (pn < 16) {
            const bool isk = pn >= 8; const int hd = pn & 7;
            const float l2g = ret_log2g(hd);
            const float* cR = p->cosR; const float* sR = p->sinR;
#pragma unroll
            for (int ai = 0; ai < 2; ++ai)
#pragma unroll
                for (int m = 0; m < 4; ++m) {
                    const int t = row0 + ai * 128 + m * 16;
                    const float dec = isk ? exp2f((float)(127 - (t & 127)) * l2g) : exp2f((float)((t & 127) + 1) * l2g);
                    f32x4 lo[2], hi[2];
#pragma unroll
                    for (int n = 0; n < 2; ++n) {
                        const f32x4 c = *(const f32x4*)(cR + t * 128 + ci + 4 * n), s = *(const f32x4*)(sR + t * 128 + ci + 4 * n);
                        const f32x4 x1 = acc[ai][0][m][n], x2 = acc[ai][1][m][n];
                        lo[n] = x1 * c - x2 * s; hi[n] = x1 * s + x2 * c;
                        if (isk) { lo[n] *= 0.0625f; hi[n] *= 0.0625f; }
                    }
                    const size_t o = (size_t)t * 2048 + hd * 256 + ci;
                    u16* d0 = isk ? p->kr : p->qr; u16* d1 = isk ? p->kz : p->qx;
                    u32x4 w;
                    w.x = pack2(lo[0][0], lo[0][1]); w.y = pack2(lo[0][2], lo[0][3]); w.z = pack2(lo[1][0], lo[1][1]); w.w = pack2(lo[1][2], lo[1][3]);
                    *(u32x4*)(d0 + o) = w;
                    w.x = pack2(hi[0][0], hi[0][1]); w.y = pack2(hi[0][2], hi[0][3]); w.z = pack2(hi[1][0], hi[1][1]); w.w = pack2(hi[1][2], hi[1][3]);
                    *(u32x4*)(d0 + o + 128) = w;
                    lo[0] *= dec; lo[1] *= dec; hi[0] *= dec; hi[1] *= dec;
                    w.x = pack2(lo[0][0], lo[0][1]); w.y = pack2(lo[0][2], lo[0][3]); w.z = pack2(lo[1][0], lo[1][1]); w.w = pack2(lo[1][2], lo[1][3]);
                    *(u32x4*)(d1 + o) = w;
                    w.x = pack2(hi[0][0], hi[0][1]); w.y = pack2(hi[0][2], hi[0][3]); w.z = pack2(hi[1][0], hi[1][1]); w.w = pack2(hi[1][2], hi[1][3]);
                    *(u32x4*)(d1 + o + 128) = w;
                    asm volatile("" ::: "memory");
                }
        } else {
            const bool isg = pn >= 32;
            u16* dst = isg ? p->sg : p->v1;
            const int cbase = (isg ? pn - 32 : pn - 16) * 256 + ci;
#pragma unroll
            for (int ai = 0; ai < 2; ++ai)
#pragma unroll
                for (int m = 0; m < 4; ++m)
#pragma unroll
                    for (int bj = 0; bj < 2; ++bj) {
                        f32x4 a = acc[ai][bj][m][0], b = acc[ai][bj][m][1];
                        if (isg) {
#pragma unroll
                            for (int e = 0; e < 4; ++e) { a[e] = silu_f(a[e]); b[e] = silu_f(b[e]); }
                        }
                        u32x4 w; w.x = pack2(a[0], a[1]); w.y = pack2(a[2], a[3]); w.z = pack2(b[0], b[1]); w.w = pack2(b[2], b[3]);
                        *(u32x4*)(dst + (size_t)(row0 + ai * 128 + m * 16) * 4096 + cbase + bj * 128) = w;
                    }
        }
    }
};

struct PgEpiBf16N {
    static constexpr bool PERM = true, AFTER_DRAIN = false;
    u16* C; int ldc; int ncols;
    __device__ __forceinline__ void operator()(const pg8::f32x4 (&acc)[2][2][4][2], const pg8::Unit& u, int wr, int wc, int fr, int fq) const {
        const int row0 = u.pm * 256 + wr * 64 + fr, col0 = u.pn * 256 + wc * 32 + 8 * fq;
#pragma unroll
        for (int ai = 0; ai < 2; ++ai)
#pragma unroll
            for (int m = 0; m < 4; ++m)
#pragma unroll
                for (int bj = 0; bj < 2; ++bj) {
                    const int c = col0 + bj * 128;
                    if (c < ncols) {
                        const pg8::f32x4 a = acc[ai][bj][m][0], b = acc[ai][bj][m][1];
                        u32x4 w; w.x = pack2(a[0], a[1]); w.y = pack2(a[2], a[3]); w.z = pack2(b[0], b[1]); w.w = pack2(b[2], b[3]);
                        *(u32x4*)(C + (size_t)(row0 + ai * 128 + m * 16) * ldc + c) = w;
                    }
                }
    }
};
struct PgEpiSwiglu {
    static constexpr bool PERM = true, AFTER_DRAIN = false;
    u16* C; int ldc;
    __device__ __forceinline__ void operator()(const pg8::f32x4 (&acc)[2][2][4][2], const pg8::Unit& u, int wr, int wc, int fr, int fq) const {
        const int row0 = u.pm * 256 + wr * 64 + fr, col0 = u.pn * 128 + wc * 32 + 8 * fq;
#pragma unroll
        for (int ai = 0; ai < 2; ++ai)
#pragma unroll
            for (int m = 0; m < 4; ++m) {
                const pg8::f32x4 g0 = acc[ai][0][m][0], g1 = acc[ai][0][m][1], u0 = acc[ai][1][m][0], u1 = acc[ai][1][m][1];
                float o[8];
#pragma unroll
                for (int e = 0; e < 4; ++e) { o[e] = silu_f(g0[e]) * u0[e]; o[4 + e] = silu_f(g1[e]) * u1[e]; }
                u32x4 w; w.x = pack2(o[0], o[1]); w.y = pack2(o[2], o[3]); w.z = pack2(o[4], o[5]); w.w = pack2(o[6], o[7]);
                *(u32x4*)(C + (size_t)(row0 + ai * 128 + m * 16) * ldc + col0) = w;
            }
    }
};
template <bool ADD_ROUTED, bool ROUTE, bool WRITE_B, bool WRITE_F, bool BLK = false>
__device__ __forceinline__ void ph_ln(KP p, const u16* Y, const float* g, const float* b, float* XF, u16* XB, u16* XL, int tb = 0) {
    const int lane = ltid() & 63;
    const int gw = BLK ? tb + (ltid() >> 6) : (blockIdx.x * NT + ltid()) >> 6, nw = BLK ? 8 : (gridDim.x * NT) >> 6;
    const int T_end = BLK ? tb + 32 : T_;
    f32x4 gg[8], bb[8];
#pragma unroll
    for (int j = 0; j < 8; ++j) { gg[j] = *(const f32x4*)(g + j * 256 + lane * 4); bb[j] = *(const f32x4*)(b + j * 256 + lane * 4); }
    for (int t0 = gw; t0 < T_end; t0 += 2 * nw) {
        u32x2 raw[2][8], r0raw[2][8], r1raw[2][8];
#pragma unroll
        for (int rr = 0; rr < 2; ++rr) {
            const int t = t0 + rr * nw < T_end ? t0 + rr * nw : t0;
            const u16* y = Y + (size_t)t * D_;
#pragma unroll
            for (int j = 0; j < 8; ++j) raw[rr][j] = *(const u32x2*)(y + j * 256 + lane * 4);
            if constexpr (ADD_ROUTED) {
                const u16* r0 = p->yr + (size_t)(2 * t) * D_;
                const u16* r1 = r0 + D_;
#pragma unroll
                for (int j = 0; j < 8; ++j) { r0raw[rr][j] = *(const u32x2*)(r0 + j * 256 + lane * 4); r1raw[rr][j] = *(const u32x2*)(r1 + j * 256 + lane * 4); }
            }
        }
#pragma unroll
        for (int rr = 0; rr < 2; ++rr) {
            const int t = t0 + rr * nw;
            if (t >= T_end) break;
            float v[32];
            float sum = 0.f;
#pragma unroll
            for (int j = 0; j < 8; ++j) {
                const u32x2 a = raw[rr][j];
                v[4 * j] = __uint_as_float(a.x << 16); v[4 * j + 1] = __uint_as_float(a.x & 0xffff0000u);
                v[4 * j + 2] = __uint_as_float(a.y << 16); v[4 * j + 3] = __uint_as_float(a.y & 0xffff0000u);
            }
            if constexpr (ADD_ROUTED) {
#pragma unroll
                for (int j = 0; j < 8; ++j) {
                    const u32x2 a = r0raw[rr][j], c = r1raw[rr][j];
                    v[4 * j]     += __uint_as_float(a.x << 16) + __uint_as_float(c.x << 16);
                    v[4 * j + 1] += __uint_as_float(a.x & 0xffff0000u) + __uint_as_float(c.x & 0xffff0000u);
                    v[4 * j + 2] += __uint_as_float(a.y << 16) + __uint_as_float(c.y << 16);
                    v[4 * j + 3] += __uint_as_float(a.y & 0xffff0000u) + __uint_as_float(c.y & 0xffff0000u);
                }
            }
#pragma unroll
            for (int i = 0; i < 32; ++i) sum += v[i];
            const float mu = wave_sum(sum) * (1.f / 2048.f);
            float var = 0.f;
#pragma unroll
            for (int i = 0; i < 32; ++i) { const float d = v[i] - mu; var += d * d; }
            var = wave_sum(var) * (1.f / 2048.f);
            const float rs = rsqrtf(var + 1e-5f);
#pragma unroll
            for (int j = 0; j < 8; ++j) {
                const int c = j * 256 + lane * 4;
                f32x4 o;
#pragma unroll
                for (int e = 0; e < 4; ++e) o[e] = (v[4 * j + e] - mu) * rs * gg[j][e] + bb[j][e];
                if constexpr (WRITE_F) *(f32x4*)(XF + (size_t)t * D_ + c) = o;
                if constexpr (WRITE_B) {
                    u32x2 w; w.x = pack2(o[0], o[1]); w.y = pack2(o[2], o[3]);
                    *(u32x2*)(XB + (size_t)t * D_ + c) = w;
                    if constexpr (ROUTE) {
                        u32x2 wl;
                        wl.x = pack2(o[0] - __uint_as_float(w.x << 16), o[1] - __uint_as_float(w.x & 0xffff0000u));
                        wl.y = pack2(o[2] - __uint_as_float(w.y << 16), o[3] - __uint_as_float(w.y & 0xffff0000u));
                        *(u32x2*)(XL + (size_t)t * D_ + c) = wl;
                    }
                }
            }
        }
    }
}

__device__ __forceinline__ void route_token(KP p, int t, float logit, int lane, unsigned* cnt, int* list) {
    const float sc = 1.f / (1.f + __expf(-logit));
    const float bi = sc + p->router_b[lane];
    float m1 = bi;
    m1 = fmaxf(m1, __shfl_xor(m1, 1)); m1 = fmaxf(m1, __shfl_xor(m1, 2)); m1 = fmaxf(m1, __shfl_xor(m1, 4));
    const int seg = lane >> 3;
    unsigned long long bal = __ballot(bi == m1);
    const int f1 = __builtin_ctz((unsigned)((bal >> (seg * 8)) & 0xffull));
    const float b2 = ((lane & 7) == f1) ? -1e30f : bi;
    float m2 = b2;
    m2 = fmaxf(m2, __shfl_xor(m2, 1)); m2 = fmaxf(m2, __shfl_xor(m2, 2)); m2 = fmaxf(m2, __shfl_xor(m2, 4));
    bal = __ballot(b2 == m2);
    const int f2 = __builtin_ctz((unsigned)((bal >> (seg * 8)) & 0xffull));
    const float gs = m1 + m2;
    float gm = gs;
    gm = fmaxf(gm, __shfl_xor(gm, 8)); gm = fmaxf(gm, __shfl_xor(gm, 16)); gm = fmaxf(gm, __shfl_xor(gm, 32));
    bal = __ballot(gs == gm);
    const int gsel = (int)(__builtin_ctzll(bal) >> 3);
    const int e0 = gsel * 8 + __shfl(f1, gsel * 8);
    const int e1 = gsel * 8 + __shfl(f2, gsel * 8);
    const float s0 = __shfl(sc, e0), s1 = __shfl(sc, e1);
    if (lane == 0) {
        const float inv = 1.f / (s0 + s1);
        const unsigned p0 = atomicAdd(&cnt[e0 * CNT_STRIDE], 1u);
        const unsigned p1 = atomicAdd(&cnt[e1 * CNT_STRIDE], 1u);
        list[e0 * T_ + p0] = 2 * t;
        list[e1 * T_ + p1] = 2 * t + 1;
        p->tok_g[2 * t] = s0 * inv;
        p->tok_g[2 * t + 1] = s1 * inv;
    }
}

__device__ __forceinline__ void router_block(KP p, unsigned char* smem, unsigned* cnt, int* list, int blk) {
    const int tid = ltid(), lane = tid & 63, wid = tid >> 6, grp = wid >> 2, kq = wid & 3, fr = lane & 15, fq = lane >> 4;
    float* part = (float*)smem;
    {
        const int t0 = blk * 32 + grp * 16;
        f32x4 acc[4];
#pragma unroll
        for (int c = 0; c < 4; ++c) acc[c] = (f32x4){0.f, 0.f, 0.f, 0.f};
        const u16* ah = p->xab + (size_t)(t0 + fr) * D_ + kq * 512 + fq * 8;
        const u16* al = p->xlb + (size_t)(t0 + fr) * D_ + kq * 512 + fq * 8;
        const u16* bh = p->whT + (size_t)fr * D_ + kq * 512 + fq * 8;
        const u16* bl = p->wlT + (size_t)fr * D_ + kq * 512 + fq * 8;
#pragma unroll 8
        for (int s = 0; s < 16; ++s) {
            const bf16x8 xh = *(const bf16x8*)(ah + 32 * s), xl = *(const bf16x8*)(al + 32 * s);
#pragma unroll
            for (int c = 0; c < 4; ++c) {
                const bf16x8 wh = *(const bf16x8*)(bh + (size_t)c * 16 * D_ + 32 * s);
                const bf16x8 wl = *(const bf16x8*)(bl + (size_t)c * 16 * D_ + 32 * s);
                acc[c] = __builtin_amdgcn_mfma_f32_16x16x32_bf16(xh, wh, acc[c], 0, 0, 0);
                acc[c] = __builtin_amdgcn_mfma_f32_16x16x32_bf16(xh, wl, acc[c], 0, 0, 0);
                acc[c] = __builtin_amdgcn_mfma_f32_16x16x32_bf16(xl, wh, acc[c], 0, 0, 0);
            }
        }
        float* mine = part + (grp * 4 + kq) * 1024;
#pragma unroll
        for (int c = 0; c < 4; ++c)
#pragma unroll
            for (int j = 0; j < 4; ++j) mine[(4 * fq + j) * 64 + 16 * c + fr] = acc[c][j];
        __syncthreads();
#pragma unroll
        for (int tt = 0; tt < 4; ++tt) {
            const int tok = 4 * kq + tt;
            const float* q = part + (grp * 4) * 1024 + tok * 64 + lane;
            const float logit = (q[0] + q[1024]) + (q[2048] + q[3072]);
            route_token(p, t0 + tok, logit, lane, cnt, list);
        }
        __syncthreads();
    }
}
__device__ __forceinline__ void ph_ln_router(KP p, const u16* Y, const float* g, const float* b, u16* XB, u16* XL, unsigned char* smem, unsigned* cnt, int* list) {
    for (int blk = blockIdx.x; blk < T_ / 32; blk += gridDim.x) {
        ph_ln<false, true, true, false, true>(p, Y, g, b, nullptr, XB, XL, blk * 32);
        asm volatile("s_waitcnt vmcnt(0)" ::: "memory");
        __syncthreads();
        router_block(p, smem, cnt, list, blk);
    }
}

struct ColGateUp16 { int c0; const u16* up;
    __device__ __forceinline__ const u16* base16(const u16* B, int hsel) const { return hsel ? up : B; }
    __device__ __forceinline__ unsigned off8(int hsel, int ch8) const { return (unsigned)(c0 + ch8 * 8); }
    __device__ __forceinline__ int vchunk(int hsel, int ch8) const { const int r = ch8 * 8; return ((r >> 5) * 64 + hsel * 32 + (r & 31)) >> 3; } };
struct ColGateUp { int c0; const float* up;
    __device__ __forceinline__ const float* base(const float* B, int hsel) const { return hsel ? up : B; }
    __device__ __forceinline__ unsigned off4(int hsel, int g4) const { return (unsigned)(c0 + g4 * 4); }
    __device__ __forceinline__ int vcol4(int hsel, int g4) const { const int r = g4 * 4; return (r >> 5) * 64 + hsel * 32 + (r & 31); } };
struct RowList { const int* lst; int m0, n; __device__ __forceinline__ int operator()(int r) const { const int i = m0 + r; return lst[i < n ? i : n - 1] >> 1; } };
struct EpiSwiglu {
    u16* C; int ldc; int row0, c0, nrows;
    __device__ __forceinline__ void operator()(Acc& acc, unsigned char* stg) const {
        const int wr0 = WR0_, cb = c0 + (WC0_ >> 1);
        u16* Cp = C; const int ld = ldc, rbase = row0, nr = nrows;
        stage_pairs(acc, stg, [=](int r, int c4, f32x4 g, f32x4 u) {
            const int rr = wr0 + r;
            if (rr < nr) {
                f32x4 o;
#pragma unroll
                for (int e = 0; e < 4; ++e) o[e] = silu_f(g[e]) * u[e];
                *(u32x2*)(Cp + (size_t)(rbase + rr) * ld + cb + c4) = pack4(o);
            }
        });
    }
};
struct SlotGate { int slot; float g; };
struct EpiDownRouted {
    u16* yr; const int* lst; const float* tg; int m0, n, col0;
    __device__ __forceinline__ void operator()(Acc& acc, unsigned char* stg) const {
        const int wr0 = WR0_, cb = col0 + WC0_;
        u16* yp = yr; const int* lp = lst; const float* tgp = tg; const int mm0 = m0, nn = n;
        stage_rows_pre<SlotGate>(acc, stg,
            [=](int r, int c4) -> SlotGate {
                const int i = mm0 + wr0 + r;
                const int s_ = lp[i < nn ? i : nn - 1];
                SlotGate sg; sg.g = tgp[s_]; sg.slot = i < nn ? s_ : -1;
                return sg; },
            [=](int r, int c4, f32x4 v, SlotGate sg) {
                if (sg.slot >= 0) *(u32x2*)(yp + (size_t)sg.slot * D_ + cb + c4) = pack4(v * sg.g); });
    }
};

struct RowH { int base, mx; __device__ __forceinline__ int operator()(int r) const { const int i = base + r; return i < mx ? i : mx; } };
__device__ __forceinline__ void moe_prefix(const unsigned* cnt, int* s_tp, int* s_off) {
    __syncthreads();
    if (ltid() == 0) {
        int tp = 0, off = 0;
        for (int e = 0; e < 64; ++e) {
            const int n = (int)__hip_atomic_load(&cnt[e * CNT_STRIDE], __ATOMIC_RELAXED, __HIP_MEMORY_SCOPE_AGENT);
            s_tp[e] = tp; s_off[e] = off;
            tp += (n + 255) >> 8; off += n;
        }
        s_tp[64] = tp; s_off[64] = off;
    }
    __syncthreads();
}

struct RowGen { const int* lst; int m0, n, base; __device__ __forceinline__ int operator()(int r) const {
    const int i = m0 + r; return lst[i < n ? i : n - 1] >> 1; } };

#define MOE_GROUP() ((int)((blockIdx.x * 4u) / gridDim.x))
template <int L>
__device__ __forceinline__ void moe_up_routed(KP p, const u16* X, unsigned char* smem, int* s_tp, int* s_off, int j0, int j1) {
    u16* lds = (u16*)smem;
    const int nrt = s_tp[64] * 8;
    for (int j = j0; j < j1; ++j) {
        const int t = (int)blockIdx.x + j * (int)gridDim.x;
        if (t >= nrt) break;
        Acc acc; acc_zero(acc);
        const int mtile = t >> 3, nt = t & 7;
        int e = 0;
        for (int s = 32; s > 0; s >>= 1) if (e + s < 64 && s_tp[e + s] <= mtile) e += s;
        const int n = s_off[e + 1] - s_off[e], m0 = (mtile - s_tp[e]) * 256;
        gemm_accum<B_F32_KN, false>(acc, X, D_, RowGen{p->list + e * T_, m0, n, 0}, p->moe_wg[L] + (size_t)e * D_ * 512, 512,
                                    ColGateUp{nt * 64, p->moe_wu[L] + (size_t)e * D_ * 512}, D_, lds);
        EpiSwiglu{p->hbuf, 512, s_off[e] + m0, nt * 64, n - m0}(acc, smem);
    }
}
template <int L>
__device__ __forceinline__ void ph_moe_up(KP p, const u16* X, unsigned char* smem, int* s_tp, int* s_off) {
    const unsigned* cnt = p->ctl + (L == 0 ? CTL_CNT0 : CTL_CNT1);
    moe_prefix(cnt, s_tp, s_off);
    moe_up_routed<L>(p, X, smem, s_tp, s_off, 0, MOE_GROUP());
    {
        __syncthreads();
        pg8::Gemm g; g.A = X; g.Bt = p->sh_gut[L]; g.M = T_; g.N = 2048; g.K = D_;
        pg8::StaticOrder S; S.init(T_, 2048, (int)gridDim.x, (int)blockIdx.x);
        pg8::gemm_phase<PgEpiSwiglu, pg8::StaticOrder>((PG8_LAS unsigned char*)smem, g, S, PgEpiSwiglu{p->hsh, 1024}, nullptr);
        __syncthreads();
    }
    { KP p2 = getp(); moe_up_routed<L>(p2, p2->xab, smem, s_tp, s_off, MOE_GROUP(), 1 << 20); }
}

template <int L>
__device__ __forceinline__ void moe_down_routed(KP p, unsigned char* smem, int* s_tp, int* s_off, int j0, int j1) {
    u16* lds = (u16*)smem;
    const int nrt = s_tp[64] * 16;
    for (int j = j0; j < j1; ++j) {
        const int t = (int)blockIdx.x + j * (int)gridDim.x;
        if (t >= nrt) break;
        Acc acc; acc_zero(acc);
        const int mtile = t >> 4, nt = t & 15;
        int e = 0;
        for (int s = 32; s > 0; s >>= 1) if (e + s < 64 && s_tp[e + s] <= mtile) e += s;
        const int n = s_off[e + 1] - s_off[e], m0 = (mtile - s_tp[e]) * 256;
        gemm_accum<B_F32_KN, false>(acc, p->hbuf, 512, RowH{s_off[e] + m0, 2 * T_ - 1}, p->moe_wd[L] + (size_t)e * 512 * D_, D_, ColOff{nt * 128}, 512, lds);
        EpiDownRouted{p->yr, p->list + e * T_, p->tok_g, m0, n, nt * 128}(acc, smem);
    }
}
template <int L>
__device__ __forceinline__ void ph_moe_down(KP p, const u16* XBres, unsigned char* smem, int* s_tp, int* s_off) {
    const unsigned* cnt = p->ctl + (L == 0 ? CTL_CNT0 : CTL_CNT1);
    moe_prefix(cnt, s_tp, s_off);
    moe_down_routed<L>(p, smem, s_tp, s_off, 0, 2 * MOE_GROUP());
    {
        __syncthreads();
        pg8::Gemm g; g.A = p->hsh; g.Bt = p->sh_dt[L]; g.M = T_; g.N = D_; g.K = 1024;
        pg8::StaticOrder S; S.init(T_, D_, (int)gridDim.x, (int)blockIdx.x);
        pg8::gemm_phase<PgEpiResid, pg8::StaticOrder>((PG8_LAS unsigned char*)smem, g, S, PgEpiResid{p->y2, XBres, D_}, nullptr);
        __syncthreads();
    }
    moe_down_routed<L>(getp(), smem, s_tp, s_off, 2 * MOE_GROUP(), 1 << 20);
}
struct ColRot { int cbase; bool rot;
    __device__ __forceinline__ const u16* base16(const u16* B, int) const { return B; }
    __device__ __forceinline__ unsigned off8(int hsel, int ch8) const { const int v = hsel * 64 + ch8 * 8; const int s = v >> 6, u = v & 63;
        return rot ? (unsigned)(cbase + s * 32 + (u < 32 ? u : 128 + (u - 32))) : (unsigned)(cbase + v); }
    __device__ __forceinline__ int vchunk(int hsel, int ch8) const { return hsel * 8 + ch8; }
    __device__ __forceinline__ const float* base(const float* B, int) const { return B; }
    __device__ __forceinline__ unsigned off4(int hsel, int g4) const { const int v = hsel * 64 + g4 * 4; const int s = v >> 6, u = v & 63;
        return rot ? (unsigned)(cbase + s * 32 + (u < 32 ? u : 128 + (u - 32))) : (unsigned)(cbase + v); }
    __device__ __forceinline__ int vcol4(int hsel, int g4) const { return hsel * 64 + g4 * 4; } };

__device__ __forceinline__ float ret_log2g(int h) { return log1pf(-exp2f(-5.f - (float)h)) * LOG2E_; }

struct EpiRetQK {
    KP p; int row0; int hd; int tp; bool isk;
    __device__ __forceinline__ void operator()(Acc& acc, unsigned char* stg) const {
        const float l2g = ret_log2g(hd);
        const int wc0 = WC0_, rb = row0 + WR0_;
        const int dbase = tp * 64 + (wc0 >> 1);
        const float* cR = p->cosR; const float* sR = p->sinR;
        const int hoff = hd * 256 + dbase;
        if (!isk) {
            u16* qr = p->qr; u16* qx = p->qx;
            stage_pairs_pre<CS8>(acc, stg,
              [=](int r, int c4) -> CS8 { CS8 t; t.c = *(const f32x4*)(cR + (rb + r) * 128 + dbase + c4); t.s = *(const f32x4*)(sR + (rb + r) * 128 + dbase + c4); return t; },
              [=](int r, int c4, f32x4 x1, f32x4 x2, CS8 cs) {
                const int t = rb + r;
                const f32x4 c = cs.c, s = cs.s;
                const f32x4 lo = x1 * c - x2 * s, hi = x1 * s + x2 * c;
                const float xi = exp2f((float)((t & 127) + 1) * l2g);
                const size_t o = (size_t)t * 2048 + hoff + c4;
                *(u32x2*)(qr + o) = pack4(lo); *(u32x2*)(qr + o + 128) = pack4(hi);
                *(u32x2*)(qx + o) = pack4(lo * xi); *(u32x2*)(qx + o + 128) = pack4(hi * xi);
            });
        } else {
            const int lane = ltid() & 63, fr = lane & 15, fq = lane >> 4;
#pragma unroll
            for (int m = 0; m < 4; ++m) {
                const int r0 = rb + m * 16 + fq * 4;
#pragma unroll
                for (int n = 0; n < 2; ++n) {
                    const int i = dbase + n * 16 + fr;
                    float zl[4], zh[4];
#pragma unroll
                    for (int j = 0; j < 4; ++j) {
                        const int t = r0 + j;
                        const float c = cR[t * 128 + i], s = sR[t * 128 + i];
                        const float x1 = acc[m][n][j], x2 = acc[m][n + 2][j];
                        const float ze = exp2f((float)(127 - (t & 127)) * l2g) * 0.0625f;
                        zl[j] = (x1 * c - x2 * s) * ze; zh[j] = (x1 * s + x2 * c) * ze;
                    }
                    u32x2 a, b;
                    a.x = pack2(zl[0], zl[1]); a.y = pack2(zl[2], zl[3]);
                    b.x = pack2(zh[0], zh[1]); b.y = pack2(zh[2], zh[3]);
                    *(u32x2*)(p->kzT + (size_t)(hd * 256 + i) * T_ + r0) = a;
                    *(u32x2*)(p->kzT + (size_t)(hd * 256 + i + 128) * T_ + r0) = b;
                }
            }
            u16* kr = p->kr;
            stage_pairs_pre<CS8>(acc, stg,
              [=](int r, int c4) -> CS8 { CS8 t; t.c = *(const f32x4*)(cR + (rb + r) * 128 + dbase + c4); t.s = *(const f32x4*)(sR + (rb + r) * 128 + dbase + c4); return t; },
              [=](int r, int c4, f32x4 x1, f32x4 x2, CS8 cs) {
                const int t = rb + r;
                const f32x4 c = cs.c, s = cs.s;
                const f32x4 lo = (x1 * c - x2 * s) * 0.0625f, hi = (x1 * s + x2 * c) * 0.0625f;
                const size_t o = (size_t)t * 2048 + hoff + c4;
                *(u32x2*)(kr + o) = pack4(lo); *(u32x2*)(kr + o + 128) = pack4(hi);
            });
        }
    }
};
struct EpiRetV {
    u16* vT; int row0, col0;
    __device__ __forceinline__ void operator()(Acc& acc, unsigned char* stg) const {
        const int lane = ltid() & 63, fr = lane & 15, fq = lane >> 4, wr0 = WR0_, wc0 = WC0_;
#pragma unroll
        for (int m = 0; m < 4; ++m) {
            const int r0 = row0 + wr0 + m * 16 + fq * 4;
#pragma unroll
            for (int n = 0; n < 4; ++n) {
                u32x2 o; o.x = pack2(acc[m][n][0], acc[m][n][1]); o.y = pack2(acc[m][n][2], acc[m][n][3]);
                *(u32x2*)(vT + (size_t)(col0 + wc0 + n * 16 + fr) * T_ + r0) = o;
            }
        }
    }
};
struct EpiSilu {
    u16* C; int ldc; int row0, col0;
    __device__ __forceinline__ void operator()(Acc& acc, unsigned char* stg) const {
        const int rb = row0 + WR0_, cb = col0 + WC0_;
        u16* Cp = C; const int ld = ldc;
        stage_rows(acc, stg, [=](int r, int c4, f32x4 v) {
            f32x4 o;
#pragma unroll
            for (int e = 0; e < 4; ++e) o[e] = silu_f(v[e]);
            *(u32x2*)(Cp + (size_t)(rb + r) * ld + cb + c4) = pack4(o);
        });
    }
};
struct EpiInner {
    u16* C; int hd;
    __device__ __forceinline__ void operator()(Acc& acc, unsigned char* stg) const {
        const float l2g = ret_log2g(hd);
        const int wr0 = WR0_, wc0 = WC0_;
        u16* Cp = C;
        stage_rows(acc, stg, [=](int r, int c4, f32x4 v) {
            const int i = wr0 + r;
            f32x4 o;
#pragma unroll
            for (int e = 0; e < 4; ++e) { const int k = wc0 + c4 + e; o[e] = i >= k ? v[e] * exp2f((float)(i - k) * l2g) : 0.f; }
            *(u32x2*)(Cp + i * 128 + wc0 + c4) = pack4(o);
        });
    }
};


__device__ __forceinline__ void ph_ret_a(KP p, u16* lds) {
    const int nkv = 8 * 64 * 4, nin = 8 * 64;
    for (int t = blockIdx.x; t < nkv + nin; t += gridDim.x) {
        Acc acc; acc_zero(acc);
        if (t < nkv) {
            const int hc = t >> 2, nt = t & 3, hd = hc >> 6, c = hc & 63;
            gemm_kk128(acc, p->kz + (size_t)(c * 128) * 2048 + hd * 256, 2048, p->v1 + (size_t)(c * 128) * 4096 + hd * 512 + nt * 128, 4096, lds);
            EpiBF16{p->KVt + (size_t)hc * 512 * 256, 512, 0, nt * 128}(acc, (unsigned char*)lds);
        } else {
            const int hc = t - nkv, hd = hc >> 6, c = hc & 63;
            gemm_accum<B_BF16_NK, true>(acc, p->qr + hd * 256, 2048, RowId{c * 128}, p->kr + hd * 256, 2048, RowId{c * 128}, 256, lds);
            if (ksplit_reduce(acc, lds)) EpiInner{p->innerG + (size_t)hc * 128 * 128, hd}(acc, (unsigned char*)lds + 65536);
        }
    }
}
__device__ __forceinline__ void ph_ret_b(KP p) {
    const int gtid = blockIdx.x * NT + ltid(), gsz = gridDim.x * NT;
    for (int e = gtid; e < 8 * 512 * 256 / 8; e += gsz) {
        const int hd = e / (512 * 256 / 8);
        const int within = e - hd * (512 * 256 / 8);
        const float g128 = exp2f(128.f * ret_log2g(hd));
        u16* base = p->KVt + (size_t)hd * 64 * 512 * 256 + (size_t)within * 8;
        float r[8];
#pragma unroll
        for (int i = 0; i < 8; ++i) r[i] = 0.f;
        u32x4 cur[8], nxt[8];
#pragma unroll
        for (int i = 0; i < 8; ++i) cur[i] = *(const u32x4*)(base + (size_t)i * 512 * 256);
#pragma unroll 1
        for (int g = 0; g < 8; ++g) {
            const int gn_ = g < 7 ? g + 1 : 7;
#pragma unroll
            for (int i = 0; i < 8; ++i) nxt[i] = *(const u32x4*)(base + (size_t)(gn_ * 8 + i) * 512 * 256);
#pragma unroll
            for (int i = 0; i < 8; ++i) {
                const u32x4 in = cur[i];
                u32x4 o;
                o.x = pack2(r[0], r[1]); o.y = pack2(r[2], r[3]); o.z = pack2(r[4], r[5]); o.w = pack2(r[6], r[7]);
                *(u32x4*)(base + (size_t)(g * 8 + i) * 512 * 256) = o;
#pragma unroll
                for (int k = 0; k < 4; ++k) {
                    r[2 * k] = r[2 * k] * g128 + __uint_as_float(in[k] << 16);
                    r[2 * k + 1] = r[2 * k + 1] * g128 + __uint_as_float(in[k] & 0xffff0000u);
                }
            }
#pragma unroll
            for (int i = 0; i < 8; ++i) cur[i] = nxt[i];
        }
    }
}
__device__ __forceinline__ void ph_ret_c(KP p, u16* lds) {
    for (int t = blockIdx.x; t < 8 * 64 * 4; t += gridDim.x) {
        const int hc = t >> 2, nt = t & 3, hd = hc >> 6, c = hc & 63;
        Acc acc; acc_zero(acc);
        gemm_accum<B_BF16_KN, true>(acc, p->innerG + (size_t)hc * 128 * 128, 128, RowId{0}, p->v1 + (size_t)(c * 128) * 4096, 4096, ColOff{hd * 512 + nt * 128}, 128, lds);
        gemm_accum<B_BF16_KN, true>(acc, p->qx + hd * 256, 2048, RowId{c * 128}, p->KVt + (size_t)hc * 512 * 256, 512, ColOff{nt * 128}, 256, lds);
        if (ksplit_reduce(acc, lds)) EpiBF16{p->obuf, 4096, c * 128, hd * 512 + nt * 128}(acc, (unsigned char*)lds + 65536);
    }
}
__device__ __forceinline__ void ph_gn(KP p) {
    const int lane = ltid() & 63;
    const int gw = (blockIdx.x * NT + ltid()) >> 6, nw = (gridDim.x * NT) >> 6;
    const int hd = gw & 7;
    float gg[8], gb[8];
    {
        const f32x4 g0 = *(const f32x4*)(p->gn_g + hd * 512 + lane * 8), g1 = *(const f32x4*)(p->gn_g + hd * 512 + lane * 8 + 4);
        const f32x4 b0 = *(const f32x4*)(p->gn_b + hd * 512 + lane * 8), b1 = *(const f32x4*)(p->gn_b + hd * 512 + lane * 8 + 4);
#pragma unroll
        for (int i = 0; i < 4; ++i) { gg[i] = g0[i]; gg[4 + i] = g1[i]; gb[i] = b0[i]; gb[4 + i] = b1[i]; }
    }
    for (int r0 = gw; r0 < T_ * 8; r0 += 4 * nw) {
        u32x4 in[4], gin[4];
#pragma unroll
        for (int u = 0; u < 4; ++u) {
            const int r = r0 + u * nw < T_ * 8 ? r0 + u * nw : r0;
            const size_t off = (size_t)(r >> 3) * 4096 + hd * 512 + lane * 8;
            in[u] = *(const u32x4*)(p->obuf + off); gin[u] = *(const u32x4*)(p->sg + off);
        }
#pragma unroll
        for (int u = 0; u < 4; ++u) {
            const int r = r0 + u * nw;
            if (r >= T_ * 8) break;
            const size_t off = (size_t)(r >> 3) * 4096 + hd * 512 + lane * 8;
            float v[8];
#pragma unroll
            for (int i = 0; i < 4; ++i) { v[2 * i] = __uint_as_float(in[u][i] << 16); v[2 * i + 1] = __uint_as_float(in[u][i] & 0xffff0000u); }
            float s = 0.f;
#pragma unroll
            for (int i = 0; i < 8; ++i) s += v[i];
            const float mu = wave_sum(s) * (1.f / 512.f);
            float var = 0.f;
#pragma unroll
            for (int i = 0; i < 8; ++i) { const float d = v[i] - mu; var += d * d; }
            var = wave_sum(var) * (1.f / 512.f);
            const float rs = rsqrtf(var + 1e-5f);
            float o[8];
#pragma unroll
            for (int i = 0; i < 8; ++i) {
                const float sgv = (i & 1) ? __uint_as_float(gin[u][i >> 1] & 0xffff0000u) : __uint_as_float(gin[u][i >> 1] << 16);
                o[i] = ((v[i] - mu) * rs * gg[i] + gb[i]) * sgv;
            }
            u32x4 w; w.x = pack2(o[0], o[1]); w.y = pack2(o[2], o[3]); w.z = pack2(o[4], o[5]); w.w = pack2(o[6], o[7]);
            *(u32x4*)(p->gated + off) = w;
        }
    }
}

#define MAXLDS_(a, b) ((a) > (b) ? (a) : (b))
#define PHASE_LDS MAXLDS_(MAXLDS_(MAXLDS_(GEMM_LDS_BYTES, 2 * ATT_LDS_BYTES), 8 * 8192), 131072)
#define LDS_TOTAL (PHASE_LDS + 16 + 16 + 65 * 4 * 2 + 8)

__global__ void __launch_bounds__(NT, 2) mega(Params kparams) {
    extern __shared__ __attribute__((aligned(16))) unsigned char smem[];
    u16* lds = (u16*)smem;
    uint4* xbw = (uint4*)(smem + PHASE_LDS);
    unsigned* misc = (unsigned*)(smem + PHASE_LDS + 16);
    int* s_tp = (int*)(smem + PHASE_LDS + 32);
    int* s_off = s_tp + 65;
    if (threadIdx.x == 0) *xbw = make_uint4(0u, 0u, 0u, 0u);
    __syncthreads();
    XcdBarrier bar = xcd_barrier_post(getp()->bar, (volatile LAS unsigned*)xbw);

    ph_prep(getp());
    {
        KP p = getp();
        for (int u = blockIdx.x; u < 32 * 14; u += gridDim.x) cvtT_block(p->w_in0, p->w_in0t, 2048, IN_AB, u / 14, u % 14, smem);
    }
    xcd_barrier(bar);
    {
        KP p = getp();
        __syncthreads();
        pg8::Gemm g; g.A = p->xb; g.Bt = p->w_in0t; g.M = T_; g.N = 3584; g.K = D_;
        pg8::StaticOrder S; S.init(T_, 3584, (int)gridDim.x, (int)blockIdx.x);
        pg8::gemm_phase<PgEpiBf16N, pg8::StaticOrder>((PG8_LAS unsigned char*)smem, g, S, PgEpiBf16N{p->H0, IN_AB, IN_AB}, nullptr);
        __syncthreads();
    }
    xcd_barrier(bar);
    ph_post0(getp());
    xcd_barrier(bar);
    {
        KP p = getp();
        const int ntm = T_ / BM;
        const int n1 = ntm * 12, n2 = ntm * 16, n3 = T_ / 16;
        for (;;) {
            __syncthreads();
            if (threadIdx.x == 0) misc[0] = atomicAdd(&p->ctl[CTL_QUEUE + 2], 1u);
            __syncthreads();
            const int it = (int)misc[0];
            if (it >= n1 + n2 + n3) break;
            if (it >= n3) {
                const int t = it - n3;
                const bool isq = t < n1;
                const int u = isq ? t : t - n1, nt = u / ntm, mt = u % ntm;
                Acc acc; acc_zero(acc);
                gemm_accum<B_BF16_KN, false>(acc, isq ? p->cqn : p->ckvn, isq ? 512 : 256, RowId{mt * BM}, isq ? p->w_uqb : p->w_ukvb,
                                     isq ? 1536 : 2048, ColOff{nt * BN}, isq ? 512 : 256, lds);
                if (isq) EpiQa{p->qa, p->cosA, p->sinA, mt * BM, nt * BN}(acc, smem);
                else EpiKva{p->ka, p->vaT, mt * BM, nt * BN}(acc, smem);
            } else {
                indexer_item(p, n3 - 1 - it);
            }
        }
    }
    xcd_barrier(bar);
    ph_topk(getp(), smem);
    xcd_barrier(bar);
    ph_attn(getp(), smem, misc);
    xcd_barrier(bar);
    ph_mla_merge(getp());
    xcd_barrier(bar);
    {
        KP p = getp();
        __syncthreads();
        pg8::Gemm g; g.A = p->outcat; g.Bt = p->w_out0t; g.M = T_; g.N = D_; g.K = D_;
        pg8::StaticOrder S; S.init(T_, D_, (int)gridDim.x, (int)blockIdx.x);
        pg8::gemm_phase<PgEpiResidF, pg8::StaticOrder>((PG8_LAS unsigned char*)smem, g, S, PgEpiResidF{p->ybuf, p->x, D_}, nullptr);
        __syncthreads();
    }
    xcd_barrier(bar);
    { KP p = getp(); ph_ln_router(p, p->ybuf, p->ln_mix_g[0], p->ln_mix_b[0], p->xab, p->xlb, smem, p->ctl + CTL_CNT0, p->list); }
    xcd_barrier(bar);
    { KP p = getp(); ph_moe_up<0>(p, p->xab, smem, s_tp, s_off); }
    xcd_barrier(bar);
    { KP p = getp(); ph_moe_down<0>(p, p->xab, smem, s_tp, s_off); }
    xcd_barrier(bar);
    { KP p = getp(); ph_ln<true, false, true, false>(p, p->y2, p->ln_ffn_g[0], p->ln_ffn_b[0], nullptr, p->xcb, nullptr); }
    xcd_barrier(bar);
    {
        KP p = getp();
        __syncthreads();
        pg8::Gemm g; g.A = p->xcb; g.Bt = p->w_in1t; g.M = T_; g.N = IN_C; g.K = D_;
        pg8::StaticOrder S; S.init(T_, IN_C, (int)gridDim.x, (int)blockIdx.x);
        pg8::gemm_phase<PgEpiL1, pg8::StaticOrder>((PG8_LAS unsigned char*)smem, g, S, PgEpiL1{p}, nullptr);
        __syncthreads();
    }
    xcd_barrier(bar);
    ph_ret_a(getp(), lds);
    xcd_barrier(bar);
    ph_ret_b(getp());
    xcd_barrier(bar);
    ph_ret_c(getp(), lds);
    xcd_barrier(bar);
    ph_gn(getp());
    xcd_barrier(bar);
    {
        KP p = getp();
        __syncthreads();
        pg8::Gemm g; g.A = p->gated; g.Bt = p->w_out1t; g.M = T_; g.N = D_; g.K = 4096;
        pg8::StaticOrder S; S.init(T_, D_, (int)gridDim.x, (int)blockIdx.x);
        pg8::gemm_phase<PgEpiResid, pg8::StaticOrder>((PG8_LAS unsigned char*)smem, g, S, PgEpiResid{p->ybuf, p->xcb, D_}, nullptr);
        __syncthreads();
    }
    xcd_barrier(bar);
    { KP p = getp(); ph_ln_router(p, p->ybuf, p->ln_mix_g[1], p->ln_mix_b[1], p->xab, p->xlb, smem, p->ctl + CTL_CNT1, p->list); }
    xcd_barrier(bar);
    { KP p = getp(); ph_moe_up<1>(p, p->xab, smem, s_tp, s_off); }
    xcd_barrier(bar);
    { KP p = getp(); ph_moe_down<1>(p, p->xab, smem, s_tp, s_off); }
    xcd_barrier(bar);
    { KP p = getp(); ph_ln<true, false, false, true>(p, p->y2, p->ln_ffn_g[1], p->ln_ffn_b[1], p->out, nullptr, nullptr); }
    {
        KP p = getp();
        if (xb_ld(&p->bar[XB_TMO])) {
            asm volatile("s_waitcnt vmcnt(0)" ::: "memory");
            for (int i = blockIdx.x * NT + ltid(); i < p->out_size; i += gridDim.x * NT) p->out[i] = __uint_as_float(0x7fc00000u);
        }
    }
}

extern "C" void kernel_launch(void* const* d_in, const int* in_sizes, int n_in,
                              void* d_out, int out_size, void* d_ws, size_t ws_size,
                              hipStream_t stream) {
    const size_t kDynLds = LDS_TOTAL;
    static int grid = 0;
    if (!grid) {
        int dev = 0, cus = 0, per_cu = 0;
        (void)hipGetDevice(&dev);
        (void)hipDeviceGetAttribute(&cus, hipDeviceAttributeMultiprocessorCount, dev);
        (void)hipFuncSetAttribute((const void*)mega, hipFuncAttributeMaxDynamicSharedMemorySize, (int)kDynLds);
        (void)hipOccupancyMaxActiveBlocksPerMultiprocessor(&per_cu, mega, NT, kDynLds);
        grid = cus * (per_cu >= 1 ? 1 : 0);
    }
    unsigned char* ws = (unsigned char*)d_ws;
    size_t off = 0;
    auto take = [&](size_t bytes) { void* q = ws + off; off += (bytes + 255) & ~(size_t)255; return q; };
    Params p{};
    p.bar = (unsigned*)take(XCD_BAR_WORDS * 4);
    p.ctl = (unsigned*)take(CTL_WORDS * 4);
    const size_t ctl_bytes = off;
    (void)hipMemsetAsync(ws, 0, ctl_bytes, stream);
    auto F = [&](int i) { return (const float*)d_in[i]; };
    p.x = F(0); p.pos = (const int*)d_in[1]; p.router_w = F(2); p.router_b = F(3);
    p.w_in0 = F(4); p.q_norm = F(5); p.w_uq = F(6); p.kv_norm = F(7); p.w_ukv = F(8); p.w_out0 = F(9);
    p.w_in1 = F(10); p.gn_g = F(11); p.gn_b = F(12); p.w_out1 = F(13);
    for (int l = 0; l < 2; ++l) {
        const int b = 14 + 10 * l;
        p.ln_mix_g[l] = F(b); p.ln_mix_b[l] = F(b + 1);
        p.moe_wg[l] = F(b + 2); p.moe_wu[l] = F(b + 3); p.moe_wd[l] = F(b + 4);
        p.sh_g[l] = F(b + 5); p.sh_u[l] = F(b + 6); p.sh_d[l] = F(b + 7);
        p.ln_ffn_g[l] = F(b + 8); p.ln_ffn_b[l] = F(b + 9);
    }
    p.out = (float*)d_out;
    p.w_in0b = nullptr; p.w_in0t = (u16*)take((size_t)3584 * D_ * 2); p.w_uqb = (u16*)take(512 * 1536 * 2); p.w_ukvb = (u16*)take(256 * 2048 * 2);
    p.w_out0b = nullptr; p.w_in1b = nullptr; p.w_out1b = nullptr; p.w_out1t = (u16*)take((size_t)4096 * D_ * 2); p.w_out0t = (u16*)take((size_t)D_ * D_ * 2); p.w_in1t = (u16*)take((size_t)D_ * IN_C * 2);
    for (int l = 0; l < 2; ++l) { p.sh_gb[l] = nullptr; p.sh_ub[l] = nullptr; p.sh_db[l] = nullptr; p.sh_gut[l] = (u16*)take((size_t)2048 * D_ * 2); p.sh_dt[l] = (u16*)take((size_t)D_ * 1024 * 2); }
    const size_t T = T_;
    p.cosA = (float*)take(T * 32 * 4); p.sinA = (float*)take(T * 32 * 4);
    p.cosR = (float*)take(T * 128 * 4); p.sinR = (float*)take(T * 128 * 4);
    p.xb = (u16*)take(T * 2048 * 2); p.H0 = (u16*)take(T * IN_AB * 2);
    p.cqn = (u16*)take(T * 512 * 2); p.ckvn = (u16*)take(T * 256 * 2); p.kpe = (u16*)take(T * 64 * 2);
    p.qb = (u16*)take(T * 1024 * 2); p.kb = (u16*)take(T * 256 * 2); p.vb = (u16*)take(T * 256 * 2);
    p.iqb = (u16*)take(T * 1024 * 2); p.ikb = (u16*)take(T * 64 * 2); p.iwf = (float*)take(T * 16 * 4);
    p.qa = (u16*)take(T * 1536 * 2); p.ka = (u16*)take(T * 1024 * 2); p.vaT = (u16*)take(T * 1024 * 2);
    p.scores = (float*)take(T * T * 4); p.sel = (u16*)take(T * 256 * 2); p.outcat = (u16*)take(T * 2048 * 2); p.mla_po = (float*)take((size_t)256 * 256 * 128 * 4); p.mla_ml = (float*)take((size_t)256 * 256 * 2 * 4);
    p.ybuf = (u16*)take(T * 2048 * 2); p.xab = (u16*)take(T * 2048 * 2); p.xlb = (u16*)take(T * 2048 * 2); p.whT = (u16*)take(64 * 2048 * 2); p.wlT = (u16*)take(64 * 2048 * 2);
    p.y2 = (u16*)take(T * 2048 * 2); p.xcb = (u16*)take(T * 2048 * 2);
    p.tok_e = (int*)take(T * 2 * 4); p.tok_g = (float*)take(T * 2 * 4); p.list = (int*)take(2 * 64 * T * 4);
    p.hbuf = (u16*)take(T * 2 * 512 * 2); p.hsh = (u16*)take(T * 1024 * 2); p.yr = (u16*)take(T * 2 * 2048 * 2);
    p.qr = (u16*)take(T * 2048 * 2); p.qx = (u16*)take(T * 2048 * 2); p.kr = (u16*)take(T * 2048 * 2);
    p.kzT = nullptr; p.kz = (u16*)take(T * 2048 * 2); p.v1 = (u16*)take(T * 4096 * 2); p.sg = (u16*)take(T * 4096 * 2);
    p.innerG = (u16*)take((size_t)8 * 64 * 128 * 128 * 2);
    {
        unsigned char* sbase = (unsigned char*)p.scores;
        p.KVt = (u16*)sbase; p.obuf = (u16*)(sbase + ((size_t)128 << 20)); p.gated = (u16*)(sbase + ((size_t)192 << 20));
    }
    p.out_size = out_size; p.pad_ = 0;
    if (off > ws_size) return;
    mega<<<dim3(grid), dim3(NT), kDynLds, stream>>>(p);
}
```

```cpp
#include <hip/hip_runtime.h>
#include <stdint.h>

typedef unsigned short u16;
typedef __attribute__((ext_vector_type(8))) short bf16x8;
typedef __attribute__((ext_vector_type(4))) float f32x4;
typedef __attribute__((ext_vector_type(2))) float f32x2;
typedef __attribute__((ext_vector_type(4))) unsigned u32x4;
typedef __attribute__((ext_vector_type(2))) unsigned u32x2;
typedef __attribute__((ext_vector_type(2))) __bf16 bf16x2_t;
typedef __attribute__((ext_vector_type(4))) short s16x4;

#define XB_TMO      128
#define XB_XCNT(j)  (256  + 64 * (j))
#define XB_XSUB(j)  (1280 + 64 * (j))
#define XB_XGEN(j)  (2304 + 64 * (j))
#define XB_TOP      3328
#define XB_TOPGEN   3392
#define XCD_BAR_WORDS 3456
#define XB_SPIN_CAP (1u << 22)
#define LAS __attribute__((address_space(3)))

__device__ __forceinline__ unsigned xb_ld(unsigned* p)              { return __hip_atomic_load(p, __ATOMIC_RELAXED, __HIP_MEMORY_SCOPE_AGENT); }
__device__ __forceinline__ unsigned xb_add(unsigned* p, unsigned v) { return __hip_atomic_fetch_add(p, v, __ATOMIC_RELAXED, __HIP_MEMORY_SCOPE_AGENT); }
__device__ __forceinline__ unsigned xb_xcc_id() { return (unsigned)__builtin_amdgcn_s_getreg((3 << 11) | 20) & 0xFu; }
#define XB_SPIN(cond, bar) do { unsigned _sp = 0; while (cond) { __builtin_amdgcn_s_sleep(1); \
    if ((++_sp & 255u) == 0u) { if (xb_ld(&(bar)[XB_TMO])) break; if (_sp > XB_SPIN_CAP) { atomicAdd(&(bar)[XB_TMO], 1u); break; } } } } while (0)

struct XcdBarrier { unsigned* bar; unsigned x; volatile LAS unsigned* st; };

__device__ __forceinline__ XcdBarrier xcd_barrier_post(unsigned* bar, volatile LAS unsigned* st) {
    XcdBarrier b; b.bar = bar; b.x = xb_xcc_id(); b.st = st;
    if (threadIdx.x == 0) (void)xb_add(&bar[XB_XCNT(b.x)], 1u);
    return b;
}
__device__ __forceinline__ void xcd_barrier_complete(unsigned* bar, unsigned x, unsigned& nloc, unsigned& nx) {
    const unsigned G = gridDim.x * gridDim.y * gridDim.z;
    unsigned sum, cnt, mine, sp = 0u;
    for (;;) {
        sum = 0u; cnt = 0u; mine = 0u;
#pragma unroll
        for (unsigned j = 0; j < 16; ++j) { const unsigned c = xb_ld(&bar[XB_XCNT(j)]); sum += c; cnt += (c > 0u) ? 1u : 0u; mine = (j == x) ? c : mine; }
        if (sum == G) break;
        __builtin_amdgcn_s_sleep(1);
        if ((++sp & 255u) == 0u) { if (xb_ld(&bar[XB_TMO])) break; if (sp > XB_SPIN_CAP) { atomicAdd(&bar[XB_TMO], 1u); break; } }
    }
    nloc = mine > 0u ? mine : 1u; nx = cnt > 0u ? cnt : 1u;
}
__device__ __forceinline__ void xcd_barrier(const XcdBarrier& b) {
    asm volatile("s_waitcnt vmcnt(0)" ::: "memory");
    __syncthreads();
    if (threadIdx.x == 0) {
        unsigned* bar = b.bar;
        __builtin_amdgcn_s_waitcnt(0);
        unsigned nloc = b.st[0], nx = b.st[1];
        if (nloc == 0u) { xcd_barrier_complete(bar, b.x, nloc, nx); b.st[0] = nloc; b.st[1] = nx; }
        const unsigned old = xb_add(&bar[XB_XSUB(b.x)], 1u);
        const unsigned gen = old / nloc;
        if (old + 1u == (gen + 1u) * nloc) {
            __builtin_amdgcn_fence(__ATOMIC_RELEASE, "agent");
            asm volatile("s_waitcnt vmcnt(0)" ::: "memory");
            const unsigned og = xb_add(&bar[XB_TOP], 1u);
            const unsigned tg = og / nx;
            if (og + 1u == (tg + 1u) * nx) xb_add(&bar[XB_TOPGEN], 1u);
            else XB_SPIN(xb_ld(&bar[XB_TOPGEN]) == tg, bar);
            __builtin_amdgcn_fence(__ATOMIC_ACQUIRE, "agent");
            xb_add(&bar[XB_XGEN(b.x)], 1u);
            asm volatile("s_waitcnt vmcnt(0)" ::: "memory");
        } else {
            XB_SPIN(xb_ld(&bar[XB_XGEN(b.x)]) == gen, bar);
            __builtin_amdgcn_fence(__ATOMIC_ACQUIRE, "agent");
            asm volatile("s_waitcnt vmcnt(0)" ::: "memory");
        }
    }
    __syncthreads();
}

__device__ __forceinline__ int ltid() { int t = threadIdx.x; asm volatile("" : "+v"(t)); return t; }
__device__ __forceinline__ u16 f2bf(float f) {
    unsigned u = __float_as_uint(f);
    u += 0x7fffu + ((u >> 16) & 1u);
    return (u16)(u >> 16);
}
__device__ __forceinline__ float bf2f(u16 h) { return __uint_as_float(((unsigned)h) << 16); }
__device__ __forceinline__ unsigned pack2(float a, float b) {
    f32x2 v = {a, b};
    bf16x2_t r = __builtin_convertvector(v, bf16x2_t);
    return *(unsigned*)&r;
}

namespace pg8 {
#define PG8_LAS __attribute__((address_space(3)))
typedef unsigned short bf16_t;
typedef short bf16x8 __attribute__((ext_vector_type(8)));
typedef float f32x4 __attribute__((ext_vector_type(4)));
typedef unsigned u32x4 __attribute__((ext_vector_type(4)));
constexpr int BM = 256, BK = 64, HALF = 128, HTB = HALF * BK * 2  , STAGE_BYTES = 8 * HTB, NXCD = 8, WGM = 8;

__host__ __device__ __forceinline__ int lds_byte(int r, int c) { const int st = (r >> 4) * 2 + (c >> 5), rr = r & 15, cc = c & 31, ob = rr * 64 + cc * 2; return st * 1024 + (ob ^ (((ob >> 9) & 1) << 5)); }
__host__ __device__ __forceinline__ void stage_rc(int b, int& R, int& C) { const int st = b / 1024, sb = b % 1024, swz = sb ^ (((sb >> 9) & 1) << 5); R = (st >> 1) * 16 + swz / 64; C = (st & 1) * 32 + (swz % 64) / 2; }
__host__ __device__ __forceinline__ int perm32(int rho) { const int n = rho >> 4, i = rho & 15; return 8 * (i >> 2) + 4 * n + (i & 3); }

struct Unit { int pm, pn; };
struct Gemm { const bf16_t* A; const bf16_t* Bt; int M, N, K; };

struct StaticOrder {
    int nM, nN, nwg, G, c;
    __host__ __device__ void init(int M, int N, int G_, int c_) { nM = M / BM; nN = N / BM; nwg = nM * nN; G = G_; c = c_; }
    __host__ __device__ bool next(int i, Unit& u) const {
        const long L = (long)i * G + c; if (L >= nwg) return false;
        int wgid = (int)L; { const int q = nwg / NXCD, r = nwg % NXCD, xcd = wgid % NXCD, off = wgid / NXCD; wgid = (xcd < r ? xcd * (q + 1) : r * (q + 1) + (xcd - r) * q) + off; }
        const int nig = WGM * nN, gid = wgid / nig, fm = gid * WGM, gsz = (nM - fm) < WGM ? (nM - fm) : WGM;
        u.pm = fm + ((wgid % nig) % gsz); u.pn = (wgid % nig) / gsz; return true;
    }
    __device__ __forceinline__ void a_ready(const Unit&) const {}
    __device__ __forceinline__ void done(const Unit&) const {}
};
__device__ __forceinline__ unsigned cvt_pk_bf16(float lo, float hi) { unsigned r; asm volatile("v_cvt_pk_bf16_f32 %0, %1, %2" : "=v"(r) : "v"(lo), "v"(hi)); return r; }
template <class Epi, class Sched, bool STAMP = false>
__device__ __forceinline__ void gemm_phase(PG8_LAS unsigned char* lds, const Gemm g, const Sched& S, const Epi& E, unsigned long long* stamps) {
    const int tid = ltid(), wid = __builtin_amdgcn_readfirstlane(tid >> 6), lane = tid & 63, wr = wid >> 2, wc = wid & 3, fr = lane & 15, fq = lane >> 4;
    const int K = g.K, nt = K / BK;
    int ts_lo = 0, ts_hi = 0, nts = 0; const unsigned long long rt_entry = STAMP ? (unsigned long long)wall_clock64() : 0ull;
#define PG8_STAMP() do { if (STAMP && wid == 0 && nts < 64) { const unsigned long long _c = (unsigned long long)clock64(); \
        ts_lo = (lane == nts) ? (int)(unsigned)_c : ts_lo; ts_hi = (lane == nts) ? (int)(unsigned)(_c >> 32) : ts_hi; ++nts; } } while (0)
    PG8_STAMP();
    unsigned voffA[2], voffB[2];
#pragma unroll
    for (int i = 0; i < 2; ++i) { int R, C; stage_rc(tid * 16 + i * 8192, R, C); const int Rb = Epi::PERM ? ((R & ~31) + perm32(R & 31)) : R;
        voffA[i] = (unsigned)(R * K + C) * 2u; voffB[i] = (unsigned)(Rb * K + C) * 2u; }
    const size_t kstep = (size_t)(BK * 2);
    const size_t hstep = (size_t)HALF * K * 2;
    const size_t tstep = 2 * hstep;
    const unsigned ldsw = (unsigned)wid * 1024u;
    const int aoff = lds_byte(wr * 64 + fr, fq * 8), boff = lds_byte(wc * 32 + fr, fq * 8);
#define PG8_SA(b, h) (((b) * 2 + (h)) * HTB)
#define PG8_SB(b, h) ((4 + (b) * 2 + (h)) * HTB)
#define PG8_STAGE(bufoff, gbase, voff) do { _Pragma("unroll") for (int _i = 0; _i < 2; ++_i) \
        __builtin_amdgcn_global_load_lds((const unsigned*)((const char*)(gbase) + (voff)[_i]), (PG8_LAS unsigned*)(lds + (bufoff) + ldsw + _i * 8192), 16, 0, 0); } while (0)
#define PG8_LDA(dst, b, h) do { _Pragma("unroll") for (int m = 0; m < 4; ++m) _Pragma("unroll") for (int k = 0; k < 2; ++k) dst[m][k] = *(const PG8_LAS bf16x8*)(lds + PG8_SA(b, h) + aoff + m * 2048 + k * 1024); } while (0)
#define PG8_LDB(dst, b, h) do { _Pragma("unroll") for (int n = 0; n < 2; ++n) _Pragma("unroll") for (int k = 0; k < 2; ++k) dst[n][k] = *(const PG8_LAS bf16x8*)(lds + PG8_SB(b, h) + boff + n * 2048 + k * 1024); } while (0)
#define PG8_MMA(ai, bj, At, Bt) do { __builtin_amdgcn_s_setprio(1); _Pragma("unroll") for (int m = 0; m < 4; ++m) _Pragma("unroll") for (int n = 0; n < 2; ++n) _Pragma("unroll") for (int k = 0; k < 2; ++k) \
        acc[ai][bj][m][n] = __builtin_amdgcn_mfma_f32_16x16x32_bf16(Bt[n][k], At[m][k], acc[ai][bj][m][n], 0, 0, 0); __builtin_amdgcn_s_setprio(0); } while (0)
#define PG8_WAIT_V(n) asm volatile("s_waitcnt vmcnt(" #n ")" ::: "memory")
#define PG8_WAIT_L(n) asm volatile("s_waitcnt lgkmcnt(" #n ")" ::: "memory")
#define PG8_BAR __builtin_amdgcn_s_barrier()
#define PG8_SCHED __builtin_amdgcn_sched_barrier(0)
    Unit cur, nxt; int ui = 0;
    if (!S.next(0, cur)) return;
    f32x4 acc[2][2][4][2];
#pragma unroll
    for (int a = 0; a < 2; ++a)
#pragma unroll
        for (int b = 0; b < 2; ++b)
#pragma unroll
            for (int m = 0; m < 4; ++m)
#pragma unroll
                for (int n = 0; n < 2; ++n) acc[a][b][m][n] = (f32x4){0.f, 0.f, 0.f, 0.f};
    bf16x8 At[4][2], B0[2][2], B1[2][2];
    const char* cA = (const char*)g.A + (size_t)cur.pm * tstep; const char* cB = (const char*)g.Bt + (size_t)cur.pn * tstep;
    S.a_ready(cur);
    PG8_STAGE(PG8_SB(0, 0), cB, voffB); PG8_STAGE(PG8_SA(0, 0), cA, voffA); PG8_STAGE(PG8_SB(0, 1), cB + hstep, voffB); PG8_STAGE(PG8_SA(0, 1), cA + hstep, voffA);
    if (wr == 1) PG8_BAR;
    PG8_WAIT_V(4); PG8_BAR;
    PG8_STAGE(PG8_SB(1, 0), cB + kstep, voffB); PG8_STAGE(PG8_SA(1, 0), cA + kstep, voffA); PG8_STAGE(PG8_SB(1, 1), cB + hstep + kstep, voffB);
    PG8_WAIT_V(6); PG8_BAR;
    PG8_STAMP();
    for (;;) {
        const bool has_next = S.next(ui + 1, nxt);
        const char* nA = has_next ? (const char*)g.A + (size_t)nxt.pm * tstep : cA; const char* nB = has_next ? (const char*)g.Bt + (size_t)nxt.pn * tstep : cB;
        for (int t = 0; t < nt; t += 2) {
            const bool last = (t == nt - 2);
            const char* a1 = cA + (size_t)(t + 1) * kstep;
            const char* a2 = last ? nA : cA + (size_t)(t + 2) * kstep; const char* b2 = last ? nB : cB + (size_t)(t + 2) * kstep;
            const char* a3 = a2 + kstep; const char* b3 = b2 + kstep;
            if (last && has_next) S.a_ready(nxt);
            PG8_LDB(B0, 0, 0); PG8_SCHED; PG8_LDA(At, 0, 0); PG8_STAGE(PG8_SA(1, 1), a1 + hstep, voffA);
            PG8_WAIT_L(8); PG8_BAR; PG8_WAIT_L(0); PG8_MMA(0, 0, At, B0); PG8_BAR; PG8_SCHED;
            PG8_LDB(B1, 0, 1); PG8_STAGE(PG8_SB(0, 0), b2, voffB);
            PG8_BAR; PG8_WAIT_L(0); PG8_MMA(0, 1, At, B1); PG8_BAR;
            PG8_LDA(At, 0, 1); PG8_STAGE(PG8_SA(0, 0), a2, voffA);
            PG8_BAR; PG8_WAIT_L(0); PG8_MMA(1, 0, At, B0); PG8_BAR; PG8_SCHED;
            PG8_STAGE(PG8_SB(0, 1), b2 + hstep, voffB);
            PG8_WAIT_V(6); PG8_BAR; PG8_MMA(1, 1, At, B1); PG8_BAR;
            PG8_LDB(B0, 1, 0); PG8_SCHED; PG8_LDA(At, 1, 0); PG8_STAGE(PG8_SA(0, 1), a2 + hstep, voffA);
            PG8_WAIT_L(8); PG8_BAR; PG8_WAIT_L(0); PG8_MMA(0, 0, At, B0); PG8_BAR; PG8_SCHED;
            PG8_LDB(B1, 1, 1); PG8_STAGE(PG8_SB(1, 0), b3, voffB);
            PG8_BAR; PG8_WAIT_L(0); PG8_MMA(0, 1, At, B1); PG8_BAR;
            PG8_LDA(At, 1, 1); PG8_STAGE(PG8_SA(1, 0), a3, voffA);
            PG8_BAR; PG8_WAIT_L(0); PG8_MMA(1, 0, At, B0); PG8_BAR; PG8_SCHED;
            PG8_STAGE(PG8_SB(1, 1), b3 + hstep, voffB);
            PG8_WAIT_V(6); PG8_BAR; PG8_MMA(1, 1, At, B1); PG8_BAR;
        }
        PG8_STAMP();
        if constexpr (!Epi::AFTER_DRAIN) { E(acc, cur, wr, wc, fr, fq); S.done(cur); }
        PG8_STAMP();
        if (!has_next) break;
#pragma unroll
        for (int a = 0; a < 2; ++a)
#pragma unroll
            for (int b = 0; b < 2; ++b)
#pragma unroll
                for (int m = 0; m < 4; ++m)
#pragma unroll
                    for (int n = 0; n < 2; ++n) acc[a][b][m][n] = (f32x4){0.f, 0.f, 0.f, 0.f};
        cur = nxt; cA = nA; cB = nB; ++ui;
    }
    PG8_WAIT_V(0);
    if (wr == 0) PG8_BAR;
    PG8_BAR;
    if constexpr (Epi::AFTER_DRAIN) { E.fused(acc, cur, wr, wc, fr, fq, lds, wid, lane); S.done(cur); }
    PG8_STAMP();
    if (STAMP && wid == 0) { stamps[lane] = lane < nts ? (((unsigned long long)(unsigned)ts_hi << 32) | (unsigned)ts_lo) : 0ull;
        if (lane == 62) stamps[62] = rt_entry; if (lane == 63) stamps[63] = (unsigned long long)wall_clock64(); }
#undef PG8_STAMP
#undef PG8_SA
#undef PG8_SB
#undef PG8_STAGE
#undef PG8_LDA
#undef PG8_LDB
#undef PG8_MMA
#undef PG8_WAIT_V
#undef PG8_WAIT_L
#undef PG8_BAR
#undef PG8_SCHED
}
}

__device__ __forceinline__ float wave_sum(float v) {
#pragma unroll
    for (int o = 32; o > 0; o >>= 1) v += __shfl_xor(v, o);
    return v;
}
__device__ __forceinline__ float wave_max(float v) {
#pragma unroll
    for (int o = 32; o > 0; o >>= 1) v = fmaxf(v, __shfl_xor(v, o));
    return v;
}
__device__ __forceinline__ int wave_isum(int v) {
#pragma unroll
    for (int o = 32; o > 0; o >>= 1) v += __shfl_xor(v, o);
    return v;
}
__device__ __forceinline__ float silu_f(float x) { return x / (1.f + __expf(-x)); }

#define T_ 8192
#define D_ 2048
#define IN_AB 3472
#define IN_C 12288
#define NT 512
#define ALPHA_ 1.4142135623730951f
#define LOG2E_ 1.4426950408889634f

#define BM 256
#define BN 128
#define BK 64
#define LROW 80
#define GEMM_BUF (BM * LROW + BN * LROW)
#define GEMM_LDS_BYTES (2 * GEMM_BUF * 2)

#define B_F32_KN 0
#define B_BF16_NK 1
#define B_BF16_KN 2

typedef f32x4 Acc[4][4];

__device__ __forceinline__ __amdgpu_buffer_rsrc_t make_rsrc(const void* p) {
    const unsigned long long a = (unsigned long long)p;
    const unsigned lo = __builtin_amdgcn_readfirstlane((unsigned)a), hi = __builtin_amdgcn_readfirstlane((unsigned)(a >> 32));
    return __builtin_amdgcn_make_buffer_rsrc((void*)(((unsigned long long)hi << 32) | lo), 0, 0x7fffffff, 0x00020000);
}
__device__ __forceinline__ u32x4 bload16(__amdgpu_buffer_rsrc_t r, unsigned voff, unsigned soff) {
    return __builtin_amdgcn_raw_buffer_load_b128(r, (int)voff, (int)soff, 0);
}

__device__ __forceinline__ void acc_zero(Acc& acc) {
#pragma unroll
    for (int m = 0; m < 4; ++m)
#pragma unroll
        for (int n = 0; n < 4; ++n) acc[m][n] = (f32x4){0.f, 0.f, 0.f, 0.f};
}

template <int BMODE, bool KS, bool LONGK = false, class ARow, class BSel>
__device__ __forceinline__ void gemm_accum(Acc& acc, const u16* __restrict__ A, int lda, ARow arow,
                                           const void* __restrict__ Bv, int ldb, BSel bsel,
                                           int K, u16* lds) {
    const int tid = ltid(), lane = tid & 63;
    const int wid = __builtin_amdgcn_readfirstlane(tid >> 6);
    const int wr = KS ? ((wid & 3) >> 1) : (wid >> 1), wc = wid & 1, fr = lane & 15, fq = lane >> 4;
    constexpr int NA = KS ? 2 : 4;
    const int ac = tid & 7, ar0 = tid >> 3;
    unsigned ao[NA];
#pragma unroll
    for (int i = 0; i < NA; ++i) ao[i] = ((unsigned)arow(ar0 + 64 * i) * (unsigned)lda + ac * 8) * 2u;
    const int nk = K / BK;
    const int sa_w = ar0 * LROW + ac * 8;
    constexpr int SB0 = BM * LROW;
    const __amdgpu_buffer_rsrc_t rA = make_rsrc(A);

#define MMA16(AF, BF) do { \
        __builtin_amdgcn_s_setprio(1); \
        _Pragma("unroll") for (int m = 0; m < 4; ++m) \
        _Pragma("unroll") for (int n = 0; n < 4; ++n) \
            acc[m][n] = __builtin_amdgcn_mfma_f32_16x16x32_bf16(AF[m], BF[n], acc[m][n], 0, 0, 0); \
        __builtin_amdgcn_s_setprio(0); } while (0)
#define MEMFENCE_ asm volatile("" ::: "memory")
#define GEMM_COMPUTE(buf) do { \
        const u16* sA = lds + (buf) * GEMM_BUF; const u16* sB = sA + SB0; \
        _Pragma("unroll") for (int ks = 0; ks < 2; ++ks) { \
            if (KS && ks != (wid >> 2)) continue; \
            bf16x8 af[4], bfr[4]; \
            _Pragma("unroll") for (int m = 0; m < 4; ++m) af[m] = *(const bf16x8*)(sA + (wr * 64 + m * 16 + fr) * LROW + ks * 32 + fq * 8); \
            _Pragma("unroll") for (int n = 0; n < 4; ++n) bfr[n] = *(const bf16x8*)(sB + (wc * 64 + n * 16 + fr) * LROW + ks * 32 + fq * 8); \
            _Pragma("unroll") for (int m = 0; m < 4; ++m) \
            _Pragma("unroll") for (int n = 0; n < 4; ++n) \
                acc[m][n] = __builtin_amdgcn_mfma_f32_16x16x32_bf16(af[m], bfr[n], acc[m][n], 0, 0, 0); \
        } } while (0)

    __syncthreads();

#define FRAG_KN(buf, ks, AF, BF) do { \
        const u16* sA = lds + (buf) * GEMM_BUF; \
        const LAS char* cB = (const LAS char*)(lds + (buf) * GEMM_BUF); \
        _Pragma("unroll") for (int m = 0; m < 4; ++m) AF[m] = *(const bf16x8*)(sA + (wr * 64 + m * 16 + fr) * LROW + (ks) * 32 + fq * 8); \
        _Pragma("unroll") for (int n = 0; n < 4; ++n) { \
            const s16x4 lo_ = __builtin_amdgcn_ds_read_tr16_b64_v4i16((LAS s16x4*)(cB + rdo[0][n] + (ks) * 8192)); \
            const s16x4 hi_ = __builtin_amdgcn_ds_read_tr16_b64_v4i16((LAS s16x4*)(cB + rdo[1][n] + (ks) * 8192)); \
            BF[n] = __builtin_shufflevector(lo_, hi_, 0, 1, 2, 3, 4, 5, 6, 7); } } while (0)
    if constexpr (BMODE == B_BF16_KN) {
        const int ch8 = tid & 7, kr = tid >> 3;
        const __amdgpu_buffer_rsrc_t rB0 = make_rsrc(bsel.base16((const u16*)Bv, 0));
        const __amdgpu_buffer_rsrc_t rB1 = make_rsrc(bsel.base16((const u16*)Bv, 1));
        const unsigned ldb2 = (unsigned)ldb * 2u;
        const unsigned bof0 = (unsigned)kr * ldb2 + bsel.off8(0, ch8) * 2u, bof1 = (unsigned)kr * ldb2 + bsel.off8(1, ch8) * 2u;
        const int xw = ((kr & 3) << 2) | ((kr >> 2) & 3);
        const int sbw0 = SB0 * 2 + kr * 256 + 16 * (bsel.vchunk(0, ch8) ^ xw);
        const int sbw1 = SB0 * 2 + kr * 256 + 16 * (bsel.vchunk(1, ch8) ^ xw);
        int rdo[2][4];
#pragma unroll
        for (int t = 0; t < 2; ++t) {
            const int xr = ((fr >> 2) << 2) | ((2 * fq + t) & 3);
#pragma unroll
            for (int n = 0; n < 4; ++n)
                rdo[t][n] = SB0 * 2 + (8 * fq + 4 * t + (fr >> 2)) * 256 + 16 * ((2 * (wc * 4 + n) + ((fr & 3) >> 1)) ^ xr) + 8 * (fr & 1);
        }
        u32x4 ra0[NA], ra1[NA]; u32x4 rb0[2], rb1[2];
#define GL_KB(k0, RA, RB) do { \
        _Pragma("unroll") for (int i = 0; i < NA; ++i) RA[i] = bload16(rA, ao[i], (unsigned)(k0) * 2u); \
        const unsigned s0_ = (unsigned)(k0) * ldb2; \
        RB[0] = bload16(rB0, bof0, s0_); RB[1] = bload16(rB1, bof1, s0_); } while (0)
#define LW_KB(buf, RA, RB) do { \
        u16* sb_ = lds + (buf) * GEMM_BUF; \
        _Pragma("unroll") for (int i = 0; i < NA; ++i) *(u32x4*)(sb_ + sa_w + 64 * i * LROW) = RA[i]; \
        char* cb_ = (char*)sb_; \
        *(u32x4*)(cb_ + sbw0) = RB[0]; *(u32x4*)(cb_ + sbw1) = RB[1]; } while (0)
        GL_KB(0, ra0, rb0);
        GL_KB(BK, ra1, rb1);
        LW_KB(0, ra0, rb0);
        if (LONGK || 2 < nk) GL_KB((2 < nk ? 2 : nk - 1) * BK, ra0, rb0);
        __syncthreads();
        bf16x8 af0[4], bf0[4], af1[4], bf1[4];
        for (int kt = 0; kt < nk; kt += 2) {
            if (!KS) { FRAG_KN(0, 0, af0, bf0); } else { FRAG_KN(0, (wid >> 2), af0, bf0); }
            MEMFENCE_;
            LW_KB(1, ra1, rb1);
            if (LONGK || kt + 3 < nk) GL_KB((kt + 3 < nk ? kt + 3 : nk - 1) * BK, ra1, rb1);
            MEMFENCE_;
            if (!KS) FRAG_KN(0, 1, af1, bf1);
            MMA16(af0, bf0);
            if (!KS) MMA16(af1, bf1);
            __syncthreads();
            if (!KS) { FRAG_KN(1, 0, af0, bf0); } else { FRAG_KN(1, (wid >> 2), af0, bf0); }
            MEMFENCE_;
            if (LONGK || kt + 2 < nk) LW_KB(0, ra0, rb0);
            if (LONGK || kt + 4 < nk) GL_KB((kt + 4 < nk ? kt + 4 : nk - 1) * BK, ra0, rb0);
            MEMFENCE_;
            if (!KS) FRAG_KN(1, 1, af1, bf1);
            MMA16(af0, bf0);
            if (!KS) MMA16(af1, bf1);
            __syncthreads();
        }
#undef GL_KB
#undef LW_KB
    } else if constexpr (BMODE == B_F32_KN) {
        const int g4 = tid & 15, kr = tid >> 4;
        const __amdgpu_buffer_rsrc_t rB0 = make_rsrc(bsel.base((const float*)Bv, 0));
        const __amdgpu_buffer_rsrc_t rB1 = make_rsrc(bsel.base((const float*)Bv, 1));
        const unsigned ldb4 = (unsigned)ldb * 4u;
        const unsigned bof0 = (unsigned)kr * ldb4 + bsel.off4(0, g4) * 4u, bof1 = (unsigned)kr * ldb4 + bsel.off4(1, g4) * 4u;
        const int xw = ((kr & 3) << 2) | ((kr >> 2) & 3);
        const int v00 = bsel.vcol4(0, g4), v01 = bsel.vcol4(1, g4);
        const int sbw0 = SB0 * 2 + kr * 256 + 16 * ((v00 >> 3) ^ xw) + 8 * ((v00 >> 2) & 1);
        const int sbw1 = SB0 * 2 + kr * 256 + 16 * ((v01 >> 3) ^ xw) + 8 * ((v01 >> 2) & 1);
        int rdo[2][4];
#pragma unroll
        for (int t = 0; t < 2; ++t) {
            const int xr = ((fr >> 2) << 2) | ((2 * fq + t) & 3);
#pragma unroll
            for (int n = 0; n < 4; ++n)
                rdo[t][n] = SB0 * 2 + (8 * fq + 4 * t + (fr >> 2)) * 256 + 16 * ((2 * (wc * 4 + n) + ((fr & 3) >> 1)) ^ xr) + 8 * (fr & 1);
        }
        u32x4 ra0[NA], ra1[NA]; u32x4 rb0[4], rb1[4];
#define PK4_(V) (w_.x = pack2(__uint_as_float(V[0]), __uint_as_float(V[1])), w_.y = pack2(__uint_as_float(V[2]), __uint_as_float(V[3])))
#define GL_F32(k0, RA, RB) do { \
        _Pragma("unroll") for (int i = 0; i < NA; ++i) RA[i] = bload16(rA, ao[i], (unsigned)(k0) * 2u); \
        const unsigned s0_ = (unsigned)(k0) * ldb4, s1_ = s0_ + 32u * ldb4; \
        RB[0] = bload16(rB0, bof0, s0_); RB[1] = bload16(rB1, bof1, s0_); \
        RB[2] = bload16(rB0, bof0, s1_); RB[3] = bload16(rB1, bof1, s1_); } while (0)
#define LW_F32(buf, RA, RB) do { \
        u16* sb_ = lds + (buf) * GEMM_BUF; \
        _Pragma("unroll") for (int i = 0; i < NA; ++i) *(u32x4*)(sb_ + sa_w + 64 * i * LROW) = RA[i]; \
        char* cb_ = (char*)sb_; \
        u32x2 w_; \
        PK4_(RB[0]); *(u32x2*)(cb_ + sbw0) = w_; \
        PK4_(RB[1]); *(u32x2*)(cb_ + sbw1) = w_; \
        PK4_(RB[2]); *(u32x2*)(cb_ + sbw0 + 32 * 256) = w_; \
        PK4_(RB[3]); *(u32x2*)(cb_ + sbw1 + 32 * 256) = w_; } while (0)
        GL_F32(0, ra0, rb0);
        GL_F32(BK, ra1, rb1);
        LW_F32(0, ra0, rb0);
        if (LONGK || 2 < nk) GL_F32((2 < nk ? 2 : nk - 1) * BK, ra0, rb0);
        __syncthreads();
        bf16x8 af0[4], bf0[4], af1[4], bf1[4];
        for (int kt = 0; kt < nk; kt += 2) {
            if (!KS) { FRAG_KN(0, 0, af0, bf0); } else { FRAG_KN(0, (wid >> 2), af0, bf0); }
            MEMFENCE_;
            LW_F32(1, ra1, rb1);
            if (LONGK || kt + 3 < nk) GL_F32((kt + 3 < nk ? kt + 3 : nk - 1) * BK, ra1, rb1);
            MEMFENCE_;
            if (!KS) FRAG_KN(0, 1, af1, bf1);
            MMA16(af0, bf0);
            if (!KS) MMA16(af1, bf1);
            __syncthreads();
            if (!KS) { FRAG_KN(1, 0, af0, bf0); } else { FRAG_KN(1, (wid >> 2), af0, bf0); }
            MEMFENCE_;
            if (LONGK || kt + 2 < nk) LW_F32(0, ra0, rb0);
            if (LONGK || kt + 4 < nk) GL_F32((kt + 4 < nk ? kt + 4 : nk - 1) * BK, ra0, rb0);
            MEMFENCE_;
            if (!KS) FRAG_KN(1, 1, af1, bf1);
            MMA16(af0, bf0);
            if (!KS) MMA16(af1, bf1);
            __syncthreads();
        }
#undef GL_F32
#undef LW_F32
    } else {
        const __amdgpu_buffer_rsrc_t rB = make_rsrc(Bv);
        unsigned bo[2];
#pragma unroll
        for (int i = 0; i < 2; ++i) bo[i] = ((unsigned)bsel(ar0 + 64 * i) * (unsigned)ldb + ac * 8) * 2u;
        u32x4 ra0[NA], ra1[NA], rb0[2], rb1[2];
#define GL_BF(k0, RA, RB) do { \
        _Pragma("unroll") for (int i = 0; i < NA; ++i) RA[i] = bload16(rA, ao[i], (unsigned)(k0) * 2u); \
        _Pragma("unroll") for (int i = 0; i < 2; ++i) RB[i] = bload16(rB, bo[i], (unsigned)(k0) * 2u); } while (0)
#define LW_BF(buf, RA, RB) do { \
        u16* sb_ = lds + (buf) * GEMM_BUF; \
        _Pragma("unroll") for (int i = 0; i < NA; ++i) *(u32x4*)(sb_ + sa_w + 64 * i * LROW) = RA[i]; \
        _Pragma("unroll") for (int i = 0; i < 2; ++i) *(u32x4*)(sb_ + SB0 + sa_w + 64 * i * LROW) = RB[i]; } while (0)
        GL_BF(0, ra0, rb0);
        GL_BF(BK, ra1, rb1);
        LW_BF(0, ra0, rb0);
        if (LONGK || 2 < nk) GL_BF((2 < nk ? 2 : nk - 1) * BK, ra0, rb0);
        __syncthreads();
#define FRAG_NK(buf, ks, AF, BF) do { \
        const u16* sA = lds + (buf) * GEMM_BUF; const u16* sB = sA + SB0; \
        _Pragma("unroll") for (int m = 0; m < 4; ++m) AF[m] = *(const bf16x8*)(sA + (wr * 64 + m * 16 + fr) * LROW + (ks) * 32 + fq * 8); \
        _Pragma("unroll") for (int n = 0; n < 4; ++n) BF[n] = *(const bf16x8*)(sB + (wc * 64 + n * 16 + fr) * LROW + (ks) * 32 + fq * 8); } while (0)
        bf16x8 af0[4], bf0[4], af1[4], bf1[4];
        for (int kt = 0; kt < nk; kt += 2) {
            if (!KS) { FRAG_NK(0, 0, af0, bf0); } else { FRAG_NK(0, (wid >> 2), af0, bf0); }
            MEMFENCE_;
            LW_BF(1, ra1, rb1);
            if (LONGK || kt + 3 < nk) GL_BF((kt + 3 < nk ? kt + 3 : nk - 1) * BK, ra1, rb1);
            MEMFENCE_;
            if (!KS) FRAG_NK(0, 1, af1, bf1);
            MMA16(af0, bf0);
            if (!KS) MMA16(af1, bf1);
            __syncthreads();
            if (!KS) { FRAG_NK(1, 0, af0, bf0); } else { FRAG_NK(1, (wid >> 2), af0, bf0); }
            MEMFENCE_;
            if (LONGK || kt + 2 < nk) LW_BF(0, ra0, rb0);
            if (LONGK || kt + 4 < nk) GL_BF((kt + 4 < nk ? kt + 4 : nk - 1) * BK, ra0, rb0);
            MEMFENCE_;
            if (!KS) FRAG_NK(1, 1, af1, bf1);
            MMA16(af0, bf0);
            if (!KS) MMA16(af1, bf1);
            __syncthreads();
        }
#undef FRAG_NK
#undef GL_BF
#undef LW_BF
    }
#undef GEMM_COMPUTE
#undef FRAG_KN
}

__device__ __forceinline__ void gemm_kk128(Acc& acc, const u16* __restrict__ Akm, int lda, const u16* __restrict__ Bkn, int ldb, u16* lds) {
    const int tid = ltid(), lane = tid & 63;
    const int wid = __builtin_amdgcn_readfirstlane(tid >> 6);
    const int wr = wid >> 1, wc = wid & 1, fr = lane & 15, fq = lane >> 4;
    char* sA = (char*)lds;
    char* sB = (char*)lds + 65536;
    __syncthreads();
    {
        u32x4 ra[8], rb[4];
#pragma unroll
        for (int i = 0; i < 8; ++i) { const int k = (tid >> 5) + 16 * i, ch = tid & 31; ra[i] = *(const u32x4*)(Akm + (size_t)k * lda + ch * 8); }
#pragma unroll
        for (int i = 0; i < 4; ++i) { const int k = (tid >> 4) + 32 * i, ch = tid & 15; rb[i] = *(const u32x4*)(Bkn + (size_t)k * ldb + ch * 8); }
#pragma unroll
        for (int i = 0; i < 8; ++i) { const int k = (tid >> 5) + 16 * i, ch = tid & 31; const int x = ((k & 3) << 2) | ((k >> 2) & 3);
            *(u32x4*)(sA + k * 512 + 16 * (ch ^ x)) = ra[i]; }
#pragma unroll
        for (int i = 0; i < 4; ++i) { const int k = (tid >> 4) + 32 * i, ch = tid & 15; const int x = ((k & 3) << 2) | ((k >> 2) & 3);
            *(u32x4*)(sB + k * 256 + 16 * (ch ^ x)) = rb[i]; }
    }
    __syncthreads();
    const LAS char* cA = (const LAS char*)sA; const LAS char* cB = (const LAS char*)sB;
#pragma unroll
    for (int ks = 0; ks < 4; ++ks) {
        bf16x8 af[4], bfr[4];
#pragma unroll
        for (int t = 0; t < 2; ++t) { }
#pragma unroll
        for (int m = 0; m < 4; ++m) {
            const int row0 = 32 * ks + 8 * fq + (fr >> 2), xr0 = ((fr >> 2) << 2) | ((2 * fq) & 3), xr1 = ((fr >> 2) << 2) | ((2 * fq + 1) & 3);
            const int chunk = 2 * (wr * 4 + m) + ((fr & 3) >> 1);
            const s16x4 lo_ = __builtin_amdgcn_ds_read_tr16_b64_v4i16((LAS s16x4*)(cA + row0 * 512 + 16 * (chunk ^ xr0) + 8 * (fr & 1)));
            const s16x4 hi_ = __builtin_amdgcn_ds_read_tr16_b64_v4i16((LAS s16x4*)(cA + (row0 + 4) * 512 + 16 * (chunk ^ xr1) + 8 * (fr & 1)));
            af[m] = __builtin_shufflevector(lo_, hi_, 0, 1, 2, 3, 4, 5, 6, 7);
        }
#pragma unroll
        for (int n = 0; n < 4; ++n) {
            const int row0 = 32 * ks + 8 * fq + (fr >> 2), xr0 = ((fr >> 2) << 2) | ((2 * fq) & 3), xr1 = ((fr >> 2) << 2) | ((2 * fq + 1) & 3);
            const int chunk = 2 * (wc * 4 + n) + ((fr & 3) >> 1);
            const s16x4 lo_ = __builtin_amdgcn_ds_read_tr16_b64_v4i16((LAS s16x4*)(cB + row0 * 256 + 16 * (chunk ^ xr0) + 8 * (fr & 1)));
            const s16x4 hi_ = __builtin_amdgcn_ds_read_tr16_b64_v4i16((LAS s16x4*)(cB + (row0 + 4) * 256 + 16 * (chunk ^ xr1) + 8 * (fr & 1)));
            bfr[n] = __builtin_shufflevector(lo_, hi_, 0, 1, 2, 3, 4, 5, 6, 7);
        }
#pragma unroll
        for (int m = 0; m < 4; ++m)
#pragma unroll
            for (int n = 0; n < 4; ++n) acc[m][n] = __builtin_amdgcn_mfma_f32_16x16x32_bf16(af[m], bfr[n], acc[m][n], 0, 0, 0);
    }
    __syncthreads();
}

__device__ __forceinline__ bool ksplit_reduce(Acc& acc, u16* lds) {
    const int tid = ltid(), lane = tid & 63;
    const int wid = __builtin_amdgcn_readfirstlane(tid >> 6);
    float* f = (float*)lds + (wid & 3) * 4096 + lane;
    if (wid >= 4) {
#pragma unroll
        for (int m = 0; m < 4; ++m)
#pragma unroll
            for (int n = 0; n < 4; ++n)
#pragma unroll
                for (int j = 0; j < 4; ++j) f[((m * 4 + n) * 4 + j) * 64] = acc[m][n][j];
    }
    __syncthreads();
    if (wid < 4) {
#pragma unroll
        for (int m = 0; m < 4; ++m)
#pragma unroll
            for (int n = 0; n < 4; ++n)
#pragma unroll
                for (int j = 0; j < 4; ++j) acc[m][n][j] += f[((m * 4 + n) * 4 + j) * 64];
    }
    return wid < 4;
}


#define STG_LD 68
#define STG_WAVE_BYTES (32 * STG_LD * 4)
#define WR0_ ((ltid() >> 7) * 64)
#define WC0_ (((ltid() >> 6) & 1) * 64)
template <class F>
__device__ __forceinline__ void stage_rows(Acc& acc, unsigned char* stage_base, F f) {
    const int tid = ltid(), lane = tid & 63, wid = tid >> 6, fr = lane & 15, fq = lane >> 4;
    float* st = (float*)(stage_base + wid * STG_WAVE_BYTES);
#pragma unroll
    for (int h = 0; h < 2; ++h) {
#pragma unroll
        for (int mm = 0; mm < 2; ++mm)
#pragma unroll
            for (int n = 0; n < 4; ++n)
#pragma unroll
                for (int j = 0; j < 4; ++j) st[(mm * 16 + fq * 4 + j) * STG_LD + n * 16 + fr] = acc[2 * h + mm][n][j];
        __builtin_amdgcn_s_waitcnt(0xc07f);
#pragma unroll
        for (int i = 0; i < 8; ++i) {
            const int r = (lane >> 4) + 4 * i, c4 = (lane & 15) * 4;
            const f32x4 v = *(const f32x4*)(st + r * STG_LD + c4);
            f(h * 32 + r, c4, v);
        }
        __builtin_amdgcn_s_waitcnt(0xc07f);
    }
}
template <class F>
__device__ __forceinline__ void stage_pairs(Acc& acc, unsigned char* stage_base, F f) {
    const int tid = ltid(), lane = tid & 63, wid = tid >> 6, fr = lane & 15, fq = lane >> 4;
    float* st = (float*)(stage_base + wid * STG_WAVE_BYTES);
#pragma unroll
    for (int h = 0; h < 2; ++h) {
#pragma unroll
        for (int mm = 0; mm < 2; ++mm)
#pragma unroll
            for (int n = 0; n < 4; ++n)
#pragma unroll
                for (int j = 0; j < 4; ++j) st[(mm * 16 + fq * 4 + j) * STG_LD + n * 16 + fr] = acc[2 * h + mm][n][j];
        __builtin_amdgcn_s_waitcnt(0xc07f);
#pragma unroll
        for (int i = 0; i < 4; ++i) {
            const int r = (lane >> 3) + 8 * i, c4 = (lane & 7) * 4;
            const f32x4 lo = *(const f32x4*)(st + r * STG_LD + c4);
            const f32x4 hi = *(const f32x4*)(st + r * STG_LD + c4 + 32);
            f(h * 32 + r, c4, lo, hi);
        }
        __builtin_amdgcn_s_waitcnt(0xc07f);
    }
}

template <class AUX, class PRE, class F>
__device__ __forceinline__ void stage_rows_pre(Acc& acc, unsigned char* stage_base, PRE pre, F f) {
    const int tid = ltid(), lane = tid & 63, wid = tid >> 6, fr = lane & 15, fq = lane >> 4;
    float* st = (float*)(stage_base + wid * STG_WAVE_BYTES);
#pragma unroll
    for (int h = 0; h < 2; ++h) {
        AUX aux[8];
#pragma unroll
        for (int i = 0; i < 8; ++i) aux[i] = pre(h * 32 + (lane >> 4) + 4 * i, (lane & 15) * 4);
#pragma unroll
        for (int mm = 0; mm < 2; ++mm)
#pragma unroll
            for (int n = 0; n < 4; ++n)
#pragma unroll
                for (int j = 0; j < 4; ++j) st[(mm * 16 + fq * 4 + j) * STG_LD + n * 16 + fr] = acc[2 * h + mm][n][j];
        __builtin_amdgcn_s_waitcnt(0xc07f);
        f32x4 v[8];
#pragma unroll
        for (int i = 0; i < 8; ++i) v[i] = *(const f32x4*)(st + ((lane >> 4) + 4 * i) * STG_LD + (lane & 15) * 4);
        asm volatile("" ::: "memory");
#pragma unroll
        for (int i = 0; i < 8; ++i) f(h * 32 + (lane >> 4) + 4 * i, (lane & 15) * 4, v[i], aux[i]);
        __builtin_amdgcn_s_waitcnt(0xc07f);
    }
}
template <class AUX, class PRE, class F>
__device__ __forceinline__ void stage_pairs_pre(Acc& acc, unsigned char* stage_base, PRE pre, F f) {
    const int tid = ltid(), lane = tid & 63, wid = tid >> 6, fr = lane & 15, fq = lane >> 4;
    float* st = (float*)(stage_base + wid * STG_WAVE_BYTES);
#pragma unroll
    for (int h = 0; h < 2; ++h) {
        AUX aux[4];
#pragma unroll
        for (int i = 0; i < 4; ++i) aux[i] = pre(h * 32 + (lane >> 3) + 8 * i, (lane & 7) * 4);
#pragma unroll
        for (int mm = 0; mm < 2; ++mm)
#pragma unroll
            for (int n = 0; n < 4; ++n)
#pragma unroll
                for (int j = 0; j < 4; ++j) st[(mm * 16 + fq * 4 + j) * STG_LD + n * 16 + fr] = acc[2 * h + mm][n][j];
        __builtin_amdgcn_s_waitcnt(0xc07f);
        f32x4 lo[4], hi[4];
#pragma unroll
        for (int i = 0; i < 4; ++i) {
            lo[i] = *(const f32x4*)(st + ((lane >> 3) + 8 * i) * STG_LD + (lane & 7) * 4);
            hi[i] = *(const f32x4*)(st + ((lane >> 3) + 8 * i) * STG_LD + (lane & 7) * 4 + 32);
        }
        asm volatile("" ::: "memory");
#pragma unroll
        for (int i = 0; i < 4; ++i) f(h * 32 + (lane >> 3) + 8 * i, (lane & 7) * 4, lo[i], hi[i], aux[i]);
        __builtin_amdgcn_s_waitcnt(0xc07f);
    }
}
__device__ __forceinline__ u32x2 pack4(f32x4 v) { u32x2 w; w.x = pack2(v[0], v[1]); w.y = pack2(v[2], v[3]); return w; }

struct Params {
    const float* x; const int* pos; const float* router_w; const float* router_b;
    const float* w_in0; const float* q_norm; const float* w_uq; const float* kv_norm; const float* w_ukv; const float* w_out0;
    const float* w_in1; const float* gn_g; const float* gn_b; const float* w_out1;
    const float* ln_mix_g[2]; const float* ln_mix_b[2];
    const float* moe_wg[2]; const float* moe_wu[2]; const float* moe_wd[2];
    const float* sh_g[2]; const float* sh_u[2]; const float* sh_d[2];
    const float* ln_ffn_g[2]; const float* ln_ffn_b[2];
    float* out;
    u16* w_in0b; u16* w_uqb; u16* w_ukvb; u16* w_out0b; u16* w_in1b; u16* w_out1b; u16* w_out1t; u16* w_out0t; u16* w_in1t; u16* w_in0t; u16* sh_gut[2]; u16* sh_dt[2]; u16* sh_gb[2]; u16* sh_ub[2]; u16* sh_db[2];
    unsigned* bar; unsigned* ctl;
    float* cosA; float* sinA; float* cosR; float* sinR;
    u16* xb; u16* H0;
    u16* cqn; u16* ckvn; u16* kpe; u16* qb; u16* kb; u16* vb; u16* iqb; u16* ikb; float* iwf;
    u16* qa; u16* ka; u16* vaT;
    float* scores; u16* sel; u16* outcat; float* mla_po; float* mla_ml;
    u16* ybuf; u16* xab; u16* xlb; u16* whT; u16* wlT; u16* y2; u16* xcb;
    int* tok_e; float* tok_g; int* list; u16* hbuf; u16* hsh; u16* yr;
    u16* qr; u16* qx; u16* kr; u16* kzT; u16* v1; u16* kz; u16* sg; u16* KVt; u16* innerG; u16* obuf; u16* gated;
    int out_size; int pad_;
};
typedef const __attribute__((address_space(4))) Params* KP;
__device__ __forceinline__ KP getp() { KP kp = (KP)__builtin_amdgcn_kernarg_segment_ptr(); asm volatile("" : "+s"(kp)); return kp; }
#define CTL_FLAGS 0
#define CTL_QUEUE 16
#define CNT_STRIDE 32
#define CTL_CNT0 64
#define CTL_CNT1 (64 + 64 * CNT_STRIDE)
#define CTL_CNTX (64 + 128 * CNT_STRIDE)
#define CTL_WORDS (64 + 192 * CNT_STRIDE)

struct RowId { int base; __device__ __forceinline__ int operator()(int r) const { return base + r; } };
struct ColOff { int c0;
    __device__ __forceinline__ const u16* base16(const u16* B, int) const { return B; }
    __device__ __forceinline__ unsigned off8(int hsel, int ch8) const { return (unsigned)(c0 + hsel * 64 + ch8 * 8); }
    __device__ __forceinline__ int vchunk(int hsel, int ch8) const { return hsel * 8 + ch8; }
    __device__ __forceinline__ const float* base(const float* B, int) const { return B; }
    __device__ __forceinline__ unsigned off4(int hsel, int g4) const { return (unsigned)(c0 + hsel * 64 + g4 * 4); }
    __device__ __forceinline__ int vcol4(int hsel, int g4) const { return hsel * 64 + g4 * 4; } };
struct ColClampOff { int c0, n;
    __device__ __forceinline__ const u16* base16(const u16* B, int) const { return B; }
    __device__ __forceinline__ unsigned off8(int hsel, int ch8) const { const int c = c0 + hsel * 64 + ch8 * 8; return (unsigned)(c < n - 8 ? c : n - 8); }
    __device__ __forceinline__ int vchunk(int hsel, int ch8) const { return hsel * 8 + ch8; }
    __device__ __forceinline__ const float* base(const float* B, int) const { return B; }
    __device__ __forceinline__ unsigned off4(int hsel, int g4) const { const int c = c0 + hsel * 64 + g4 * 4; return (unsigned)(c < n - 4 ? c : n - 4); }
    __device__ __forceinline__ int vcol4(int hsel, int g4) const { return hsel * 64 + g4 * 4; } };

__device__ __forceinline__ void ph_prep(KP p) {
    const int gtid = blockIdx.x * NT + ltid(), gsz = gridDim.x * NT;
    {
        const size_t n4 = (size_t)T_ * D_ / 4;
        for (size_t i0 = gtid; i0 < n4; i0 += (size_t)8 * gsz) {
            float4 v[8];
#pragma unroll
            for (int u = 0; u < 8; ++u) { const size_t i = i0 + (size_t)u * gsz; v[u] = ((const float4*)p->x)[i < n4 ? i : i0]; }
#pragma unroll
            for (int u = 0; u < 8; ++u) {
                const size_t i = i0 + (size_t)u * gsz;
                u32x2 o; o.x = pack2(v[u].x, v[u].y); o.y = pack2(v[u].z, v[u].w);
                if (i < n4) ((u32x2*)p->xb)[i] = o;
            }
        }
    }
    for (int idx = gtid; idx < D_ * 64; idx += gsz) {
        const int k = idx >> 6, e = idx & 63;
        const float w = p->router_w[idx];
        const u16 hi = f2bf(w);
        p->whT[(size_t)e * D_ + k] = hi;
        p->wlT[(size_t)e * D_ + k] = f2bf(w - bf2f(hi));
    }
    {
        auto cvt = [&](const float* src, u16* dst, size_t n) {
            for (size_t i = gtid; i < n / 8; i += gsz) {
                const f32x4 a = ((const f32x4*)src)[2 * i], b = ((const f32x4*)src)[2 * i + 1];
                u32x4 o; o.x = pack2(a[0], a[1]); o.y = pack2(a[2], a[3]); o.z = pack2(b[0], b[1]); o.w = pack2(b[2], b[3]);
                ((u32x4*)dst)[i] = o;
            }
        };
        cvt(p->w_uq, p->w_uqb, (size_t)512 * 1536);
        cvt(p->w_ukv, p->w_ukvb, (size_t)256 * 2048);
    }
    const double inv2pi = 0.15915494309189535;
    for (int idx = gtid; idx < T_ * 32; idx += gsz) {
        const int t = idx >> 5, i = idx & 31;
        const float inv = (float)exp2(-(double)i * (18.931568569324174 / 32.0));
        double rev = (double)p->pos[t] * (double)inv * inv2pi;
        rev -= floor(rev);
        p->cosA[idx] = __builtin_amdgcn_cosf((float)rev);
        p->sinA[idx] = __builtin_amdgcn_sinf((float)rev);
    }
    for (int idx = gtid; idx < T_ * 128; idx += gsz) {
        const int t = idx >> 7, i = idx & 127;
        const float inv = (float)exp2(-(double)i * (13.287712379549449 / 128.0));
        double rev = (double)p->pos[t] * (double)inv * inv2pi;
        rev -= floor(rev);
        p->cosR[idx] = __builtin_amdgcn_cosf((float)rev);
        p->sinR[idx] = __builtin_amdgcn_sinf((float)rev);
    }
}

struct EpiF32 {
    float* C; int ldc; int row0, col0, ncols;
    __device__ __forceinline__ void operator()(Acc& acc, unsigned char* stg) const {
        const int rb = row0 + WR0_, cb = col0 + WC0_;
        float* Cp = C; const int ld = ldc, nc = ncols;
        stage_rows(acc, stg, [=](int r, int c4, f32x4 v) {
            const int c = cb + c4;
            if (c < nc) *(f32x4*)(Cp + (size_t)(rb + r) * ld + c) = v;
        });
    }
};
struct EpiBF16N {
    u16* C; int ldc; int row0, col0, ncols;
    __device__ __forceinline__ void operator()(Acc& acc, unsigned char* stg) const {
        const int rb = row0 + WR0_, cb = col0 + WC0_;
        u16* Cp = C; const int ld = ldc, nc = ncols;
        stage_rows(acc, stg, [=](int r, int c4, f32x4 v) {
            const int c = cb + c4;
            if (c < nc) *(u32x2*)(Cp + (size_t)(rb + r) * ld + c) = pack4(v);
        });
    }
};
struct EpiBF16 {
    u16* C; int ldc; int row0, col0;
    __device__ __forceinline__ void operator()(Acc& acc, unsigned char* stg) const {
        const int rb = row0 + WR0_, cb = col0 + WC0_;
        u16* Cp = C; const int ld = ldc;
        stage_rows(acc, stg, [=](int r, int c4, f32x4 v) { *(u32x2*)(Cp + (size_t)(rb + r) * ld + cb + c4) = pack4(v); });
    }
};
template <bool XB>
struct EpiResid {
    u16* C; const void* X; int ldc; int row0, col0;
    __device__ __forceinline__ void operator()(Acc& acc, unsigned char* stg) const {
        const int rb = row0 + WR0_, cb = col0 + WC0_;
        u16* Cp = C; const void* Xp = X; const int ld = ldc;
        stage_rows_pre<f32x4>(acc, stg,
            [=](int r, int c4) -> f32x4 {
                const size_t o = (size_t)(rb + r) * ld + cb + c4;
                f32x4 x;
                if constexpr (XB) {
                    const u32x2 xr = *(const u32x2*)((const u16*)Xp + o);
                    x[0] = __uint_as_float(xr.x << 16); x[1] = __uint_as_float(xr.x & 0xffff0000u);
                    x[2] = __uint_as_float(xr.y << 16); x[3] = __uint_as_float(xr.y & 0xffff0000u);
                } else x = *(const f32x4*)((const float*)Xp + o);
                return x; },
            [=](int r, int c4, f32x4 v, f32x4 x) {
                *(u32x2*)(Cp + (size_t)(rb + r) * ld + cb + c4) = pack4(x * ALPHA_ + v); });
    }
};

__device__ __forceinline__ void ph_post0(KP p) {
    const int lane = ltid() & 63;
    const int gw = (blockIdx.x * NT + ltid()) >> 6, nw = (gridDim.x * NT) >> 6;
    const float qscale = 0.08838834764831845f * LOG2E_;
    const int dq = lane, d7 = lane & 127;
    const float qn[8] = {p->q_norm[lane], p->q_norm[lane + 64], p->q_norm[lane + 128], p->q_norm[lane + 192],
                         p->q_norm[lane + 256], p->q_norm[lane + 320], p->q_norm[lane + 384], p->q_norm[lane + 448]};
    const float kn[4] = {p->kv_norm[lane], p->kv_norm[lane + 64], p->kv_norm[lane + 128], p->kv_norm[lane + 192]};
    (void)dq; (void)d7;
    for (int t = gw; t < T_; t += nw) {
        const u16* hb = p->H0 + (size_t)t * IN_AB;
#define h_(i) bf2f(hb[i])
        const float* ca = p->cosA + t * 32;
        const float* sa = p->sinA + t * 32;
        const float c32 = ca[lane & 31], s32 = sa[lane & 31];
        const float c16 = ca[2 * (lane & 15)], s16 = sa[2 * (lane & 15)];
        const float c8 = ca[4 * (lane & 7)], s8 = sa[4 * (lane & 7)];
        float vq[8], vkv[4];
#pragma unroll
        for (int j = 0; j < 8; ++j) vq[j] = h_(lane + 64 * j);
#pragma unroll
        for (int j = 0; j < 4; ++j) vkv[j] = h_(512 + lane + 64 * j);
        const float kx1 = h_(768 + (lane & 31)), kx2 = h_(768 + 32 + (lane & 31));
        float q1[16], q2[16];
#pragma unroll
        for (int j = 0; j < 16; ++j) {
            const int e = lane + 64 * j, hd = e >> 7, d = e & 127, i = d & 15;
            const int i1 = d < 32 ? 832 + hd * 128 + i : 832 + e;
            q1[j] = h_(i1); q2[j] = h_(d < 32 ? i1 + 16 : i1);
        }
        float k1[4], k2[4], vv[4];
#pragma unroll
        for (int j = 0; j < 4; ++j) {
            const int e = lane + 64 * j, hd = e >> 7, d = e & 127, i = d & 15;
            const int i1 = d < 32 ? 1856 + hd * 128 + i : 1856 + e;
            k1[j] = h_(i1); k2[j] = h_(d < 32 ? i1 + 16 : i1);
            vv[j] = h_(2112 + e);
        }
        float iq1[16], iq2[16];
#pragma unroll
        for (int j = 0; j < 16; ++j) {
            const int e = lane + 64 * j, hd = e >> 6, d = e & 63, i = d & 7;
            const int i1 = d < 16 ? 2368 + hd * 64 + i : 2368 + e;
            iq1[j] = h_(i1); iq2[j] = h_(d < 16 ? i1 + 8 : i1);
        }
        const int iki = lane < 16 ? 3392 + (lane & 7) : 3392 + lane;
        const float ik1 = h_(iki), ik2 = h_(lane < 16 ? iki + 8 : iki);
        const float iwv = h_(3456 + (lane & 15));
        {
            float ss = 0.f;
#pragma unroll
            for (int j = 0; j < 8; ++j) ss += vq[j] * vq[j];
            ss = wave_sum(ss);
            const float r = rsqrtf(ss * (1.f / 512.f) + 1e-6f);
#pragma unroll
            for (int j = 0; j < 8; ++j) p->cqn[(size_t)t * 512 + lane + 64 * j] = f2bf(vq[j] * r * qn[j]);
        }
        {
            float ss = 0.f;
#pragma unroll
            for (int j = 0; j < 4; ++j) ss += vkv[j] * vkv[j];
            ss = wave_sum(ss);
            const float r = rsqrtf(ss * (1.f / 256.f) + 1e-6f);
#pragma unroll
            for (int j = 0; j < 4; ++j) p->ckvn[(size_t)t * 256 + lane + 64 * j] = f2bf(vkv[j] * r * kn[j]);
        }
        p->kpe[(size_t)t * 64 + lane] = f2bf(lane < 32 ? kx1 * c32 - kx2 * s32 : kx1 * s32 + kx2 * c32);
#pragma unroll
        for (int j = 0; j < 16; ++j) {
            const int d = (lane + 64 * j) & 127;
            const float m1 = d < 16 ? c16 : (d < 32 ? s16 : 1.f), m2 = d < 16 ? -s16 : (d < 32 ? c16 : 0.f);
            p->qb[(size_t)t * 1024 + lane + 64 * j] = f2bf((q1[j] * m1 + q2[j] * m2) * qscale);
        }
#pragma unroll
        for (int j = 0; j < 4; ++j) {
            const int d = (lane + 64 * j) & 127;
            const float m1 = d < 16 ? c16 : (d < 32 ? s16 : 1.f), m2 = d < 16 ? -s16 : (d < 32 ? c16 : 0.f);
            p->kb[(size_t)t * 256 + lane + 64 * j] = f2bf(k1[j] * m1 + k2[j] * m2);
            p->vb[(size_t)t * 256 + lane + 64 * j] = f2bf(vv[j]);
        }
        {
            const float m1 = lane < 8 ? c8 : (lane < 16 ? s8 : 1.f), m2 = lane < 8 ? -s8 : (lane < 16 ? c8 : 0.f);
#pragma unroll
            for (int j = 0; j < 16; ++j) p->iqb[(size_t)t * 1024 + lane + 64 * j] = f2bf(iq1[j] * m1 + iq2[j] * m2);
            p->ikb[(size_t)t * 64 + lane] = f2bf(ik1 * m1 + ik2 * m2);
        }
        if (lane < 16) p->iwf[t * 16 + lane] = iwv * 0.03125f;
    }
#undef h_
}

struct CS8 { f32x4 c, s; };
struct EpiQa {
    u16* C; const float* ca; const float* sa; int row0, col0;
    __device__ __forceinline__ void operator()(Acc& acc, unsigned char* stg) const {
        const float sc = 0.07216878364870323f * LOG2E_;
        const int rb = row0 + WR0_, cbase = col0 + WC0_;
        const bool rope = (cbase % 192) == 128;
        u16* Cp = C; const float* cap = ca; const float* sap = sa;
        stage_pairs_pre<CS8>(acc, stg,
            [=](int r, int c4) -> CS8 {
                CS8 t; t.c = (f32x4){1.f, 1.f, 1.f, 1.f}; t.s = (f32x4){0.f, 0.f, 0.f, 0.f};
                if (rope) { t.c = *(const f32x4*)(cap + (rb + r) * 32 + c4); t.s = *(const f32x4*)(sap + (rb + r) * 32 + c4); }
                return t; },
            [=](int r, int c4, f32x4 lo, f32x4 hi, CS8 t) {
                const int tt = rb + r;
                const f32x4 a = lo * t.c - hi * t.s, b = lo * t.s + hi * t.c;
                *(u32x2*)(Cp + (size_t)tt * 1536 + cbase + c4) = pack4(a * sc);
                *(u32x2*)(Cp + (size_t)tt * 1536 + cbase + c4 + 32) = pack4(b * sc); });
    }
};
struct EpiKva {
    u16* ka; u16* vaT; int row0, col0;
    __device__ __forceinline__ void operator()(Acc& acc, unsigned char* stg) const {
        const int cbase = col0 + WC0_;
        const int hd = cbase >> 8, within = cbase & 255;
        if (within < 128) {
            const int rb = row0 + WR0_;
            u16* kp = ka + hd * 128 + within;
            stage_rows(acc, stg, [=](int r, int c4, f32x4 v) { *(u32x2*)(kp + (size_t)(rb + r) * 1024 + c4) = pack4(v); });
        } else {
            const int lane = ltid() & 63, fr = lane & 15, fq = lane >> 4;
#pragma unroll
            for (int m = 0; m < 4; ++m) {
                const int r = row0 + WR0_ + m * 16 + fq * 4;
#pragma unroll
                for (int n = 0; n < 4; ++n) {
                    const int c = within - 128 + n * 16 + fr;
                    u32x2 o; o.x = pack2(acc[m][n][0], acc[m][n][1]); o.y = pack2(acc[m][n][2], acc[m][n][3]);
                    *(u32x2*)(vaT + (size_t)(hd * 128 + c) * T_ + r) = o;
                }
            }
        }
    }
};

__device__ __forceinline__ void indexer_tile(KP p, int qt, int kt) {
    const int lane = ltid() & 63, wid = (ltid() >> 6) & 3;
    const int wr = wid >> 1, wc = wid & 1, fr = lane & 15, fq = lane >> 4;
    const int k0 = kt * 128 + wr * 64, q0 = qt * 128 + wc * 64;
    bf16x8 af[4][2];
#pragma unroll
    for (int m = 0; m < 4; ++m)
#pragma unroll
        for (int ks = 0; ks < 2; ++ks)
            af[m][ks] = *(const bf16x8*)(p->ikb + (size_t)(k0 + m * 16 + fr) * 64 + ks * 32 + fq * 8);
    Acc sc; acc_zero(sc);
    for (int h = 0; h < 16; ++h) {
        bf16x8 bq[4][2]; float w[4];
#pragma unroll
        for (int n = 0; n < 4; ++n) {
            const size_t qrow = (size_t)(q0 + n * 16 + fr);
            bq[n][0] = *(const bf16x8*)(p->iqb + qrow * 1024 + h * 64 + fq * 8);
            bq[n][1] = *(const bf16x8*)(p->iqb + qrow * 1024 + h * 64 + 32 + fq * 8);
            w[n] = p->iwf[qrow * 16 + h];
        }
#pragma unroll
        for (int m = 0; m < 4; ++m)
#pragma unroll
            for (int n = 0; n < 4; ++n) {
                f32x4 d = (f32x4){0.f, 0.f, 0.f, 0.f};
                d = __builtin_amdgcn_mfma_f32_16x16x32_bf16(af[m][0], bq[n][0], d, 0, 0, 0);
                d = __builtin_amdgcn_mfma_f32_16x16x32_bf16(af[m][1], bq[n][1], d, 0, 0, 0);
#pragma unroll
                for (int j = 0; j < 4; ++j) sc[m][n][j] += w[n] * fmaxf(d[j], 0.f);
            }
    }
#pragma unroll
    for (int m = 0; m < 4; ++m)
#pragma unroll
        for (int n = 0; n < 4; ++n)
            *(f32x4*)(p->scores + (size_t)(q0 + n * 16 + fr) * T_ + k0 + m * 16 + fq * 4) = sc[m][n];
}

__device__ __forceinline__ void indexer_item(KP p, int g) {
    const int lane = ltid() & 63, wid = __builtin_amdgcn_readfirstlane(ltid() >> 6);
    const int fr = lane & 15, fq = lane >> 4;
    const int q0 = g * 16, nkb = g + 1;
    bf16x8 bq[16][2]; float w[16];
    {
        const u16* qrow = p->iqb + (size_t)(q0 + fr) * 1024 + fq * 8;
#pragma unroll
        for (int h = 0; h < 16; ++h) { bq[h][0] = *(const bf16x8*)(qrow + h * 64); bq[h][1] = *(const bf16x8*)(qrow + h * 64 + 32); }
        const float* wrow = p->iwf + (size_t)(q0 + fr) * 16;
#pragma unroll
        for (int h4 = 0; h4 < 4; ++h4) {
            const f32x4 wv = *(const f32x4*)(wrow + h4 * 4);
#pragma unroll
            for (int j = 0; j < 4; ++j) w[h4 * 4 + j] = wv[j];
        }
    }
    const u16* kbase = p->ikb + (size_t)fr * 64 + fq * 8;
    float* srow = p->scores + (size_t)(q0 + fr) * T_ + 4 * fq;
#define IDX_LOAD(A, kb_) do { const int kc_ = (kb_) < nkb ? (kb_) : nkb - 1; \
        A[0] = *(const bf16x8*)(kbase + (size_t)kc_ * 1024); A[1] = *(const bf16x8*)(kbase + (size_t)kc_ * 1024 + 32); } while (0)
#define IDX_COMP(A, kb_) do { if ((kb_) < nkb) { \
        f32x4 sc_ = (f32x4){0.f, 0.f, 0.f, 0.f}; \
        _Pragma("unroll") for (int h = 0; h < 16; ++h) { \
            f32x4 d_ = (f32x4){0.f, 0.f, 0.f, 0.f}; \
            d_ = __builtin_amdgcn_mfma_f32_16x16x32_bf16(A[0], bq[h][0], d_, 0, 0, 0); \
            d_ = __builtin_amdgcn_mfma_f32_16x16x32_bf16(A[1], bq[h][1], d_, 0, 0, 0); \
            _Pragma("unroll") for (int j = 0; j < 4; ++j) sc_[j] += w[h] * fmaxf(d_[j], 0.f); } \
        *(f32x4*)(srow + (size_t)(kb_) * 16) = sc_; } } while (0)
    bf16x8 a0[2], a1[2], a2[2], a3[2];
    int kb = wid;
    IDX_LOAD(a0, kb); IDX_LOAD(a1, kb + 8); IDX_LOAD(a2, kb + 16); IDX_LOAD(a3, kb + 24);
    for (; kb < nkb; kb += 32) {
        IDX_COMP(a0, kb); IDX_LOAD(a0, kb + 32);
        IDX_COMP(a1, kb + 8); IDX_LOAD(a1, kb + 40);
        IDX_COMP(a2, kb + 16); IDX_LOAD(a2, kb + 48);
        IDX_COMP(a3, kb + 24); IDX_LOAD(a3, kb + 56);
    }
#undef IDX_LOAD
#undef IDX_COMP
}

__device__ __forceinline__ unsigned fkey(float f) {
    const unsigned u = __float_as_uint(f);
    return (u & 0x80000000u) ? ~u : (u | 0x80000000u);
}
#define TOPK_WLDS (1024 * 4 + 1024 * 2)
template <bool ITEM>
__device__ __forceinline__ void ph_topk(KP p, unsigned char* smem, int q0 = 0) {
    const int lane0 = ltid() & 63, wid = ltid() >> 6;
    const int gw = __builtin_amdgcn_readfirstlane((blockIdx.x * NT + ltid()) >> 6), nw = (gridDim.x * NT) >> 6;
    const int widu = __builtin_amdgcn_readfirstlane(ltid() >> 6);
    unsigned* ckey = (unsigned*)(smem + wid * TOPK_WLDS);
    u16* cidx = (u16*)(smem + wid * TOPK_WLDS + 4096);
    for (int qq = ITEM ? 0 : gw; qq < (ITEM ? 1 : T_ / 2); qq += nw)
    for (int sside = 0; sside < 2; ++sside) {
        int lane = lane0; asm volatile("" : "+v"(lane));
        const int q = ITEM ? q0 + 2 * widu + sside : (sside ? (T_ - 1 - qq) : qq);
        u16* so = p->sel + (size_t)q * 256;
        if (q < 256) {
#pragma unroll
            for (int i = 0; i < 4; ++i) { const int s = lane + 64 * i; so[s] = (u16)(s <= q ? s : 0); }
            continue;
        }
        const int ng = (q >> 10) + 1;
        unsigned key[128];
        const float* row = p->scores + (size_t)q * T_;
        unsigned gm[4] = {0u, 0u, 0u, 0u};
        const int qml = q - lane;
#pragma unroll
        for (int g = 0; g < 8; ++g) {
            if (g < ng) {
                const float* rg = row + g * 1024 + lane;
#pragma unroll
                for (int i = 0; i < 16; ++i) {
                    const unsigned kx = fkey(rg[64 * i]) & ~(unsigned)((qml - 64 * (g * 16 + i)) >> 31);
                    key[g * 16 + i] = kx;
                    gm[i & 3] = kx > gm[i & 3] ? kx : gm[i & 3];
                }
            } else {
#pragma unroll
                for (int i = 0; i < 16; ++i) key[g * 16 + i] = 0u;
            }
        }
        unsigned Lk = gm[0] < gm[1] ? gm[0] : gm[1], Mk = gm[0] > gm[1] ? gm[0] : gm[1];
        { const unsigned l2 = gm[2] < gm[3] ? gm[2] : gm[3], m2 = gm[2] > gm[3] ? gm[2] : gm[3];
          Lk = Lk < l2 ? Lk : l2; Mk = Mk > m2 ? Mk : m2; }
#pragma unroll
        for (int o = 32; o > 0; o >>= 1) {
            const unsigned lo_ = (unsigned)__shfl_xor((int)Lk, o), mo_ = (unsigned)__shfl_xor((int)Mk, o);
            Lk = Lk < lo_ ? Lk : lo_; Mk = Mk > mo_ ? Mk : mo_;
        }
        Lk = (unsigned)__builtin_amdgcn_readfirstlane((int)Lk); Mk = (unsigned)__builtin_amdgcn_readfirstlane((int)Mk);
        unsigned prefix = 0u;
        int C = q + 1, b = 31;
        bool exact = false;
        if (Lk == Mk) { prefix = Mk; b = -1; }
        else { b = 31 - __builtin_clz(Lk ^ Mk); prefix = Mk & ~((2u << b) - 1u); }
        if (b < 31) {
            int cnt = 0;
#pragma unroll
            for (int g = 0; g < 8; ++g) {
                if (g < ng) {
#pragma unroll
                    for (int i = 0; i < 16; ++i) cnt += __builtin_popcountll(__ballot(key[g * 16 + i] >= prefix));
                }
            }
            C = cnt;
            if (cnt == 256) { exact = true; b = -1; }
        }
        for (; b >= 0 && C > 1024; --b) {
            const unsigned cand = prefix | (1u << b);
            int cnt = 0;
#pragma unroll
            for (int g = 0; g < 8; ++g) {
                if (g < ng) {
#pragma unroll
                    for (int i = 0; i < 16; ++i) cnt += __builtin_popcountll(__ballot(key[g * 16 + i] >= cand));
                }
            }
            if (cnt >= 256) { prefix = cand; C = cnt; }
            if (cnt == 256) { exact = true; --b; break; }
        }
        if (C > 1024) {
            int wp = 0;
#pragma unroll
            for (int g = 0; g < 8; ++g) {
                if (g < ng) {
#pragma unroll
                    for (int i = 0; i < 16; ++i) {
                        const bool gt = key[g * 16 + i] > prefix;
                        const unsigned long long m = __ballot(gt);
                        if (gt) so[wp + (int)__builtin_amdgcn_mbcnt_hi((unsigned)(m >> 32), __builtin_amdgcn_mbcnt_lo((unsigned)m, 0u))] = (u16)(lane + 64 * (g * 16 + i));
                        wp += __builtin_popcountll(m);
                    }
                }
            }
#pragma unroll
            for (int g = 0; g < 8; ++g) {
                if (g < ng && wp < 256) {
#pragma unroll
                    for (int i = 0; i < 16; ++i) {
                        const bool eq = key[g * 16 + i] == prefix && (lane + 64 * (g * 16 + i)) <= q;
                        const unsigned long long m = __ballot(eq);
                        if (eq) {
                            const int pos = wp + (int)__builtin_amdgcn_mbcnt_hi((unsigned)(m >> 32), __builtin_amdgcn_mbcnt_lo((unsigned)m, 0u));
                            if (pos < 256) so[pos] = (u16)(lane + 64 * (g * 16 + i));
                        }
                        wp += __builtin_popcountll(m);
                    }
                }
            }
            continue;
        }
        int base = 0;
#pragma unroll
        for (int g = 0; g < 8; ++g) {
            if (g < ng) {
#pragma unroll
                for (int i = 0; i < 16; ++i) {
                    const bool ge = key[g * 16 + i] >= prefix && (lane + 64 * (g * 16 + i)) <= q;
                    const unsigned long long m = __ballot(ge);
                    if (ge) {
                        const int pos = base + (int)__builtin_amdgcn_mbcnt_hi((unsigned)(m >> 32), __builtin_amdgcn_mbcnt_lo((unsigned)m, 0u));
                        ckey[pos] = key[g * 16 + i]; cidx[pos] = (u16)(lane + 64 * (g * 16 + i));
                    }
                    base += __builtin_popcountll(m);
                }
            }
        }
        __builtin_amdgcn_s_waitcnt(0xc07f);
        unsigned ck[16];
#pragma unroll
        for (int i = 0; i < 16; ++i) {
            const int s = lane + 64 * i;
            ck[i] = s < base ? ckey[s] : 0u;
        }
        if (!exact) {
            for (; b >= 0; --b) {
                const unsigned cand = prefix | (1u << b);
                int cnt = 0;
#pragma unroll
                for (int i = 0; i < 16; ++i) cnt += __builtin_popcountll(__ballot(ck[i] >= cand));
                if (cnt >= 256) prefix = cand;
                if (cnt == 256) break;
            }
        }
        int wpos = 0;
#pragma unroll
        for (int i = 0; i < 16; ++i) {
            const bool gt = ck[i] > prefix;
            const unsigned long long m = __ballot(gt);
            if (gt) so[wpos + (int)__builtin_amdgcn_mbcnt_hi((unsigned)(m >> 32), __builtin_amdgcn_mbcnt_lo((unsigned)m, 0u))] = cidx[lane + 64 * i];
            wpos += __builtin_popcountll(m);
        }
#pragma unroll
        for (int i = 0; i < 16; ++i) {
            if (wpos < 256) {
                const bool eq = ck[i] == prefix && (lane + 64 * i) < base;
                const unsigned long long m = __ballot(eq);
                if (eq) {
                    const int pos = wpos + (int)__builtin_amdgcn_mbcnt_hi((unsigned)(m >> 32), __builtin_amdgcn_mbcnt_lo((unsigned)m, 0u));
                    if (pos < 256) so[pos] = cidx[lane + 64 * i];
                }
                wpos += __builtin_popcountll(m);
            }
        }
        __builtin_amdgcn_s_waitcnt(0xc07f);
    }
}

#define KROW 208
#define VROW 80
#define ATT_LDS_BYTES (64 * KROW * 2 + 128 * VROW * 2)

__device__ __forceinline__ void mla_item(KP p, int h, int qb, u16* lds, int seg) {
    const int tid = ltid(), lane = tid & 63, wid = tid >> 6, fr = lane & 15, fq = lane >> 4;
    u16* sK = lds;
    u16* sV = lds + 64 * KROW;
    const int q0 = qb * 256;
    bf16x8 qf[2][6];
#pragma unroll
    for (int nq = 0; nq < 2; ++nq)
#pragma unroll
        for (int kc = 0; kc < 6; ++kc)
            qf[nq][kc] = *(const bf16x8*)(p->qa + (size_t)(q0 + wid * 32 + nq * 16 + fr) * 1536 + h * 192 + kc * 32 + fq * 8);
    f32x4 O[8][2];
#pragma unroll
    for (int m = 0; m < 8; ++m) { O[m][0] = (f32x4){0.f, 0.f, 0.f, 0.f}; O[m][1] = (f32x4){0.f, 0.f, 0.f, 0.f}; }
    float mrun[2] = {-1e30f, -1e30f}, lrun[2] = {0.f, 0.f};

    const int k0t = tid >> 4, k1t = tid >> 3;
    const u16* kpn = p->ka + (size_t)k0t * 1024 + h * 128 + (tid & 15) * 8;
    const u16* kpr = p->kpe + (size_t)k1t * 64 + (tid & 7) * 8;
    const u16* vpp = p->vaT + (size_t)(h * 128 + k1t) * T_ + (tid & 7) * 8;
    const int kln = (((k0t >> 2) & 1) * 16 + (k0t >> 3) * 4 + (k0t & 3)) * KROW + (tid & 15) * 8;
    const int e1 = k1t & 31;
    const int klr = ((k1t >> 5) * 32 + ((e1 >> 2) & 1) * 16 + (e1 >> 3) * 4 + (e1 & 3)) * KROW + 128 + (tid & 7) * 8;
    const int vl0 = k1t * VROW + (tid & 7) * 8;
    u32x4 kreg[3], vreg[2];
    const int ntiles = 4 * qb + 4;
    const int kt_lo = seg == 1 ? ntiles / 2 : 0, kt_hi = seg == 0 ? ntiles / 2 : ntiles;
#define ATT_GLOAD(kt) do { \
    _Pragma("unroll") for (int i = 0; i < 2; ++i) kreg[i] = *(const u32x4*)(kpn + (size_t)((kt) * 64 + 32 * i) * 1024); \
    kreg[2] = *(const u32x4*)(kpr + (size_t)((kt) * 64) * 64); \
    _Pragma("unroll") for (int i = 0; i < 2; ++i) vreg[i] = *(const u32x4*)(vpp + (size_t)(64 * i) * T_ + (kt) * 64); } while (0)
#define ATT_LWRITE(buf) do { \
        u16* sK_ = lds + (buf) * (ATT_LDS_BYTES / 2); u16* sV_ = sK_ + 64 * KROW; \
        _Pragma("unroll") for (int i = 0; i < 2; ++i) *(u32x4*)(sK_ + kln + 32 * i * KROW) = kreg[i]; \
        *(u32x4*)(sK_ + klr) = kreg[2]; \
        _Pragma("unroll") for (int i = 0; i < 2; ++i) *(u32x4*)(sV_ + vl0 + 64 * i * VROW) = vreg[i]; } while (0)
    ATT_GLOAD(kt_lo);
    __syncthreads();
    ATT_LWRITE(0);
    if (kt_lo + 1 < kt_hi) ATT_GLOAD(kt_lo + 1);
    __syncthreads();
    for (int kt = kt_lo; kt < kt_hi; ++kt) {
        const int cb = (kt - kt_lo) & 1;
        sK = lds + cb * (ATT_LDS_BYTES / 2);
        sV = sK + 64 * KROW;
        if (kt * 64 > q0 + wid * 32 + 31) {
            if (kt + 1 < kt_hi) ATT_LWRITE(cb ^ 1);
            if (kt + 2 < kt_hi) ATT_GLOAD(kt + 2);
            __syncthreads(); continue;
        }
        f32x4 s[2][4];
#pragma unroll
        for (int n = 0; n < 4; ++n) { s[0][n] = (f32x4){0.f, 0.f, 0.f, 0.f}; s[1][n] = (f32x4){0.f, 0.f, 0.f, 0.f}; }
#pragma unroll
        for (int kc = 0; kc < 6; ++kc)
#pragma unroll
            for (int n = 0; n < 4; ++n) {
                const bf16x8 a = *(const bf16x8*)(sK + (n * 16 + fr) * KROW + kc * 32 + fq * 8);
                s[0][n] = __builtin_amdgcn_mfma_f32_16x16x32_bf16(a, qf[0][kc], s[0][n], 0, 0, 0);
                s[1][n] = __builtin_amdgcn_mfma_f32_16x16x32_bf16(a, qf[1][kc], s[1][n], 0, 0, 0);
            }
        if (kt + 1 < kt_hi) ATT_LWRITE(cb ^ 1);
        if (kt + 2 < kt_hi) ATT_GLOAD(kt + 2);
        if (kt >= ntiles - 4) {
#pragma unroll
            for (int nq = 0; nq < 2; ++nq) {
                const int qi = q0 + wid * 32 + nq * 16 + fr;
#pragma unroll
                for (int n = 0; n < 4; ++n)
#pragma unroll
                    for (int j = 0; j < 4; ++j) {
                        const int ki = kt * 64 + (n >> 1) * 32 + fq * 8 + (n & 1) * 4 + j;
                        if (ki > qi) s[nq][n][j] = -1e30f;
                    }
            }
        }
        bf16x8 pf[2][2];
#pragma unroll
        for (int nq = 0; nq < 2; ++nq) {
            float mx = -1e30f;
#pragma unroll
            for (int n = 0; n < 4; ++n)
#pragma unroll
                for (int j = 0; j < 4; ++j) mx = fmaxf(mx, s[nq][n][j]);
            mx = fmaxf(mx, __shfl_xor(mx, 16));
            mx = fmaxf(mx, __shfl_xor(mx, 32));
            const float mnew = fmaxf(mrun[nq], mx);
            const float al = __builtin_amdgcn_exp2f(mrun[nq] - mnew);
            mrun[nq] = mnew;
            float ps = 0.f;
#pragma unroll
            for (int n = 0; n < 4; ++n)
#pragma unroll
                for (int j = 0; j < 4; ++j) { const float e = __builtin_amdgcn_exp2f(s[nq][n][j] - mnew); s[nq][n][j] = e; ps += e; }
            lrun[nq] = lrun[nq] * al + ps;
            if (__ballot(al != 1.0f) != 0ull) {
#pragma unroll
                for (int m = 0; m < 8; ++m) O[m][nq] *= al;
            }
#pragma unroll
            for (int c = 0; c < 2; ++c) {
                u32x4 w;
                w.x = pack2(s[nq][2 * c][0], s[nq][2 * c][1]);
                w.y = pack2(s[nq][2 * c][2], s[nq][2 * c][3]);
                w.z = pack2(s[nq][2 * c + 1][0], s[nq][2 * c + 1][1]);
                w.w = pack2(s[nq][2 * c + 1][2], s[nq][2 * c + 1][3]);
                pf[nq][c] = *(bf16x8*)&w;
            }
        }
#pragma unroll
        for (int m = 0; m < 8; ++m)
#pragma unroll
            for (int c = 0; c < 2; ++c) {
                const bf16x8 a = *(const bf16x8*)(sV + (m * 16 + fr) * VROW + c * 32 + fq * 8);
                O[m][0] = __builtin_amdgcn_mfma_f32_16x16x32_bf16(a, pf[0][c], O[m][0], 0, 0, 0);
                O[m][1] = __builtin_amdgcn_mfma_f32_16x16x32_bf16(a, pf[1][c], O[m][1], 0, 0, 0);
            }
        __syncthreads();
    }
#undef ATT_GLOAD
#undef ATT_LWRITE
#pragma unroll
    for (int nq = 0; nq < 2; ++nq) {
        float l = lrun[nq];
        l += __shfl_xor(l, 16);
        l += __shfl_xor(l, 32);
        const int qi = q0 + wid * 32 + nq * 16 + fr;
        if (seg < 0) {
            const float il = 1.f / l;
#pragma unroll
            for (int m = 0; m < 8; ++m) {
                u32x2 o;
                o.x = pack2(O[m][nq][0] * il, O[m][nq][1] * il);
                o.y = pack2(O[m][nq][2] * il, O[m][nq][3] * il);
                *(u32x2*)(p->outcat + (size_t)qi * 2048 + h * 128 + m * 16 + fq * 4) = o;
            }
        } else {
            const size_t slot = (size_t)((h * 16 + (qb - 16)) * 2 + seg);
            float* po = p->mla_po + (slot * 256 + (qi - q0)) * 128;
#pragma unroll
            for (int m = 0; m < 8; ++m) *(f32x4*)(po + m * 16 + fq * 4) = O[m][nq];
            if (fq == 0) { p->mla_ml[(slot * 256 + (qi - q0)) * 2] = mrun[nq]; p->mla_ml[(slot * 256 + (qi - q0)) * 2 + 1] = l; }
        }
    }
}

__device__ __forceinline__ void ph_mla_merge(KP p) {
    const int gtid = blockIdx.x * NT + ltid(), gsz = gridDim.x * NT;
    for (int i = gtid; i < 128 * 256 * 32; i += gsz) {
        const int d4 = i & 31, qq = (i >> 5) & 255, item = i >> 13;
        const int h = item >> 4, qb = 16 + (item & 15);
        const size_t s0 = (size_t)(item * 2) * 256 + qq, s1 = s0 + 256;
        const float m0 = p->mla_ml[s0 * 2], l0 = p->mla_ml[s0 * 2 + 1], m1 = p->mla_ml[s1 * 2], l1 = p->mla_ml[s1 * 2 + 1];
        const float m = fmaxf(m0, m1);
        const float w0 = __builtin_amdgcn_exp2f(m0 - m), w1 = __builtin_amdgcn_exp2f(m1 - m);
        const float il = 1.f / (l0 * w0 + l1 * w1);
        const f32x4 a = *(const f32x4*)(p->mla_po + s0 * 128 + d4 * 4), b = *(const f32x4*)(p->mla_po + s1 * 128 + d4 * 4);
        const f32x4 o = (a * w0 + b * w1) * il;
        *(u32x2*)(p->outcat + (size_t)(qb * 256 + qq) * 2048 + h * 128 + d4 * 4) = pack4(o);
    }
}

#define DSA_WLDS 5632
__device__ __forceinline__ void dsa_task(KP p, int q, int g, unsigned char* wl) {
    const int lane = ltid() & 63;
    u16* sQ = (u16*)wl;
    float* sP = (float*)(wl + 1024);
    u16* sS = (u16*)(wl + 1024 + 4096);
    const int nsel = q < 255 ? q + 1 : 256;
    {
        const u16* qsrc = p->qb + (size_t)q * 1024 + g * 512;
        *(u32x4*)(sQ + lane * 8) = *(const u32x4*)(qsrc + lane * 8);
        *(u32x2*)(sS + lane * 4) = *(const u32x2*)(p->sel + (size_t)q * 256 + lane * 4);
    }
    __builtin_amdgcn_s_waitcnt(0);
    float sc[4][4];
    float mx[4] = {-1e30f, -1e30f, -1e30f, -1e30f};
#pragma unroll
    for (int r = 0; r < 4; ++r) {
        const int slot = lane + 64 * r;
        float a0 = 0.f, a1 = 0.f, a2 = 0.f, a3 = 0.f;
        if (slot < nsel) {
            const int ki = sS[slot];
            const u16* kr = p->kb + (size_t)ki * 256 + g * 128;
#pragma unroll
            for (int c = 0; c < 16; ++c) {
                const u32x4 kv = *(const u32x4*)(kr + c * 8);
                const u32x4 q0v = *(const u32x4*)(sQ + 0 * 128 + c * 8);
                const u32x4 q1v = *(const u32x4*)(sQ + 1 * 128 + c * 8);
                const u32x4 q2v = *(const u32x4*)(sQ + 2 * 128 + c * 8);
                const u32x4 q3v = *(const u32x4*)(sQ + 3 * 128 + c * 8);
#pragma unroll
                for (int e = 0; e < 4; ++e) {
                    const unsigned kk = kv[e];
                    const bf16x2_t kb2 = *(const bf16x2_t*)&kk;
                    unsigned t0 = q0v[e], t1 = q1v[e], t2 = q2v[e], t3 = q3v[e];
                    a0 = __builtin_amdgcn_fdot2_f32_bf16(kb2, *(const bf16x2_t*)&t0, a0, false);
                    a1 = __builtin_amdgcn_fdot2_f32_bf16(kb2, *(const bf16x2_t*)&t1, a1, false);
                    a2 = __builtin_amdgcn_fdot2_f32_bf16(kb2, *(const bf16x2_t*)&t2, a2, false);
                    a3 = __builtin_amdgcn_fdot2_f32_bf16(kb2, *(const bf16x2_t*)&t3, a3, false);
                }
            }
        } else { a0 = a1 = a2 = a3 = -1e30f; }
        sc[r][0] = a0; sc[r][1] = a1; sc[r][2] = a2; sc[r][3] = a3;
        mx[0] = fmaxf(mx[0], a0); mx[1] = fmaxf(mx[1], a1); mx[2] = fmaxf(mx[2], a2); mx[3] = fmaxf(mx[3], a3);
    }
    float ls[4];
#pragma unroll
    for (int hh = 0; hh < 4; ++hh) {
        const float m = wave_max(mx[hh]);
        float s = 0.f;
#pragma unroll
        for (int r = 0; r < 4; ++r) { const float e = exp2f(sc[r][hh] - m); sc[r][hh] = e; s += e; }
        ls[hh] = wave_sum(s);
    }
#pragma unroll
    for (int r = 0; r < 4; ++r) {
        f32x4 pv = {sc[r][0], sc[r][1], sc[r][2], sc[r][3]};
        *(f32x4*)(sP + (lane + 64 * r) * 4) = pv;
    }
    __builtin_amdgcn_s_waitcnt(0);
    float o[4][8];
#pragma unroll
    for (int hh = 0; hh < 4; ++hh)
#pragma unroll
        for (int d = 0; d < 8; ++d) o[hh][d] = 0.f;
    const int kg = lane >> 4, dc = lane & 15;
    const u16* vbase = p->vb + g * 128 + dc * 8;
    const int nit = (nsel + 3) >> 2;
    for (int it = 0; it < nit; it += 4) {
        u32x4 vv[4]; f32x4 pp[4];
#pragma unroll
        for (int u = 0; u < 4; ++u) {
            if (it + u < nit) {
                const int slot = (it + u) * 4 + kg;
                const int ki = sS[slot];
                vv[u] = *(const u32x4*)(vbase + (size_t)ki * 256);
                pp[u] = *(const f32x4*)(sP + slot * 4);
            } else { vv[u] = (u32x4){0u, 0u, 0u, 0u}; pp[u] = (f32x4){0.f, 0.f, 0.f, 0.f}; }
        }
#pragma unroll
        for (int u = 0; u < 4; ++u)
#pragma unroll
            for (int e = 0; e < 4; ++e) {
                const float v0 = __uint_as_float(vv[u][e] << 16), v1 = __uint_as_float(vv[u][e] & 0xffff0000u);
#pragma unroll
                for (int hh = 0; hh < 4; ++hh) { o[hh][2 * e] += pp[u][hh] * v0; o[hh][2 * e + 1] += pp[u][hh] * v1; }
            }
    }
#pragma unroll
    for (int hh = 0; hh < 4; ++hh)
#pragma unroll
        for (int d = 0; d < 8; ++d) {
            float v = o[hh][d];
            v += __shfl_xor(v, 16);
            v += __shfl_xor(v, 32);
            o[hh][d] = v;
        }
    if (kg == 0) {
#pragma unroll
        for (int hh = 0; hh < 4; ++hh) {
            const float il = 1.f / ls[hh];
            u32x4 w;
            w.x = pack2(o[hh][0] * il, o[hh][1] * il); w.y = pack2(o[hh][2] * il, o[hh][3] * il);
            w.z = pack2(o[hh][4] * il, o[hh][5] * il); w.w = pack2(o[hh][6] * il, o[hh][7] * il);
            *(u32x4*)(p->outcat + (size_t)q * 2048 + 1024 + (g * 4 + hh) * 128 + dc * 8) = w;
        }
    }
    __builtin_amdgcn_s_waitcnt(0);
}

#define DSA2_WLDS (8192 + 512)
__device__ __forceinline__ void dsa_task2(KP p, int q, unsigned char* wl, u16* outp, int ldo, int coff) {
    const int lane = ltid() & 63, fr = lane & 15, fq = lane >> 4;
    unsigned char* sV = wl;
    u16* sS = (u16*)(wl + 8192);
    const int nsel = q < 255 ? q + 1 : 256;
    *(u32x2*)(sS + lane * 4) = *(const u32x2*)(p->sel + (size_t)q * 256 + lane * 4);
    const int vch = lane & 15, vr0 = lane >> 4;
    int rdo[2];
#pragma unroll
    for (int t = 0; t < 2; ++t) rdo[t] = (8 * fq + 4 * t + (fr >> 2)) * 256 + 8 * (fr & 1);
    const int xr0 = ((fr >> 2) << 2) | ((2 * fq) & 3), xr1 = ((fr >> 2) << 2) | ((2 * fq + 1) & 3);
    const int hsel = (fr & 3) >> 1;
    __builtin_amdgcn_s_waitcnt(0);
#pragma unroll 1
    for (int g = 0; g < 2; ++g) {
        bf16x8 qf[4];
#pragma unroll
        for (int c = 0; c < 4; ++c) {
            u32x4 v = (u32x4){0u, 0u, 0u, 0u};
            if (fr < 4) v = *(const u32x4*)(p->qb + (size_t)q * 1024 + (g * 4 + fr) * 128 + c * 32 + fq * 8);
            qf[c] = *(bf16x8*)&v;
        }
        f32x4 O[8];
#pragma unroll
        for (int cc = 0; cc < 8; ++cc) O[cc] = (f32x4){0.f, 0.f, 0.f, 0.f};
        float mrun = -1e30f, lrun = 0.f;
        const int nstep = (nsel + 31) >> 5;
        bf16x8 fa0[4], fb0[4], fa1[4], fb1[4];
        u32x4 vv0[8], vv1[8];
#define DSA_LOAD(c, FA, FB, VV) do { \
            const int ka_ = sS[32 * (c) + fr], kb_ = sS[32 * (c) + 16 + fr]; \
            const u16* kra = p->kb + (size_t)ka_ * 256 + g * 128 + fq * 8; \
            const u16* krb = p->kb + (size_t)kb_ * 256 + g * 128 + fq * 8; \
            _Pragma("unroll") for (int cc = 0; cc < 4; ++cc) { FA[cc] = *(const bf16x8*)(kra + cc * 32); FB[cc] = *(const bf16x8*)(krb + cc * 32); } \
            _Pragma("unroll") for (int i = 0; i < 8; ++i) { \
                const int r = vr0 + 4 * i; \
                const int kv = sS[32 * (c) + 16 * ((r >> 2) & 1) + 4 * (r >> 3) + (r & 3)]; \
                VV[i] = *(const u32x4*)(p->vb + (size_t)kv * 256 + g * 128 + vch * 8); } } while (0)
#define DSA_COMP(c, FA, FB, VV) do { \
            f32x4 s0 = (f32x4){0.f, 0.f, 0.f, 0.f}, s1 = (f32x4){0.f, 0.f, 0.f, 0.f}; \
            _Pragma("unroll") for (int cc = 0; cc < 4; ++cc) { \
                s0 = __builtin_amdgcn_mfma_f32_16x16x32_bf16(FA[cc], qf[cc], s0, 0, 0, 0); \
                s1 = __builtin_amdgcn_mfma_f32_16x16x32_bf16(FB[cc], qf[cc], s1, 0, 0, 0); } \
            float mx = -1e30f; \
            _Pragma("unroll") for (int j = 0; j < 4; ++j) { \
                if (32 * (c) + 4 * fq + j >= nsel) s0[j] = -1e30f; \
                if (32 * (c) + 16 + 4 * fq + j >= nsel) s1[j] = -1e30f; \
                mx = fmaxf(mx, fmaxf(s0[j], s1[j])); } \
            mx = fmaxf(mx, __shfl_xor(mx, 16)); \
            mx = fmaxf(mx, __shfl_xor(mx, 32)); \
            const float mnew = fmaxf(mrun, mx); \
            const float al = __builtin_amdgcn_exp2f(mrun - mnew); \
            mrun = mnew; \
            float ps = 0.f; \
            _Pragma("unroll") for (int j = 0; j < 4; ++j) { \
                s0[j] = __builtin_amdgcn_exp2f(s0[j] - mnew); s1[j] = __builtin_amdgcn_exp2f(s1[j] - mnew); \
                ps += s0[j] + s1[j]; } \
            lrun = lrun * al + ps; \
            if (__ballot(al != 1.0f) != 0ull) { _Pragma("unroll") for (int cc = 0; cc < 8; ++cc) O[cc] *= al; } \
            u32x4 pw; \
            pw.x = pack2(s0[0], s0[1]); pw.y = pack2(s0[2], s0[3]); pw.z = pack2(s1[0], s1[1]); pw.w = pack2(s1[2], s1[3]); \
            const bf16x8 pf = *(bf16x8*)&pw; \
            _Pragma("unroll") for (int i = 0; i < 8; ++i) { \
                const int r = vr0 + 4 * i; \
                *(u32x4*)(sV + r * 256 + 16 * (vch ^ (((r & 3) << 2) | ((r >> 2) & 3)))) = VV[i]; } \
            __builtin_amdgcn_s_waitcnt(0xc07f); \
            _Pragma("unroll") for (int cc = 0; cc < 8; ++cc) { \
                const s16x4 lo_ = __builtin_amdgcn_ds_read_tr16_b64_v4i16((LAS s16x4*)(sV + rdo[0] + 16 * ((2 * cc + hsel) ^ xr0))); \
                const s16x4 hi_ = __builtin_amdgcn_ds_read_tr16_b64_v4i16((LAS s16x4*)(sV + rdo[1] + 16 * ((2 * cc + hsel) ^ xr1))); \
                const bf16x8 vf = __builtin_shufflevector(lo_, hi_, 0, 1, 2, 3, 4, 5, 6, 7); \
                O[cc] = __builtin_amdgcn_mfma_f32_16x16x32_bf16(vf, pf, O[cc], 0, 0, 0); } \
            __builtin_amdgcn_s_waitcnt(0xc07f); } while (0)
        DSA_LOAD(0, fa0, fb0, vv0);
#pragma unroll 1
        for (int c = 0; c < nstep; c += 2) {
            const int c1 = c + 1 < nstep ? c + 1 : nstep - 1, c2 = c + 2 < nstep ? c + 2 : nstep - 1;
            DSA_LOAD(c1, fa1, fb1, vv1);
            DSA_COMP(c, fa0, fb0, vv0);
            DSA_LOAD(c2, fa0, fb0, vv0);
            if (c + 1 < nstep) DSA_COMP(c + 1, fa1, fb1, vv1);
        }
#undef DSA_LOAD
#undef DSA_COMP
        float l = lrun;
        l += __shfl_xor(l, 16);
        l += __shfl_xor(l, 32);
        if (fr < 4) {
            const float il = 1.f / l;
            u16* dst = outp + (size_t)q * ldo + coff + (g * 4 + fr) * 128 + 4 * fq;
#pragma unroll
            for (int cc = 0; cc < 8; ++cc) {
                u32x2 w; w.x = pack2(O[cc][0] * il, O[cc][1] * il); w.y = pack2(O[cc][2] * il, O[cc][3] * il);
                *(u32x2*)(dst + 16 * cc) = w;
            }
        }
    }
    __builtin_amdgcn_s_waitcnt(0);
}

#define ATT_NMLA 384
#define CVT_CHUNK (256 * 1024)
#define CVT_N_OUT0 16
#define CVT_N_IN1 96
#define CVT_N_OUT1 32
#define CVT_N_SH 8
#define ATT_NCVT (CVT_N_OUT0 + CVT_N_IN1 + CVT_N_OUT1 + 6 * CVT_N_SH)
template <int RMAP = 0>
__device__ __forceinline__ void cvtT_block(const float* src, u16* dst, int K, int N, int kb, int nb, unsigned char* smem) {
    const int tid = ltid();
    u16* t = (u16*)smem;
    __syncthreads();
#pragma unroll
    for (int i = 0; i < 8; ++i) {
        const int k = (tid >> 6) + 8 * i, n4 = (tid & 63) * 4;
        f32x4 v = (f32x4){0.f, 0.f, 0.f, 0.f};
        if (nb * 256 + n4 < N) v = *(const f32x4*)(src + (size_t)(kb * 64 + k) * N + nb * 256 + n4);
#pragma unroll
        for (int e = 0; e < 4; ++e) t[(n4 + e) * 72 + k] = f2bf(v[e]);
    }
    __syncthreads();
#pragma unroll
    for (int i = 0; i < 4; ++i) {
        const int n = (tid >> 3) + 64 * i, ch = tid & 7;
        const int drow = RMAP == 0 ? nb * 256 + n : 512 * nb + (n >> 7) * 256 + 128 * (RMAP - 1) + (n & 127);
        *(u32x4*)(dst + (size_t)drow * K + kb * 64 + ch * 8) = *(const u32x4*)(t + n * 72 + ch * 8);
    }
}
#define CVT_NT_OUT1 (64 * 8)
#define CVT_NT_OUT0 (32 * 8)
#define CVT_NT_IN1 (32 * 48)
#define CVT_NT_SHGU (32 * 4)
#define CVT_NT_SHD (16 * 8)
#define CVT_NT_SH (2 * CVT_NT_SHGU + CVT_NT_SHD)
__device__ __forceinline__ void cvt_item(KP p, int c, unsigned char* smem) {
    if (c >= ATT_NCVT) {
        int u = c - ATT_NCVT;
        if (u < CVT_NT_OUT1) { cvtT_block(p->w_out1, p->w_out1t, 4096, 2048, u >> 3, u & 7, smem); return; }
        u -= CVT_NT_OUT1;
        if (u < CVT_NT_OUT0) { cvtT_block(p->w_out0, p->w_out0t, 2048, 2048, u >> 3, u & 7, smem); return; }
        u -= CVT_NT_OUT0;
        if (u < CVT_NT_IN1) { cvtT_block(p->w_in1, p->w_in1t, 2048, IN_C, u / 48, u % 48, smem); return; }
        u -= CVT_NT_IN1;
        const int l = u / CVT_NT_SH; u -= l * CVT_NT_SH;
        if (u < CVT_NT_SHGU) { cvtT_block<1>(p->sh_g[l], p->sh_gut[l], 2048, 1024, u >> 2, u & 3, smem); return; }
        u -= CVT_NT_SHGU;
        if (u < CVT_NT_SHGU) { cvtT_block<2>(p->sh_u[l], p->sh_gut[l], 2048, 1024, u >> 2, u & 3, smem); return; }
        u -= CVT_NT_SHGU;
        cvtT_block(p->sh_d[l], p->sh_dt[l], 1024, 2048, u >> 3, u & 7, smem); return;
    }
    const float* src; u16* dst;
    if (c < CVT_N_OUT0) { return; }
    else if ((c -= CVT_N_OUT0) < CVT_N_IN1) { return; }
    else if ((c -= CVT_N_IN1) < CVT_N_OUT1) { return; }
    else {
        return;
        c -= CVT_N_OUT1;
        const int which = c / CVT_N_SH; c -= which * CVT_N_SH;
        const int l = which / 3, m = which % 3;
        src = m == 0 ? p->sh_g[l] : (m == 1 ? p->sh_u[l] : p->sh_d[l]);
        dst = m == 0 ? p->sh_gb[l] : (m == 1 ? p->sh_ub[l] : p->sh_db[l]);
    }
    const size_t base = (size_t)c * CVT_CHUNK;
    for (int i = ltid(); i < CVT_CHUNK / 8; i += NT) {
        const f32x4 a = *(const f32x4*)(src + base + (size_t)i * 8), b = *(const f32x4*)(src + base + (size_t)i * 8 + 4);
        u32x4 o; o.x = pack2(a[0], a[1]); o.y = pack2(a[2], a[3]); o.z = pack2(b[0], b[1]); o.w = pack2(b[2], b[3]);
        *(u32x4*)(dst + base + (size_t)i * 8) = o;
    }
}
__device__ const unsigned char mla_order[48] = {31, 63, 79, 30, 62, 29, 61, 78, 28, 60, 27, 59, 77, 26, 58, 25, 57, 76, 24, 56, 23, 55, 75, 22, 54, 21, 53, 74, 20, 52, 19, 51, 73, 18, 50, 17, 49, 72, 16, 48, 71, 70, 69, 68, 67, 66, 65, 64};
#define ATT_NTOTAL (ATT_NMLA + 512 + ATT_NCVT + CVT_NT_OUT1 + CVT_NT_OUT0 + CVT_NT_IN1 + 2 * CVT_NT_SH)
__device__ __forceinline__ void ph_attn(KP p, unsigned char* smem, unsigned* misc, int qword = CTL_QUEUE, int lo = 0, int hi = ATT_NTOTAL) {
    const int tid = ltid(), wid = tid >> 6;
    for (;;) {
        __syncthreads();
        if (tid == 0) misc[0] = atomicAdd(&p->ctl[qword], 1u);
        __syncthreads();
        const int it = (int)misc[0] + lo;
        if (it >= hi) break;
        if (it < ATT_NMLA) {
            const int e = mla_order[it >> 3];
            const int sg = e >> 5;
            mla_item(p, it & 7, e & 31, (u16*)smem, sg == 2 ? -1 : sg);
        } else if (it >= ATT_NMLA + 512) {
            cvt_item(p, it - ATT_NMLA - 512, smem);
        } else {
            const int base = (it - ATT_NMLA) * 16;
#ifdef DSA_VALU
            for (int k = 0; k < 4; ++k) {
                const int task = wid * 4 + k;
                dsa_task(p, base + (task >> 1), task & 1, smem + wid * DSA_WLDS);
            }
#else
            for (int k = 0; k < 2; ++k) dsa_task2(p, base + wid * 2 + k, smem + wid * DSA2_WLDS, p->outcat, 2048, 1024);
#endif
        }
    }
}
__device__ __forceinline__ float ret_log2g(int h);

struct PgEpiResid {
    static constexpr bool PERM = true, AFTER_DRAIN = false;
    u16* C; const u16* X; int ldc;
    __device__ __forceinline__ void operator()(const pg8::f32x4 (&acc)[2][2][4][2], const pg8::Unit& u, int wr, int wc, int fr, int fq) const {
        const int row0 = u.pm * 256 + wr * 64 + fr, col0 = u.pn * 256 + wc * 32 + 8 * fq;
#pragma unroll
        for (int ai = 0; ai < 2; ++ai) {
            u32x4 xv[4][2];
#pragma unroll
            for (int m = 0; m < 4; ++m)
#pragma unroll
                for (int bj = 0; bj < 2; ++bj) xv[m][bj] = *(const u32x4*)(X + (size_t)(row0 + ai * 128 + m * 16) * ldc + col0 + bj * 128);
#pragma unroll
            for (int m = 0; m < 4; ++m)
#pragma unroll
                for (int bj = 0; bj < 2; ++bj) {
                    const pg8::f32x4 v0 = acc[ai][bj][m][0], v1 = acc[ai][bj][m][1];
                    const u32x4 x = xv[m][bj];
                    u32x4 w;
                    w.x = pack2(__uint_as_float(x.x << 16) * ALPHA_ + v0[0], __uint_as_float(x.x & 0xffff0000u) * ALPHA_ + v0[1]);
                    w.y = pack2(__uint_as_float(x.y << 16) * ALPHA_ + v0[2], __uint_as_float(x.y & 0xffff0000u) * ALPHA_ + v0[3]);
                    w.z = pack2(__uint_as_float(x.z << 16) * ALPHA_ + v1[0], __uint_as_float(x.z & 0xffff0000u) * ALPHA_ + v1[1]);
                    w.w = pack2(__uint_as_float(x.w << 16) * ALPHA_ + v1[2], __uint_as_float(x.w & 0xffff0000u) * ALPHA_ + v1[3]);
                    *(u32x4*)(C + (size_t)(row0 + ai * 128 + m * 16) * ldc + col0 + bj * 128) = w;
                }
        }
    }
};

struct PgEpiResidF {
    static constexpr bool PERM = true, AFTER_DRAIN = false;
    u16* C; const float* X; int ldc;
    __device__ __forceinline__ void operator()(const pg8::f32x4 (&acc)[2][2][4][2], const pg8::Unit& u, int wr, int wc, int fr, int fq) const {
        const int row0 = u.pm * 256 + wr * 64 + fr, col0 = u.pn * 256 + wc * 32 + 8 * fq;
#pragma unroll
        for (int ai = 0; ai < 2; ++ai)
#pragma unroll
            for (int m = 0; m < 4; ++m) {
                f32x4 xv[2][2];
#pragma unroll
                for (int bj = 0; bj < 2; ++bj) {
                    const float* xp = X + (size_t)(row0 + ai * 128 + m * 16) * ldc + col0 + bj * 128;
                    xv[bj][0] = *(const f32x4*)xp; xv[bj][1] = *(const f32x4*)(xp + 4);
                }
#pragma unroll
                for (int bj = 0; bj < 2; ++bj) {
                    const f32x4 a = xv[bj][0] * ALPHA_ + acc[ai][bj][m][0], b = xv[bj][1] * ALPHA_ + acc[ai][bj][m][1];
                    u32x4 w; w.x = pack2(a[0], a[1]); w.y = pack2(a[2], a[3]); w.z = pack2(b[0], b[1]); w.w = pack2(b[2], b[3]);
                    *(u32x4*)(C + (size_t)(row0 + ai * 128 + m * 16) * ldc + col0 + bj * 128) = w;
                }
                asm volatile("" ::: "memory");
            }
    }
};
struct PgEpiL1 {
    static constexpr bool PERM = true, AFTER_DRAIN = false;
    KP p;
    __device__ __forceinline__ void operator()(const pg8::f32x4 (&acc)[2][2][4][2], const pg8::Unit& u, int wr, int wc, int fr, int fq) const {
        const int row0 = u.pm * 256 + wr * 64 + fr, ci = wc * 32 + 8 * fq;
        const int pn = u.pn;
        if (pn < 16) {
            const bool isk = pn >= 8; const int hd = pn & 7;
            const float l2g = ret_log2g(hd);
            const float* cR = p->cosR; const float* sR = p->sinR;
#pragma unroll
            for (int ai = 0; ai < 2; ++ai)
#pragma unroll
                for (int m = 0; m < 4; ++m) {
                    const int t = row0 + ai * 128 + m * 16;
                    const float dec = isk ? exp2f((float)(127 - (t & 127)) * l2g) : exp2f((float)((t & 127) + 1) * l2g);
                    f32x4 lo[2], hi[2];
#pragma unroll
                    for (int n = 0; n < 2; ++n) {
                        const f32x4 c = *(const f32x4*)(cR + t * 128 + ci + 4 * n), s = *(const f32x4*)(sR + t * 128 + ci + 4 * n);
                        const f32x4 x1 = acc[ai][0][m][n], x2 = acc[ai][1][m][n];
                        lo[n] = x1 * c - x2 * s; hi[n] = x1 * s + x2 * c;
                        if (isk) { lo[n] *= 0.0625f; hi[n] *= 0.0625f; }
                    }
                    const size_t o = (size_t)t * 2048 + hd * 256 + ci;
                    u16* d0 = isk ? p->kr : p->qr; u16* d1 = isk ? p->kz : p->qx;
                    u32x4 w;
                    w.x = pack2(lo[0][0], lo[0][1]); w.y = pack2(lo[0][2], lo[0][3]); w.z = pack2(lo[1][0], lo[1][1]); w.w = pack2(lo[1][2], lo[1][3]);
                    *(u32x4*)(d0 + o) = w;
                    w.x = pack2(hi[0][0], hi[0][1]); w.y = pack2(hi[0][2], hi[0][3]); w.z = pack2(hi[1][0], hi[1][1]); w.w = pack2(hi[1][2], hi[1][3]);
                    *(u32x4*)(d0 + o + 128) = w;
                    lo[0] *= dec; lo[1] *= dec; hi[0] *= dec; hi[1] *= dec;
                    w.x = pack2(lo[0][0], lo[0][1]); w.y = pack2(lo[0][2], lo[0][3]); w.z = pack2(lo[1][0], lo[1][1]); w.w = pack2(lo[1][2], lo[1][3]);
                    *(u32x4*)(d1 + o) = w;
                    w.x = pack2(hi[0][0], hi[0][1]); w.y = pack2(hi[0][2], hi[0][3]); w.z = pack2(hi[1][0], hi[1][1]); w.w = pack2(hi[1][2], hi[1][3]);
                    *(u32x4*)(d1 + o + 128) = w;
                    asm volatile("" ::: "memory");
                }
        } else {
            const bool isg = pn >= 32;
            u16* dst = isg ? p->sg : p->v1;
            const int cbase = (isg ? pn - 32 : pn - 16) * 256 + ci;
#pragma unroll
            for (int ai = 0; ai < 2; ++ai)
#pragma unroll
                for (int m = 0; m < 4; ++m)
#pragma unroll
                    for (int bj = 0; bj < 2; ++bj) {
                        f32x4 a = acc[ai][bj][m][0], b = acc[ai][bj][m][1];
                        if (isg) {
#pragma unroll
                            for (int e = 0; e < 4; ++e) { a[e] = silu_f(a[e]); b[e] = silu_f(b[e]); }
                        }
                        u32x4 w; w.x = pack2(a[0], a[1]); w.y = pack2(a[2], a[3]); w.z = pack2(b[0], b[1]); w.w = pack2(b[2], b[3]);
                        *(u32x4*)(dst + (size_t)(row0 + ai * 128 + m * 16) * 4096 + cbase + bj * 128) = w;
                    }
        }
    }
};

struct PgEpiBf16N {
    static constexpr bool PERM = true, AFTER_DRAIN = false;
    u16* C; int ldc; int ncols;
    __device__ __forceinline__ void operator()(const pg8::f32x4 (&acc)[2][2][4][2], const pg8::Unit& u, int wr, int wc, int fr, int fq) const {
        const int row0 = u.pm * 256 + wr * 64 + fr, col0 = u.pn * 256 + wc * 32 + 8 * fq;
#pragma unroll
        for (int ai = 0; ai < 2; ++ai)
#pragma unroll
            for (int m = 0; m < 4; ++m)
#pragma unroll
                for (int bj = 0; bj < 2; ++bj) {
                    const int c = col0 + bj * 128;
                    if (c < ncols) {
                        const pg8::f32x4 a = acc[ai][bj][m][0], b = acc[ai][bj][m][1];
                        u32x4 w; w.x = pack2(a[0], a[1]); w.y = pack2(a[2], a[3]); w.z = pack2(b[0], b[1]); w.w = pack2(b[2], b[3]);
                        *(u32x4*)(C + (size_t)(row0 + ai * 128 + m * 16) * ldc + c) = w;
                    }
                }
    }
};
struct PgEpiSwiglu {
    static constexpr bool PERM = true, AFTER_DRAIN = false;
    u16* C; int ldc;
    __device__ __forceinline__ void operator()(const pg8::f32x4 (&acc)[2][2][4][2], const pg8::Unit& u, int wr, int wc, int fr, int fq) const {
        const int row0 = u.pm * 256 + wr * 64 + fr, col0 = u.pn * 128 + wc * 32 + 8 * fq;
#pragma unroll
        for (int ai = 0; ai < 2; ++ai)
#pragma unroll
            for (int m = 0; m < 4; ++m) {
                const pg8::f32x4 g0 = acc[ai][0][m][0], g1 = acc[ai][0][m][1], u0 = acc[ai][1][m][0], u1 = acc[ai][1][m][1];
                float o[8];
#pragma unroll
                for (int e = 0; e < 4; ++e) { o[e] = silu_f(g0[e]) * u0[e]; o[4 + e] = silu_f(g1[e]) * u1[e]; }
                u32x4 w; w.x = pack2(o[0], o[1]); w.y = pack2(o[2], o[3]); w.z = pack2(o[4], o[5]); w.w = pack2(o[6], o[7]);
                *(u32x4*)(C + (size_t)(row0 + ai * 128 + m * 16) * ldc + col0) = w;
            }
    }
};
template <bool ADD_ROUTED, bool ROUTE, bool WRITE_B, bool WRITE_F, bool BLK = false>
__device__ __forceinline__ void ph_ln(KP p, const u16* Y, const float* g, const float* b, float* XF, u16* XB, u16* XL, int tb = 0) {
    const int lane = ltid() & 63;
    const int gw = BLK ? tb + (ltid() >> 6) : (blockIdx.x * NT + ltid()) >> 6, nw = BLK ? 8 : (gridDim.x * NT) >> 6;
    const int T_end = BLK ? tb + 32 : T_;
    f32x4 gg[8], bb[8];
#pragma unroll
    for (int j = 0; j < 8; ++j) { gg[j] = *(const f32x4*)(g + j * 256 + lane * 4); bb[j] = *(const f32x4*)(b + j * 256 + lane * 4); }
    for (int t0 = gw; t0 < T_end; t0 += 2 * nw) {
        u32x2 raw[2][8], r0raw[2][8], r1raw[2][8];
#pragma unroll
        for (int rr = 0; rr < 2; ++rr) {
            const int t = t0 + rr * nw < T_end ? t0 + rr * nw : t0;
            const u16* y = Y + (size_t)t * D_;
#pragma unroll
            for (int j = 0; j < 8; ++j) raw[rr][j] = *(const u32x2*)(y + j * 256 + lane * 4);
            if constexpr (ADD_ROUTED) {
                const u16* r0 = p->yr + (size_t)(2 * t) * D_;
                const u16* r1 = r0 + D_;
#pragma unroll
                for (int j = 0; j < 8; ++j) { r0raw[rr][j] = *(const u32x2*)(r0 + j * 256 + lane * 4); r1raw[rr][j] = *(const u32x2*)(r1 + j * 256 + lane * 4); }
            }
        }
#pragma unroll
        for (int rr = 0; rr < 2; ++rr) {
            const int t = t0 + rr * nw;
            if (t >= T_end) break;
            float v[32];
            float sum = 0.f;
#pragma unroll
            for (int j = 0; j < 8; ++j) {
                const u32x2 a = raw[rr][j];
                v[4 * j] = __uint_as_float(a.x << 16); v[4 * j + 1] = __uint_as_float(a.x & 0xffff0000u);
                v[4 * j + 2] = __uint_as_float(a.y << 16); v[4 * j + 3] = __uint_as_float(a.y & 0xffff0000u);
            }
            if constexpr (ADD_ROUTED) {
#pragma unroll
                for (int j = 0; j < 8; ++j) {
                    const u32x2 a = r0raw[rr][j], c = r1raw[rr][j];
                    v[4 * j]     += __uint_as_float(a.x << 16) + __uint_as_float(c.x << 16);
                    v[4 * j + 1] += __uint_as_float(a.x & 0xffff0000u) + __uint_as_float(c.x & 0xffff0000u);
                    v[4 * j + 2] += __uint_as_float(a.y << 16) + __uint_as_float(c.y << 16);
                    v[4 * j + 3] += __uint_as_float(a.y & 0xffff0000u) + __uint_as_float(c.y & 0xffff0000u);
                }
            }
#pragma unroll
            for (int i = 0; i < 32; ++i) sum += v[i];
            const float mu = wave_sum(sum) * (1.f / 2048.f);
            float var = 0.f;
#pragma unroll
            for (int i = 0; i < 32; ++i) { const float d = v[i] - mu; var += d * d; }
            var = wave_sum(var) * (1.f / 2048.f);
            const float rs = rsqrtf(var + 1e-5f);
#pragma unroll
            for (int j = 0; j < 8; ++j) {
                const int c = j * 256 + lane * 4;
                f32x4 o;
#pragma unroll
                for (int e = 0; e < 4; ++e) o[e] = (v[4 * j + e] - mu) * rs * gg[j][e] + bb[j][e];
                if constexpr (WRITE_F) *(f32x4*)(XF + (size_t)t * D_ + c) = o;
                if constexpr (WRITE_B) {
                    u32x2 w; w.x = pack2(o[0], o[1]); w.y = pack2(o[2], o[3]);
                    *(u32x2*)(XB + (size_t)t * D_ + c) = w;
                    if constexpr (ROUTE) {
                        u32x2 wl;
                        wl.x = pack2(o[0] - __uint_as_float(w.x << 16), o[1] - __uint_as_float(w.x & 0xffff0000u));
                        wl.y = pack2(o[2] - __uint_as_float(w.y << 16), o[3] - __uint_as_float(w.y & 0xffff0000u));
                        *(u32x2*)(XL + (size_t)t * D_ + c) = wl;
                    }
                }
            }
        }
    }
}

__device__ __forceinline__ void route_token(KP p, int t, float logit, int lane, unsigned* cnt, int* list) {
    const float sc = 1.f / (1.f + __expf(-logit));
    const float bi = sc + p->router_b[lane];
    float m1 = bi;
    m1 = fmaxf(m1, __shfl_xor(m1, 1)); m1 = fmaxf(m1, __shfl_xor(m1, 2)); m1 = fmaxf(m1, __shfl_xor(m1, 4));
    const int seg = lane >> 3;
    unsigned long long bal = __ballot(bi == m1);
    const int f1 = __builtin_ctz((unsigned)((bal >> (seg * 8)) & 0xffull));
    const float b2 = ((lane & 7) == f1) ? -1e30f : bi;
    float m2 = b2;
    m2 = fmaxf(m2, __shfl_xor(m2, 1)); m2 = fmaxf(m2, __shfl_xor(m2, 2)); m2 = fmaxf(m2, __shfl_xor(m2, 4));
    bal = __ballot(b2 == m2);
    const int f2 = __builtin_ctz((unsigned)((bal >> (seg * 8)) & 0xffull));
    const float gs = m1 + m2;
    float gm = gs;
    gm = fmaxf(gm, __shfl_xor(gm, 8)); gm = fmaxf(gm, __shfl_xor(gm, 16)); gm = fmaxf(gm, __shfl_xor(gm, 32));
    bal = __ballot(gs == gm);
    const int gsel = (int)(__builtin_ctzll(bal) >> 3);
    const int e0 = gsel * 8 + __shfl(f1, gsel * 8);
    const int e1 = gsel * 8 + __shfl(f2, gsel * 8);
    const float s0 = __shfl(sc, e0), s1 = __shfl(sc, e1);
    if (lane == 0) {
        const float inv = 1.f / (s0 + s1);
        const unsigned p0 = atomicAdd(&cnt[e0 * CNT_STRIDE], 1u);
        const unsigned p1 = atomicAdd(&cnt[e1 * CNT_STRIDE], 1u);
        list[e0 * T_ + p0] = 2 * t;
        list[e1 * T_ + p1] = 2 * t + 1;
        p->tok_g[2 * t] = s0 * inv;
        p->tok_g[2 * t + 1] = s1 * inv;
    }
}

__device__ __forceinline__ void router_block(KP p, unsigned char* smem, unsigned* cnt, int* list, int blk) {
    const int tid = ltid(), lane = tid & 63, wid = tid >> 6, grp = wid >> 2, kq = wid & 3, fr = lane & 15, fq = lane >> 4;
    float* part = (float*)smem;
    {
        const int t0 = blk * 32 + grp * 16;
        f32x4 acc[4];
#pragma unroll
        for (int c = 0; c < 4; ++c) acc[c] = (f32x4){0.f, 0.f, 0.f, 0.f};
        const u16* ah = p->xab + (size_t)(t0 + fr) * D_ + kq * 512 + fq * 8;
        const u16* al = p->xlb + (size_t)(t0 + fr) * D_ + kq * 512 + fq * 8;
        const u16* bh = p->whT + (size_t)fr * D_ + kq * 512 + fq * 8;
        const u16* bl = p->wlT + (size_t)fr * D_ + kq * 512 + fq * 8;
#pragma unroll 8
        for (int s = 0; s < 16; ++s) {
            const bf16x8 xh = *(const bf16x8*)(ah + 32 * s), xl = *(const bf16x8*)(al + 32 * s);
#pragma unroll
            for (int c = 0; c < 4; ++c) {
                const bf16x8 wh = *(const bf16x8*)(bh + (size_t)c * 16 * D_ + 32 * s);
                const bf16x8 wl = *(const bf16x8*)(bl + (size_t)c * 16 * D_ + 32 * s);
                acc[c] = __builtin_amdgcn_mfma_f32_16x16x32_bf16(xh, wh, acc[c], 0, 0, 0);
                acc[c] = __builtin_amdgcn_mfma_f32_16x16x32_bf16(xh, wl, acc[c], 0, 0, 0);
                acc[c] = __builtin_amdgcn_mfma_f32_16x16x32_bf16(xl, wh, acc[c], 0, 0, 0);
            }
        }
        float* mine = part + (grp * 4 + kq) * 1024;
#pragma unroll
        for (int c = 0; c < 4; ++c)
#pragma unroll
            for (int j = 0; j < 4; ++j) mine[(4 * fq + j) * 64 + 16 * c + fr] = acc[c][j];
        __syncthreads();
#pragma unroll
        for (int tt = 0; tt < 4; ++tt) {
            const int tok = 4 * kq + tt;
            const float* q = part + (grp * 4) * 1024 + tok * 64 + lane;
            const float logit = (q[0] + q[1024]) + (q[2048] + q[3072]);
            route_token(p, t0 + tok, logit, lane, cnt, list);
        }
        __syncthreads();
    }
}
__device__ __forceinline__ void ph_ln_router(KP p, const u16* Y, const float* g, const float* b, u16* XB, u16* XL, unsigned char* smem, unsigned* cnt, int* list) {
    for (int blk = blockIdx.x; blk < T_ / 32; blk += gridDim.x) {
        ph_ln<false, true, true, false, true>(p, Y, g, b, nullptr, XB, XL, blk * 32);
        asm volatile("s_waitcnt vmcnt(0)" ::: "memory");
        __syncthreads();
        router_block(p, smem, cnt, list, blk);
    }
}

struct ColGateUp16 { int c0; const u16* up;
    __device__ __forceinline__ const u16* base16(const u16* B, int hsel) const { return hsel ? up : B; }
    __device__ __forceinline__ unsigned off8(int hsel, int ch8) const { return (unsigned)(c0 + ch8 * 8); }
    __device__ __forceinline__ int vchunk(int hsel, int ch8) const { const int r = ch8 * 8; return ((r >> 5) * 64 + hsel * 32 + (r & 31)) >> 3; } };
struct ColGateUp { int c0; const float* up;
    __device__ __forceinline__ const float* base(const float* B, int hsel) const { return hsel ? up : B; }
    __device__ __forceinline__ unsigned off4(int hsel, int g4) const { return (unsigned)(c0 + g4 * 4); }
    __device__ __forceinline__ int vcol4(int hsel, int g4) const { const int r = g4 * 4; return (r >> 5) * 64 + hsel * 32 + (r & 31); } };
struct RowList { const int* lst; int m0, n; __device__ __forceinline__ int operator()(int r) const { const int i = m0 + r; return lst[i < n ? i : n - 1] >> 1; } };
struct EpiSwiglu {
    u16* C; int ldc; int row0, c0, nrows;
    __device__ __forceinline__ void operator()(Acc& acc, unsigned char* stg) const {
        const int wr0 = WR0_, cb = c0 + (WC0_ >> 1);
        u16* Cp = C; const int ld = ldc, rbase = row0, nr = nrows;
        stage_pairs(acc, stg, [=](int r, int c4, f32x4 g, f32x4 u) {
            const int rr = wr0 + r;
            if (rr < nr) {
                f32x4 o;
#pragma unroll
                for (int e = 0; e < 4; ++e) o[e] = silu_f(g[e]) * u[e];
                *(u32x2*)(Cp + (size_t)(rbase + rr) * ld + cb + c4) = pack4(o);
            }
        });
    }
};
struct SlotGate { int slot; float g; };
struct EpiDownRouted {
    u16* yr; const int* lst; const float* tg; int m0, n, col0;
    __device__ __forceinline__ void operator()(Acc& acc, unsigned char* stg) const {
        const int wr0 = WR0_, cb = col0 + WC0_;
        u16* yp = yr; const int* lp = lst; const float* tgp = tg; const int mm0 = m0, nn = n;
        stage_rows_pre<SlotGate>(acc, stg,
            [=](int r, int c4) -> SlotGate {
                const int i = mm0 + wr0 + r;
                const int s_ = lp[i < nn ? i : nn - 1];
                SlotGate sg; sg.g = tgp[s_]; sg.slot = i < nn ? s_ : -1;
                return sg; },
            [=](int r, int c4, f32x4 v, SlotGate sg) {
                if (sg.slot >= 0) *(u32x2*)(yp + (size_t)sg.slot * D_ + cb + c4) = pack4(v * sg.g); });
    }
};

struct RowH { int base, mx; __device__ __forceinline__ int operator()(int r) const { const int i = base + r; return i < mx ? i : mx; } };
__device__ __forceinline__ void moe_prefix(const unsigned* cnt, int* s_tp, int* s_off) {
    __syncthreads();
    if (ltid() == 0) {
        int tp = 0, off = 0;
        for (int e = 0; e < 64; ++e) {
            const int n = (int)__hip_atomic_load(&cnt[e * CNT_STRIDE], __ATOMIC_RELAXED, __HIP_MEMORY_SCOPE_AGENT);
            s_tp[e] = tp; s_off[e] = off;
            tp += (n + 255) >> 8; off += n;
        }
        s_tp[64] = tp; s_off[64] = off;
    }
    __syncthreads();
}

struct RowGen { const int* lst; int m0, n, base; __device__ __forceinline__ int operator()(int r) const {
    const int i = m0 + r; return lst[i < n ? i : n - 1] >> 1; } };

#define MOE_GROUP() ((int)((blockIdx.x * 4u) / gridDim.x))
template <int L>
__device__ __forceinline__ void moe_up_routed(KP p, const u16* X, unsigned char* smem, int* s_tp, int* s_off, int j0, int j1) {
    u16* lds = (u16*)smem;
    const int nrt = s_tp[64] * 8;
    for (int j = j0; j < j1; ++j) {
        const int t = (int)blockIdx.x + j * (int)gridDim.x;
        if (t >= nrt) break;
        Acc acc; acc_zero(acc);
        const int mtile = t >> 3, nt = t & 7;
        int e = 0;
        for (int s = 32; s > 0; s >>= 1) if (e + s < 64 && s_tp[e + s] <= mtile) e += s;
        const int n = s_off[e + 1] - s_off[e], m0 = (mtile - s_tp[e]) * 256;
        gemm_accum<B_F32_KN, false>(acc, X, D_, RowGen{p->list + e * T_, m0, n, 0}, p->moe_wg[L] + (size_t)e * D_ * 512, 512,
                                    ColGateUp{nt * 64, p->moe_wu[L] + (size_t)e * D_ * 512}, D_, lds);
        EpiSwiglu{p->hbuf, 512, s_off[e] + m0, nt * 64, n - m0}(acc, smem);
    }
}
template <int L>
__device__ __forceinline__ void ph_moe_up(KP p, const u16* X, unsigned char* smem, int* s_tp, int* s_off) {
    const unsigned* cnt = p->ctl + (L == 0 ? CTL_CNT0 : CTL_CNT1);
    moe_prefix(cnt, s_tp, s_off);
    moe_up_routed<L>(p, X, smem, s_tp, s_off, 0, MOE_GROUP());
    {
        __syncthreads();
        pg8::Gemm g; g.A = X; g.Bt = p->sh_gut[L]; g.M = T_; g.N = 2048; g.K = D_;
        pg8::StaticOrder S; S.init(T_, 2048, (int)gridDim.x, (int)blockIdx.x);
        pg8::gemm_phase<PgEpiSwiglu, pg8::StaticOrder>((PG8_LAS unsigned char*)smem, g, S, PgEpiSwiglu{p->hsh, 1024}, nullptr);
        __syncthreads();
    }
    { KP p2 = getp(); moe_up_routed<L>(p2, p2->xab, smem, s_tp, s_off, MOE_GROUP(), 1 << 20); }
}

template <int L>
__device__ __forceinline__ void moe_down_routed(KP p, unsigned char* smem, int* s_tp, int* s_off, int j0, int j1) {
    u16* lds = (u16*)smem;
    const int nrt = s_tp[64] * 16;
    for (int j = j0; j < j1; ++j) {
        const int t = (int)blockIdx.x + j * (int)gridDim.x;
        if (t >= nrt) break;
        Acc acc; acc_zero(acc);
        const int mtile = t >> 4, nt = t & 15;
        int e = 0;
        for (int s = 32; s > 0; s >>= 1) if (e + s < 64 && s_tp[e + s] <= mtile) e += s;
        const int n = s_off[e + 1] - s_off[e], m0 = (mtile - s_tp[e]) * 256;
        gemm_accum<B_F32_KN, false>(acc, p->hbuf, 512, RowH{s_off[e] + m0, 2 * T_ - 1}, p->moe_wd[L] + (size_t)e * 512 * D_, D_, ColOff{nt * 128}, 512, lds);
        EpiDownRouted{p->yr, p->list + e * T_, p->tok_g, m0, n, nt * 128}(acc, smem);
    }
}
template <int L>
__device__ __forceinline__ void ph_moe_down(KP p, const u16* XBres, unsigned char* smem, int* s_tp, int* s_off) {
    const unsigned* cnt = p->ctl + (L == 0 ? CTL_CNT0 : CTL_CNT1);
    moe_prefix(cnt, s_tp, s_off);
    moe_down_routed<L>(p, smem, s_tp, s_off, 0, 2 * MOE_GROUP());
    {
        __syncthreads();
        pg8::Gemm g; g.A = p->hsh; g.Bt = p->sh_dt[L]; g.M = T_; g.N = D_; g.K = 1024;
        pg8::StaticOrder S; S.init(T_, D_, (int)gridDim.x, (int)blockIdx.x);
        pg8::gemm_phase<PgEpiResid, pg8::StaticOrder>((PG8_LAS unsigned char*)smem, g, S, PgEpiResid{p->y2, XBres, D_}, nullptr);
        __syncthreads();
    }
    moe_down_routed<L>(getp(), smem, s_tp, s_off, 2 * MOE_GROUP(), 1 << 20);
}
struct ColRot { int cbase; bool rot;
    __device__ __forceinline__ const u16* base16(const u16* B, int) const { return B; }
    __device__ __forceinline__ unsigned off8(int hsel, int ch8) const { const int v = hsel * 64 + ch8 * 8; const int s = v >> 6, u = v & 63;
        return rot ? (unsigned)(cbase + s * 32 + (u < 32 ? u : 128 + (u - 32))) : (unsigned)(cbase + v); }
    __device__ __forceinline__ int vchunk(int hsel, int ch8) const { return hsel * 8 + ch8; }
    __device__ __forceinline__ const float* base(const float* B, int) const { return B; }
    __device__ __forceinline__ unsigned off4(int hsel, int g4) const { const int v = hsel * 64 + g4 * 4; const int s = v >> 6, u = v & 63;
        return rot ? (unsigned)(cbase + s * 32 + (u < 32 ? u : 128 + (u - 32))) : (unsigned)(cbase + v); }
    __device__ __forceinline__ int vcol4(int hsel, int g4) const { return hsel * 64 + g4 * 4; } };

__device__ __forceinline__ float ret_log2g(int h) { return log1pf(-exp2f(-5.f - (float)h)) * LOG2E_; }

struct EpiRetQK {
    KP p; int row0; int hd; int tp; bool isk;
    __device__ __forceinline__ void operator()(Acc& acc, unsigned char* stg) const {
        const float l2g = ret_log2g(hd);
        const int wc0 = WC0_, rb = row0 + WR0_;
        const int dbase = tp * 64 + (wc0 >> 1);
        const float* cR = p->cosR; const float* sR = p->sinR;
        const int hoff = hd * 256 + dbase;
        if (!isk) {
            u16* qr = p->qr; u16* qx = p->qx;
            stage_pairs_pre<CS8>(acc, stg,
              [=](int r, int c4) -> CS8 { CS8 t; t.c = *(const f32x4*)(cR + (rb + r) * 128 + dbase + c4); t.s = *(const f32x4*)(sR + (rb + r) * 128 + dbase + c4); return t; },
              [=](int r, int c4, f32x4 x1, f32x4 x2, CS8 cs) {
                const int t = rb + r;
                const f32x4 c = cs.c, s = cs.s;
                const f32x4 lo = x1 * c - x2 * s, hi = x1 * s + x2 * c;
                const float xi = exp2f((float)((t & 127) + 1) * l2g);
                const size_t o = (size_t)t * 2048 + hoff + c4;
                *(u32x2*)(qr + o) = pack4(lo); *(u32x2*)(qr + o + 128) = pack4(hi);
                *(u32x2*)(qx + o) = pack4(lo * xi); *(u32x2*)(qx + o + 128) = pack4(hi * xi);
            });
        } else {
            const int lane = ltid() & 63, fr = lane & 15, fq = lane >> 4;
#pragma unroll
            for (int m = 0; m < 4; ++m) {
                const int r0 = rb + m * 16 + fq * 4;
#pragma unroll
                for (int n = 0; n < 2; ++n) {
                    const int i = dbase + n * 16 + fr;
                    float zl[4], zh[4];
#pragma unroll
                    for (int j = 0; j < 4; ++j) {
                        const int t = r0 + j;
                        const float c = cR[t * 128 + i], s = sR[t * 128 + i];
                        const float x1 = acc[m][n][j], x2 = acc[m][n + 2][j];
                        const float ze = exp2f((float)(127 - (t & 127)) * l2g) * 0.0625f;
                        zl[j] = (x1 * c - x2 * s) * ze; zh[j] = (x1 * s + x2 * c) * ze;
                    }
                    u32x2 a, b;
                    a.x = pack2(zl[0], zl[1]); a.y = pack2(zl[2], zl[3]);
                    b.x = pack2(zh[0], zh[1]); b.y = pack2(zh[2], zh[3]);
                    *(u32x2*)(p->kzT + (size_t)(hd * 256 + i) * T_ + r0) = a;
                    *(u32x2*)(p->kzT + (size_t)(hd * 256 + i + 128) * T_ + r0) = b;
                }
            }
            u16* kr = p->kr;
            stage_pairs_pre<CS8>(acc, stg,
              [=](int r, int c4) -> CS8 { CS8 t; t.c = *(const f32x4*)(cR + (rb + r) * 128 + dbase + c4); t.s = *(const f32x4*)(sR + (rb + r) * 128 + dbase + c4); return t; },
              [=](int r, int c4, f32x4 x1, f32x4 x2, CS8 cs) {
                const int t = rb + r;
                const f32x4 c = cs.c, s = cs.s;
                const f32x4 lo = (x1 * c - x2 * s) * 0.0625f, hi = (x1 * s + x2 * c) * 0.0625f;
                const size_t o = (size_t)t * 2048 + hoff + c4;
                *(u32x2*)(kr + o) = pack4(lo); *(u32x2*)(kr + o + 128) = pack4(hi);
            });
        }
    }
};
struct EpiRetV {
    u16* vT; int row0, col0;
    __device__ __forceinline__ void operator()(Acc& acc, unsigned char* stg) const {
        const int lane = ltid() & 63, fr = lane & 15, fq = lane >> 4, wr0 = WR0_, wc0 = WC0_;
#pragma unroll
        for (int m = 0; m < 4; ++m) {
            const int r0 = row0 + wr0 + m * 16 + fq * 4;
#pragma unroll
            for (int n = 0; n < 4; ++n) {
                u32x2 o; o.x = pack2(acc[m][n][0], acc[m][n][1]); o.y = pack2(acc[m][n][2], acc[m][n][3]);
                *(u32x2*)(vT + (size_t)(col0 + wc0 + n * 16 + fr) * T_ + r0) = o;
            }
        }
    }
};
struct EpiSilu {
    u16* C; int ldc; int row0, col0;
    __device__ __forceinline__ void operator()(Acc& acc, unsigned char* stg) const {
        const int rb = row0 + WR0_, cb = col0 + WC0_;
        u16* Cp = C; const int ld = ldc;
        stage_rows(acc, stg, [=](int r, int c4, f32x4 v) {
            f32x4 o;
#pragma unroll
            for (int e = 0; e < 4; ++e) o[e] = silu_f(v[e]);
            *(u32x2*)(Cp + (size_t)(rb + r) * ld + cb + c4) = pack4(o);
        });
    }
};
struct EpiInner {
    u16* C; int hd;
    __device__ __forceinline__ void operator()(Acc& acc, unsigned char* stg) const {
        const float l2g = ret_log2g(hd);
        const int wr0 = WR0_, wc0 = WC0_;
        u16* Cp = C;
        stage_rows(acc, stg, [=](int r, int c4, f32x4 v) {
            const int i = wr0 + r;
            f32x4 o;
#pragma unroll
            for (int e = 0; e < 4; ++e) { const int k = wc0 + c4 + e; o[e] = i >= k ? v[e] * exp2f((float)(i - k) * l2g) : 0.f; }
            *(u32x2*)(Cp + i * 128 + wc0 + c4) = pack4(o);
        });
    }
};


__device__ __forceinline__ void ph_ret_a(KP p, u16* lds) {
    const int nkv = 8 * 64 * 4, nin = 8 * 64;
    for (int t = blockIdx.x; t < nkv + nin; t += gridDim.x) {
        Acc acc; acc_zero(acc);
        if (t < nkv) {
            const int hc = t >> 2, nt = t & 3, hd = hc >> 6, c = hc & 63;
            gemm_kk128(acc, p->kz + (size_t)(c * 128) * 2048 + hd * 256, 2048, p->v1 + (size_t)(c * 128) * 4096 + hd * 512 + nt * 128, 4096, lds);
            EpiBF16{p->KVt + (size_t)hc * 512 * 256, 512, 0, nt * 128}(acc, (unsigned char*)lds);
        } else {
            const int hc = t - nkv, hd = hc >> 6, c = hc & 63;
            gemm_accum<B_BF16_NK, true>(acc, p->qr + hd * 256, 2048, RowId{c * 128}, p->kr + hd * 256, 2048, RowId{c * 128}, 256, lds);
            if (ksplit_reduce(acc, lds)) EpiInner{p->innerG + (size_t)hc * 128 * 128, hd}(acc, (unsigned char*)lds + 65536);
        }
    }
}
__device__ __forceinline__ void ph_ret_b(KP p) {
    const int gtid = blockIdx.x * NT + ltid(), gsz = gridDim.x * NT;
    for (int e = gtid; e < 8 * 512 * 256 / 8; e += gsz) {
        const int hd = e / (512 * 256 / 8);
        const int within = e - hd * (512 * 256 / 8);
        const float g128 = exp2f(128.f * ret_log2g(hd));
        u16* base = p->KVt + (size_t)hd * 64 * 512 * 256 + (size_t)within * 8;
        float r[8];
#pragma unroll
        for (int i = 0; i < 8; ++i) r[i] = 0.f;
        u32x4 cur[8], nxt[8];
#pragma unroll
        for (int i = 0; i < 8; ++i) cur[i] = *(const u32x4*)(base + (size_t)i * 512 * 256);
#pragma unroll 1
        for (int g = 0; g < 8; ++g) {
            const int gn_ = g < 7 ? g + 1 : 7;
#pragma unroll
            for (int i = 0; i < 8; ++i) nxt[i] = *(const u32x4*)(base + (size_t)(gn_ * 8 + i) * 512 * 256);
#pragma unroll
            for (int i = 0; i < 8; ++i) {
                const u32x4 in = cur[i];
                u32x4 o;
                o.x = pack2(r[0], r[1]); o.y = pack2(r[2], r[3]); o.z = pack2(r[4], r[5]); o.w = pack2(r[6], r[7]);
                *(u32x4*)(base + (size_t)(g * 8 + i) * 512 * 256) = o;
#pragma unroll
                for (int k = 0; k < 4; ++k) {
                    r[2 * k] = r[2 * k] * g128 + __uint_as_float(in[k] << 16);
                    r[2 * k + 1] = r[2 * k + 1] * g128 + __uint_as_float(in[k] & 0xffff0000u);
                }
            }
#pragma unroll
            for (int i = 0; i < 8; ++i) cur[i] = nxt[i];
        }
    }
}
__device__ __forceinline__ void ph_ret_c(KP p, u16* lds) {
    for (int t = blockIdx.x; t < 8 * 64 * 4; t += gridDim.x) {
        const int hc = t >> 2, nt = t & 3, hd = hc >> 6, c = hc & 63;
        Acc acc; acc_zero(acc);
        gemm_accum<B_BF16_KN, true>(acc, p->innerG + (size_t)hc * 128 * 128, 128, RowId{0}, p->v1 + (size_t)(c * 128) * 4096, 4096, ColOff{hd * 512 + nt * 128}, 128, lds);
        gemm_accum<B_BF16_KN, true>(acc, p->qx + hd * 256, 2048, RowId{c * 128}, p->KVt + (size_t)hc * 512 * 256, 512, ColOff{nt * 128}, 256, lds);
        if (ksplit_reduce(acc, lds)) EpiBF16{p->obuf, 4096, c * 128, hd * 512 + nt * 128}(acc, (unsigned char*)lds + 65536);
    }
}
__device__ __forceinline__ void ph_gn(KP p) {
    const int lane = ltid() & 63;
    const int gw = (blockIdx.x * NT + ltid()) >> 6, nw = (gridDim.x * NT) >> 6;
    const int hd = gw & 7;
    float gg[8], gb[8];
    {
        const f32x4 g0 = *(const f32x4*)(p->gn_g + hd * 512 + lane * 8), g1 = *(const f32x4*)(p->gn_g + hd * 512 + lane * 8 + 4);
        const f32x4 b0 = *(const f32x4*)(p->gn_b + hd * 512 + lane * 8), b1 = *(const f32x4*)(p->gn_b + hd * 512 + lane * 8 + 4);
#pragma unroll
        for (int i = 0; i < 4; ++i) { gg[i] = g0[i]; gg[4 + i] = g1[i]; gb[i] = b0[i]; gb[4 + i] = b1[i]; }
    }
    for (int r0 = gw; r0 < T_ * 8; r0 += 4 * nw) {
        u32x4 in[4], gin[4];
#pragma unroll
        for (int u = 0; u < 4; ++u) {
            const int r = r0 + u * nw < T_ * 8 ? r0 + u * nw : r0;
            const size_t off = (size_t)(r >> 3) * 4096 + hd * 512 + lane * 8;
            in[u] = *(const u32x4*)(p->obuf + off); gin[u] = *(const u32x4*)(p->sg + off);
        }
#pragma unroll
        for (int u = 0; u < 4; ++u) {
            const int r = r0 + u * nw;
            if (r >= T_ * 8) break;
            const size_t off = (size_t)(r >> 3) * 4096 + hd * 512 + lane * 8;
            float v[8];
#pragma unroll
            for (int i = 0; i < 4; ++i) { v[2 * i] = __uint_as_float(in[u][i] << 16); v[2 * i + 1] = __uint_as_float(in[u][i] & 0xffff0000u); }
            float s = 0.f;
#pragma unroll
            for (int i = 0; i < 8; ++i) s += v[i];
            const float mu = wave_sum(s) * (1.f / 512.f);
            float var = 0.f;
#pragma unroll
            for (int i = 0; i < 8; ++i) { const float d = v[i] - mu; var += d * d; }
            var = wave_sum(var) * (1.f / 512.f);
            const float rs = rsqrtf(var + 1e-5f);
            float o[8];
#pragma unroll
            for (int i = 0; i < 8; ++i) {
                const float sgv = (i & 1) ? __uint_as_float(gin[u][i >> 1] & 0xffff0000u) : __uint_as_float(gin[u][i >> 1] << 16);
                o[i] = ((v[i] - mu) * rs * gg[i] + gb[i]) * sgv;
            }
            u32x4 w; w.x = pack2(o[0], o[1]); w.y = pack2(o[2], o[3]); w.z = pack2(o[4], o[5]); w.w = pack2(o[6], o[7]);
            *(u32x4*)(p->gated + off) = w;
        }
    }
}

#define MAXLDS_(a, b) ((a) > (b) ? (a) : (b))
#define PHASE_LDS MAXLDS_(MAXLDS_(MAXLDS_(GEMM_LDS_BYTES, 2 * ATT_LDS_BYTES), 8 * 8192), 131072)
#define LDS_TOTAL (PHASE_LDS + 16 + 16 + 65 * 4 * 2 + 8)

__global__ void __launch_bounds__(NT, 2) mega(Params kparams) {
    extern __shared__ __attribute__((aligned(16))) unsigned char smem[];
    u16* lds = (u16*)smem;
    uint4* xbw = (uint4*)(smem + PHASE_LDS);
    unsigned* misc = (unsigned*)(smem + PHASE_LDS + 16);
    int* s_tp = (int*)(smem + PHASE_LDS + 32);
    int* s_off = s_tp + 65;
    if (threadIdx.x == 0) *xbw = make_uint4(0u, 0u, 0u, 0u);
    __syncthreads();
    XcdBarrier bar = xcd_barrier_post(getp()->bar, (volatile LAS unsigned*)xbw);

    ph_prep(getp());
    {
        KP p = getp();
        for (int u = blockIdx.x; u < 32 * 14; u += gridDim.x) cvtT_block(p->w_in0, p->w_in0t, 2048, IN_AB, u / 14, u % 14, smem);
    }
    xcd_barrier(bar);
    {
        KP p = getp();
        __syncthreads();
        pg8::Gemm g; g.A = p->xb; g.Bt = p->w_in0t; g.M = T_; g.N = 3584; g.K = D_;
        pg8::StaticOrder S; S.init(T_, 3584, (int)gridDim.x, (int)blockIdx.x);
        pg8::gemm_phase<PgEpiBf16N, pg8::StaticOrder>((PG8_LAS unsigned char*)smem, g, S, PgEpiBf16N{p->H0, IN_AB, IN_AB}, nullptr);
        __syncthreads();
    }
    xcd_barrier(bar);
    ph_post0(getp());
    xcd_barrier(bar);
    {
        KP p = getp();
        const int ntm = T_ / BM;
        const int n1 = ntm * 12, n2 = ntm * 16, n3 = T_ / 16;
        for (;;) {
            __syncthreads();
            if (threadIdx.x == 0) misc[0] = atomicAdd(&p->ctl[CTL_QUEUE + 2], 1u);
            __syncthreads();
            const int it = (int)misc[0];
            if (it >= n1 + n2 + n3) break;
            if (it >= n3) {
                const int t = it - n3;
                const bool isq = t < n1;
                const int u = isq ? t : t - n1, nt = u / ntm, mt = u % ntm;
                Acc acc; acc_zero(acc);
                gemm_accum<B_BF16_KN, false>(acc, isq ? p->cqn : p->ckvn, isq ? 512 : 256, RowId{mt * BM}, isq ? p->w_uqb : p->w_ukvb,
                                     isq ? 1536 : 2048, ColOff{nt * BN}, isq ? 512 : 256, lds);
                if (isq) EpiQa{p->qa, p->cosA, p->sinA, mt * BM, nt * BN}(acc, smem);
                else EpiKva{p->ka, p->vaT, mt * BM, nt * BN}(acc, smem);
            } else {
                indexer_item(p, n3 - 1 - it);
                asm volatile("s_waitcnt vmcnt(0)" ::: "memory");
                __syncthreads();
                ph_topk<true>(p, smem, 16 * (n3 - 1 - it));
            }
        }
    }
    xcd_barrier(bar);
    ph_attn(getp(), smem, misc);
    xcd_barrier(bar);
    ph_mla_merge(getp());
    xcd_barrier(bar);
    {
        KP p = getp();
        __syncthreads();
        pg8::Gemm g; g.A = p->outcat; g.Bt = p->w_out0t; g.M = T_; g.N = D_; g.K = D_;
        pg8::StaticOrder S; S.init(T_, D_, (int)gridDim.x, (int)blockIdx.x);
        pg8::gemm_phase<PgEpiResidF, pg8::StaticOrder>((PG8_LAS unsigned char*)smem, g, S, PgEpiResidF{p->ybuf, p->x, D_}, nullptr);
        __syncthreads();
    }
    xcd_barrier(bar);
    { KP p = getp(); ph_ln_router(p, p->ybuf, p->ln_mix_g[0], p->ln_mix_b[0], p->xab, p->xlb, smem, p->ctl + CTL_CNT0, p->list); }
    xcd_barrier(bar);
    { KP p = getp(); ph_moe_up<0>(p, p->xab, smem, s_tp, s_off); }
    xcd_barrier(bar);
    { KP p = getp(); ph_moe_down<0>(p, p->xab, smem, s_tp, s_off); }
    xcd_barrier(bar);
    { KP p = getp(); ph_ln<true, false, true, false>(p, p->y2, p->ln_ffn_g[0], p->ln_ffn_b[0], nullptr, p->xcb, nullptr); }
    xcd_barrier(bar);
    {
        KP p = getp();
        __syncthreads();
        pg8::Gemm g; g.A = p->xcb; g.Bt = p->w_in1t; g.M = T_; g.N = IN_C; g.K = D_;
        pg8::StaticOrder S; S.init(T_, IN_C, (int)gridDim.x, (int)blockIdx.x);
        pg8::gemm_phase<PgEpiL1, pg8::StaticOrder>((PG8_LAS unsigned char*)smem, g, S, PgEpiL1{p}, nullptr);
        __syncthreads();
    }
    xcd_barrier(bar);
    ph_ret_a(getp(), lds);
    xcd_barrier(bar);
    ph_ret_b(getp());
    xcd_barrier(bar);
    ph_ret_c(getp(), lds);
    xcd_barrier(bar);
    ph_gn(getp());
    xcd_barrier(bar);
    {
        KP p = getp();
        __syncthreads();
        pg8::Gemm g; g.A = p->gated; g.Bt = p->w_out1t; g.M = T_; g.N = D_; g.K = 4096;
        pg8::StaticOrder S; S.init(T_, D_, (int)gridDim.x, (int)blockIdx.x);
        pg8::gemm_phase<PgEpiResid, pg8::StaticOrder>((PG8_LAS unsigned char*)smem, g, S, PgEpiResid{p->ybuf, p->xcb, D_}, nullptr);
        __syncthreads();
    }
    xcd_barrier(bar);
    { KP p = getp(); ph_ln_router(p, p->ybuf, p->ln_mix_g[1], p->ln_mix_b[1], p->xab, p->xlb, smem, p->ctl + CTL_CNT1, p->list); }
    xcd_barrier(bar);
    { KP p = getp(); ph_moe_up<1>(p, p->xab, smem, s_tp, s_off); }
    xcd_barrier(bar);
    { KP p = getp(); ph_moe_down<1>(p, p->xab, smem, s_tp, s_off); }
    xcd_barrier(bar);
    { KP p = getp(); ph_ln<true, false, false, true>(p, p->y2, p->ln_ffn_g[1], p->ln_ffn_b[1], p->out, nullptr, nullptr); }
    {
        KP p = getp();
        if (xb_ld(&p->bar[XB_TMO])) {
            asm volatile("s_waitcnt vmcnt(0)" ::: "memory");
            for (int i = blockIdx.x * NT + ltid(); i < p->out_size; i += gridDim.x * NT) p->out[i] = __uint_as_float(0x7fc00000u);
        }
    }
}

extern "C" void kernel_launch(void* const* d_in, const int* in_sizes, int n_in,
                              void* d_out, int out_size, void* d_ws, size_t ws_size,
                              hipStream_t stream) {
    const size_t kDynLds = LDS_TOTAL;
    static int grid = 0;
    if (!grid) {
        int dev = 0, cus = 0, per_cu = 0;
        (void)hipGetDevice(&dev);
        (void)hipDeviceGetAttribute(&cus, hipDeviceAttributeMultiprocessorCount, dev);
        (void)hipFuncSetAttribute((const void*)mega, hipFuncAttributeMaxDynamicSharedMemorySize, (int)kDynLds);
        (void)hipOccupancyMaxActiveBlocksPerMultiprocessor(&per_cu, mega, NT, kDynLds);
        grid = cus * (per_cu >= 1 ? 1 : 0);
    }
    unsigned char* ws = (unsigned char*)d_ws;
    size_t off = 0;
    auto take = [&](size_t bytes) { void* q = ws + off; off += (bytes + 255) & ~(size_t)255; return q; };
    Params p{};
    p.bar = (unsigned*)take(XCD_BAR_WORDS * 4);
    p.ctl = (unsigned*)take(CTL_WORDS * 4);
    const size_t ctl_bytes = off;
    (void)hipMemsetAsync(ws, 0, ctl_bytes, stream);
    auto F = [&](int i) { return (const float*)d_in[i]; };
    p.x = F(0); p.pos = (const int*)d_in[1]; p.router_w = F(2); p.router_b = F(3);
    p.w_in0 = F(4); p.q_norm = F(5); p.w_uq = F(6); p.kv_norm = F(7); p.w_ukv = F(8); p.w_out0 = F(9);
    p.w_in1 = F(10); p.gn_g = F(11); p.gn_b = F(12); p.w_out1 = F(13);
    for (int l = 0; l < 2; ++l) {
        const int b = 14 + 10 * l;
        p.ln_mix_g[l] = F(b); p.ln_mix_b[l] = F(b + 1);
        p.moe_wg[l] = F(b + 2); p.moe_wu[l] = F(b + 3); p.moe_wd[l] = F(b + 4);
        p.sh_g[l] = F(b + 5); p.sh_u[l] = F(b + 6); p.sh_d[l] = F(b + 7);
        p.ln_ffn_g[l] = F(b + 8); p.ln_ffn_b[l] = F(b + 9);
    }
    p.out = (float*)d_out;
    p.w_in0b = nullptr; p.w_in0t = (u16*)take((size_t)3584 * D_ * 2); p.w_uqb = (u16*)take(512 * 1536 * 2); p.w_ukvb = (u16*)take(256 * 2048 * 2);
    p.w_out0b = nullptr; p.w_in1b = nullptr; p.w_out1b = nullptr; p.w_out1t = (u16*)take((size_t)4096 * D_ * 2); p.w_out0t = (u16*)take((size_t)D_ * D_ * 2); p.w_in1t = (u16*)take((size_t)D_ * IN_C * 2);
    for (int l = 0; l < 2; ++l) { p.sh_gb[l] = nullptr; p.sh_ub[l] = nullptr; p.sh_db[l] = nullptr; p.sh_gut[l] = (u16*)take((size_t)2048 * D_ * 2); p.sh_dt[l] = (u16*)take((size_t)D_ * 1024 * 2); }
    const size_t T = T_;
    p.cosA = (float*)take(T * 32 * 4); p.sinA = (float*)take(T * 32 * 4);
    p.cosR = (float*)take(T * 128 * 4); p.sinR = (float*)take(T * 128 * 4);
    p.xb = (u16*)take(T * 2048 * 2); p.H0 = (u16*)take(T * IN_AB * 2);
    p.cqn = (u16*)take(T * 512 * 2); p.ckvn = (u16*)take(T * 256 * 2); p.kpe = (u16*)take(T * 64 * 2);
    p.qb = (u16*)take(T * 1024 * 2); p.kb = (u16*)take(T * 256 * 2); p.vb = (u16*)take(T * 256 * 2);
    p.iqb = (u16*)take(T * 1024 * 2); p.ikb = (u16*)take(T * 64 * 2); p.iwf = (float*)take(T * 16 * 4);
    p.qa = (u16*)take(T * 1536 * 2); p.ka = (u16*)take(T * 1024 * 2); p.vaT = (u16*)take(T * 1024 * 2);
    p.scores = (float*)take(T * T * 4); p.sel = (u16*)take(T * 256 * 2); p.outcat = (u16*)take(T * 2048 * 2); p.mla_po = (float*)take((size_t)256 * 256 * 128 * 4); p.mla_ml = (float*)take((size_t)256 * 256 * 2 * 4);
    p.ybuf = (u16*)take(T * 2048 * 2); p.xab = (u16*)take(T * 2048 * 2); p.xlb = (u16*)take(T * 2048 * 2); p.whT = (u16*)take(64 * 2048 * 2); p.wlT = (u16*)take(64 * 2048 * 2);
    p.y2 = (u16*)take(T * 2048 * 2); p.xcb = (u16*)take(T * 2048 * 2);
    p.tok_e = (int*)take(T * 2 * 4); p.tok_g = (float*)take(T * 2 * 4); p.list = (int*)take(2 * 64 * T * 4);
    p.hbuf = (u16*)take(T * 2 * 512 * 2); p.hsh = (u16*)take(T * 1024 * 2); p.yr = (u16*)take(T * 2 * 2048 * 2);
    p.qr = (u16*)take(T * 2048 * 2); p.qx = (u16*)take(T * 2048 * 2); p.kr = (u16*)take(T * 2048 * 2);
    p.kzT = nullptr; p.kz = (u16*)take(T * 2048 * 2); p.v1 = (u16*)take(T * 4096 * 2); p.sg = (u16*)take(T * 4096 * 2);
    p.innerG = (u16*)take((size_t)8 * 64 * 128 * 128 * 2);
    {
        unsigned char* sbase = (unsigned char*)p.scores;
        p.KVt = (u16*)sbase; p.obuf = (u16*)(sbase + ((size_t)128 << 20)); p.gated = (u16*)(sbase + ((size_t)192 << 20));
    }
    p.out_size = out_size; p.pad_ = 0;
    if (off > ws_size) return;
    mega<<<dim3(grid), dim3(NT), kDynLds, stream>>>(p);
}
```

```cpp
#include <hip/hip_runtime.h>
#include <stdint.h>

typedef unsigned short u16;
typedef __attribute__((ext_vector_type(8))) short bf16x8;
typedef __attribute__((ext_vector_type(4))) float f32x4;
typedef __attribute__((ext_vector_type(2))) float f32x2;
typedef __attribute__((ext_vector_type(4))) unsigned u32x4;
typedef __attribute__((ext_vector_type(2))) unsigned u32x2;
typedef __attribute__((ext_vector_type(2))) __bf16 bf16x2_t;
typedef __attribute__((ext_vector_type(4))) short s16x4;

#define XB_TMO      128
#define XB_XCNT(j)  (256  + 64 * (j))
#define XB_XSUB(j)  (1280 + 64 * (j))
#define XB_XGEN(j)  (2304 + 64 * (j))
#define XB_TOP      3328
#define XB_TOPGEN   3392
#define XCD_BAR_WORDS 3456
#define XB_SPIN_CAP (1u << 22)
#define LAS __attribute__((address_space(3)))

__device__ __forceinline__ unsigned xb_ld(unsigned* p)              { return __hip_atomic_load(p, __ATOMIC_RELAXED, __HIP_MEMORY_SCOPE_AGENT); }
__device__ __forceinline__ unsigned xb_add(unsigned* p, unsigned v) { return __hip_atomic_fetch_add(p, v, __ATOMIC_RELAXED, __HIP_MEMORY_SCOPE_AGENT); }
__device__ __forceinline__ unsigned xb_xcc_id() { return (unsigned)__builtin_amdgcn_s_getreg((3 << 11) | 20) & 0xFu; }
#define XB_SPIN(cond, bar) do { unsigned _sp = 0; while (cond) { __builtin_amdgcn_s_sleep(1); \
    if ((++_sp & 255u) == 0u) { if (xb_ld(&(bar)[XB_TMO])) break; if (_sp > XB_SPIN_CAP) { atomicAdd(&(bar)[XB_TMO], 1u); break; } } } } while (0)

struct XcdBarrier { unsigned* bar; unsigned x; volatile LAS unsigned* st; };

__device__ __forceinline__ XcdBarrier xcd_barrier_post(unsigned* bar, volatile LAS unsigned* st) {
    XcdBarrier b; b.bar = bar; b.x = xb_xcc_id(); b.st = st;
    if (threadIdx.x == 0) (void)xb_add(&bar[XB_XCNT(b.x)], 1u);
    return b;
}
__device__ __forceinline__ void xcd_barrier_complete(unsigned* bar, unsigned x, unsigned& nloc, unsigned& nx) {
    const unsigned G = gridDim.x * gridDim.y * gridDim.z;
    unsigned sum, cnt, mine, sp = 0u;
    for (;;) {
        sum = 0u; cnt = 0u; mine = 0u;
#pragma unroll
        for (unsigned j = 0; j < 16; ++j) { const unsigned c = xb_ld(&bar[XB_XCNT(j)]); sum += c; cnt += (c > 0u) ? 1u : 0u; mine = (j == x) ? c : mine; }
        if (sum == G) break;
        __builtin_amdgcn_s_sleep(1);
        if ((++sp & 255u) == 0u) { if (xb_ld(&bar[XB_TMO])) break; if (sp > XB_SPIN_CAP) { atomicAdd(&bar[XB_TMO], 1u); break; } }
    }
    nloc = mine > 0u ? mine : 1u; nx = cnt > 0u ? cnt : 1u;
}
__device__ __forceinline__ void xcd_barrier(const XcdBarrier& b) {
    asm volatile("s_waitcnt vmcnt(0)" ::: "memory");
    __syncthreads();
    if (threadIdx.x == 0) {
        unsigned* bar = b.bar;
        __builtin_amdgcn_s_waitcnt(0);
        unsigned nloc = b.st[0], nx = b.st[1];
        if (nloc == 0u) { xcd_barrier_complete(bar, b.x, nloc, nx); b.st[0] = nloc; b.st[1] = nx; }
        const unsigned old = xb_add(&bar[XB_XSUB(b.x)], 1u);
        const unsigned gen = old / nloc;
        if (old + 1u == (gen + 1u) * nloc) {
            __builtin_amdgcn_fence(__ATOMIC_RELEASE, "agent");
            asm volatile("s_waitcnt vmcnt(0)" ::: "memory");
            const unsigned og = xb_add(&bar[XB_TOP], 1u);
            const unsigned tg = og / nx;
            if (og + 1u == (tg + 1u) * nx) xb_add(&bar[XB_TOPGEN], 1u);
            else XB_SPIN(xb_ld(&bar[XB_TOPGEN]) == tg, bar);
            __builtin_amdgcn_fence(__ATOMIC_ACQUIRE, "agent");
            xb_add(&bar[XB_XGEN(b.x)], 1u);
            asm volatile("s_waitcnt vmcnt(0)" ::: "memory");
        } else {
            XB_SPIN(xb_ld(&bar[XB_XGEN(b.x)]) == gen, bar);
            __builtin_amdgcn_fence(__ATOMIC_ACQUIRE, "agent");
            asm volatile("s_waitcnt vmcnt(0)" ::: "memory");
        }
    }
    __syncthreads();
}

__device__ __forceinline__ int ltid() { int t = threadIdx.x; asm volatile("" : "+v"(t)); return t; }
__device__ __forceinline__ u16 f2bf(float f) {
    unsigned u = __float_as_uint(f);
    u += 0x7fffu + ((u >> 16) & 1u);
    return (u16)(u >> 16);
}
__device__ __forceinline__ float bf2f(u16 h) { return __uint_as_float(((unsigned)h) << 16); }
__device__ __forceinline__ unsigned pack2(float a, float b) {
    f32x2 v = {a, b};
    bf16x2_t r = __builtin_convertvector(v, bf16x2_t);
    return *(unsigned*)&r;
}

namespace pg8 {
#define PG8_LAS __attribute__((address_space(3)))
typedef unsigned short bf16_t;
typedef short bf16x8 __attribute__((ext_vector_type(8)));
typedef float f32x4 __attribute__((ext_vector_type(4)));
typedef unsigned u32x4 __attribute__((ext_vector_type(4)));
constexpr int BM = 256, BK = 64, HALF = 128, HTB = HALF * BK * 2  , STAGE_BYTES = 8 * HTB, NXCD = 8, WGM = 8;

__host__ __device__ __forceinline__ int lds_byte(int r, int c) { const int st = (r >> 4) * 2 + (c >> 5), rr = r & 15, cc = c & 31, ob = rr * 64 + cc * 2; return st * 1024 + (ob ^ (((ob >> 9) & 1) << 5)); }
__host__ __device__ __forceinline__ void stage_rc(int b, int& R, int& C) { const int st = b / 1024, sb = b % 1024, swz = sb ^ (((sb >> 9) & 1) << 5); R = (st >> 1) * 16 + swz / 64; C = (st & 1) * 32 + (swz % 64) / 2; }
__host__ __device__ __forceinline__ int perm32(int rho) { const int n = rho >> 4, i = rho & 15; return 8 * (i >> 2) + 4 * n + (i & 3); }

struct Unit { int pm, pn; };
struct Gemm { const bf16_t* A; const bf16_t* Bt; int M, N, K; };

struct StaticOrder {
    int nM, nN, nwg, G, c;
    __host__ __device__ void init(int M, int N, int G_, int c_) { nM = M / BM; nN = N / BM; nwg = nM * nN; G = G_; c = c_; }
    __host__ __device__ bool next(int i, Unit& u) const {
        const long L = (long)i * G + c; if (L >= nwg) return false;
        int wgid = (int)L; { const int q = nwg / NXCD, r = nwg % NXCD, xcd = wgid % NXCD, off = wgid / NXCD; wgid = (xcd < r ? xcd * (q + 1) : r * (q + 1) + (xcd - r) * q) + off; }
        const int nig = WGM * nN, gid = wgid / nig, fm = gid * WGM, gsz = (nM - fm) < WGM ? (nM - fm) : WGM;
        u.pm = fm + ((wgid % nig) % gsz); u.pn = (wgid % nig) / gsz; return true;
    }
    __device__ __forceinline__ void a_ready(const Unit&) const {}
    __device__ __forceinline__ void done(const Unit&) const {}
};
__device__ __forceinline__ unsigned cvt_pk_bf16(float lo, float hi) { unsigned r; asm volatile("v_cvt_pk_bf16_f32 %0, %1, %2" : "=v"(r) : "v"(lo), "v"(hi)); return r; }
template <class Epi, class Sched, bool STAMP = false>
__device__ __forceinline__ void gemm_phase(PG8_LAS unsigned char* lds, const Gemm g, const Sched& S, const Epi& E, unsigned long long* stamps) {
    const int tid = ltid(), wid = __builtin_amdgcn_readfirstlane(tid >> 6), lane = tid & 63, wr = wid >> 2, wc = wid & 3, fr = lane & 15, fq = lane >> 4;
    const int K = g.K, nt = K / BK;
    int ts_lo = 0, ts_hi = 0, nts = 0; const unsigned long long rt_entry = STAMP ? (unsigned long long)wall_clock64() : 0ull;
#define PG8_STAMP() do { if (STAMP && wid == 0 && nts < 64) { const unsigned long long _c = (unsigned long long)clock64(); \
        ts_lo = (lane == nts) ? (int)(unsigned)_c : ts_lo; ts_hi = (lane == nts) ? (int)(unsigned)(_c >> 32) : ts_hi; ++nts; } } while (0)
    PG8_STAMP();
    unsigned voffA[2], voffB[2];
#pragma unroll
    for (int i = 0; i < 2; ++i) { int R, C; stage_rc(tid * 16 + i * 8192, R, C); const int Rb = Epi::PERM ? ((R & ~31) + perm32(R & 31)) : R;
        voffA[i] = (unsigned)(R * K + C) * 2u; voffB[i] = (unsigned)(Rb * K + C) * 2u; }
    const size_t kstep = (size_t)(BK * 2);
    const size_t hstep = (size_t)HALF * K * 2;
    const size_t tstep = 2 * hstep;
    const unsigned ldsw = (unsigned)wid * 1024u;
    const int aoff = lds_byte(wr * 64 + fr, fq * 8), boff = lds_byte(wc * 32 + fr, fq * 8);
#define PG8_SA(b, h) (((b) * 2 + (h)) * HTB)
#define PG8_SB(b, h) ((4 + (b) * 2 + (h)) * HTB)
#define PG8_STAGE(bufoff, gbase, voff) do { _Pragma("unroll") for (int _i = 0; _i < 2; ++_i) \
        __builtin_amdgcn_global_load_lds((const unsigned*)((const char*)(gbase) + (voff)[_i]), (PG8_LAS unsigned*)(lds + (bufoff) + ldsw + _i * 8192), 16, 0, 0); } while (0)
#define PG8_LDA(dst, b, h) do { _Pragma("unroll") for (int m = 0; m < 4; ++m) _Pragma("unroll") for (int k = 0; k < 2; ++k) dst[m][k] = *(const PG8_LAS bf16x8*)(lds + PG8_SA(b, h) + aoff + m * 2048 + k * 1024); } while (0)
#define PG8_LDB(dst, b, h) do { _Pragma("unroll") for (int n = 0; n < 2; ++n) _Pragma("unroll") for (int k = 0; k < 2; ++k) dst[n][k] = *(const PG8_LAS bf16x8*)(lds + PG8_SB(b, h) + boff + n * 2048 + k * 1024); } while (0)
#define PG8_MMA(ai, bj, At, Bt) do { __builtin_amdgcn_s_setprio(1); _Pragma("unroll") for (int m = 0; m < 4; ++m) _Pragma("unroll") for (int n = 0; n < 2; ++n) _Pragma("unroll") for (int k = 0; k < 2; ++k) \
        acc[ai][bj][m][n] = __builtin_amdgcn_mfma_f32_16x16x32_bf16(Bt[n][k], At[m][k], acc[ai][bj][m][n], 0, 0, 0); __builtin_amdgcn_s_setprio(0); } while (0)
#define PG8_WAIT_V(n) asm volatile("s_waitcnt vmcnt(" #n ")" ::: "memory")
#define PG8_WAIT_L(n) asm volatile("s_waitcnt lgkmcnt(" #n ")" ::: "memory")
#define PG8_BAR __builtin_amdgcn_s_barrier()
#define PG8_SCHED __builtin_amdgcn_sched_barrier(0)
    Unit cur, nxt; int ui = 0;
    if (!S.next(0, cur)) return;
    f32x4 acc[2][2][4][2];
#pragma unroll
    for (int a = 0; a < 2; ++a)
#pragma unroll
        for (int b = 0; b < 2; ++b)
#pragma unroll
            for (int m = 0; m < 4; ++m)
#pragma unroll
                for (int n = 0; n < 2; ++n) acc[a][b][m][n] = (f32x4){0.f, 0.f, 0.f, 0.f};
    bf16x8 At[4][2], B0[2][2], B1[2][2];
    const char* cA = (const char*)g.A + (size_t)cur.pm * tstep; const char* cB = (const char*)g.Bt + (size_t)cur.pn * tstep;
    S.a_ready(cur);
    PG8_STAGE(PG8_SB(0, 0), cB, voffB); PG8_STAGE(PG8_SA(0, 0), cA, voffA); PG8_STAGE(PG8_SB(0, 1), cB + hstep, voffB); PG8_STAGE(PG8_SA(0, 1), cA + hstep, voffA);
    if (wr == 1) PG8_BAR;
    PG8_WAIT_V(4); PG8_BAR;
    PG8_STAGE(PG8_SB(1, 0), cB + kstep, voffB); PG8_STAGE(PG8_SA(1, 0), cA + kstep, voffA); PG8_STAGE(PG8_SB(1, 1), cB + hstep + kstep, voffB);
    PG8_WAIT_V(6); PG8_BAR;
    PG8_STAMP();
    for (;;) {
        const bool has_next = S.next(ui + 1, nxt);
        const char* nA = has_next ? (const char*)g.A + (size_t)nxt.pm * tstep : cA; const char* nB = has_next ? (const char*)g.Bt + (size_t)nxt.pn * tstep : cB;
        for (int t = 0; t < nt; t += 2) {
            const bool last = (t == nt - 2);
            const char* a1 = cA + (size_t)(t + 1) * kstep;
            const char* a2 = last ? nA : cA + (size_t)(t + 2) * kstep; const char* b2 = last ? nB : cB + (size_t)(t + 2) * kstep;
            const char* a3 = a2 + kstep; const char* b3 = b2 + kstep;
            if (last && has_next) S.a_ready(nxt);
            PG8_LDB(B0, 0, 0); PG8_SCHED; PG8_LDA(At, 0, 0); PG8_STAGE(PG8_SA(1, 1), a1 + hstep, voffA);
            PG8_WAIT_L(8); PG8_BAR; PG8_WAIT_L(0); PG8_MMA(0, 0, At, B0); PG8_BAR; PG8_SCHED;
            PG8_LDB(B1, 0, 1); PG8_STAGE(PG8_SB(0, 0), b2, voffB);
            PG8_BAR; PG8_WAIT_L(0); PG8_MMA(0, 1, At, B1); PG8_BAR;
            PG8_LDA(At, 0, 1); PG8_STAGE(PG8_SA(0, 0), a2, voffA);
            PG8_BAR; PG8_WAIT_L(0); PG8_MMA(1, 0, At, B0); PG8_BAR; PG8_SCHED;
            PG8_STAGE(PG8_SB(0, 1), b2 + hstep, voffB);
            PG8_WAIT_V(6); PG8_BAR; PG8_MMA(1, 1, At, B1); PG8_BAR;
            PG8_LDB(B0, 1, 0); PG8_SCHED; PG8_LDA(At, 1, 0); PG8_STAGE(PG8_SA(0, 1), a2 + hstep, voffA);
            PG8_WAIT_L(8); PG8_BAR; PG8_WAIT_L(0); PG8_MMA(0, 0, At, B0); PG8_BAR; PG8_SCHED;
            PG8_LDB(B1, 1, 1); PG8_STAGE(PG8_SB(1, 0), b3, voffB);
            PG8_BAR; PG8_WAIT_L(0); PG8_MMA(0, 1, At, B1); PG8_BAR;
            PG8_LDA(At, 1, 1); PG8_STAGE(PG8_SA(1, 0), a3, voffA);
            PG8_BAR; PG8_WAIT_L(0); PG8_MMA(1, 0, At, B0); PG8_BAR; PG8_SCHED;
            PG8_STAGE(PG8_SB(1, 1), b3 + hstep, voffB);
            PG8_WAIT_V(6); PG8_BAR; PG8_MMA(1, 1, At, B1); PG8_BAR;
        }
        PG8_STAMP();
        if constexpr (!Epi::AFTER_DRAIN) { E(acc, cur, wr, wc, fr, fq); S.done(cur); }
        PG8_STAMP();
        if (!has_next) break;
#pragma unroll
        for (int a = 0; a < 2; ++a)
#pragma unroll
            for (int b = 0; b < 2; ++b)
#pragma unroll
                for (int m = 0; m < 4; ++m)
#pragma unroll
                    for (int n = 0; n < 2; ++n) acc[a][b][m][n] = (f32x4){0.f, 0.f, 0.f, 0.f};
        cur = nxt; cA = nA; cB = nB; ++ui;
    }
    PG8_WAIT_V(0);
    if (wr == 0) PG8_BAR;
    PG8_BAR;
    if constexpr (Epi::AFTER_DRAIN) { E.fused(acc, cur, wr, wc, fr, fq, lds, wid, lane); S.done(cur); }
    PG8_STAMP();
    if (STAMP && wid == 0) { stamps[lane] = lane < nts ? (((unsigned long long)(unsigned)ts_hi << 32) | (unsigned)ts_lo) : 0ull;
        if (lane == 62) stamps[62] = rt_entry; if (lane == 63) stamps[63] = (unsigned long long)wall_clock64(); }
#undef PG8_STAMP
#undef PG8_SA
#undef PG8_SB
#undef PG8_STAGE
#undef PG8_LDA
#undef PG8_LDB
#undef PG8_MMA
#undef PG8_WAIT_V
#undef PG8_WAIT_L
#undef PG8_BAR
#undef PG8_SCHED
}
}

__device__ __forceinline__ float wave_sum(float v) {
#pragma unroll
    for (int o = 32; o > 0; o >>= 1) v += __shfl_xor(v, o);
    return v;
}
__device__ __forceinline__ float wave_max(float v) {
#pragma unroll
    for (int o = 32; o > 0; o >>= 1) v = fmaxf(v, __shfl_xor(v, o));
    return v;
}
__device__ __forceinline__ int wave_isum(int v) {
#pragma unroll
    for (int o = 32; o > 0; o >>= 1) v += __shfl_xor(v, o);
    return v;
}
__device__ __forceinline__ float silu_f(float x) { return x / (1.f + __expf(-x)); }

#define T_ 8192
#define D_ 2048
#define IN_AB 3472
#define IN_C 12288
#define NT 512
#define ALPHA_ 1.4142135623730951f
#define LOG2E_ 1.4426950408889634f

#define BM 256
#define BN 128
#define BK 64
#define LROW 80
#define GEMM_BUF (BM * LROW + BN * LROW)
#define GEMM_LDS_BYTES (2 * GEMM_BUF * 2)

#define B_F32_KN 0
#define B_BF16_NK 1
#define B_BF16_KN 2

typedef f32x4 Acc[4][4];

__device__ __forceinline__ __amdgpu_buffer_rsrc_t make_rsrc(const void* p) {
    const unsigned long long a = (unsigned long long)p;
    const unsigned lo = __builtin_amdgcn_readfirstlane((unsigned)a), hi = __builtin_amdgcn_readfirstlane((unsigned)(a >> 32));
    return __builtin_amdgcn_make_buffer_rsrc((void*)(((unsigned long long)hi << 32) | lo), 0, 0x7fffffff, 0x00020000);
}
__device__ __forceinline__ u32x4 bload16(__amdgpu_buffer_rsrc_t r, unsigned voff, unsigned soff) {
    return __builtin_amdgcn_raw_buffer_load_b128(r, (int)voff, (int)soff, 0);
}

__device__ __forceinline__ void acc_zero(Acc& acc) {
#pragma unroll
    for (int m = 0; m < 4; ++m)
#pragma unroll
        for (int n = 0; n < 4; ++n) acc[m][n] = (f32x4){0.f, 0.f, 0.f, 0.f};
}

template <int BMODE, bool KS, bool LONGK = false, class ARow, class BSel>
__device__ __forceinline__ void gemm_accum(Acc& acc, const u16* __restrict__ A, int lda, ARow arow,
                                           const void* __restrict__ Bv, int ldb, BSel bsel,
                                           int K, u16* lds) {
    const int tid = ltid(), lane = tid & 63;
    const int wid = __builtin_amdgcn_readfirstlane(tid >> 6);
    const int wr = KS ? ((wid & 3) >> 1) : (wid >> 1), wc = wid & 1, fr = lane & 15, fq = lane >> 4;
    constexpr int NA = KS ? 2 : 4;
    const int ac = tid & 7, ar0 = tid >> 3;
    unsigned ao[NA];
#pragma unroll
    for (int i = 0; i < NA; ++i) ao[i] = ((unsigned)arow(ar0 + 64 * i) * (unsigned)lda + ac * 8) * 2u;
    const int nk = K / BK;
    const int sa_w = ar0 * LROW + ac * 8;
    constexpr int SB0 = BM * LROW;
    const __amdgpu_buffer_rsrc_t rA = make_rsrc(A);

#define MMA16(AF, BF) do { \
        __builtin_amdgcn_s_setprio(1); \
        _Pragma("unroll") for (int m = 0; m < 4; ++m) \
        _Pragma("unroll") for (int n = 0; n < 4; ++n) \
            acc[m][n] = __builtin_amdgcn_mfma_f32_16x16x32_bf16(AF[m], BF[n], acc[m][n], 0, 0, 0); \
        __builtin_amdgcn_s_setprio(0); } while (0)
#define MEMFENCE_ asm volatile("" ::: "memory")
#define GEMM_COMPUTE(buf) do { \
        const u16* sA = lds + (buf) * GEMM_BUF; const u16* sB = sA + SB0; \
        _Pragma("unroll") for (int ks = 0; ks < 2; ++ks) { \
            if (KS && ks != (wid >> 2)) continue; \
            bf16x8 af[4], bfr[4]; \
            _Pragma("unroll") for (int m = 0; m < 4; ++m) af[m] = *(const bf16x8*)(sA + (wr * 64 + m * 16 + fr) * LROW + ks * 32 + fq * 8); \
            _Pragma("unroll") for (int n = 0; n < 4; ++n) bfr[n] = *(const bf16x8*)(sB + (wc * 64 + n * 16 + fr) * LROW + ks * 32 + fq * 8); \
            _Pragma("unroll") for (int m = 0; m < 4; ++m) \
            _Pragma("unroll") for (int n = 0; n < 4; ++n) \
                acc[m][n] = __builtin_amdgcn_mfma_f32_16x16x32_bf16(af[m], bfr[n], acc[m][n], 0, 0, 0); \
        } } while (0)

    __syncthreads();

#define FRAG_KN(buf, ks, AF, BF) do { \
        const u16* sA = lds + (buf) * GEMM_BUF; \
        const LAS char* cB = (const LAS char*)(lds + (buf) * GEMM_BUF); \
        _Pragma("unroll") for (int m = 0; m < 4; ++m) AF[m] = *(const bf16x8*)(sA + (wr * 64 + m * 16 + fr) * LROW + (ks) * 32 + fq * 8); \
        _Pragma("unroll") for (int n = 0; n < 4; ++n) { \
            const s16x4 lo_ = __builtin_amdgcn_ds_read_tr16_b64_v4i16((LAS s16x4*)(cB + rdo[0][n] + (ks) * 8192)); \
            const s16x4 hi_ = __builtin_amdgcn_ds_read_tr16_b64_v4i16((LAS s16x4*)(cB + rdo[1][n] + (ks) * 8192)); \
            BF[n] = __builtin_shufflevector(lo_, hi_, 0, 1, 2, 3, 4, 5, 6, 7); } } while (0)
    if constexpr (BMODE == B_BF16_KN) {
        const int ch8 = tid & 7, kr = tid >> 3;
        const __amdgpu_buffer_rsrc_t rB0 = make_rsrc(bsel.base16((const u16*)Bv, 0));
        const __amdgpu_buffer_rsrc_t rB1 = make_rsrc(bsel.base16((const u16*)Bv, 1));
        const unsigned ldb2 = (unsigned)ldb * 2u;
        const unsigned bof0 = (unsigned)kr * ldb2 + bsel.off8(0, ch8) * 2u, bof1 = (unsigned)kr * ldb2 + bsel.off8(1, ch8) * 2u;
        const int xw = ((kr & 3) << 2) | ((kr >> 2) & 3);
        const int sbw0 = SB0 * 2 + kr * 256 + 16 * (bsel.vchunk(0, ch8) ^ xw);
        const int sbw1 = SB0 * 2 + kr * 256 + 16 * (bsel.vchunk(1, ch8) ^ xw);
        int rdo[2][4];
#pragma unroll
        for (int t = 0; t < 2; ++t) {
            const int xr = ((fr >> 2) << 2) | ((2 * fq + t) & 3);
#pragma unroll
            for (int n = 0; n < 4; ++n)
                rdo[t][n] = SB0 * 2 + (8 * fq + 4 * t + (fr >> 2)) * 256 + 16 * ((2 * (wc * 4 + n) + ((fr & 3) >> 1)) ^ xr) + 8 * (fr & 1);
        }
        u32x4 ra0[NA], ra1[NA]; u32x4 rb0[2], rb1[2];
#define GL_KB(k0, RA, RB) do { \
        _Pragma("unroll") for (int i = 0; i < NA; ++i) RA[i] = bload16(rA, ao[i], (unsigned)(k0) * 2u); \
        const unsigned s0_ = (unsigned)(k0) * ldb2; \
        RB[0] = bload16(rB0, bof0, s0_); RB[1] = bload16(rB1, bof1, s0_); } while (0)
#define LW_KB(buf, RA, RB) do { \
        u16* sb_ = lds + (buf) * GEMM_BUF; \
        _Pragma("unroll") for (int i = 0; i < NA; ++i) *(u32x4*)(sb_ + sa_w + 64 * i * LROW) = RA[i]; \
        char* cb_ = (char*)sb_; \
        *(u32x4*)(cb_ + sbw0) = RB[0]; *(u32x4*)(cb_ + sbw1) = RB[1]; } while (0)
        GL_KB(0, ra0, rb0);
        GL_KB(BK, ra1, rb1);
        LW_KB(0, ra0, rb0);
        if (LONGK || 2 < nk) GL_KB((2 < nk ? 2 : nk - 1) * BK, ra0, rb0);
        __syncthreads();
        bf16x8 af0[4], bf0[4], af1[4], bf1[4];
        for (int kt = 0; kt < nk; kt += 2) {
            if (!KS) { FRAG_KN(0, 0, af0, bf0); } else { FRAG_KN(0, (wid >> 2), af0, bf0); }
            MEMFENCE_;
            LW_KB(1, ra1, rb1);
            if (LONGK || kt + 3 < nk) GL_KB((kt + 3 < nk ? kt + 3 : nk - 1) * BK, ra1, rb1);
            MEMFENCE_;
            if (!KS) FRAG_KN(0, 1, af1, bf1);
            MMA16(af0, bf0);
            if (!KS) MMA16(af1, bf1);
            __syncthreads();
            if (!KS) { FRAG_KN(1, 0, af0, bf0); } else { FRAG_KN(1, (wid >> 2), af0, bf0); }
            MEMFENCE_;
            if (LONGK || kt + 2 < nk) LW_KB(0, ra0, rb0);
            if (LONGK || kt + 4 < nk) GL_KB((kt + 4 < nk ? kt + 4 : nk - 1) * BK, ra0, rb0);
            MEMFENCE_;
            if (!KS) FRAG_KN(1, 1, af1, bf1);
            MMA16(af0, bf0);
            if (!KS) MMA16(af1, bf1);
            __syncthreads();
        }
#undef GL_KB
#undef LW_KB
    } else if constexpr (BMODE == B_F32_KN) {
        const int g4 = tid & 15, kr = tid >> 4;
        const __amdgpu_buffer_rsrc_t rB0 = make_rsrc(bsel.base((const float*)Bv, 0));
        const __amdgpu_buffer_rsrc_t rB1 = make_rsrc(bsel.base((const float*)Bv, 1));
        const unsigned ldb4 = (unsigned)ldb * 4u;
        const unsigned bof0 = (unsigned)kr * ldb4 + bsel.off4(0, g4) * 4u, bof1 = (unsigned)kr * ldb4 + bsel.off4(1, g4) * 4u;
        const int xw = ((kr & 3) << 2) | ((kr >> 2) & 3);
        const int v00 = bsel.vcol4(0, g4), v01 = bsel.vcol4(1, g4);
        const int sbw0 = SB0 * 2 + kr * 256 + 16 * ((v00 >> 3) ^ xw) + 8 * ((v00 >> 2) & 1);
        const int sbw1 = SB0 * 2 + kr * 256 + 16 * ((v01 >> 3) ^ xw) + 8 * ((v01 >> 2) & 1);
        int rdo[2][4];
#pragma unroll
        for (int t = 0; t < 2; ++t) {
            const int xr = ((fr >> 2) << 2) | ((2 * fq + t) & 3);
#pragma unroll
            for (int n = 0; n < 4; ++n)
                rdo[t][n] = SB0 * 2 + (8 * fq + 4 * t + (fr >> 2)) * 256 + 16 * ((2 * (wc * 4 + n) + ((fr & 3) >> 1)) ^ xr) + 8 * (fr & 1);
        }
        u32x4 ra0[NA], ra1[NA]; u32x4 rb0[4], rb1[4];
#define PK4_(V) (w_.x = pack2(__uint_as_float(V[0]), __uint_as_float(V[1])), w_.y = pack2(__uint_as_float(V[2]), __uint_as_float(V[3])))
#define GL_F32(k0, RA, RB) do { \
        _Pragma("unroll") for (int i = 0; i < NA; ++i) RA[i] = bload16(rA, ao[i], (unsigned)(k0) * 2u); \
        const unsigned s0_ = (unsigned)(k0) * ldb4, s1_ = s0_ + 32u * ldb4; \
        RB[0] = bload16(rB0, bof0, s0_); RB[1] = bload16(rB1, bof1, s0_); \
        RB[2] = bload16(rB0, bof0, s1_); RB[3] = bload16(rB1, bof1, s1_); } while (0)
#define LW_F32(buf, RA, RB) do { \
        u16* sb_ = lds + (buf) * GEMM_BUF; \
        _Pragma("unroll") for (int i = 0; i < NA; ++i) *(u32x4*)(sb_ + sa_w + 64 * i * LROW) = RA[i]; \
        char* cb_ = (char*)sb_; \
        u32x2 w_; \
        PK4_(RB[0]); *(u32x2*)(cb_ + sbw0) = w_; \
        PK4_(RB[1]); *(u32x2*)(cb_ + sbw1) = w_; \
        PK4_(RB[2]); *(u32x2*)(cb_ + sbw0 + 32 * 256) = w_; \
        PK4_(RB[3]); *(u32x2*)(cb_ + sbw1 + 32 * 256) = w_; } while (0)
        GL_F32(0, ra0, rb0);
        GL_F32(BK, ra1, rb1);
        LW_F32(0, ra0, rb0);
        if (LONGK || 2 < nk) GL_F32((2 < nk ? 2 : nk - 1) * BK, ra0, rb0);
        __syncthreads();
        bf16x8 af0[4], bf0[4], af1[4], bf1[4];
        for (int kt = 0; kt < nk; kt += 2) {
            if (!KS) { FRAG_KN(0, 0, af0, bf0); } else { FRAG_KN(0, (wid >> 2), af0, bf0); }
            MEMFENCE_;
            LW_F32(1, ra1, rb1);
            if (LONGK || kt + 3 < nk) GL_F32((kt + 3 < nk ? kt + 3 : nk - 1) * BK, ra1, rb1);
            MEMFENCE_;
            if (!KS) FRAG_KN(0, 1, af1, bf1);
            MMA16(af0, bf0);
            if (!KS) MMA16(af1, bf1);
            __syncthreads();
            if (!KS) { FRAG_KN(1, 0, af0, bf0); } else { FRAG_KN(1, (wid >> 2), af0, bf0); }
            MEMFENCE_;
            if (LONGK || kt + 2 < nk) LW_F32(0, ra0, rb0);
            if (LONGK || kt + 4 < nk) GL_F32((kt + 4 < nk ? kt + 4 : nk - 1) * BK, ra0, rb0);
            MEMFENCE_;
            if (!KS) FRAG_KN(1, 1, af1, bf1);
            MMA16(af0, bf0);
            if (!KS) MMA16(af1, bf1);
            __syncthreads();
        }
#undef GL_F32
#undef LW_F32
    } else {
        const __amdgpu_buffer_rsrc_t rB = make_rsrc(Bv);
        unsigned bo[2];
#pragma unroll
        for (int i = 0; i < 2; ++i) bo[i] = ((unsigned)bsel(ar0 + 64 * i) * (unsigned)ldb + ac * 8) * 2u;
        u32x4 ra0[NA], ra1[NA], rb0[2], rb1[2];
#define GL_BF(k0, RA, RB) do { \
        _Pragma("unroll") for (int i = 0; i < NA; ++i) RA[i] = bload16(rA, ao[i], (unsigned)(k0) * 2u); \
        _Pragma("unroll") for (int i = 0; i < 2; ++i) RB[i] = bload16(rB, bo[i], (unsigned)(k0) * 2u); } while (0)
#define LW_BF(buf, RA, RB) do { \
        u16* sb_ = lds + (buf) * GEMM_BUF; \
        _Pragma("unroll") for (int i = 0; i < NA; ++i) *(u32x4*)(sb_ + sa_w + 64 * i * LROW) = RA[i]; \
        _Pragma("unroll") for (int i = 0; i < 2; ++i) *(u32x4*)(sb_ + SB0 + sa_w + 64 * i * LROW) = RB[i]; } while (0)
        GL_BF(0, ra0, rb0);
        GL_BF(BK, ra1, rb1);
        LW_BF(0, ra0, rb0);
        if (LONGK || 2 < nk) GL_BF((2 < nk ? 2 : nk - 1) * BK, ra0, rb0);
        __syncthreads();
#define FRAG_NK(buf, ks, AF, BF) do { \
        const u16* sA = lds + (buf) * GEMM_BUF; const u16* sB = sA + SB0; \
        _Pragma("unroll") for (int m = 0; m < 4; ++m) AF[m] = *(const bf16x8*)(sA + (wr * 64 + m * 16 + fr) * LROW + (ks) * 32 + fq * 8); \
        _Pragma("unroll") for (int n = 0; n < 4; ++n) BF[n] = *(const bf16x8*)(sB + (wc * 64 + n * 16 + fr) * LROW + (ks) * 32 + fq * 8); } while (0)
        bf16x8 af0[4], bf0[4], af1[4], bf1[4];
        for (int kt = 0; kt < nk; kt += 2) {
            if (!KS) { FRAG_NK(0, 0, af0, bf0); } else { FRAG_NK(0, (wid >> 2), af0, bf0); }
            MEMFENCE_;
            LW_BF(1, ra1, rb1);
            if (LONGK || kt + 3 < nk) GL_BF((kt + 3 < nk ? kt + 3 : nk - 1) * BK, ra1, rb1);
            MEMFENCE_;
            if (!KS) FRAG_NK(0, 1, af1, bf1);
            MMA16(af0, bf0);
            if (!KS) MMA16(af1, bf1);
            __syncthreads();
            if (!KS) { FRAG_NK(1, 0, af0, bf0); } else { FRAG_NK(1, (wid >> 2), af0, bf0); }
            MEMFENCE_;
            if (LONGK || kt + 2 < nk) LW_BF(0, ra0, rb0);
            if (LONGK || kt + 4 < nk) GL_BF((kt + 4 < nk ? kt + 4 : nk - 1) * BK, ra0, rb0);
            MEMFENCE_;
            if (!KS) FRAG_NK(1, 1, af1, bf1);
            MMA16(af0, bf0);
            if (!KS) MMA16(af1, bf1);
            __syncthreads();
        }
#undef FRAG_NK
#undef GL_BF
#undef LW_BF
    }
#undef GEMM_COMPUTE
#undef FRAG_KN
}

__device__ __forceinline__ void gemm_kk128(Acc& acc, const u16* __restrict__ Akm, int lda, const u16* __restrict__ Bkn, int ldb, u16* lds) {
    const int tid = ltid(), lane = tid & 63;
    const int wid = __builtin_amdgcn_readfirstlane(tid >> 6);
    const int wr = wid >> 1, wc = wid & 1, fr = lane & 15, fq = lane >> 4;
    char* sA = (char*)lds;
    char* sB = (char*)lds + 65536;
    __syncthreads();
    {
        u32x4 ra[8], rb[4];
#pragma unroll
        for (int i = 0; i < 8; ++i) { const int k = (tid >> 5) + 16 * i, ch = tid & 31; ra[i] = *(const u32x4*)(Akm + (size_t)k * lda + ch * 8); }
#pragma unroll
        for (int i = 0; i < 4; ++i) { const int k = (tid >> 4) + 32 * i, ch = tid & 15; rb[i] = *(const u32x4*)(Bkn + (size_t)k * ldb + ch * 8); }
#pragma unroll
        for (int i = 0; i < 8; ++i) { const int k = (tid >> 5) + 16 * i, ch = tid & 31; const int x = ((k & 3) << 2) | ((k >> 2) & 3);
            *(u32x4*)(sA + k * 512 + 16 * (ch ^ x)) = ra[i]; }
#pragma unroll
        for (int i = 0; i < 4; ++i) { const int k = (tid >> 4) + 32 * i, ch = tid & 15; const int x = ((k & 3) << 2) | ((k >> 2) & 3);
            *(u32x4*)(sB + k * 256 + 16 * (ch ^ x)) = rb[i]; }
    }
    __syncthreads();
    const LAS char* cA = (const LAS char*)sA; const LAS char* cB = (const LAS char*)sB;
#pragma unroll
    for (int ks = 0; ks < 4; ++ks) {
        bf16x8 af[4], bfr[4];
#pragma unroll
        for (int t = 0; t < 2; ++t) { }
#pragma unroll
        for (int m = 0; m < 4; ++m) {
            const int row0 = 32 * ks + 8 * fq + (fr >> 2), xr0 = ((fr >> 2) << 2) | ((2 * fq) & 3), xr1 = ((fr >> 2) << 2) | ((2 * fq + 1) & 3);
            const int chunk = 2 * (wr * 4 + m) + ((fr & 3) >> 1);
            const s16x4 lo_ = __builtin_amdgcn_ds_read_tr16_b64_v4i16((LAS s16x4*)(cA + row0 * 512 + 16 * (chunk ^ xr0) + 8 * (fr & 1)));
            const s16x4 hi_ = __builtin_amdgcn_ds_read_tr16_b64_v4i16((LAS s16x4*)(cA + (row0 + 4) * 512 + 16 * (chunk ^ xr1) + 8 * (fr & 1)));
            af[m] = __builtin_shufflevector(lo_, hi_, 0, 1, 2, 3, 4, 5, 6, 7);
        }
#pragma unroll
        for (int n = 0; n < 4; ++n) {
            const int row0 = 32 * ks + 8 * fq + (fr >> 2), xr0 = ((fr >> 2) << 2) | ((2 * fq) & 3), xr1 = ((fr >> 2) << 2) | ((2 * fq + 1) & 3);
            const int chunk = 2 * (wc * 4 + n) + ((fr & 3) >> 1);
            const s16x4 lo_ = __builtin_amdgcn_ds_read_tr16_b64_v4i16((LAS s16x4*)(cB + row0 * 256 + 16 * (chunk ^ xr0) + 8 * (fr & 1)));
            const s16x4 hi_ = __builtin_amdgcn_ds_read_tr16_b64_v4i16((LAS s16x4*)(cB + (row0 + 4) * 256 + 16 * (chunk ^ xr1) + 8 * (fr & 1)));
            bfr[n] = __builtin_shufflevector(lo_, hi_, 0, 1, 2, 3, 4, 5, 6, 7);
        }
#pragma unroll
        for (int m = 0; m < 4; ++m)
#pragma unroll
            for (int n = 0; n < 4; ++n) acc[m][n] = __builtin_amdgcn_mfma_f32_16x16x32_bf16(af[m], bfr[n], acc[m][n], 0, 0, 0);
    }
    __syncthreads();
}

__device__ __forceinline__ bool ksplit_reduce(Acc& acc, u16* lds) {
    const int tid = ltid(), lane = tid & 63;
    const int wid = __builtin_amdgcn_readfirstlane(tid >> 6);
    float* f = (float*)lds + (wid & 3) * 4096 + lane;
    if (wid >= 4) {
#pragma unroll
        for (int m = 0; m < 4; ++m)
#pragma unroll
            for (int n = 0; n < 4; ++n)
#pragma unroll
                for (int j = 0; j < 4; ++j) f[((m * 4 + n) * 4 + j) * 64] = acc[m][n][j];
    }
    __syncthreads();
    if (wid < 4) {
#pragma unroll
        for (int m = 0; m < 4; ++m)
#pragma unroll
            for (int n = 0; n < 4; ++n)
#pragma unroll
                for (int j = 0; j < 4; ++j) acc[m][n][j] += f[((m * 4 + n) * 4 + j) * 64];
    }
    return wid < 4;
}


#define STG_LD 68
#define STG_WAVE_BYTES (32 * STG_LD * 4)
#define WR0_ ((ltid() >> 7) * 64)
#define WC0_ (((ltid() >> 6) & 1) * 64)
template <class F>
__device__ __forceinline__ void stage_rows(Acc& acc, unsigned char* stage_base, F f) {
    const int tid = ltid(), lane = tid & 63, wid = tid >> 6, fr = lane & 15, fq = lane >> 4;
    float* st = (float*)(stage_base + wid * STG_WAVE_BYTES);
#pragma unroll
    for (int h = 0; h < 2; ++h) {
#pragma unroll
        for (int mm = 0; mm < 2; ++mm)
#pragma unroll
            for (int n = 0; n < 4; ++n)
#pragma unroll
                for (int j = 0; j < 4; ++j) st[(mm * 16 + fq * 4 + j) * STG_LD + n * 16 + fr] = acc[2 * h + mm][n][j];
        __builtin_amdgcn_s_waitcnt(0xc07f);
#pragma unroll
        for (int i = 0; i < 8; ++i) {
            const int r = (lane >> 4) + 4 * i, c4 = (lane & 15) * 4;
            const f32x4 v = *(const f32x4*)(st + r * STG_LD + c4);
            f(h * 32 + r, c4, v);
        }
        __builtin_amdgcn_s_waitcnt(0xc07f);
    }
}
template <class F>
__device__ __forceinline__ void stage_pairs(Acc& acc, unsigned char* stage_base, F f) {
    const int tid = ltid(), lane = tid & 63, wid = tid >> 6, fr = lane & 15, fq = lane >> 4;
    float* st = (float*)(stage_base + wid * STG_WAVE_BYTES);
#pragma unroll
    for (int h = 0; h < 2; ++h) {
#pragma unroll
        for (int mm = 0; mm < 2; ++mm)
#pragma unroll
            for (int n = 0; n < 4; ++n)
#pragma unroll
                for (int j = 0; j < 4; ++j) st[(mm * 16 + fq * 4 + j) * STG_LD + n * 16 + fr] = acc[2 * h + mm][n][j];
        __builtin_amdgcn_s_waitcnt(0xc07f);
#pragma unroll
        for (int i = 0; i < 4; ++i) {
            const int r = (lane >> 3) + 8 * i, c4 = (lane & 7) * 4;
            const f32x4 lo = *(const f32x4*)(st + r * STG_LD + c4);
            const f32x4 hi = *(const f32x4*)(st + r * STG_LD + c4 + 32);
            f(h * 32 + r, c4, lo, hi);
        }
        __builtin_amdgcn_s_waitcnt(0xc07f);
    }
}

template <class AUX, class PRE, class F>
__device__ __forceinline__ void stage_rows_pre(Acc& acc, unsigned char* stage_base, PRE pre, F f) {
    const int tid = ltid(), lane = tid & 63, wid = tid >> 6, fr = lane & 15, fq = lane >> 4;
    float* st = (float*)(stage_base + wid * STG_WAVE_BYTES);
#pragma unroll
    for (int h = 0; h < 2; ++h) {
        AUX aux[8];
#pragma unroll
        for (int i = 0; i < 8; ++i) aux[i] = pre(h * 32 + (lane >> 4) + 4 * i, (lane & 15) * 4);
#pragma unroll
        for (int mm = 0; mm < 2; ++mm)
#pragma unroll
            for (int n = 0; n < 4; ++n)
#pragma unroll
                for (int j = 0; j < 4; ++j) st[(mm * 16 + fq * 4 + j) * STG_LD + n * 16 + fr] = acc[2 * h + mm][n][j];
        __builtin_amdgcn_s_waitcnt(0xc07f);
        f32x4 v[8];
#pragma unroll
        for (int i = 0; i < 8; ++i) v[i] = *(const f32x4*)(st + ((lane >> 4) + 4 * i) * STG_LD + (lane & 15) * 4);
        asm volatile("" ::: "memory");
#pragma unroll
        for (int i = 0; i < 8; ++i) f(h * 32 + (lane >> 4) + 4 * i, (lane & 15) * 4, v[i], aux[i]);
        __builtin_amdgcn_s_waitcnt(0xc07f);
    }
}
template <class AUX, class PRE, class F>
__device__ __forceinline__ void stage_pairs_pre(Acc& acc, unsigned char* stage_base, PRE pre, F f) {
    const int tid = ltid(), lane = tid & 63, wid = tid >> 6, fr = lane & 15, fq = lane >> 4;
    float* st = (float*)(stage_base + wid * STG_WAVE_BYTES);
#pragma unroll
    for (int h = 0; h < 2; ++h) {
        AUX aux[4];
#pragma unroll
        for (int i = 0; i < 4; ++i) aux[i] = pre(h * 32 + (lane >> 3) + 8 * i, (lane & 7) * 4);
#pragma unroll
        for (int mm = 0; mm < 2; ++mm)
#pragma unroll
            for (int n = 0; n < 4; ++n)
#pragma unroll
                for (int j = 0; j < 4; ++j) st[(mm * 16 + fq * 4 + j) * STG_LD + n * 16 + fr] = acc[2 * h + mm][n][j];
        __builtin_amdgcn_s_waitcnt(0xc07f);
        f32x4 lo[4], hi[4];
#pragma unroll
        for (int i = 0; i < 4; ++i) {
            lo[i] = *(const f32x4*)(st + ((lane >> 3) + 8 * i) * STG_LD + (lane & 7) * 4);
            hi[i] = *(const f32x4*)(st + ((lane >> 3) + 8 * i) * STG_LD + (lane & 7) * 4 + 32);
        }
        asm volatile("" ::: "memory");
#pragma unroll
        for (int i = 0; i < 4; ++i) f(h * 32 + (lane >> 3) + 8 * i, (lane & 7) * 4, lo[i], hi[i], aux[i]);
        __builtin_amdgcn_s_waitcnt(0xc07f);
    }
}
__device__ __forceinline__ u32x2 pack4(f32x4 v) { u32x2 w; w.x = pack2(v[0], v[1]); w.y = pack2(v[2], v[3]); return w; }

struct Params {
    const float* x; const int* pos; const float* router_w; const float* router_b;
    const float* w_in0; const float* q_norm; const float* w_uq; const float* kv_norm; const float* w_ukv; const float* w_out0;
    const float* w_in1; const float* gn_g; const float* gn_b; const float* w_out1;
    const float* ln_mix_g[2]; const float* ln_mix_b[2];
    const float* moe_wg[2]; const float* moe_wu[2]; const float* moe_wd[2];
    const float* sh_g[2]; const float* sh_u[2]; const float* sh_d[2];
    const float* ln_ffn_g[2]; const float* ln_ffn_b[2];
    float* out;
    u16* w_in0b; u16* w_uqb; u16* w_ukvb; u16* w_out0b; u16* w_in1b; u16* w_out1b; u16* w_out1t; u16* w_out0t; u16* w_in1t; u16* w_in0t; u16* sh_gut[2]; u16* sh_dt[2]; u16* sh_gb[2]; u16* sh_ub[2]; u16* sh_db[2];
    unsigned* bar; unsigned* ctl;
    float* cosA; float* sinA; float* cosR; float* sinR;
    u16* xb; u16* H0;
    u16* cqn; u16* ckvn; u16* kpe; u16* qb; u16* kb; u16* vb; u16* iqb; u16* ikb; float* iwf;
    u16* qa; u16* ka; u16* vaT;
    float* scores; u16* sel; u16* outcat; float* mla_po; float* mla_ml;
    u16* ybuf; u16* xab; u16* xlb; u16* whT; u16* wlT; u16* y2; u16* xcb;
    int* tok_e; float* tok_g; int* list; u16* hbuf; u16* hsh; u16* yr;
    u16* qr; u16* qx; u16* kr; u16* kzT; u16* v1; u16* kz; u16* sg; u16* KVt; u16* innerG; u16* obuf; u16* gated;
    int out_size; int pad_;
};
typedef const __attribute__((address_space(4))) Params* KP;
__device__ __forceinline__ KP getp() { KP kp = (KP)__builtin_amdgcn_kernarg_segment_ptr(); asm volatile("" : "+s"(kp)); return kp; }
#define CTL_FLAGS 0
#define CTL_QUEUE 16
#define CNT_STRIDE 32
#define CTL_CNT0 64
#define CTL_CNT1 (64 + 64 * CNT_STRIDE)
#define CTL_CNTX (64 + 128 * CNT_STRIDE)
#define CTL_WORDS (64 + 192 * CNT_STRIDE)

struct RowId { int base; __device__ __forceinline__ int operator()(int r) const { return base + r; } };
struct ColOff { int c0;
    __device__ __forceinline__ const u16* base16(const u16* B, int) const { return B; }
    __device__ __forceinline__ unsigned off8(int hsel, int ch8) const { return (unsigned)(c0 + hsel * 64 + ch8 * 8); }
    __device__ __forceinline__ int vchunk(int hsel, int ch8) const { return hsel * 8 + ch8; }
    __device__ __forceinline__ const float* base(const float* B, int) const { return B; }
    __device__ __forceinline__ unsigned off4(int hsel, int g4) const { return (unsigned)(c0 + hsel * 64 + g4 * 4); }
    __device__ __forceinline__ int vcol4(int hsel, int g4) const { return hsel * 64 + g4 * 4; } };
struct ColClampOff { int c0, n;
    __device__ __forceinline__ const u16* base16(const u16* B, int) const { return B; }
    __device__ __forceinline__ unsigned off8(int hsel, int ch8) const { const int c = c0 + hsel * 64 + ch8 * 8; return (unsigned)(c < n - 8 ? c : n - 8); }
    __device__ __forceinline__ int vchunk(int hsel, int ch8) const { return hsel * 8 + ch8; }
    __device__ __forceinline__ const float* base(const float* B, int) const { return B; }
    __device__ __forceinline__ unsigned off4(int hsel, int g4) const { const int c = c0 + hsel * 64 + g4 * 4; return (unsigned)(c < n - 4 ? c : n - 4); }
    __device__ __forceinline__ int vcol4(int hsel, int g4) const { return hsel * 64 + g4 * 4; } };

__device__ __forceinline__ void ph_prep(KP p) {
    const int gtid = blockIdx.x * NT + ltid(), gsz = gridDim.x * NT;
    {
        const size_t n4 = (size_t)T_ * D_ / 4;
        for (size_t i0 = gtid; i0 < n4; i0 += (size_t)8 * gsz) {
            float4 v[8];
#pragma unroll
            for (int u = 0; u < 8; ++u) { const size_t i = i0 + (size_t)u * gsz; v[u] = ((const float4*)p->x)[i < n4 ? i : i0]; }
#pragma unroll
            for (int u = 0; u < 8; ++u) {
                const size_t i = i0 + (size_t)u * gsz;
                u32x2 o; o.x = pack2(v[u].x, v[u].y); o.y = pack2(v[u].z, v[u].w);
                if (i < n4) ((u32x2*)p->xb)[i] = o;
            }
        }
    }
    for (int idx = gtid; idx < D_ * 64; idx += gsz) {
        const int k = idx >> 6, e = idx & 63;
        const float w = p->router_w[idx];
        const u16 hi = f2bf(w);
        p->whT[(size_t)e * D_ + k] = hi;
        p->wlT[(size_t)e * D_ + k] = f2bf(w - bf2f(hi));
    }
    {
        auto cvt = [&](const float* src, u16* dst, size_t n) {
            for (size_t i = gtid; i < n / 8; i += gsz) {
                const f32x4 a = ((const f32x4*)src)[2 * i], b = ((const f32x4*)src)[2 * i + 1];
                u32x4 o; o.x = pack2(a[0], a[1]); o.y = pack2(a[2], a[3]); o.z = pack2(b[0], b[1]); o.w = pack2(b[2], b[3]);
                ((u32x4*)dst)[i] = o;
            }
        };
        cvt(p->w_uq, p->w_uqb, (size_t)512 * 1536);
        cvt(p->w_ukv, p->w_ukvb, (size_t)256 * 2048);
    }
    const double inv2pi = 0.15915494309189535;
    for (int idx = gtid; idx < T_ * 32; idx += gsz) {
        const int t = idx >> 5, i = idx & 31;
        const float inv = (float)exp2(-(double)i * (18.931568569324174 / 32.0));
        double rev = (double)p->pos[t] * (double)inv * inv2pi;
        rev -= floor(rev);
        p->cosA[idx] = __builtin_amdgcn_cosf((float)rev);
        p->sinA[idx] = __builtin_amdgcn_sinf((float)rev);
    }
    for (int idx = gtid; idx < T_ * 128; idx += gsz) {
        const int t = idx >> 7, i = idx & 127;
        const float inv = (float)exp2(-(double)i * (13.287712379549449 / 128.0));
        double rev = (double)p->pos[t] * (double)inv * inv2pi;
        rev -= floor(rev);
        p->cosR[idx] = __builtin_amdgcn_cosf((float)rev);
        p->sinR[idx] = __builtin_amdgcn_sinf((float)rev);
    }
}

struct EpiF32 {
    float* C; int ldc; int row0, col0, ncols;
    __device__ __forceinline__ void operator()(Acc& acc, unsigned char* stg) const {
        const int rb = row0 + WR0_, cb = col0 + WC0_;
        float* Cp = C; const int ld = ldc, nc = ncols;
        stage_rows(acc, stg, [=](int r, int c4, f32x4 v) {
            const int c = cb + c4;
            if (c < nc) *(f32x4*)(Cp + (size_t)(rb + r) * ld + c) = v;
        });
    }
};
struct EpiBF16N {
    u16* C; int ldc; int row0, col0, ncols;
    __device__ __forceinline__ void operator()(Acc& acc, unsigned char* stg) const {
        const int rb = row0 + WR0_, cb = col0 + WC0_;
        u16* Cp = C; const int ld = ldc, nc = ncols;
        stage_rows(acc, stg, [=](int r, int c4, f32x4 v) {
            const int c = cb + c4;
            if (c < nc) *(u32x2*)(Cp + (size_t)(rb + r) * ld + c) = pack4(v);
        });
    }
};
struct EpiBF16 {
    u16* C; int ldc; int row0, col0;
    __device__ __forceinline__ void operator()(Acc& acc, unsigned char* stg) const {
        const int rb = row0 + WR0_, cb = col0 + WC0_;
        u16* Cp = C; const int ld = ldc;
        stage_rows(acc, stg, [=](int r, int c4, f32x4 v) { *(u32x2*)(Cp + (size_t)(rb + r) * ld + cb + c4) = pack4(v); });
    }
};
template <bool XB>
struct EpiResid {
    u16* C; const void* X; int ldc; int row0, col0;
    __device__ __forceinline__ void operator()(Acc& acc, unsigned char* stg) const {
        const int rb = row0 + WR0_, cb = col0 + WC0_;
        u16* Cp = C; const void* Xp = X; const int ld = ldc;
        stage_rows_pre<f32x4>(acc, stg,
            [=](int r, int c4) -> f32x4 {
                const size_t o = (size_t)(rb + r) * ld + cb + c4;
                f32x4 x;
                if constexpr (XB) {
                    const u32x2 xr = *(const u32x2*)((const u16*)Xp + o);
                    x[0] = __uint_as_float(xr.x << 16); x[1] = __uint_as_float(xr.x & 0xffff0000u);
                    x[2] = __uint_as_float(xr.y << 16); x[3] = __uint_as_float(xr.y & 0xffff0000u);
                } else x = *(const f32x4*)((const float*)Xp + o);
                return x; },
            [=](int r, int c4, f32x4 v, f32x4 x) {
                *(u32x2*)(Cp + (size_t)(rb + r) * ld + cb + c4) = pack4(x * ALPHA_ + v); });
    }
};

__device__ __forceinline__ void ph_post0(KP p) {
    const int lane = ltid() & 63;
    const int gw = (blockIdx.x * NT + ltid()) >> 6, nw = (gridDim.x * NT) >> 6;
    const float qscale = 0.08838834764831845f * LOG2E_;
    const int dq = lane, d7 = lane & 127;
    const float qn[8] = {p->q_norm[lane], p->q_norm[lane + 64], p->q_norm[lane + 128], p->q_norm[lane + 192],
                         p->q_norm[lane + 256], p->q_norm[lane + 320], p->q_norm[lane + 384], p->q_norm[lane + 448]};
    const float kn[4] = {p->kv_norm[lane], p->kv_norm[lane + 64], p->kv_norm[lane + 128], p->kv_norm[lane + 192]};
    (void)dq; (void)d7;
    for (int t = gw; t < T_; t += nw) {
        const u16* hb = p->H0 + (size_t)t * IN_AB;
#define h_(i) bf2f(hb[i])
        const float* ca = p->cosA + t * 32;
        const float* sa = p->sinA + t * 32;
        const float c32 = ca[lane & 31], s32 = sa[lane & 31];
        const float c16 = ca[2 * (lane & 15)], s16 = sa[2 * (lane & 15)];
        const float c8 = ca[4 * (lane & 7)], s8 = sa[4 * (lane & 7)];
        float vq[8], vkv[4];
#pragma unroll
        for (int j = 0; j < 8; ++j) vq[j] = h_(lane + 64 * j);
#pragma unroll
        for (int j = 0; j < 4; ++j) vkv[j] = h_(512 + lane + 64 * j);
        const float kx1 = h_(768 + (lane & 31)), kx2 = h_(768 + 32 + (lane & 31));
        float q1[16], q2[16];
#pragma unroll
        for (int j = 0; j < 16; ++j) {
            const int e = lane + 64 * j, hd = e >> 7, d = e & 127, i = d & 15;
            const int i1 = d < 32 ? 832 + hd * 128 + i : 832 + e;
            q1[j] = h_(i1); q2[j] = h_(d < 32 ? i1 + 16 : i1);
        }
        float k1[4], k2[4], vv[4];
#pragma unroll
        for (int j = 0; j < 4; ++j) {
            const int e = lane + 64 * j, hd = e >> 7, d = e & 127, i = d & 15;
            const int i1 = d < 32 ? 1856 + hd * 128 + i : 1856 + e;
            k1[j] = h_(i1); k2[j] = h_(d < 32 ? i1 + 16 : i1);
            vv[j] = h_(2112 + e);
        }
        float iq1[16], iq2[16];
#pragma unroll
        for (int j = 0; j < 16; ++j) {
            const int e = lane + 64 * j, hd = e >> 6, d = e & 63, i = d & 7;
            const int i1 = d < 16 ? 2368 + hd * 64 + i : 2368 + e;
            iq1[j] = h_(i1); iq2[j] = h_(d < 16 ? i1 + 8 : i1);
        }
        const int iki = lane < 16 ? 3392 + (lane & 7) : 3392 + lane;
        const float ik1 = h_(iki), ik2 = h_(lane < 16 ? iki + 8 : iki);
        const float iwv = h_(3456 + (lane & 15));
        {
            float ss = 0.f;
#pragma unroll
            for (int j = 0; j < 8; ++j) ss += vq[j] * vq[j];
            ss = wave_sum(ss);
            const float r = rsqrtf(ss * (1.f / 512.f) + 1e-6f);
#pragma unroll
            for (int j = 0; j < 8; ++j) p->cqn[(size_t)t * 512 + lane + 64 * j] = f2bf(vq[j] * r * qn[j]);
        }
        {
            float ss = 0.f;
#pragma unroll
            for (int j = 0; j < 4; ++j) ss += vkv[j] * vkv[j];
            ss = wave_sum(ss);
            const float r = rsqrtf(ss * (1.f / 256.f) + 1e-6f);
#pragma unroll
            for (int j = 0; j < 4; ++j) p->ckvn[(size_t)t * 256 + lane + 64 * j] = f2bf(vkv[j] * r * kn[j]);
        }
        p->kpe[(size_t)t * 64 + lane] = f2bf(lane < 32 ? kx1 * c32 - kx2 * s32 : kx1 * s32 + kx2 * c32);
#pragma unroll
        for (int j = 0; j < 16; ++j) {
            const int d = (lane + 64 * j) & 127;
            const float m1 = d < 16 ? c16 : (d < 32 ? s16 : 1.f), m2 = d < 16 ? -s16 : (d < 32 ? c16 : 0.f);
            p->qb[(size_t)t * 1024 + lane + 64 * j] = f2bf((q1[j] * m1 + q2[j] * m2) * qscale);
        }
#pragma unroll
        for (int j = 0; j < 4; ++j) {
            const int d = (lane + 64 * j) & 127;
            const float m1 = d < 16 ? c16 : (d < 32 ? s16 : 1.f), m2 = d < 16 ? -s16 : (d < 32 ? c16 : 0.f);
            p->kb[(size_t)t * 256 + lane + 64 * j] = f2bf(k1[j] * m1 + k2[j] * m2);
            p->vb[(size_t)t * 256 + lane + 64 * j] = f2bf(vv[j]);
        }
        {
            const float m1 = lane < 8 ? c8 : (lane < 16 ? s8 : 1.f), m2 = lane < 8 ? -s8 : (lane < 16 ? c8 : 0.f);
#pragma unroll
            for (int j = 0; j < 16; ++j) p->iqb[(size_t)t * 1024 + lane + 64 * j] = f2bf(iq1[j] * m1 + iq2[j] * m2);
            p->ikb[(size_t)t * 64 + lane] = f2bf(ik1 * m1 + ik2 * m2);
        }
        if (lane < 16) p->iwf[t * 16 + lane] = iwv * 0.03125f;
    }
#undef h_
}

struct CS8 { f32x4 c, s; };
struct EpiQa {
    u16* C; const float* ca; const float* sa; int row0, col0;
    __device__ __forceinline__ void operator()(Acc& acc, unsigned char* stg) const {
        const float sc = 0.07216878364870323f * LOG2E_;
        const int rb = row0 + WR0_, cbase = col0 + WC0_;
        const bool rope = (cbase % 192) == 128;
        u16* Cp = C; const float* cap = ca; const float* sap = sa;
        stage_pairs_pre<CS8>(acc, stg,
            [=](int r, int c4) -> CS8 {
                CS8 t; t.c = (f32x4){1.f, 1.f, 1.f, 1.f}; t.s = (f32x4){0.f, 0.f, 0.f, 0.f};
                if (rope) { t.c = *(const f32x4*)(cap + (rb + r) * 32 + c4); t.s = *(const f32x4*)(sap + (rb + r) * 32 + c4); }
                return t; },
            [=](int r, int c4, f32x4 lo, f32x4 hi, CS8 t) {
                const int tt = rb + r;
                const f32x4 a = lo * t.c - hi * t.s, b = lo * t.s + hi * t.c;
                *(u32x2*)(Cp + (size_t)tt * 1536 + cbase + c4) = pack4(a * sc);
                *(u32x2*)(Cp + (size_t)tt * 1536 + cbase + c4 + 32) = pack4(b * sc); });
    }
};
struct EpiKva {
    u16* ka; u16* vaT; int row0, col0;
    __device__ __forceinline__ void operator()(Acc& acc, unsigned char* stg) const {
        const int cbase = col0 + WC0_;
        const int hd = cbase >> 8, within = cbase & 255;
        if (within < 128) {
            const int rb = row0 + WR0_;
            u16* kp = ka + hd * 128 + within;
            stage_rows(acc, stg, [=](int r, int c4, f32x4 v) { *(u32x2*)(kp + (size_t)(rb + r) * 1024 + c4) = pack4(v); });
        } else {
            const int lane = ltid() & 63, fr = lane & 15, fq = lane >> 4;
#pragma unroll
            for (int m = 0; m < 4; ++m) {
                const int r = row0 + WR0_ + m * 16 + fq * 4;
#pragma unroll
                for (int n = 0; n < 4; ++n) {
                    const int c = within - 128 + n * 16 + fr;
                    u32x2 o; o.x = pack2(acc[m][n][0], acc[m][n][1]); o.y = pack2(acc[m][n][2], acc[m][n][3]);
                    *(u32x2*)(vaT + (size_t)(hd * 128 + c) * T_ + r) = o;
                }
            }
        }
    }
};

__device__ __forceinline__ void indexer_tile(KP p, int qt, int kt) {
    const int lane = ltid() & 63, wid = (ltid() >> 6) & 3;
    const int wr = wid >> 1, wc = wid & 1, fr = lane & 15, fq = lane >> 4;
    const int k0 = kt * 128 + wr * 64, q0 = qt * 128 + wc * 64;
    bf16x8 af[4][2];
#pragma unroll
    for (int m = 0; m < 4; ++m)
#pragma unroll
        for (int ks = 0; ks < 2; ++ks)
            af[m][ks] = *(const bf16x8*)(p->ikb + (size_t)(k0 + m * 16 + fr) * 64 + ks * 32 + fq * 8);
    Acc sc; acc_zero(sc);
    for (int h = 0; h < 16; ++h) {
        bf16x8 bq[4][2]; float w[4];
#pragma unroll
        for (int n = 0; n < 4; ++n) {
            const size_t qrow = (size_t)(q0 + n * 16 + fr);
            bq[n][0] = *(const bf16x8*)(p->iqb + qrow * 1024 + h * 64 + fq * 8);
            bq[n][1] = *(const bf16x8*)(p->iqb + qrow * 1024 + h * 64 + 32 + fq * 8);
            w[n] = p->iwf[qrow * 16 + h];
        }
#pragma unroll
        for (int m = 0; m < 4; ++m)
#pragma unroll
            for (int n = 0; n < 4; ++n) {
                f32x4 d = (f32x4){0.f, 0.f, 0.f, 0.f};
                d = __builtin_amdgcn_mfma_f32_16x16x32_bf16(af[m][0], bq[n][0], d, 0, 0, 0);
                d = __builtin_amdgcn_mfma_f32_16x16x32_bf16(af[m][1], bq[n][1], d, 0, 0, 0);
#pragma unroll
                for (int j = 0; j < 4; ++j) sc[m][n][j] += w[n] * fmaxf(d[j], 0.f);
            }
    }
#pragma unroll
    for (int m = 0; m < 4; ++m)
#pragma unroll
        for (int n = 0; n < 4; ++n)
            *(f32x4*)(p->scores + (size_t)(q0 + n * 16 + fr) * T_ + k0 + m * 16 + fq * 4) = sc[m][n];
}

__device__ __forceinline__ void indexer_item(KP p, int g) {
    const int lane = ltid() & 63, wid = __builtin_amdgcn_readfirstlane(ltid() >> 6);
    const int fr = lane & 15, fq = lane >> 4;
    const int q0 = g * 16, nkb = g + 1;
    bf16x8 bq[16][2]; float w[16];
    {
        const u16* qrow = p->iqb + (size_t)(q0 + fr) * 1024 + fq * 8;
#pragma unroll
        for (int h = 0; h < 16; ++h) { bq[h][0] = *(const bf16x8*)(qrow + h * 64); bq[h][1] = *(const bf16x8*)(qrow + h * 64 + 32); }
        const float* wrow = p->iwf + (size_t)(q0 + fr) * 16;
#pragma unroll
        for (int h4 = 0; h4 < 4; ++h4) {
            const f32x4 wv = *(const f32x4*)(wrow + h4 * 4);
#pragma unroll
            for (int j = 0; j < 4; ++j) w[h4 * 4 + j] = wv[j];
        }
    }
    const u16* kbase = p->ikb + (size_t)fr * 64 + fq * 8;
    float* srow = p->scores + (size_t)(q0 + fr) * T_ + 4 * fq;
#define IDX_LOAD(A, kb_) do { const int kc_ = (kb_) < nkb ? (kb_) : nkb - 1; \
        A[0] = *(const bf16x8*)(kbase + (size_t)kc_ * 1024); A[1] = *(const bf16x8*)(kbase + (size_t)kc_ * 1024 + 32); } while (0)
#define IDX_COMP(A, kb_) do { if ((kb_) < nkb) { \
        f32x4 sc_ = (f32x4){0.f, 0.f, 0.f, 0.f}; \
        _Pragma("unroll") for (int h = 0; h < 16; ++h) { \
            f32x4 d_ = (f32x4){0.f, 0.f, 0.f, 0.f}; \
            d_ = __builtin_amdgcn_mfma_f32_16x16x32_bf16(A[0], bq[h][0], d_, 0, 0, 0); \
            d_ = __builtin_amdgcn_mfma_f32_16x16x32_bf16(A[1], bq[h][1], d_, 0, 0, 0); \
            _Pragma("unroll") for (int j = 0; j < 4; ++j) sc_[j] += w[h] * fmaxf(d_[j], 0.f); } \
        *(f32x4*)(srow + (size_t)(kb_) * 16) = sc_; } } while (0)
    bf16x8 a0[2], a1[2], a2[2], a3[2];
    int kb = wid;
    IDX_LOAD(a0, kb); IDX_LOAD(a1, kb + 8); IDX_LOAD(a2, kb + 16); IDX_LOAD(a3, kb + 24);
    for (; kb < nkb; kb += 32) {
        IDX_COMP(a0, kb); IDX_LOAD(a0, kb + 32);
        IDX_COMP(a1, kb + 8); IDX_LOAD(a1, kb + 40);
        IDX_COMP(a2, kb + 16); IDX_LOAD(a2, kb + 48);
        IDX_COMP(a3, kb + 24); IDX_LOAD(a3, kb + 56);
    }
#undef IDX_LOAD
#undef IDX_COMP
}

__device__ __forceinline__ unsigned fkey(float f) {
    const unsigned u = __float_as_uint(f);
    return (u & 0x80000000u) ? ~u : (u | 0x80000000u);
}
#define TOPK_WLDS (1024 * 4 + 1024 * 2)
__device__ __forceinline__ void ph_topk(KP p, unsigned char* smem) {
    const int lane0 = ltid() & 63, wid = ltid() >> 6;
    const int gw = __builtin_amdgcn_readfirstlane((blockIdx.x * NT + ltid()) >> 6), nw = (gridDim.x * NT) >> 6;
    unsigned* ckey = (unsigned*)(smem + wid * TOPK_WLDS);
    u16* cidx = (u16*)(smem + wid * TOPK_WLDS + 4096);
    for (int qq = gw; qq < T_ / 2; qq += nw)
    for (int sside = 0; sside < 2; ++sside) {
        int lane = lane0; asm volatile("" : "+v"(lane));
        const int q = sside ? (T_ - 1 - qq) : qq;
        u16* so = p->sel + (size_t)q * 256;
        if (q < 256) {
#pragma unroll
            for (int i = 0; i < 4; ++i) { const int s = lane + 64 * i; so[s] = (u16)(s <= q ? s : 0); }
            continue;
        }
        const int ng = (q >> 10) + 1;
        unsigned key[128];
        const float* row = p->scores + (size_t)q * T_;
        unsigned gm[4] = {0u, 0u, 0u, 0u};
        const int qml = q - lane;
#pragma unroll
        for (int g = 0; g < 8; ++g) {
            if (g < ng) {
                const float* rg = row + g * 1024 + lane;
#pragma unroll
                for (int i = 0; i < 16; ++i) {
                    const unsigned kx = fkey(rg[64 * i]) & ~(unsigned)((qml - 64 * (g * 16 + i)) >> 31);
                    key[g * 16 + i] = kx;
                    gm[i & 3] = kx > gm[i & 3] ? kx : gm[i & 3];
                }
            } else {
#pragma unroll
                for (int i = 0; i < 16; ++i) key[g * 16 + i] = 0u;
            }
        }
        unsigned Lk = gm[0] < gm[1] ? gm[0] : gm[1], Mk = gm[0] > gm[1] ? gm[0] : gm[1];
        { const unsigned l2 = gm[2] < gm[3] ? gm[2] : gm[3], m2 = gm[2] > gm[3] ? gm[2] : gm[3];
          Lk = Lk < l2 ? Lk : l2; Mk = Mk > m2 ? Mk : m2; }
#pragma unroll
        for (int o = 32; o > 0; o >>= 1) {
            const unsigned lo_ = (unsigned)__shfl_xor((int)Lk, o), mo_ = (unsigned)__shfl_xor((int)Mk, o);
            Lk = Lk < lo_ ? Lk : lo_; Mk = Mk > mo_ ? Mk : mo_;
        }
        Lk = (unsigned)__builtin_amdgcn_readfirstlane((int)Lk); Mk = (unsigned)__builtin_amdgcn_readfirstlane((int)Mk);
        unsigned prefix = 0u;
        int C = q + 1, b = 31;
        bool exact = false;
        if (Lk == Mk) { prefix = Mk; b = -1; }
        else { b = 31 - __builtin_clz(Lk ^ Mk); prefix = Mk & ~((2u << b) - 1u); }
        if (b < 31) {
            int cnt = 0;
#pragma unroll
            for (int g = 0; g < 8; ++g) {
                if (g < ng) {
#pragma unroll
                    for (int i = 0; i < 16; ++i) cnt += __builtin_popcountll(__ballot(key[g * 16 + i] >= prefix));
                }
            }
            C = cnt;
            if (cnt == 256) { exact = true; b = -1; }
        }
        for (; b >= 0 && C > 1024; --b) {
            const unsigned cand = prefix | (1u << b);
            int cnt = 0;
#pragma unroll
            for (int g = 0; g < 8; ++g) {
                if (g < ng) {
#pragma unroll
                    for (int i = 0; i < 16; ++i) cnt += __builtin_popcountll(__ballot(key[g * 16 + i] >= cand));
                }
            }
            if (cnt >= 256) { prefix = cand; C = cnt; }
            if (cnt == 256) { exact = true; --b; break; }
        }
        if (C > 1024) {
            int wp = 0;
#pragma unroll
            for (int g = 0; g < 8; ++g) {
                if (g < ng) {
#pragma unroll
                    for (int i = 0; i < 16; ++i) {
                        const bool gt = key[g * 16 + i] > prefix;
                        const unsigned long long m = __ballot(gt);
                        if (gt) so[wp + (int)__builtin_amdgcn_mbcnt_hi((unsigned)(m >> 32), __builtin_amdgcn_mbcnt_lo((unsigned)m, 0u))] = (u16)(lane + 64 * (g * 16 + i));
                        wp += __builtin_popcountll(m);
                    }
                }
            }
#pragma unroll
            for (int g = 0; g < 8; ++g) {
                if (g < ng && wp < 256) {
#pragma unroll
                    for (int i = 0; i < 16; ++i) {
                        const bool eq = key[g * 16 + i] == prefix && (lane + 64 * (g * 16 + i)) <= q;
                        const unsigned long long m = __ballot(eq);
                        if (eq) {
                            const int pos = wp + (int)__builtin_amdgcn_mbcnt_hi((unsigned)(m >> 32), __builtin_amdgcn_mbcnt_lo((unsigned)m, 0u));
                            if (pos < 256) so[pos] = (u16)(lane + 64 * (g * 16 + i));
                        }
                        wp += __builtin_popcountll(m);
                    }
                }
            }
            continue;
        }
        int base = 0;
#pragma unroll
        for (int g = 0; g < 8; ++g) {
            if (g < ng) {
#pragma unroll
                for (int i = 0; i < 16; ++i) {
                    const bool ge = key[g * 16 + i] >= prefix && (lane + 64 * (g * 16 + i)) <= q;
                    const unsigned long long m = __ballot(ge);
                    if (ge) {
                        const int pos = base + (int)__builtin_amdgcn_mbcnt_hi((unsigned)(m >> 32), __builtin_amdgcn_mbcnt_lo((unsigned)m, 0u));
                        ckey[pos] = key[g * 16 + i]; cidx[pos] = (u16)(lane + 64 * (g * 16 + i));
                    }
                    base += __builtin_popcountll(m);
                }
            }
        }
        __builtin_amdgcn_s_waitcnt(0xc07f);
        unsigned ck[16];
#pragma unroll
        for (int i = 0; i < 16; ++i) {
            const int s = lane + 64 * i;
            ck[i] = s < base ? ckey[s] : 0u;
        }
        if (!exact) {
            for (; b >= 0; --b) {
                const unsigned cand = prefix | (1u << b);
                int cnt = 0;
#pragma unroll
                for (int i = 0; i < 16; ++i) cnt += __builtin_popcountll(__ballot(ck[i] >= cand));
                if (cnt >= 256) prefix = cand;
                if (cnt == 256) break;
            }
        }
        int wpos = 0;
#pragma unroll
        for (int i = 0; i < 16; ++i) {
            const bool gt = ck[i] > prefix;
            const unsigned long long m = __ballot(gt);
            if (gt) so[wpos + (int)__builtin_amdgcn_mbcnt_hi((unsigned)(m >> 32), __builtin_amdgcn_mbcnt_lo((unsigned)m, 0u))] = cidx[lane + 64 * i];
            wpos += __builtin_popcountll(m);
        }
#pragma unroll
        for (int i = 0; i < 16; ++i) {
            if (wpos < 256) {
                const bool eq = ck[i] == prefix && (lane + 64 * i) < base;
                const unsigned long long m = __ballot(eq);
                if (eq) {
                    const int pos = wpos + (int)__builtin_amdgcn_mbcnt_hi((unsigned)(m >> 32), __builtin_amdgcn_mbcnt_lo((unsigned)m, 0u));
                    if (pos < 256) so[pos] = cidx[lane + 64 * i];
                }
                wpos += __builtin_popcountll(m);
            }
        }
        __builtin_amdgcn_s_waitcnt(0xc07f);
    }
}

#define KROW 208
#define VROW 80
#define ATT_LDS_BYTES (64 * KROW * 2 + 128 * VROW * 2)

__device__ __forceinline__ void mla_item(KP p, int h, int qb, u16* lds, int seg) {
    const int tid = ltid(), lane = tid & 63, wid = tid >> 6, fr = lane & 15, fq = lane >> 4;
    u16* sK = lds;
    u16* sV = lds + 64 * KROW;
    const int q0 = qb * 256;
    bf16x8 qf[2][6];
#pragma unroll
    for (int nq = 0; nq < 2; ++nq)
#pragma unroll
        for (int kc = 0; kc < 6; ++kc)
            qf[nq][kc] = *(const bf16x8*)(p->qa + (size_t)(q0 + wid * 32 + nq * 16 + fr) * 1536 + h * 192 + kc * 32 + fq * 8);
    f32x4 O[8][2];
#pragma unroll
    for (int m = 0; m < 8; ++m) { O[m][0] = (f32x4){0.f, 0.f, 0.f, 0.f}; O[m][1] = (f32x4){0.f, 0.f, 0.f, 0.f}; }
    float mrun[2] = {-1e30f, -1e30f}, lrun[2] = {0.f, 0.f};

    const int k0t = tid >> 4, k1t = tid >> 3;
    const u16* kpn = p->ka + (size_t)k0t * 1024 + h * 128 + (tid & 15) * 8;
    const u16* kpr = p->kpe + (size_t)k1t * 64 + (tid & 7) * 8;
    const u16* vpp = p->vaT + (size_t)(h * 128 + k1t) * T_ + (tid & 7) * 8;
    const int kln = (((k0t >> 2) & 1) * 16 + (k0t >> 3) * 4 + (k0t & 3)) * KROW + (tid & 15) * 8;
    const int e1 = k1t & 31;
    const int klr = ((k1t >> 5) * 32 + ((e1 >> 2) & 1) * 16 + (e1 >> 3) * 4 + (e1 & 3)) * KROW + 128 + (tid & 7) * 8;
    const int vl0 = k1t * VROW + (tid & 7) * 8;
    u32x4 kreg[3], vreg[2];
    const int ntiles = 4 * qb + 4;
    const int kt_lo = seg == 1 ? ntiles / 2 : 0, kt_hi = seg == 0 ? ntiles / 2 : ntiles;
#define ATT_GLOAD(kt) do { \
    _Pragma("unroll") for (int i = 0; i < 2; ++i) kreg[i] = *(const u32x4*)(kpn + (size_t)((kt) * 64 + 32 * i) * 1024); \
    kreg[2] = *(const u32x4*)(kpr + (size_t)((kt) * 64) * 64); \
    _Pragma("unroll") for (int i = 0; i < 2; ++i) vreg[i] = *(const u32x4*)(vpp + (size_t)(64 * i) * T_ + (kt) * 64); } while (0)
#define ATT_LWRITE(buf) do { \
        u16* sK_ = lds + (buf) * (ATT_LDS_BYTES / 2); u16* sV_ = sK_ + 64 * KROW; \
        _Pragma("unroll") for (int i = 0; i < 2; ++i) *(u32x4*)(sK_ + kln + 32 * i * KROW) = kreg[i]; \
        *(u32x4*)(sK_ + klr) = kreg[2]; \
        _Pragma("unroll") for (int i = 0; i < 2; ++i) *(u32x4*)(sV_ + vl0 + 64 * i * VROW) = vreg[i]; } while (0)
    ATT_GLOAD(kt_lo);
    __syncthreads();
    ATT_LWRITE(0);
    if (kt_lo + 1 < kt_hi) ATT_GLOAD(kt_lo + 1);
    __syncthreads();
    for (int kt = kt_lo; kt < kt_hi; ++kt) {
        const int cb = (kt - kt_lo) & 1;
        sK = lds + cb * (ATT_LDS_BYTES / 2);
        sV = sK + 64 * KROW;
        if (kt * 64 > q0 + wid * 32 + 31) {
            if (kt + 1 < kt_hi) ATT_LWRITE(cb ^ 1);
            if (kt + 2 < kt_hi) ATT_GLOAD(kt + 2);
            __syncthreads(); continue;
        }
        f32x4 s[2][4];
#pragma unroll
        for (int n = 0; n < 4; ++n) { s[0][n] = (f32x4){0.f, 0.f, 0.f, 0.f}; s[1][n] = (f32x4){0.f, 0.f, 0.f, 0.f}; }
#pragma unroll
        for (int kc = 0; kc < 6; ++kc)
#pragma unroll
            for (int n = 0; n < 4; ++n) {
                const bf16x8 a = *(const bf16x8*)(sK + (n * 16 + fr) * KROW + kc * 32 + fq * 8);
                s[0][n] = __builtin_amdgcn_mfma_f32_16x16x32_bf16(a, qf[0][kc], s[0][n], 0, 0, 0);
                s[1][n] = __builtin_amdgcn_mfma_f32_16x16x32_bf16(a, qf[1][kc], s[1][n], 0, 0, 0);
            }
        if (kt + 1 < kt_hi) ATT_LWRITE(cb ^ 1);
        if (kt + 2 < kt_hi) ATT_GLOAD(kt + 2);
        if (kt >= ntiles - 4) {
#pragma unroll
            for (int nq = 0; nq < 2; ++nq) {
                const int qi = q0 + wid * 32 + nq * 16 + fr;
#pragma unroll
                for (int n = 0; n < 4; ++n)
#pragma unroll
                    for (int j = 0; j < 4; ++j) {
                        const int ki = kt * 64 + (n >> 1) * 32 + fq * 8 + (n & 1) * 4 + j;
                        if (ki > qi) s[nq][n][j] = -1e30f;
                    }
            }
        }
        bf16x8 pf[2][2];
#pragma unroll
        for (int nq = 0; nq < 2; ++nq) {
            float mx = -1e30f;
#pragma unroll
            for (int n = 0; n < 4; ++n)
#pragma unroll
                for (int j = 0; j < 4; ++j) mx = fmaxf(mx, s[nq][n][j]);
            mx = fmaxf(mx, __shfl_xor(mx, 16));
            mx = fmaxf(mx, __shfl_xor(mx, 32));
            const float mnew = fmaxf(mrun[nq], mx);
            const float al = __builtin_amdgcn_exp2f(mrun[nq] - mnew);
            mrun[nq] = mnew;
            float ps = 0.f;
#pragma unroll
            for (int n = 0; n < 4; ++n)
#pragma unroll
                for (int j = 0; j < 4; ++j) { const float e = __builtin_amdgcn_exp2f(s[nq][n][j] - mnew); s[nq][n][j] = e; ps += e; }
            lrun[nq] = lrun[nq] * al + ps;
            if (__ballot(al != 1.0f) != 0ull) {
#pragma unroll
                for (int m = 0; m < 8; ++m) O[m][nq] *= al;
            }
#pragma unroll
            for (int c = 0; c < 2; ++c) {
                u32x4 w;
                w.x = pack2(s[nq][2 * c][0], s[nq][2 * c][1]);
                w.y = pack2(s[nq][2 * c][2], s[nq][2 * c][3]);
                w.z = pack2(s[nq][2 * c + 1][0], s[nq][2 * c + 1][1]);
                w.w = pack2(s[nq][2 * c + 1][2], s[nq][2 * c + 1][3]);
                pf[nq][c] = *(bf16x8*)&w;
            }
        }
#pragma unroll
        for (int m = 0; m < 8; ++m)
#pragma unroll
            for (int c = 0; c < 2; ++c) {
                const bf16x8 a = *(const bf16x8*)(sV + (m * 16 + fr) * VROW + c * 32 + fq * 8);
                O[m][0] = __builtin_amdgcn_mfma_f32_16x16x32_bf16(a, pf[0][c], O[m][0], 0, 0, 0);
                O[m][1] = __builtin_amdgcn_mfma_f32_16x16x32_bf16(a, pf[1][c], O[m][1], 0, 0, 0);
            }
        __syncthreads();
    }
#undef ATT_GLOAD
#undef ATT_LWRITE
#pragma unroll
    for (int nq = 0; nq < 2; ++nq) {
        float l = lrun[nq];
        l += __shfl_xor(l, 16);
        l += __shfl_xor(l, 32);
        const int qi = q0 + wid * 32 + nq * 16 + fr;
        if (seg < 0) {
            const float il = 1.f / l;
#pragma unroll
            for (int m = 0; m < 8; ++m) {
                u32x2 o;
                o.x = pack2(O[m][nq][0] * il, O[m][nq][1] * il);
                o.y = pack2(O[m][nq][2] * il, O[m][nq][3] * il);
                *(u32x2*)(p->outcat + (size_t)qi * 2048 + h * 128 + m * 16 + fq * 4) = o;
            }
        } else {
            const size_t slot = (size_t)((h * 16 + (qb - 16)) * 2 + seg);
            float* po = p->mla_po + (slot * 256 + (qi - q0)) * 128;
#pragma unroll
            for (int m = 0; m < 8; ++m) *(f32x4*)(po + m * 16 + fq * 4) = O[m][nq];
            if (fq == 0) { p->mla_ml[(slot * 256 + (qi - q0)) * 2] = mrun[nq]; p->mla_ml[(slot * 256 + (qi - q0)) * 2 + 1] = l; }
        }
    }
}

__device__ __forceinline__ void ph_mla_merge(KP p) {
    const int gtid = blockIdx.x * NT + ltid(), gsz = gridDim.x * NT;
    for (int i = gtid; i < 128 * 256 * 32; i += gsz) {
        const int d4 = i & 31, qq = (i >> 5) & 255, item = i >> 13;
        const int h = item >> 4, qb = 16 + (item & 15);
        const size_t s0 = (size_t)(item * 2) * 256 + qq, s1 = s0 + 256;
        const float m0 = p->mla_ml[s0 * 2], l0 = p->mla_ml[s0 * 2 + 1], m1 = p->mla_ml[s1 * 2], l1 = p->mla_ml[s1 * 2 + 1];
        const float m = fmaxf(m0, m1);
        const float w0 = __builtin_amdgcn_exp2f(m0 - m), w1 = __builtin_amdgcn_exp2f(m1 - m);
        const float il = 1.f / (l0 * w0 + l1 * w1);
        const f32x4 a = *(const f32x4*)(p->mla_po + s0 * 128 + d4 * 4), b = *(const f32x4*)(p->mla_po + s1 * 128 + d4 * 4);
        const f32x4 o = (a * w0 + b * w1) * il;
        *(u32x2*)(p->outcat + (size_t)(qb * 256 + qq) * 2048 + h * 128 + d4 * 4) = pack4(o);
    }
}

#define DSA_WLDS 5632
__device__ __forceinline__ void dsa_task(KP p, int q, int g, unsigned char* wl) {
    const int lane = ltid() & 63;
    u16* sQ = (u16*)wl;
    float* sP = (float*)(wl + 1024);
    u16* sS = (u16*)(wl + 1024 + 4096);
    const int nsel = q < 255 ? q + 1 : 256;
    {
        const u16* qsrc = p->qb + (size_t)q * 1024 + g * 512;
        *(u32x4*)(sQ + lane * 8) = *(const u32x4*)(qsrc + lane * 8);
        *(u32x2*)(sS + lane * 4) = *(const u32x2*)(p->sel + (size_t)q * 256 + lane * 4);
    }
    __builtin_amdgcn_s_waitcnt(0);
    float sc[4][4];
    float mx[4] = {-1e30f, -1e30f, -1e30f, -1e30f};
#pragma unroll
    for (int r = 0; r < 4; ++r) {
        const int slot = lane + 64 * r;
        float a0 = 0.f, a1 = 0.f, a2 = 0.f, a3 = 0.f;
        if (slot < nsel) {
            const int ki = sS[slot];
            const u16* kr = p->kb + (size_t)ki * 256 + g * 128;
#pragma unroll
            for (int c = 0; c < 16; ++c) {
                const u32x4 kv = *(const u32x4*)(kr + c * 8);
                const u32x4 q0v = *(const u32x4*)(sQ + 0 * 128 + c * 8);
                const u32x4 q1v = *(const u32x4*)(sQ + 1 * 128 + c * 8);
                const u32x4 q2v = *(const u32x4*)(sQ + 2 * 128 + c * 8);
                const u32x4 q3v = *(const u32x4*)(sQ + 3 * 128 + c * 8);
#pragma unroll
                for (int e = 0; e < 4; ++e) {
                    const unsigned kk = kv[e];
                    const bf16x2_t kb2 = *(const bf16x2_t*)&kk;
                    unsigned t0 = q0v[e], t1 = q1v[e], t2 = q2v[e], t3 = q3v[e];
                    a0 = __builtin_amdgcn_fdot2_f32_bf16(kb2, *(const bf16x2_t*)&t0, a0, false);
                    a1 = __builtin_amdgcn_fdot2_f32_bf16(kb2, *(const bf16x2_t*)&t1, a1, false);
                    a2 = __builtin_amdgcn_fdot2_f32_bf16(kb2, *(const bf16x2_t*)&t2, a2, false);
                    a3 = __builtin_amdgcn_fdot2_f32_bf16(kb2, *(const bf16x2_t*)&t3, a3, false);
                }
            }
        } else { a0 = a1 = a2 = a3 = -1e30f; }
        sc[r][0] = a0; sc[r][1] = a1; sc[r][2] = a2; sc[r][3] = a3;
        mx[0] = fmaxf(mx[0], a0); mx[1] = fmaxf(mx[1], a1); mx[2] = fmaxf(mx[2], a2); mx[3] = fmaxf(mx[3], a3);
    }
    float ls[4];
#pragma unroll
    for (int hh = 0; hh < 4; ++hh) {
        const float m = wave_max(mx[hh]);
        float s = 0.f;
#pragma unroll
        for (int r = 0; r < 4; ++r) { const float e = exp2f(sc[r][hh] - m); sc[r][hh] = e; s += e; }
        ls[hh] = wave_sum(s);
    }
#pragma unroll
    for (int r = 0; r < 4; ++r) {
        f32x4 pv = {sc[r][0], sc[r][1], sc[r][2], sc[r][3]};
        *(f32x4*)(sP + (lane + 64 * r) * 4) = pv;
    }
    __builtin_amdgcn_s_waitcnt(0);
    float o[4][8];
#pragma unroll
    for (int hh = 0; hh < 4; ++hh)
#pragma unroll
        for (int d = 0; d < 8; ++d) o[hh][d] = 0.f;
    const int kg = lane >> 4, dc = lane & 15;
    const u16* vbase = p->vb + g * 128 + dc * 8;
    const int nit = (nsel + 3) >> 2;
    for (int it = 0; it < nit; it += 4) {
        u32x4 vv[4]; f32x4 pp[4];
#pragma unroll
        for (int u = 0; u < 4; ++u) {
            if (it + u < nit) {
                const int slot = (it + u) * 4 + kg;
                const int ki = sS[slot];
                vv[u] = *(const u32x4*)(vbase + (size_t)ki * 256);
                pp[u] = *(const f32x4*)(sP + slot * 4);
            } else { vv[u] = (u32x4){0u, 0u, 0u, 0u}; pp[u] = (f32x4){0.f, 0.f, 0.f, 0.f}; }
        }
#pragma unroll
        for (int u = 0; u < 4; ++u)
#pragma unroll
            for (int e = 0; e < 4; ++e) {
                const float v0 = __uint_as_float(vv[u][e] << 16), v1 = __uint_as_float(vv[u][e] & 0xffff0000u);
#pragma unroll
                for (int hh = 0; hh < 4; ++hh) { o[hh][2 * e] += pp[u][hh] * v0; o[hh][2 * e + 1] += pp[u][hh] * v1; }
            }
    }
#pragma unroll
    for (int hh = 0; hh < 4; ++hh)
#pragma unroll
        for (int d = 0; d < 8; ++d) {
            float v = o[hh][d];
            v += __shfl_xor(v, 16);
            v += __shfl_xor(v, 32);
            o[hh][d] = v;
        }
    if (kg == 0) {
#pragma unroll
        for (int hh = 0; hh < 4; ++hh) {
            const float il = 1.f / ls[hh];
            u32x4 w;
            w.x = pack2(o[hh][0] * il, o[hh][1] * il); w.y = pack2(o[hh][2] * il, o[hh][3] * il);
            w.z = pack2(o[hh][4] * il, o[hh][5] * il); w.w = pack2(o[hh][6] * il, o[hh][7] * il);
            *(u32x4*)(p->outcat + (size_t)q * 2048 + 1024 + (g * 4 + hh) * 128 + dc * 8) = w;
        }
    }
    __builtin_amdgcn_s_waitcnt(0);
}

#define DSA2_WLDS (8192 + 512)
__device__ __forceinline__ void dsa_task2(KP p, int q, unsigned char* wl, u16* outp, int ldo, int coff) {
    const int lane = ltid() & 63, fr = lane & 15, fq = lane >> 4;
    unsigned char* sV = wl;
    u16* sS = (u16*)(wl + 8192);
    const int nsel = q < 255 ? q + 1 : 256;
    *(u32x2*)(sS + lane * 4) = *(const u32x2*)(p->sel + (size_t)q * 256 + lane * 4);
    const int vch = lane & 15, vr0 = lane >> 4;
    int rdo[2];
#pragma unroll
    for (int t = 0; t < 2; ++t) rdo[t] = (8 * fq + 4 * t + (fr >> 2)) * 256 + 8 * (fr & 1);
    const int xr0 = ((fr >> 2) << 2) | ((2 * fq) & 3), xr1 = ((fr >> 2) << 2) | ((2 * fq + 1) & 3);
    const int hsel = (fr & 3) >> 1;
    __builtin_amdgcn_s_waitcnt(0);
#pragma unroll 1
    for (int g = 0; g < 2; ++g) {
        bf16x8 qf[4];
#pragma unroll
        for (int c = 0; c < 4; ++c) {
            u32x4 v = (u32x4){0u, 0u, 0u, 0u};
            if (fr < 4) v = *(const u32x4*)(p->qb + (size_t)q * 1024 + (g * 4 + fr) * 128 + c * 32 + fq * 8);
            qf[c] = *(bf16x8*)&v;
        }
        f32x4 O[8];
#pragma unroll
        for (int cc = 0; cc < 8; ++cc) O[cc] = (f32x4){0.f, 0.f, 0.f, 0.f};
        float mrun = -1e30f, lrun = 0.f;
        const int nstep = (nsel + 31) >> 5;
        bf16x8 fa0[4], fb0[4], fa1[4], fb1[4];
        u32x4 vv0[8], vv1[8];
#define DSA_LOAD(c, FA, FB, VV) do { \
            const int ka_ = sS[32 * (c) + fr], kb_ = sS[32 * (c) + 16 + fr]; \
            const u16* kra = p->kb + (size_t)ka_ * 256 + g * 128 + fq * 8; \
            const u16* krb = p->kb + (size_t)kb_ * 256 + g * 128 + fq * 8; \
            _Pragma("unroll") for (int cc = 0; cc < 4; ++cc) { FA[cc] = *(const bf16x8*)(kra + cc * 32); FB[cc] = *(const bf16x8*)(krb + cc * 32); } \
            _Pragma("unroll") for (int i = 0; i < 8; ++i) { \
                const int r = vr0 + 4 * i; \
                const int kv = sS[32 * (c) + 16 * ((r >> 2) & 1) + 4 * (r >> 3) + (r & 3)]; \
                VV[i] = *(const u32x4*)(p->vb + (size_t)kv * 256 + g * 128 + vch * 8); } } while (0)
#define DSA_COMP(c, FA, FB, VV) do { \
            f32x4 s0 = (f32x4){0.f, 0.f, 0.f, 0.f}, s1 = (f32x4){0.f, 0.f, 0.f, 0.f}; \
            _Pragma("unroll") for (int cc = 0; cc < 4; ++cc) { \
                s0 = __builtin_amdgcn_mfma_f32_16x16x32_bf16(FA[cc], qf[cc], s0, 0, 0, 0); \
                s1 = __builtin_amdgcn_mfma_f32_16x16x32_bf16(FB[cc], qf[cc], s1, 0, 0, 0); } \
            float mx = -1e30f; \
            _Pragma("unroll") for (int j = 0; j < 4; ++j) { \
                if (32 * (c) + 4 * fq + j >= nsel) s0[j] = -1e30f; \
                if (32 * (c) + 16 + 4 * fq + j >= nsel) s1[j] = -1e30f; \
                mx = fmaxf(mx, fmaxf(s0[j], s1[j])); } \
            mx = fmaxf(mx, __shfl_xor(mx, 16)); \
            mx = fmaxf(mx, __shfl_xor(mx, 32)); \
            const float mnew = fmaxf(mrun, mx); \
            const float al = __builtin_amdgcn_exp2f(mrun - mnew); \
            mrun = mnew; \
            float ps = 0.f; \
            _Pragma("unroll") for (int j = 0; j < 4; ++j) { \
                s0[j] = __builtin_amdgcn_exp2f(s0[j] - mnew); s1[j] = __builtin_amdgcn_exp2f(s1[j] - mnew); \
                ps += s0[j] + s1[j]; } \
            lrun = lrun * al + ps; \
            if (__ballot(al != 1.0f) != 0ull) { _Pragma("unroll") for (int cc = 0; cc < 8; ++cc) O[cc] *= al; } \
            u32x4 pw; \
            pw.x = pack2(s0[0], s0[1]); pw.y = pack2(s0[2], s0[3]); pw.z = pack2(s1[0], s1[1]); pw.w = pack2(s1[2], s1[3]); \
            const bf16x8 pf = *(bf16x8*)&pw; \
            _Pragma("unroll") for (int i = 0; i < 8; ++i) { \
                const int r = vr0 + 4 * i; \
                *(u32x4*)(sV + r * 256 + 16 * (vch ^ (((r & 3) << 2) | ((r >> 2) & 3)))) = VV[i]; } \
            __builtin_amdgcn_s_waitcnt(0xc07f); \
            _Pragma("unroll") for (int cc = 0; cc < 8; ++cc) { \
                const s16x4 lo_ = __builtin_amdgcn_ds_read_tr16_b64_v4i16((LAS s16x4*)(sV + rdo[0] + 16 * ((2 * cc + hsel) ^ xr0))); \
                const s16x4 hi_ = __builtin_amdgcn_ds_read_tr16_b64_v4i16((LAS s16x4*)(sV + rdo[1] + 16 * ((2 * cc + hsel) ^ xr1))); \
                const bf16x8 vf = __builtin_shufflevector(lo_, hi_, 0, 1, 2, 3, 4, 5, 6, 7); \
                O[cc] = __builtin_amdgcn_mfma_f32_16x16x32_bf16(vf, pf, O[cc], 0, 0, 0); } \
            __builtin_amdgcn_s_waitcnt(0xc07f); } while (0)
        DSA_LOAD(0, fa0, fb0, vv0);
#pragma unroll 1
        for (int c = 0; c < nstep; c += 2) {
            const int c1 = c + 1 < nstep ? c + 1 : nstep - 1, c2 = c + 2 < nstep ? c + 2 : nstep - 1;
            DSA_LOAD(c1, fa1, fb1, vv1);
            DSA_COMP(c, fa0, fb0, vv0);
            DSA_LOAD(c2, fa0, fb0, vv0);
            if (c + 1 < nstep) DSA_COMP(c + 1, fa1, fb1, vv1);
        }
#undef DSA_LOAD
#undef DSA_COMP
        float l = lrun;
        l += __shfl_xor(l, 16);
        l += __shfl_xor(l, 32);
        if (fr < 4) {
            const float il = 1.f / l;
            u16* dst = outp + (size_t)q * ldo + coff + (g * 4 + fr) * 128 + 4 * fq;
#pragma unroll
            for (int cc = 0; cc < 8; ++cc) {
                u32x2 w; w.x = pack2(O[cc][0] * il, O[cc][1] * il); w.y = pack2(O[cc][2] * il, O[cc][3] * il);
                *(u32x2*)(dst + 16 * cc) = w;
            }
        }
    }
    __builtin_amdgcn_s_waitcnt(0);
}

#define ATT_NMLA 384
#define CVT_CHUNK (256 * 1024)
#define CVT_N_OUT0 16
#define CVT_N_IN1 96
#define CVT_N_OUT1 32
#define CVT_N_SH 8
#define ATT_NCVT (CVT_N_OUT0 + CVT_N_IN1 + CVT_N_OUT1 + 6 * CVT_N_SH)
template <int RMAP = 0>
__device__ __forceinline__ void cvtT_block(const float* src, u16* dst, int K, int N, int kb, int nb, unsigned char* smem) {
    const int tid = ltid();
    u16* t = (u16*)smem;
    __syncthreads();
#pragma unroll
    for (int i = 0; i < 8; ++i) {
        const int k = (tid >> 6) + 8 * i, n4 = (tid & 63) * 4;
        f32x4 v = (f32x4){0.f, 0.f, 0.f, 0.f};
        if (nb * 256 + n4 < N) v = *(const f32x4*)(src + (size_t)(kb * 64 + k) * N + nb * 256 + n4);
#pragma unroll
        for (int e = 0; e < 4; ++e) t[(n4 + e) * 72 + k] = f2bf(v[e]);
    }
    __syncthreads();
#pragma unroll
    for (int i = 0; i < 4; ++i) {
        const int n = (tid >> 3) + 64 * i, ch = tid & 7;
        const int drow = RMAP == 0 ? nb * 256 + n : 512 * nb + (n >> 7) * 256 + 128 * (RMAP - 1) + (n & 127);
        *(u32x4*)(dst + (size_t)drow * K + kb * 64 + ch * 8) = *(const u32x4*)(t + n * 72 + ch * 8);
    }
}
#define CVT_NT_OUT1 (64 * 8)
#define CVT_NT_OUT0 (32 * 8)
#define CVT_NT_IN1 (32 * 48)
#define CVT_NT_SHGU (32 * 4)
#define CVT_NT_SHD (16 * 8)
#define CVT_NT_SH (2 * CVT_NT_SHGU + CVT_NT_SHD)
__device__ __forceinline__ void cvt_item(KP p, int c, unsigned char* smem) {
    if (c >= ATT_NCVT) {
        int u = c - ATT_NCVT;
        if (u < CVT_NT_OUT1) { cvtT_block(p->w_out1, p->w_out1t, 4096, 2048, u >> 3, u & 7, smem); return; }
        u -= CVT_NT_OUT1;
        if (u < CVT_NT_OUT0) { cvtT_block(p->w_out0, p->w_out0t, 2048, 2048, u >> 3, u & 7, smem); return; }
        u -= CVT_NT_OUT0;
        if (u < CVT_NT_IN1) { cvtT_block(p->w_in1, p->w_in1t, 2048, IN_C, u / 48, u % 48, smem); return; }
        u -= CVT_NT_IN1;
        const int l = u / CVT_NT_SH; u -= l * CVT_NT_SH;
        if (u < CVT_NT_SHGU) { cvtT_block<1>(p->sh_g[l], p->sh_gut[l], 2048, 1024, u >> 2, u & 3, smem); return; }
        u -= CVT_NT_SHGU;
        if (u < CVT_NT_SHGU) { cvtT_block<2>(p->sh_u[l], p->sh_gut[l], 2048, 1024, u >> 2, u & 3, smem); return; }
        u -= CVT_NT_SHGU;
        cvtT_block(p->sh_d[l], p->sh_dt[l], 1024, 2048, u >> 3, u & 7, smem); return;
    }
    const float* src; u16* dst;
    if (c < CVT_N_OUT0) { return; }
    else if ((c -= CVT_N_OUT0) < CVT_N_IN1) { return; }
    else if ((c -= CVT_N_IN1) < CVT_N_OUT1) { return; }
    else {
        return;
        c -= CVT_N_OUT1;
        const int which = c / CVT_N_SH; c -= which * CVT_N_SH;
        const int l = which / 3, m = which % 3;
        src = m == 0 ? p->sh_g[l] : (m == 1 ? p->sh_u[l] : p->sh_d[l]);
        dst = m == 0 ? p->sh_gb[l] : (m == 1 ? p->sh_ub[l] : p->sh_db[l]);
    }
    const size_t base = (size_t)c * CVT_CHUNK;
    for (int i = ltid(); i < CVT_CHUNK / 8; i += NT) {
        const f32x4 a = *(const f32x4*)(src + base + (size_t)i * 8), b = *(const f32x4*)(src + base + (size_t)i * 8 + 4);
        u32x4 o; o.x = pack2(a[0], a[1]); o.y = pack2(a[2], a[3]); o.z = pack2(b[0], b[1]); o.w = pack2(b[2], b[3]);
        *(u32x4*)(dst + base + (size_t)i * 8) = o;
    }
}
__device__ const unsigned char mla_order[48] = {31, 63, 79, 30, 62, 29, 61, 78, 28, 60, 27, 59, 77, 26, 58, 25, 57, 76, 24, 56, 23, 55, 75, 22, 54, 21, 53, 74, 20, 52, 19, 51, 73, 18, 50, 17, 49, 72, 16, 48, 71, 70, 69, 68, 67, 66, 65, 64};
#define ATT_NTOTAL (ATT_NMLA + 512 + ATT_NCVT + CVT_NT_OUT1 + CVT_NT_OUT0 + CVT_NT_IN1 + 2 * CVT_NT_SH)
__device__ __forceinline__ void ph_attn(KP p, unsigned char* smem, unsigned* misc, int qword = CTL_QUEUE, int lo = 0, int hi = ATT_NTOTAL) {
    const int tid = ltid(), wid = tid >> 6;
    for (;;) {
        __syncthreads();
        if (tid == 0) misc[0] = atomicAdd(&p->ctl[qword], 1u);
        __syncthreads();
        const int it = (int)misc[0] + lo;
        if (it >= hi) break;
        if (it < ATT_NMLA) {
            const int e = mla_order[it >> 3];
            const int sg = e >> 5;
            mla_item(p, it & 7, e & 31, (u16*)smem, sg == 2 ? -1 : sg);
        } else if (it >= ATT_NMLA + 512) {
            cvt_item(p, it - ATT_NMLA - 512, smem);
        } else {
            const int base = (it - ATT_NMLA) * 16;
#ifdef DSA_VALU
            for (int k = 0; k < 4; ++k) {
                const int task = wid * 4 + k;
                dsa_task(p, base + (task >> 1), task & 1, smem + wid * DSA_WLDS);
            }
#else
            for (int k = 0; k < 2; ++k) dsa_task2(p, base + wid * 2 + k, smem + wid * DSA2_WLDS, p->outcat, 2048, 1024);
#endif
        }
    }
}
__device__ __forceinline__ float ret_log2g(int h);

struct PgEpiResid {
    static constexpr bool PERM = true, AFTER_DRAIN = false;
    u16* C; const u16* X; int ldc;
    __device__ __forceinline__ void operator()(const pg8::f32x4 (&acc)[2][2][4][2], const pg8::Unit& u, int wr, int wc, int fr, int fq) const {
        const int row0 = u.pm * 256 + wr * 64 + fr, col0 = u.pn * 256 + wc * 32 + 8 * fq;
#pragma unroll
        for (int ai = 0; ai < 2; ++ai) {
            u32x4 xv[4][2];
#pragma unroll
            for (int m = 0; m < 4; ++m)
#pragma unroll
                for (int bj = 0; bj < 2; ++bj) xv[m][bj] = *(const u32x4*)(X + (size_t)(row0 + ai * 128 + m * 16) * ldc + col0 + bj * 128);
#pragma unroll
            for (int m = 0; m < 4; ++m)
#pragma unroll
                for (int bj = 0; bj < 2; ++bj) {
                    const pg8::f32x4 v0 = acc[ai][bj][m][0], v1 = acc[ai][bj][m][1];
                    const u32x4 x = xv[m][bj];
                    u32x4 w;
                    w.x = pack2(__uint_as_float(x.x << 16) * ALPHA_ + v0[0], __uint_as_float(x.x & 0xffff0000u) * ALPHA_ + v0[1]);
                    w.y = pack2(__uint_as_float(x.y << 16) * ALPHA_ + v0[2], __uint_as_float(x.y & 0xffff0000u) * ALPHA_ + v0[3]);
                    w.z = pack2(__uint_as_float(x.z << 16) * ALPHA_ + v1[0], __uint_as_float(x.z & 0xffff0000u) * ALPHA_ + v1[1]);
                    w.w = pack2(__uint_as_float(x.w << 16) * ALPHA_ + v1[2], __uint_as_float(x.w & 0xffff0000u) * ALPHA_ + v1[3]);
                    *(u32x4*)(C + (size_t)(row0 + ai * 128 + m * 16) * ldc + col0 + bj * 128) = w;
                }
        }
    }
};

struct PgEpiResidF {
    static constexpr bool PERM = true, AFTER_DRAIN = false;
    u16* C; const float* X; int ldc;
    __device__ __forceinline__ void operator()(const pg8::f32x4 (&acc)[2][2][4][2], const pg8::Unit& u, int wr, int wc, int fr, int fq) const {
        const int row0 = u.pm * 256 + wr * 64 + fr, col0 = u.pn * 256 + wc * 32 + 8 * fq;
#pragma unroll
        for (int ai = 0; ai < 2; ++ai)
#pragma unroll
            for (int m = 0; m < 4; ++m) {
                f32x4 xv[2][2];
#pragma unroll
                for (int bj = 0; bj < 2; ++bj) {
                    const float* xp = X + (size_t)(row0 + ai * 128 + m * 16) * ldc + col0 + bj * 128;
                    xv[bj][0] = *(const f32x4*)xp; xv[bj][1] = *(const f32x4*)(xp + 4);
                }
#pragma unroll
                for (int bj = 0; bj < 2; ++bj) {
                    const f32x4 a = xv[bj][0] * ALPHA_ + acc[ai][bj][m][0], b = xv[bj][1] * ALPHA_ + acc[ai][bj][m][1];
                    u32x4 w; w.x = pack2(a[0], a[1]); w.y = pack2(a[2], a[3]); w.z = pack2(b[0], b[1]); w.w = pack2(b[2], b[3]);
                    *(u32x4*)(C + (size_t)(row0 + ai * 128 + m * 16) * ldc + col0 + bj * 128) = w;
                }
                asm volatile("" ::: "memory");
            }
    }
};
#define RET_CH 512
#define RET_NCH (T_ / RET_CH)
struct PgEpiL1 {
    static constexpr bool PERM = true, AFTER_DRAIN = false;
    KP p;
    __device__ __forceinline__ void operator()(const pg8::f32x4 (&acc)[2][2][4][2], const pg8::Unit& u, int wr, int wc, int fr, int fq) const {
        const int row0 = u.pm * 256 + wr * 64 + fr, ci = wc * 32 + 8 * fq;
        const int pn = u.pn;
        if (pn < 16) {
            const bool isk = pn >= 8; const int hd = pn & 7;
            const float l2g = ret_log2g(hd);
            const float* cR = p->cosR; const float* sR = p->sinR;
#pragma unroll
            for (int ai = 0; ai < 2; ++ai)
#pragma unroll
                for (int m = 0; m < 4; ++m) {
                    const int t = row0 + ai * 128 + m * 16;
                    const float dec = isk ? exp2f((float)(RET_CH - 1 - (t & (RET_CH - 1))) * l2g) : exp2f((float)((t & (RET_CH - 1)) + 1) * l2g);
                    f32x4 lo[2], hi[2];
#pragma unroll
                    for (int n = 0; n < 2; ++n) {
                        const f32x4 c = *(const f32x4*)(cR + t * 128 + ci + 4 * n), s = *(const f32x4*)(sR + t * 128 + ci + 4 * n);
                        const f32x4 x1 = acc[ai][0][m][n], x2 = acc[ai][1][m][n];
                        lo[n] = x1 * c - x2 * s; hi[n] = x1 * s + x2 * c;
                        if (isk) { lo[n] *= 0.0625f; hi[n] *= 0.0625f; }
                    }
                    const size_t o = (size_t)t * 2048 + hd * 256 + ci;
                    u16* d0 = isk ? p->kr : p->qr; u16* d1 = isk ? p->kz : p->qx;
                    u32x4 w;
                    w.x = pack2(lo[0][0], lo[0][1]); w.y = pack2(lo[0][2], lo[0][3]); w.z = pack2(lo[1][0], lo[1][1]); w.w = pack2(lo[1][2], lo[1][3]);
                    *(u32x4*)(d0 + o) = w;
                    w.x = pack2(hi[0][0], hi[0][1]); w.y = pack2(hi[0][2], hi[0][3]); w.z = pack2(hi[1][0], hi[1][1]); w.w = pack2(hi[1][2], hi[1][3]);
                    *(u32x4*)(d0 + o + 128) = w;
                    lo[0] *= dec; lo[1] *= dec; hi[0] *= dec; hi[1] *= dec;
                    w.x = pack2(lo[0][0], lo[0][1]); w.y = pack2(lo[0][2], lo[0][3]); w.z = pack2(lo[1][0], lo[1][1]); w.w = pack2(lo[1][2], lo[1][3]);
                    *(u32x4*)(d1 + o) = w;
                    w.x = pack2(hi[0][0], hi[0][1]); w.y = pack2(hi[0][2], hi[0][3]); w.z = pack2(hi[1][0], hi[1][1]); w.w = pack2(hi[1][2], hi[1][3]);
                    *(u32x4*)(d1 + o + 128) = w;
                    asm volatile("" ::: "memory");
                }
        } else {
            const bool isg = pn >= 32;
            u16* dst = isg ? p->sg : p->v1;
            const int cbase = (isg ? pn - 32 : pn - 16) * 256 + ci;
#pragma unroll
            for (int ai = 0; ai < 2; ++ai)
#pragma unroll
                for (int m = 0; m < 4; ++m)
#pragma unroll
                    for (int bj = 0; bj < 2; ++bj) {
                        f32x4 a = acc[ai][bj][m][0], b = acc[ai][bj][m][1];
                        if (isg) {
#pragma unroll
                            for (int e = 0; e < 4; ++e) { a[e] = silu_f(a[e]); b[e] = silu_f(b[e]); }
                        }
                        u32x4 w; w.x = pack2(a[0], a[1]); w.y = pack2(a[2], a[3]); w.z = pack2(b[0], b[1]); w.w = pack2(b[2], b[3]);
                        *(u32x4*)(dst + (size_t)(row0 + ai * 128 + m * 16) * 4096 + cbase + bj * 128) = w;
                    }
        }
    }
};

struct PgEpiBf16N {
    static constexpr bool PERM = true, AFTER_DRAIN = false;
    u16* C; int ldc; int ncols;
    __device__ __forceinline__ void operator()(const pg8::f32x4 (&acc)[2][2][4][2], const pg8::Unit& u, int wr, int wc, int fr, int fq) const {
        const int row0 = u.pm * 256 + wr * 64 + fr, col0 = u.pn * 256 + wc * 32 + 8 * fq;
#pragma unroll
        for (int ai = 0; ai < 2; ++ai)
#pragma unroll
            for (int m = 0; m < 4; ++m)
#pragma unroll
                for (int bj = 0; bj < 2; ++bj) {
                    const int c = col0 + bj * 128;
                    if (c < ncols) {
                        const pg8::f32x4 a = acc[ai][bj][m][0], b = acc[ai][bj][m][1];
                        u32x4 w; w.x = pack2(a[0], a[1]); w.y = pack2(a[2], a[3]); w.z = pack2(b[0], b[1]); w.w = pack2(b[2], b[3]);
                        *(u32x4*)(C + (size_t)(row0 + ai * 128 + m * 16) * ldc + c) = w;
                    }
                }
    }
};
struct PgEpiSwiglu {
    static constexpr bool PERM = true, AFTER_DRAIN = false;
    u16* C; int ldc;
    __device__ __forceinline__ void operator()(const pg8::f32x4 (&acc)[2][2][4][2], const pg8::Unit& u, int wr, int wc, int fr, int fq) const {
        const int row0 = u.pm * 256 + wr * 64 + fr, col0 = u.pn * 128 + wc * 32 + 8 * fq;
#pragma unroll
        for (int ai = 0; ai < 2; ++ai)
#pragma unroll
            for (int m = 0; m < 4; ++m) {
                const pg8::f32x4 g0 = acc[ai][0][m][0], g1 = acc[ai][0][m][1], u0 = acc[ai][1][m][0], u1 = acc[ai][1][m][1];
                float o[8];
#pragma unroll
                for (int e = 0; e < 4; ++e) { o[e] = silu_f(g0[e]) * u0[e]; o[4 + e] = silu_f(g1[e]) * u1[e]; }
                u32x4 w; w.x = pack2(o[0], o[1]); w.y = pack2(o[2], o[3]); w.z = pack2(o[4], o[5]); w.w = pack2(o[6], o[7]);
                *(u32x4*)(C + (size_t)(row0 + ai * 128 + m * 16) * ldc + col0) = w;
            }
    }
};
template <bool ADD_ROUTED, bool ROUTE, bool WRITE_B, bool WRITE_F, bool BLK = false>
__device__ __forceinline__ void ph_ln(KP p, const u16* Y, const float* g, const float* b, float* XF, u16* XB, u16* XL, int tb = 0) {
    const int lane = ltid() & 63;
    const int gw = BLK ? tb + (ltid() >> 6) : (blockIdx.x * NT + ltid()) >> 6, nw = BLK ? 8 : (gridDim.x * NT) >> 6;
    const int T_end = BLK ? tb + 32 : T_;
    f32x4 gg[8], bb[8];
#pragma unroll
    for (int j = 0; j < 8; ++j) { gg[j] = *(const f32x4*)(g + j * 256 + lane * 4); bb[j] = *(const f32x4*)(b + j * 256 + lane * 4); }
    for (int t0 = gw; t0 < T_end; t0 += 2 * nw) {
        u32x2 raw[2][8], r0raw[2][8], r1raw[2][8];
#pragma unroll
        for (int rr = 0; rr < 2; ++rr) {
            const int t = t0 + rr * nw < T_end ? t0 + rr * nw : t0;
            const u16* y = Y + (size_t)t * D_;
#pragma unroll
            for (int j = 0; j < 8; ++j) raw[rr][j] = *(const u32x2*)(y + j * 256 + lane * 4);
            if constexpr (ADD_ROUTED) {
                const u16* r0 = p->yr + (size_t)(2 * t) * D_;
                const u16* r1 = r0 + D_;
#pragma unroll
                for (int j = 0; j < 8; ++j) { r0raw[rr][j] = *(const u32x2*)(r0 + j * 256 + lane * 4); r1raw[rr][j] = *(const u32x2*)(r1 + j * 256 + lane * 4); }
            }
        }
#pragma unroll
        for (int rr = 0; rr < 2; ++rr) {
            const int t = t0 + rr * nw;
            if (t >= T_end) break;
            float v[32];
            float sum = 0.f;
#pragma unroll
            for (int j = 0; j < 8; ++j) {
                const u32x2 a = raw[rr][j];
                v[4 * j] = __uint_as_float(a.x << 16); v[4 * j + 1] = __uint_as_float(a.x & 0xffff0000u);
                v[4 * j + 2] = __uint_as_float(a.y << 16); v[4 * j + 3] = __uint_as_float(a.y & 0xffff0000u);
            }
            if constexpr (ADD_ROUTED) {
#pragma unroll
                for (int j = 0; j < 8; ++j) {
                    const u32x2 a = r0raw[rr][j], c = r1raw[rr][j];
                    v[4 * j]     += __uint_as_float(a.x << 16) + __uint_as_float(c.x << 16);
                    v[4 * j + 1] += __uint_as_float(a.x & 0xffff0000u) + __uint_as_float(c.x & 0xffff0000u);
                    v[4 * j + 2] += __uint_as_float(a.y << 16) + __uint_as_float(c.y << 16);
                    v[4 * j + 3] += __uint_as_float(a.y & 0xffff0000u) + __uint_as_float(c.y & 0xffff0000u);
                }
            }
#pragma unroll
            for (int i = 0; i < 32; ++i) sum += v[i];
            const float mu = wave_sum(sum) * (1.f / 2048.f);
            float var = 0.f;
#pragma unroll
            for (int i = 0; i < 32; ++i) { const float d = v[i] - mu; var += d * d; }
            var = wave_sum(var) * (1.f / 2048.f);
            const float rs = rsqrtf(var + 1e-5f);
#pragma unroll
            for (int j = 0; j < 8; ++j) {
                const int c = j * 256 + lane * 4;
                f32x4 o;
#pragma unroll
                for (int e = 0; e < 4; ++e) o[e] = (v[4 * j + e] - mu) * rs * gg[j][e] + bb[j][e];
                if constexpr (WRITE_F) *(f32x4*)(XF + (size_t)t * D_ + c) = o;
                if constexpr (WRITE_B) {
                    u32x2 w; w.x = pack2(o[0], o[1]); w.y = pack2(o[2], o[3]);
                    *(u32x2*)(XB + (size_t)t * D_ + c) = w;
                    if constexpr (ROUTE) {
                        u32x2 wl;
                        wl.x = pack2(o[0] - __uint_as_float(w.x << 16), o[1] - __uint_as_float(w.x & 0xffff0000u));
                        wl.y = pack2(o[2] - __uint_as_float(w.y << 16), o[3] - __uint_as_float(w.y & 0xffff0000u));
                        *(u32x2*)(XL + (size_t)t * D_ + c) = wl;
                    }
                }
            }
        }
    }
}

__device__ __forceinline__ void route_token(KP p, int t, float logit, int lane, unsigned* cnt, int* list) {
    const float sc = 1.f / (1.f + __expf(-logit));
    const float bi = sc + p->router_b[lane];
    float m1 = bi;
    m1 = fmaxf(m1, __shfl_xor(m1, 1)); m1 = fmaxf(m1, __shfl_xor(m1, 2)); m1 = fmaxf(m1, __shfl_xor(m1, 4));
    const int seg = lane >> 3;
    unsigned long long bal = __ballot(bi == m1);
    const int f1 = __builtin_ctz((unsigned)((bal >> (seg * 8)) & 0xffull));
    const float b2 = ((lane & 7) == f1) ? -1e30f : bi;
    float m2 = b2;
    m2 = fmaxf(m2, __shfl_xor(m2, 1)); m2 = fmaxf(m2, __shfl_xor(m2, 2)); m2 = fmaxf(m2, __shfl_xor(m2, 4));
    bal = __ballot(b2 == m2);
    const int f2 = __builtin_ctz((unsigned)((bal >> (seg * 8)) & 0xffull));
    const float gs = m1 + m2;
    float gm = gs;
    gm = fmaxf(gm, __shfl_xor(gm, 8)); gm = fmaxf(gm, __shfl_xor(gm, 16)); gm = fmaxf(gm, __shfl_xor(gm, 32));
    bal = __ballot(gs == gm);
    const int gsel = (int)(__builtin_ctzll(bal) >> 3);
    const int e0 = gsel * 8 + __shfl(f1, gsel * 8);
    const int e1 = gsel * 8 + __shfl(f2, gsel * 8);
    const float s0 = __shfl(sc, e0), s1 = __shfl(sc, e1);
    if (lane == 0) {
        const float inv = 1.f / (s0 + s1);
        const unsigned p0 = atomicAdd(&cnt[e0 * CNT_STRIDE], 1u);
        const unsigned p1 = atomicAdd(&cnt[e1 * CNT_STRIDE], 1u);
        list[e0 * T_ + p0] = 2 * t;
        list[e1 * T_ + p1] = 2 * t + 1;
        p->tok_g[2 * t] = s0 * inv;
        p->tok_g[2 * t + 1] = s1 * inv;
    }
}

__device__ __forceinline__ void router_block(KP p, unsigned char* smem, unsigned* cnt, int* list, int blk) {
    const int tid = ltid(), lane = tid & 63, wid = tid >> 6, grp = wid >> 2, kq = wid & 3, fr = lane & 15, fq = lane >> 4;
    float* part = (float*)smem;
    {
        const int t0 = blk * 32 + grp * 16;
        f32x4 acc[4];
#pragma unroll
        for (int c = 0; c < 4; ++c) acc[c] = (f32x4){0.f, 0.f, 0.f, 0.f};
        const u16* ah = p->xab + (size_t)(t0 + fr) * D_ + kq * 512 + fq * 8;
        const u16* al = p->xlb + (size_t)(t0 + fr) * D_ + kq * 512 + fq * 8;
        const u16* bh = p->whT + (size_t)fr * D_ + kq * 512 + fq * 8;
        const u16* bl = p->wlT + (size_t)fr * D_ + kq * 512 + fq * 8;
#pragma unroll 8
        for (int s = 0; s < 16; ++s) {
            const bf16x8 xh = *(const bf16x8*)(ah + 32 * s), xl = *(const bf16x8*)(al + 32 * s);
#pragma unroll
            for (int c = 0; c < 4; ++c) {
                const bf16x8 wh = *(const bf16x8*)(bh + (size_t)c * 16 * D_ + 32 * s);
                const bf16x8 wl = *(const bf16x8*)(bl + (size_t)c * 16 * D_ + 32 * s);
                acc[c] = __builtin_amdgcn_mfma_f32_16x16x32_bf16(xh, wh, acc[c], 0, 0, 0);
                acc[c] = __builtin_amdgcn_mfma_f32_16x16x32_bf16(xh, wl, acc[c], 0, 0, 0);
                acc[c] = __builtin_amdgcn_mfma_f32_16x16x32_bf16(xl, wh, acc[c], 0, 0, 0);
            }
        }
        float* mine = part + (grp * 4 + kq) * 1024;
#pragma unroll
        for (int c = 0; c < 4; ++c)
#pragma unroll
            for (int j = 0; j < 4; ++j) mine[(4 * fq + j) * 64 + 16 * c + fr] = acc[c][j];
        __syncthreads();
#pragma unroll
        for (int tt = 0; tt < 4; ++tt) {
            const int tok = 4 * kq + tt;
            const float* q = part + (grp * 4) * 1024 + tok * 64 + lane;
            const float logit = (q[0] + q[1024]) + (q[2048] + q[3072]);
            route_token(p, t0 + tok, logit, lane, cnt, list);
        }
        __syncthreads();
    }
}
__device__ __forceinline__ void ph_ln_router(KP p, const u16* Y, const float* g, const float* b, u16* XB, u16* XL, unsigned char* smem, unsigned* cnt, int* list) {
    for (int blk = blockIdx.x; blk < T_ / 32; blk += gridDim.x) {
        ph_ln<false, true, true, false, true>(p, Y, g, b, nullptr, XB, XL, blk * 32);
        asm volatile("s_waitcnt vmcnt(0)" ::: "memory");
        __syncthreads();
        router_block(p, smem, cnt, list, blk);
    }
}

struct ColGateUp16 { int c0; const u16* up;
    __device__ __forceinline__ const u16* base16(const u16* B, int hsel) const { return hsel ? up : B; }
    __device__ __forceinline__ unsigned off8(int hsel, int ch8) const { return (unsigned)(c0 + ch8 * 8); }
    __device__ __forceinline__ int vchunk(int hsel, int ch8) const { const int r = ch8 * 8; return ((r >> 5) * 64 + hsel * 32 + (r & 31)) >> 3; } };
struct ColGateUp { int c0; const float* up;
    __device__ __forceinline__ const float* base(const float* B, int hsel) const { return hsel ? up : B; }
    __device__ __forceinline__ unsigned off4(int hsel, int g4) const { return (unsigned)(c0 + g4 * 4); }
    __device__ __forceinline__ int vcol4(int hsel, int g4) const { const int r = g4 * 4; return (r >> 5) * 64 + hsel * 32 + (r & 31); } };
struct RowList { const int* lst; int m0, n; __device__ __forceinline__ int operator()(int r) const { const int i = m0 + r; return lst[i < n ? i : n - 1] >> 1; } };
struct EpiSwiglu {
    u16* C; int ldc; int row0, c0, nrows;
    __device__ __forceinline__ void operator()(Acc& acc, unsigned char* stg) const {
        const int wr0 = WR0_, cb = c0 + (WC0_ >> 1);
        u16* Cp = C; const int ld = ldc, rbase = row0, nr = nrows;
        stage_pairs(acc, stg, [=](int r, int c4, f32x4 g, f32x4 u) {
            const int rr = wr0 + r;
            if (rr < nr) {
                f32x4 o;
#pragma unroll
                for (int e = 0; e < 4; ++e) o[e] = silu_f(g[e]) * u[e];
                *(u32x2*)(Cp + (size_t)(rbase + rr) * ld + cb + c4) = pack4(o);
            }
        });
    }
};
struct SlotGate { int slot; float g; };
struct EpiDownRouted {
    u16* yr; const int* lst; const float* tg; int m0, n, col0;
    __device__ __forceinline__ void operator()(Acc& acc, unsigned char* stg) const {
        const int wr0 = WR0_, cb = col0 + WC0_;
        u16* yp = yr; const int* lp = lst; const float* tgp = tg; const int mm0 = m0, nn = n;
        stage_rows_pre<SlotGate>(acc, stg,
            [=](int r, int c4) -> SlotGate {
                const int i = mm0 + wr0 + r;
                const int s_ = lp[i < nn ? i : nn - 1];
                SlotGate sg; sg.g = tgp[s_]; sg.slot = i < nn ? s_ : -1;
                return sg; },
            [=](int r, int c4, f32x4 v, SlotGate sg) {
                if (sg.slot >= 0) *(u32x2*)(yp + (size_t)sg.slot * D_ + cb + c4) = pack4(v * sg.g); });
    }
};

struct RowH { int base, mx; __device__ __forceinline__ int operator()(int r) const { const int i = base + r; return i < mx ? i : mx; } };
__device__ __forceinline__ void moe_prefix(const unsigned* cnt, int* s_tp, int* s_off) {
    __syncthreads();
    if (ltid() == 0) {
        int tp = 0, off = 0;
        for (int e = 0; e < 64; ++e) {
            const int n = (int)__hip_atomic_load(&cnt[e * CNT_STRIDE], __ATOMIC_RELAXED, __HIP_MEMORY_SCOPE_AGENT);
            s_tp[e] = tp; s_off[e] = off;
            tp += (n + 255) >> 8; off += n;
        }
        s_tp[64] = tp; s_off[64] = off;
    }
    __syncthreads();
}

struct RowGen { const int* lst; int m0, n, base; __device__ __forceinline__ int operator()(int r) const {
    const int i = m0 + r; return lst[i < n ? i : n - 1] >> 1; } };

#define MOE_GROUP() ((int)((blockIdx.x * 4u) / gridDim.x))
template <int L>
__device__ __forceinline__ void moe_up_routed(KP p, const u16* X, unsigned char* smem, int* s_tp, int* s_off, int j0, int j1) {
    u16* lds = (u16*)smem;
    const int nrt = s_tp[64] * 8;
    for (int j = j0; j < j1; ++j) {
        const int t = (int)blockIdx.x + j * (int)gridDim.x;
        if (t >= nrt) break;
        Acc acc; acc_zero(acc);
        const int mtile = t >> 3, nt = t & 7;
        int e = 0;
        for (int s = 32; s > 0; s >>= 1) if (e + s < 64 && s_tp[e + s] <= mtile) e += s;
        const int n = s_off[e + 1] - s_off[e], m0 = (mtile - s_tp[e]) * 256;
        gemm_accum<B_F32_KN, false>(acc, X, D_, RowGen{p->list + e * T_, m0, n, 0}, p->moe_wg[L] + (size_t)e * D_ * 512, 512,
                                    ColGateUp{nt * 64, p->moe_wu[L] + (size_t)e * D_ * 512}, D_, lds);
        EpiSwiglu{p->hbuf, 512, s_off[e] + m0, nt * 64, n - m0}(acc, smem);
    }
}
template <int L>
__device__ __forceinline__ void ph_moe_up(KP p, const u16* X, unsigned char* smem, int* s_tp, int* s_off) {
    const unsigned* cnt = p->ctl + (L == 0 ? CTL_CNT0 : CTL_CNT1);
    moe_prefix(cnt, s_tp, s_off);
    moe_up_routed<L>(p, X, smem, s_tp, s_off, 0, MOE_GROUP());
    {
        __syncthreads();
        pg8::Gemm g; g.A = X; g.Bt = p->sh_gut[L]; g.M = T_; g.N = 2048; g.K = D_;
        pg8::StaticOrder S; S.init(T_, 2048, (int)gridDim.x, (int)blockIdx.x);
        pg8::gemm_phase<PgEpiSwiglu, pg8::StaticOrder>((PG8_LAS unsigned char*)smem, g, S, PgEpiSwiglu{p->hsh, 1024}, nullptr);
        __syncthreads();
    }
    { KP p2 = getp(); moe_up_routed<L>(p2, p2->xab, smem, s_tp, s_off, MOE_GROUP(), 1 << 20); }
}

template <int L>
__device__ __forceinline__ void moe_down_routed(KP p, unsigned char* smem, int* s_tp, int* s_off, int j0, int j1) {
    u16* lds = (u16*)smem;
    const int nrt = s_tp[64] * 16;
    for (int j = j0; j < j1; ++j) {
        const int t = (int)blockIdx.x + j * (int)gridDim.x;
        if (t >= nrt) break;
        Acc acc; acc_zero(acc);
        const int mtile = t >> 4, nt = t & 15;
        int e = 0;
        for (int s = 32; s > 0; s >>= 1) if (e + s < 64 && s_tp[e + s] <= mtile) e += s;
        const int n = s_off[e + 1] - s_off[e], m0 = (mtile - s_tp[e]) * 256;
        gemm_accum<B_F32_KN, false>(acc, p->hbuf, 512, RowH{s_off[e] + m0, 2 * T_ - 1}, p->moe_wd[L] + (size_t)e * 512 * D_, D_, ColOff{nt * 128}, 512, lds);
        EpiDownRouted{p->yr, p->list + e * T_, p->tok_g, m0, n, nt * 128}(acc, smem);
    }
}
template <int L>
__device__ __forceinline__ void ph_moe_down(KP p, const u16* XBres, unsigned char* smem, int* s_tp, int* s_off) {
    const unsigned* cnt = p->ctl + (L == 0 ? CTL_CNT0 : CTL_CNT1);
    moe_prefix(cnt, s_tp, s_off);
    moe_down_routed<L>(p, smem, s_tp, s_off, 0, 2 * MOE_GROUP());
    {
        __syncthreads();
        pg8::Gemm g; g.A = p->hsh; g.Bt = p->sh_dt[L]; g.M = T_; g.N = D_; g.K = 1024;
        pg8::StaticOrder S; S.init(T_, D_, (int)gridDim.x, (int)blockIdx.x);
        pg8::gemm_phase<PgEpiResid, pg8::StaticOrder>((PG8_LAS unsigned char*)smem, g, S, PgEpiResid{p->y2, XBres, D_}, nullptr);
        __syncthreads();
    }
    moe_down_routed<L>(getp(), smem, s_tp, s_off, 2 * MOE_GROUP(), 1 << 20);
}
struct ColRot { int cbase; bool rot;
    __device__ __forceinline__ const u16* base16(const u16* B, int) const { return B; }
    __device__ __forceinline__ unsigned off8(int hsel, int ch8) const { const int v = hsel * 64 + ch8 * 8; const int s = v >> 6, u = v & 63;
        return rot ? (unsigned)(cbase + s * 32 + (u < 32 ? u : 128 + (u - 32))) : (unsigned)(cbase + v); }
    __device__ __forceinline__ int vchunk(int hsel, int ch8) const { return hsel * 8 + ch8; }
    __device__ __forceinline__ const float* base(const float* B, int) const { return B; }
    __device__ __forceinline__ unsigned off4(int hsel, int g4) const { const int v = hsel * 64 + g4 * 4; const int s = v >> 6, u = v & 63;
        return rot ? (unsigned)(cbase + s * 32 + (u < 32 ? u : 128 + (u - 32))) : (unsigned)(cbase + v); }
    __device__ __forceinline__ int vcol4(int hsel, int g4) const { return hsel * 64 + g4 * 4; } };

__device__ __forceinline__ float ret_log2g(int h) { return log1pf(-exp2f(-5.f - (float)h)) * LOG2E_; }

struct EpiRetQK {
    KP p; int row0; int hd; int tp; bool isk;
    __device__ __forceinline__ void operator()(Acc& acc, unsigned char* stg) const {
        const float l2g = ret_log2g(hd);
        const int wc0 = WC0_, rb = row0 + WR0_;
        const int dbase = tp * 64 + (wc0 >> 1);
        const float* cR = p->cosR; const float* sR = p->sinR;
        const int hoff = hd * 256 + dbase;
        if (!isk) {
            u16* qr = p->qr; u16* qx = p->qx;
            stage_pairs_pre<CS8>(acc, stg,
              [=](int r, int c4) -> CS8 { CS8 t; t.c = *(const f32x4*)(cR + (rb + r) * 128 + dbase + c4); t.s = *(const f32x4*)(sR + (rb + r) * 128 + dbase + c4); return t; },
              [=](int r, int c4, f32x4 x1, f32x4 x2, CS8 cs) {
                const int t = rb + r;
                const f32x4 c = cs.c, s = cs.s;
                const f32x4 lo = x1 * c - x2 * s, hi = x1 * s + x2 * c;
                const float xi = exp2f((float)((t & 127) + 1) * l2g);
                const size_t o = (size_t)t * 2048 + hoff + c4;
                *(u32x2*)(qr + o) = pack4(lo); *(u32x2*)(qr + o + 128) = pack4(hi);
                *(u32x2*)(qx + o) = pack4(lo * xi); *(u32x2*)(qx + o + 128) = pack4(hi * xi);
            });
        } else {
            const int lane = ltid() & 63, fr = lane & 15, fq = lane >> 4;
#pragma unroll
            for (int m = 0; m < 4; ++m) {
                const int r0 = rb + m * 16 + fq * 4;
#pragma unroll
                for (int n = 0; n < 2; ++n) {
                    const int i = dbase + n * 16 + fr;
                    float zl[4], zh[4];
#pragma unroll
                    for (int j = 0; j < 4; ++j) {
                        const int t = r0 + j;
                        const float c = cR[t * 128 + i], s = sR[t * 128 + i];
                        const float x1 = acc[m][n][j], x2 = acc[m][n + 2][j];
                        const float ze = exp2f((float)(127 - (t & 127)) * l2g) * 0.0625f;
                        zl[j] = (x1 * c - x2 * s) * ze; zh[j] = (x1 * s + x2 * c) * ze;
                    }
                    u32x2 a, b;
                    a.x = pack2(zl[0], zl[1]); a.y = pack2(zl[2], zl[3]);
                    b.x = pack2(zh[0], zh[1]); b.y = pack2(zh[2], zh[3]);
                    *(u32x2*)(p->kzT + (size_t)(hd * 256 + i) * T_ + r0) = a;
                    *(u32x2*)(p->kzT + (size_t)(hd * 256 + i + 128) * T_ + r0) = b;
                }
            }
            u16* kr = p->kr;
            stage_pairs_pre<CS8>(acc, stg,
              [=](int r, int c4) -> CS8 { CS8 t; t.c = *(const f32x4*)(cR + (rb + r) * 128 + dbase + c4); t.s = *(const f32x4*)(sR + (rb + r) * 128 + dbase + c4); return t; },
              [=](int r, int c4, f32x4 x1, f32x4 x2, CS8 cs) {
                const int t = rb + r;
                const f32x4 c = cs.c, s = cs.s;
                const f32x4 lo = (x1 * c - x2 * s) * 0.0625f, hi = (x1 * s + x2 * c) * 0.0625f;
                const size_t o = (size_t)t * 2048 + hoff + c4;
                *(u32x2*)(kr + o) = pack4(lo); *(u32x2*)(kr + o + 128) = pack4(hi);
            });
        }
    }
};
struct EpiRetV {
    u16* vT; int row0, col0;
    __device__ __forceinline__ void operator()(Acc& acc, unsigned char* stg) const {
        const int lane = ltid() & 63, fr = lane & 15, fq = lane >> 4, wr0 = WR0_, wc0 = WC0_;
#pragma unroll
        for (int m = 0; m < 4; ++m) {
            const int r0 = row0 + wr0 + m * 16 + fq * 4;
#pragma unroll
            for (int n = 0; n < 4; ++n) {
                u32x2 o; o.x = pack2(acc[m][n][0], acc[m][n][1]); o.y = pack2(acc[m][n][2], acc[m][n][3]);
                *(u32x2*)(vT + (size_t)(col0 + wc0 + n * 16 + fr) * T_ + r0) = o;
            }
        }
    }
};
struct EpiSilu {
    u16* C; int ldc; int row0, col0;
    __device__ __forceinline__ void operator()(Acc& acc, unsigned char* stg) const {
        const int rb = row0 + WR0_, cb = col0 + WC0_;
        u16* Cp = C; const int ld = ldc;
        stage_rows(acc, stg, [=](int r, int c4, f32x4 v) {
            f32x4 o;
#pragma unroll
            for (int e = 0; e < 4; ++e) o[e] = silu_f(v[e]);
            *(u32x2*)(Cp + (size_t)(rb + r) * ld + cb + c4) = pack4(o);
        });
    }
};
struct EpiInner {
    u16* C; int hd; int ioff, joff;
    __device__ __forceinline__ void operator()(Acc& acc, unsigned char* stg) const {
        const float l2g = ret_log2g(hd);
        const int wr0 = WR0_, wc0 = WC0_;
        u16* Cp = C; const int io = ioff, jo = joff;
        stage_rows(acc, stg, [=](int r, int c4, f32x4 v) {
            const int i = wr0 + r;
            f32x4 o;
#pragma unroll
            for (int e = 0; e < 4; ++e) { const int d = (i + io) - (wc0 + c4 + e + jo); o[e] = d >= 0 ? v[e] * exp2f((float)d * l2g) : 0.f; }
            *(u32x2*)(Cp + (size_t)(i + io) * RET_CH + jo + wc0 + c4) = pack4(o);
        });
    }
};


__device__ __forceinline__ void ph_ret_a(KP p, u16* lds) {
    constexpr int NTI = RET_CH / 128, NSUB = NTI * (NTI + 1) / 2;
    const int nkv = 8 * RET_NCH * 4, nin = 8 * RET_NCH * NSUB;
    for (int t = blockIdx.x; t < nkv + nin; t += gridDim.x) {
        Acc acc; acc_zero(acc);
        if (t < nkv) {
            const int hc = t >> 2, nt = t & 3, hd = hc / RET_NCH, c = hc % RET_NCH;
#pragma unroll 1
            for (int half = 0; half < RET_CH / 128; ++half) {
                const int t0 = c * RET_CH + half * 128;
                gemm_kk128(acc, p->kz + (size_t)t0 * 2048 + hd * 256, 2048, p->v1 + (size_t)t0 * 4096 + hd * 512 + nt * 128, 4096, lds);
            }
            EpiBF16{p->KVt + (size_t)hc * 512 * 256, 512, 0, nt * 128}(acc, (unsigned char*)lds);
        } else {
            const int u = t - nkv, hc = u / NSUB, s = u - hc * NSUB, hd = hc / RET_NCH, c = hc % RET_NCH;
            int it = 0;
            while ((it + 1) * (it + 2) / 2 <= s) ++it;
            const int jt = s - it * (it + 1) / 2;
            gemm_accum<B_BF16_NK, true>(acc, p->qr + hd * 256, 2048, RowId{c * RET_CH + it * 128}, p->kr + hd * 256, 2048, RowId{c * RET_CH + jt * 128}, 256, lds);
            if (ksplit_reduce(acc, lds)) EpiInner{p->innerG + (size_t)hc * RET_CH * RET_CH, hd, it * 128, jt * 128}(acc, (unsigned char*)lds + 65536);
        }
    }
}
__device__ __forceinline__ void ph_ret_b(KP p) {
    const int gtid = blockIdx.x * NT + ltid(), gsz = gridDim.x * NT;
    for (int e = gtid; e < 8 * 512 * 256 / 8; e += gsz) {
        const int hd = e / (512 * 256 / 8);
        const int within = e - hd * (512 * 256 / 8);
        const float gch = exp2f((float)RET_CH * ret_log2g(hd));
        u16* base = p->KVt + (size_t)hd * RET_NCH * 512 * 256 + (size_t)within * 8;
        float r[8];
#pragma unroll
        for (int i = 0; i < 8; ++i) r[i] = 0.f;
        u32x4 cur[8], nxt[8];
#pragma unroll
        for (int i = 0; i < 8; ++i) cur[i] = *(const u32x4*)(base + (size_t)i * 512 * 256);
#pragma unroll 1
        for (int g = 0; g < RET_NCH / 8; ++g) {
            const int gn_ = g < RET_NCH / 8 - 1 ? g + 1 : RET_NCH / 8 - 1;
#pragma unroll
            for (int i = 0; i < 8; ++i) nxt[i] = *(const u32x4*)(base + (size_t)(gn_ * 8 + i) * 512 * 256);
#pragma unroll
            for (int i = 0; i < 8; ++i) {
                const u32x4 in = cur[i];
                u32x4 o;
                o.x = pack2(r[0], r[1]); o.y = pack2(r[2], r[3]); o.z = pack2(r[4], r[5]); o.w = pack2(r[6], r[7]);
                *(u32x4*)(base + (size_t)(g * 8 + i) * 512 * 256) = o;
#pragma unroll
                for (int k = 0; k < 4; ++k) {
                    r[2 * k] = r[2 * k] * gch + __uint_as_float(in[k] << 16);
                    r[2 * k + 1] = r[2 * k + 1] * gch + __uint_as_float(in[k] & 0xffff0000u);
                }
            }
#pragma unroll
            for (int i = 0; i < 8; ++i) cur[i] = nxt[i];
        }
    }
}
__device__ __forceinline__ void ph_ret_c(KP p, u16* lds) {
    constexpr int NTI = RET_CH / 128;
    for (int t = blockIdx.x; t < 8 * RET_NCH * NTI * 4; t += gridDim.x) {
        const int nt = t & 3, hc = t / (4 * NTI), it = (int)(((unsigned)(t >> 2) + (unsigned)(hc >> 4)) % (unsigned)NTI), hd = hc / RET_NCH, c = hc % RET_NCH;
        Acc acc; acc_zero(acc);
        gemm_accum<B_BF16_KN, true>(acc, p->innerG + (size_t)hc * RET_CH * RET_CH + (size_t)(it * 128) * RET_CH, RET_CH, RowId{0},
                                    p->v1 + (size_t)(c * RET_CH) * 4096, 4096, ColOff{hd * 512 + nt * 128}, 128 * (it + 1), lds);
        gemm_accum<B_BF16_KN, true>(acc, p->qx + hd * 256, 2048, RowId{c * RET_CH + it * 128}, p->KVt + (size_t)hc * 512 * 256, 512, ColOff{nt * 128}, 256, lds);
        if (ksplit_reduce(acc, lds)) EpiBF16{p->obuf, 4096, c * RET_CH + it * 128, hd * 512 + nt * 128}(acc, (unsigned char*)lds + 65536);
    }
}
__device__ __forceinline__ void ph_gn(KP p) {
    const int lane = ltid() & 63;
    const int gw = (blockIdx.x * NT + ltid()) >> 6, nw = (gridDim.x * NT) >> 6;
    const int hd = gw & 7;
    float gg[8], gb[8];
    {
        const f32x4 g0 = *(const f32x4*)(p->gn_g + hd * 512 + lane * 8), g1 = *(const f32x4*)(p->gn_g + hd * 512 + lane * 8 + 4);
        const f32x4 b0 = *(const f32x4*)(p->gn_b + hd * 512 + lane * 8), b1 = *(const f32x4*)(p->gn_b + hd * 512 + lane * 8 + 4);
#pragma unroll
        for (int i = 0; i < 4; ++i) { gg[i] = g0[i]; gg[4 + i] = g1[i]; gb[i] = b0[i]; gb[4 + i] = b1[i]; }
    }
    for (int r0 = gw; r0 < T_ * 8; r0 += 4 * nw) {
        u32x4 in[4], gin[4];
#pragma unroll
        for (int u = 0; u < 4; ++u) {
            const int r = r0 + u * nw < T_ * 8 ? r0 + u * nw : r0;
            const size_t off = (size_t)(r >> 3) * 4096 + hd * 512 + lane * 8;
            in[u] = *(const u32x4*)(p->obuf + off); gin[u] = *(const u32x4*)(p->sg + off);
        }
#pragma unroll
        for (int u = 0; u < 4; ++u) {
            const int r = r0 + u * nw;
            if (r >= T_ * 8) break;
            const size_t off = (size_t)(r >> 3) * 4096 + hd * 512 + lane * 8;
            float v[8];
#pragma unroll
            for (int i = 0; i < 4; ++i) { v[2 * i] = __uint_as_float(in[u][i] << 16); v[2 * i + 1] = __uint_as_float(in[u][i] & 0xffff0000u); }
            float s = 0.f;
#pragma unroll
            for (int i = 0; i < 8; ++i) s += v[i];
            const float mu = wave_sum(s) * (1.f / 512.f);
            float var = 0.f;
#pragma unroll
            for (int i = 0; i < 8; ++i) { const float d = v[i] - mu; var += d * d; }
            var = wave_sum(var) * (1.f / 512.f);
            const float rs = rsqrtf(var + 1e-5f);
            float o[8];
#pragma unroll
            for (int i = 0; i < 8; ++i) {
                const float sgv = (i & 1) ? __uint_as_float(gin[u][i >> 1] & 0xffff0000u) : __uint_as_float(gin[u][i >> 1] << 16);
                o[i] = ((v[i] - mu) * rs * gg[i] + gb[i]) * sgv;
            }
            u32x4 w; w.x = pack2(o[0], o[1]); w.y = pack2(o[2], o[3]); w.z = pack2(o[4], o[5]); w.w = pack2(o[6], o[7]);
            *(u32x4*)(p->gated + off) = w;
        }
    }
}

#define MAXLDS_(a, b) ((a) > (b) ? (a) : (b))
#define PHASE_LDS MAXLDS_(MAXLDS_(MAXLDS_(GEMM_LDS_BYTES, 2 * ATT_LDS_BYTES), 8 * 8192), 131072)
#define LDS_TOTAL (PHASE_LDS + 16 + 16 + 65 * 4 * 2 + 8)

__global__ void __launch_bounds__(NT, 2) mega(Params kparams) {
    extern __shared__ __attribute__((aligned(16))) unsigned char smem[];
    u16* lds = (u16*)smem;
    uint4* xbw = (uint4*)(smem + PHASE_LDS);
    unsigned* misc = (unsigned*)(smem + PHASE_LDS + 16);
    int* s_tp = (int*)(smem + PHASE_LDS + 32);
    int* s_off = s_tp + 65;
    if (threadIdx.x == 0) *xbw = make_uint4(0u, 0u, 0u, 0u);
    __syncthreads();
    XcdBarrier bar = xcd_barrier_post(getp()->bar, (volatile LAS unsigned*)xbw);

    ph_prep(getp());
    {
        KP p = getp();
        for (int u = blockIdx.x; u < 32 * 14; u += gridDim.x) cvtT_block(p->w_in0, p->w_in0t, 2048, IN_AB, u / 14, u % 14, smem);
    }
    xcd_barrier(bar);
    {
        KP p = getp();
        __syncthreads();
        pg8::Gemm g; g.A = p->xb; g.Bt = p->w_in0t; g.M = T_; g.N = 3584; g.K = D_;
        pg8::StaticOrder S; S.init(T_, 3584, (int)gridDim.x, (int)blockIdx.x);
        pg8::gemm_phase<PgEpiBf16N, pg8::StaticOrder>((PG8_LAS unsigned char*)smem, g, S, PgEpiBf16N{p->H0, IN_AB, IN_AB}, nullptr);
        __syncthreads();
    }
    xcd_barrier(bar);
    ph_post0(getp());
    xcd_barrier(bar);
    {
        KP p = getp();
        const int ntm = T_ / BM;
        const int n1 = ntm * 12, n2 = ntm * 16, n3 = T_ / 16;
        for (;;) {
            __syncthreads();
            if (threadIdx.x == 0) misc[0] = atomicAdd(&p->ctl[CTL_QUEUE + 2], 1u);
            __syncthreads();
            const int it = (int)misc[0];
            if (it >= n1 + n2 + n3) break;
            if (it >= n3) {
                const int t = it - n3;
                const bool isq = t < n1;
                const int u = isq ? t : t - n1, nt = u / ntm, mt = u % ntm;
                Acc acc; acc_zero(acc);
                gemm_accum<B_BF16_KN, false>(acc, isq ? p->cqn : p->ckvn, isq ? 512 : 256, RowId{mt * BM}, isq ? p->w_uqb : p->w_ukvb,
                                     isq ? 1536 : 2048, ColOff{nt * BN}, isq ? 512 : 256, lds);
                if (isq) EpiQa{p->qa, p->cosA, p->sinA, mt * BM, nt * BN}(acc, smem);
                else EpiKva{p->ka, p->vaT, mt * BM, nt * BN}(acc, smem);
            } else {
                indexer_item(p, n3 - 1 - it);
            }
        }
    }
    xcd_barrier(bar);
    ph_topk(getp(), smem);
    xcd_barrier(bar);
    ph_attn(getp(), smem, misc);
    xcd_barrier(bar);
    ph_mla_merge(getp());
    xcd_barrier(bar);
    {
        KP p = getp();
        __syncthreads();
        pg8::Gemm g; g.A = p->outcat; g.Bt = p->w_out0t; g.M = T_; g.N = D_; g.K = D_;
        pg8::StaticOrder S; S.init(T_, D_, (int)gridDim.x, (int)blockIdx.x);
        pg8::gemm_phase<PgEpiResidF, pg8::StaticOrder>((PG8_LAS unsigned char*)smem, g, S, PgEpiResidF{p->ybuf, p->x, D_}, nullptr);
        __syncthreads();
    }
    xcd_barrier(bar);
    { KP p = getp(); ph_ln_router(p, p->ybuf, p->ln_mix_g[0], p->ln_mix_b[0], p->xab, p->xlb, smem, p->ctl + CTL_CNT0, p->list); }
    xcd_barrier(bar);
    { KP p = getp(); ph_moe_up<0>(p, p->xab, smem, s_tp, s_off); }
    xcd_barrier(bar);
    { KP p = getp(); ph_moe_down<0>(p, p->xab, smem, s_tp, s_off); }
    xcd_barrier(bar);
    { KP p = getp(); ph_ln<true, false, true, false>(p, p->y2, p->ln_ffn_g[0], p->ln_ffn_b[0], nullptr, p->xcb, nullptr); }
    xcd_barrier(bar);
    {
        KP p = getp();
        __syncthreads();
        pg8::Gemm g; g.A = p->xcb; g.Bt = p->w_in1t; g.M = T_; g.N = IN_C; g.K = D_;
        pg8::StaticOrder S; S.init(T_, IN_C, (int)gridDim.x, (int)blockIdx.x);
        pg8::gemm_phase<PgEpiL1, pg8::StaticOrder>((PG8_LAS unsigned char*)smem, g, S, PgEpiL1{p}, nullptr);
        __syncthreads();
    }
    xcd_barrier(bar);
    ph_ret_a(getp(), lds);
    xcd_barrier(bar);
    ph_ret_b(getp());
    xcd_barrier(bar);
    ph_ret_c(getp(), lds);
    xcd_barrier(bar);
    ph_gn(getp());
    xcd_barrier(bar);
    {
        KP p = getp();
        __syncthreads();
        pg8::Gemm g; g.A = p->gated; g.Bt = p->w_out1t; g.M = T_; g.N = D_; g.K = 4096;
        pg8::StaticOrder S; S.init(T_, D_, (int)gridDim.x, (int)blockIdx.x);
        pg8::gemm_phase<PgEpiResid, pg8::StaticOrder>((PG8_LAS unsigned char*)smem, g, S, PgEpiResid{p->ybuf, p->xcb, D_}, nullptr);
        __syncthreads();
    }
    xcd_barrier(bar);
    { KP p = getp(); ph_ln_router(p, p->ybuf, p->ln_mix_g[1], p->ln_mix_b[1], p->xab, p->xlb, smem, p->ctl + CTL_CNT1, p->list); }
    xcd_barrier(bar);
    { KP p = getp(); ph_moe_up<1>(p, p->xab, smem, s_tp, s_off); }
    xcd_barrier(bar);
    { KP p = getp(); ph_moe_down<1>(p, p->xab, smem, s_tp, s_off); }
    xcd_barrier(bar);
    { KP p = getp(); ph_ln<true, false, false, true>(p, p->y2, p->ln_ffn_g[1], p->ln_ffn_b[1], p->out, nullptr, nullptr); }
    {
        KP p = getp();
        if (xb_ld(&p->bar[XB_TMO])) {
            asm volatile("s_waitcnt vmcnt(0)" ::: "memory");
            for (int i = blockIdx.x * NT + ltid(); i < p->out_size; i += gridDim.x * NT) p->out[i] = __uint_as_float(0x7fc00000u);
        }
    }
}

extern "C" void kernel_launch(void* const* d_in, const int* in_sizes, int n_in,
                              void* d_out, int out_size, void* d_ws, size_t ws_size,
                              hipStream_t stream) {
    const size_t kDynLds = LDS_TOTAL;
    static int grid = 0;
    if (!grid) {
        int dev = 0, cus = 0, per_cu = 0;
        (void)hipGetDevice(&dev);
        (void)hipDeviceGetAttribute(&cus, hipDeviceAttributeMultiprocessorCount, dev);
        (void)hipFuncSetAttribute((const void*)mega, hipFuncAttributeMaxDynamicSharedMemorySize, (int)kDynLds);
        (void)hipOccupancyMaxActiveBlocksPerMultiprocessor(&per_cu, mega, NT, kDynLds);
        grid = cus * (per_cu >= 1 ? 1 : 0);
    }
    unsigned char* ws = (unsigned char*)d_ws;
    size_t off = 0;
    auto take = [&](size_t bytes) { void* q = ws + off; off += (bytes + 255) & ~(size_t)255; return q; };
    Params p{};
    p.bar = (unsigned*)take(XCD_BAR_WORDS * 4);
    p.ctl = (unsigned*)take(CTL_WORDS * 4);
    const size_t ctl_bytes = off;
    (void)hipMemsetAsync(ws, 0, ctl_bytes, stream);
    auto F = [&](int i) { return (const float*)d_in[i]; };
    p.x = F(0); p.pos = (const int*)d_in[1]; p.router_w = F(2); p.router_b = F(3);
    p.w_in0 = F(4); p.q_norm = F(5); p.w_uq = F(6); p.kv_norm = F(7); p.w_ukv = F(8); p.w_out0 = F(9);
    p.w_in1 = F(10); p.gn_g = F(11); p.gn_b = F(12); p.w_out1 = F(13);
    for (int l = 0; l < 2; ++l) {
        const int b = 14 + 10 * l;
        p.ln_mix_g[l] = F(b); p.ln_mix_b[l] = F(b + 1);
        p.moe_wg[l] = F(b + 2); p.moe_wu[l] = F(b + 3); p.moe_wd[l] = F(b + 4);
        p.sh_g[l] = F(b + 5); p.sh_u[l] = F(b + 6); p.sh_d[l] = F(b + 7);
        p.ln_ffn_g[l] = F(b + 8); p.ln_ffn_b[l] = F(b + 9);
    }
    p.out = (float*)d_out;
    p.w_in0b = nullptr; p.w_in0t = (u16*)take((size_t)3584 * D_ * 2); p.w_uqb = (u16*)take(512 * 1536 * 2); p.w_ukvb = (u16*)take(256 * 2048 * 2);
    p.w_out0b = nullptr; p.w_in1b = nullptr; p.w_out1b = nullptr; p.w_out1t = (u16*)take((size_t)4096 * D_ * 2); p.w_out0t = (u16*)take((size_t)D_ * D_ * 2); p.w_in1t = (u16*)take((size_t)D_ * IN_C * 2);
    for (int l = 0; l < 2; ++l) { p.sh_gb[l] = nullptr; p.sh_ub[l] = nullptr; p.sh_db[l] = nullptr; p.sh_gut[l] = (u16*)take((size_t)2048 * D_ * 2); p.sh_dt[l] = (u16*)take((size_t)D_ * 1024 * 2); }
    const size_t T = T_;
    p.cosA = (float*)take(T * 32 * 4); p.sinA = (float*)take(T * 32 * 4);
    p.cosR = (float*)take(T * 128 * 4); p.sinR = (float*)take(T * 128 * 4);
    p.xb = (u16*)take(T * 2048 * 2); p.H0 = (u16*)take(T * IN_AB * 2);
    p.cqn = (u16*)take(T * 512 * 2); p.ckvn = (u16*)take(T * 256 * 2); p.kpe = (u16*)take(T * 64 * 2);
    p.qb = (u16*)take(T * 1024 * 2); p.kb = (u16*)take(T * 256 * 2); p.vb = (u16*)take(T * 256 * 2);
    p.iqb = (u16*)take(T * 1024 * 2); p.ikb = (u16*)take(T * 64 * 2); p.iwf = (float*)take(T * 16 * 4);
    p.qa = (u16*)take(T * 1536 * 2); p.ka = (u16*)take(T * 1024 * 2); p.vaT = (u16*)take(T * 1024 * 2);
    p.scores = (float*)take(T * T * 4); p.sel = (u16*)take(T * 256 * 2); p.outcat = (u16*)take(T * 2048 * 2); p.mla_po = (float*)take((size_t)256 * 256 * 128 * 4); p.mla_ml = (float*)take((size_t)256 * 256 * 2 * 4);
    p.ybuf = (u16*)take(T * 2048 * 2); p.xab = (u16*)take(T * 2048 * 2); p.xlb = (u16*)take(T * 2048 * 2); p.whT = (u16*)take(64 * 2048 * 2); p.wlT = (u16*)take(64 * 2048 * 2);
    p.y2 = (u16*)take(T * 2048 * 2); p.xcb = (u16*)take(T * 2048 * 2);
    p.tok_e = (int*)take(T * 2 * 4); p.tok_g = (float*)take(T * 2 * 4); p.list = (int*)take(2 * 64 * T * 4);
    p.hbuf = (u16*)take(T * 2 * 512 * 2); p.hsh = (u16*)take(T * 1024 * 2); p.yr = (u16*)take(T * 2 * 2048 * 2);
    p.qr = (u16*)take(T * 2048 * 2); p.qx = (u16*)take(T * 2048 * 2); p.kr = (u16*)take(T * 2048 * 2);
    p.kzT = nullptr; p.kz = (u16*)take(T * 2048 * 2); p.v1 = (u16*)take(T * 4096 * 2); p.sg = (u16*)take(T * 4096 * 2);
    p.innerG = (u16*)take((size_t)8 * RET_NCH * RET_CH * RET_CH * 2);
    {
        unsigned char* sbase = (unsigned char*)p.scores;
        p.KVt = (u16*)sbase; p.obuf = (u16*)(sbase + ((size_t)128 << 20)); p.gated = (u16*)(sbase + ((size_t)192 << 20));
    }
    p.out_size = out_size; p.pad_ = 0;
    if (off > ws_size) return;
    mega<<<dim3(grid), dim3(NT), kDynLds, stream>>>(p);
}
```
